# Optimizing an MI355X kernel written in HIP

```python
import math
import jax
import jax.numpy as jnp
from jax import lax
import numpy as np

D_MODEL = 1024
BATCH = 4
SEQ = 4096
DEPTH = 2

GRID_W = 64
CTX_LEN = 256
EPS = 1e-6
F32 = jnp.float32

POOL_WINDOWS = (2, 4, 8, 16)
D_POOL = D_MODEL
POOL_GROUP = D_POOL // len(POOL_WINDOWS)

D_MLSTM = D_MODEL
MLSTM_HEADS = 4
MLSTM_HEAD_DIM = D_MLSTM // MLSTM_HEADS
MLSTM_CHUNK = 64
QK_CONV = 4

D_SSD = D_MODEL
SSD_HEAD_DIM = 64
SSD_HEADS = D_SSD // SSD_HEAD_DIM
SSD_GROUPS = 4
SSD_STATE = 128
SSD_CHUNK = 64
SSD_CONV = 4
D_XBC = D_SSD + 2 * SSD_GROUPS * SSD_STATE

N_BRANCH = 3
D_BRANCH = D_MODEL

N_EXPERT_GROUPS = 4
EXPERTS_PER_GROUP = 8
N_EXPERTS = N_EXPERT_GROUPS * EXPERTS_PER_GROUP
TOP_K_IN_GROUP = 2
D_EXPERT = 512
MOE_BLOCK = 256

IN_SPLITS = (D_POOL,
             D_MLSTM, D_MLSTM, D_MLSTM, D_MLSTM,
             4 * MLSTM_HEADS,
             D_SSD, D_SSD,
             SSD_GROUPS * SSD_STATE, SSD_GROUPS * SSD_STATE,
             2 * SSD_HEADS,
             N_BRANCH * D_MODEL)
D_IN = sum(IN_SPLITS)

kernel_name = 'hybrid_pool_mlstm_ssd_hmoe_diffusion'


def rmsnorm(x, g):
    xf = x.astype(F32)
    y = xf * lax.rsqrt(jnp.mean(xf * xf, axis=-1, keepdims=True) + EPS)
    return (y * g.astype(F32)).astype(x.dtype)


def modulate(h, shift, scale):
    return h * (1 + scale) + shift


def split_cols(u, sizes):
    out, start = [], 0
    for s in sizes:
        out.append(u[..., start:start + s])
        start += s
    return out


def flip(t):
    return jnp.flip(t, axis=1)


def to_colmajor(t):
    b, l = t.shape[:2]
    rows = l // GRID_W
    return t.reshape(b, rows, GRID_W, *t.shape[2:]).swapaxes(1, 2).reshape(t.shape)


def to_rowmajor(t):
    b, l = t.shape[:2]
    rows = l // GRID_W
    return t.reshape(b, GRID_W, rows, *t.shape[2:]).swapaxes(1, 2).reshape(t.shape)


def short_conv(x, w, b):
    k = w.shape[0]
    l = x.shape[1]
    xp = jnp.pad(x, ((0, 0), (k // 2, k - 1 - k // 2), (0, 0)))
    y = b + w[0] * xp[:, 0:l]
    for j in range(1, k):
        y = y + w[j] * xp[:, j:j + l]
    return y


def window_mean_minus_self(x, w):
    l = x.shape[-2]
    t = np.arange(l)
    lo = np.clip(t - w // 2, 0, l - 1)
    hi = np.clip(t - w // 2 + w - 1, 0, l - 1)
    cnt = jnp.asarray((hi - lo + 1).astype(np.float32))[:, None]
    xf = x.astype(F32)
    cs = jnp.cumsum(xf, axis=-2)
    cs = jnp.concatenate([jnp.zeros_like(cs[..., :1, :]), cs], axis=-2)
    s = jnp.take(cs, hi + 1, axis=-2) - jnp.take(cs, lo, axis=-2)
    return s / cnt - xf


def pool_mixer(a, pool_w, pool_scale, grid):
    b, l, cw = a.shape
    if grid:
        a = a.reshape(b, l // GRID_W, GRID_W, cw)
    groups = jnp.split(a, len(POOL_WINDOWS), axis=-1)
    pooled = jnp.stack([window_mean_minus_self(g, w) for g, w in zip(groups, POOL_WINDOWS)], axis=-2)
    y = jnp.einsum('...gc,gcd->...gd', pooled, pool_w.astype(F32)).reshape(b, l, cw)
    return (y * pool_scale.astype(F32)).astype(a.dtype)


def mlstm_inputs(q, k, v, gates, conv_w, conv_b, gate_b):
    b, l, _ = q.shape
    qk = jax.nn.silu(short_conv(jnp.concatenate([q, k], axis=-1), conv_w, conv_b))
    q, k = jnp.split(qk, 2, axis=-1)
    heads = lambda t: t.astype(F32).reshape(b, l, MLSTM_HEADS, MLSTM_HEAD_DIM)
    q, k, v = heads(q), heads(k) * (MLSTM_HEAD_DIM ** -0.5), heads(v)
    g = gates.astype(F32).reshape(b, l, 4, MLSTM_HEADS) + gate_b.astype(F32)
    fwd = (g[:, :, 0], jax.nn.log_sigmoid(g[:, :, 2]))
    bwd = (g[:, :, 1], jax.nn.log_sigmoid(g[:, :, 3]))
    return q, k, v, fwd, bwd


def mlstm_scan(q, k, v, ig, lf, state):
    b, l, h, dh = q.shape
    nc = l // MLSTM_CHUNK
    causal = jnp.tril(jnp.ones((MLSTM_CHUNK, MLSTM_CHUNK), bool))

    def chunks(t):
        return jnp.moveaxis(t.reshape(b, nc, MLSTM_CHUNK, *t.shape[2:]), 1, 0)

    def step(carry, inp):
        c_st, n_st, m_st = carry
        qc, kc, vc, ic, fc = inp
        cum = jnp.cumsum(fc, axis=1)
        dmat = cum[:, :, None, :] - cum[:, None, :, :] + ic[:, None, :, :]
        dmat = jnp.where(causal[None, :, :, None], dmat, -jnp.inf)
        g = cum + m_st[:, None, :]
        m_t = jnp.maximum(g, dmat.max(axis=2))
        w = jnp.exp(dmat - m_t[:, :, None, :])
        sg = jnp.exp(g - m_t)
        a = w * jnp.einsum('bthd,bshd->btsh', qc, kc)
        num = jnp.einsum('btsh,bshe->bthe', a, vc) + sg[..., None] * jnp.einsum('bthd,bhde->bthe', qc, c_st)
        den = a.sum(axis=2) + sg * jnp.einsum('bthd,bhd->bth', qc, n_st)
        h_out = num / jnp.maximum(jnp.abs(den), jnp.exp(-m_t))[..., None]
        last = cum[:, -1]
        wl_log = last[:, None] - cum + ic
        m_new = jnp.maximum(last + m_st, wl_log.max(axis=1))
        wl = jnp.exp(wl_log - m_new[:, None])
        decay = jnp.exp(last + m_st - m_new)
        c_st = decay[..., None, None] * c_st + jnp.einsum('bsh,bshd,bshe->bhde', wl, kc, vc)
        n_st = decay[..., None] * n_st + jnp.einsum('bsh,bshd->bhd', wl, kc)
        return (c_st, n_st, m_new), h_out

    state, hs = lax.scan(step, state, (chunks(q), chunks(k), chunks(v), chunks(ig), chunks(lf)))
    return jnp.moveaxis(hs, 0, 1).reshape(b, l, h, dh), state


def mlstm_out(h, o, norm_g):
    b, l = o.shape[:2]
    hn = h * lax.rsqrt(jnp.mean(h * h, axis=-1, keepdims=True) + EPS)
    hn = hn.reshape(b, l, D_MLSTM) * norm_g.astype(F32)
    return (jax.nn.sigmoid(o.astype(F32)) * hn).astype(o.dtype)


def ssd_inputs(xs, bs, cs, dt_raw, conv_w, conv_b, dt_bias):
    b, l, _ = xs.shape
    xbc = jax.nn.silu(short_conv(jnp.concatenate([xs, bs, cs], axis=-1), conv_w, conv_b))
    xs, bs, cs = split_cols(xbc, (D_SSD, SSD_GROUPS * SSD_STATE, SSD_GROUPS * SSD_STATE))
    xh = xs.astype(F32).reshape(b, l, SSD_HEADS, SSD_HEAD_DIM)
    bg = bs.astype(F32).reshape(b, l, SSD_GROUPS, SSD_STATE)
    cg = cs.astype(F32).reshape(b, l, SSD_GROUPS, SSD_STATE)
    dt = jax.nn.softplus(dt_raw.astype(F32).reshape(b, l, 2, SSD_HEADS) + dt_bias.astype(F32))
    return xh, bg, cg, dt[:, :, 0], dt[:, :, 1]


def ssd_scan(x, dt, a_neg, bm, cm, s0):
    b, l, h, p = x.shape
    g, n = bm.shape[2:]
    hg = h // g
    q = SSD_CHUNK
    nc = l // q
    xc = x.reshape(b, nc, q, g, hg, p)
    dtc = dt.reshape(b, nc, q, g, hg)
    bc = bm.reshape(b, nc, q, g, n)
    cc = cm.reshape(b, nc, q, g, n)
    acs = jnp.cumsum(dtc * a_neg.reshape(g, hg), axis=2)
    causal = jnp.tril(jnp.ones((q, q), bool))
    seg = acs[:, :, :, None] - acs[:, :, None, :]
    lmat = jnp.exp(jnp.where(causal[:, :, None, None], seg, -jnp.inf))
    cb = jnp.einsum('bctgn,bcsgn->bctsg', cc, bc)
    xdt = xc * dtc[..., None]
    y_intra = jnp.einsum('bctsg,bctsgh,bcsghp->bctghp', cb, lmat, xdt)
    decay_to_end = jnp.exp(acs[:, :, -1:] - acs)
    chunk_states = jnp.einsum('bcsgn,bcsgh,bcsghp->bcghpn', bc, decay_to_end, xdt)
    chunk_decay = jnp.exp(acs[:, :, -1])

    def step(s, inp):
        st, dec = inp
        return dec[..., None, None] * s + st, s

    s_final, s_starts = lax.scan(step, s0.reshape(b, g, hg, p, n),
                                 (jnp.moveaxis(chunk_states, 1, 0), jnp.moveaxis(chunk_decay, 1, 0)))
    s_starts = jnp.moveaxis(s_starts, 0, 1)
    y_inter = jnp.einsum('bctgn,bcghpn,bctgh->bctghp', cc, s_starts, jnp.exp(acs))
    return (y_intra + y_inter).reshape(b, l, h, p), s_final.reshape(b, h, p, n)


def ssd_out(y, xh, d_skip, z, norm_g):
    b, l = z.shape[:2]
    y = (y + d_skip[:, None] * xh).reshape(b, l, D_SSD)
    return rmsnorm(y * jax.nn.silu(z.astype(F32)), norm_g).astype(z.dtype)


def merge_branches(branches, gate_pre, w_branch, w_out):
    br = jnp.stack(branches, axis=-2)
    proj = jnp.einsum('blid,ide->blie', br, w_branch)
    gate = jax.nn.sigmoid(gate_pre.astype(F32)).reshape(proj.shape).astype(proj.dtype)
    return (gate * proj).sum(axis=-2) @ w_out


def token_mixer(hc, hl, keep_ctx, w_in, pool_w, pool_scale, mlstm_conv_w, mlstm_conv_b, mlstm_gate_b,
                mlstm_norm_g, ssd_conv_w, ssd_conv_b, ssd_dt_bias, ssd_a_log, ssd_d, ssd_norm_g,
                w_branch, w_out):
    b = hl.shape[0]
    uc = hc @ w_in
    ul = hl @ w_in
    pa_c, q_c, k_c, v_c, o_c, ga_c, sx_c, sz_c, sb_c, sc_c, sdt_c, mg_c = split_cols(uc, IN_SPLITS)
    pa_l, q_l, k_l, v_l, o_l, ga_l, sx_l, sz_l, sb_l, sc_l, sdt_l, mg_l = split_cols(ul, IN_SPLITS)

    pool_l = pool_mixer(pa_l, pool_w, pool_scale, True)

    qc, kc, vc, gfc, gbc = mlstm_inputs(q_c, k_c, v_c, ga_c, mlstm_conv_w, mlstm_conv_b, mlstm_gate_b)
    ql, kl, vl, gfl, gbl = mlstm_inputs(to_colmajor(q_l), to_colmajor(k_l), to_colmajor(v_l),
                                        to_colmajor(ga_l), mlstm_conv_w, mlstm_conv_b, mlstm_gate_b)
    zero_m = (jnp.zeros((b, MLSTM_HEADS, MLSTM_HEAD_DIM, MLSTM_HEAD_DIM), F32),
              jnp.zeros((b, MLSTM_HEADS, MLSTM_HEAD_DIM), F32),
              jnp.zeros((b, MLSTM_HEADS), F32))
    h_cf, st_f = mlstm_scan(qc, kc, vc, gfc[0], gfc[1], zero_m)
    h_cb, st_b = mlstm_scan(flip(qc), flip(kc), flip(vc), flip(gbc[0]), flip(gbc[1]), zero_m)
    h_lf, _ = mlstm_scan(ql, kl, vl, gfl[0], gfl[1], st_f)
    h_lb, _ = mlstm_scan(flip(ql), flip(kl), flip(vl), flip(gbl[0]), flip(gbl[1]), st_b)
    mlstm_l = mlstm_out(to_rowmajor(h_lf + flip(h_lb)), o_l, mlstm_norm_g)

    a_neg = -jnp.exp(ssd_a_log.astype(F32))
    d_skip = ssd_d.astype(F32)
    xc_, bc_, cc_, dtf_c, dtb_c = ssd_inputs(sx_c, sb_c, sc_c, sdt_c, ssd_conv_w, ssd_conv_b, ssd_dt_bias)
    xl_, bl_, cl_, dtf_l, dtb_l = ssd_inputs(sx_l, sb_l, sc_l, sdt_l, ssd_conv_w, ssd_conv_b, ssd_dt_bias)
    zero_s = jnp.zeros((b, SSD_HEADS, SSD_HEAD_DIM, SSD_STATE), F32)
    y_cf, s_f = ssd_scan(xc_, dtf_c, a_neg[0], bc_, cc_, zero_s)
    y_cb, s_b = ssd_scan(flip(xc_), flip(dtb_c), a_neg[1], flip(bc_), flip(cc_), zero_s)
    y_lf, _ = ssd_scan(xl_, dtf_l, a_neg[0], bl_, cl_, s_f)
    y_lb, _ = ssd_scan(flip(xl_), flip(dtb_l), a_neg[1], flip(bl_), flip(cl_), s_b)
    ssd_l = ssd_out(y_lf + flip(y_lb), xl_, d_skip, sz_l, ssd_norm_g)

    out_l = merge_branches((pool_l, mlstm_l, ssd_l), mg_l, w_branch, w_out)
    if not keep_ctx:
        return None, out_l
    pool_c = pool_mixer(pa_c, pool_w, pool_scale, False)
    mlstm_c = mlstm_out(h_cf + flip(h_cb), o_c, mlstm_norm_g)
    ssd_c = ssd_out(y_cf + flip(y_cb), xc_, d_skip, sz_c, ssd_norm_g)
    out_c = merge_branches((pool_c, mlstm_c, ssd_c), mg_c, w_branch, w_out)
    return out_c, out_l


def hier_moe(h, w_rg, b_rg, w_re, b_re, w_gate, w_up, w_down):
    b, l, d = h.shape
    n_tok = b * l
    t = h.reshape(n_tok, d)
    lg = (t @ w_rg).astype(F32) + b_rg.astype(F32)
    grp_p = jax.nn.softmax(lg, axis=-1)
    _, grp = lax.top_k(lg, 1)
    p_grp = jnp.take_along_axis(grp_p, grp, axis=-1)
    le = ((t @ w_re).astype(F32) + b_re.astype(F32)).reshape(n_tok, N_EXPERT_GROUPS, EXPERTS_PER_GROUP)
    le = jnp.take_along_axis(le, grp[:, :, None], axis=1)[:, 0]
    top_v, top_i = lax.top_k(le, TOP_K_IN_GROUP)
    weight = p_grp * jax.nn.softmax(top_v, axis=-1)
    expert = grp * EXPERTS_PER_GROUP + top_i

    n_asg = n_tok * TOP_K_IN_GROUP
    flat_e = expert.reshape(-1)
    flat_w = weight.reshape(-1)
    flat_tok = jnp.repeat(jnp.arange(n_tok, dtype=jnp.int32), TOP_K_IN_GROUP)
    order = jnp.argsort(flat_e)
    se = flat_e[order]
    counts = jnp.bincount(flat_e, length=N_EXPERTS)
    starts = jnp.cumsum(counts) - counts
    padded = (counts + MOE_BLOCK - 1) // MOE_BLOCK * MOE_BLOCK
    pends = jnp.cumsum(padded)
    pstarts = pends - padded
    dest = pstarts[se] + (jnp.arange(n_asg, dtype=jnp.int32) - starts[se])
    cap = -(-n_asg // MOE_BLOCK) * MOE_BLOCK + N_EXPERTS * MOE_BLOCK
    n_blocks = cap // MOE_BLOCK
    buf_tok = jnp.full((cap,), n_tok, jnp.int32).at[dest].set(flat_tok[order])
    buf_w = jnp.zeros((cap,), F32).at[dest].set(flat_w[order])
    block_expert = jnp.clip(jnp.searchsorted(pends, jnp.arange(n_blocks) * MOE_BLOCK, side='right'),
                            0, N_EXPERTS - 1)
    t_pad = jnp.concatenate([t, jnp.zeros((1, d), t.dtype)], axis=0)
    xb = t_pad[buf_tok].reshape(n_blocks, MOE_BLOCK, d)

    def expert_block(args):
        xblk, e = args
        a = jax.nn.silu(xblk @ w_gate[e]) * (xblk @ w_up[e])
        return a @ w_down[e]

    yb = lax.map(expert_block, (xb, block_expert)).reshape(cap, d)
    y = jax.ops.segment_sum(yb * buf_w[:, None].astype(yb.dtype), buf_tok, num_segments=n_tok + 1)[:n_tok]
    return y.reshape(b, l, d)


def setup_inputs(seed: int = 0) -> dict:
    key = jax.random.key(seed)
    ks = jax.random.split(key, 32)
    nrm = lambda k, shape, s: jax.random.normal(k, shape, F32) * s
    D = D_MODEL
    dt0 = jnp.exp(jax.random.uniform(ks[17], (DEPTH, 2, SSD_HEADS), F32, math.log(1e-3), math.log(1e-1)))
    return {
        'x': nrm(ks[0], (BATCH, SEQ, D), 1.0),
        'c': nrm(ks[1], (BATCH, D), 1.0),
        'ctx': nrm(ks[2], (BATCH, CTX_LEN, D), 1.0),
        'c_ctx': nrm(ks[3], (D,), 1.0),
        'w_ada': nrm(ks[4], (DEPTH, D, 6 * D), 0.5 * D ** -0.5),
        'b_ada': nrm(ks[5], (DEPTH, 6 * D), 0.02),
        'g_norm_mix': 1.0 + nrm(ks[6], (DEPTH, D), 0.05),
        'g_norm_ffn': 1.0 + nrm(ks[7], (DEPTH, D), 0.05),
        'w_in': nrm(ks[8], (DEPTH, D, D_IN), D ** -0.5),
        'pool_w': nrm(ks[9], (DEPTH, len(POOL_WINDOWS), POOL_GROUP, POOL_GROUP), POOL_GROUP ** -0.5),
        'pool_scale': 1.0 + nrm(ks[10], (DEPTH, D_POOL), 0.05),
        'mlstm_conv_w': nrm(ks[11], (DEPTH, QK_CONV, 2 * D_MLSTM), QK_CONV ** -0.5),
        'mlstm_conv_b': nrm(ks[12], (DEPTH, 2 * D_MLSTM), 0.02),
        'mlstm_gate_b': jnp.concatenate([nrm(ks[13], (DEPTH, 2, MLSTM_HEADS), 0.1),
                                         3.0 + 3.0 * jax.random.uniform(ks[14], (DEPTH, 2, MLSTM_HEADS), F32)],
                                        axis=1),
        'mlstm_norm_g': 1.0 + nrm(ks[15], (DEPTH, D_MLSTM), 0.05),
        'ssd_conv_w': nrm(ks[16], (DEPTH, SSD_CONV, D_XBC), SSD_CONV ** -0.5),
        'ssd_conv_b': nrm(ks[18], (DEPTH, D_XBC), 0.02),
        'ssd_dt_bias': dt0 + jnp.log(-jnp.expm1(-dt0)),
        'ssd_a_log': jnp.log(jax.random.uniform(ks[19], (DEPTH, 2, SSD_HEADS), F32, 1.0, 16.0)),
        'ssd_d': 1.0 + nrm(ks[20], (DEPTH, SSD_HEADS), 0.1),
        'ssd_norm_g': 1.0 + nrm(ks[21], (DEPTH, D_SSD), 0.05),
        'w_branch': nrm(ks[22], (DEPTH, N_BRANCH, D_BRANCH, D), D_BRANCH ** -0.5),
        'w_out': nrm(ks[23], (DEPTH, D, D), D ** -0.5),
        'w_route_group': nrm(ks[24], (DEPTH, D, N_EXPERT_GROUPS), D ** -0.5),
        'b_route_group': nrm(ks[25], (DEPTH, N_EXPERT_GROUPS), 0.01),
        'w_route_expert': nrm(ks[26], (DEPTH, D, N_EXPERTS), D ** -0.5),
        'b_route_expert': nrm(ks[27], (DEPTH, N_EXPERTS), 0.01),
        'w_exp_gate': nrm(ks[28], (DEPTH, N_EXPERTS, D, D_EXPERT), D ** -0.5),
        'w_exp_up': nrm(ks[29], (DEPTH, N_EXPERTS, D, D_EXPERT), D ** -0.5),
        'w_exp_down': nrm(ks[30], (DEPTH, N_EXPERTS, D_EXPERT, D), D_EXPERT ** -0.5),
        'g_final': 1.0 + nrm(ks[31], (D,), 0.05),
    }


def reference(x, c, ctx, c_ctx, w_ada, b_ada, g_norm_mix, g_norm_ffn, w_in, pool_w, pool_scale,
              mlstm_conv_w, mlstm_conv_b, mlstm_gate_b, mlstm_norm_g, ssd_conv_w, ssd_conv_b,
              ssd_dt_bias, ssd_a_log, ssd_d, ssd_norm_g, w_branch, w_out, w_route_group, b_route_group,
              w_route_expert, b_route_expert, w_exp_gate, w_exp_up, w_exp_down, g_final):
    silu_c = jax.nn.silu(c)
    silu_cc = jax.nn.silu(c_ctx)
    lc = ctx.shape[1]
    xl, xc = x, ctx
    for layer in range(DEPTH):
        keep_ctx = layer < DEPTH - 1
        mod_l = [m[:, None, :] for m in jnp.split(silu_c @ w_ada[layer] + b_ada[layer], 6, axis=-1)]
        mod_c = jnp.split(silu_cc @ w_ada[layer] + b_ada[layer], 6, axis=-1)
        hl = modulate(rmsnorm(xl, g_norm_mix[layer]), mod_l[0], mod_l[1])
        hc = modulate(rmsnorm(xc, g_norm_mix[layer]), mod_c[0], mod_c[1])
        oc, ol = token_mixer(hc, hl, keep_ctx, w_in[layer], pool_w[layer], pool_scale[layer],
                             mlstm_conv_w[layer], mlstm_conv_b[layer], mlstm_gate_b[layer], mlstm_norm_g[layer],
                             ssd_conv_w[layer], ssd_conv_b[layer], ssd_dt_bias[layer], ssd_a_log[layer],
                             ssd_d[layer], ssd_norm_g[layer], w_branch[layer], w_out[layer])
        xl = xl + mod_l[2] * ol
        hl = modulate(rmsnorm(xl, g_norm_ffn[layer]), mod_l[3], mod_l[4])
        moe_w = (w_route_group[layer], b_route_group[layer], w_route_expert[layer], b_route_expert[layer],
                 w_exp_gate[layer], w_exp_up[layer], w_exp_down[layer])
        if keep_ctx:
            xc = xc + mod_c[2] * oc
            hc = modulate(rmsnorm(xc, g_norm_ffn[layer]), mod_c[3], mod_c[4])
            y = hier_moe(jnp.concatenate([hc, hl], axis=1), *moe_w)
            xc = xc + mod_c[5] * y[:, :lc]
            xl = xl + mod_l[5] * y[:, lc:]
        else:
            xl = xl + mod_l[5] * hier_moe(hl, *moe_w)
    return rmsnorm(xl, g_final)
```

```cpp
#include <hip/hip_runtime.h>
#include <hip/hip_cooperative_groups.h>
#include <cstdio>
namespace cg = cooperative_groups;

#ifndef SINGLE_LAUNCH
#define SINGLE_LAUNCH 0
#endif
#ifndef USE_MFMA_GEMM
#define USE_MFMA_GEMM 0
#endif

typedef unsigned short bf16_t;
typedef float f32x4 __attribute__((ext_vector_type(4)));
typedef unsigned u32x4 __attribute__((ext_vector_type(4)));
typedef unsigned u32x2 __attribute__((ext_vector_type(2)));

constexpr int NTHR = 512;
constexpr int D = 1024, NB = 4, SEQ = 4096, CTXL = 256;
constexpr int MC = NB * CTXL;
constexpr int ML = NB * SEQ;
constexpr int MT = MC + ML;
constexpr int DIN = 11312, NPAD = 11520;
constexpr int NE = 32, DE = 512;
constexpr int CAP = 43008;
constexpr float EPS = 1e-6f;
constexpr int LDS_BYTES = 155648;

constexpr size_t MiB = 1u << 20;
constexpr size_t WS_HIST = 0;
constexpr size_t WS_BLKEXP = 64 * 1024;
constexpr size_t WS_MOD = 1 * MiB;
constexpr size_t WS_GA = 2 * MiB;
constexpr size_t WS_DT = 4 * MiB;
constexpr size_t WS_EID = 7 * MiB;
constexpr size_t WS_EWT = 7 * MiB + 256 * 1024;
constexpr size_t WS_SLOT = 7 * MiB + 512 * 1024;
constexpr size_t WS_WIN = 8 * MiB;
constexpr size_t WS_WPOOL = 31 * MiB;
constexpr size_t WS_WBR = 32 * MiB;
constexpr size_t WS_WOUT = 38 * MiB;
constexpr size_t WS_XL = 40 * MiB;
constexpr size_t WS_H = 108 * MiB;
constexpr size_t WS_BR = 142 * MiB;
constexpr size_t WS_Q = 244 * MiB, WS_K = 278 * MiB, WS_V = 312 * MiB;
constexpr size_t WS_SX = 346 * MiB, WS_SB = 380 * MiB, WS_SC = 397 * MiB;
constexpr size_t WS_MG = 414 * MiB;
constexpr size_t WS_HF = 516 * MiB, WS_HB = 550 * MiB;
constexpr size_t WS_END = 584 * MiB;
constexpr size_t WS_YF = WS_Q, WS_YB = WS_K;
constexpr size_t WS_MERGED = WS_Q;
constexpr size_t WS_EW1 = 244 * MiB;
constexpr size_t WS_EW2 = 308 * MiB;
constexpr size_t WS_XB = WS_BR;
constexpr size_t WS_ACT = WS_SX;
constexpr size_t WS_Y = WS_MG;

struct Params {
    const float *x, *c, *ctx, *c_ctx, *w_ada, *b_ada, *g_mix, *g_ffn, *w_in, *pool_w, *pool_scale,
        *mconv_w, *mconv_b, *mgate_b, *mnorm_g, *sconv_w, *sconv_b, *sdt_bias, *sa_log, *sd, *snorm_g,
        *w_branch, *w_out, *w_rg, *b_rg, *w_re, *b_re, *w_eg, *w_eu, *w_ed, *g_final;
    float* out; unsigned char* ws; int ph_lo, ph_hi;
};

__device__ __forceinline__ float bf2f(unsigned b) { return __uint_as_float(b << 16); }
__device__ __forceinline__ unsigned f2bf(float f) { unsigned u = __float_as_uint(f); return (u + 0x7fffu + ((u >> 16) & 1u)) >> 16; }
__device__ __forceinline__ unsigned pk2(float lo, float hi) { return f2bf(lo) | (f2bf(hi) << 16); }
__device__ __forceinline__ float lo16(unsigned w) { return __uint_as_float(w << 16); }
__device__ __forceinline__ float hi16(unsigned w) { return __uint_as_float(w & 0xffff0000u); }
__device__ __forceinline__ float wave_sum(float v) {
#pragma unroll
    for (int o = 1; o < 64; o <<= 1) v += __shfl_xor(v, o);
    return v;
}
__device__ __forceinline__ float sigmoid_f(float x) { return 1.f / (1.f + __expf(-x)); }
__device__ __forceinline__ float silu_f(float x) { return x / (1.f + __expf(-x)); }
__device__ __forceinline__ float softplus_f(float x) { return fmaxf(x, 0.f) + log1pf(__expf(-fabsf(x))); }
__device__ __forceinline__ float logsigmoid_f(float x) { return fminf(x, 0.f) - log1pf(__expf(-fabsf(x))); }
__device__ __forceinline__ void unpack8(u32x4 w, float* f) {
    f[0] = lo16(w.x); f[1] = hi16(w.x); f[2] = lo16(w.y); f[3] = hi16(w.y);
    f[4] = lo16(w.z); f[5] = hi16(w.z); f[6] = lo16(w.w); f[7] = hi16(w.w);
}
__device__ __forceinline__ u32x4 pack8(f32x4 a, f32x4 b) {
    u32x4 w; w.x = pk2(a[0], a[1]); w.y = pk2(a[2], a[3]); w.z = pk2(b[0], b[1]); w.w = pk2(b[2], b[3]); return w;
}
__device__ __forceinline__ int scanrow(int row) {
    if (row < MC) return row;
    const int r = row - MC, b = r >> 12, t = r & 4095;
    return MC + (b << 12) + ((t & 63) << 6) + (t >> 6);
}
__device__ __forceinline__ int modrow(int row) { return row < MC ? 4 : ((row - MC) >> 12); }

struct Unit { const bf16_t* A; const bf16_t* B; int pm, pn; };

__device__ __forceinline__ void tile_order(int L, int nM, int nN, int& pm, int& pn) {
    const int nwg = nM * nN; int wgid = L;
    { const int q = nwg / 8, r = nwg % 8, xcd = wgid % 8, off = wgid / 8; wgid = (xcd < r ? xcd * (q + 1) : r * (q + 1) + (xcd - r) * q) + off; }
    const int nig = 8 * nN, gid = wgid / nig, fm = gid * 8, gsz = (nM - fm) < 8 ? (nM - fm) : 8;
    pm = fm + ((wgid % nig) % gsz); pn = (wgid % nig) / gsz;
}
struct SchedGrid {
    const bf16_t* A; const bf16_t* B; int lda, ldb, pm0, nM, nN, G, c;
    __device__ __forceinline__ bool next(int i, Unit& u) const {
        const long L = (long)i * G + c; if (L >= (long)nM * nN) return false;
        int pm, pn; tile_order((int)L, nM, nN, pm, pn); pm += pm0;
        u.pm = pm; u.pn = pn; u.A = A + (size_t)pm * 256 * lda; u.B = B + (size_t)pn * 256 * ldb; return true;
    }
};
struct SchedPool {
    const bf16_t* A; const bf16_t* B; int pm0, nM, G, c;
    __device__ __forceinline__ bool next(int i, Unit& u) const {
        const long L = (long)i * G + c; if (L >= (long)nM * 4) return false;
        const int pm = pm0 + (int)(L >> 2), g = (int)(L & 3);
        u.pm = pm; u.pn = g; u.A = A + (size_t)pm * 256 * 1024 + g * 256; u.B = B + (size_t)g * 65536; return true;
    }
};
struct SchedMoe {
    const bf16_t* A; const bf16_t* B; const int* blkexp; int lda, nblk, G, c; size_t bexp_stride, ldb;
    __device__ __forceinline__ bool next(int i, Unit& u) const {
        const long L = (long)i * G + c; if (L >= (long)nblk * 4) return false;
        const int blk = (int)(L >> 2), nt = (int)(L & 3); const int e = blkexp[blk];
        u.pm = blk; u.pn = nt; u.A = A + (size_t)blk * 256 * lda; u.B = B + (size_t)e * bexp_stride + (size_t)nt * 256 * ldb; return true;
    }
};

struct EpiInproj {
    unsigned char* ws;
    __device__ __forceinline__ void seg(const Unit& u, int, int r, int c0, f32x4& lo0, f32x4& lo1, f32x4& hi0, f32x4& hi1) const {
        const int row = u.pm * 256 + r, t = u.pn;
        bf16_t* dst; size_t ld; int cb;
        if (t < 4) { dst = (bf16_t*)(ws + WS_BR) + (size_t)row * 3072; cb = t * 256; }
        else if (t < 16) { const int w = (t - 4) >> 2; dst = (bf16_t*)(ws + WS_Q + (size_t)w * 34 * MiB) + (size_t)scanrow(row) * 1024; cb = ((t - 4) & 3) * 256; }
        else if (t < 20) { dst = (bf16_t*)(ws + WS_BR) + (size_t)row * 3072 + 1024; cb = (t - 16) * 256; }
        else if (t < 24) { dst = (bf16_t*)(ws + WS_SX) + (size_t)row * 1024; cb = (t - 20) * 256; }
        else if (t < 28) { dst = (bf16_t*)(ws + WS_BR) + (size_t)row * 3072 + 2048; cb = (t - 24) * 256; }
        else if (t < 30) { dst = (bf16_t*)(ws + WS_SB) + (size_t)row * 512; cb = (t - 28) * 256; }
        else if (t < 32) { dst = (bf16_t*)(ws + WS_SC) + (size_t)row * 512; cb = (t - 30) * 256; }
        else if (t < 44) {
            dst = (bf16_t*)(ws + WS_MG) + (size_t)row * 3072; cb = (t - 32) * 256;
#pragma unroll
            for (int j = 0; j < 4; ++j) { lo0[j] = sigmoid_f(lo0[j]); lo1[j] = sigmoid_f(lo1[j]); hi0[j] = sigmoid_f(hi0[j]); hi1[j] = sigmoid_f(hi1[j]); }
        } else {
            if (c0 < 32) { float* d = (float*)(ws + WS_DT) + (size_t)row * 32 + c0; *(f32x4*)d = lo0; *(f32x4*)(d + 4) = lo1; }
            else if (c0 < 48) { float* d = (float*)(ws + WS_GA) + (size_t)scanrow(row) * 16 + (c0 - 32); *(f32x4*)d = lo0; *(f32x4*)(d + 4) = lo1; }
            return;
        }
        *(u32x4*)(dst + cb + c0) = pack8(lo0, lo1);
        *(u32x4*)(dst + cb + 128 + c0) = pack8(hi0, hi1);
    }
};
struct EpiPool {
    bf16_t* BR; const float* scale;
    __device__ __forceinline__ void seg(const Unit& u, int, int r, int c0, f32x4& lo0, f32x4& lo1, f32x4& hi0, f32x4& hi1) const {
        const int row = u.pm * 256 + r, cb = u.pn * 256 + c0;
        const f32x4 s0 = *(const f32x4*)(scale + cb), s1 = *(const f32x4*)(scale + cb + 4), s2 = *(const f32x4*)(scale + cb + 128), s3 = *(const f32x4*)(scale + cb + 132);
        bf16_t* d = BR + (size_t)row * 3072 + cb;
        *(u32x4*)d = pack8(lo0 * s0, lo1 * s1);
        *(u32x4*)(d + 128) = pack8(hi0 * s2, hi1 * s3);
    }
};
struct EpiBranch {
    const bf16_t* MG; bf16_t* OUT;
    __device__ __forceinline__ void seg(const Unit& u, int sg, int r, int c0, f32x4& lo0, f32x4& lo1, f32x4& hi0, f32x4& hi1) const {
        const int row = u.pm * 256 + r, col = u.pn * 256 + c0;
        const bf16_t* g = MG + (size_t)row * 3072 + sg * 1024 + col;
        float a[8], b[8]; unpack8(*(const u32x4*)g, a); unpack8(*(const u32x4*)(g + 128), b);
        if (sg < 2) { float a2[8], b2[8]; unpack8(*(const u32x4*)(g + 1024), a2); unpack8(*(const u32x4*)(g + 1024 + 128), b2);
#pragma unroll
            for (int j = 0; j < 8; ++j) { a[j] = a[j] / a2[j]; b[j] = b[j] / b2[j]; } }
#pragma unroll
        for (int j = 0; j < 4; ++j) { lo0[j] *= a[j]; lo1[j] *= a[4 + j]; hi0[j] *= b[j]; hi1[j] *= b[4 + j]; }
        if (sg == 2) { bf16_t* d = OUT + (size_t)row * 1024 + col; *(u32x4*)d = pack8(lo0, lo1); *(u32x4*)(d + 128) = pack8(hi0, hi1); }
    }
};
struct EpiOut {
    float* XL; const float* mod;
    __device__ __forceinline__ void seg(const Unit& u, int, int r, int c0, f32x4& lo0, f32x4& lo1, f32x4& hi0, f32x4& hi1) const {
        const int row = u.pm * 256 + r, col = u.pn * 256 + c0;
        const float* g = mod + modrow(row) * 6144 + 2 * 1024 + col;
        float* x = XL + (size_t)row * 1024 + col;
        *(f32x4*)x = *(const f32x4*)x + *(const f32x4*)g * lo0;
        *(f32x4*)(x + 4) = *(const f32x4*)(x + 4) + *(const f32x4*)(g + 4) * lo1;
        *(f32x4*)(x + 128) = *(const f32x4*)(x + 128) + *(const f32x4*)(g + 128) * hi0;
        *(f32x4*)(x + 132) = *(const f32x4*)(x + 132) + *(const f32x4*)(g + 132) * hi1;
    }
};
struct EpiMoe1 {
    bf16_t* ACT;
    __device__ __forceinline__ void seg(const Unit& u, int, int r, int c0, f32x4& lo0, f32x4& lo1, f32x4& hi0, f32x4& hi1) const {
        const int row = u.pm * 256 + r;
        f32x4 a, b;
#pragma unroll
        for (int j = 0; j < 4; ++j) { a[j] = silu_f(lo0[j]) * hi0[j]; b[j] = silu_f(lo1[j]) * hi1[j]; }
        *(u32x4*)(ACT + (size_t)row * 512 + u.pn * 128 + c0) = pack8(a, b);
    }
};
struct EpiMoe2 {
    bf16_t* Y;
    __device__ __forceinline__ void seg(const Unit& u, int, int r, int c0, f32x4& lo0, f32x4& lo1, f32x4& hi0, f32x4& hi1) const {
        bf16_t* d = Y + (size_t)(u.pm * 256 + r) * 1024 + u.pn * 256 + c0;
        *(u32x4*)d = pack8(lo0, lo1); *(u32x4*)(d + 128) = pack8(hi0, hi1);
    }
};

template <class Sched, class Epi>
__device__ __forceinline__ void gemm_naive(float* lds, const Sched& S, const Epi& E, int K, int lda, int ldb, int nseg) {
    const int tid = threadIdx.x, tr = tid >> 4, tc = tid & 15;
    float* As = lds; float* Bs = lds + 16 * 128;
    Unit u;
    const int kseg = K / nseg;
    for (int i = 0; S.next(i, u); ++i) {
        for (int half = 0; half < 2; ++half) {
            f32x4 acc[4][4];
#pragma unroll
            for (int a = 0; a < 4; ++a)
#pragma unroll
                for (int b = 0; b < 4; ++b) acc[a][b] = (f32x4){0.f, 0.f, 0.f, 0.f};
            for (int k0 = 0; k0 < K; k0 += 16) {
                __syncthreads();
                { const int row = tid >> 1, kh = (tid & 1) * 8; float fb[8];
                  unpack8(*(const u32x4*)(u.B + (size_t)row * ldb + k0 + kh), fb);
#pragma unroll
                  for (int j = 0; j < 8; ++j) Bs[(kh + j) * 256 + row] = fb[j];
                  if (tid < 256) { float fa[8]; unpack8(*(const u32x4*)(u.A + (size_t)(half * 128 + row) * lda + k0 + kh), fa);
#pragma unroll
                      for (int j = 0; j < 8; ++j) As[(kh + j) * 128 + row] = fa[j]; } }
                __syncthreads();
#pragma unroll 4
                for (int kk = 0; kk < 16; ++kk) {
                    const f32x4 a0 = *(const f32x4*)(As + kk * 128 + tr * 4);
                    const f32x4 b0 = *(const f32x4*)(Bs + kk * 256 + tc * 8), b1 = *(const f32x4*)(Bs + kk * 256 + tc * 8 + 4);
                    const f32x4 b2 = *(const f32x4*)(Bs + kk * 256 + 128 + tc * 8), b3 = *(const f32x4*)(Bs + kk * 256 + 128 + tc * 8 + 4);
#pragma unroll
                    for (int a = 0; a < 4; ++a) { const float av = a0[a];
                        acc[a][0] += av * b0; acc[a][1] += av * b1; acc[a][2] += av * b2; acc[a][3] += av * b3; }
                }
                if (((k0 + 16) % kseg) == 0) { const int sg = (k0 + 16) / kseg - 1;
#pragma unroll
                    for (int a = 0; a < 4; ++a) E.seg(u, sg, half * 128 + tr * 4 + a, tc * 8, acc[a][0], acc[a][1], acc[a][2], acc[a][3]); }
            }
        }
    }
    __syncthreads();
}

template <class Sched, class Epi>
__device__ __forceinline__ void gemm_run(unsigned char* lds, const Sched& S, const Epi& E, int K, int lda, int ldb, int nseg) {
    gemm_naive(reinterpret_cast<float*>(lds), S, E, K, lda, ldb, nseg);
}

__device__ __forceinline__ void tr_item(const float* W, int ld_src, int n_src, int nv, bf16_t* WT, int ld_dst, int n_dst, int kdst0, int k0, float* scr, int lane) {
    const int col = lane & 31;
#pragma unroll 8
    for (int i = 0; i < 32; ++i) { const int kk = 2 * i + (lane >> 5);
        scr[kk * 33 + col] = (col < nv) ? W[(size_t)(k0 + kk) * ld_src + n_src + col] : 0.f; }
    asm volatile("s_waitcnt lgkmcnt(0)" ::: "memory");
    const int c = lane & 7;
#pragma unroll
    for (int j = 0; j < 4; ++j) { const int n = (lane >> 3) + 8 * j; const float* s = scr + (8 * c) * 33 + n;
        u32x4 o; o.x = pk2(s[0 * 33], s[1 * 33]); o.y = pk2(s[2 * 33], s[3 * 33]); o.z = pk2(s[4 * 33], s[5 * 33]); o.w = pk2(s[6 * 33], s[7 * 33]);
        *(u32x4*)(WT + (size_t)(n_dst + n) * ld_dst + kdst0 + k0 + 8 * c) = o; }
    asm volatile("s_waitcnt lgkmcnt(0)" ::: "memory");
}
constexpr int CV_MIX_ITEMS = 5760 + 128 + 1536 + 512;
__device__ __forceinline__ void convert_mix_item(const Params& p, int l, int it, float* scr, int lane) {
    unsigned char* ws = p.ws;
    if (it < 5760) { const int R = it >> 4, kb = it & 15; int src, nv = 32; const int dstn = R * 32;
        if (R < 160) src = dstn; else if (R < 256) src = dstn + 16; else if (R < 352) src = dstn + 48;
        else if (R == 352) src = 8208; else if (R == 353) { src = 5120; nv = 16; } else { src = 0; nv = 0; }
        tr_item(p.w_in + (size_t)l * 1024 * DIN, DIN, src, nv, (bf16_t*)(ws + WS_WIN), 1024, dstn, 0, kb * 64, scr, lane); return; }
    it -= 5760;
    if (it < 128) { const int g = it >> 5, r = it & 31, kb = r >> 3, nb = r & 7;
        tr_item(p.pool_w + (size_t)(l * 4 + g) * 65536, 256, nb * 32, 32, (bf16_t*)(ws + WS_WPOOL) + (size_t)g * 65536, 256, nb * 32, 0, kb * 64, scr, lane); return; }
    it -= 128;
    if (it < 1536) { const int br = it >> 9, r = it & 511, kb = r >> 5, nb = r & 31;
        tr_item(p.w_branch + (size_t)(l * 3 + br) * 1048576, 1024, nb * 32, 32, (bf16_t*)(ws + WS_WBR), 3072, nb * 32, br * 1024, kb * 64, scr, lane); return; }
    it -= 1536;
    { const int kb = it >> 5, nb = it & 31;
      tr_item(p.w_out + (size_t)l * 1048576, 1024, nb * 32, 32, (bf16_t*)(ws + WS_WOUT), 1024, nb * 32, 0, kb * 64, scr, lane); }
}
constexpr int CV_EXP_ITEMS = 32 * 768;
__device__ __forceinline__ void convert_exp_item(const Params& p, int l, int it, float* scr, int lane) {
    unsigned char* ws = p.ws;
    const int e = it / 768, r = it % 768;
    if (r < 512) { const int up = r >> 8, q = r & 255, kb = q >> 4, nb = q & 15; const int c = nb * 32;
        const float* src = (up ? p.w_eu : p.w_eg) + (size_t)(l * 32 + e) * 1024 * 512;
        tr_item(src, 512, c, 32, (bf16_t*)(ws + WS_EW1) + (size_t)e * 1048576, 1024, (c >> 7) * 256 + up * 128 + (c & 127), 0, kb * 64, scr, lane); }
    else { const int q = r - 512, kb = q >> 5, nb = q & 31;
        tr_item(p.w_ed + (size_t)(l * 32 + e) * 512 * 1024, 1024, nb * 32, 32, (bf16_t*)(ws + WS_EW2) + (size_t)e * 524288, 512, nb * 32, 0, kb * 64, scr, lane); }
}

__device__ __forceinline__ void phase_pre(const Params& p, unsigned char* ldsb, int bid, int nb) {
    float* lds = reinterpret_cast<float*>(ldsb);
    const int tid = threadIdx.x, lane = tid & 63, wave = tid >> 6;
    for (int i = tid; i < 5 * 1024; i += NTHR) { const float v = i < 4096 ? p.c[i] : p.c_ctx[i - 4096]; lds[i] = silu_f(v); }
    __syncthreads();
    float* red = lds + 5120;
    for (int it = bid; it < 2 * 96; it += nb) {
        const int l = it / 96, j = (it % 96) * 64 + lane;
        const float* w = p.w_ada + (size_t)l * 1024 * 6144 + j;
        float a0 = 0, a1 = 0, a2 = 0, a3 = 0, a4 = 0;
        for (int k = wave * 128; k < wave * 128 + 128; ++k) { const float wv = w[(size_t)k * 6144];
            a0 += lds[k] * wv; a1 += lds[1024 + k] * wv; a2 += lds[2048 + k] * wv; a3 += lds[3072 + k] * wv; a4 += lds[4096 + k] * wv; }
        red[(wave * 5 + 0) * 64 + lane] = a0; red[(wave * 5 + 1) * 64 + lane] = a1; red[(wave * 5 + 2) * 64 + lane] = a2;
        red[(wave * 5 + 3) * 64 + lane] = a3; red[(wave * 5 + 4) * 64 + lane] = a4;
        __syncthreads();
        if (tid < 320) { const int r = tid >> 6, jj = tid & 63; float s = 0;
            for (int w8 = 0; w8 < 8; ++w8) s += red[(w8 * 5 + r) * 64 + jj];
            const int col = (it % 96) * 64 + jj;
            ((float*)(p.ws + WS_MOD))[(size_t)(l * 5 + r) * 6144 + col] = s + p.b_ada[l * 6144 + col]; }
        __syncthreads();
    }
    float* scr = lds + 8192 + wave * (64 * 33);
    for (int it = bid * 8 + wave; it < CV_MIX_ITEMS; it += nb * 8) convert_mix_item(p, 0, it, scr, lane);
}

__device__ __forceinline__ void norm_mod_row(f32x4 (&v)[4], const float* g, const float* shift, const float* scale, int lane) {
    float s = 0.f;
#pragma unroll
    for (int j = 0; j < 4; ++j) s += (v[j][0] * v[j][0] + v[j][1] * v[j][1]) + (v[j][2] * v[j][2] + v[j][3] * v[j][3]);
    const float rs = 1.0f / sqrtf(wave_sum(s) * (1.f / 1024.f) + EPS);
#pragma unroll
    for (int j = 0; j < 4; ++j) { const int c = 4 * lane + 256 * j; const f32x4 gg = *(const f32x4*)(g + c);
        f32x4 y = v[j] * rs * gg;
        if (shift) { const f32x4 sh = *(const f32x4*)(shift + c), sc = *(const f32x4*)(scale + c); y = y * (1.f + sc) + sh; }
        v[j] = y; }
}
__device__ __forceinline__ void store_row_bf16(bf16_t* dst, const f32x4 (&v)[4], int lane) {
#pragma unroll
    for (int j = 0; j < 4; ++j) { u32x2 w; w.x = pk2(v[j][0], v[j][1]); w.y = pk2(v[j][2], v[j][3]); *(u32x2*)(dst + 4 * lane + 256 * j) = w; }
}

__device__ __forceinline__ void phase_norm1(const Params& p, int bid, int nb) {
    const int lane = threadIdx.x & 63, wave = threadIdx.x >> 6;
    const float* mod = (const float*)(p.ws + WS_MOD);
    for (int m = bid * 8 + wave; m < MT; m += nb * 8) {
        const float* src = m < MC ? p.ctx + (size_t)m * 1024 : p.x + (size_t)(m - MC) * 1024;
        f32x4 v[4];
#pragma unroll
        for (int j = 0; j < 4; ++j) v[j] = *(const f32x4*)(src + 4 * lane + 256 * j);
        float* xl = (float*)(p.ws + WS_XL) + (size_t)m * 1024;
#pragma unroll
        for (int j = 0; j < 4; ++j) *(f32x4*)(xl + 4 * lane + 256 * j) = v[j];
        const float* mr = mod + modrow(m) * 6144;
        norm_mod_row(v, p.g_mix, mr, mr + 1024, lane);
        store_row_bf16((bf16_t*)(p.ws + WS_H) + (size_t)m * 1024, v, lane);
    }
}

__device__ __forceinline__ void pool_window_item(const Params& p, int it) {
    const bf16_t* BR = (const bf16_t*)(p.ws + WS_BR); bf16_t* H = (bf16_t*)(p.ws + WS_H);
    const int row0 = it * 64;
    int seq_lo, seq_hi;
    if (row0 < MC) { seq_lo = (row0 / 256) * 256; seq_hi = seq_lo + 256; } else { seq_lo = row0; seq_hi = row0 + 64; }
    for (int q = threadIdx.x; q < 64 * 128; q += NTHR) {
        const int tl = q >> 7, ch = (q & 127) * 8, g = ch >> 8, w = 2 << g;
        const int row = row0 + tl;
        int lo = row - (w >> 1), hi = lo + w - 1; lo = lo < seq_lo ? seq_lo : lo; hi = hi > seq_hi - 1 ? seq_hi - 1 : hi;
        float s[8] = {0, 0, 0, 0, 0, 0, 0, 0}, self[8];
        for (int rr = lo; rr <= hi; ++rr) { float f[8]; unpack8(*(const u32x4*)(BR + (size_t)rr * 3072 + ch), f);
#pragma unroll
            for (int j = 0; j < 8; ++j) s[j] += f[j]; }
        unpack8(*(const u32x4*)(BR + (size_t)row * 3072 + ch), self);
        const float inv = 1.f / (float)(hi - lo + 1);
        f32x4 a, b;
#pragma unroll
        for (int j = 0; j < 4; ++j) { a[j] = s[j] * inv - self[j]; b[j] = s[4 + j] * inv - self[4 + j]; }
        *(u32x4*)(H + (size_t)row * 1024 + ch) = pack8(a, b);
    }
}

__device__ __forceinline__ void mlstm_scan_item(const Params& p, int l, int item, unsigned char* ldsb) {
    float* lds = reinterpret_cast<float*>(ldsb);
    float* qs = lds; float* ks = lds + 32 * 256; float* vs = lds + 64 * 256; float* igs = vs + 32 * 32; float* lfs = igs + 32;
    const int tid = threadIdx.x, lane = tid & 63, wave = tid >> 6;
    const int b = item >> 6, hd = (item >> 4) & 3, dir = (item >> 3) & 1, eg = item & 7;
    const bf16_t* Q = (const bf16_t*)(p.ws + WS_Q); const bf16_t* Kb = (const bf16_t*)(p.ws + WS_K); const bf16_t* V = (const bf16_t*)(p.ws + WS_V);
    const float* GA = (const float*)(p.ws + WS_GA);
    bf16_t* OUT = (bf16_t*)(p.ws + (dir ? WS_HB : WS_HF));
    const float* cw = p.mconv_w + (size_t)l * 4 * 2048; const float* cbias = p.mconv_b + (size_t)l * 2048;
    const float gb_i = p.mgate_b[l * 16 + dir * 4 + hd], gb_f = p.mgate_b[l * 16 + (2 + dir) * 4 + hd];
    const int e_local = wave * 4 + (lane >> 4), dg = lane & 15;
    float C[16], n[16];
#pragma unroll
    for (int d = 0; d < 16; ++d) { C[d] = 0.f; n[d] = 0.f; }
    float m = 0.f;
    for (int ch = 0; ch < 136; ++ch) {
        const bool isctx = ch < 8;
        const int len = isctx ? 256 : 4096, rbase = isctx ? b * 256 : MC + b * 4096;
        const int cc = isctx ? ch : ch - 8;
        const int tfirst = dir ? len - 1 - cc * 32 : cc * 32, tstep = dir ? -1 : 1;
        __syncthreads();
        {
            const int i = tid >> 4, d0 = (tid & 15) * 16, t = tfirst + tstep * i;
            float aq[16], ak[16];
#pragma unroll
            for (int d = 0; d < 16; ++d) { aq[d] = cbias[hd * 256 + d0 + d]; ak[d] = cbias[1024 + hd * 256 + d0 + d]; }
#pragma unroll
            for (int j = 0; j < 4; ++j) { const int tt = t + j - 2; if (tt >= 0 && tt < len) {
                const size_t ro = (size_t)(rbase + tt) * 1024 + hd * 256 + d0;
                float fq[16], fk[16];
                unpack8(*(const u32x4*)(Q + ro), fq); unpack8(*(const u32x4*)(Q + ro + 8), fq + 8);
                unpack8(*(const u32x4*)(Kb + ro), fk); unpack8(*(const u32x4*)(Kb + ro + 8), fk + 8);
#pragma unroll
                for (int d = 0; d < 16; ++d) { aq[d] += cw[j * 2048 + hd * 256 + d0 + d] * fq[d]; ak[d] += cw[j * 2048 + 1024 + hd * 256 + d0 + d] * fk[d]; } } }
#pragma unroll
            for (int d = 0; d < 16; ++d) { qs[i * 256 + d0 + d] = silu_f(aq[d]); ks[i * 256 + d0 + d] = silu_f(ak[d]) * 0.0625f; }
        }
        for (int q = tid; q < 32 * 32; q += NTHR) { const int i = q >> 5, e = q & 31, t = tfirst + tstep * i;
            vs[q] = bf2f(V[(size_t)(rbase + t) * 1024 + hd * 256 + eg * 32 + e]); }
        if (tid < 32) { const int t = tfirst + tstep * tid; const float* g = GA + (size_t)(rbase + t) * 16;
            igs[tid] = g[dir * 4 + hd] + gb_i; lfs[tid] = logsigmoid_f(g[(2 + dir) * 4 + hd] + gb_f); }
        __syncthreads();
        for (int i = 0; i < 32; ++i) {
            const float ig = igs[i], lf = lfs[i];
            const float mn = fmaxf(lf + m, ig); const float ip = __expf(ig - mn), fp = __expf(lf + m - mn); m = mn;
            const float kv = ip * vs[i * 32 + e_local];
            const float* qr = qs + i * 256 + dg * 16; const float* kr = ks + i * 256 + dg * 16;
            float num = 0.f, qn = 0.f;
#pragma unroll
            for (int d4 = 0; d4 < 4; ++d4) { const f32x4 kq = *(const f32x4*)(kr + d4 * 4), qq = *(const f32x4*)(qr + d4 * 4);
#pragma unroll
                for (int d = 0; d < 4; ++d) { const int dd = d4 * 4 + d; C[dd] = fp * C[dd] + kv * kq[d]; n[dd] = fp * n[dd] + ip * kq[d]; num += qq[d] * C[dd]; qn += qq[d] * n[dd]; } }
#pragma unroll
            for (int o = 1; o < 16; o <<= 1) { num += __shfl_xor(num, o); qn += __shfl_xor(qn, o); }
            const float hv = num / fmaxf(fabsf(qn), __expf(-m));
            if (dg == 0) { const int t = tfirst + tstep * i; OUT[(size_t)(rbase + t) * 1024 + hd * 256 + eg * 32 + e_local] = (bf16_t)f2bf(hv); }
        }
    }
    __syncthreads();
}

__device__ __forceinline__ void ssd_scan_item(const Params& p, int l, int item, unsigned char* ldsb) {
    float* lds = reinterpret_cast<float*>(ldsb);
    float* xs = lds; float* Bs = lds + 32 * 32; float* Cs = Bs + 32 * 128; float* dts = Cs + 32 * 128;
    const int tid = threadIdx.x, lane = tid & 63, wave = tid >> 6;
    const int b = item >> 6, hd = (item >> 2) & 15, dir = (item >> 1) & 1, ps = item & 1, grp = hd >> 2;
    const bf16_t* SX = (const bf16_t*)(p.ws + WS_SX); const bf16_t* SB = (const bf16_t*)(p.ws + WS_SB); const bf16_t* SC = (const bf16_t*)(p.ws + WS_SC);
    const float* DT = (const float*)(p.ws + WS_DT);
    bf16_t* OUT = (bf16_t*)(p.ws + (dir ? WS_YB : WS_YF));
    const float* cw = p.sconv_w + (size_t)l * 4 * 2048; const float* cbias = p.sconv_b + (size_t)l * 2048;
    const float dtb = p.sdt_bias[l * 32 + dir * 16 + hd], aneg = -__expf(p.sa_log[l * 32 + dir * 16 + hd]), dskip = p.sd[l * 16 + hd];
    const int p_local = wave * 4 + (lane >> 4), ng = lane & 15;
    float S[8];
#pragma unroll
    for (int j = 0; j < 8; ++j) S[j] = 0.f;
    for (int ch = 0; ch < 136; ++ch) {
        const bool isctx = ch < 8;
        const int len = isctx ? 256 : 4096, rbase = isctx ? b * 256 : MC + b * 4096;
        const int cc = isctx ? ch : ch - 8;
        const int tfirst = dir ? len - 1 - cc * 32 : cc * 32, tstep = dir ? -1 : 1;
        __syncthreads();
        for (int q = tid; q < 32 * 288; q += NTHR) {
            const int i = q / 288, cidx = q % 288, t = tfirst + tstep * i;
            const bf16_t* src; int ld, col, cch;
            if (cidx < 32) { src = SX; ld = 1024; col = hd * 64 + ps * 32 + cidx; cch = col; }
            else if (cidx < 160) { src = SB; ld = 512; col = grp * 128 + (cidx - 32); cch = 1024 + col; }
            else { src = SC; ld = 512; col = grp * 128 + (cidx - 160); cch = 1536 + col; }
            float a = cbias[cch];
#pragma unroll
            for (int j = 0; j < 4; ++j) { const int tt = t + j - 2; if (tt >= 0 && tt < len) a += cw[j * 2048 + cch] * bf2f(src[(size_t)(rbase + tt) * ld + col]); }
            a = silu_f(a);
            if (cidx < 32) xs[i * 32 + cidx] = a; else if (cidx < 160) Bs[i * 128 + cidx - 32] = a; else Cs[i * 128 + cidx - 160] = a;
        }
        if (tid < 32) { const int t = tfirst + tstep * tid; dts[tid] = softplus_f(DT[(size_t)(rbase + t) * 32 + dir * 16 + hd] + dtb); }
        __syncthreads();
        for (int i = 0; i < 32; ++i) {
            const float dt = dts[i], dec = __expf(dt * aneg), xv = xs[i * 32 + p_local], dx = dt * xv;
            const f32x4 b0 = *(const f32x4*)(Bs + i * 128 + ng * 8), b1 = *(const f32x4*)(Bs + i * 128 + ng * 8 + 4);
            const f32x4 c0 = *(const f32x4*)(Cs + i * 128 + ng * 8), c1 = *(const f32x4*)(Cs + i * 128 + ng * 8 + 4);
            float y = 0.f;
#pragma unroll
            for (int j = 0; j < 4; ++j) { S[j] = dec * S[j] + dx * b0[j]; y += S[j] * c0[j]; S[4 + j] = dec * S[4 + j] + dx * b1[j]; y += S[4 + j] * c1[j]; }
#pragma unroll
            for (int o = 1; o < 16; o <<= 1) y += __shfl_xor(y, o);
            if (dir == 0) y += dskip * xv;
            if (ng == 0) { const int t = tfirst + tstep * i; OUT[(size_t)(rbase + t) * 1024 + hd * 64 + ps * 32 + p_local] = (bf16_t)f2bf(y); }
        }
    }
    __syncthreads();
}

__device__ __forceinline__ void mlstm_finish_rows(const Params& p, int l, int row_lo, int gw, int ngw) {
    const int lane = threadIdx.x & 63;
    const bf16_t* HF = (const bf16_t*)(p.ws + WS_HF); const bf16_t* HB = (const bf16_t*)(p.ws + WS_HB);
    bf16_t* BR = (bf16_t*)(p.ws + WS_BR);
    const float* ng = p.mnorm_g + l * 1024;
    for (int row = row_lo + gw; row < MT; row += ngw) {
        const size_t so = (size_t)scanrow(row) * 1024;
#pragma unroll
        for (int hd = 0; hd < 4; ++hd) { const int c = hd * 256 + 4 * lane;
            const u32x2 a = *(const u32x2*)(HF + so + c), b2 = *(const u32x2*)(HB + so + c), o = *(const u32x2*)(BR + (size_t)row * 3072 + 1024 + c);
            f32x4 h; h[0] = lo16(a.x) + lo16(b2.x); h[1] = hi16(a.x) + hi16(b2.x); h[2] = lo16(a.y) + lo16(b2.y); h[3] = hi16(a.y) + hi16(b2.y);
            const float ss = wave_sum((h[0] * h[0] + h[1] * h[1]) + (h[2] * h[2] + h[3] * h[3]));
            const float rs = 1.0f / sqrtf(ss * (1.f / 256.f) + EPS);
            const f32x4 g = *(const f32x4*)(ng + c);
            f32x4 r; r[0] = sigmoid_f(lo16(o.x)) * (h[0] * rs * g[0]); r[1] = sigmoid_f(hi16(o.x)) * (h[1] * rs * g[1]);
            r[2] = sigmoid_f(lo16(o.y)) * (h[2] * rs * g[2]); r[3] = sigmoid_f(hi16(o.y)) * (h[3] * rs * g[3]);
            u32x2 w; w.x = pk2(r[0], r[1]); w.y = pk2(r[2], r[3]);
            *(u32x2*)(BR + (size_t)row * 3072 + 1024 + c) = w; }
    }
}
__device__ __forceinline__ void ssd_finish_rows(const Params& p, int l, int row_lo, int gw, int ngw) {
    const int lane = threadIdx.x & 63;
    const bf16_t* YF = (const bf16_t*)(p.ws + WS_YF); const bf16_t* YB = (const bf16_t*)(p.ws + WS_YB);
    bf16_t* BR = (bf16_t*)(p.ws + WS_BR);
    const float* ng = p.snorm_g + l * 1024;
    for (int row = row_lo + gw; row < MT; row += ngw) {
        f32x4 v[4]; float ss = 0.f;
#pragma unroll
        for (int j = 0; j < 4; ++j) { const int c = 4 * lane + 256 * j;
            const u32x2 a = *(const u32x2*)(YF + (size_t)row * 1024 + c), b2 = *(const u32x2*)(YB + (size_t)row * 1024 + c), z = *(const u32x2*)(BR + (size_t)row * 3072 + 2048 + c);
            v[j][0] = (lo16(a.x) + lo16(b2.x)) * silu_f(lo16(z.x)); v[j][1] = (hi16(a.x) + hi16(b2.x)) * silu_f(hi16(z.x));
            v[j][2] = (lo16(a.y) + lo16(b2.y)) * silu_f(lo16(z.y)); v[j][3] = (hi16(a.y) + hi16(b2.y)) * silu_f(hi16(z.y));
            ss += (v[j][0] * v[j][0] + v[j][1] * v[j][1]) + (v[j][2] * v[j][2] + v[j][3] * v[j][3]); }
        const float rs = 1.0f / sqrtf(wave_sum(ss) * (1.f / 1024.f) + EPS);
#pragma unroll
        for (int j = 0; j < 4; ++j) { const int c = 4 * lane + 256 * j; const f32x4 g = *(const f32x4*)(ng + c);
            u32x2 w; w.x = pk2(v[j][0] * rs * g[0], v[j][1] * rs * g[1]); w.y = pk2(v[j][2] * rs * g[2], v[j][3] * rs * g[3]);
            *(u32x2*)(BR + (size_t)row * 3072 + 2048 + c) = w; }
    }
}

__device__ __forceinline__ void phase_route(const Params& p, int l, unsigned char* ldsb, int bid, int nb) {
    float* lds = reinterpret_cast<float*>(ldsb);
    float* Wt = lds;
    int* hist = reinterpret_cast<int*>(lds + 36 * 1024);
    const int tid = threadIdx.x, lane = tid & 63, wave = tid >> 6;
    const int row_lo = l == 0 ? 0 : MC, rpb = l == 0 ? 68 : 64;
    const float* wrg = p.w_rg + (size_t)l * 1024 * 4; const float* wre = p.w_re + (size_t)l * 1024 * 32;
    for (int i = tid; i < 1024 * 4; i += NTHR) { const int k = i >> 2, g = i & 3; Wt[g * 1024 + k] = wrg[i]; }
    for (int i = tid; i < 1024 * 32; i += NTHR) { const int k = i >> 5, e = i & 31; Wt[(4 + e) * 1024 + k] = wre[i]; }
    const float* mod = (const float*)(p.ws + WS_MOD) + l * 5 * 6144;
    const float* XL = (const float*)(p.ws + WS_XL);
    int* EID = (int*)(p.ws + WS_EID); float* EWT = (float*)(p.ws + WS_EWT);
    for (int vb = bid; vb < 256; vb += nb) {
        if (tid < 32) hist[tid] = 0;
        __syncthreads();
        for (int rr = wave; rr < rpb; rr += 8) {
            const int row = row_lo + vb * rpb + rr;
            f32x4 v[4];
#pragma unroll
            for (int j = 0; j < 4; ++j) v[j] = *(const f32x4*)(XL + (size_t)row * 1024 + 4 * lane + 256 * j);
            const float* mr = mod + modrow(row) * 6144;
            norm_mod_row(v, p.g_ffn + l * 1024, mr + 3 * 1024, mr + 4 * 1024, lane);
            store_row_bf16((bf16_t*)(p.ws + WS_H) + (size_t)row * 1024, v, lane);
            float lg[36];
#pragma unroll
            for (int e = 0; e < 36; ++e) { float s = 0.f;
#pragma unroll
                for (int j = 0; j < 4; ++j) { const f32x4 w = *(const f32x4*)(Wt + e * 1024 + 4 * lane + 256 * j); s += (v[j][0] * w[0] + v[j][1] * w[1]) + (v[j][2] * w[2] + v[j][3] * w[3]); }
                lg[e] = wave_sum(s); }
            float gl[4]; int gi = 0; float gmax;
#pragma unroll
            for (int g = 0; g < 4; ++g) gl[g] = lg[g] + p.b_rg[l * 4 + g];
            gmax = gl[0];
#pragma unroll
            for (int g = 1; g < 4; ++g) if (gl[g] > gmax) { gmax = gl[g]; gi = g; }
            float den = 0.f;
#pragma unroll
            for (int g = 0; g < 4; ++g) den += __expf(gl[g] - gmax);
            const float pg = 1.f / den;
            float v1 = -3.0e38f, v2 = -3.0e38f; int i1 = 0, i2 = 0;
#pragma unroll
            for (int g = 0; g < 4; ++g) if (g == gi) {
#pragma unroll
                for (int j = 0; j < 8; ++j) { const float x = lg[4 + g * 8 + j] + p.b_re[l * 32 + g * 8 + j];
                    if (x > v1) { v2 = v1; i2 = i1; v1 = x; i1 = j; } else if (x > v2) { v2 = x; i2 = j; } } }
            const float e2 = __expf(v2 - v1), w1 = pg / (1.f + e2), w2 = pg * e2 / (1.f + e2);
            if (lane == 0) { EID[row * 2] = gi * 8 + i1; EID[row * 2 + 1] = gi * 8 + i2; EWT[row * 2] = w1; EWT[row * 2 + 1] = w2;
                atomicAdd(&hist[gi * 8 + i1], 1); atomicAdd(&hist[gi * 8 + i2], 1); }
        }
        __syncthreads();
        if (tid < 32) ((int*)(p.ws + WS_HIST))[vb * 32 + tid] = hist[tid];
        __syncthreads();
    }
    __syncthreads();
    float* scr = lds + wave * (64 * 33);
    for (int it = bid * 8 + wave; it < CV_EXP_ITEMS; it += nb * 8) convert_exp_item(p, l, it, scr, lane);
    if (l + 1 < 2) for (int it = bid * 8 + wave; it < CV_MIX_ITEMS; it += nb * 8) convert_mix_item(p, l + 1, it, scr, lane);
}

__device__ __forceinline__ void phase_scatter(const Params& p, int l, unsigned char* ldsb, int bid, int nb) {
    int* li = reinterpret_cast<int*>(ldsb);
    int* tot = li; int* pre = li + 32; int* pst = li + 64; int* ea = li + 128; int* pos = li + 384;
    const int tid = threadIdx.x, lane = tid & 63, wave = tid >> 6;
    const int row_lo = l == 0 ? 0 : MC, rpb = l == 0 ? 68 : 64;
    const int* HIST = (const int*)(p.ws + WS_HIST); const int* EID = (const int*)(p.ws + WS_EID);
    int* SLOT = (int*)(p.ws + WS_SLOT);
    for (int vb = bid; vb < 256; vb += nb) {
        __syncthreads();
        if (tid < 32) { int t = 0, pr = 0; for (int j = 0; j < 256; ++j) { const int hv = HIST[j * 32 + tid]; t += hv; if (j < vb) pr += hv; } tot[tid] = t; pre[tid] = pr; }
        __syncthreads();
        if (tid == 0) { int s = 0; for (int e = 0; e < 32; ++e) { pst[e] = s; s += ((tot[e] + 255) >> 8) << 8; }
            if (vb == 0) { int* BE = (int*)(p.ws + WS_BLKEXP); int nblk = 0;
                for (int e = 0; e < 32; ++e) { const int nbk = (tot[e] + 255) >> 8; for (int j = 0; j < nbk; ++j) BE[nblk++] = e; }
                BE[200] = nblk; } }
        if (tid < rpb * 2) ea[tid] = EID[(row_lo + vb * rpb) * 2 + tid];
        __syncthreads();
        if (tid < rpb * 2) { const int e = ea[tid]; int rk = 0; for (int j = 0; j < tid; ++j) rk += (ea[j] == e) ? 1 : 0;
            const int ps = pst[e] + pre[e] + rk; pos[tid] = ps; SLOT[(row_lo + vb * rpb) * 2 + tid] = ps; }
        __syncthreads();
        for (int a = wave; a < rpb * 2; a += 8) { const int row = row_lo + vb * rpb + (a >> 1);
            const u32x4* s = (const u32x4*)((const bf16_t*)(p.ws + WS_H) + (size_t)row * 1024);
            u32x4* d = (u32x4*)((bf16_t*)(p.ws + WS_XB) + (size_t)pos[a] * 1024);
            d[lane] = s[lane]; d[lane + 64] = s[lane + 64]; }
    }
    __syncthreads();
}

__device__ __forceinline__ void phase_combine(const Params& p, int l, int bid, int nb) {
    const int lane = threadIdx.x & 63, wave = threadIdx.x >> 6;
    const float* mod = (const float*)(p.ws + WS_MOD);
    const int* SLOT = (const int*)(p.ws + WS_SLOT); const float* EWT = (const float*)(p.ws + WS_EWT);
    const bf16_t* Y = (const bf16_t*)(p.ws + WS_Y);
    float* XL = (float*)(p.ws + WS_XL);
    const int row_lo = l == 0 ? 0 : MC;
    for (int row = row_lo + bid * 8 + wave; row < MT; row += nb * 8) {
        const int s0 = SLOT[row * 2], s1 = SLOT[row * 2 + 1]; const float w0 = EWT[row * 2], w1 = EWT[row * 2 + 1];
        const float* g5 = mod + (l * 5 + modrow(row)) * 6144 + 5 * 1024;
        f32x4 v[4];
#pragma unroll
        for (int j = 0; j < 4; ++j) { const int c = 4 * lane + 256 * j;
            const u32x2 a = *(const u32x2*)(Y + (size_t)s0 * 1024 + c), b2 = *(const u32x2*)(Y + (size_t)s1 * 1024 + c);
            f32x4 y; y[0] = w0 * lo16(a.x) + w1 * lo16(b2.x); y[1] = w0 * hi16(a.x) + w1 * hi16(b2.x); y[2] = w0 * lo16(a.y) + w1 * lo16(b2.y); y[3] = w0 * hi16(a.y) + w1 * hi16(b2.y);
            v[j] = *(const f32x4*)(XL + (size_t)row * 1024 + c) + *(const f32x4*)(g5 + c) * y; }
        if (l == 0) {
#pragma unroll
            for (int j = 0; j < 4; ++j) *(f32x4*)(XL + (size_t)row * 1024 + 4 * lane + 256 * j) = v[j];
            const float* mr = mod + (5 + modrow(row)) * 6144;
            norm_mod_row(v, p.g_mix + 1024, mr, mr + 1024, lane);
            store_row_bf16((bf16_t*)(p.ws + WS_H) + (size_t)row * 1024, v, lane);
        } else {
            norm_mod_row(v, p.g_final, nullptr, nullptr, lane);
            float* o = p.out + (size_t)(row - MC) * 1024;
#pragma unroll
            for (int j = 0; j < 4; ++j) *(f32x4*)(o + 4 * lane + 256 * j) = v[j];
        }
    }
}

constexpr int NPHASES = 25;
__device__ __forceinline__ void run_phase(const Params& p, int ph, unsigned char* lds) {
    const int bid = blockIdx.x, nb = gridDim.x;
    const int wave = threadIdx.x >> 6;
#ifndef ONLY_S
    if (ph == 0) { phase_pre(p, lds, bid, nb); return; }
#else
    if (ph == 0) { if (ONLY_S == 99) phase_pre(p, lds, bid, nb); return; }
#endif
    const int l = (ph - 1) / 12, s = (ph - 1) % 12;
    unsigned char* ws = p.ws;
    const int pm0 = l == 0 ? 0 : 4, nMrows = l == 0 ? 68 : 64, row_lo = l == 0 ? 0 : MC;
#ifdef ONLY_S
    if (s != ONLY_S) return;
#endif
    switch (s) {
    case 0: if (l == 0) phase_norm1(p, bid, nb); break;
    case 1: { SchedGrid S{(const bf16_t*)(ws + WS_H), (const bf16_t*)(ws + WS_WIN), 1024, 1024, 0, 68, 45, nb, bid}; EpiInproj E{ws};
              gemm_run(lds, S, E, 1024, 1024, 1024, 1); } break;
    case 2: { for (int it = bid; it < 256; it += nb) mlstm_scan_item(p, l, it, lds);
              for (int it = (l == 0 ? 0 : 16) + bid; it < 272; it += nb) pool_window_item(p, it); } break;
    case 3: { for (int it = bid; it < 256; it += nb) ssd_scan_item(p, l, it, lds);
              SchedPool S{(const bf16_t*)(ws + WS_H), (const bf16_t*)(ws + WS_WPOOL), pm0, nMrows, nb, bid}; EpiPool E{(bf16_t*)(ws + WS_BR), p.pool_scale + l * 1024};
              gemm_run(lds, S, E, 256, 1024, 256, 1);
              mlstm_finish_rows(p, l, row_lo, bid * 8 + wave, nb * 8); } break;
    case 4: ssd_finish_rows(p, l, row_lo, bid * 8 + wave, nb * 8); break;
    case 5: { SchedGrid S{(const bf16_t*)(ws + WS_BR), (const bf16_t*)(ws + WS_WBR), 3072, 3072, pm0, nMrows, 4, nb, bid}; EpiBranch E{(const bf16_t*)(ws + WS_MG), (bf16_t*)(ws + WS_MERGED)};
              gemm_run(lds, S, E, 3072, 3072, 3072, 3); } break;
    case 6: { SchedGrid S{(const bf16_t*)(ws + WS_MERGED), (const bf16_t*)(ws + WS_WOUT), 1024, 1024, pm0, nMrows, 4, nb, bid}; EpiOut E{(float*)(ws + WS_XL), (const float*)(ws + WS_MOD) + l * 5 * 6144};
              gemm_run(lds, S, E, 1024, 1024, 1024, 1); } break;
    case 7: phase_route(p, l, lds, bid, nb); break;
    case 8: phase_scatter(p, l, lds, bid, nb); break;
    case 9: { const int* BE = (const int*)(ws + WS_BLKEXP);
              SchedMoe S{(const bf16_t*)(ws + WS_XB), (const bf16_t*)(ws + WS_EW1), BE, 1024, BE[200], nb, bid, (size_t)1048576, (size_t)1024}; EpiMoe1 E{(bf16_t*)(ws + WS_ACT)};
              gemm_run(lds, S, E, 1024, 1024, 1024, 1); } break;
    case 10: { const int* BE = (const int*)(ws + WS_BLKEXP);
              SchedMoe S{(const bf16_t*)(ws + WS_ACT), (const bf16_t*)(ws + WS_EW2), BE, 512, BE[200], nb, bid, (size_t)524288, (size_t)512}; EpiMoe2 E{(bf16_t*)(ws + WS_Y)};
              gemm_run(lds, S, E, 512, 512, 512, 1); } break;
    case 11: phase_combine(p, l, bid, nb); break;
    }
}

constexpr int PARAM_OFF = LDS_BYTES - 512;
__global__ void __launch_bounds__(NTHR, 2) fwd_kernel(Params pk) {
    extern __shared__ __attribute__((aligned(16))) unsigned char lds[];
    cg::grid_group grid = cg::this_grid();
    const Params& p = pk;
    const int lo = pk.ph_lo, hi = pk.ph_hi;
#define STEP(k) if (lo <= (k) && (k) < hi) { run_phase(p, (k), lds); if ((k) + 1 < hi) grid.sync(); }
    STEP(0) STEP(1) STEP(2) STEP(3) STEP(4) STEP(5) STEP(6) STEP(7) STEP(8) STEP(9) STEP(10) STEP(11) STEP(12)
    STEP(14) STEP(15) STEP(16) STEP(17) STEP(18) STEP(19) STEP(20) STEP(21) STEP(22) STEP(23) STEP(24)
#undef STEP
}

extern "C" void kernel_launch(void* const* d_in, const int* in_sizes, int n_in, void* d_out, int out_size, void* d_ws, size_t ws_size, hipStream_t stream) {
    static int grid_blocks = 0;
    if (!grid_blocks) {
        if (n_in != 31 || ws_size < WS_END) { fprintf(stderr, "kernel_launch: unexpected n_in %d / ws_size %zu (need %zu)\n", n_in, ws_size, (size_t)WS_END); grid_blocks = -1; return; }
        int dev = 0, cus = 0, per_cu = 0;
        hipGetDevice(&dev);
        hipDeviceGetAttribute(&cus, hipDeviceAttributeMultiprocessorCount, dev);
        if (hipFuncSetAttribute((const void*)fwd_kernel, hipFuncAttributeMaxDynamicSharedMemorySize, LDS_BYTES) != hipSuccess) fprintf(stderr, "kernel_launch: hipFuncSetAttribute failed\n");
        hipOccupancyMaxActiveBlocksPerMultiprocessor(&per_cu, (const void*)fwd_kernel, NTHR, LDS_BYTES);
        if (per_cu < 1) { fprintf(stderr, "kernel_launch: occupancy query says %d blocks per CU\n", per_cu); per_cu = 1; }
        grid_blocks = cus * per_cu;
        (void)hipGetLastError();
    }
    if (grid_blocks < 0) return;
    Params p{};
    const float** dst = (const float**)&p;
    for (int i = 0; i < 31; ++i) dst[i] = (const float*)d_in[i];
    p.out = (float*)d_out; p.ws = (unsigned char*)d_ws;
#if SINGLE_LAUNCH
    p.ph_lo = 0; p.ph_hi = NPHASES;
    void* args[] = {&p};
    hipError_t e = hipLaunchCooperativeKernel((const void*)fwd_kernel, dim3(grid_blocks), dim3(NTHR), args, LDS_BYTES, stream);
    if (e != hipSuccess) fprintf(stderr, "cooperative launch failed: %s (grid %d)\n", hipGetErrorString(e), grid_blocks);
#else
    for (int ph = 0; ph < NPHASES; ++ph) {
        if (ph == 13) continue;
        p.ph_lo = ph; p.ph_hi = ph + 1;
        hipLaunchKernelGGL(fwd_kernel, dim3(grid_blocks), dim3(NTHR), LDS_BYTES, stream, p);
    }
#endif
}
```

```cpp
#include <hip/hip_runtime.h>
#include <hip/hip_cooperative_groups.h>
#include <cstdio>
namespace cg = cooperative_groups;

#ifndef SINGLE_LAUNCH
#define SINGLE_LAUNCH 1
#endif
#ifndef PROBE_DUP_MASK
#define PROBE_DUP_MASK 0
#endif
#ifndef PROBE_DUP_N
#define PROBE_DUP_N 1
#endif
#ifndef USE_MLSTM_CHUNK
#define USE_MLSTM_CHUNK 1
#endif
#ifndef USE_SSD_CHUNK
#define USE_SSD_CHUNK 1
#endif
#ifndef USE_MFMA_GEMM
#define USE_MFMA_GEMM 1
#endif

typedef unsigned short bf16_t;
typedef float f32x4 __attribute__((ext_vector_type(4)));
typedef unsigned u32x4 __attribute__((ext_vector_type(4)));
typedef unsigned u32x2 __attribute__((ext_vector_type(2)));

constexpr int NTHR = 512;
constexpr int D = 1024, NB = 4, SEQ = 4096, CTXL = 256;
constexpr int MC = NB * CTXL;
constexpr int ML = NB * SEQ;
constexpr int MT = MC + ML;
constexpr int DIN = 11312, NPAD = 11520;
constexpr int NE = 32, DE = 512;
constexpr int CAP = 43008;
constexpr float EPS = 1e-6f;
constexpr int LDS_BYTES = 163840;

constexpr size_t MiB = 1u << 20;
constexpr size_t WS_HIST = 0;
constexpr size_t WS_BLKEXP = 64 * 1024;
constexpr size_t WS_BAR = 128 * 1024;
constexpr size_t WS_MOD = 1 * MiB;
constexpr size_t WS_GA = 2 * MiB;
constexpr size_t WS_DT = 4 * MiB;
constexpr size_t WS_EID = 7 * MiB;
constexpr size_t WS_EWT = 7 * MiB + 256 * 1024;
constexpr size_t WS_SLOT = 7 * MiB + 512 * 1024;
constexpr size_t WS_WIN = 8 * MiB;
constexpr size_t WS_WPOOL = 31 * MiB;
constexpr size_t WS_WBR = 32 * MiB;
constexpr size_t WS_WOUT = 38 * MiB;
constexpr size_t WS_XL = 40 * MiB;
constexpr size_t WS_H = 108 * MiB;
constexpr size_t WS_BR = 142 * MiB;
constexpr size_t WS_Q = 244 * MiB, WS_K = 278 * MiB, WS_V = 312 * MiB;
constexpr size_t WS_SX = 346 * MiB, WS_SB = 380 * MiB, WS_SC = 397 * MiB;
constexpr size_t WS_MG = 414 * MiB;
constexpr size_t WS_HF = 516 * MiB, WS_HB = 550 * MiB;
constexpr size_t WS_VT = 584 * MiB;
constexpr size_t WS_END = 618 * MiB;
constexpr size_t WS_QC = WS_H, WS_KC = WS_HF, WS_KCT = WS_HB;
constexpr size_t WS_HF2 = WS_Q, WS_HB2 = WS_K;
constexpr size_t WS_XCT = WS_HF;
constexpr size_t WS_BC = WS_H, WS_CC = WS_H + 17 * MiB, WS_BCT = WS_HB;
constexpr size_t WS_YF = WS_SX, WS_YB = WS_SB;
constexpr size_t WS_MERGED = WS_Q;
constexpr size_t WS_EW1 = 244 * MiB;
constexpr size_t WS_EW2 = 308 * MiB;
constexpr size_t WS_XB = WS_BR;
constexpr size_t WS_ACT = WS_SX;
constexpr size_t WS_Y = WS_MG;

struct Params {
    const float *x, *c, *ctx, *c_ctx, *w_ada, *b_ada, *g_mix, *g_ffn, *w_in, *pool_w, *pool_scale,
        *mconv_w, *mconv_b, *mgate_b, *mnorm_g, *sconv_w, *sconv_b, *sdt_bias, *sa_log, *sd, *snorm_g,
        *w_branch, *w_out, *w_rg, *b_rg, *w_re, *b_re, *w_eg, *w_eu, *w_ed, *g_final;
    float* out; unsigned char* ws; int ph_lo, ph_hi, dup, pad;
};

__device__ __forceinline__ int tid_fresh() { int t = threadIdx.x; asm volatile("" : "+v"(t)); return t; }
__device__ __forceinline__ float bf2f(unsigned b) { return __uint_as_float(b << 16); }
__device__ __forceinline__ unsigned f2bf(float f) { unsigned u = __float_as_uint(f); return (u + 0x7fffu + ((u >> 16) & 1u)) >> 16; }
__device__ __forceinline__ unsigned pk2(float lo, float hi) { return f2bf(lo) | (f2bf(hi) << 16); }
__device__ __forceinline__ float lo16(unsigned w) { return __uint_as_float(w << 16); }
__device__ __forceinline__ float hi16(unsigned w) { return __uint_as_float(w & 0xffff0000u); }
__device__ __forceinline__ float wave_sum(float v) {
#pragma unroll
    for (int o = 1; o < 64; o <<= 1) v += __shfl_xor(v, o);
    return v;
}
__device__ __forceinline__ float sigmoid_f(float x) { return 1.f / (1.f + __expf(-x)); }
__device__ __forceinline__ float silu_f(float x) { return x / (1.f + __expf(-x)); }
__device__ __forceinline__ float softplus_f(float x) { return fmaxf(x, 0.f) + log1pf(__expf(-fabsf(x))); }
__device__ __forceinline__ float logsigmoid_f(float x) { return fminf(x, 0.f) - log1pf(__expf(-fabsf(x))); }
__device__ __forceinline__ void unpack8(u32x4 w, float* f) {
    f[0] = lo16(w.x); f[1] = hi16(w.x); f[2] = lo16(w.y); f[3] = hi16(w.y);
    f[4] = lo16(w.z); f[5] = hi16(w.z); f[6] = lo16(w.w); f[7] = hi16(w.w);
}
__device__ __forceinline__ u32x4 pack8(f32x4 a, f32x4 b) {
    u32x4 w; w.x = pk2(a[0], a[1]); w.y = pk2(a[2], a[3]); w.z = pk2(b[0], b[1]); w.w = pk2(b[2], b[3]); return w;
}
__device__ __forceinline__ int scanrow(int row) {
    if (row < MC) return row;
    const int r = row - MC, b = r >> 12, t = r & 4095;
    return MC + (b << 12) + ((t & 63) << 6) + (t >> 6);
}
__device__ __forceinline__ int modrow(int row) { return row < MC ? 4 : ((row - MC) >> 12); }

struct Unit { const bf16_t* A; const bf16_t* B; int pm, pn; };

__device__ __forceinline__ void tile_order(int L, int nM, int nN, int& pm, int& pn) {
    const int nwg = nM * nN; int wgid = L;
    { const int q = nwg / 8, r = nwg % 8, xcd = wgid % 8, off = wgid / 8; wgid = (xcd < r ? xcd * (q + 1) : r * (q + 1) + (xcd - r) * q) + off; }
    const int nig = 8 * nN, gid = wgid / nig, fm = gid * 8, gsz = (nM - fm) < 8 ? (nM - fm) : 8;
    pm = fm + ((wgid % nig) % gsz); pn = (wgid % nig) / gsz;
}
struct SchedGrid {
    const bf16_t* A; const bf16_t* B; int lda, ldb, pm0, nM, nN, G, c;
    __device__ __forceinline__ bool next(int i, Unit& u) const {
        const long L = (long)i * G + c; if (L >= (long)nM * nN) return false;
        int pm, pn; tile_order((int)L, nM, nN, pm, pn); pm += pm0;
        u.pm = pm; u.pn = pn; u.A = A + (size_t)pm * 256 * lda; u.B = B + (size_t)pn * 256 * ldb; return true;
    }
};
struct SchedPool {
    const bf16_t* A; const bf16_t* B; int pm0, nM, G, c;
    __device__ __forceinline__ bool next(int i, Unit& u) const {
        const long L = (long)i * G + c; if (L >= (long)nM * 4) return false;
        const int pm = pm0 + (int)(L >> 2), g = (int)(L & 3);
        u.pm = pm; u.pn = g; u.A = A + (size_t)pm * 256 * 3072 + g * 256; u.B = B + (size_t)g * 65536; return true;
    }
};
struct SchedMoe {
    const bf16_t* A; const bf16_t* B; const int* blkexp; int lda, nblk, G, c; size_t bexp_stride, ldb;
    __device__ __forceinline__ bool next(int i, Unit& u) const {
        const long L = (long)i * G + c; if (L >= (long)nblk * 4) return false;
        const int blk = (int)(L >> 2), nt = (int)(L & 3); const int e = blkexp[blk];
        u.pm = blk; u.pn = nt; u.A = A + (size_t)blk * 256 * lda; u.B = B + (size_t)e * bexp_stride + (size_t)nt * 256 * ldb; return true;
    }
};

struct EpiInproj {
    unsigned char* ws;
    __device__ __forceinline__ void seg(const Unit& u, int, int r, int c0, f32x4& lo0, f32x4& lo1, f32x4& hi0, f32x4& hi1) const {
        const int row = u.pm * 256 + r, t = u.pn;
        bf16_t* dst; size_t ld; int cb;
        if (t < 4) { dst = (bf16_t*)(ws + WS_BR) + (size_t)row * 3072; cb = t * 256; }
        else if (t < 16) { const int w = (t - 4) >> 2; dst = (bf16_t*)(ws + WS_Q + (size_t)w * 34 * MiB) + (size_t)scanrow(row) * 1024; cb = ((t - 4) & 3) * 256; }
        else if (t < 20) { dst = (bf16_t*)(ws + WS_BR) + (size_t)row * 3072 + 1024; cb = (t - 16) * 256; }
        else if (t < 24) { dst = (bf16_t*)(ws + WS_SX) + (size_t)row * 1024; cb = (t - 20) * 256; }
        else if (t < 28) { dst = (bf16_t*)(ws + WS_BR) + (size_t)row * 3072 + 2048; cb = (t - 24) * 256; }
        else if (t < 30) { dst = (bf16_t*)(ws + WS_SB) + (size_t)row * 512; cb = (t - 28) * 256; }
        else if (t < 32) { dst = (bf16_t*)(ws + WS_SC) + (size_t)row * 512; cb = (t - 30) * 256; }
        else if (t < 44) {
            dst = (bf16_t*)(ws + WS_MG) + (size_t)row * 3072; cb = (t - 32) * 256;
#pragma unroll
            for (int j = 0; j < 4; ++j) { lo0[j] = sigmoid_f(lo0[j]); lo1[j] = sigmoid_f(lo1[j]); hi0[j] = sigmoid_f(hi0[j]); hi1[j] = sigmoid_f(hi1[j]); }
        } else {
            if (c0 < 32) { float* d = (float*)(ws + WS_DT) + (size_t)row * 32 + c0; *(f32x4*)d = lo0; *(f32x4*)(d + 4) = lo1; }
            else if (c0 < 48) { float* d = (float*)(ws + WS_GA) + (size_t)scanrow(row) * 16 + (c0 - 32); *(f32x4*)d = lo0; *(f32x4*)(d + 4) = lo1; }
            return;
        }
        *(u32x4*)(dst + cb + c0) = pack8(lo0, lo1);
        *(u32x4*)(dst + cb + 128 + c0) = pack8(hi0, hi1);
    }
};
struct EpiPool {
    bf16_t* BR;
    __device__ __forceinline__ void seg(const Unit& u, int, int r, int c0, f32x4& lo0, f32x4& lo1, f32x4& hi0, f32x4& hi1) const {
        bf16_t* d = BR + (size_t)(u.pm * 256 + r) * 3072 + u.pn * 256 + c0;
        *(u32x4*)d = pack8(lo0, lo1);
        *(u32x4*)(d + 128) = pack8(hi0, hi1);
    }
};
struct EpiBranch {
    const bf16_t* MG; bf16_t* OUT;
    __device__ __forceinline__ void seg(const Unit& u, int sg, int r, int c0, f32x4& lo0, f32x4& lo1, f32x4& hi0, f32x4& hi1) const {
        const int row = u.pm * 256 + r, col = u.pn * 256 + c0;
        const bf16_t* g = MG + (size_t)row * 3072 + sg * 1024 + col;
        const int nx = sg < 2 ? 1024 : 0;
        const u32x4 ga = *(const u32x4*)g, gb = *(const u32x4*)(g + 128), gc = *(const u32x4*)(g + nx), gd = *(const u32x4*)(g + nx + 128);
        float a[8], b[8], a2[8], b2[8]; unpack8(ga, a); unpack8(gb, b); unpack8(gc, a2); unpack8(gd, b2);
        if (sg < 2) {
#pragma unroll
            for (int j = 0; j < 8; ++j) { a[j] = a[j] * __builtin_amdgcn_rcpf(a2[j]); b[j] = b[j] * __builtin_amdgcn_rcpf(b2[j]); } }
#pragma unroll
        for (int j = 0; j < 4; ++j) { lo0[j] *= a[j]; lo1[j] *= a[4 + j]; hi0[j] *= b[j]; hi1[j] *= b[4 + j]; }
        if (sg == 2) { bf16_t* d = OUT + (size_t)row * 1024 + col; *(u32x4*)d = pack8(lo0, lo1); *(u32x4*)(d + 128) = pack8(hi0, hi1); }
    }
};
struct EpiOut {
    float* XL; const float* mod; int dup;
    __device__ __forceinline__ void seg(const Unit& u, int, int r, int c0, f32x4& lo0, f32x4& lo1, f32x4& hi0, f32x4& hi1) const {
        const int row = u.pm * 256 + r, col = u.pn * 256 + c0;
        const float* g = mod + modrow(row) * 6144 + 2 * 1024 + col;
        float* x = XL + (size_t)row * 1024 + col;
        const f32x4 x0 = *(const f32x4*)x, x1 = *(const f32x4*)(x + 4), x2 = *(const f32x4*)(x + 128), x3 = *(const f32x4*)(x + 132);
        const f32x4 g0 = *(const f32x4*)g, g1 = *(const f32x4*)(g + 4), g2 = *(const f32x4*)(g + 128), g3 = *(const f32x4*)(g + 132);
        if (dup) return;
        *(f32x4*)x = x0 + g0 * lo0; *(f32x4*)(x + 4) = x1 + g1 * lo1; *(f32x4*)(x + 128) = x2 + g2 * hi0; *(f32x4*)(x + 132) = x3 + g3 * hi1;
    }
};
struct EpiMoe1 {
    bf16_t* ACT;
    __device__ __forceinline__ void seg(const Unit& u, int, int r, int c0, f32x4& lo0, f32x4& lo1, f32x4& hi0, f32x4& hi1) const {
        const int row = u.pm * 256 + r;
        f32x4 a, b;
#pragma unroll
        for (int j = 0; j < 4; ++j) { a[j] = silu_f(lo0[j]) * hi0[j]; b[j] = silu_f(lo1[j]) * hi1[j]; }
        *(u32x4*)(ACT + (size_t)row * 512 + u.pn * 128 + c0) = pack8(a, b);
    }
};
struct EpiMoe2 {
    bf16_t* Y;
    __device__ __forceinline__ void seg(const Unit& u, int, int r, int c0, f32x4& lo0, f32x4& lo1, f32x4& hi0, f32x4& hi1) const {
        bf16_t* d = Y + (size_t)(u.pm * 256 + r) * 1024 + u.pn * 256 + c0;
        *(u32x4*)d = pack8(lo0, lo1); *(u32x4*)(d + 128) = pack8(hi0, hi1);
    }
};

template <class Sched, class Epi>
__device__ __forceinline__ void gemm_naive(float* lds, const Sched& S, const Epi& E, int K, int lda, int ldb, int nseg) {
    const int tid = tid_fresh(), tr = tid >> 4, tc = tid & 15;
    float* As = lds; float* Bs = lds + 16 * 128;
    Unit u;
    const int kseg = K / nseg;
    for (int i = 0; S.next(i, u); ++i) {
        for (int half = 0; half < 2; ++half) {
            f32x4 acc[4][4];
#pragma unroll
            for (int a = 0; a < 4; ++a)
#pragma unroll
                for (int b = 0; b < 4; ++b) acc[a][b] = (f32x4){0.f, 0.f, 0.f, 0.f};
            for (int k0 = 0; k0 < K; k0 += 16) {
                __syncthreads();
                { const int row = tid >> 1, kh = (tid & 1) * 8; float fb[8];
                  unpack8(*(const u32x4*)(u.B + (size_t)row * ldb + k0 + kh), fb);
#pragma unroll
                  for (int j = 0; j < 8; ++j) Bs[(kh + j) * 256 + row] = fb[j];
                  if (tid < 256) { float fa[8]; unpack8(*(const u32x4*)(u.A + (size_t)(half * 128 + row) * lda + k0 + kh), fa);
#pragma unroll
                      for (int j = 0; j < 8; ++j) As[(kh + j) * 128 + row] = fa[j]; } }
                __syncthreads();
#pragma unroll 4
                for (int kk = 0; kk < 16; ++kk) {
                    const f32x4 a0 = *(const f32x4*)(As + kk * 128 + tr * 4);
                    const f32x4 b0 = *(const f32x4*)(Bs + kk * 256 + tc * 8), b1 = *(const f32x4*)(Bs + kk * 256 + tc * 8 + 4);
                    const f32x4 b2 = *(const f32x4*)(Bs + kk * 256 + 128 + tc * 8), b3 = *(const f32x4*)(Bs + kk * 256 + 128 + tc * 8 + 4);
#pragma unroll
                    for (int a = 0; a < 4; ++a) { const float av = a0[a];
                        acc[a][0] += av * b0; acc[a][1] += av * b1; acc[a][2] += av * b2; acc[a][3] += av * b3; }
                }
                if (((k0 + 16) % kseg) == 0) { const int sg = (k0 + 16) / kseg - 1;
#pragma unroll
                    for (int a = 0; a < 4; ++a) E.seg(u, sg, half * 128 + tr * 4 + a, tc * 8, acc[a][0], acc[a][1], acc[a][2], acc[a][3]); }
            }
        }
    }
    __syncthreads();
}

#define LAS __attribute__((address_space(3)))
typedef short bf16x8 __attribute__((ext_vector_type(8)));
constexpr int HTB = 128 * 64 * 2;
__device__ __forceinline__ int lds_byte(int r, int c) { const int st = (r >> 4) * 2 + (c >> 5), rr = r & 15, cc = c & 31, ob = rr * 64 + cc * 2; return st * 1024 + (ob ^ (((ob >> 9) & 1) << 5)); }
__device__ __forceinline__ void stage_rc(int b, int& R, int& C) { const int st = b / 1024, sb = b % 1024, swz = sb ^ (((sb >> 9) & 1) << 5); R = (st >> 1) * 16 + swz / 64; C = (st & 1) * 32 + (swz % 64) / 2; }
__device__ __forceinline__ int perm32(int rho) { const int n = rho >> 4, i = rho & 15; return 8 * (i >> 2) + 4 * n + (i & 3); }

template <class Sched, class Epi>
__device__ __forceinline__ void gemm_mfma(LAS unsigned char* lds, const Sched& S, const Epi& E, const int K, const int lda, const int ldb, const int nseg) {
    const int tid = tid_fresh(), wid = __builtin_amdgcn_readfirstlane(tid >> 6), lane = tid & 63, wr = wid >> 2, wc = wid & 3, fr = lane & 15, fq = lane >> 4;
    const int nt = K / 64, tseg = nt / nseg;
    unsigned voffA[2], voffB[2];
#pragma unroll
    for (int i = 0; i < 2; ++i) { int R, C; stage_rc(tid * 16 + i * 8192, R, C); const int Rb = (R & ~31) + perm32(R & 31);
        voffA[i] = (unsigned)(R * lda + C) * 2u; voffB[i] = (unsigned)(Rb * ldb + C) * 2u; }
    const size_t kstep = 128;
    const size_t hstepA = (size_t)128 * lda * 2, hstepB = (size_t)128 * ldb * 2;
    const unsigned ldsw = (unsigned)wid * 1024u;
    const int aoff = lds_byte(wr * 64 + fr, fq * 8), boff = lds_byte(wc * 32 + fr, fq * 8);
#define PG8_SA(b, h) (((b) * 2 + (h)) * HTB)
#define PG8_SB(b, h) ((4 + (b) * 2 + (h)) * HTB)
#define PG8_STAGE(bufoff, gbase, voff) do { _Pragma("unroll") for (int _i = 0; _i < 2; ++_i) \
        __builtin_amdgcn_global_load_lds((const unsigned*)((const char*)(gbase) + (voff)[_i]), (LAS unsigned*)(lds + (bufoff) + ldsw + _i * 8192), 16, 0, 0); } while (0)
#define PG8_LDA(dst, b, h) do { _Pragma("unroll") for (int m = 0; m < 4; ++m) _Pragma("unroll") for (int k = 0; k < 2; ++k) dst[m][k] = *(const LAS bf16x8*)(lds + PG8_SA(b, h) + aoff + m * 2048 + k * 1024); } while (0)
#define PG8_LDB(dst, b, h) do { _Pragma("unroll") for (int n = 0; n < 2; ++n) _Pragma("unroll") for (int k = 0; k < 2; ++k) dst[n][k] = *(const LAS bf16x8*)(lds + PG8_SB(b, h) + boff + n * 2048 + k * 1024); } while (0)
#define PG8_MMA(ai, bj, At, Bt) do { __builtin_amdgcn_s_setprio(1); _Pragma("unroll") for (int m = 0; m < 4; ++m) _Pragma("unroll") for (int n = 0; n < 2; ++n) _Pragma("unroll") for (int k = 0; k < 2; ++k) \
        acc[ai][bj][m][n] = __builtin_amdgcn_mfma_f32_16x16x32_bf16(Bt[n][k], At[m][k], acc[ai][bj][m][n], 0, 0, 0); __builtin_amdgcn_s_setprio(0); } while (0)
#define PG8_WAIT_V(n) asm volatile("s_waitcnt vmcnt(" #n ")" ::: "memory")
#define PG8_WAIT_L(n) asm volatile("s_waitcnt lgkmcnt(" #n ")" ::: "memory")
#define PG8_BAR __builtin_amdgcn_s_barrier()
#define PG8_SCHED __builtin_amdgcn_sched_barrier(0)
#define PG8_EPI(sg) do { _Pragma("unroll") for (int ai = 0; ai < 2; ++ai) _Pragma("unroll") for (int m = 0; m < 4; ++m) { \
        int r_ = ai * 128 + wr * 64 + m * 16 + fr; asm volatile("" : "+v"(r_));     \
        E.seg(cur, (sg), r_, wc * 32 + fq * 8, acc[ai][0][m][0], acc[ai][0][m][1], acc[ai][1][m][0], acc[ai][1][m][1]); } } while (0)
    Unit cur, nxt; int ui = 0;
    if (!S.next(0, cur)) return;
    f32x4 acc[2][2][4][2];
#pragma unroll
    for (int a = 0; a < 2; ++a)
#pragma unroll
        for (int b = 0; b < 2; ++b)
#pragma unroll
            for (int m = 0; m < 4; ++m)
#pragma unroll
                for (int n = 0; n < 2; ++n) acc[a][b][m][n] = (f32x4){0.f, 0.f, 0.f, 0.f};
    bf16x8 At[4][2], B0[2][2], B1[2][2];
    const char* cA = (const char*)cur.A; const char* cB = (const char*)cur.B;
    PG8_STAGE(PG8_SB(0, 0), cB, voffB); PG8_STAGE(PG8_SA(0, 0), cA, voffA); PG8_STAGE(PG8_SB(0, 1), cB + hstepB, voffB); PG8_STAGE(PG8_SA(0, 1), cA + hstepA, voffA);
    if (wr == 1) PG8_BAR;
    PG8_WAIT_V(4); PG8_BAR;
    PG8_STAGE(PG8_SB(1, 0), cB + kstep, voffB); PG8_STAGE(PG8_SA(1, 0), cA + kstep, voffA); PG8_STAGE(PG8_SB(1, 1), cB + hstepB + kstep, voffB);
    PG8_WAIT_V(6); PG8_BAR;
    for (;;) {
        const bool has_next = S.next(ui + 1, nxt);
        const char* nA = has_next ? (const char*)nxt.A : cA; const char* nB = has_next ? (const char*)nxt.B : cB;
#pragma nounroll
        for (int sg = 0; sg < nseg; ++sg) {
#pragma nounroll
        for (int tt = 0; tt < tseg; tt += 2) {
            const int t = sg * tseg + tt;
            const bool last = (t == nt - 2);
            const char* a1 = cA + (size_t)(t + 1) * kstep;
            const char* a2 = last ? nA : cA + (size_t)(t + 2) * kstep; const char* b2 = last ? nB : cB + (size_t)(t + 2) * kstep;
            const char* a3 = a2 + kstep; const char* b3 = b2 + kstep;
            PG8_LDB(B0, 0, 0); PG8_SCHED; PG8_LDA(At, 0, 0); PG8_STAGE(PG8_SA(1, 1), a1 + hstepA, voffA);
            PG8_WAIT_L(8); PG8_BAR; PG8_WAIT_L(0); PG8_MMA(0, 0, At, B0); PG8_BAR; PG8_SCHED;
            PG8_LDB(B1, 0, 1); PG8_STAGE(PG8_SB(0, 0), b2, voffB);
            PG8_BAR; PG8_WAIT_L(0); PG8_MMA(0, 1, At, B1); PG8_BAR;
            PG8_LDA(At, 0, 1); PG8_STAGE(PG8_SA(0, 0), a2, voffA);
            PG8_BAR; PG8_WAIT_L(0); PG8_MMA(1, 0, At, B0); PG8_BAR; PG8_SCHED;
            PG8_STAGE(PG8_SB(0, 1), b2 + hstepB, voffB);
            PG8_WAIT_V(6); PG8_BAR; PG8_MMA(1, 1, At, B1); PG8_BAR;
            PG8_LDB(B0, 1, 0); PG8_SCHED; PG8_LDA(At, 1, 0); PG8_STAGE(PG8_SA(0, 1), a2 + hstepA, voffA);
            PG8_WAIT_L(8); PG8_BAR; PG8_WAIT_L(0); PG8_MMA(0, 0, At, B0); PG8_BAR; PG8_SCHED;
            PG8_LDB(B1, 1, 1); PG8_STAGE(PG8_SB(1, 0), b3, voffB);
            PG8_BAR; PG8_WAIT_L(0); PG8_MMA(0, 1, At, B1); PG8_BAR;
            PG8_LDA(At, 1, 1); PG8_STAGE(PG8_SA(1, 0), a3, voffA);
            PG8_BAR; PG8_WAIT_L(0); PG8_MMA(1, 0, At, B0); PG8_BAR; PG8_SCHED;
            PG8_STAGE(PG8_SB(1, 1), b3 + hstepB, voffB);
            PG8_WAIT_V(6); PG8_BAR; PG8_MMA(1, 1, At, B1); PG8_BAR;
        }
        PG8_EPI(sg);
        }
        if (!has_next) break;
#pragma unroll
        for (int a = 0; a < 2; ++a)
#pragma unroll
            for (int b = 0; b < 2; ++b)
#pragma unroll
                for (int m = 0; m < 4; ++m)
#pragma unroll
                    for (int n = 0; n < 2; ++n) acc[a][b][m][n] = (f32x4){0.f, 0.f, 0.f, 0.f};
        cur = nxt; cA = nA; cB = nB; ++ui;
    }
    PG8_WAIT_V(0);
    if (wr == 0) PG8_BAR;
    PG8_BAR;
#undef PG8_SA
#undef PG8_SB
#undef PG8_STAGE
#undef PG8_LDA
#undef PG8_LDB
#undef PG8_MMA
#undef PG8_WAIT_V
#undef PG8_WAIT_L
#undef PG8_BAR
#undef PG8_SCHED
#undef PG8_EPI
}

template <class Sched, class Epi>
__device__ __forceinline__ void gemm_run(unsigned char* lds, const Sched& S, const Epi& E, int K, int lda, int ldb, int nseg) {
#if USE_MFMA_GEMM
    __syncthreads();
    gemm_mfma((LAS unsigned char*)lds, S, E, K, lda, ldb, nseg);
    __syncthreads();
#else
    gemm_naive(reinterpret_cast<float*>(lds), S, E, K, lda, ldb, nseg);
#endif
}

__device__ __forceinline__ void tr_item64(const float* W, int ld_src, int srcq, bf16_t* WT, int ld_dst, int n_dst, int kdst0, int k0, float* scr, int lane, const float* cscale = nullptr) {
    f32x4 v[16];
    const int c4 = (lane & 15) * 4, kr = lane >> 4;
    if (srcq >= 0) {
#pragma unroll
        for (int i = 0; i < 16; ++i) v[i] = *(const f32x4*)(W + (size_t)(k0 + kr + 4 * i) * ld_src + srcq);
        if (cscale) { const f32x4 s = *(const f32x4*)(cscale + srcq);
#pragma unroll
            for (int i = 0; i < 16; ++i) v[i] = v[i] * s; }
    } else {
#pragma unroll
        for (int i = 0; i < 16; ++i) v[i] = (f32x4){0.f, 0.f, 0.f, 0.f};
    }
#pragma unroll
    for (int i = 0; i < 16; ++i) { float* d = scr + (kr + 4 * i) * 65 + c4; d[0] = v[i][0]; d[1] = v[i][1]; d[2] = v[i][2]; d[3] = v[i][3]; }
    asm volatile("s_waitcnt lgkmcnt(0)" ::: "memory");
    const int c = lane & 7;
#pragma unroll
    for (int j = 0; j < 8; ++j) { const int n = (lane >> 3) + 8 * j; const float* s = scr + (8 * c) * 65 + n;
        u32x4 o; o.x = pk2(s[0 * 65], s[1 * 65]); o.y = pk2(s[2 * 65], s[3 * 65]); o.z = pk2(s[4 * 65], s[5 * 65]); o.w = pk2(s[6 * 65], s[7 * 65]);
        *(u32x4*)(WT + (size_t)(n_dst + n) * ld_dst + kdst0 + k0 + 8 * c) = o; }
    asm volatile("s_waitcnt lgkmcnt(0)" ::: "memory");
}
constexpr int CV_MIX_ITEMS = 2880 + 64 + 768 + 256;
__device__ __forceinline__ void convert_mix_item(const Params& p, int l, int it, float* scr, int lane) {
    unsigned char* ws = p.ws;
    const int c4 = (lane & 15) * 4;
    if (it < 2880) { const int R = it >> 4, kb = it & 15, dstn = R * 64; int srcq;
        if (R < 80) srcq = dstn + c4; else if (R < 128) srcq = dstn + 16 + c4; else if (R < 176) srcq = dstn + 48 + c4;
        else if (R == 176) srcq = c4 < 32 ? 8208 + c4 : (c4 < 48 ? 5120 + (c4 - 32) : -1); else srcq = -1;
        tr_item64(p.w_in + (size_t)l * 1024 * DIN, DIN, srcq, (bf16_t*)(ws + WS_WIN), 1024, dstn, 0, kb * 64, scr, lane); return; }
    it -= 2880;
    if (it < 64) { const int g = it >> 4, r = it & 15, kb = r >> 2, nb = r & 3;
        tr_item64(p.pool_w + (size_t)(l * 4 + g) * 65536, 256, nb * 64 + c4, (bf16_t*)(ws + WS_WPOOL) + (size_t)g * 65536, 256, nb * 64, 0, kb * 64, scr, lane, p.pool_scale + l * 1024 + g * 256); return; }
    it -= 64;
    if (it < 768) { const int br = it >> 8, r = it & 255, kb = r >> 4, nb = r & 15;
        tr_item64(p.w_branch + (size_t)(l * 3 + br) * 1048576, 1024, nb * 64 + c4, (bf16_t*)(ws + WS_WBR), 3072, nb * 64, br * 1024, kb * 64, scr, lane); return; }
    it -= 768;
    { const int kb = it >> 4, nb = it & 15;
      tr_item64(p.w_out + (size_t)l * 1048576, 1024, nb * 64 + c4, (bf16_t*)(ws + WS_WOUT), 1024, nb * 64, 0, kb * 64, scr, lane); }
}
constexpr int CV_EXP_ITEMS = 32 * 384;
__device__ __forceinline__ void convert_exp_item(const Params& p, int l, int it, float* scr, int lane) {
    unsigned char* ws = p.ws;
    const int c4 = (lane & 15) * 4;
    const int e = it / 384, r = it % 384;
    if (r < 256) { const int up = r >> 7, q = r & 127, kb = q >> 3, nb = q & 7; const int c = nb * 64;
        const float* src = (up ? p.w_eu : p.w_eg) + (size_t)(l * 32 + e) * 1024 * 512;
        tr_item64(src, 512, c + c4, (bf16_t*)(ws + WS_EW1) + (size_t)e * 1048576, 1024, (c >> 7) * 256 + up * 128 + (c & 127), 0, kb * 64, scr, lane); }
    else { const int q = r - 256, kb = q >> 4, nb = q & 15;
        tr_item64(p.w_ed + (size_t)(l * 32 + e) * 512 * 1024, 1024, nb * 64 + c4, (bf16_t*)(ws + WS_EW2) + (size_t)e * 524288, 512, nb * 64, 0, kb * 64, scr, lane); }
}

__device__ __forceinline__ void phase_pre(const Params& p, unsigned char* ldsb, int bid, int nb) {
    float* lds = reinterpret_cast<float*>(ldsb);
    const int tid = tid_fresh(), lane = tid & 63, wave = tid >> 6;
    for (int i = tid; i < 5 * 1024; i += NTHR) { const float v = i < 4096 ? p.c[i] : p.c_ctx[i - 4096]; lds[i] = silu_f(v); }
    __syncthreads();
    float* red = lds + 5120;
    for (int it = bid; it < 2 * 96; it += nb) {
        const int l = it / 96, j = (it % 96) * 64 + lane;
        const float* w = p.w_ada + (size_t)l * 1024 * 6144 + j;
        float a0 = 0, a1 = 0, a2 = 0, a3 = 0, a4 = 0;
        for (int k = wave * 128; k < wave * 128 + 128; ++k) { const float wv = w[(size_t)k * 6144];
            a0 += lds[k] * wv; a1 += lds[1024 + k] * wv; a2 += lds[2048 + k] * wv; a3 += lds[3072 + k] * wv; a4 += lds[4096 + k] * wv; }
        red[(wave * 5 + 0) * 64 + lane] = a0; red[(wave * 5 + 1) * 64 + lane] = a1; red[(wave * 5 + 2) * 64 + lane] = a2;
        red[(wave * 5 + 3) * 64 + lane] = a3; red[(wave * 5 + 4) * 64 + lane] = a4;
        __syncthreads();
        if (tid < 320) { const int r = tid >> 6, jj = tid & 63; float s = 0;
            for (int w8 = 0; w8 < 8; ++w8) s += red[(w8 * 5 + r) * 64 + jj];
            const int col = (it % 96) * 64 + jj;
            ((float*)(p.ws + WS_MOD))[(size_t)(l * 5 + r) * 6144 + col] = s + p.b_ada[l * 6144 + col]; }
        __syncthreads();
    }
    __syncthreads();
    float* scr = lds + wave * (64 * 65);
    for (int it = bid * 8 + wave; it < CV_MIX_ITEMS; it += nb * 8) convert_mix_item(p, 0, it, scr, lane);
}

__device__ __forceinline__ void norm_mod_row(f32x4 (&v)[4], const float* g, const float* shift, const float* scale, int lane) {
    float s = 0.f;
#pragma unroll
    for (int j = 0; j < 4; ++j) s += (v[j][0] * v[j][0] + v[j][1] * v[j][1]) + (v[j][2] * v[j][2] + v[j][3] * v[j][3]);
    const float rs = 1.0f / sqrtf(wave_sum(s) * (1.f / 1024.f) + EPS);
#pragma unroll
    for (int j = 0; j < 4; ++j) { const int c = 4 * lane + 256 * j; const f32x4 gg = *(const f32x4*)(g + c);
        f32x4 y = v[j] * rs * gg;
        if (shift) { const f32x4 sh = *(const f32x4*)(shift + c), sc = *(const f32x4*)(scale + c); y = y * (1.f + sc) + sh; }
        v[j] = y; }
}
__device__ __forceinline__ void store_row_bf16(bf16_t* dst, const f32x4 (&v)[4], int lane) {
#pragma unroll
    for (int j = 0; j < 4; ++j) { u32x2 w; w.x = pk2(v[j][0], v[j][1]); w.y = pk2(v[j][2], v[j][3]); *(u32x2*)(dst + 4 * lane + 256 * j) = w; }
}

__device__ __forceinline__ void phase_norm1(const Params& p, int bid, int nb) {
    const int lane = tid_fresh() & 63, wave = tid_fresh() >> 6;
    const float* mod = (const float*)(p.ws + WS_MOD);
    const int stride = nb * 8;
    int m = bid * 8 + wave;
    f32x4 v[4], w[4];
    if (m < MT) { const float* src = m < MC ? p.ctx + (size_t)m * 1024 : p.x + (size_t)(m - MC) * 1024;
#pragma unroll
        for (int j = 0; j < 4; ++j) v[j] = *(const f32x4*)(src + 4 * lane + 256 * j); }
    for (; m < MT; m += stride) {
        const int mn = m + stride;
        if (mn < MT) { const float* src = mn < MC ? p.ctx + (size_t)mn * 1024 : p.x + (size_t)(mn - MC) * 1024;
#pragma unroll
            for (int j = 0; j < 4; ++j) w[j] = *(const f32x4*)(src + 4 * lane + 256 * j); }
        float* xl = (float*)(p.ws + WS_XL) + (size_t)m * 1024;
#pragma unroll
        for (int j = 0; j < 4; ++j) *(f32x4*)(xl + 4 * lane + 256 * j) = v[j];
        const float* mr = mod + modrow(m) * 6144;
        norm_mod_row(v, p.g_mix, mr, mr + 1024, lane);
        store_row_bf16((bf16_t*)(p.ws + WS_H) + (size_t)m * 1024, v, lane);
#pragma unroll
        for (int j = 0; j < 4; ++j) v[j] = w[j];
    }
}

__device__ __forceinline__ float wave_incl_sum(float v, int lane) {
#pragma unroll
    for (int o = 1; o < 64; o <<= 1) { const float u = __shfl_up(v, o); if (lane >= o) v += u; }
    return v;
}
__device__ __forceinline__ float wave_incl_max(float v, int lane) {
#pragma unroll
    for (int o = 1; o < 64; o <<= 1) { const float u = __shfl_up(v, o); if (lane >= o) v = fmaxf(v, u); }
    return v;
}
__device__ __forceinline__ u32x2 pack4(f32x4 a) { u32x2 w; w.x = pk2(a[0], a[1]); w.y = pk2(a[2], a[3]); return w; }

__device__ __forceinline__ void chunk_geom(int gc, int& rbase, int& n0, int& len) {
    const int b = gc / 68, cin = gc % 68;
    if (cin < 4) { rbase = b * 256; n0 = cin * 64; len = 256; } else { rbase = MC + b * 4096; n0 = (cin - 4) * 64; len = 4096; }
}
__device__ __forceinline__ void conv8x4(const u32x4 (&raw)[7], const float* cw, const float* cb, int ch0, float scale, u32x4 (&out)[4]) {
    float w[4][8], bs[8];
#pragma unroll
    for (int j = 0; j < 4; ++j) { const f32x4 a = *(const f32x4*)(cw + j * 2048 + ch0), b2 = *(const f32x4*)(cw + j * 2048 + ch0 + 4);
#pragma unroll
        for (int i = 0; i < 4; ++i) { w[j][i] = a[i]; w[j][4 + i] = b2[i]; } }
    { const f32x4 a = *(const f32x4*)(cb + ch0), b2 = *(const f32x4*)(cb + ch0 + 4);
#pragma unroll
      for (int i = 0; i < 4; ++i) { bs[i] = a[i]; bs[4 + i] = b2[i]; } }
    float f[7][8];
#pragma unroll
    for (int k = 0; k < 7; ++k) unpack8(raw[k], f[k]);
#pragma unroll
    for (int pp = 0; pp < 4; ++pp) { f32x4 o0, o1;
#pragma unroll
        for (int i = 0; i < 8; ++i) { float a = bs[i];
#pragma unroll
            for (int j = 0; j < 4; ++j) a += w[j][i] * f[pp + j][i];
            a = silu_f(a) * scale; if (i < 4) o0[i] = a; else o1[i - 4] = a; }
        out[pp] = pack8(o0, o1); }
}
__device__ __forceinline__ void load_raw7(const bf16_t* src, size_t ld, int rbase, int tbase, int len, u32x4 (&raw)[7]) {
#pragma unroll
    for (int k = 0; k < 7; ++k) { const int t = tbase + k; const bool ok = (t >= 0) && (t < len); const int tc = t < 0 ? 0 : (t >= len ? len - 1 : t);
        u32x4 a = *(const u32x4*)(src + (size_t)(rbase + tc) * ld);
        if (!ok) a = (u32x4){0u, 0u, 0u, 0u};
        raw[k] = a; }
}
template <class F>
__device__ __forceinline__ void tile_transpose_out(const LAS bf16_t* tile, int ldsw, int ncol, int tid, F rowptr) {
    for (int q = tid; q < ncol * 8; q += NTHR) { const int c = q % ncol, sc = q / ncol;
        unsigned v[8];
#pragma unroll
        for (int i = 0; i < 8; ++i) v[i] = tile[(sc * 8 + i) * ldsw + c];
        u32x4 w; w.x = v[0] | (v[1] << 16); w.y = v[2] | (v[3] << 16); w.z = v[4] | (v[5] << 16); w.w = v[6] | (v[7] << 16);
        *(u32x4*)(rowptr(c) + sc * 8) = w; }
}

__device__ __forceinline__ void conv_m_item(const Params& p, int l, int item, LAS unsigned char* lds) {
    const int tid = tid_fresh(), gc = item >> 2, hd = item & 3;
    int rbase, n0, len; chunk_geom(gc, rbase, n0, len);
    const int cs = tid & 31, tg = tid >> 5, d0 = cs * 8, i0 = tg * 4;
    const float* cw = p.mconv_w + (size_t)l * 4 * 2048; const float* cb = p.mconv_b + (size_t)l * 2048;
    LAS bf16_t* Kl = (LAS bf16_t*)lds; LAS bf16_t* Vl = (LAS bf16_t*)(lds + 64 * 528);
    __syncthreads();
    { u32x4 raw[7], o[4];
      load_raw7((const bf16_t*)(p.ws + WS_Q) + hd * 256 + d0, 1024, rbase, n0 + i0 - 2, len, raw);
      conv8x4(raw, cw, cb, hd * 256 + d0, 1.0f, o);
#pragma unroll
      for (int pp = 0; pp < 4; ++pp) *(u32x4*)((bf16_t*)(p.ws + WS_QC) + (size_t)(rbase + n0 + i0 + pp) * 1024 + hd * 256 + d0) = o[pp];
      load_raw7((const bf16_t*)(p.ws + WS_K) + hd * 256 + d0, 1024, rbase, n0 + i0 - 2, len, raw);
      conv8x4(raw, cw, cb, 1024 + hd * 256 + d0, 0.0625f, o);
#pragma unroll
      for (int pp = 0; pp < 4; ++pp) { *(u32x4*)((bf16_t*)(p.ws + WS_KC) + (size_t)(rbase + n0 + i0 + pp) * 1024 + hd * 256 + d0) = o[pp];
          *(LAS u32x4*)((LAS unsigned char*)Kl + (i0 + pp) * 528 + d0 * 2) = o[pp]; } }
#pragma unroll
    for (int j = 0; j < 4; ++j) { const int q = tid + NTHR * j, row = q >> 5, ch = q & 31;
        *(LAS u32x4*)((LAS unsigned char*)Vl + row * 528 + ch * 16) = *(const u32x4*)((const bf16_t*)(p.ws + WS_V) + (size_t)(rbase + n0 + row) * 1024 + hd * 256 + ch * 8); }
    __syncthreads();
    bf16_t* kct = (bf16_t*)(p.ws + WS_KCT) + (size_t)(gc * 4 + hd) * 16384; bf16_t* vt = (bf16_t*)(p.ws + WS_VT) + (size_t)(gc * 4 + hd) * 16384;
    tile_transpose_out(Kl, 264, 256, tid, [&](int c) { return kct + c * 64; });
    tile_transpose_out(Vl, 264, 256, tid, [&](int c) { return vt + c * 64; });
}

__device__ __forceinline__ void conv_s_item(const Params& p, int l, int item, LAS unsigned char* lds) {
    const int tid = tid_fresh(), gc = item >> 2, grp = item & 3;
    int rbase, n0, len; chunk_geom(gc, rbase, n0, len);
    const int cs = tid & 31, tg = tid >> 5, i0 = tg * 4;
    const float* cw = p.sconv_w + (size_t)l * 4 * 2048; const float* cb = p.sconv_b + (size_t)l * 2048;
    LAS bf16_t* Bl = (LAS bf16_t*)lds; LAS bf16_t* Xl = (LAS bf16_t*)(lds + 64 * 272);
    __syncthreads();
    { u32x4 raw[7], o[4];
      const int isC = cs >> 4, nn = (cs & 15) * 8;
      load_raw7((const bf16_t*)(p.ws + (isC ? WS_SC : WS_SB)) + grp * 128 + nn, 512, rbase, n0 + i0 - 2, len, raw);
      conv8x4(raw, cw, cb, 1024 + isC * 512 + grp * 128 + nn, 1.0f, o);
      bf16_t* dst = (bf16_t*)(p.ws + (isC ? WS_CC : WS_BC)) + grp * 128 + nn;
#pragma unroll
      for (int pp = 0; pp < 4; ++pp) { *(u32x4*)(dst + (size_t)(rbase + n0 + i0 + pp) * 512) = o[pp];
          if (!isC) *(LAS u32x4*)((LAS unsigned char*)Bl + (i0 + pp) * 272 + nn * 2) = o[pp]; }
      load_raw7((const bf16_t*)(p.ws + WS_SX) + grp * 256 + cs * 8, 1024, rbase, n0 + i0 - 2, len, raw);
      conv8x4(raw, cw, cb, grp * 256 + cs * 8, 1.0f, o);
#pragma unroll
      for (int pp = 0; pp < 4; ++pp) *(LAS u32x4*)((LAS unsigned char*)Xl + (i0 + pp) * 528 + cs * 16) = o[pp]; }
    __syncthreads();
    bf16_t* bct = (bf16_t*)(p.ws + WS_BCT) + (size_t)(gc * 4 + grp) * 8192; bf16_t* xct = (bf16_t*)(p.ws + WS_XCT) + (size_t)(gc * 16 + grp * 4) * 4096;
    tile_transpose_out(Bl, 136, 128, tid, [&](int c) { return bct + c * 64; });
    tile_transpose_out(Xl, 264, 256, tid, [&](int c) { return xct + c * 64; });
}

__device__ __forceinline__ void pool_window_item(const Params& p, int it, LAS unsigned char* lds) {
    const int tid = tid_fresh();
    bf16_t* BR = (bf16_t*)(p.ws + WS_BR);
    __syncthreads();
    if (it < 256) {
        const int row0 = MC + it * 64;
        for (int q = tid; q < 64 * 128; q += NTHR) { const int r = q >> 7, ch = q & 127;
            *(LAS u32x4*)(lds + q * 16) = *(const u32x4*)(BR + (size_t)(row0 + r) * 3072 + ch * 8); }
        __syncthreads();
        for (int q = tid; q < 64 * 128; q += NTHR) { const int r = q >> 7, ch = q & 127, w = 2 << (ch >> 5);
            int lo = r - (w >> 1), hi = lo + w - 1; lo = lo < 0 ? 0 : lo; hi = hi > 63 ? 63 : hi;
            float s[8] = {0, 0, 0, 0, 0, 0, 0, 0}, self[8];
            for (int rr = lo; rr <= hi; ++rr) { float f[8]; unpack8(*(const LAS u32x4*)(lds + (rr * 128 + ch) * 16), f);
#pragma unroll
                for (int j = 0; j < 8; ++j) s[j] += f[j]; }
            unpack8(*(const LAS u32x4*)(lds + q * 16), self);
            const float inv = 1.f / (float)(hi - lo + 1); f32x4 a, b;
#pragma unroll
            for (int j = 0; j < 4; ++j) { a[j] = s[j] * inv - self[j]; b[j] = s[4 + j] * inv - self[4 + j]; }
            *(u32x4*)(BR + (size_t)(row0 + r) * 3072 + ch * 8) = pack8(a, b); }
    } else {
        const int bb = (it - 256) >> 2, g = (it - 256) & 3, row0 = bb * 256, w = 2 << g;
        for (int q = tid; q < 256 * 32; q += NTHR) { const int r = q >> 5, ch = q & 31;
            *(LAS u32x4*)(lds + q * 16) = *(const u32x4*)(BR + (size_t)(row0 + r) * 3072 + g * 256 + ch * 8); }
        __syncthreads();
        for (int q = tid; q < 256 * 32; q += NTHR) { const int r = q >> 5, ch = q & 31;
            int lo = r - (w >> 1), hi = lo + w - 1; lo = lo < 0 ? 0 : lo; hi = hi > 255 ? 255 : hi;
            float s[8] = {0, 0, 0, 0, 0, 0, 0, 0}, self[8];
            for (int rr = lo; rr <= hi; ++rr) { float f[8]; unpack8(*(const LAS u32x4*)(lds + (rr * 32 + ch) * 16), f);
#pragma unroll
                for (int j = 0; j < 8; ++j) s[j] += f[j]; }
            unpack8(*(const LAS u32x4*)(lds + q * 16), self);
            const float inv = 1.f / (float)(hi - lo + 1); f32x4 a, b;
#pragma unroll
            for (int j = 0; j < 4; ++j) { a[j] = s[j] * inv - self[j]; b[j] = s[4 + j] * inv - self[4 + j]; }
            *(u32x4*)(BR + (size_t)(row0 + r) * 3072 + g * 256 + ch * 8) = pack8(a, b); }
    }
    __syncthreads();
}

constexpr int ML_VT = 0, ML_VWT = 5280, ML_CT = 10560, ML_Q = 28512, ML_K = 63328, ML_KT = 98144, ML_A = 139104, ML_MISC = 149344;
__device__ __forceinline__ void mlstm_chunk_item(const Params& p, int l, int item, LAS unsigned char* lds) {
    const int tid = tid_fresh(), lane = tid & 63, wid = __builtin_amdgcn_readfirstlane(tid >> 6), fr = lane & 15, fq = lane >> 4;
    const int b = item >> 6, hd = (item >> 4) & 3, dir = (item >> 3) & 1, eg = item & 7;
    const bf16_t* QC = (const bf16_t*)(p.ws + WS_QC); const bf16_t* KC = (const bf16_t*)(p.ws + WS_KC);
    const bf16_t* KCT = (const bf16_t*)(p.ws + WS_KCT); const bf16_t* VT = (const bf16_t*)(p.ws + WS_VT);
    const float* GA = (const float*)(p.ws + WS_GA);
    bf16_t* OUT = (bf16_t*)(p.ws + (dir ? WS_HB2 : WS_HF2));
    LAS float* misc = (LAS float*)(lds + ML_MISC);
    const float gb_i = p.mgate_b[l * 16 + dir * 4 + hd], gb_f = p.mgate_b[l * 16 + (2 + dir) * 4 + hd];
    const int ti = wid >> 1, wh = wid & 1;
    __syncthreads();
    for (int i = tid; i < 17952 / 4; i += NTHR) ((LAS unsigned*)(lds + ML_CT))[i] = 0u;
    if (tid < 64) ((LAS bf16_t*)(lds + ML_VT + 32 * 160))[tid] = (bf16_t)0x3F80;
    f32x4 Cacc[2][3];
#pragma unroll
    for (int j = 0; j < 2; ++j)
#pragma unroll
        for (int e = 0; e < 3; ++e) Cacc[j][e] = (f32x4){0.f, 0.f, 0.f, 0.f};
    float m_st = 0.f;
    __syncthreads();
    for (int c = -1; c < 68; ++c) {
        const int cn = c + 1;
        u32x4 rq[4], rk[4], rt[4], rv = (u32x4){0u, 0u, 0u, 0u}; float g_i = 0.f, g_f = 0.f;
#pragma unroll
        for (int j = 0; j < 4; ++j) { rq[j] = (u32x4){0u, 0u, 0u, 0u}; rk[j] = rq[j]; rt[j] = rq[j]; }
        if (cn < 68) {
            const int cin = cn < 4 ? (dir ? 3 - cn : cn) : 4 + (dir ? 67 - cn : cn - 4), gc = b * 68 + cin;
            int rbase, n0, len; chunk_geom(gc, rbase, n0, len);
#pragma unroll
            for (int j = 0; j < 4; ++j) { const int q = tid + NTHR * j;
                const size_t ro = (size_t)(rbase + n0 + (q >> 5)) * 1024 + hd * 256 + (q & 31) * 8;
                rq[j] = *(const u32x4*)(QC + ro); rk[j] = *(const u32x4*)(KC + ro);
                rt[j] = *(const u32x4*)(KCT + (size_t)(gc * 4 + hd) * 16384 + (size_t)q * 8); }
            if (tid < 256) rv = *(const u32x4*)(VT + ((size_t)(gc * 4 + hd) * 256 + eg * 32) * 64 + (size_t)tid * 8);
            { const int j = dir ? 63 - lane : lane; const float* g = GA + (size_t)(rbase + n0 + j) * 16; g_i = g[dir * 4 + hd]; g_f = g[(2 + dir) * 4 + hd]; }
        }
        if (c >= 0) {
            const int cin = c < 4 ? (dir ? 3 - c : c) : 4 + (dir ? 67 - c : c - 4), gc = b * 68 + cin;
            int rbase, n0, len; chunk_geom(gc, rbase, n0, len);
            {
                f32x4 st[2] = {(f32x4){0.f, 0.f, 0.f, 0.f}, (f32x4){0.f, 0.f, 0.f, 0.f}};
                const LAS unsigned char* qb = lds + ML_Q + (16 * ti + fr) * 544 + fq * 16;
                const LAS unsigned char* kb0 = lds + ML_K + (16 * (2 * wh) + fr) * 544 + fq * 16;
#pragma unroll
                for (int kd = 0; kd < 8; ++kd) {
                    const bf16x8 qf = *(const LAS bf16x8*)(qb + kd * 64);
                    const bf16x8 k0 = *(const LAS bf16x8*)(kb0 + kd * 64), k1 = *(const LAS bf16x8*)(kb0 + 16 * 544 + kd * 64);
                    st[0] = __builtin_amdgcn_mfma_f32_16x16x32_bf16(k0, qf, st[0], 0, 0, 0);
                    st[1] = __builtin_amdgcn_mfma_f32_16x16x32_bf16(k1, qf, st[1], 0, 0, 0);
                }
                const int t = 16 * ti + fr; const float Mt = misc[64 + t];
#pragma unroll
                for (int j = 0; j < 2; ++j) { const int s0 = 16 * (2 * wh + j) + 4 * fq; const f32x4 av = *(const LAS f32x4*)(misc + s0);
                    f32x4 o;
#pragma unroll
                    for (int r = 0; r < 4; ++r) { const bool keep = dir ? (s0 + r >= t) : (s0 + r <= t); o[r] = keep ? st[j][r] * __expf(av[r] - Mt) : 0.f; }
                    *(LAS u32x2*)(lds + ML_A + t * 160 + s0 * 2) = pack4(o); }
                { const int e = tid >> 4, s4 = (tid & 15) * 4; const u32x2 v = *(const LAS u32x2*)(lds + ML_VT + e * 160 + s4 * 2); const f32x4 w = *(const LAS f32x4*)(misc + 256 + s4);
                  f32x4 o; o[0] = lo16(v.x) * w[0]; o[1] = hi16(v.x) * w[1]; o[2] = lo16(v.y) * w[2]; o[3] = hi16(v.y) * w[3];
                  *(LAS u32x2*)(lds + ML_VWT + e * 160 + s4 * 2) = pack4(o);
                  if (tid < 16) *(LAS u32x2*)(lds + ML_VWT + 32 * 160 + s4 * 2) = pack4(w); }
            }
            __syncthreads();
            {
                f32x4 n1o = (f32x4){0.f, 0.f, 0.f, 0.f}, n1a = n1o, n2o = n1o, n2a = n1o;
                const LAS unsigned char* ab = lds + ML_A + (16 * ti + fr) * 160 + fq * 16;
                const LAS unsigned char* vo = lds + ML_VT + (16 * wh + fr) * 160 + fq * 16;
                const LAS unsigned char* va = lds + ML_VT + (32 + fr) * 160 + fq * 16;
#pragma unroll
                for (int ks = 0; ks < 2; ++ks) { const bf16x8 af = *(const LAS bf16x8*)(ab + ks * 64);
                    n1o = __builtin_amdgcn_mfma_f32_16x16x32_bf16(af, *(const LAS bf16x8*)(vo + ks * 64), n1o, 0, 0, 0);
                    n1a = __builtin_amdgcn_mfma_f32_16x16x32_bf16(af, *(const LAS bf16x8*)(va + ks * 64), n1a, 0, 0, 0); }
                const LAS unsigned char* qb = lds + ML_Q + (16 * ti + fr) * 544 + fq * 16;
                const LAS unsigned char* co = lds + ML_CT + (16 * wh + fr) * 544 + fq * 16;
                const LAS unsigned char* ca = lds + ML_CT + (32 + fr) * 544 + fq * 16;
#pragma unroll
                for (int kd = 0; kd < 8; ++kd) { const bf16x8 qf = *(const LAS bf16x8*)(qb + kd * 64);
                    n2o = __builtin_amdgcn_mfma_f32_16x16x32_bf16(qf, *(const LAS bf16x8*)(co + kd * 64), n2o, 0, 0, 0);
                    n2a = __builtin_amdgcn_mfma_f32_16x16x32_bf16(qf, *(const LAS bf16x8*)(ca + kd * 64), n2a, 0, 0, 0); }
                const int t0 = 16 * ti + 4 * fq;
                const f32x4 sgv = *(const LAS f32x4*)(misc + 128 + t0), emv = *(const LAS f32x4*)(misc + 192 + t0);
                const bool wr_out = !(l == 1 && cin < 4);
#pragma unroll
                for (int r = 0; r < 4; ++r) {
                    const float den = __shfl(n1a[r] + sgv[r] * n2a[r], lane & 48);
                    const float hv = (n1o[r] + sgv[r] * n2o[r]) / fmaxf(fabsf(den), emv[r]);
                    if (wr_out) OUT[(size_t)(rbase + n0 + t0 + r) * 1024 + hd * 256 + eg * 32 + 16 * wh + fr] = (bf16_t)f2bf(hv);
                }
                const float decay = misc[320];
#pragma unroll
                for (int j = 0; j < 2; ++j)
#pragma unroll
                    for (int e = 0; e < 3; ++e) Cacc[j][e] = Cacc[j][e] * decay;
                const LAS unsigned char* kt = lds + ML_KT + (16 * (2 * wid) + fr) * 160 + fq * 16;
                const LAS unsigned char* vw = lds + ML_VWT + fr * 160 + fq * 16;
#pragma unroll
                for (int ks = 0; ks < 2; ++ks) {
                    const bf16x8 k0 = *(const LAS bf16x8*)(kt + ks * 64), k1 = *(const LAS bf16x8*)(kt + 16 * 160 + ks * 64);
                    const bf16x8 v0 = *(const LAS bf16x8*)(vw + ks * 64), v1 = *(const LAS bf16x8*)(vw + 16 * 160 + ks * 64), v2 = *(const LAS bf16x8*)(vw + 32 * 160 + ks * 64);
                    Cacc[0][0] = __builtin_amdgcn_mfma_f32_16x16x32_bf16(k0, v0, Cacc[0][0], 0, 0, 0);
                    Cacc[0][1] = __builtin_amdgcn_mfma_f32_16x16x32_bf16(k0, v1, Cacc[0][1], 0, 0, 0);
                    Cacc[0][2] = __builtin_amdgcn_mfma_f32_16x16x32_bf16(k0, v2, Cacc[0][2], 0, 0, 0);
                    Cacc[1][0] = __builtin_amdgcn_mfma_f32_16x16x32_bf16(k1, v0, Cacc[1][0], 0, 0, 0);
                    Cacc[1][1] = __builtin_amdgcn_mfma_f32_16x16x32_bf16(k1, v1, Cacc[1][1], 0, 0, 0);
                    Cacc[1][2] = __builtin_amdgcn_mfma_f32_16x16x32_bf16(k1, v2, Cacc[1][2], 0, 0, 0);
                }
            }
            __syncthreads();
#pragma unroll
            for (int j = 0; j < 2; ++j) { const int dcol = (16 * (2 * wid + j) + 4 * fq) * 2;
                *(LAS u32x2*)(lds + ML_CT + fr * 544 + dcol) = pack4(Cacc[j][0]);
                *(LAS u32x2*)(lds + ML_CT + (16 + fr) * 544 + dcol) = pack4(Cacc[j][1]);
                if (fr == 0) *(LAS u32x2*)(lds + ML_CT + 32 * 544 + dcol) = pack4(Cacc[j][2]); }
        }
        if (cn < 68) {
#pragma unroll
            for (int j = 0; j < 4; ++j) { const int q = tid + NTHR * j;
                *(LAS u32x4*)(lds + ML_Q + (q >> 5) * 544 + (q & 31) * 16) = rq[j];
                *(LAS u32x4*)(lds + ML_K + (q >> 5) * 544 + (q & 31) * 16) = rk[j];
                *(LAS u32x4*)(lds + ML_KT + (q >> 3) * 160 + (q & 7) * 16) = rt[j]; }
            if (tid < 256) *(LAS u32x4*)(lds + ML_VT + (tid >> 3) * 160 + (tid & 7) * 16) = rv;
            if (wid == 0) {
                const int j = dir ? 63 - lane : lane;
                const float ig = g_i + gb_i, lf = logsigmoid_f(g_f + gb_f);
                const float cum = wave_incl_sum(lf, lane), a = ig - cum, pm = wave_incl_max(a, lane);
                const float M = fmaxf(m_st, pm), sg = __expf(m_st - M), mt = cum + M;
                const float M63 = __shfl(M, 63), cum63 = __shfl(cum, 63);
                misc[j] = a; misc[64 + j] = M; misc[128 + j] = sg; misc[192 + j] = __expf(-mt); misc[256 + j] = __expf(a - M63);
                if (lane == 0) misc[320] = __expf(m_st - M63);
                m_st = cum63 + M63;
            }
        }
        __syncthreads();
    }
}

constexpr int SS_C = 0, SS_B = 18432, SS_BT = 36864, SS_XT = 57344, SS_XWT = 62464, SS_G = 67584, SS_S = 77824, SS_XRT = 87040, SS_MISC = 92160;
__device__ __forceinline__ void ssd_chunk_item(const Params& p, int l, int item, LAS unsigned char* lds) {
    const int tid = tid_fresh(), lane = tid & 63, wid = __builtin_amdgcn_readfirstlane(tid >> 6), fr = lane & 15, fq = lane >> 4;
    const int b = item >> 6, hd = (item >> 2) & 15, dir = (item >> 1) & 1, ps = item & 1, grp = hd >> 2;
    const bf16_t* BC = (const bf16_t*)(p.ws + WS_BC); const bf16_t* CC = (const bf16_t*)(p.ws + WS_CC);
    const bf16_t* BCT = (const bf16_t*)(p.ws + WS_BCT); const bf16_t* XCT = (const bf16_t*)(p.ws + WS_XCT);
    const float* DT = (const float*)(p.ws + WS_DT);
    bf16_t* OUT = (bf16_t*)(p.ws + (dir ? WS_YB : WS_YF));
    LAS float* misc = (LAS float*)(lds + SS_MISC);
    const float dtb = p.sdt_bias[l * 32 + dir * 16 + hd], aneg = -__expf(p.sa_log[l * 32 + dir * 16 + hd]), dskip = p.sd[l * 16 + hd];
    const int ti = wid >> 1, wh = wid & 1;
    __syncthreads();
    for (int i = tid; i < 9216 / 4; i += NTHR) ((LAS unsigned*)(lds + SS_S))[i] = 0u;
    f32x4 Sacc[2] = {(f32x4){0.f, 0.f, 0.f, 0.f}, (f32x4){0.f, 0.f, 0.f, 0.f}};
    __syncthreads();
    for (int c = -1; c < 68; ++c) {
        const int cn = c + 1;
        u32x4 rc[2], rb[2], rt[2], rx = (u32x4){0u, 0u, 0u, 0u}; float dtraw = 0.f;
#pragma unroll
        for (int j = 0; j < 2; ++j) { rc[j] = (u32x4){0u, 0u, 0u, 0u}; rb[j] = rc[j]; rt[j] = rc[j]; }
        if (cn < 68) {
            const int cin = cn < 4 ? (dir ? 3 - cn : cn) : 4 + (dir ? 67 - cn : cn - 4), gc = b * 68 + cin;
            int rbase, n0, len; chunk_geom(gc, rbase, n0, len);
#pragma unroll
            for (int j = 0; j < 2; ++j) { const int q = tid + NTHR * j;
                const size_t ro = (size_t)(rbase + n0 + (q >> 4)) * 512 + grp * 128 + (q & 15) * 8;
                rc[j] = *(const u32x4*)(CC + ro); rb[j] = *(const u32x4*)(BC + ro);
                rt[j] = *(const u32x4*)(BCT + (size_t)(gc * 4 + grp) * 8192 + (size_t)q * 8); }
            if (tid < 256) rx = *(const u32x4*)(XCT + ((size_t)(gc * 16 + hd) * 64 + ps * 32) * 64 + (size_t)tid * 8);
            { const int j = dir ? 63 - lane : lane; dtraw = DT[(size_t)(rbase + n0 + j) * 32 + dir * 16 + hd]; }
        }
        if (c >= 0) {
            const int cin = c < 4 ? (dir ? 3 - c : c) : 4 + (dir ? 67 - c : c - 4), gc = b * 68 + cin;
            int rbase, n0, len; chunk_geom(gc, rbase, n0, len);
            {
                f32x4 st[2] = {(f32x4){0.f, 0.f, 0.f, 0.f}, (f32x4){0.f, 0.f, 0.f, 0.f}};
                const LAS unsigned char* cbp = lds + SS_C + (16 * ti + fr) * 288 + fq * 16;
                const LAS unsigned char* bb0 = lds + SS_B + (16 * (2 * wh) + fr) * 288 + fq * 16;
#pragma unroll
                for (int kn = 0; kn < 4; ++kn) {
                    const bf16x8 cf = *(const LAS bf16x8*)(cbp + kn * 64);
                    const bf16x8 b0 = *(const LAS bf16x8*)(bb0 + kn * 64), b1 = *(const LAS bf16x8*)(bb0 + 16 * 288 + kn * 64);
                    st[0] = __builtin_amdgcn_mfma_f32_16x16x32_bf16(b0, cf, st[0], 0, 0, 0);
                    st[1] = __builtin_amdgcn_mfma_f32_16x16x32_bf16(b1, cf, st[1], 0, 0, 0);
                }
                const int t = 16 * ti + fr; const float at = misc[t];
#pragma unroll
                for (int j = 0; j < 2; ++j) { const int s0 = 16 * (2 * wh + j) + 4 * fq; const f32x4 av = *(const LAS f32x4*)(misc + s0);
                    f32x4 o;
#pragma unroll
                    for (int r = 0; r < 4; ++r) { const bool keep = dir ? (s0 + r >= t) : (s0 + r <= t); o[r] = keep ? st[j][r] * __expf(at - av[r]) : 0.f; }
                    *(LAS u32x2*)(lds + SS_G + t * 160 + s0 * 2) = pack4(o); }
                { const int e = tid >> 4, s4 = (tid & 15) * 4; const u32x2 v = *(const LAS u32x2*)(lds + SS_XRT + e * 160 + s4 * 2);
                  const f32x4 w = *(const LAS f32x4*)(misc + 128 + s4), dv = *(const LAS f32x4*)(misc + 192 + s4);
                  f32x4 o; o[0] = lo16(v.x) * dv[0]; o[1] = hi16(v.x) * dv[1]; o[2] = lo16(v.y) * dv[2]; o[3] = hi16(v.y) * dv[3];
                  *(LAS u32x2*)(lds + SS_XT + e * 160 + s4 * 2) = pack4(o);
                  *(LAS u32x2*)(lds + SS_XWT + e * 160 + s4 * 2) = pack4(o * w); }
            }
            __syncthreads();
            {
                f32x4 y1 = (f32x4){0.f, 0.f, 0.f, 0.f}, y2 = y1;
                const LAS unsigned char* gb = lds + SS_G + (16 * ti + fr) * 160 + fq * 16;
                const LAS unsigned char* xb = lds + SS_XT + (16 * wh + fr) * 160 + fq * 16;
#pragma unroll
                for (int ks = 0; ks < 2; ++ks) y1 = __builtin_amdgcn_mfma_f32_16x16x32_bf16(*(const LAS bf16x8*)(gb + ks * 64), *(const LAS bf16x8*)(xb + ks * 64), y1, 0, 0, 0);
                const LAS unsigned char* cbp = lds + SS_C + (16 * ti + fr) * 288 + fq * 16;
                const LAS unsigned char* sb = lds + SS_S + (16 * wh + fr) * 288 + fq * 16;
#pragma unroll
                for (int kn = 0; kn < 4; ++kn) y2 = __builtin_amdgcn_mfma_f32_16x16x32_bf16(*(const LAS bf16x8*)(cbp + kn * 64), *(const LAS bf16x8*)(sb + kn * 64), y2, 0, 0, 0);
                const int t0 = 16 * ti + 4 * fq;
                const f32x4 eav = *(const LAS f32x4*)(misc + 64 + t0);
                const u32x2 xs = *(const LAS u32x2*)(lds + SS_XRT + (16 * wh + fr) * 160 + t0 * 2);
                const float xv[4] = {lo16(xs.x), hi16(xs.x), lo16(xs.y), hi16(xs.y)};
                const bool wr_out = !(l == 1 && cin < 4);
#pragma unroll
                for (int r = 0; r < 4; ++r) {
                    float yv = y1[r] + eav[r] * y2[r];
                    if (dir == 0) yv += dskip * xv[r];
                    if (wr_out) OUT[(size_t)(rbase + n0 + t0 + r) * 1024 + hd * 64 + ps * 32 + 16 * wh + fr] = (bf16_t)f2bf(yv);
                }
                const float dec = misc[256];
                Sacc[0] = Sacc[0] * dec; Sacc[1] = Sacc[1] * dec;
                const LAS unsigned char* bt = lds + SS_BT + (16 * wid + fr) * 160 + fq * 16;
                const LAS unsigned char* xw = lds + SS_XWT + fr * 160 + fq * 16;
#pragma unroll
                for (int ks = 0; ks < 2; ++ks) { const bf16x8 bf = *(const LAS bf16x8*)(bt + ks * 64);
                    Sacc[0] = __builtin_amdgcn_mfma_f32_16x16x32_bf16(bf, *(const LAS bf16x8*)(xw + ks * 64), Sacc[0], 0, 0, 0);
                    Sacc[1] = __builtin_amdgcn_mfma_f32_16x16x32_bf16(bf, *(const LAS bf16x8*)(xw + 16 * 160 + ks * 64), Sacc[1], 0, 0, 0); }
            }
            __syncthreads();
            { const int ncol = (16 * wid + 4 * fq) * 2;
              *(LAS u32x2*)(lds + SS_S + fr * 288 + ncol) = pack4(Sacc[0]);
              *(LAS u32x2*)(lds + SS_S + (16 + fr) * 288 + ncol) = pack4(Sacc[1]); }
        }
        if (cn < 68) {
#pragma unroll
            for (int j = 0; j < 2; ++j) { const int q = tid + NTHR * j;
                *(LAS u32x4*)(lds + SS_C + (q >> 4) * 288 + (q & 15) * 16) = rc[j];
                *(LAS u32x4*)(lds + SS_B + (q >> 4) * 288 + (q & 15) * 16) = rb[j];
                *(LAS u32x4*)(lds + SS_BT + (q >> 3) * 160 + (q & 7) * 16) = rt[j]; }
            if (tid < 256) *(LAS u32x4*)(lds + SS_XRT + (tid >> 3) * 160 + (tid & 7) * 16) = rx;
            if (wid == 0) {
                const int j = dir ? 63 - lane : lane;
                const float dtv = softplus_f(dtraw + dtb);
                const float acs = wave_incl_sum(dtv * aneg, lane);
                const float a63 = __shfl(acs, 63);
                misc[j] = acs; misc[64 + j] = __expf(acs); misc[128 + j] = __expf(a63 - acs); misc[192 + j] = dtv;
                if (lane == 0) misc[256] = __expf(a63);
            }
        }
        __syncthreads();
    }
}

__device__ __forceinline__ void mlstm_finish_rows(const Params& p, int l, int row_lo, int gw, int ngw) {
    if (p.dup) return;
    const int lane = tid_fresh() & 63;
    const bf16_t* HF = (const bf16_t*)(p.ws + WS_HF2); const bf16_t* HB = (const bf16_t*)(p.ws + WS_HB2);
    bf16_t* BR = (bf16_t*)(p.ws + WS_BR);
    const float* ng = p.mnorm_g + l * 1024;
    int row = row_lo + gw;
    u32x2 ca[4], cb[4], co[4], na[4], nbv[4], no[4];
    if (row < MT) { const size_t so = (size_t)scanrow(row) * 1024;
#pragma unroll
        for (int hd = 0; hd < 4; ++hd) { const int c = hd * 256 + 4 * lane; ca[hd] = *(const u32x2*)(HF + so + c); cb[hd] = *(const u32x2*)(HB + so + c); co[hd] = *(const u32x2*)(BR + (size_t)row * 3072 + 1024 + c); } }
    for (; row < MT; row += ngw) {
        const int rn = row + ngw;
        if (rn < MT) { const size_t so = (size_t)scanrow(rn) * 1024;
#pragma unroll
            for (int hd = 0; hd < 4; ++hd) { const int c = hd * 256 + 4 * lane; na[hd] = *(const u32x2*)(HF + so + c); nbv[hd] = *(const u32x2*)(HB + so + c); no[hd] = *(const u32x2*)(BR + (size_t)rn * 3072 + 1024 + c); } }
#pragma unroll
        for (int hd = 0; hd < 4; ++hd) { const int c = hd * 256 + 4 * lane;
            const u32x2 a = ca[hd], b2 = cb[hd], o = co[hd];
            f32x4 h; h[0] = lo16(a.x) + lo16(b2.x); h[1] = hi16(a.x) + hi16(b2.x); h[2] = lo16(a.y) + lo16(b2.y); h[3] = hi16(a.y) + hi16(b2.y);
            const float ss = wave_sum((h[0] * h[0] + h[1] * h[1]) + (h[2] * h[2] + h[3] * h[3]));
            const float rs = 1.0f / sqrtf(ss * (1.f / 256.f) + EPS);
            const f32x4 g = *(const f32x4*)(ng + c);
            f32x4 r; r[0] = sigmoid_f(lo16(o.x)) * (h[0] * rs * g[0]); r[1] = sigmoid_f(hi16(o.x)) * (h[1] * rs * g[1]);
            r[2] = sigmoid_f(lo16(o.y)) * (h[2] * rs * g[2]); r[3] = sigmoid_f(hi16(o.y)) * (h[3] * rs * g[3]);
            u32x2 w; w.x = pk2(r[0], r[1]); w.y = pk2(r[2], r[3]);
            *(u32x2*)(BR + (size_t)row * 3072 + 1024 + c) = w; }
#pragma unroll
        for (int hd = 0; hd < 4; ++hd) { ca[hd] = na[hd]; cb[hd] = nbv[hd]; co[hd] = no[hd]; }
    }
}
__device__ __forceinline__ void ssd_finish_rows(const Params& p, int l, int row_lo, int gw, int ngw) {
    if (p.dup) return;
    const int lane = tid_fresh() & 63;
    const bf16_t* YF = (const bf16_t*)(p.ws + WS_YF); const bf16_t* YB = (const bf16_t*)(p.ws + WS_YB);
    bf16_t* BR = (bf16_t*)(p.ws + WS_BR);
    const float* ng = p.snorm_g + l * 1024;
    int row = row_lo + gw;
    u32x2 ca[4], cb[4], cz[4], na[4], nbv[4], nz[4];
    if (row < MT) {
#pragma unroll
        for (int j = 0; j < 4; ++j) { const int c = 4 * lane + 256 * j; ca[j] = *(const u32x2*)(YF + (size_t)row * 1024 + c); cb[j] = *(const u32x2*)(YB + (size_t)row * 1024 + c); cz[j] = *(const u32x2*)(BR + (size_t)row * 3072 + 2048 + c); } }
    for (; row < MT; row += ngw) {
        const int rn = row + ngw;
        if (rn < MT) {
#pragma unroll
            for (int j = 0; j < 4; ++j) { const int c = 4 * lane + 256 * j; na[j] = *(const u32x2*)(YF + (size_t)rn * 1024 + c); nbv[j] = *(const u32x2*)(YB + (size_t)rn * 1024 + c); nz[j] = *(const u32x2*)(BR + (size_t)rn * 3072 + 2048 + c); } }
        f32x4 v[4]; float ss = 0.f;
#pragma unroll
        for (int j = 0; j < 4; ++j) { const u32x2 a = ca[j], b2 = cb[j], z = cz[j];
            v[j][0] = (lo16(a.x) + lo16(b2.x)) * silu_f(lo16(z.x)); v[j][1] = (hi16(a.x) + hi16(b2.x)) * silu_f(hi16(z.x));
            v[j][2] = (lo16(a.y) + lo16(b2.y)) * silu_f(lo16(z.y)); v[j][3] = (hi16(a.y) + hi16(b2.y)) * silu_f(hi16(z.y));
            ss += (v[j][0] * v[j][0] + v[j][1] * v[j][1]) + (v[j][2] * v[j][2] + v[j][3] * v[j][3]); }
        const float rs = 1.0f / sqrtf(wave_sum(ss) * (1.f / 1024.f) + EPS);
#pragma unroll
        for (int j = 0; j < 4; ++j) { const int c = 4 * lane + 256 * j; const f32x4 g = *(const f32x4*)(ng + c);
            u32x2 w; w.x = pk2(v[j][0] * rs * g[0], v[j][1] * rs * g[1]); w.y = pk2(v[j][2] * rs * g[2], v[j][3] * rs * g[3]);
            *(u32x2*)(BR + (size_t)row * 3072 + 2048 + c) = w; }
#pragma unroll
        for (int j = 0; j < 4; ++j) { ca[j] = na[j]; cb[j] = nbv[j]; cz[j] = nz[j]; }
    }
}

__device__ __forceinline__ void phase_route(const Params& p, int l, unsigned char* ldsb, int bid, int nb) {
    float* lds = reinterpret_cast<float*>(ldsb);
    float* Wt = lds;
    int* hist = reinterpret_cast<int*>(lds + 36 * 1024);
    const int tid = tid_fresh(), lane = tid & 63, wave = tid >> 6;
    const int row_lo = l == 0 ? 0 : MC, rpb = l == 0 ? 68 : 64;
    const float* wrg = p.w_rg + (size_t)l * 1024 * 4; const float* wre = p.w_re + (size_t)l * 1024 * 32;
    for (int i = tid; i < 1024 * 4; i += NTHR) { const int k = i >> 2, g = i & 3; Wt[g * 1024 + k] = wrg[i]; }
    for (int i = tid; i < 1024 * 32; i += NTHR) { const int k = i >> 5, e = i & 31; Wt[(4 + e) * 1024 + k] = wre[i]; }
    const float* mod = (const float*)(p.ws + WS_MOD) + l * 5 * 6144;
    const float* XL = (const float*)(p.ws + WS_XL);
    int* EID = (int*)(p.ws + WS_EID); float* EWT = (float*)(p.ws + WS_EWT);
    for (int vb = bid; vb < 256; vb += nb) {
        if (tid < 32) hist[tid] = 0;
        __syncthreads();
        for (int rr = wave; rr < rpb; rr += 8) {
            const int row = row_lo + vb * rpb + rr;
            f32x4 v[4];
#pragma unroll
            for (int j = 0; j < 4; ++j) v[j] = *(const f32x4*)(XL + (size_t)row * 1024 + 4 * lane + 256 * j);
            const float* mr = mod + modrow(row) * 6144;
            norm_mod_row(v, p.g_ffn + l * 1024, mr + 3 * 1024, mr + 4 * 1024, lane);
            store_row_bf16((bf16_t*)(p.ws + WS_H) + (size_t)row * 1024, v, lane);
            float lg[36];
#pragma unroll
            for (int e = 0; e < 36; ++e) { float s = 0.f;
#pragma unroll
                for (int j = 0; j < 4; ++j) { const f32x4 w = *(const f32x4*)(Wt + e * 1024 + 4 * lane + 256 * j); s += (v[j][0] * w[0] + v[j][1] * w[1]) + (v[j][2] * w[2] + v[j][3] * w[3]); }
                lg[e] = wave_sum(s); }
            float gl[4]; int gi = 0; float gmax;
#pragma unroll
            for (int g = 0; g < 4; ++g) gl[g] = lg[g] + p.b_rg[l * 4 + g];
            gmax = gl[0];
#pragma unroll
            for (int g = 1; g < 4; ++g) if (gl[g] > gmax) { gmax = gl[g]; gi = g; }
            float den = 0.f;
#pragma unroll
            for (int g = 0; g < 4; ++g) den += __expf(gl[g] - gmax);
            const float pg = 1.f / den;
            float v1 = -3.0e38f, v2 = -3.0e38f; int i1 = 0, i2 = 0;
#pragma unroll
            for (int g = 0; g < 4; ++g) if (g == gi) {
#pragma unroll
                for (int j = 0; j < 8; ++j) { const float x = lg[4 + g * 8 + j] + p.b_re[l * 32 + g * 8 + j];
                    if (x > v1) { v2 = v1; i2 = i1; v1 = x; i1 = j; } else if (x > v2) { v2 = x; i2 = j; } } }
            const float e2 = __expf(v2 - v1), w1 = pg / (1.f + e2), w2 = pg * e2 / (1.f + e2);
            if (lane == 0) { EID[row * 2] = gi * 8 + i1; EID[row * 2 + 1] = gi * 8 + i2; EWT[row * 2] = w1; EWT[row * 2 + 1] = w2;
                atomicAdd(&hist[gi * 8 + i1], 1); atomicAdd(&hist[gi * 8 + i2], 1); }
        }
        __syncthreads();
        if (tid < 32) ((int*)(p.ws + WS_HIST))[vb * 32 + tid] = hist[tid];
        __syncthreads();
    }
    __syncthreads();
    float* scr = lds + wave * (64 * 65);
    for (int it = bid * 8 + wave; it < CV_EXP_ITEMS; it += nb * 8) convert_exp_item(p, l, it, scr, lane);
    if (l + 1 < 2) for (int it = bid * 8 + wave; it < CV_MIX_ITEMS; it += nb * 8) convert_mix_item(p, l + 1, it, scr, lane);
}

__device__ __forceinline__ void phase_scatter(const Params& p, int l, unsigned char* ldsb, int bid, int nb) {
    int* li = reinterpret_cast<int*>(ldsb);
    int* tot = li; int* pre = li + 32; int* pst = li + 64; int* ea = li + 128; int* pos = li + 384;
    const int tid = tid_fresh(), lane = tid & 63, wave = tid >> 6;
    const int row_lo = l == 0 ? 0 : MC, rpb = l == 0 ? 68 : 64;
    const int* HIST = (const int*)(p.ws + WS_HIST); const int* EID = (const int*)(p.ws + WS_EID);
    int* SLOT = (int*)(p.ws + WS_SLOT);
    for (int vb = bid; vb < 256; vb += nb) {
        __syncthreads();
        if (tid < 32) { int t = 0, pr = 0; for (int j = 0; j < 256; ++j) { const int hv = HIST[j * 32 + tid]; t += hv; if (j < vb) pr += hv; } tot[tid] = t; pre[tid] = pr; }
        __syncthreads();
        if (tid == 0) { int s = 0; for (int e = 0; e < 32; ++e) { pst[e] = s; s += ((tot[e] + 255) >> 8) << 8; }
            if (vb == 0) { int* BE = (int*)(p.ws + WS_BLKEXP); int nblk = 0;
                for (int e = 0; e < 32; ++e) { const int nbk = (tot[e] + 255) >> 8; for (int j = 0; j < nbk; ++j) BE[nblk++] = e; }
                BE[200] = nblk; } }
        if (tid < rpb * 2) ea[tid] = EID[(row_lo + vb * rpb) * 2 + tid];
        __syncthreads();
        if (tid < rpb * 2) { const int e = ea[tid]; int rk = 0; for (int j = 0; j < tid; ++j) rk += (ea[j] == e) ? 1 : 0;
            const int ps = pst[e] + pre[e] + rk; pos[tid] = ps; SLOT[(row_lo + vb * rpb) * 2 + tid] = ps; }
        __syncthreads();
        for (int a = wave; a < rpb * 2; a += 8) { const int row = row_lo + vb * rpb + (a >> 1);
            const u32x4* s = (const u32x4*)((const bf16_t*)(p.ws + WS_H) + (size_t)row * 1024);
            u32x4* d = (u32x4*)((bf16_t*)(p.ws + WS_XB) + (size_t)pos[a] * 1024);
            d[lane] = s[lane]; d[lane + 64] = s[lane + 64]; }
    }
    __syncthreads();
}

__device__ __forceinline__ void phase_combine(const Params& p, int l, int bid, int nb) {
    if (p.dup && l == 0) return;
    const int lane = tid_fresh() & 63, wave = tid_fresh() >> 6;
    const float* mod = (const float*)(p.ws + WS_MOD);
    const int* SLOT = (const int*)(p.ws + WS_SLOT); const float* EWT = (const float*)(p.ws + WS_EWT);
    const bf16_t* Y = (const bf16_t*)(p.ws + WS_Y);
    float* XL = (float*)(p.ws + WS_XL);
    const int row_lo = l == 0 ? 0 : MC, stride = nb * 8;
    for (int rowA = row_lo + bid * 8 + wave; rowA < MT; rowA += 2 * stride) {
        const int rowB = rowA + stride; const bool hasB = rowB < MT; const int rb = hasB ? rowB : rowA;
        const int sA0 = SLOT[rowA * 2], sA1 = SLOT[rowA * 2 + 1], sB0 = SLOT[rb * 2], sB1 = SLOT[rb * 2 + 1];
        const float wA0 = EWT[rowA * 2], wA1 = EWT[rowA * 2 + 1], wB0 = EWT[rb * 2], wB1 = EWT[rb * 2 + 1];
        u32x2 yA0[4], yA1[4], yB0[4], yB1[4]; f32x4 xA[4], xB[4];
#pragma unroll
        for (int j = 0; j < 4; ++j) { const int c = 4 * lane + 256 * j;
            yA0[j] = *(const u32x2*)(Y + (size_t)sA0 * 1024 + c); yA1[j] = *(const u32x2*)(Y + (size_t)sA1 * 1024 + c); xA[j] = *(const f32x4*)(XL + (size_t)rowA * 1024 + c);
            yB0[j] = *(const u32x2*)(Y + (size_t)sB0 * 1024 + c); yB1[j] = *(const u32x2*)(Y + (size_t)sB1 * 1024 + c); xB[j] = *(const f32x4*)(XL + (size_t)rb * 1024 + c); }
#pragma unroll
        for (int half = 0; half < 2; ++half) {
            if (half == 1 && !hasB) break;
            const int row = half ? rowB : rowA; const float w0 = half ? wB0 : wA0, w1 = half ? wB1 : wA1;
            const float* g5 = mod + (l * 5 + modrow(row)) * 6144 + 5 * 1024;
            f32x4 v[4];
#pragma unroll
            for (int j = 0; j < 4; ++j) { const int c = 4 * lane + 256 * j;
                const u32x2 a = half ? yB0[j] : yA0[j], b2 = half ? yB1[j] : yA1[j];
                f32x4 y; y[0] = w0 * lo16(a.x) + w1 * lo16(b2.x); y[1] = w0 * hi16(a.x) + w1 * hi16(b2.x); y[2] = w0 * lo16(a.y) + w1 * lo16(b2.y); y[3] = w0 * hi16(a.y) + w1 * hi16(b2.y);
                v[j] = (half ? xB[j] : xA[j]) + *(const f32x4*)(g5 + c) * y; }
            if (l == 0) {
#pragma unroll
                for (int j = 0; j < 4; ++j) *(f32x4*)(XL + (size_t)row * 1024 + 4 * lane + 256 * j) = v[j];
                const float* mr = mod + (5 + modrow(row)) * 6144;
                norm_mod_row(v, p.g_mix + 1024, mr, mr + 1024, lane);
                store_row_bf16((bf16_t*)(p.ws + WS_H) + (size_t)row * 1024, v, lane);
            } else {
                norm_mod_row(v, p.g_final, nullptr, nullptr, lane);
                float* o = p.out + (size_t)(row - MC) * 1024;
#pragma unroll
                for (int j = 0; j < 4; ++j) *(f32x4*)(o + 4 * lane + 256 * j) = v[j];
            }
        }
    }
}

constexpr int NPH_L = 14, NPHASES = 1 + 2 * NPH_L;
__device__ __forceinline__ void run_phase(const Params& p, int ph, unsigned char* lds) {
    const int bid = blockIdx.x, nb = gridDim.x;
    const int wave = tid_fresh() >> 6;
#ifndef ONLY_S
    if (ph == 0) { phase_pre(p, lds, bid, nb); return; }
#else
    if (ph == 0) { if (ONLY_S == 99) phase_pre(p, lds, bid, nb); return; }
#endif
    const int l = (ph - 1) / NPH_L, s = (ph - 1) % NPH_L;
    unsigned char* ws = p.ws;
    const int pm0 = l == 0 ? 0 : 4, nMrows = l == 0 ? 68 : 64, row_lo = l == 0 ? 0 : MC;
#ifdef ONLY_S
    if (s != ONLY_S) return;
#endif
    switch (s) {
    case 0: if (l == 0) phase_norm1(p, bid, nb); break;
    case 1: { SchedGrid S{(const bf16_t*)(ws + WS_H), (const bf16_t*)(ws + WS_WIN), 1024, 1024, 0, 68, 45, nb, bid}; EpiInproj E{ws};
              gemm_run(lds, S, E, 1024, 1024, 1024, 1); } break;
    case 2: { for (int it = bid; it < 1088; it += nb) conv_m_item(p, l, it, (LAS unsigned char*)lds);
              if (!p.dup) for (int it = bid; it < (l == 0 ? 272 : 256); it += nb) pool_window_item(p, it, (LAS unsigned char*)lds); } break;
    case 3: { for (int it = bid; it < 256; it += nb) mlstm_chunk_item(p, l, it, (LAS unsigned char*)lds);
              SchedPool S{(const bf16_t*)(ws + WS_BR), (const bf16_t*)(ws + WS_WPOOL), pm0, nMrows, nb, bid}; EpiPool E{(bf16_t*)(ws + WS_BR)};
              if (!p.dup) gemm_run(lds, S, E, 256, 3072, 256, 1); } break;
    case 4: { for (int it = bid; it < 1088; it += nb) conv_s_item(p, l, it, (LAS unsigned char*)lds);
              mlstm_finish_rows(p, l, row_lo, bid * 8 + wave, nb * 8); } break;
    case 5: for (int it = bid; it < 256; it += nb) ssd_chunk_item(p, l, it, (LAS unsigned char*)lds); break;
    case 6: ssd_finish_rows(p, l, row_lo, bid * 8 + wave, nb * 8); break;
    case 7: { SchedGrid S{(const bf16_t*)(ws + WS_BR), (const bf16_t*)(ws + WS_WBR), 3072, 3072, pm0, nMrows, 4, nb, bid}; EpiBranch E{(const bf16_t*)(ws + WS_MG), (bf16_t*)(ws + WS_MERGED)};
              gemm_run(lds, S, E, 3072, 3072, 3072, 3); } break;
    case 8: { SchedGrid S{(const bf16_t*)(ws + WS_MERGED), (const bf16_t*)(ws + WS_WOUT), 1024, 1024, pm0, nMrows, 4, nb, bid}; EpiOut E{(float*)(ws + WS_XL), (const float*)(ws + WS_MOD) + l * 5 * 6144, p.dup};
              gemm_run(lds, S, E, 1024, 1024, 1024, 1); } break;
    case 9: phase_route(p, l, lds, bid, nb); break;
    case 10: phase_scatter(p, l, lds, bid, nb); break;
    case 11: { const int* BE = (const int*)(ws + WS_BLKEXP);
              SchedMoe S{(const bf16_t*)(ws + WS_XB), (const bf16_t*)(ws + WS_EW1), BE, 1024, BE[200], nb, bid, (size_t)1048576, (size_t)1024}; EpiMoe1 E{(bf16_t*)(ws + WS_ACT)};
              gemm_run(lds, S, E, 1024, 1024, 1024, 1); } break;
    case 12: { const int* BE = (const int*)(ws + WS_BLKEXP);
              SchedMoe S{(const bf16_t*)(ws + WS_ACT), (const bf16_t*)(ws + WS_EW2), BE, 512, BE[200], nb, bid, (size_t)524288, (size_t)512}; EpiMoe2 E{(bf16_t*)(ws + WS_Y)};
              gemm_run(lds, S, E, 512, 512, 512, 1); } break;
    case 13: phase_combine(p, l, bid, nb); break;
    }
}

#define XB_TMO      128
#define XB_XCNT(j)  (256  + 64 * (j))
#define XB_XSUB(j)  (1280 + 64 * (j))
#define XB_XGEN(j)  (2304 + 64 * (j))
#define XB_TOP      3328
#define XB_TOPGEN   3392
#define XCD_BAR_WORDS 3456
#define XB_SPIN_CAP (1u << 18)
__device__ __forceinline__ unsigned xb_ld(unsigned* p)              { return __hip_atomic_load(p, __ATOMIC_RELAXED, __HIP_MEMORY_SCOPE_AGENT); }
__device__ __forceinline__ unsigned xb_add(unsigned* p, unsigned v) { return __hip_atomic_fetch_add(p, v, __ATOMIC_RELAXED, __HIP_MEMORY_SCOPE_AGENT); }
__device__ __forceinline__ unsigned xb_xcc_id() { return (unsigned)__builtin_amdgcn_s_getreg((3 << 11) | 20) & 0xFu; }
#define XB_SPIN(cond, bar) do { unsigned _sp = 0; while (cond) { __builtin_amdgcn_s_sleep(1); \
    if ((++_sp & 255u) == 0u) { if (xb_ld(&(bar)[XB_TMO])) break; if (_sp > XB_SPIN_CAP) { atomicAdd(&(bar)[XB_TMO], 1u); break; } } } } while (0)
__device__ __forceinline__ void xcd_barrier_complete(unsigned* bar, unsigned x, unsigned& nloc, unsigned& nx) {
    const unsigned G = gridDim.x * gridDim.y * gridDim.z;
    unsigned sum, cnt, mine, sp = 0u;
    for (;;) {
        sum = 0u; cnt = 0u; mine = 0u;
#pragma unroll
        for (unsigned j = 0; j < 16; ++j) { const unsigned c = xb_ld(&bar[XB_XCNT(j)]); sum += c; cnt += (c > 0u) ? 1u : 0u; mine = (j == x) ? c : mine; }
        if (sum == G) break;
        __builtin_amdgcn_s_sleep(1);
        if ((++sp & 255u) == 0u) { if (xb_ld(&bar[XB_TMO])) break; if (sp > XB_SPIN_CAP) { atomicAdd(&bar[XB_TMO], 1u); break; } }
    }
    nloc = mine > 0u ? mine : 1u; nx = cnt > 0u ? cnt : 1u;
}
__device__ __forceinline__ void xcd_barrier(unsigned* bar, volatile LAS unsigned* st) {
    asm volatile("s_waitcnt vmcnt(0)" ::: "memory");
    __syncthreads();
    if (threadIdx.x == 0) {
        __builtin_amdgcn_s_waitcnt(0);
        const unsigned x = xb_xcc_id();
        unsigned nloc = st[0], nx = st[1];
        if (nloc == 0u) { xcd_barrier_complete(bar, x, nloc, nx); st[0] = nloc; st[1] = nx; }
        const unsigned old = xb_add(&bar[XB_XSUB(x)], 1u);
        const unsigned gen = old / nloc;
        if (old + 1u == (gen + 1u) * nloc) {
            __builtin_amdgcn_fence(__ATOMIC_RELEASE, "agent");
            asm volatile("s_waitcnt vmcnt(0)" ::: "memory");
            const unsigned og = xb_add(&bar[XB_TOP], 1u);
            const unsigned tg = og / nx;
            if (og + 1u == (tg + 1u) * nx) xb_add(&bar[XB_TOPGEN], 1u);
            else XB_SPIN(xb_ld(&bar[XB_TOPGEN]) == tg, bar);
            __builtin_amdgcn_fence(__ATOMIC_ACQUIRE, "agent");
            xb_add(&bar[XB_XGEN(x)], 1u);
            asm volatile("s_waitcnt vmcnt(0)" ::: "memory");
        } else {
            XB_SPIN(xb_ld(&bar[XB_XGEN(x)]) == gen, bar);
            __builtin_amdgcn_fence(__ATOMIC_ACQUIRE, "agent");
            asm volatile("s_waitcnt vmcnt(0)" ::: "memory");
        }
    }
    __syncthreads();
}

constexpr int BAR_LDS_OFF = LDS_BYTES - 16;
__global__ void __launch_bounds__(NTHR, 2) fwd_kernel(Params pk) {
    extern __shared__ __attribute__((aligned(16))) unsigned char lds[];
    const Params& p = pk;
    const int lo = pk.ph_lo, hi = pk.ph_hi;
    unsigned* bar = (unsigned*)(pk.ws + WS_BAR);
    volatile LAS unsigned* bst = (volatile LAS unsigned*)((LAS unsigned char*)lds + BAR_LDS_OFF);
    if (hi - lo > 1) {
        if (threadIdx.x == 0) { bst[0] = 0u; bst[1] = 0u; (void)xb_add(&bar[XB_XCNT(xb_xcc_id())], 1u); }
        __syncthreads();
    }
#define STEP(k) if (lo <= (k) && (k) < hi) { run_phase(p, (k), lds); if ((k) + 1 < hi) { if ((k) == 0) cg::this_grid().sync(); else xcd_barrier(bar, bst); } }
    STEP(0) STEP(1) STEP(2) STEP(3) STEP(4) STEP(5) STEP(6) STEP(7) STEP(8) STEP(9) STEP(10) STEP(11) STEP(12) STEP(13) STEP(14)
    STEP(16) STEP(17) STEP(18) STEP(19) STEP(20) STEP(21) STEP(22) STEP(23) STEP(24) STEP(25) STEP(26) STEP(27) STEP(28)
#undef STEP
}

extern "C" void kernel_launch(void* const* d_in, const int* in_sizes, int n_in, void* d_out, int out_size, void* d_ws, size_t ws_size, hipStream_t stream) {
    static int grid_blocks = 0;
    if (!grid_blocks) {
        if (n_in != 31 || ws_size < WS_END) { fprintf(stderr, "kernel_launch: unexpected n_in %d / ws_size %zu (need %zu)\n", n_in, ws_size, (size_t)WS_END); grid_blocks = -1; return; }
        int dev = 0, cus = 0, per_cu = 0;
        hipGetDevice(&dev);
        hipDeviceGetAttribute(&cus, hipDeviceAttributeMultiprocessorCount, dev);
        if (hipFuncSetAttribute((const void*)fwd_kernel, hipFuncAttributeMaxDynamicSharedMemorySize, LDS_BYTES) != hipSuccess) fprintf(stderr, "kernel_launch: hipFuncSetAttribute failed\n");
        hipOccupancyMaxActiveBlocksPerMultiprocessor(&per_cu, (const void*)fwd_kernel, NTHR, LDS_BYTES);
        if (per_cu < 1) { fprintf(stderr, "kernel_launch: occupancy query says %d blocks per CU\n", per_cu); per_cu = 1; }
        grid_blocks = cus * per_cu;
        (void)hipGetLastError();
    }
    if (grid_blocks < 0) return;
    Params p{};
    const float** dst = (const float**)&p;
    for (int i = 0; i < 31; ++i) dst[i] = (const float*)d_in[i];
    p.out = (float*)d_out; p.ws = (unsigned char*)d_ws;
#if SINGLE_LAUNCH
    if (hipMemsetAsync((char*)d_ws + WS_BAR, 0, 16384, stream) != hipSuccess) fprintf(stderr, "kernel_launch: hipMemsetAsync failed\n");
    p.ph_lo = 0; p.ph_hi = NPHASES;
    void* args[] = {&p};
    hipError_t e = hipLaunchCooperativeKernel((const void*)fwd_kernel, dim3(grid_blocks), dim3(NTHR), args, LDS_BYTES, stream);
    if (e != hipSuccess) fprintf(stderr, "cooperative launch failed: %s (grid %d)\n", hipGetErrorString(e), grid_blocks);
#else
    for (int ph = 0; ph < NPHASES; ++ph) {
        if (ph == 1 + NPH_L) continue;
        p.ph_lo = ph; p.ph_hi = ph + 1;
        hipLaunchKernelGGL(fwd_kernel, dim3(grid_blocks), dim3(NTHR), LDS_BYTES, stream, p);
        const int sidx = ph == 0 ? 14 : (ph - 1) % NPH_L;
        if ((PROBE_DUP_MASK >> sidx) & 1) { p.dup = 1; for (int r = 0; r < PROBE_DUP_N; ++r) hipLaunchKernelGGL(fwd_kernel, dim3(grid_blocks), dim3(NTHR), LDS_BYTES, stream, p); p.dup = 0; }
    }
#endif
}
```

```cpp
#include <hip/hip_runtime.h>
#include <hip/hip_cooperative_groups.h>
#include <cstdio>
namespace cg = cooperative_groups;

#ifndef SINGLE_LAUNCH
#define SINGLE_LAUNCH 1
#endif
#ifndef PROBE_DUP_MASK
#define PROBE_DUP_MASK 0
#endif
#ifndef PROBE_DUP_N
#define PROBE_DUP_N 1
#endif
#ifndef USE_MLSTM_CHUNK
#define USE_MLSTM_CHUNK 1
#endif
#ifndef USE_SSD_CHUNK
#define USE_SSD_CHUNK 1
#endif
#ifndef USE_MFMA_GEMM
#define USE_MFMA_GEMM 1
#endif

typedef unsigned short bf16_t;
typedef float f32x4 __attribute__((ext_vector_type(4)));
typedef unsigned u32x4 __attribute__((ext_vector_type(4)));
typedef unsigned u32x2 __attribute__((ext_vector_type(2)));

constexpr int NTHR = 512;
constexpr int D = 1024, NB = 4, SEQ = 4096, CTXL = 256;
constexpr int MC = NB * CTXL;
constexpr int ML = NB * SEQ;
constexpr int MT = MC + ML;
constexpr int DIN = 11312, NPAD = 11520;
constexpr int NE = 32, DE = 512;
constexpr int CAP = 43008;
constexpr float EPS = 1e-6f;
constexpr int LDS_BYTES = 163840;

constexpr size_t MiB = 1u << 20;
constexpr size_t WS_HIST = 0;
constexpr size_t WS_BLKEXP = 64 * 1024;
constexpr size_t WS_BAR = 128 * 1024;
constexpr size_t WS_TOK = 256 * 1024;
constexpr size_t WS_MOD = 1 * MiB;
constexpr size_t WS_GA = 2 * MiB;
constexpr size_t WS_DT = 4 * MiB;
constexpr size_t WS_EID = 7 * MiB;
constexpr size_t WS_EWT = 7 * MiB + 256 * 1024;
constexpr size_t WS_SLOT = 7 * MiB + 512 * 1024;
constexpr size_t WS_WIN = 8 * MiB;
constexpr size_t WS_WPOOL = 31 * MiB;
constexpr size_t WS_WBR = 32 * MiB;
constexpr size_t WS_WOUT = 38 * MiB;
constexpr size_t WS_XL = 40 * MiB;
constexpr size_t WS_H = 108 * MiB;
constexpr size_t WS_BR = 142 * MiB;
constexpr size_t WS_Q = 244 * MiB, WS_K = 278 * MiB, WS_V = 312 * MiB;
constexpr size_t WS_SX = 346 * MiB, WS_SB = 380 * MiB, WS_SC = 397 * MiB;
constexpr size_t WS_MG = 414 * MiB;
constexpr size_t WS_HF = 516 * MiB, WS_HB = 550 * MiB;
constexpr size_t WS_VT = 584 * MiB;
constexpr size_t WS_END = 618 * MiB;
constexpr size_t WS_QC = WS_H, WS_KC = WS_HF, WS_KCT = WS_HB;
constexpr size_t WS_HF2 = WS_Q, WS_HB2 = WS_K;
constexpr size_t WS_XCT = WS_HF;
constexpr size_t WS_BC = WS_H, WS_CC = WS_H + 17 * MiB, WS_BCT = WS_HB;
constexpr size_t WS_YF = WS_SX, WS_YB = WS_SB;
constexpr size_t WS_MERGED = WS_Q;
constexpr size_t WS_EW1 = 244 * MiB;
constexpr size_t WS_EW2 = 308 * MiB;
constexpr size_t WS_XB = WS_BR;
constexpr size_t WS_ACT = WS_SX;
constexpr size_t WS_Y = WS_MG;

struct Params {
    const float *x, *c, *ctx, *c_ctx, *w_ada, *b_ada, *g_mix, *g_ffn, *w_in, *pool_w, *pool_scale,
        *mconv_w, *mconv_b, *mgate_b, *mnorm_g, *sconv_w, *sconv_b, *sdt_bias, *sa_log, *sd, *snorm_g,
        *w_branch, *w_out, *w_rg, *b_rg, *w_re, *b_re, *w_eg, *w_eu, *w_ed, *g_final;
    float* out; unsigned char* ws; int ph_lo, ph_hi, dup, pad;
};

__device__ __forceinline__ int tid_fresh() { int t = threadIdx.x; asm volatile("" : "+v"(t)); return t; }
__device__ __forceinline__ float bf2f(unsigned b) { return __uint_as_float(b << 16); }
__device__ __forceinline__ unsigned f2bf(float f) { unsigned u = __float_as_uint(f); return (u + 0x7fffu + ((u >> 16) & 1u)) >> 16; }
__device__ __forceinline__ unsigned pk2(float lo, float hi) { return f2bf(lo) | (f2bf(hi) << 16); }
__device__ __forceinline__ float lo16(unsigned w) { return __uint_as_float(w << 16); }
__device__ __forceinline__ float hi16(unsigned w) { return __uint_as_float(w & 0xffff0000u); }
__device__ __forceinline__ float wave_sum(float v) {
#pragma unroll
    for (int o = 1; o < 64; o <<= 1) v += __shfl_xor(v, o);
    return v;
}
__device__ __forceinline__ float sigmoid_f(float x) { return 1.f / (1.f + __expf(-x)); }
__device__ __forceinline__ float silu_f(float x) { return x / (1.f + __expf(-x)); }
__device__ __forceinline__ float softplus_f(float x) { return fmaxf(x, 0.f) + log1pf(__expf(-fabsf(x))); }
__device__ __forceinline__ float logsigmoid_f(float x) { return fminf(x, 0.f) - log1pf(__expf(-fabsf(x))); }
__device__ __forceinline__ void unpack8(u32x4 w, float* f) {
    f[0] = lo16(w.x); f[1] = hi16(w.x); f[2] = lo16(w.y); f[3] = hi16(w.y);
    f[4] = lo16(w.z); f[5] = hi16(w.z); f[6] = lo16(w.w); f[7] = hi16(w.w);
}
__device__ __forceinline__ u32x4 pack8(f32x4 a, f32x4 b) {
    u32x4 w; w.x = pk2(a[0], a[1]); w.y = pk2(a[2], a[3]); w.z = pk2(b[0], b[1]); w.w = pk2(b[2], b[3]); return w;
}
__device__ __forceinline__ int scanrow(int row) {
    if (row < MC) return row;
    const int r = row - MC, b = r >> 12, t = r & 4095;
    return MC + (b << 12) + ((t & 63) << 6) + (t >> 6);
}
__device__ __forceinline__ int modrow(int row) { return row < MC ? 4 : ((row - MC) >> 12); }

struct Unit { const bf16_t* A; const bf16_t* B; const int* tok; int pm, pn; };

__device__ __forceinline__ void tile_order(int L, int nM, int nN, int& pm, int& pn) {
    const int nwg = nM * nN; int wgid = L;
    { const int q = nwg / 8, r = nwg % 8, xcd = wgid % 8, off = wgid / 8; wgid = (xcd < r ? xcd * (q + 1) : r * (q + 1) + (xcd - r) * q) + off; }
    const int nig = 8 * nN, gid = wgid / nig, fm = gid * 8, gsz = (nM - fm) < 8 ? (nM - fm) : 8;
    pm = fm + ((wgid % nig) % gsz); pn = (wgid % nig) / gsz;
}
struct SchedGrid {
    const bf16_t* A; const bf16_t* B; int lda, ldb, pm0, nM, nN, G, c;
    __device__ __forceinline__ bool next(int i, Unit& u) const {
        const long L = (long)i * G + c; if (L >= (long)nM * nN) return false;
        int pm, pn; tile_order((int)L, nM, nN, pm, pn); pm += pm0;
        u.pm = pm; u.pn = pn; u.tok = nullptr; u.A = A + (size_t)pm * 256 * lda; u.B = B + (size_t)pn * 256 * ldb; return true;
    }
};
struct SchedPool {
    const bf16_t* A; const bf16_t* B; int pm0, nM, G, c;
    __device__ __forceinline__ bool next(int i, Unit& u) const {
        const long L = (long)i * G + c; if (L >= (long)nM * 4) return false;
        const int pm = pm0 + (int)(L >> 2), g = (int)(L & 3);
        u.pm = pm; u.pn = g; u.tok = nullptr; u.A = A + (size_t)pm * 256 * 3072 + g * 256; u.B = B + (size_t)g * 65536; return true;
    }
};
struct SchedMoe {
    const bf16_t* A; const bf16_t* B; const int* blkexp; const int* tok; int lda, nblk, G, c; size_t bexp_stride, ldb;
    __device__ __forceinline__ bool next(int i, Unit& u) const {
        const long L = (long)i * G + c; if (L >= (long)nblk * 4) return false;
        const int blk = (int)(L >> 2), nt = (int)(L & 3); const int e = blkexp[blk];
        u.pm = blk; u.pn = nt; u.tok = tok ? tok + blk * 256 : nullptr; u.A = tok ? A : A + (size_t)blk * 256 * lda;
        u.B = B + (size_t)e * bexp_stride + (size_t)nt * 256 * ldb; return true;
    }
};

struct EpiInproj {
    unsigned char* ws;
    __device__ __forceinline__ void seg(const Unit& u, int, int r, int c0, f32x4& lo0, f32x4& lo1, f32x4& hi0, f32x4& hi1) const {
        const int row = u.pm * 256 + r, t = u.pn;
        bf16_t* dst; size_t ld; int cb;
        if (t < 4) { dst = (bf16_t*)(ws + WS_BR) + (size_t)row * 3072; cb = t * 256; }
        else if (t < 16) { const int w = (t - 4) >> 2; dst = (bf16_t*)(ws + WS_Q + (size_t)w * 34 * MiB) + (size_t)scanrow(row) * 1024; cb = ((t - 4) & 3) * 256; }
        else if (t < 20) { dst = (bf16_t*)(ws + WS_BR) + (size_t)row * 3072 + 1024; cb = (t - 16) * 256; }
        else if (t < 24) { dst = (bf16_t*)(ws + WS_SX) + (size_t)row * 1024; cb = (t - 20) * 256; }
        else if (t < 28) { dst = (bf16_t*)(ws + WS_BR) + (size_t)row * 3072 + 2048; cb = (t - 24) * 256; }
        else if (t < 30) { dst = (bf16_t*)(ws + WS_SB) + (size_t)row * 512; cb = (t - 28) * 256; }
        else if (t < 32) { dst = (bf16_t*)(ws + WS_SC) + (size_t)row * 512; cb = (t - 30) * 256; }
        else if (t < 44) {
            dst = (bf16_t*)(ws + WS_MG) + (size_t)row * 3072; cb = (t - 32) * 256;
#pragma unroll
            for (int j = 0; j < 4; ++j) { lo0[j] = sigmoid_f(lo0[j]); lo1[j] = sigmoid_f(lo1[j]); hi0[j] = sigmoid_f(hi0[j]); hi1[j] = sigmoid_f(hi1[j]); }
        } else {
            if (c0 < 32) { float* d = (float*)(ws + WS_DT) + (size_t)row * 32 + c0; *(f32x4*)d = lo0; *(f32x4*)(d + 4) = lo1; }
            else if (c0 < 48) { float* d = (float*)(ws + WS_GA) + (size_t)scanrow(row) * 16 + (c0 - 32); *(f32x4*)d = lo0; *(f32x4*)(d + 4) = lo1; }
            return;
        }
        *(u32x4*)(dst + cb + c0) = pack8(lo0, lo1);
        *(u32x4*)(dst + cb + 128 + c0) = pack8(hi0, hi1);
    }
};
struct EpiPool {
    bf16_t* BR;
    __device__ __forceinline__ void seg(const Unit& u, int, int r, int c0, f32x4& lo0, f32x4& lo1, f32x4& hi0, f32x4& hi1) const {
        bf16_t* d = BR + (size_t)(u.pm * 256 + r) * 3072 + u.pn * 256 + c0;
        *(u32x4*)d = pack8(lo0, lo1);
        *(u32x4*)(d + 128) = pack8(hi0, hi1);
    }
};
struct EpiBranch {
    const bf16_t* MG; bf16_t* OUT;
    __device__ __forceinline__ void seg(const Unit& u, int sg, int r, int c0, f32x4& lo0, f32x4& lo1, f32x4& hi0, f32x4& hi1) const {
        const int row = u.pm * 256 + r, col = u.pn * 256 + c0;
        const bf16_t* g = MG + (size_t)row * 3072 + sg * 1024 + col;
        const int nx = sg < 2 ? 1024 : 0;
        const u32x4 ga = *(const u32x4*)g, gb = *(const u32x4*)(g + 128), gc = *(const u32x4*)(g + nx), gd = *(const u32x4*)(g + nx + 128);
        float a[8], b[8], a2[8], b2[8]; unpack8(ga, a); unpack8(gb, b); unpack8(gc, a2); unpack8(gd, b2);
        if (sg < 2) {
#pragma unroll
            for (int j = 0; j < 8; ++j) { a[j] = a[j] * __builtin_amdgcn_rcpf(a2[j]); b[j] = b[j] * __builtin_amdgcn_rcpf(b2[j]); } }
#pragma unroll
        for (int j = 0; j < 4; ++j) { lo0[j] *= a[j]; lo1[j] *= a[4 + j]; hi0[j] *= b[j]; hi1[j] *= b[4 + j]; }
        if (sg == 2) { bf16_t* d = OUT + (size_t)row * 1024 + col; *(u32x4*)d = pack8(lo0, lo1); *(u32x4*)(d + 128) = pack8(hi0, hi1); }
    }
};
struct EpiOut {
    float* XL; const float* mod; int dup;
    __device__ __forceinline__ void seg(const Unit& u, int, int r, int c0, f32x4& lo0, f32x4& lo1, f32x4& hi0, f32x4& hi1) const {
        const int row = u.pm * 256 + r, col = u.pn * 256 + c0;
        const float* g = mod + modrow(row) * 6144 + 2 * 1024 + col;
        float* x = XL + (size_t)row * 1024 + col;
        const f32x4 x0 = *(const f32x4*)x, x1 = *(const f32x4*)(x + 4), x2 = *(const f32x4*)(x + 128), x3 = *(const f32x4*)(x + 132);
        const f32x4 g0 = *(const f32x4*)g, g1 = *(const f32x4*)(g + 4), g2 = *(const f32x4*)(g + 128), g3 = *(const f32x4*)(g + 132);
        if (dup) return;
        *(f32x4*)x = x0 + g0 * lo0; *(f32x4*)(x + 4) = x1 + g1 * lo1; *(f32x4*)(x + 128) = x2 + g2 * hi0; *(f32x4*)(x + 132) = x3 + g3 * hi1;
    }
};
struct EpiMoe1 {
    bf16_t* ACT;
    __device__ __forceinline__ void seg(const Unit& u, int, int r, int c0, f32x4& lo0, f32x4& lo1, f32x4& hi0, f32x4& hi1) const {
        const int row = u.pm * 256 + r;
        f32x4 a, b;
#pragma unroll
        for (int j = 0; j < 4; ++j) { a[j] = silu_f(lo0[j]) * hi0[j]; b[j] = silu_f(lo1[j]) * hi1[j]; }
        *(u32x4*)(ACT + (size_t)row * 512 + u.pn * 128 + c0) = pack8(a, b);
    }
};
struct EpiMoe2 {
    bf16_t* Y;
    __device__ __forceinline__ void seg(const Unit& u, int, int r, int c0, f32x4& lo0, f32x4& lo1, f32x4& hi0, f32x4& hi1) const {
        bf16_t* d = Y + (size_t)(u.pm * 256 + r) * 1024 + u.pn * 256 + c0;
        *(u32x4*)d = pack8(lo0, lo1); *(u32x4*)(d + 128) = pack8(hi0, hi1);
    }
};

#define LAS __attribute__((address_space(3)))
typedef short bf16x8 __attribute__((ext_vector_type(8)));
constexpr int HTB = 128 * 64 * 2;
__device__ __forceinline__ int lds_byte(int r, int c) { const int st = (r >> 4) * 2 + (c >> 5), rr = r & 15, cc = c & 31, ob = rr * 64 + cc * 2; return st * 1024 + (ob ^ (((ob >> 9) & 1) << 5)); }
__device__ __forceinline__ void stage_rc(int b, int& R, int& C) { const int st = b / 1024, sb = b % 1024, swz = sb ^ (((sb >> 9) & 1) << 5); R = (st >> 1) * 16 + swz / 64; C = (st & 1) * 32 + (swz % 64) / 2; }
__device__ __forceinline__ int perm32(int rho) { const int n = rho >> 4, i = rho & 15; return 8 * (i >> 2) + 4 * n + (i & 3); }

template <bool GATHER, class Sched, class Epi>
__device__ __forceinline__ void gemm_mfma(LAS unsigned char* lds, const Sched& S, const Epi& E, const int K, const int lda, const int ldb, const int nseg) {
    const int tid = tid_fresh(), wid = __builtin_amdgcn_readfirstlane(tid >> 6), lane = tid & 63, wr = wid >> 2, wc = wid & 3, fr = lane & 15, fq = lane >> 4;
    const int nt = K / 64, tseg = nt / nseg;
    unsigned vA0[2], vA1[2], nA0[2], nA1[2], voffB[2]; int rowA[2], colA[2];
#pragma unroll
    for (int i = 0; i < 2; ++i) { int R, C; stage_rc(tid * 16 + i * 8192, R, C); const int Rb = (R & ~31) + perm32(R & 31);
        rowA[i] = R; colA[i] = C;
        vA0[i] = (unsigned)(R * lda + C) * 2u; vA1[i] = vA0[i] + (unsigned)(128 * lda * 2); nA0[i] = vA0[i]; nA1[i] = vA1[i];
        voffB[i] = (unsigned)(Rb * ldb + C) * 2u; }
    const size_t kstep = 128;
    const size_t hstepB = (size_t)128 * ldb * 2;
    const unsigned ldsw = (unsigned)wid * 1024u;
    const int aoff = lds_byte(wr * 64 + fr, fq * 8), boff = lds_byte(wc * 32 + fr, fq * 8);
#define PG8_SA(b, h) (((b) * 2 + (h)) * HTB)
#define PG8_SB(b, h) ((4 + (b) * 2 + (h)) * HTB)
#define PG8_STAGE(bufoff, gbase, voff) do { _Pragma("unroll") for (int _i = 0; _i < 2; ++_i) \
        __builtin_amdgcn_global_load_lds((const unsigned*)((const char*)(gbase) + (voff)[_i]), (LAS unsigned*)(lds + (bufoff) + ldsw + _i * 8192), 16, 0, 0); } while (0)
#define PG8_LDA(dst, b, h) do { _Pragma("unroll") for (int m = 0; m < 4; ++m) _Pragma("unroll") for (int k = 0; k < 2; ++k) dst[m][k] = *(const LAS bf16x8*)(lds + PG8_SA(b, h) + aoff + m * 2048 + k * 1024); } while (0)
#define PG8_LDB(dst, b, h) do { _Pragma("unroll") for (int n = 0; n < 2; ++n) _Pragma("unroll") for (int k = 0; k < 2; ++k) dst[n][k] = *(const LAS bf16x8*)(lds + PG8_SB(b, h) + boff + n * 2048 + k * 1024); } while (0)
#define PG8_MMA(ai, bj, At, Bt) do { __builtin_amdgcn_s_setprio(1); _Pragma("unroll") for (int m = 0; m < 4; ++m) _Pragma("unroll") for (int n = 0; n < 2; ++n) _Pragma("unroll") for (int k = 0; k < 2; ++k) \
        acc[ai][bj][m][n] = __builtin_amdgcn_mfma_f32_16x16x32_bf16(Bt[n][k], At[m][k], acc[ai][bj][m][n], 0, 0, 0); __builtin_amdgcn_s_setprio(0); } while (0)
#define PG8_WAIT_V(n) asm volatile("s_waitcnt vmcnt(" #n ")" ::: "memory")
#define PG8_WAIT_L(n) asm volatile("s_waitcnt lgkmcnt(" #n ")" ::: "memory")
#define PG8_BAR __builtin_amdgcn_s_barrier()
#define PG8_SCHED __builtin_amdgcn_sched_barrier(0)
#define PG8_EPI(sg) do { _Pragma("unroll") for (int ai = 0; ai < 2; ++ai) _Pragma("unroll") for (int m = 0; m < 4; ++m) { \
        int r_ = ai * 128 + wr * 64 + m * 16 + fr; asm volatile("" : "+v"(r_));     \
        E.seg(cur, (sg), r_, wc * 32 + fq * 8, acc[ai][0][m][0], acc[ai][0][m][1], acc[ai][1][m][0], acc[ai][1][m][1]); } } while (0)
    Unit cur, nxt; int ui = 0;
    if (!S.next(0, cur)) return;
    f32x4 acc[2][2][4][2];
#pragma unroll
    for (int a = 0; a < 2; ++a)
#pragma unroll
        for (int b = 0; b < 2; ++b)
#pragma unroll
            for (int m = 0; m < 4; ++m)
#pragma unroll
                for (int n = 0; n < 2; ++n) acc[a][b][m][n] = (f32x4){0.f, 0.f, 0.f, 0.f};
    bf16x8 At[4][2], B0[2][2], B1[2][2];
    const char* cA = (const char*)cur.A; const char* cB = (const char*)cur.B;
    if (GATHER) {
#pragma unroll
        for (int i = 0; i < 2; ++i) { vA0[i] = (unsigned)(cur.tok[rowA[i]] * lda + colA[i]) * 2u; vA1[i] = (unsigned)(cur.tok[128 + rowA[i]] * lda + colA[i]) * 2u; nA0[i] = vA0[i]; nA1[i] = vA1[i]; }
    }
    PG8_STAGE(PG8_SB(0, 0), cB, voffB); PG8_STAGE(PG8_SA(0, 0), cA, vA0); PG8_STAGE(PG8_SB(0, 1), cB + hstepB, voffB); PG8_STAGE(PG8_SA(0, 1), cA, vA1);
    if (wr == 1) PG8_BAR;
    PG8_WAIT_V(4); PG8_BAR;
    PG8_STAGE(PG8_SB(1, 0), cB + kstep, voffB); PG8_STAGE(PG8_SA(1, 0), cA + kstep, vA0); PG8_STAGE(PG8_SB(1, 1), cB + hstepB + kstep, voffB);
    PG8_WAIT_V(6); PG8_BAR;
    for (;;) {
        const bool has_next = S.next(ui + 1, nxt);
        const char* nA = has_next ? (const char*)nxt.A : cA; const char* nB = has_next ? (const char*)nxt.B : cB;
        if (GATHER) {
            const int* tk = has_next ? nxt.tok : cur.tok;
#pragma unroll
            for (int i = 0; i < 2; ++i) { nA0[i] = (unsigned)(tk[rowA[i]] * lda + colA[i]) * 2u; nA1[i] = (unsigned)(tk[128 + rowA[i]] * lda + colA[i]) * 2u; }
        }
#pragma nounroll
        for (int sg = 0; sg < nseg; ++sg) {
#pragma nounroll
        for (int tt = 0; tt < tseg; tt += 2) {
            const int t = sg * tseg + tt;
            const bool last = (t == nt - 2);
            const char* a1 = cA + (size_t)(t + 1) * kstep;
            const char* a2 = last ? nA : cA + (size_t)(t + 2) * kstep; const char* b2 = last ? nB : cB + (size_t)(t + 2) * kstep;
            const char* a3 = a2 + kstep; const char* b3 = b2 + kstep;
            unsigned w0[2], w1[2];
#pragma unroll
            for (int i = 0; i < 2; ++i) { w0[i] = last ? nA0[i] : vA0[i]; w1[i] = last ? nA1[i] : vA1[i]; }
            PG8_LDB(B0, 0, 0); PG8_SCHED; PG8_LDA(At, 0, 0); PG8_STAGE(PG8_SA(1, 1), a1, vA1);
            PG8_WAIT_L(8); PG8_BAR; PG8_WAIT_L(0); PG8_MMA(0, 0, At, B0); PG8_BAR; PG8_SCHED;
            PG8_LDB(B1, 0, 1); PG8_STAGE(PG8_SB(0, 0), b2, voffB);
            PG8_BAR; PG8_WAIT_L(0); PG8_MMA(0, 1, At, B1); PG8_BAR;
            PG8_LDA(At, 0, 1); PG8_STAGE(PG8_SA(0, 0), a2, w0);
            PG8_BAR; PG8_WAIT_L(0); PG8_MMA(1, 0, At, B0); PG8_BAR; PG8_SCHED;
            PG8_STAGE(PG8_SB(0, 1), b2 + hstepB, voffB);
            PG8_WAIT_V(6); PG8_BAR; PG8_MMA(1, 1, At, B1); PG8_BAR;
            PG8_LDB(B0, 1, 0); PG8_SCHED; PG8_LDA(At, 1, 0); PG8_STAGE(PG8_SA(0, 1), a2, w1);
            PG8_WAIT_L(8); PG8_BAR; PG8_WAIT_L(0); PG8_MMA(0, 0, At, B0); PG8_BAR; PG8_SCHED;
            PG8_LDB(B1, 1, 1); PG8_STAGE(PG8_SB(1, 0), b3, voffB);
            PG8_BAR; PG8_WAIT_L(0); PG8_MMA(0, 1, At, B1); PG8_BAR;
            PG8_LDA(At, 1, 1); PG8_STAGE(PG8_SA(1, 0), a3, w0);
            PG8_BAR; PG8_WAIT_L(0); PG8_MMA(1, 0, At, B0); PG8_BAR; PG8_SCHED;
            PG8_STAGE(PG8_SB(1, 1), b3 + hstepB, voffB);
            PG8_WAIT_V(6); PG8_BAR; PG8_MMA(1, 1, At, B1); PG8_BAR;
        }
        PG8_EPI(sg);
        }
        if (!has_next) break;
#pragma unroll
        for (int a = 0; a < 2; ++a)
#pragma unroll
            for (int b = 0; b < 2; ++b)
#pragma unroll
                for (int m = 0; m < 4; ++m)
#pragma unroll
                    for (int n = 0; n < 2; ++n) acc[a][b][m][n] = (f32x4){0.f, 0.f, 0.f, 0.f};
        cur = nxt; cA = nA; cB = nB; ++ui;
#pragma unroll
        for (int i = 0; i < 2; ++i) { vA0[i] = nA0[i]; vA1[i] = nA1[i]; }
    }
    PG8_WAIT_V(0);
    if (wr == 0) PG8_BAR;
    PG8_BAR;
#undef PG8_SA
#undef PG8_SB
#undef PG8_STAGE
#undef PG8_LDA
#undef PG8_LDB
#undef PG8_MMA
#undef PG8_WAIT_V
#undef PG8_WAIT_L
#undef PG8_BAR
#undef PG8_SCHED
#undef PG8_EPI
}

template <bool GATHER = false, class Sched, class Epi>
__device__ __forceinline__ void gemm_run(unsigned char* lds, const Sched& S, const Epi& E, int K, int lda, int ldb, int nseg) {
    __syncthreads();
    gemm_mfma<GATHER>((LAS unsigned char*)lds, S, E, K, lda, ldb, nseg);
    __syncthreads();
}

struct TrDesc { const float* src; const float* cscale; bf16_t* dst; int ld_src, ld_dst, valid; };
__device__ __forceinline__ void tr_load(const TrDesc& d, f32x4 (&v)[16]) {
    if (d.src) {
#pragma unroll
        for (int i = 0; i < 16; ++i) v[i] = *(const f32x4*)(d.src + (size_t)(4 * i) * d.ld_src);
    } else {
#pragma unroll
        for (int i = 0; i < 16; ++i) v[i] = (f32x4){0.f, 0.f, 0.f, 0.f};
    }
}
__device__ __forceinline__ void tr_store(const TrDesc& d, f32x4 (&v)[16], float* scr, int lane) {
    const int c4 = (lane & 15) * 4, kr = lane >> 4;
    if (d.cscale) { const f32x4 s = *(const f32x4*)d.cscale;
#pragma unroll
        for (int i = 0; i < 16; ++i) v[i] = v[i] * s; }
#pragma unroll
    for (int i = 0; i < 16; ++i) { float* q = scr + (kr + 4 * i) * 65 + c4; q[0] = v[i][0]; q[1] = v[i][1]; q[2] = v[i][2]; q[3] = v[i][3]; }
    asm volatile("s_waitcnt lgkmcnt(0)" ::: "memory");
    const int c = lane & 7;
#pragma unroll
    for (int j = 0; j < 8; ++j) { const int n = (lane >> 3) + 8 * j; const float* s = scr + (8 * c) * 65 + n;
        u32x4 o; o.x = pk2(s[0 * 65], s[1 * 65]); o.y = pk2(s[2 * 65], s[3 * 65]); o.z = pk2(s[4 * 65], s[5 * 65]); o.w = pk2(s[6 * 65], s[7 * 65]);
        *(u32x4*)(d.dst + (size_t)n * d.ld_dst + 8 * c) = o; }
    asm volatile("s_waitcnt lgkmcnt(0)" ::: "memory");
}
__device__ __forceinline__ TrDesc tr_desc(const float* W, int ld_src, int srcq, bf16_t* WT, int ld_dst, int n_dst, int kdst0, int k0, int lane, const float* cscale = nullptr) {
    TrDesc d; d.ld_src = ld_src; d.ld_dst = ld_dst; d.valid = 1;
    d.src = srcq >= 0 ? W + (size_t)(k0 + (lane >> 4)) * ld_src + srcq : nullptr;
    d.cscale = (cscale && srcq >= 0) ? cscale + srcq : nullptr;
    d.dst = WT + (size_t)n_dst * ld_dst + kdst0 + k0; return d;
}
constexpr int CV_MIX_ITEMS = 2880 + 64 + 768 + 256;
constexpr int CV_EXP_ITEMS = 32 * 384;
__device__ __forceinline__ TrDesc convert_desc(const Params& p, int le, int lm, int it, int lane) {
    unsigned char* ws = p.ws;
    const int c4 = (lane & 15) * 4;
    if (le >= 0) {
        if (it < CV_EXP_ITEMS) {
            const int e = it / 384, r = it % 384;
            if (r < 256) { const int up = r >> 7, q = r & 127, kb = q >> 3, nb = q & 7; const int c = nb * 64;
                const float* src = (up ? p.w_eu : p.w_eg) + (size_t)(le * 32 + e) * 1024 * 512;
                return tr_desc(src, 512, c + c4, (bf16_t*)(ws + WS_EW1) + (size_t)e * 1048576, 1024, (c >> 7) * 256 + up * 128 + (c & 127), 0, kb * 64, lane); }
            const int q = r - 256, kb = q >> 4, nb = q & 15;
            return tr_desc(p.w_ed + (size_t)(le * 32 + e) * 512 * 1024, 1024, nb * 64 + c4, (bf16_t*)(ws + WS_EW2) + (size_t)e * 524288, 512, nb * 64, 0, kb * 64, lane);
        }
        it -= CV_EXP_ITEMS;
    }
    const int l = lm;
    if (it < 2880) { const int R = it >> 4, kb = it & 15, dstn = R * 64; int srcq;
        if (R < 80) srcq = dstn + c4; else if (R < 128) srcq = dstn + 16 + c4; else if (R < 176) srcq = dstn + 48 + c4;
        else if (R == 176) srcq = c4 < 32 ? 8208 + c4 : (c4 < 48 ? 5120 + (c4 - 32) : -1); else srcq = -1;
        return tr_desc(p.w_in + (size_t)l * 1024 * DIN, DIN, srcq, (bf16_t*)(ws + WS_WIN), 1024, dstn, 0, kb * 64, lane); }
    it -= 2880;
    if (it < 64) { const int g = it >> 4, r = it & 15, kb = r >> 2, nb = r & 3;
        return tr_desc(p.pool_w + (size_t)(l * 4 + g) * 65536, 256, nb * 64 + c4, (bf16_t*)(ws + WS_WPOOL) + (size_t)g * 65536, 256, nb * 64, 0, kb * 64, lane, p.pool_scale + l * 1024 + g * 256); }
    it -= 64;
    if (it < 768) { const int br = it >> 8, r = it & 255, kb = r >> 4, nb = r & 15;
        return tr_desc(p.w_branch + (size_t)(l * 3 + br) * 1048576, 1024, nb * 64 + c4, (bf16_t*)(ws + WS_WBR), 3072, nb * 64, br * 1024, kb * 64, lane); }
    it -= 768;
    { const int kb = it >> 4, nb = it & 15;
      return tr_desc(p.w_out + (size_t)l * 1048576, 1024, nb * 64 + c4, (bf16_t*)(ws + WS_WOUT), 1024, nb * 64, 0, kb * 64, lane); }
}
__device__ __forceinline__ void convert_run(const Params& p, int le, int lm, int first, int step, float* scr, int lane) {
    const int nitems = (le >= 0 ? CV_EXP_ITEMS : 0) + (lm >= 0 ? CV_MIX_ITEMS : 0);
    if (first >= nitems) return;
    f32x4 va[16], vb[16];
    TrDesc da = convert_desc(p, le, lm, first, lane), db;
    tr_load(da, va);
    for (int it = first; it < nitems; it += 2 * step) {
        const int i1 = it + step, i2 = it + 2 * step;
        if (i1 < nitems) { db = convert_desc(p, le, lm, i1, lane); tr_load(db, vb); }
        tr_store(da, va, scr, lane);
        if (i1 >= nitems) break;
        if (i2 < nitems) { da = convert_desc(p, le, lm, i2, lane); tr_load(da, va); }
        tr_store(db, vb, scr, lane);
    }
}

__device__ __forceinline__ void phase_pre(const Params& p, unsigned char* ldsb, int bid, int nb) {
    float* lds = reinterpret_cast<float*>(ldsb);
    const int tid = tid_fresh(), lane = tid & 63, wave = tid >> 6;
    for (int i = tid; i < 5 * 1024; i += NTHR) { const float v = i < 4096 ? p.c[i] : p.c_ctx[i - 4096]; lds[i] = silu_f(v); }
    __syncthreads();
    float* red = lds + 5120;
    for (int it = bid; it < 2 * 96; it += nb) {
        const int l = it / 96, j = (it % 96) * 64 + lane;
        const float* w = p.w_ada + (size_t)l * 1024 * 6144 + j;
        float a0 = 0, a1 = 0, a2 = 0, a3 = 0, a4 = 0;
        for (int k = wave * 128; k < wave * 128 + 128; ++k) { const float wv = w[(size_t)k * 6144];
            a0 += lds[k] * wv; a1 += lds[1024 + k] * wv; a2 += lds[2048 + k] * wv; a3 += lds[3072 + k] * wv; a4 += lds[4096 + k] * wv; }
        red[(wave * 5 + 0) * 64 + lane] = a0; red[(wave * 5 + 1) * 64 + lane] = a1; red[(wave * 5 + 2) * 64 + lane] = a2;
        red[(wave * 5 + 3) * 64 + lane] = a3; red[(wave * 5 + 4) * 64 + lane] = a4;
        __syncthreads();
        if (tid < 320) { const int r = tid >> 6, jj = tid & 63; float s = 0;
            for (int w8 = 0; w8 < 8; ++w8) s += red[(w8 * 5 + r) * 64 + jj];
            const int col = (it % 96) * 64 + jj;
            ((float*)(p.ws + WS_MOD))[(size_t)(l * 5 + r) * 6144 + col] = s + p.b_ada[l * 6144 + col]; }
        __syncthreads();
    }
    __syncthreads();
    float* scr = lds + wave * (64 * 65);
    convert_run(p, -1, 0, bid * 8 + wave, nb * 8, scr, lane);
}

__device__ __forceinline__ void norm_mod_row(f32x4 (&v)[4], const float* g, const float* shift, const float* scale, int lane) {
    float s = 0.f;
#pragma unroll
    for (int j = 0; j < 4; ++j) s += (v[j][0] * v[j][0] + v[j][1] * v[j][1]) + (v[j][2] * v[j][2] + v[j][3] * v[j][3]);
    const float rs = 1.0f / sqrtf(wave_sum(s) * (1.f / 1024.f) + EPS);
#pragma unroll
    for (int j = 0; j < 4; ++j) { const int c = 4 * lane + 256 * j; const f32x4 gg = *(const f32x4*)(g + c);
        f32x4 y = v[j] * rs * gg;
        if (shift) { const f32x4 sh = *(const f32x4*)(shift + c), sc = *(const f32x4*)(scale + c); y = y * (1.f + sc) + sh; }
        v[j] = y; }
}
__device__ __forceinline__ void store_row_bf16(bf16_t* dst, const f32x4 (&v)[4], int lane) {
#pragma unroll
    for (int j = 0; j < 4; ++j) { u32x2 w; w.x = pk2(v[j][0], v[j][1]); w.y = pk2(v[j][2], v[j][3]); *(u32x2*)(dst + 4 * lane + 256 * j) = w; }
}

__device__ __forceinline__ void phase_norm1(const Params& p, int bid, int nb) {
    const int lane = tid_fresh() & 63, wave = tid_fresh() >> 6;
    const float* mod = (const float*)(p.ws + WS_MOD);
    const int stride = nb * 8;
    int m = bid * 8 + wave;
    f32x4 v[4], w[4];
    if (m < MT) { const float* src = m < MC ? p.ctx + (size_t)m * 1024 : p.x + (size_t)(m - MC) * 1024;
#pragma unroll
        for (int j = 0; j < 4; ++j) v[j] = *(const f32x4*)(src + 4 * lane + 256 * j); }
    for (; m < MT; m += stride) {
        const int mn = m + stride;
        if (mn < MT) { const float* src = mn < MC ? p.ctx + (size_t)mn * 1024 : p.x + (size_t)(mn - MC) * 1024;
#pragma unroll
            for (int j = 0; j < 4; ++j) w[j] = *(const f32x4*)(src + 4 * lane + 256 * j); }
        float* xl = (float*)(p.ws + WS_XL) + (size_t)m * 1024;
#pragma unroll
        for (int j = 0; j < 4; ++j) *(f32x4*)(xl + 4 * lane + 256 * j) = v[j];
        const float* mr = mod + modrow(m) * 6144;
        norm_mod_row(v, p.g_mix, mr, mr + 1024, lane);
        store_row_bf16((bf16_t*)(p.ws + WS_H) + (size_t)m * 1024, v, lane);
#pragma unroll
        for (int j = 0; j < 4; ++j) v[j] = w[j];
    }
}

__device__ __forceinline__ float wave_incl_sum(float v, int lane) {
#pragma unroll
    for (int o = 1; o < 64; o <<= 1) { const float u = __shfl_up(v, o); if (lane >= o) v += u; }
    return v;
}
__device__ __forceinline__ float wave_incl_max(float v, int lane) {
#pragma unroll
    for (int o = 1; o < 64; o <<= 1) { const float u = __shfl_up(v, o); if (lane >= o) v = fmaxf(v, u); }
    return v;
}
__device__ __forceinline__ u32x2 pack4(f32x4 a) { u32x2 w; w.x = pk2(a[0], a[1]); w.y = pk2(a[2], a[3]); return w; }

__device__ __forceinline__ void chunk_geom(int gc, int& rbase, int& n0, int& len) {
    const int b = gc / 68, cin = gc % 68;
    if (cin < 4) { rbase = b * 256; n0 = cin * 64; len = 256; } else { rbase = MC + b * 4096; n0 = (cin - 4) * 64; len = 4096; }
}
__device__ __forceinline__ void conv8x4(const u32x4 (&raw)[7], const float* cw, const float* cb, int ch0, float scale, u32x4 (&out)[4]) {
    float w[4][8], bs[8];
#pragma unroll
    for (int j = 0; j < 4; ++j) { const f32x4 a = *(const f32x4*)(cw + j * 2048 + ch0), b2 = *(const f32x4*)(cw + j * 2048 + ch0 + 4);
#pragma unroll
        for (int i = 0; i < 4; ++i) { w[j][i] = a[i]; w[j][4 + i] = b2[i]; } }
    { const f32x4 a = *(const f32x4*)(cb + ch0), b2 = *(const f32x4*)(cb + ch0 + 4);
#pragma unroll
      for (int i = 0; i < 4; ++i) { bs[i] = a[i]; bs[4 + i] = b2[i]; } }
    float f[7][8];
#pragma unroll
    for (int k = 0; k < 7; ++k) unpack8(raw[k], f[k]);
#pragma unroll
    for (int pp = 0; pp < 4; ++pp) { f32x4 o0, o1;
#pragma unroll
        for (int i = 0; i < 8; ++i) { float a = bs[i];
#pragma unroll
            for (int j = 0; j < 4; ++j) a += w[j][i] * f[pp + j][i];
            a = silu_f(a) * scale; if (i < 4) o0[i] = a; else o1[i - 4] = a; }
        out[pp] = pack8(o0, o1); }
}
__device__ __forceinline__ void load_raw7(const bf16_t* src, size_t ld, int rbase, int tbase, int len, u32x4 (&raw)[7]) {
#pragma unroll
    for (int k = 0; k < 7; ++k) { const int t = tbase + k; const bool ok = (t >= 0) && (t < len); const int tc = t < 0 ? 0 : (t >= len ? len - 1 : t);
        u32x4 a = *(const u32x4*)(src + (size_t)(rbase + tc) * ld);
        if (!ok) a = (u32x4){0u, 0u, 0u, 0u};
        raw[k] = a; }
}
template <class F>
__device__ __forceinline__ void tile_transpose_out(const LAS bf16_t* tile, int ldsw, int ncol, int tid, F rowptr) {
    for (int q = tid; q < ncol * 8; q += NTHR) { const int c = q % ncol, sc = q / ncol;
        unsigned v[8];
#pragma unroll
        for (int i = 0; i < 8; ++i) v[i] = tile[(sc * 8 + i) * ldsw + c];
        u32x4 w; w.x = v[0] | (v[1] << 16); w.y = v[2] | (v[3] << 16); w.z = v[4] | (v[5] << 16); w.w = v[6] | (v[7] << 16);
        *(u32x4*)(rowptr(c) + sc * 8) = w; }
}

__device__ __forceinline__ void conv_m_item(const Params& p, int l, int item, LAS unsigned char* lds) {
    const int tid = tid_fresh(), gc = item >> 2, hd = item & 3;
    int rbase, n0, len; chunk_geom(gc, rbase, n0, len);
    const int cs = tid & 31, tg = tid >> 5, d0 = cs * 8, i0 = tg * 4;
    const float* cw = p.mconv_w + (size_t)l * 4 * 2048; const float* cb = p.mconv_b + (size_t)l * 2048;
    LAS bf16_t* Kl = (LAS bf16_t*)lds; LAS bf16_t* Vl = (LAS bf16_t*)(lds + 64 * 528);
    __syncthreads();
    { u32x4 raw[7], o[4];
      load_raw7((const bf16_t*)(p.ws + WS_Q) + hd * 256 + d0, 1024, rbase, n0 + i0 - 2, len, raw);
      conv8x4(raw, cw, cb, hd * 256 + d0, 1.0f, o);
#pragma unroll
      for (int pp = 0; pp < 4; ++pp) *(u32x4*)((bf16_t*)(p.ws + WS_QC) + (size_t)(rbase + n0 + i0 + pp) * 1024 + hd * 256 + d0) = o[pp];
      load_raw7((const bf16_t*)(p.ws + WS_K) + hd * 256 + d0, 1024, rbase, n0 + i0 - 2, len, raw);
      conv8x4(raw, cw, cb, 1024 + hd * 256 + d0, 0.0625f, o);
#pragma unroll
      for (int pp = 0; pp < 4; ++pp) { *(u32x4*)((bf16_t*)(p.ws + WS_KC) + (size_t)(rbase + n0 + i0 + pp) * 1024 + hd * 256 + d0) = o[pp];
          *(LAS u32x4*)((LAS unsigned char*)Kl + (i0 + pp) * 528 + d0 * 2) = o[pp]; } }
#pragma unroll
    for (int j = 0; j < 4; ++j) { const int q = tid + NTHR * j, row = q >> 5, ch = q & 31;
        *(LAS u32x4*)((LAS unsigned char*)Vl + row * 528 + ch * 16) = *(const u32x4*)((const bf16_t*)(p.ws + WS_V) + (size_t)(rbase + n0 + row) * 1024 + hd * 256 + ch * 8); }
    __syncthreads();
    bf16_t* kct = (bf16_t*)(p.ws + WS_KCT) + (size_t)(gc * 4 + hd) * 16384; bf16_t* vt = (bf16_t*)(p.ws + WS_VT) + (size_t)(gc * 4 + hd) * 16384;
    tile_transpose_out(Kl, 264, 256, tid, [&](int c) { return kct + c * 64; });
    tile_transpose_out(Vl, 264, 256, tid, [&](int c) { return vt + c * 64; });
}

__device__ __forceinline__ void conv_s_item(const Params& p, int l, int item, LAS unsigned char* lds) {
    const int tid = tid_fresh(), gc = item >> 2, grp = item & 3;
    int rbase, n0, len; chunk_geom(gc, rbase, n0, len);
    const int cs = tid & 31, tg = tid >> 5, i0 = tg * 4;
    const float* cw = p.sconv_w + (size_t)l * 4 * 2048; const float* cb = p.sconv_b + (size_t)l * 2048;
    LAS bf16_t* Bl = (LAS bf16_t*)lds; LAS bf16_t* Xl = (LAS bf16_t*)(lds + 64 * 272);
    __syncthreads();
    { u32x4 raw[7], o[4];
      const int isC = cs >> 4, nn = (cs & 15) * 8;
      load_raw7((const bf16_t*)(p.ws + (isC ? WS_SC : WS_SB)) + grp * 128 + nn, 512, rbase, n0 + i0 - 2, len, raw);
      conv8x4(raw, cw, cb, 1024 + isC * 512 + grp * 128 + nn, 1.0f, o);
      bf16_t* dst = (bf16_t*)(p.ws + (isC ? WS_CC : WS_BC)) + grp * 128 + nn;
#pragma unroll
      for (int pp = 0; pp < 4; ++pp) { *(u32x4*)(dst + (size_t)(rbase + n0 + i0 + pp) * 512) = o[pp];
          if (!isC) *(LAS u32x4*)((LAS unsigned char*)Bl + (i0 + pp) * 272 + nn * 2) = o[pp]; }
      load_raw7((const bf16_t*)(p.ws + WS_SX) + grp * 256 + cs * 8, 1024, rbase, n0 + i0 - 2, len, raw);
      conv8x4(raw, cw, cb, grp * 256 + cs * 8, 1.0f, o);
#pragma unroll
      for (int pp = 0; pp < 4; ++pp) *(LAS u32x4*)((LAS unsigned char*)Xl + (i0 + pp) * 528 + cs * 16) = o[pp]; }
    __syncthreads();
    bf16_t* bct = (bf16_t*)(p.ws + WS_BCT) + (size_t)(gc * 4 + grp) * 8192; bf16_t* xct = (bf16_t*)(p.ws + WS_XCT) + (size_t)(gc * 16 + grp * 4) * 4096;
    tile_transpose_out(Bl, 136, 128, tid, [&](int c) { return bct + c * 64; });
    tile_transpose_out(Xl, 264, 256, tid, [&](int c) { return xct + c * 64; });
}

__device__ __forceinline__ void pool_window_item(const Params& p, int it, LAS unsigned char* lds) {
    const int tid = tid_fresh();
    bf16_t* BR = (bf16_t*)(p.ws + WS_BR);
    __syncthreads();
    if (it < 256) {
        const int row0 = MC + it * 64;
        for (int q = tid; q < 64 * 128; q += NTHR) { const int r = q >> 7, ch = q & 127;
            *(LAS u32x4*)(lds + q * 16) = *(const u32x4*)(BR + (size_t)(row0 + r) * 3072 + ch * 8); }
        __syncthreads();
        for (int q = tid; q < 64 * 128; q += NTHR) { const int r = q >> 7, ch = q & 127, w = 2 << (ch >> 5);
            int lo = r - (w >> 1), hi = lo + w - 1; lo = lo < 0 ? 0 : lo; hi = hi > 63 ? 63 : hi;
            float s[8] = {0, 0, 0, 0, 0, 0, 0, 0}, self[8];
            for (int rr = lo; rr <= hi; ++rr) { float f[8]; unpack8(*(const LAS u32x4*)(lds + (rr * 128 + ch) * 16), f);
#pragma unroll
                for (int j = 0; j < 8; ++j) s[j] += f[j]; }
            unpack8(*(const LAS u32x4*)(lds + q * 16), self);
            const float inv = 1.f / (float)(hi - lo + 1); f32x4 a, b;
#pragma unroll
            for (int j = 0; j < 4; ++j) { a[j] = s[j] * inv - self[j]; b[j] = s[4 + j] * inv - self[4 + j]; }
            *(u32x4*)(BR + (size_t)(row0 + r) * 3072 + ch * 8) = pack8(a, b); }
    } else {
        const int bb = (it - 256) >> 2, g = (it - 256) & 3, row0 = bb * 256, w = 2 << g;
        for (int q = tid; q < 256 * 32; q += NTHR) { const int r = q >> 5, ch = q & 31;
            *(LAS u32x4*)(lds + q * 16) = *(const u32x4*)(BR + (size_t)(row0 + r) * 3072 + g * 256 + ch * 8); }
        __syncthreads();
        for (int q = tid; q < 256 * 32; q += NTHR) { const int r = q >> 5, ch = q & 31;
            int lo = r - (w >> 1), hi = lo + w - 1; lo = lo < 0 ? 0 : lo; hi = hi > 255 ? 255 : hi;
            float s[8] = {0, 0, 0, 0, 0, 0, 0, 0}, self[8];
            for (int rr = lo; rr <= hi; ++rr) { float f[8]; unpack8(*(const LAS u32x4*)(lds + (rr * 32 + ch) * 16), f);
#pragma unroll
                for (int j = 0; j < 8; ++j) s[j] += f[j]; }
            unpack8(*(const LAS u32x4*)(lds + q * 16), self);
            const float inv = 1.f / (float)(hi - lo + 1); f32x4 a, b;
#pragma unroll
            for (int j = 0; j < 4; ++j) { a[j] = s[j] * inv - self[j]; b[j] = s[4 + j] * inv - self[4 + j]; }
            *(u32x4*)(BR + (size_t)(row0 + r) * 3072 + g * 256 + ch * 8) = pack8(a, b); }
    }
    __syncthreads();
}

constexpr int ML_VT = 0, ML_VWT = 5280, ML_CT = 10560, ML_Q = 28512, ML_K = 63328, ML_KT = 98144, ML_A = 139104, ML_MISC = 149344;
__device__ __forceinline__ void mlstm_chunk_item(const Params& p, int l, int item, LAS unsigned char* lds) {
    const int tid = tid_fresh(), lane = tid & 63, wid = __builtin_amdgcn_readfirstlane(tid >> 6), fr = lane & 15, fq = lane >> 4;
    const int b = item >> 6, hd = (item >> 4) & 3, dir = (item >> 3) & 1, eg = item & 7;
    const bf16_t* QC = (const bf16_t*)(p.ws + WS_QC); const bf16_t* KC = (const bf16_t*)(p.ws + WS_KC);
    const bf16_t* KCT = (const bf16_t*)(p.ws + WS_KCT); const bf16_t* VT = (const bf16_t*)(p.ws + WS_VT);
    const float* GA = (const float*)(p.ws + WS_GA);
    bf16_t* OUT = (bf16_t*)(p.ws + (dir ? WS_HB2 : WS_HF2));
    LAS float* misc = (LAS float*)(lds + ML_MISC);
    const float gb_i = p.mgate_b[l * 16 + dir * 4 + hd], gb_f = p.mgate_b[l * 16 + (2 + dir) * 4 + hd];
    const int ti = wid >> 1, wh = wid & 1;
    __syncthreads();
    for (int i = tid; i < 17952 / 4; i += NTHR) ((LAS unsigned*)(lds + ML_CT))[i] = 0u;
    if (tid < 64) ((LAS bf16_t*)(lds + ML_VT + 32 * 160))[tid] = (bf16_t)0x3F80;
    f32x4 Cacc[2][3];
#pragma unroll
    for (int j = 0; j < 2; ++j)
#pragma unroll
        for (int e = 0; e < 3; ++e) Cacc[j][e] = (f32x4){0.f, 0.f, 0.f, 0.f};
    float m_st = 0.f;
    __syncthreads();
    for (int c = -1; c < 68; ++c) {
        const int cn = c + 1;
        u32x4 rq[4], rk[4], rt[4], rv = (u32x4){0u, 0u, 0u, 0u}; float g_i = 0.f, g_f = 0.f;
#pragma unroll
        for (int j = 0; j < 4; ++j) { rq[j] = (u32x4){0u, 0u, 0u, 0u}; rk[j] = rq[j]; rt[j] = rq[j]; }
        if (cn < 68) {
            const int cin = cn < 4 ? (dir ? 3 - cn : cn) : 4 + (dir ? 67 - cn : cn - 4), gc = b * 68 + cin;
            int rbase, n0, len; chunk_geom(gc, rbase, n0, len);
#pragma unroll
            for (int j = 0; j < 4; ++j) { const int q = tid + NTHR * j;
                const size_t ro = (size_t)(rbase + n0 + (q >> 5)) * 1024 + hd * 256 + (q & 31) * 8;
                rq[j] = *(const u32x4*)(QC + ro); rk[j] = *(const u32x4*)(KC + ro);
                rt[j] = *(const u32x4*)(KCT + (size_t)(gc * 4 + hd) * 16384 + (size_t)q * 8); }
            if (tid < 256) rv = *(const u32x4*)(VT + ((size_t)(gc * 4 + hd) * 256 + eg * 32) * 64 + (size_t)tid * 8);
            { const int j = dir ? 63 - lane : lane; const float* g = GA + (size_t)(rbase + n0 + j) * 16; g_i = g[dir * 4 + hd]; g_f = g[(2 + dir) * 4 + hd]; }
        }
        if (c >= 0) {
            const int cin = c < 4 ? (dir ? 3 - c : c) : 4 + (dir ? 67 - c : c - 4), gc = b * 68 + cin;
            int rbase, n0, len; chunk_geom(gc, rbase, n0, len);
            {
                f32x4 st[2] = {(f32x4){0.f, 0.f, 0.f, 0.f}, (f32x4){0.f, 0.f, 0.f, 0.f}};
                const LAS unsigned char* qb = lds + ML_Q + (16 * ti + fr) * 544 + fq * 16;
                const LAS unsigned char* kb0 = lds + ML_K + (16 * (2 * wh) + fr) * 544 + fq * 16;
#pragma unroll
                for (int kd = 0; kd < 8; ++kd) {
                    const bf16x8 qf = *(const LAS bf16x8*)(qb + kd * 64);
                    const bf16x8 k0 = *(const LAS bf16x8*)(kb0 + kd * 64), k1 = *(const LAS bf16x8*)(kb0 + 16 * 544 + kd * 64);
                    st[0] = __builtin_amdgcn_mfma_f32_16x16x32_bf16(k0, qf, st[0], 0, 0, 0);
                    st[1] = __builtin_amdgcn_mfma_f32_16x16x32_bf16(k1, qf, st[1], 0, 0, 0);
                }
                const int t = 16 * ti + fr; const float Mt = misc[64 + t];
#pragma unroll
                for (int j = 0; j < 2; ++j) { const int s0 = 16 * (2 * wh + j) + 4 * fq; const f32x4 av = *(const LAS f32x4*)(misc + s0);
                    f32x4 o;
#pragma unroll
                    for (int r = 0; r < 4; ++r) { const bool keep = dir ? (s0 + r >= t) : (s0 + r <= t); o[r] = keep ? st[j][r] * __expf(av[r] - Mt) : 0.f; }
                    *(LAS u32x2*)(lds + ML_A + t * 160 + s0 * 2) = pack4(o); }
                { const int e = tid >> 4, s4 = (tid & 15) * 4; const u32x2 v = *(const LAS u32x2*)(lds + ML_VT + e * 160 + s4 * 2); const f32x4 w = *(const LAS f32x4*)(misc + 256 + s4);
                  f32x4 o; o[0] = lo16(v.x) * w[0]; o[1] = hi16(v.x) * w[1]; o[2] = lo16(v.y) * w[2]; o[3] = hi16(v.y) * w[3];
                  *(LAS u32x2*)(lds + ML_VWT + e * 160 + s4 * 2) = pack4(o);
                  if (tid < 16) *(LAS u32x2*)(lds + ML_VWT + 32 * 160 + s4 * 2) = pack4(w); }
            }
            __syncthreads();
            {
                f32x4 n1o = (f32x4){0.f, 0.f, 0.f, 0.f}, n1a = n1o, n2o = n1o, n2a = n1o;
                const LAS unsigned char* ab = lds + ML_A + (16 * ti + fr) * 160 + fq * 16;
                const LAS unsigned char* vo = lds + ML_VT + (16 * wh + fr) * 160 + fq * 16;
                const LAS unsigned char* va = lds + ML_VT + (32 + fr) * 160 + fq * 16;
#pragma unroll
                for (int ks = 0; ks < 2; ++ks) { const bf16x8 af = *(const LAS bf16x8*)(ab + ks * 64);
                    n1o = __builtin_amdgcn_mfma_f32_16x16x32_bf16(af, *(const LAS bf16x8*)(vo + ks * 64), n1o, 0, 0, 0);
                    n1a = __builtin_amdgcn_mfma_f32_16x16x32_bf16(af, *(const LAS bf16x8*)(va + ks * 64), n1a, 0, 0, 0); }
                const LAS unsigned char* qb = lds + ML_Q + (16 * ti + fr) * 544 + fq * 16;
                const LAS unsigned char* co = lds + ML_CT + (16 * wh + fr) * 544 + fq * 16;
                const LAS unsigned char* ca = lds + ML_CT + (32 + fr) * 544 + fq * 16;
#pragma unroll
                for (int kd = 0; kd < 8; ++kd) { const bf16x8 qf = *(const LAS bf16x8*)(qb + kd * 64);
                    n2o = __builtin_amdgcn_mfma_f32_16x16x32_bf16(qf, *(const LAS bf16x8*)(co + kd * 64), n2o, 0, 0, 0);
                    n2a = __builtin_amdgcn_mfma_f32_16x16x32_bf16(qf, *(const LAS bf16x8*)(ca + kd * 64), n2a, 0, 0, 0); }
                const int t0 = 16 * ti + 4 * fq;
                const f32x4 sgv = *(const LAS f32x4*)(misc + 128 + t0), emv = *(const LAS f32x4*)(misc + 192 + t0);
                const bool wr_out = !(l == 1 && cin < 4);
#pragma unroll
                for (int r = 0; r < 4; ++r) {
                    const float den = __shfl(n1a[r] + sgv[r] * n2a[r], lane & 48);
                    const float hv = (n1o[r] + sgv[r] * n2o[r]) / fmaxf(fabsf(den), emv[r]);
                    if (wr_out) OUT[(size_t)(rbase + n0 + t0 + r) * 1024 + hd * 256 + eg * 32 + 16 * wh + fr] = (bf16_t)f2bf(hv);
                }
                const float decay = misc[320];
#pragma unroll
                for (int j = 0; j < 2; ++j)
#pragma unroll
                    for (int e = 0; e < 3; ++e) Cacc[j][e] = Cacc[j][e] * decay;
                const LAS unsigned char* kt = lds + ML_KT + (16 * (2 * wid) + fr) * 160 + fq * 16;
                const LAS unsigned char* vw = lds + ML_VWT + fr * 160 + fq * 16;
#pragma unroll
                for (int ks = 0; ks < 2; ++ks) {
                    const bf16x8 k0 = *(const LAS bf16x8*)(kt + ks * 64), k1 = *(const LAS bf16x8*)(kt + 16 * 160 + ks * 64);
                    const bf16x8 v0 = *(const LAS bf16x8*)(vw + ks * 64), v1 = *(const LAS bf16x8*)(vw + 16 * 160 + ks * 64), v2 = *(const LAS bf16x8*)(vw + 32 * 160 + ks * 64);
                    Cacc[0][0] = __builtin_amdgcn_mfma_f32_16x16x32_bf16(k0, v0, Cacc[0][0], 0, 0, 0);
                    Cacc[0][1] = __builtin_amdgcn_mfma_f32_16x16x32_bf16(k0, v1, Cacc[0][1], 0, 0, 0);
                    Cacc[0][2] = __builtin_amdgcn_mfma_f32_16x16x32_bf16(k0, v2, Cacc[0][2], 0, 0, 0);
                    Cacc[1][0] = __builtin_amdgcn_mfma_f32_16x16x32_bf16(k1, v0, Cacc[1][0], 0, 0, 0);
                    Cacc[1][1] = __builtin_amdgcn_mfma_f32_16x16x32_bf16(k1, v1, Cacc[1][1], 0, 0, 0);
                    Cacc[1][2] = __builtin_amdgcn_mfma_f32_16x16x32_bf16(k1, v2, Cacc[1][2], 0, 0, 0);
                }
            }
            __syncthreads();
#pragma unroll
            for (int j = 0; j < 2; ++j) { const int dcol = (16 * (2 * wid + j) + 4 * fq) * 2;
                *(LAS u32x2*)(lds + ML_CT + fr * 544 + dcol) = pack4(Cacc[j][0]);
                *(LAS u32x2*)(lds + ML_CT + (16 + fr) * 544 + dcol) = pack4(Cacc[j][1]);
                if (fr == 0) *(LAS u32x2*)(lds + ML_CT + 32 * 544 + dcol) = pack4(Cacc[j][2]); }
        }
        if (cn < 68) {
#pragma unroll
            for (int j = 0; j < 4; ++j) { const int q = tid + NTHR * j;
                *(LAS u32x4*)(lds + ML_Q + (q >> 5) * 544 + (q & 31) * 16) = rq[j];
                *(LAS u32x4*)(lds + ML_K + (q >> 5) * 544 + (q & 31) * 16) = rk[j];
                *(LAS u32x4*)(lds + ML_KT + (q >> 3) * 160 + (q & 7) * 16) = rt[j]; }
            if (tid < 256) *(LAS u32x4*)(lds + ML_VT + (tid >> 3) * 160 + (tid & 7) * 16) = rv;
            if (wid == 0) {
                const int j = dir ? 63 - lane : lane;
                const float ig = g_i + gb_i, lf = logsigmoid_f(g_f + gb_f);
                const float cum = wave_incl_sum(lf, lane), a = ig - cum, pm = wave_incl_max(a, lane);
                const float M = fmaxf(m_st, pm), sg = __expf(m_st - M), mt = cum + M;
                const float M63 = __shfl(M, 63), cum63 = __shfl(cum, 63);
                misc[j] = a; misc[64 + j] = M; misc[128 + j] = sg; misc[192 + j] = __expf(-mt); misc[256 + j] = __expf(a - M63);
                if (lane == 0) misc[320] = __expf(m_st - M63);
                m_st = cum63 + M63;
            }
        }
        __syncthreads();
    }
}

constexpr int SS_C = 0, SS_B = 18432, SS_BT = 36864, SS_XT = 57344, SS_XWT = 62464, SS_G = 67584, SS_S = 77824, SS_XRT = 87040, SS_MISC = 92160;
__device__ __forceinline__ void ssd_chunk_item(const Params& p, int l, int item, LAS unsigned char* lds) {
    const int tid = tid_fresh(), lane = tid & 63, wid = __builtin_amdgcn_readfirstlane(tid >> 6), fr = lane & 15, fq = lane >> 4;
    const int b = item >> 6, hd = (item >> 2) & 15, dir = (item >> 1) & 1, ps = item & 1, grp = hd >> 2;
    const bf16_t* BC = (const bf16_t*)(p.ws + WS_BC); const bf16_t* CC = (const bf16_t*)(p.ws + WS_CC);
    const bf16_t* BCT = (const bf16_t*)(p.ws + WS_BCT); const bf16_t* XCT = (const bf16_t*)(p.ws + WS_XCT);
    const float* DT = (const float*)(p.ws + WS_DT);
    bf16_t* OUT = (bf16_t*)(p.ws + (dir ? WS_YB : WS_YF));
    LAS float* misc = (LAS float*)(lds + SS_MISC);
    const float dtb = p.sdt_bias[l * 32 + dir * 16 + hd], aneg = -__expf(p.sa_log[l * 32 + dir * 16 + hd]), dskip = p.sd[l * 16 + hd];
    const int ti = wid >> 1, wh = wid & 1;
    __syncthreads();
    for (int i = tid; i < 9216 / 4; i += NTHR) ((LAS unsigned*)(lds + SS_S))[i] = 0u;
    f32x4 Sacc[2] = {(f32x4){0.f, 0.f, 0.f, 0.f}, (f32x4){0.f, 0.f, 0.f, 0.f}};
    __syncthreads();
    for (int c = -1; c < 68; ++c) {
        const int cn = c + 1;
        u32x4 rc[2], rb[2], rt[2], rx = (u32x4){0u, 0u, 0u, 0u}; float dtraw = 0.f;
#pragma unroll
        for (int j = 0; j < 2; ++j) { rc[j] = (u32x4){0u, 0u, 0u, 0u}; rb[j] = rc[j]; rt[j] = rc[j]; }
        if (cn < 68) {
            const int cin = cn < 4 ? (dir ? 3 - cn : cn) : 4 + (dir ? 67 - cn : cn - 4), gc = b * 68 + cin;
            int rbase, n0, len; chunk_geom(gc, rbase, n0, len);
#pragma unroll
            for (int j = 0; j < 2; ++j) { const int q = tid + NTHR * j;
                const size_t ro = (size_t)(rbase + n0 + (q >> 4)) * 512 + grp * 128 + (q & 15) * 8;
                rc[j] = *(const u32x4*)(CC + ro); rb[j] = *(const u32x4*)(BC + ro);
                rt[j] = *(const u32x4*)(BCT + (size_t)(gc * 4 + grp) * 8192 + (size_t)q * 8); }
            if (tid < 256) rx = *(const u32x4*)(XCT + ((size_t)(gc * 16 + hd) * 64 + ps * 32) * 64 + (size_t)tid * 8);
            { const int j = dir ? 63 - lane : lane; dtraw = DT[(size_t)(rbase + n0 + j) * 32 + dir * 16 + hd]; }
        }
        if (c >= 0) {
            const int cin = c < 4 ? (dir ? 3 - c : c) : 4 + (dir ? 67 - c : c - 4), gc = b * 68 + cin;
            int rbase, n0, len; chunk_geom(gc, rbase, n0, len);
            {
                f32x4 st[2] = {(f32x4){0.f, 0.f, 0.f, 0.f}, (f32x4){0.f, 0.f, 0.f, 0.f}};
                const LAS unsigned char* cbp = lds + SS_C + (16 * ti + fr) * 288 + fq * 16;
                const LAS unsigned char* bb0 = lds + SS_B + (16 * (2 * wh) + fr) * 288 + fq * 16;
#pragma unroll
                for (int kn = 0; kn < 4; ++kn) {
                    const bf16x8 cf = *(const LAS bf16x8*)(cbp + kn * 64);
                    const bf16x8 b0 = *(const LAS bf16x8*)(bb0 + kn * 64), b1 = *(const LAS bf16x8*)(bb0 + 16 * 288 + kn * 64);
                    st[0] = __builtin_amdgcn_mfma_f32_16x16x32_bf16(b0, cf, st[0], 0, 0, 0);
                    st[1] = __builtin_amdgcn_mfma_f32_16x16x32_bf16(b1, cf, st[1], 0, 0, 0);
                }
                const int t = 16 * ti + fr; const float at = misc[t];
#pragma unroll
                for (int j = 0; j < 2; ++j) { const int s0 = 16 * (2 * wh + j) + 4 * fq; const f32x4 av = *(const LAS f32x4*)(misc + s0);
                    f32x4 o;
#pragma unroll
                    for (int r = 0; r < 4; ++r) { const bool keep = dir ? (s0 + r >= t) : (s0 + r <= t); o[r] = keep ? st[j][r] * __expf(at - av[r]) : 0.f; }
                    *(LAS u32x2*)(lds + SS_G + t * 160 + s0 * 2) = pack4(o); }
                { const int e = tid >> 4, s4 = (tid & 15) * 4; const u32x2 v = *(const LAS u32x2*)(lds + SS_XRT + e * 160 + s4 * 2);
                  const f32x4 w = *(const LAS f32x4*)(misc + 128 + s4), dv = *(const LAS f32x4*)(misc + 192 + s4);
                  f32x4 o; o[0] = lo16(v.x) * dv[0]; o[1] = hi16(v.x) * dv[1]; o[2] = lo16(v.y) * dv[2]; o[3] = hi16(v.y) * dv[3];
                  *(LAS u32x2*)(lds + SS_XT + e * 160 + s4 * 2) = pack4(o);
                  *(LAS u32x2*)(lds + SS_XWT + e * 160 + s4 * 2) = pack4(o * w); }
            }
            __syncthreads();
            {
                f32x4 y1 = (f32x4){0.f, 0.f, 0.f, 0.f}, y2 = y1;
                const LAS unsigned char* gb = lds + SS_G + (16 * ti + fr) * 160 + fq * 16;
                const LAS unsigned char* xb = lds + SS_XT + (16 * wh + fr) * 160 + fq * 16;
#pragma unroll
                for (int ks = 0; ks < 2; ++ks) y1 = __builtin_amdgcn_mfma_f32_16x16x32_bf16(*(const LAS bf16x8*)(gb + ks * 64), *(const LAS bf16x8*)(xb + ks * 64), y1, 0, 0, 0);
                const LAS unsigned char* cbp = lds + SS_C + (16 * ti + fr) * 288 + fq * 16;
                const LAS unsigned char* sb = lds + SS_S + (16 * wh + fr) * 288 + fq * 16;
#pragma unroll
                for (int kn = 0; kn < 4; ++kn) y2 = __builtin_amdgcn_mfma_f32_16x16x32_bf16(*(const LAS bf16x8*)(cbp + kn * 64), *(const LAS bf16x8*)(sb + kn * 64), y2, 0, 0, 0);
                const int t0 = 16 * ti + 4 * fq;
                const f32x4 eav = *(const LAS f32x4*)(misc + 64 + t0);
                const u32x2 xs = *(const LAS u32x2*)(lds + SS_XRT + (16 * wh + fr) * 160 + t0 * 2);
                const float xv[4] = {lo16(xs.x), hi16(xs.x), lo16(xs.y), hi16(xs.y)};
                const bool wr_out = !(l == 1 && cin < 4);
#pragma unroll
                for (int r = 0; r < 4; ++r) {
                    float yv = y1[r] + eav[r] * y2[r];
                    if (dir == 0) yv += dskip * xv[r];
                    if (wr_out) OUT[(size_t)(rbase + n0 + t0 + r) * 1024 + hd * 64 + ps * 32 + 16 * wh + fr] = (bf16_t)f2bf(yv);
                }
                const float dec = misc[256];
                Sacc[0] = Sacc[0] * dec; Sacc[1] = Sacc[1] * dec;
                const LAS unsigned char* bt = lds + SS_BT + (16 * wid + fr) * 160 + fq * 16;
                const LAS unsigned char* xw = lds + SS_XWT + fr * 160 + fq * 16;
#pragma unroll
                for (int ks = 0; ks < 2; ++ks) { const bf16x8 bf = *(const LAS bf16x8*)(bt + ks * 64);
                    Sacc[0] = __builtin_amdgcn_mfma_f32_16x16x32_bf16(bf, *(const LAS bf16x8*)(xw + ks * 64), Sacc[0], 0, 0, 0);
                    Sacc[1] = __builtin_amdgcn_mfma_f32_16x16x32_bf16(bf, *(const LAS bf16x8*)(xw + 16 * 160 + ks * 64), Sacc[1], 0, 0, 0); }
            }
            __syncthreads();
            { const int ncol = (16 * wid + 4 * fq) * 2;
              *(LAS u32x2*)(lds + SS_S + fr * 288 + ncol) = pack4(Sacc[0]);
              *(LAS u32x2*)(lds + SS_S + (16 + fr) * 288 + ncol) = pack4(Sacc[1]); }
        }
        if (cn < 68) {
#pragma unroll
            for (int j = 0; j < 2; ++j) { const int q = tid + NTHR * j;
                *(LAS u32x4*)(lds + SS_C + (q >> 4) * 288 + (q & 15) * 16) = rc[j];
                *(LAS u32x4*)(lds + SS_B + (q >> 4) * 288 + (q & 15) * 16) = rb[j];
                *(LAS u32x4*)(lds + SS_BT + (q >> 3) * 160 + (q & 7) * 16) = rt[j]; }
            if (tid < 256) *(LAS u32x4*)(lds + SS_XRT + (tid >> 3) * 160 + (tid & 7) * 16) = rx;
            if (wid == 0) {
                const int j = dir ? 63 - lane : lane;
                const float dtv = softplus_f(dtraw + dtb);
                const float acs = wave_incl_sum(dtv * aneg, lane);
                const float a63 = __shfl(acs, 63);
                misc[j] = acs; misc[64 + j] = __expf(acs); misc[128 + j] = __expf(a63 - acs); misc[192 + j] = dtv;
                if (lane == 0) misc[256] = __expf(a63);
            }
        }
        __syncthreads();
    }
}

__device__ __forceinline__ void mlstm_finish_rows(const Params& p, int l, int row_lo, int gw, int ngw) {
    if (p.dup) return;
    const int lane = tid_fresh() & 63;
    const bf16_t* HF = (const bf16_t*)(p.ws + WS_HF2); const bf16_t* HB = (const bf16_t*)(p.ws + WS_HB2);
    bf16_t* BR = (bf16_t*)(p.ws + WS_BR);
    const float* ng = p.mnorm_g + l * 1024;
    int row = row_lo + gw;
    u32x2 ca[4], cb[4], co[4], na[4], nbv[4], no[4];
    if (row < MT) { const size_t so = (size_t)scanrow(row) * 1024;
#pragma unroll
        for (int hd = 0; hd < 4; ++hd) { const int c = hd * 256 + 4 * lane; ca[hd] = *(const u32x2*)(HF + so + c); cb[hd] = *(const u32x2*)(HB + so + c); co[hd] = *(const u32x2*)(BR + (size_t)row * 3072 + 1024 + c); } }
    for (; row < MT; row += ngw) {
        const int rn = row + ngw;
        if (rn < MT) { const size_t so = (size_t)scanrow(rn) * 1024;
#pragma unroll
            for (int hd = 0; hd < 4; ++hd) { const int c = hd * 256 + 4 * lane; na[hd] = *(const u32x2*)(HF + so + c); nbv[hd] = *(const u32x2*)(HB + so + c); no[hd] = *(const u32x2*)(BR + (size_t)rn * 3072 + 1024 + c); } }
#pragma unroll
        for (int hd = 0; hd < 4; ++hd) { const int c = hd * 256 + 4 * lane;
            const u32x2 a = ca[hd], b2 = cb[hd], o = co[hd];
            f32x4 h; h[0] = lo16(a.x) + lo16(b2.x); h[1] = hi16(a.x) + hi16(b2.x); h[2] = lo16(a.y) + lo16(b2.y); h[3] = hi16(a.y) + hi16(b2.y);
            const float ss = wave_sum((h[0] * h[0] + h[1] * h[1]) + (h[2] * h[2] + h[3] * h[3]));
            const float rs = 1.0f / sqrtf(ss * (1.f / 256.f) + EPS);
            const f32x4 g = *(const f32x4*)(ng + c);
            f32x4 r; r[0] = sigmoid_f(lo16(o.x)) * (h[0] * rs * g[0]); r[1] = sigmoid_f(hi16(o.x)) * (h[1] * rs * g[1]);
            r[2] = sigmoid_f(lo16(o.y)) * (h[2] * rs * g[2]); r[3] = sigmoid_f(hi16(o.y)) * (h[3] * rs * g[3]);
            u32x2 w; w.x = pk2(r[0], r[1]); w.y = pk2(r[2], r[3]);
            *(u32x2*)(BR + (size_t)row * 3072 + 1024 + c) = w; }
#pragma unroll
        for (int hd = 0; hd < 4; ++hd) { ca[hd] = na[hd]; cb[hd] = nbv[hd]; co[hd] = no[hd]; }
    }
}
__device__ __forceinline__ void ssd_finish_rows(const Params& p, int l, int row_lo, int gw, int ngw) {
    if (p.dup) return;
    const int lane = tid_fresh() & 63;
    const bf16_t* YF = (const bf16_t*)(p.ws + WS_YF); const bf16_t* YB = (const bf16_t*)(p.ws + WS_YB);
    bf16_t* BR = (bf16_t*)(p.ws + WS_BR);
    const float* ng = p.snorm_g + l * 1024;
    int row = row_lo + gw;
    u32x2 ca[4], cb[4], cz[4], na[4], nbv[4], nz[4];
    if (row < MT) {
#pragma unroll
        for (int j = 0; j < 4; ++j) { const int c = 4 * lane + 256 * j; ca[j] = *(const u32x2*)(YF + (size_t)row * 1024 + c); cb[j] = *(const u32x2*)(YB + (size_t)row * 1024 + c); cz[j] = *(const u32x2*)(BR + (size_t)row * 3072 + 2048 + c); } }
    for (; row < MT; row += ngw) {
        const int rn = row + ngw;
        if (rn < MT) {
#pragma unroll
            for (int j = 0; j < 4; ++j) { const int c = 4 * lane + 256 * j; na[j] = *(const u32x2*)(YF + (size_t)rn * 1024 + c); nbv[j] = *(const u32x2*)(YB + (size_t)rn * 1024 + c); nz[j] = *(const u32x2*)(BR + (size_t)rn * 3072 + 2048 + c); } }
        f32x4 v[4]; float ss = 0.f;
#pragma unroll
        for (int j = 0; j < 4; ++j) { const u32x2 a = ca[j], b2 = cb[j], z = cz[j];
            v[j][0] = (lo16(a.x) + lo16(b2.x)) * silu_f(lo16(z.x)); v[j][1] = (hi16(a.x) + hi16(b2.x)) * silu_f(hi16(z.x));
            v[j][2] = (lo16(a.y) + lo16(b2.y)) * silu_f(lo16(z.y)); v[j][3] = (hi16(a.y) + hi16(b2.y)) * silu_f(hi16(z.y));
            ss += (v[j][0] * v[j][0] + v[j][1] * v[j][1]) + (v[j][2] * v[j][2] + v[j][3] * v[j][3]); }
        const float rs = 1.0f / sqrtf(wave_sum(ss) * (1.f / 1024.f) + EPS);
#pragma unroll
        for (int j = 0; j < 4; ++j) { const int c = 4 * lane + 256 * j; const f32x4 g = *(const f32x4*)(ng + c);
            u32x2 w; w.x = pk2(v[j][0] * rs * g[0], v[j][1] * rs * g[1]); w.y = pk2(v[j][2] * rs * g[2], v[j][3] * rs * g[3]);
            *(u32x2*)(BR + (size_t)row * 3072 + 2048 + c) = w; }
#pragma unroll
        for (int j = 0; j < 4; ++j) { ca[j] = na[j]; cb[j] = nbv[j]; cz[j] = nz[j]; }
    }
}

__device__ __forceinline__ void phase_route(const Params& p, int l, unsigned char* ldsb, int bid, int nb) {
    float* lds = reinterpret_cast<float*>(ldsb);
    float* Wt = lds;
    int* hist = reinterpret_cast<int*>(lds + 36 * 1024);
    const int tid = tid_fresh(), lane = tid & 63, wave = tid >> 6;
    const int row_lo = l == 0 ? 0 : MC, rpb = l == 0 ? 68 : 64;
    const float* wrg = p.w_rg + (size_t)l * 1024 * 4; const float* wre = p.w_re + (size_t)l * 1024 * 32;
    for (int i = tid; i < 1024 * 4; i += NTHR) { const int k = i >> 2, g = i & 3; Wt[g * 1024 + (k ^ ((g & 7) << 2))] = wrg[i]; }
    for (int i = tid; i < 1024 * 32; i += NTHR) { const int k = i >> 5, e = i & 31; Wt[(4 + e) * 1024 + (k ^ (((4 + e) & 7) << 2))] = wre[i]; }
    const float* mod = (const float*)(p.ws + WS_MOD) + l * 5 * 6144;
    const float* XL = (const float*)(p.ws + WS_XL);
    int* EID = (int*)(p.ws + WS_EID); float* EWT = (float*)(p.ws + WS_EWT);
    for (int vb = bid; vb < 256; vb += nb) {
        if (tid < 32) hist[tid] = 0;
        __syncthreads();
        for (int rr = wave; rr < rpb; rr += 8) {
            const int row = row_lo + vb * rpb + rr;
            f32x4 v[4];
#pragma unroll
            for (int j = 0; j < 4; ++j) v[j] = *(const f32x4*)(XL + (size_t)row * 1024 + 4 * lane + 256 * j);
            const float* mr = mod + modrow(row) * 6144;
            norm_mod_row(v, p.g_ffn + l * 1024, mr + 3 * 1024, mr + 4 * 1024, lane);
            store_row_bf16((bf16_t*)(p.ws + WS_H) + (size_t)row * 1024, v, lane);
            float lg[36];
#pragma unroll
            for (int e = 0; e < 36; ++e) { float s = 0.f;
#pragma unroll
                for (int j = 0; j < 4; ++j) { const f32x4 w = *(const f32x4*)(Wt + e * 1024 + ((4 * lane + 256 * j) ^ ((e & 7) << 2))); s += (v[j][0] * w[0] + v[j][1] * w[1]) + (v[j][2] * w[2] + v[j][3] * w[3]); }
                lg[e] = wave_sum(s); }
            float gl[4]; int gi = 0; float gmax;
#pragma unroll
            for (int g = 0; g < 4; ++g) gl[g] = lg[g] + p.b_rg[l * 4 + g];
            gmax = gl[0];
#pragma unroll
            for (int g = 1; g < 4; ++g) if (gl[g] > gmax) { gmax = gl[g]; gi = g; }
            float den = 0.f;
#pragma unroll
            for (int g = 0; g < 4; ++g) den += __expf(gl[g] - gmax);
            const float pg = 1.f / den;
            float v1 = -3.0e38f, v2 = -3.0e38f; int i1 = 0, i2 = 0;
#pragma unroll
            for (int g = 0; g < 4; ++g) if (g == gi) {
#pragma unroll
                for (int j = 0; j < 8; ++j) { const float x = lg[4 + g * 8 + j] + p.b_re[l * 32 + g * 8 + j];
                    if (x > v1) { v2 = v1; i2 = i1; v1 = x; i1 = j; } else if (x > v2) { v2 = x; i2 = j; } } }
            const float e2 = __expf(v2 - v1), w1 = pg / (1.f + e2), w2 = pg * e2 / (1.f + e2);
            if (lane == 0) { EID[row * 2] = gi * 8 + i1; EID[row * 2 + 1] = gi * 8 + i2; EWT[row * 2] = w1; EWT[row * 2 + 1] = w2;
                atomicAdd(&hist[gi * 8 + i1], 1); atomicAdd(&hist[gi * 8 + i2], 1); }
        }
        __syncthreads();
        if (tid < 32) ((int*)(p.ws + WS_HIST))[vb * 32 + tid] = hist[tid];
        __syncthreads();
    }
    __syncthreads();
    float* scr = lds + wave * (64 * 65);
    convert_run(p, l, l + 1 < 2 ? l + 1 : -1, bid * 8 + wave, nb * 8, scr, lane);
}

__device__ __forceinline__ void phase_scatter(const Params& p, int l, unsigned char* ldsb, int bid, int nb) {
    int* li = reinterpret_cast<int*>(ldsb);
    int* tot = li; int* pre = li + 32; int* pst = li + 64; int* ea = li + 128; int* pos = li + 384;
    const int tid = tid_fresh(), lane = tid & 63, wave = tid >> 6;
    const int row_lo = l == 0 ? 0 : MC, rpb = l == 0 ? 68 : 64;
    const int* HIST = (const int*)(p.ws + WS_HIST); const int* EID = (const int*)(p.ws + WS_EID);
    int* SLOT = (int*)(p.ws + WS_SLOT);
    for (int vb = bid; vb < 256; vb += nb) {
        __syncthreads();
        if (tid < 32) { int t = 0, pr = 0; for (int j = 0; j < 256; ++j) { const int hv = HIST[j * 32 + tid]; t += hv; if (j < vb) pr += hv; } tot[tid] = t; pre[tid] = pr; }
        __syncthreads();
        if (tid == 0) { int s = 0; for (int e = 0; e < 32; ++e) { pst[e] = s; s += ((tot[e] + 255) >> 8) << 8; }
            if (vb == 0) { int* BE = (int*)(p.ws + WS_BLKEXP); int nblk = 0;
                for (int e = 0; e < 32; ++e) { const int nbk = (tot[e] + 255) >> 8; for (int j = 0; j < nbk; ++j) BE[nblk++] = e; }
                BE[200] = nblk; } }
        if (tid < rpb * 2) ea[tid] = EID[(row_lo + vb * rpb) * 2 + tid];
        __syncthreads();
        if (tid < rpb * 2) { const int e = ea[tid]; int rk = 0; for (int j = 0; j < tid; ++j) rk += (ea[j] == e) ? 1 : 0;
            const int ps = pst[e] + pre[e] + rk; SLOT[(row_lo + vb * rpb) * 2 + tid] = ps; ((int*)(p.ws + WS_TOK))[ps] = row_lo + vb * rpb + (tid >> 1); }
        if (vb == 0 && tid < 32) { int* TOK = (int*)(p.ws + WS_TOK); const int e0 = pst[tid] + tot[tid], e1 = pst[tid] + (((tot[tid] + 255) >> 8) << 8);
            for (int q = e0; q < e1; ++q) TOK[q] = row_lo; }
    }
    __syncthreads();
}

__device__ __forceinline__ void phase_combine(const Params& p, int l, int bid, int nb) {
    if (p.dup && l == 0) return;
    const int lane = tid_fresh() & 63, wave = tid_fresh() >> 6;
    const float* mod = (const float*)(p.ws + WS_MOD);
    const int* SLOT = (const int*)(p.ws + WS_SLOT); const float* EWT = (const float*)(p.ws + WS_EWT);
    const bf16_t* Y = (const bf16_t*)(p.ws + WS_Y);
    float* XL = (float*)(p.ws + WS_XL);
    const int row_lo = l == 0 ? 0 : MC, stride = nb * 8;
    for (int rowA = row_lo + bid * 8 + wave; rowA < MT; rowA += 2 * stride) {
        const int rowB = rowA + stride; const bool hasB = rowB < MT; const int rb = hasB ? rowB : rowA;
        const int sA0 = SLOT[rowA * 2], sA1 = SLOT[rowA * 2 + 1], sB0 = SLOT[rb * 2], sB1 = SLOT[rb * 2 + 1];
        const float wA0 = EWT[rowA * 2], wA1 = EWT[rowA * 2 + 1], wB0 = EWT[rb * 2], wB1 = EWT[rb * 2 + 1];
        u32x2 yA0[4], yA1[4], yB0[4], yB1[4]; f32x4 xA[4], xB[4];
#pragma unroll
        for (int j = 0; j < 4; ++j) { const int c = 4 * lane + 256 * j;
            yA0[j] = *(const u32x2*)(Y + (size_t)sA0 * 1024 + c); yA1[j] = *(const u32x2*)(Y + (size_t)sA1 * 1024 + c); xA[j] = *(const f32x4*)(XL + (size_t)rowA * 1024 + c);
            yB0[j] = *(const u32x2*)(Y + (size_t)sB0 * 1024 + c); yB1[j] = *(const u32x2*)(Y + (size_t)sB1 * 1024 + c); xB[j] = *(const f32x4*)(XL + (size_t)rb * 1024 + c); }
#pragma unroll
        for (int half = 0; half < 2; ++half) {
            if (half == 1 && !hasB) break;
            const int row = half ? rowB : rowA; const float w0 = half ? wB0 : wA0, w1 = half ? wB1 : wA1;
            const float* g5 = mod + (l * 5 + modrow(row)) * 6144 + 5 * 1024;
            f32x4 v[4];
#pragma unroll
            for (int j = 0; j < 4; ++j) { const int c = 4 * lane + 256 * j;
                const u32x2 a = half ? yB0[j] : yA0[j], b2 = half ? yB1[j] : yA1[j];
                f32x4 y; y[0] = w0 * lo16(a.x) + w1 * lo16(b2.x); y[1] = w0 * hi16(a.x) + w1 * hi16(b2.x); y[2] = w0 * lo16(a.y) + w1 * lo16(b2.y); y[3] = w0 * hi16(a.y) + w1 * hi16(b2.y);
                v[j] = (half ? xB[j] : xA[j]) + *(const f32x4*)(g5 + c) * y; }
            if (l == 0) {
#pragma unroll
                for (int j = 0; j < 4; ++j) *(f32x4*)(XL + (size_t)row * 1024 + 4 * lane + 256 * j) = v[j];
                const float* mr = mod + (5 + modrow(row)) * 6144;
                norm_mod_row(v, p.g_mix + 1024, mr, mr + 1024, lane);
                store_row_bf16((bf16_t*)(p.ws + WS_H) + (size_t)row * 1024, v, lane);
            } else {
                norm_mod_row(v, p.g_final, nullptr, nullptr, lane);
                float* o = p.out + (size_t)(row - MC) * 1024;
#pragma unroll
                for (int j = 0; j < 4; ++j) *(f32x4*)(o + 4 * lane + 256 * j) = v[j];
            }
        }
    }
}

constexpr int NPH_L = 14, NPHASES = 1 + 2 * NPH_L;
__device__ __forceinline__ void run_phase(const Params& p, int ph, unsigned char* lds) {
    const int bid = blockIdx.x, nb = gridDim.x;
    const int wave = tid_fresh() >> 6;
#ifndef ONLY_S
    if (ph == 0) { phase_pre(p, lds, bid, nb); return; }
#else
    if (ph == 0) { if (ONLY_S == 99) phase_pre(p, lds, bid, nb); return; }
#endif
    const int l = (ph - 1) / NPH_L, s = (ph - 1) % NPH_L;
    unsigned char* ws = p.ws;
    const int pm0 = l == 0 ? 0 : 4, nMrows = l == 0 ? 68 : 64, row_lo = l == 0 ? 0 : MC;
#ifdef ONLY_S
    if (s != ONLY_S) return;
#endif
    switch (s) {
    case 0: if (l == 0) phase_norm1(p, bid, nb); break;
    case 1: { SchedGrid S{(const bf16_t*)(ws + WS_H), (const bf16_t*)(ws + WS_WIN), 1024, 1024, 0, 68, 45, nb, bid}; EpiInproj E{ws};
              gemm_run(lds, S, E, 1024, 1024, 1024, 1); } break;
    case 2: { for (int it = bid; it < 1088; it += nb) conv_m_item(p, l, it, (LAS unsigned char*)lds);
              if (!p.dup) for (int it = bid; it < (l == 0 ? 272 : 256); it += nb) pool_window_item(p, it, (LAS unsigned char*)lds); } break;
    case 3: { for (int it = bid; it < 256; it += nb) mlstm_chunk_item(p, l, it, (LAS unsigned char*)lds);
              SchedPool S{(const bf16_t*)(ws + WS_BR), (const bf16_t*)(ws + WS_WPOOL), pm0, nMrows, nb, bid}; EpiPool E{(bf16_t*)(ws + WS_BR)};
              if (!p.dup) gemm_run(lds, S, E, 256, 3072, 256, 1); } break;
    case 4: { for (int it = bid; it < 1088; it += nb) conv_s_item(p, l, it, (LAS unsigned char*)lds);
              mlstm_finish_rows(p, l, row_lo, bid * 8 + wave, nb * 8); } break;
    case 5: for (int it = bid; it < 256; it += nb) ssd_chunk_item(p, l, it, (LAS unsigned char*)lds); break;
    case 6: ssd_finish_rows(p, l, row_lo, bid * 8 + wave, nb * 8); break;
    case 7: { SchedGrid S{(const bf16_t*)(ws + WS_BR), (const bf16_t*)(ws + WS_WBR), 3072, 3072, pm0, nMrows, 4, nb, bid}; EpiBranch E{(const bf16_t*)(ws + WS_MG), (bf16_t*)(ws + WS_MERGED)};
              gemm_run(lds, S, E, 3072, 3072, 3072, 3); } break;
    case 8: { SchedGrid S{(const bf16_t*)(ws + WS_MERGED), (const bf16_t*)(ws + WS_WOUT), 1024, 1024, pm0, nMrows, 4, nb, bid}; EpiOut E{(float*)(ws + WS_XL), (const float*)(ws + WS_MOD) + l * 5 * 6144, p.dup};
              gemm_run(lds, S, E, 1024, 1024, 1024, 1); } break;
    case 9: phase_route(p, l, lds, bid, nb); break;
    case 10: phase_scatter(p, l, lds, bid, nb); break;
    case 11: { const int* BE = (const int*)(ws + WS_BLKEXP);
              SchedMoe S{(const bf16_t*)(ws + WS_H), (const bf16_t*)(ws + WS_EW1), BE, (const int*)(ws + WS_TOK), 1024, BE[200], nb, bid, (size_t)1048576, (size_t)1024}; EpiMoe1 E{(bf16_t*)(ws + WS_ACT)};
              gemm_run<true>(lds, S, E, 1024, 1024, 1024, 1); } break;
    case 12: { const int* BE = (const int*)(ws + WS_BLKEXP);
              SchedMoe S{(const bf16_t*)(ws + WS_ACT), (const bf16_t*)(ws + WS_EW2), BE, nullptr, 512, BE[200], nb, bid, (size_t)524288, (size_t)512}; EpiMoe2 E{(bf16_t*)(ws + WS_Y)};
              gemm_run(lds, S, E, 512, 512, 512, 1); } break;
    case 13: phase_combine(p, l, bid, nb); break;
    }
}

#define XB_TMO      128
#define XB_XCNT(j)  (256  + 64 * (j))
#define XB_XSUB(j)  (1280 + 64 * (j))
#define XB_XGEN(j)  (2304 + 64 * (j))
#define XB_TOP      3328
#define XB_TOPGEN   3392
#define XCD_BAR_WORDS 3456
#define XB_SPIN_CAP (1u << 18)
__device__ __forceinline__ unsigned xb_ld(unsigned* p)              { return __hip_atomic_load(p, __ATOMIC_RELAXED, __HIP_MEMORY_SCOPE_AGENT); }
__device__ __forceinline__ unsigned xb_add(unsigned* p, unsigned v) { return __hip_atomic_fetch_add(p, v, __ATOMIC_RELAXED, __HIP_MEMORY_SCOPE_AGENT); }
__device__ __forceinline__ unsigned xb_xcc_id() { return (unsigned)__builtin_amdgcn_s_getreg((3 << 11) | 20) & 0xFu; }
#define XB_SPIN(cond, bar) do { unsigned _sp = 0; while (cond) { __builtin_amdgcn_s_sleep(1); \
    if ((++_sp & 255u) == 0u) { if (xb_ld(&(bar)[XB_TMO])) break; if (_sp > XB_SPIN_CAP) { atomicAdd(&(bar)[XB_TMO], 1u); break; } } } } while (0)
__device__ __forceinline__ void xcd_barrier_complete(unsigned* bar, unsigned x, unsigned& nloc, unsigned& nx) {
    const unsigned G = gridDim.x * gridDim.y * gridDim.z;
    unsigned sum, cnt, mine, sp = 0u;
    for (;;) {
        sum = 0u; cnt = 0u; mine = 0u;
#pragma unroll
        for (unsigned j = 0; j < 16; ++j) { const unsigned c = xb_ld(&bar[XB_XCNT(j)]); sum += c; cnt += (c > 0u) ? 1u : 0u; mine = (j == x) ? c : mine; }
        if (sum == G) break;
        __builtin_amdgcn_s_sleep(1);
        if ((++sp & 255u) == 0u) { if (xb_ld(&bar[XB_TMO])) break; if (sp > XB_SPIN_CAP) { atomicAdd(&bar[XB_TMO], 1u); break; } }
    }
    nloc = mine > 0u ? mine : 1u; nx = cnt > 0u ? cnt : 1u;
}
__device__ __forceinline__ void xcd_barrier(unsigned* bar, volatile LAS unsigned* st) {
    asm volatile("s_waitcnt vmcnt(0)" ::: "memory");
    __syncthreads();
    if (threadIdx.x == 0) {
        __builtin_amdgcn_s_waitcnt(0);
        const unsigned x = xb_xcc_id();
        unsigned nloc = st[0], nx = st[1];
        if (nloc == 0u) { xcd_barrier_complete(bar, x, nloc, nx); st[0] = nloc; st[1] = nx; }
        const unsigned old = xb_add(&bar[XB_XSUB(x)], 1u);
        const unsigned gen = old / nloc;
        if (old + 1u == (gen + 1u) * nloc) {
            __builtin_amdgcn_fence(__ATOMIC_RELEASE, "agent");
            asm volatile("s_waitcnt vmcnt(0)" ::: "memory");
            const unsigned og = xb_add(&bar[XB_TOP], 1u);
            const unsigned tg = og / nx;
            if (og + 1u == (tg + 1u) * nx) xb_add(&bar[XB_TOPGEN], 1u);
            else XB_SPIN(xb_ld(&bar[XB_TOPGEN]) == tg, bar);
            __builtin_amdgcn_fence(__ATOMIC_ACQUIRE, "agent");
            xb_add(&bar[XB_XGEN(x)], 1u);
            asm volatile("s_waitcnt vmcnt(0)" ::: "memory");
        } else {
            XB_SPIN(xb_ld(&bar[XB_XGEN(x)]) == gen, bar);
            __builtin_amdgcn_fence(__ATOMIC_ACQUIRE, "agent");
            asm volatile("s_waitcnt vmcnt(0)" ::: "memory");
        }
    }
    __syncthreads();
}

constexpr int BAR_LDS_OFF = LDS_BYTES - 16;
__global__ void __launch_bounds__(NTHR, 2) fwd_kernel(Params pk) {
    extern __shared__ __attribute__((aligned(16))) unsigned char lds[];
    const Params& p = pk;
    const int lo = pk.ph_lo, hi = pk.ph_hi;
    unsigned* bar = (unsigned*)(pk.ws + WS_BAR);
    volatile LAS unsigned* bst = (volatile LAS unsigned*)((LAS unsigned char*)lds + BAR_LDS_OFF);
    if (hi - lo > 1) {
        if (threadIdx.x == 0) { bst[0] = 0u; bst[1] = 0u; (void)xb_add(&bar[XB_XCNT(xb_xcc_id())], 1u); }
        __syncthreads();
    }
#define STEP(k) if (lo <= (k) && (k) < hi) { run_phase(p, (k), lds); if ((k) + 1 < hi) { if ((k) == 0) cg::this_grid().sync(); else xcd_barrier(bar, bst); } }
    STEP(0) STEP(1) STEP(2) STEP(3) STEP(4) STEP(5) STEP(6) STEP(7) STEP(8) STEP(9) STEP(10) STEP(11) STEP(12) STEP(13) STEP(14)
    STEP(16) STEP(17) STEP(18) STEP(19) STEP(20) STEP(21) STEP(22) STEP(23) STEP(24) STEP(25) STEP(26) STEP(27) STEP(28)
#undef STEP
}

extern "C" void kernel_launch(void* const* d_in, const int* in_sizes, int n_in, void* d_out, int out_size, void* d_ws, size_t ws_size, hipStream_t stream) {
    static int grid_blocks = 0;
    if (!grid_blocks) {
        if (n_in != 31 || ws_size < WS_END) { fprintf(stderr, "kernel_launch: unexpected n_in %d / ws_size %zu (need %zu)\n", n_in, ws_size, (size_t)WS_END); grid_blocks = -1; return; }
        int dev = 0, cus = 0, per_cu = 0;
        hipGetDevice(&dev);
        hipDeviceGetAttribute(&cus, hipDeviceAttributeMultiprocessorCount, dev);
        if (hipFuncSetAttribute((const void*)fwd_kernel, hipFuncAttributeMaxDynamicSharedMemorySize, LDS_BYTES) != hipSuccess) fprintf(stderr, "kernel_launch: hipFuncSetAttribute failed\n");
        hipOccupancyMaxActiveBlocksPerMultiprocessor(&per_cu, (const void*)fwd_kernel, NTHR, LDS_BYTES);
        if (per_cu < 1) { fprintf(stderr, "kernel_launch: occupancy query says %d blocks per CU\n", per_cu); per_cu = 1; }
        grid_blocks = cus * per_cu;
        (void)hipGetLastError();
    }
    if (grid_blocks < 0) return;
    Params p{};
    const float** dst = (const float**)&p;
    for (int i = 0; i < 31; ++i) dst[i] = (const float*)d_in[i];
    p.out = (float*)d_out; p.ws = (unsigned char*)d_ws;
#if SINGLE_LAUNCH
    if (hipMemsetAsync((char*)d_ws + WS_BAR, 0, 16384, stream) != hipSuccess) fprintf(stderr, "kernel_launch: hipMemsetAsync failed\n");
    p.ph_lo = 0; p.ph_hi = NPHASES;
    void* args[] = {&p};
    hipError_t e = hipLaunchCooperativeKernel((const void*)fwd_kernel, dim3(grid_blocks), dim3(NTHR), args, LDS_BYTES, stream);
    if (e != hipSuccess) fprintf(stderr, "cooperative launch failed: %s (grid %d)\n", hipGetErrorString(e), grid_blocks);
#else
    for (int ph = 0; ph < NPHASES; ++ph) {
        if (ph == 1 + NPH_L) continue;
        p.ph_lo = ph; p.ph_hi = ph + 1;
        hipLaunchKernelGGL(fwd_kernel, dim3(grid_blocks), dim3(NTHR), LDS_BYTES, stream, p);
        const int sidx = ph == 0 ? 14 : (ph - 1) % NPH_L;
        if ((PROBE_DUP_MASK >> sidx) & 1) { p.dup = 1; for (int r = 0; r < PROBE_DUP_N; ++r) hipLaunchKernelGGL(fwd_kernel, dim3(grid_blocks), dim3(NTHR), LDS_BYTES, stream, p); p.dup = 0; }
    }
#endif
}
```

```cpp
#include <hip/hip_runtime.h>
#include <hip/hip_cooperative_groups.h>
#include <cstdio>
namespace cg = cooperative_groups;

#ifndef SINGLE_LAUNCH
#define SINGLE_LAUNCH 1
#endif
#ifndef PROBE_DUP_MASK
#define PROBE_DUP_MASK 0
#endif
#ifndef PROBE_DUP_N
#define PROBE_DUP_N 1
#endif
#ifndef USE_MLSTM_CHUNK
#define USE_MLSTM_CHUNK 1
#endif
#ifndef USE_SSD_CHUNK
#define USE_SSD_CHUNK 1
#endif
#ifndef USE_MFMA_GEMM
#define USE_MFMA_GEMM 1
#endif

typedef unsigned short bf16_t;
typedef float f32x4 __attribute__((ext_vector_type(4)));
typedef unsigned u32x4 __attribute__((ext_vector_type(4)));
typedef unsigned u32x2 __attribute__((ext_vector_type(2)));

constexpr int NTHR = 512;
constexpr int D = 1024, NB = 4, SEQ = 4096, CTXL = 256;
constexpr int MC = NB * CTXL;
constexpr int ML = NB * SEQ;
constexpr int MT = MC + ML;
constexpr int DIN = 11312, NPAD = 11520;
constexpr int NE = 32, DE = 512;
constexpr int CAP = 43008;
constexpr float EPS = 1e-6f;
constexpr int LDS_BYTES = 163840;

constexpr size_t MiB = 1u << 20;
constexpr size_t WS_HIST = 0;
constexpr size_t WS_BLKEXP = 64 * 1024;
constexpr size_t WS_BAR = 128 * 1024;
constexpr size_t WS_TOK = 256 * 1024;
constexpr size_t WS_MOD = 1 * MiB;
constexpr size_t WS_GA = 2 * MiB;
constexpr size_t WS_DT = 4 * MiB;
constexpr size_t WS_EID = 7 * MiB;
constexpr size_t WS_EWT = 7 * MiB + 256 * 1024;
constexpr size_t WS_SLOT = 7 * MiB + 512 * 1024;
constexpr size_t WS_WIN = 8 * MiB;
constexpr size_t WS_WPOOL = 31 * MiB;
constexpr size_t WS_WBR = 32 * MiB;
constexpr size_t WS_WOUT = 38 * MiB;
constexpr size_t WS_XL = 40 * MiB;
constexpr size_t WS_H = 108 * MiB;
constexpr size_t WS_BR = 142 * MiB;
constexpr size_t WS_Q = 244 * MiB, WS_K = 278 * MiB, WS_V = 312 * MiB;
constexpr size_t WS_SX = 346 * MiB, WS_SB = 380 * MiB, WS_SC = 397 * MiB;
constexpr size_t WS_MG = 414 * MiB;
constexpr size_t WS_HF = 516 * MiB, WS_HB = 550 * MiB;
constexpr size_t WS_VT = 584 * MiB;
constexpr size_t WS_END = 618 * MiB;
constexpr size_t WS_QC = WS_H, WS_KC = WS_HF, WS_KCT = WS_HB;
constexpr size_t WS_HF2 = WS_Q, WS_HB2 = WS_K;
constexpr size_t WS_XCT = WS_HF;
constexpr size_t WS_BC = WS_H, WS_CC = WS_H + 17 * MiB, WS_BCT = WS_HB;
constexpr size_t WS_YF = WS_SX, WS_YB = WS_SB;
constexpr size_t WS_MERGED = WS_Q;
constexpr size_t WS_EW1 = 244 * MiB;
constexpr size_t WS_EW2 = 308 * MiB;
constexpr size_t WS_XB = WS_BR;
constexpr size_t WS_ACT = WS_SX;
constexpr size_t WS_Y = WS_MG;

struct Params {
    const float *x, *c, *ctx, *c_ctx, *w_ada, *b_ada, *g_mix, *g_ffn, *w_in, *pool_w, *pool_scale,
        *mconv_w, *mconv_b, *mgate_b, *mnorm_g, *sconv_w, *sconv_b, *sdt_bias, *sa_log, *sd, *snorm_g,
        *w_branch, *w_out, *w_rg, *b_rg, *w_re, *b_re, *w_eg, *w_eu, *w_ed, *g_final;
    float* out; unsigned char* ws; int ph_lo, ph_hi, dup, pad;
};

__device__ __forceinline__ int tid_fresh() { int t = threadIdx.x; asm volatile("" : "+v"(t)); return t; }
__device__ __forceinline__ float bf2f(unsigned b) { return __uint_as_float(b << 16); }
__device__ __forceinline__ unsigned f2bf(float f) { unsigned u = __float_as_uint(f); return (u + 0x7fffu + ((u >> 16) & 1u)) >> 16; }
typedef __bf16 bf16x2_t __attribute__((ext_vector_type(2)));
typedef float f32x2_t __attribute__((ext_vector_type(2)));
__device__ __forceinline__ unsigned pk2(float lo, float hi) { const f32x2_t v = {lo, hi}; return __builtin_bit_cast(unsigned, __builtin_convertvector(v, bf16x2_t)); }
__device__ __forceinline__ float lo16(unsigned w) { return __uint_as_float(w << 16); }
__device__ __forceinline__ float hi16(unsigned w) { return __uint_as_float(w & 0xffff0000u); }
__device__ __forceinline__ float wave_sum(float v) {
#pragma unroll
    for (int o = 1; o < 64; o <<= 1) v += __shfl_xor(v, o);
    return v;
}
__device__ __forceinline__ float sigmoid_f(float x) { return 1.f / (1.f + __expf(-x)); }
__device__ __forceinline__ float silu_f(float x) { return x / (1.f + __expf(-x)); }
__device__ __forceinline__ float softplus_f(float x) { return fmaxf(x, 0.f) + log1pf(__expf(-fabsf(x))); }
__device__ __forceinline__ float logsigmoid_f(float x) { return fminf(x, 0.f) - log1pf(__expf(-fabsf(x))); }
__device__ __forceinline__ void unpack8(u32x4 w, float* f) {
    f[0] = lo16(w.x); f[1] = hi16(w.x); f[2] = lo16(w.y); f[3] = hi16(w.y);
    f[4] = lo16(w.z); f[5] = hi16(w.z); f[6] = lo16(w.w); f[7] = hi16(w.w);
}
__device__ __forceinline__ u32x4 pack8(f32x4 a, f32x4 b) {
    u32x4 w; w.x = pk2(a[0], a[1]); w.y = pk2(a[2], a[3]); w.z = pk2(b[0], b[1]); w.w = pk2(b[2], b[3]); return w;
}
__device__ __forceinline__ int scanrow(int row) {
    if (row < MC) return row;
    const int r = row - MC, b = r >> 12, t = r & 4095;
    return MC + (b << 12) + ((t & 63) << 6) + (t >> 6);
}
__device__ __forceinline__ int modrow(int row) { return row < MC ? 4 : ((row - MC) >> 12); }

struct Unit { const bf16_t* A; const bf16_t* B; const int* tok; int pm, pn; };

__device__ __forceinline__ void tile_order(int L, int nM, int nN, int& pm, int& pn) {
    const int nwg = nM * nN; int wgid = L;
    { const int q = nwg / 8, r = nwg % 8, xcd = wgid % 8, off = wgid / 8; wgid = (xcd < r ? xcd * (q + 1) : r * (q + 1) + (xcd - r) * q) + off; }
    const int nig = 8 * nN, gid = wgid / nig, fm = gid * 8, gsz = (nM - fm) < 8 ? (nM - fm) : 8;
    pm = fm + ((wgid % nig) % gsz); pn = (wgid % nig) / gsz;
}
struct SchedGrid {
    const bf16_t* A; const bf16_t* B; int lda, ldb, pm0, nM, nN, G, c;
    __device__ __forceinline__ bool next(int i, Unit& u) const {
        const long L = (long)i * G + c; if (L >= (long)nM * nN) return false;
        int pm, pn; tile_order((int)L, nM, nN, pm, pn); pm += pm0;
        u.pm = pm; u.pn = pn; u.tok = nullptr; u.A = A + (size_t)pm * 256 * lda; u.B = B + (size_t)pn * 256 * ldb; return true;
    }
};
struct SchedPool {
    const bf16_t* A; const bf16_t* B; int pm0, nM, G, c;
    __device__ __forceinline__ bool next(int i, Unit& u) const {
        const long L = (long)i * G + c; if (L >= (long)nM * 4) return false;
        const int pm = pm0 + (int)(L >> 2), g = (int)(L & 3);
        u.pm = pm; u.pn = g; u.tok = nullptr; u.A = A + (size_t)pm * 256 * 3072 + g * 256; u.B = B + (size_t)g * 65536; return true;
    }
};
struct SchedMoe {
    const bf16_t* A; const bf16_t* B; const int* blkexp; const int* tok; int lda, nblk, G, c; size_t bexp_stride, ldb;
    __device__ __forceinline__ bool next(int i, Unit& u) const {
        const long L = (long)i * G + c; if (L >= (long)nblk * 4) return false;
        const int blk = (int)(L >> 2), nt = (int)(L & 3); const int e = blkexp[blk];
        u.pm = blk; u.pn = nt; u.tok = tok ? tok + blk * 256 : nullptr; u.A = tok ? A : A + (size_t)blk * 256 * lda;
        u.B = B + (size_t)e * bexp_stride + (size_t)nt * 256 * ldb; return true;
    }
};

struct EpiInproj {
    unsigned char* ws;
    __device__ __forceinline__ void seg(const Unit& u, int, int r, int c0, f32x4& lo0, f32x4& lo1, f32x4& hi0, f32x4& hi1) const {
        const int row = u.pm * 256 + r, t = u.pn;
        bf16_t* dst; size_t ld; int cb;
        if (t < 4) { dst = (bf16_t*)(ws + WS_BR) + (size_t)row * 3072; cb = t * 256; }
        else if (t < 16) { const int w = (t - 4) >> 2; dst = (bf16_t*)(ws + WS_Q + (size_t)w * 34 * MiB) + (size_t)scanrow(row) * 1024; cb = ((t - 4) & 3) * 256; }
        else if (t < 20) { dst = (bf16_t*)(ws + WS_BR) + (size_t)row * 3072 + 1024; cb = (t - 16) * 256; }
        else if (t < 24) { dst = (bf16_t*)(ws + WS_SX) + (size_t)row * 1024; cb = (t - 20) * 256; }
        else if (t < 28) { dst = (bf16_t*)(ws + WS_BR) + (size_t)row * 3072 + 2048; cb = (t - 24) * 256; }
        else if (t < 30) { dst = (bf16_t*)(ws + WS_SB) + (size_t)row * 512; cb = (t - 28) * 256; }
        else if (t < 32) { dst = (bf16_t*)(ws + WS_SC) + (size_t)row * 512; cb = (t - 30) * 256; }
        else if (t < 44) {
            dst = (bf16_t*)(ws + WS_MG) + (size_t)row * 3072; cb = (t - 32) * 256;
#pragma unroll
            for (int j = 0; j < 4; ++j) { lo0[j] = sigmoid_f(lo0[j]); lo1[j] = sigmoid_f(lo1[j]); hi0[j] = sigmoid_f(hi0[j]); hi1[j] = sigmoid_f(hi1[j]); }
        } else {
            if (c0 < 32) { float* d = (float*)(ws + WS_DT) + (size_t)row * 32 + c0; *(f32x4*)d = lo0; *(f32x4*)(d + 4) = lo1; }
            else if (c0 < 48) { float* d = (float*)(ws + WS_GA) + (size_t)scanrow(row) * 16 + (c0 - 32); *(f32x4*)d = lo0; *(f32x4*)(d + 4) = lo1; }
            return;
        }
        *(u32x4*)(dst + cb + c0) = pack8(lo0, lo1);
        *(u32x4*)(dst + cb + 128 + c0) = pack8(hi0, hi1);
    }
};
struct EpiPool {
    bf16_t* BR;
    __device__ __forceinline__ void seg(const Unit& u, int, int r, int c0, f32x4& lo0, f32x4& lo1, f32x4& hi0, f32x4& hi1) const {
        bf16_t* d = BR + (size_t)(u.pm * 256 + r) * 3072 + u.pn * 256 + c0;
        *(u32x4*)d = pack8(lo0, lo1);
        *(u32x4*)(d + 128) = pack8(hi0, hi1);
    }
};
struct EpiBranch {
    const bf16_t* MG; bf16_t* OUT;
    __device__ __forceinline__ void seg(const Unit& u, int sg, int r, int c0, f32x4& lo0, f32x4& lo1, f32x4& hi0, f32x4& hi1) const {
        const int row = u.pm * 256 + r, col = u.pn * 256 + c0;
        const bf16_t* g = MG + (size_t)row * 3072 + sg * 1024 + col;
        const int nx = sg < 2 ? 1024 : 0;
        const u32x4 ga = *(const u32x4*)g, gb = *(const u32x4*)(g + 128), gc = *(const u32x4*)(g + nx), gd = *(const u32x4*)(g + nx + 128);
        float a[8], b[8], a2[8], b2[8]; unpack8(ga, a); unpack8(gb, b); unpack8(gc, a2); unpack8(gd, b2);
        if (sg < 2) {
#pragma unroll
            for (int j = 0; j < 8; ++j) { a[j] = a[j] * __builtin_amdgcn_rcpf(a2[j]); b[j] = b[j] * __builtin_amdgcn_rcpf(b2[j]); } }
#pragma unroll
        for (int j = 0; j < 4; ++j) { lo0[j] *= a[j]; lo1[j] *= a[4 + j]; hi0[j] *= b[j]; hi1[j] *= b[4 + j]; }
        if (sg == 2) { bf16_t* d = OUT + (size_t)row * 1024 + col; *(u32x4*)d = pack8(lo0, lo1); *(u32x4*)(d + 128) = pack8(hi0, hi1); }
    }
};
struct EpiOut {
    float* XL; const float* mod; const float* x_in; const float* ctx_in; int dup;
    __device__ __forceinline__ void seg(const Unit& u, int, int r, int c0, f32x4& lo0, f32x4& lo1, f32x4& hi0, f32x4& hi1) const {
        const int row = u.pm * 256 + r, col = u.pn * 256 + c0;
        const float* g = mod + modrow(row) * 6144 + 2 * 1024 + col;
        float* x = XL + (size_t)row * 1024 + col;
        const float* rs = x_in ? (row < MC ? ctx_in + (size_t)row * 1024 + col : x_in + (size_t)(row - MC) * 1024 + col) : x;
        const f32x4 x0 = *(const f32x4*)rs, x1 = *(const f32x4*)(rs + 4), x2 = *(const f32x4*)(rs + 128), x3 = *(const f32x4*)(rs + 132);
        const f32x4 g0 = *(const f32x4*)g, g1 = *(const f32x4*)(g + 4), g2 = *(const f32x4*)(g + 128), g3 = *(const f32x4*)(g + 132);
        if (dup) return;
        *(f32x4*)x = x0 + g0 * lo0; *(f32x4*)(x + 4) = x1 + g1 * lo1; *(f32x4*)(x + 128) = x2 + g2 * hi0; *(f32x4*)(x + 132) = x3 + g3 * hi1;
    }
};
struct EpiMoe1 {
    bf16_t* ACT;
    __device__ __forceinline__ void seg(const Unit& u, int, int r, int c0, f32x4& lo0, f32x4& lo1, f32x4& hi0, f32x4& hi1) const {
        const int row = u.pm * 256 + r;
        f32x4 a, b;
#pragma unroll
        for (int j = 0; j < 4; ++j) { a[j] = silu_f(lo0[j]) * hi0[j]; b[j] = silu_f(lo1[j]) * hi1[j]; }
        *(u32x4*)(ACT + (size_t)row * 512 + u.pn * 128 + c0) = pack8(a, b);
    }
};
struct EpiMoe2 {
    bf16_t* Y;
    __device__ __forceinline__ void seg(const Unit& u, int, int r, int c0, f32x4& lo0, f32x4& lo1, f32x4& hi0, f32x4& hi1) const {
        bf16_t* d = Y + (size_t)(u.pm * 256 + r) * 1024 + u.pn * 256 + c0;
        *(u32x4*)d = pack8(lo0, lo1); *(u32x4*)(d + 128) = pack8(hi0, hi1);
    }
};

#define LAS __attribute__((address_space(3)))
typedef short bf16x8 __attribute__((ext_vector_type(8)));
constexpr int HTB = 128 * 64 * 2;
__device__ __forceinline__ int lds_byte(int r, int c) { const int st = (r >> 4) * 2 + (c >> 5), rr = r & 15, cc = c & 31, ob = rr * 64 + cc * 2; return st * 1024 + (ob ^ (((ob >> 9) & 1) << 5)); }
__device__ __forceinline__ void stage_rc(int b, int& R, int& C) { const int st = b / 1024, sb = b % 1024, swz = sb ^ (((sb >> 9) & 1) << 5); R = (st >> 1) * 16 + swz / 64; C = (st & 1) * 32 + (swz % 64) / 2; }
__device__ __forceinline__ int perm32(int rho) { const int n = rho >> 4, i = rho & 15; return 8 * (i >> 2) + 4 * n + (i & 3); }

template <bool GATHER, class Sched, class Epi>
__device__ __forceinline__ void gemm_mfma(LAS unsigned char* lds, const Sched& S, const Epi& E, const int K, const int lda, const int ldb, const int nseg) {
    const int tid = tid_fresh(), wid = __builtin_amdgcn_readfirstlane(tid >> 6), lane = tid & 63, wr = wid >> 2, wc = wid & 3, fr = lane & 15, fq = lane >> 4;
    const int nt = K / 64, tseg = nt / nseg;
    unsigned vA0[2], vA1[2], nA0[2], nA1[2], voffB[2]; int rowA[2], colA[2];
#pragma unroll
    for (int i = 0; i < 2; ++i) { int R, C; stage_rc(tid * 16 + i * 8192, R, C); const int Rb = (R & ~31) + perm32(R & 31);
        rowA[i] = R; colA[i] = C;
        vA0[i] = (unsigned)(R * lda + C) * 2u; vA1[i] = vA0[i] + (unsigned)(128 * lda * 2); nA0[i] = vA0[i]; nA1[i] = vA1[i];
        voffB[i] = (unsigned)(Rb * ldb + C) * 2u; }
    const size_t kstep = 128;
    const size_t hstepB = (size_t)128 * ldb * 2;
    const unsigned ldsw = (unsigned)wid * 1024u;
    const int aoff = lds_byte(wr * 64 + fr, fq * 8), boff = lds_byte(wc * 32 + fr, fq * 8);
#define PG8_SA(b, h) (((b) * 2 + (h)) * HTB)
#define PG8_SB(b, h) ((4 + (b) * 2 + (h)) * HTB)
#define PG8_STAGE(bufoff, gbase, voff) do { _Pragma("unroll") for (int _i = 0; _i < 2; ++_i) \
        __builtin_amdgcn_global_load_lds((const unsigned*)((const char*)(gbase) + (voff)[_i]), (LAS unsigned*)(lds + (bufoff) + ldsw + _i * 8192), 16, 0, 0); } while (0)
#define PG8_LDA(dst, b, h) do { _Pragma("unroll") for (int m = 0; m < 4; ++m) _Pragma("unroll") for (int k = 0; k < 2; ++k) dst[m][k] = *(const LAS bf16x8*)(lds + PG8_SA(b, h) + aoff + m * 2048 + k * 1024); } while (0)
#define PG8_LDB(dst, b, h) do { _Pragma("unroll") for (int n = 0; n < 2; ++n) _Pragma("unroll") for (int k = 0; k < 2; ++k) dst[n][k] = *(const LAS bf16x8*)(lds + PG8_SB(b, h) + boff + n * 2048 + k * 1024); } while (0)
#define PG8_MMA(ai, bj, At, Bt) do { __builtin_amdgcn_s_setprio(1); _Pragma("unroll") for (int m = 0; m < 4; ++m) _Pragma("unroll") for (int n = 0; n < 2; ++n) _Pragma("unroll") for (int k = 0; k < 2; ++k) \
        acc[ai][bj][m][n] = __builtin_amdgcn_mfma_f32_16x16x32_bf16(Bt[n][k], At[m][k], acc[ai][bj][m][n], 0, 0, 0); __builtin_amdgcn_s_setprio(0); } while (0)
#define PG8_WAIT_V(n) asm volatile("s_waitcnt vmcnt(" #n ")" ::: "memory")
#define PG8_WAIT_L(n) asm volatile("s_waitcnt lgkmcnt(" #n ")" ::: "memory")
#define PG8_BAR __builtin_amdgcn_s_barrier()
#define PG8_SCHED __builtin_amdgcn_sched_barrier(0)
#define PG8_EPI(sg) do { _Pragma("unroll") for (int ai = 0; ai < 2; ++ai) _Pragma("unroll") for (int m = 0; m < 4; ++m) { \
        int r_ = ai * 128 + wr * 64 + m * 16 + fr; asm volatile("" : "+v"(r_));     \
        E.seg(cur, (sg), r_, wc * 32 + fq * 8, acc[ai][0][m][0], acc[ai][0][m][1], acc[ai][1][m][0], acc[ai][1][m][1]); } } while (0)
    Unit cur, nxt; int ui = 0;
    if (!S.next(0, cur)) return;
    f32x4 acc[2][2][4][2];
#pragma unroll
    for (int a = 0; a < 2; ++a)
#pragma unroll
        for (int b = 0; b < 2; ++b)
#pragma unroll
            for (int m = 0; m < 4; ++m)
#pragma unroll
                for (int n = 0; n < 2; ++n) acc[a][b][m][n] = (f32x4){0.f, 0.f, 0.f, 0.f};
    bf16x8 At[4][2], B0[2][2], B1[2][2];
    const char* cA = (const char*)cur.A; const char* cB = (const char*)cur.B;
    if (GATHER) {
#pragma unroll
        for (int i = 0; i < 2; ++i) { vA0[i] = (unsigned)(cur.tok[rowA[i]] * lda + colA[i]) * 2u; vA1[i] = (unsigned)(cur.tok[128 + rowA[i]] * lda + colA[i]) * 2u; nA0[i] = vA0[i]; nA1[i] = vA1[i]; }
    }
    PG8_STAGE(PG8_SB(0, 0), cB, voffB); PG8_STAGE(PG8_SA(0, 0), cA, vA0); PG8_STAGE(PG8_SB(0, 1), cB + hstepB, voffB); PG8_STAGE(PG8_SA(0, 1), cA, vA1);
    if (wr == 1) PG8_BAR;
    PG8_WAIT_V(4); PG8_BAR;
    PG8_STAGE(PG8_SB(1, 0), cB + kstep, voffB); PG8_STAGE(PG8_SA(1, 0), cA + kstep, vA0); PG8_STAGE(PG8_SB(1, 1), cB + hstepB + kstep, voffB);
    PG8_WAIT_V(6); PG8_BAR;
    for (;;) {
        const bool has_next = S.next(ui + 1, nxt);
        const char* nA = has_next ? (const char*)nxt.A : cA; const char* nB = has_next ? (const char*)nxt.B : cB;
        if (GATHER) {
            const int* tk = has_next ? nxt.tok : cur.tok;
#pragma unroll
            for (int i = 0; i < 2; ++i) { nA0[i] = (unsigned)(tk[rowA[i]] * lda + colA[i]) * 2u; nA1[i] = (unsigned)(tk[128 + rowA[i]] * lda + colA[i]) * 2u; }
        }
#pragma nounroll
        for (int sg = 0; sg < nseg; ++sg) {
#pragma nounroll
        for (int tt = 0; tt < tseg; tt += 2) {
            const int t = sg * tseg + tt;
            const bool last = (t == nt - 2);
            const char* a1 = cA + (size_t)(t + 1) * kstep;
            const char* a2 = last ? nA : cA + (size_t)(t + 2) * kstep; const char* b2 = last ? nB : cB + (size_t)(t + 2) * kstep;
            const char* a3 = a2 + kstep; const char* b3 = b2 + kstep;
            unsigned w0[2], w1[2];
#pragma unroll
            for (int i = 0; i < 2; ++i) { w0[i] = last ? nA0[i] : vA0[i]; w1[i] = last ? nA1[i] : vA1[i]; }
            PG8_LDB(B0, 0, 0); PG8_SCHED; PG8_LDA(At, 0, 0); PG8_STAGE(PG8_SA(1, 1), a1, vA1);
            PG8_WAIT_L(8); PG8_BAR; PG8_WAIT_L(0); PG8_MMA(0, 0, At, B0); PG8_BAR; PG8_SCHED;
            PG8_LDB(B1, 0, 1); PG8_STAGE(PG8_SB(0, 0), b2, voffB);
            PG8_BAR; PG8_WAIT_L(0); PG8_MMA(0, 1, At, B1); PG8_BAR;
            PG8_LDA(At, 0, 1); PG8_STAGE(PG8_SA(0, 0), a2, w0);
            PG8_BAR; PG8_WAIT_L(0); PG8_MMA(1, 0, At, B0); PG8_BAR; PG8_SCHED;
            PG8_STAGE(PG8_SB(0, 1), b2 + hstepB, voffB);
            PG8_WAIT_V(6); PG8_BAR; PG8_MMA(1, 1, At, B1); PG8_BAR;
            PG8_LDB(B0, 1, 0); PG8_SCHED; PG8_LDA(At, 1, 0); PG8_STAGE(PG8_SA(0, 1), a2, w1);
            PG8_WAIT_L(8); PG8_BAR; PG8_WAIT_L(0); PG8_MMA(0, 0, At, B0); PG8_BAR; PG8_SCHED;
            PG8_LDB(B1, 1, 1); PG8_STAGE(PG8_SB(1, 0), b3, voffB);
            PG8_BAR; PG8_WAIT_L(0); PG8_MMA(0, 1, At, B1); PG8_BAR;
            PG8_LDA(At, 1, 1); PG8_STAGE(PG8_SA(1, 0), a3, w0);
            PG8_BAR; PG8_WAIT_L(0); PG8_MMA(1, 0, At, B0); PG8_BAR; PG8_SCHED;
            PG8_STAGE(PG8_SB(1, 1), b3 + hstepB, voffB);
            PG8_WAIT_V(6); PG8_BAR; PG8_MMA(1, 1, At, B1); PG8_BAR;
        }
        PG8_EPI(sg);
        }
        if (!has_next) break;
#pragma unroll
        for (int a = 0; a < 2; ++a)
#pragma unroll
            for (int b = 0; b < 2; ++b)
#pragma unroll
                for (int m = 0; m < 4; ++m)
#pragma unroll
                    for (int n = 0; n < 2; ++n) acc[a][b][m][n] = (f32x4){0.f, 0.f, 0.f, 0.f};
        cur = nxt; cA = nA; cB = nB; ++ui;
#pragma unroll
        for (int i = 0; i < 2; ++i) { vA0[i] = nA0[i]; vA1[i] = nA1[i]; }
    }
    PG8_WAIT_V(0);
    if (wr == 0) PG8_BAR;
    PG8_BAR;
#undef PG8_SA
#undef PG8_SB
#undef PG8_STAGE
#undef PG8_LDA
#undef PG8_LDB
#undef PG8_MMA
#undef PG8_WAIT_V
#undef PG8_WAIT_L
#undef PG8_BAR
#undef PG8_SCHED
#undef PG8_EPI
}

template <bool GATHER = false, class Sched, class Epi>
__device__ __forceinline__ void gemm_run(unsigned char* lds, const Sched& S, const Epi& E, int K, int lda, int ldb, int nseg) {
    __syncthreads();
    gemm_mfma<GATHER>((LAS unsigned char*)lds, S, E, K, lda, ldb, nseg);
    __syncthreads();
}

struct TrDesc { const float* src; const float* cscale; bf16_t* dst; int ld_src, ld_dst, valid; };
__device__ __forceinline__ void tr_load(const TrDesc& d, f32x4 (&v)[16]) {
    if (d.src) {
#pragma unroll
        for (int i = 0; i < 16; ++i) v[i] = *(const f32x4*)(d.src + (size_t)(4 * i) * d.ld_src);
    } else {
#pragma unroll
        for (int i = 0; i < 16; ++i) v[i] = (f32x4){0.f, 0.f, 0.f, 0.f};
    }
}
__device__ __forceinline__ void tr_store(const TrDesc& d, f32x4 (&v)[16], float* scr, int lane) {
    const int c4 = (lane & 15) * 4, kr = lane >> 4;
    if (d.cscale) { const f32x4 s = *(const f32x4*)d.cscale;
#pragma unroll
        for (int i = 0; i < 16; ++i) v[i] = v[i] * s; }
#pragma unroll
    for (int i = 0; i < 16; ++i) { float* q = scr + (kr + 4 * i) * 65 + c4; q[0] = v[i][0]; q[1] = v[i][1]; q[2] = v[i][2]; q[3] = v[i][3]; }
    asm volatile("s_waitcnt lgkmcnt(0)" ::: "memory");
    const int c = lane & 7;
#pragma unroll
    for (int j = 0; j < 8; ++j) { const int n = (lane >> 3) + 8 * j; const float* s = scr + (8 * c) * 65 + n;
        u32x4 o; o.x = pk2(s[0 * 65], s[1 * 65]); o.y = pk2(s[2 * 65], s[3 * 65]); o.z = pk2(s[4 * 65], s[5 * 65]); o.w = pk2(s[6 * 65], s[7 * 65]);
        *(u32x4*)(d.dst + (size_t)n * d.ld_dst + 8 * c) = o; }
    asm volatile("s_waitcnt lgkmcnt(0)" ::: "memory");
}
__device__ __forceinline__ TrDesc tr_desc(const float* W, int ld_src, int srcq, bf16_t* WT, int ld_dst, int n_dst, int kdst0, int k0, int lane, const float* cscale = nullptr) {
    TrDesc d; d.ld_src = ld_src; d.ld_dst = ld_dst; d.valid = 1;
    d.src = srcq >= 0 ? W + (size_t)(k0 + (lane >> 4)) * ld_src + srcq : nullptr;
    d.cscale = (cscale && srcq >= 0) ? cscale + srcq : nullptr;
    d.dst = WT + (size_t)n_dst * ld_dst + kdst0 + k0; return d;
}
constexpr int CV_MIX_ITEMS = 2880 + 64 + 768 + 256;
constexpr int CV_EXP_ITEMS = 32 * 384;
__device__ __forceinline__ TrDesc convert_desc(const Params& p, int le, int lm, int it, int lane) {
    unsigned char* ws = p.ws;
    const int c4 = (lane & 15) * 4;
    if (le >= 0) {
        if (it < CV_EXP_ITEMS) {
            const int e = it / 384, r = it % 384;
            if (r < 256) { const int up = r >> 7, q = r & 127, kb = q >> 3, nb = q & 7; const int c = nb * 64;
                const float* src = (up ? p.w_eu : p.w_eg) + (size_t)(le * 32 + e) * 1024 * 512;
                return tr_desc(src, 512, c + c4, (bf16_t*)(ws + WS_EW1) + (size_t)e * 1048576, 1024, (c >> 7) * 256 + up * 128 + (c & 127), 0, kb * 64, lane); }
            const int q = r - 256, kb = q >> 4, nb = q & 15;
            return tr_desc(p.w_ed + (size_t)(le * 32 + e) * 512 * 1024, 1024, nb * 64 + c4, (bf16_t*)(ws + WS_EW2) + (size_t)e * 524288, 512, nb * 64, 0, kb * 64, lane);
        }
        it -= CV_EXP_ITEMS;
    }
    const int l = lm;
    if (it < 2880) { const int R = it >> 4, kb = it & 15, dstn = R * 64; int srcq;
        if (R < 80) srcq = dstn + c4; else if (R < 128) srcq = dstn + 16 + c4; else if (R < 176) srcq = dstn + 48 + c4;
        else if (R == 176) srcq = c4 < 32 ? 8208 + c4 : (c4 < 48 ? 5120 + (c4 - 32) : -1); else srcq = -1;
        return tr_desc(p.w_in + (size_t)l * 1024 * DIN, DIN, srcq, (bf16_t*)(ws + WS_WIN), 1024, dstn, 0, kb * 64, lane); }
    it -= 2880;
    if (it < 64) { const int g = it >> 4, r = it & 15, kb = r >> 2, nb = r & 3;
        return tr_desc(p.pool_w + (size_t)(l * 4 + g) * 65536, 256, nb * 64 + c4, (bf16_t*)(ws + WS_WPOOL) + (size_t)g * 65536, 256, nb * 64, 0, kb * 64, lane, p.pool_scale + l * 1024 + g * 256); }
    it -= 64;
    if (it < 768) { const int br = it >> 8, r = it & 255, kb = r >> 4, nb = r & 15;
        return tr_desc(p.w_branch + (size_t)(l * 3 + br) * 1048576, 1024, nb * 64 + c4, (bf16_t*)(ws + WS_WBR), 3072, nb * 64, br * 1024, kb * 64, lane); }
    it -= 768;
    { const int kb = it >> 4, nb = it & 15;
      return tr_desc(p.w_out + (size_t)l * 1048576, 1024, nb * 64 + c4, (bf16_t*)(ws + WS_WOUT), 1024, nb * 64, 0, kb * 64, lane); }
}
__device__ __forceinline__ void convert_run(const Params& p, int le, int lm, int first, int step, float* scr, int lane) {
    const int nitems = (le >= 0 ? CV_EXP_ITEMS : 0) + (lm >= 0 ? CV_MIX_ITEMS : 0);
    if (first >= nitems) return;
    f32x4 va[16], vb[16];
    TrDesc da = convert_desc(p, le, lm, first, lane), db;
    tr_load(da, va);
    for (int it = first; it < nitems; it += 2 * step) {
        const int i1 = it + step, i2 = it + 2 * step;
        if (i1 < nitems) { db = convert_desc(p, le, lm, i1, lane); tr_load(db, vb); }
        tr_store(da, va, scr, lane);
        if (i1 >= nitems) break;
        if (i2 < nitems) { da = convert_desc(p, le, lm, i2, lane); tr_load(da, va); }
        tr_store(db, vb, scr, lane);
    }
}

__device__ __forceinline__ void phase_pre(const Params& p, unsigned char* ldsb, int bid, int nb) {
    float* lds = reinterpret_cast<float*>(ldsb);
    const int tid = tid_fresh(), lane = tid & 63, wave = tid >> 6;
    for (int i = tid; i < 5 * 1024; i += NTHR) { const float v = i < 4096 ? p.c[i] : p.c_ctx[i - 4096]; lds[i] = silu_f(v); }
    __syncthreads();
    float* red = lds + 5120;
    for (int it = bid; it < 2 * 96; it += nb) {
        const int l = it / 96, j = (it % 96) * 64 + lane;
        const float* w = p.w_ada + (size_t)l * 1024 * 6144 + j;
        float a0 = 0, a1 = 0, a2 = 0, a3 = 0, a4 = 0;
        for (int k = wave * 128; k < wave * 128 + 128; ++k) { const float wv = w[(size_t)k * 6144];
            a0 += lds[k] * wv; a1 += lds[1024 + k] * wv; a2 += lds[2048 + k] * wv; a3 += lds[3072 + k] * wv; a4 += lds[4096 + k] * wv; }
        red[(wave * 5 + 0) * 64 + lane] = a0; red[(wave * 5 + 1) * 64 + lane] = a1; red[(wave * 5 + 2) * 64 + lane] = a2;
        red[(wave * 5 + 3) * 64 + lane] = a3; red[(wave * 5 + 4) * 64 + lane] = a4;
        __syncthreads();
        if (tid < 320) { const int r = tid >> 6, jj = tid & 63; float s = 0;
            for (int w8 = 0; w8 < 8; ++w8) s += red[(w8 * 5 + r) * 64 + jj];
            const int col = (it % 96) * 64 + jj;
            ((float*)(p.ws + WS_MOD))[(size_t)(l * 5 + r) * 6144 + col] = s + p.b_ada[l * 6144 + col]; }
        __syncthreads();
    }
    __syncthreads();
    float* scr = lds + wave * (64 * 65);
    convert_run(p, -1, 0, bid * 8 + wave, nb * 8, scr, lane);
}

__device__ __forceinline__ void norm_mod_row(f32x4 (&v)[4], const float* g, const float* shift, const float* scale, int lane) {
    float s = 0.f;
#pragma unroll
    for (int j = 0; j < 4; ++j) s += (v[j][0] * v[j][0] + v[j][1] * v[j][1]) + (v[j][2] * v[j][2] + v[j][3] * v[j][3]);
    const float rs = 1.0f / sqrtf(wave_sum(s) * (1.f / 1024.f) + EPS);
#pragma unroll
    for (int j = 0; j < 4; ++j) { const int c = 4 * lane + 256 * j; const f32x4 gg = *(const f32x4*)(g + c);
        f32x4 y = v[j] * rs * gg;
        if (shift) { const f32x4 sh = *(const f32x4*)(shift + c), sc = *(const f32x4*)(scale + c); y = y * (1.f + sc) + sh; }
        v[j] = y; }
}
__device__ __forceinline__ void store_row_bf16(bf16_t* dst, const f32x4 (&v)[4], int lane) {
#pragma unroll
    for (int j = 0; j < 4; ++j) { u32x2 w; w.x = pk2(v[j][0], v[j][1]); w.y = pk2(v[j][2], v[j][3]); *(u32x2*)(dst + 4 * lane + 256 * j) = w; }
}

__device__ __forceinline__ void phase_norm1(const Params& p, int bid, int nb) {
    const int lane = tid_fresh() & 63, wave = tid_fresh() >> 6;
    const float* mod = (const float*)(p.ws + WS_MOD);
    const int stride = nb * 8;
    int m = bid * 8 + wave;
    f32x4 v[4], w[4];
    if (m < MT) { const float* src = m < MC ? p.ctx + (size_t)m * 1024 : p.x + (size_t)(m - MC) * 1024;
#pragma unroll
        for (int j = 0; j < 4; ++j) v[j] = *(const f32x4*)(src + 4 * lane + 256 * j); }
    for (; m < MT; m += stride) {
        const int mn = m + stride;
        if (mn < MT) { const float* src = mn < MC ? p.ctx + (size_t)mn * 1024 : p.x + (size_t)(mn - MC) * 1024;
#pragma unroll
            for (int j = 0; j < 4; ++j) w[j] = *(const f32x4*)(src + 4 * lane + 256 * j); }
        const float* mr = mod + modrow(m) * 6144;
        norm_mod_row(v, p.g_mix, mr, mr + 1024, lane);
        store_row_bf16((bf16_t*)(p.ws + WS_H) + (size_t)m * 1024, v, lane);
#pragma unroll
        for (int j = 0; j < 4; ++j) v[j] = w[j];
    }
}

__device__ __forceinline__ float wave_incl_sum(float v, int lane) {
#pragma unroll
    for (int o = 1; o < 64; o <<= 1) { const float u = __shfl_up(v, o); if (lane >= o) v += u; }
    return v;
}
__device__ __forceinline__ float wave_incl_max(float v, int lane) {
#pragma unroll
    for (int o = 1; o < 64; o <<= 1) { const float u = __shfl_up(v, o); if (lane >= o) v = fmaxf(v, u); }
    return v;
}
__device__ __forceinline__ u32x2 pack4(f32x4 a) { u32x2 w; w.x = pk2(a[0], a[1]); w.y = pk2(a[2], a[3]); return w; }

__device__ __forceinline__ void chunk_geom(int gc, int& rbase, int& n0, int& len) {
    const int b = gc / 68, cin = gc % 68;
    if (cin < 4) { rbase = b * 256; n0 = cin * 64; len = 256; } else { rbase = MC + b * 4096; n0 = (cin - 4) * 64; len = 4096; }
}
__device__ __forceinline__ void conv8x4(const u32x4 (&raw)[7], const float* cw, const float* cb, int ch0, float scale, u32x4 (&out)[4]) {
    float w[4][8], bs[8];
#pragma unroll
    for (int j = 0; j < 4; ++j) { const f32x4 a = *(const f32x4*)(cw + j * 2048 + ch0), b2 = *(const f32x4*)(cw + j * 2048 + ch0 + 4);
#pragma unroll
        for (int i = 0; i < 4; ++i) { w[j][i] = a[i]; w[j][4 + i] = b2[i]; } }
    { const f32x4 a = *(const f32x4*)(cb + ch0), b2 = *(const f32x4*)(cb + ch0 + 4);
#pragma unroll
      for (int i = 0; i < 4; ++i) { bs[i] = a[i]; bs[4 + i] = b2[i]; } }
    float f[7][8];
#pragma unroll
    for (int k = 0; k < 7; ++k) unpack8(raw[k], f[k]);
#pragma unroll
    for (int pp = 0; pp < 4; ++pp) { f32x4 o0, o1;
#pragma unroll
        for (int i = 0; i < 8; ++i) { float a = bs[i];
#pragma unroll
            for (int j = 0; j < 4; ++j) a += w[j][i] * f[pp + j][i];
            a = silu_f(a) * scale; if (i < 4) o0[i] = a; else o1[i - 4] = a; }
        out[pp] = pack8(o0, o1); }
}
__device__ __forceinline__ void load_raw7(const bf16_t* src, size_t ld, int rbase, int tbase, int len, u32x4 (&raw)[7]) {
#pragma unroll
    for (int k = 0; k < 7; ++k) { const int t = tbase + k; const bool ok = (t >= 0) && (t < len); const int tc = t < 0 ? 0 : (t >= len ? len - 1 : t);
        u32x4 a = *(const u32x4*)(src + (size_t)(rbase + tc) * ld);
        if (!ok) a = (u32x4){0u, 0u, 0u, 0u};
        raw[k] = a; }
}
template <class F>
__device__ __forceinline__ void tile_transpose_out(const LAS bf16_t* tile, int ldsw, int ncol, int tid, F rowptr) {
    for (int q = tid; q < ncol * 8; q += NTHR) { const int c = q % ncol, sc = q / ncol;
        unsigned v[8];
#pragma unroll
        for (int i = 0; i < 8; ++i) v[i] = tile[(sc * 8 + i) * ldsw + c];
        u32x4 w; w.x = v[0] | (v[1] << 16); w.y = v[2] | (v[3] << 16); w.z = v[4] | (v[5] << 16); w.w = v[6] | (v[7] << 16);
        *(u32x4*)(rowptr(c) + sc * 8) = w; }
}

__device__ __forceinline__ void conv_m_item(const Params& p, int l, int item, LAS unsigned char* lds) {
    const int tid = tid_fresh(), gc = item >> 2, hd = item & 3;
    int rbase, n0, len; chunk_geom(gc, rbase, n0, len);
    const int cs = tid & 31, tg = tid >> 5, d0 = cs * 8, i0 = tg * 4;
    const float* cw = p.mconv_w + (size_t)l * 4 * 2048; const float* cb = p.mconv_b + (size_t)l * 2048;
    LAS bf16_t* Kl = (LAS bf16_t*)lds; LAS bf16_t* Vl = (LAS bf16_t*)(lds + 64 * 528);
    __syncthreads();
    { u32x4 raw[7], o[4];
      load_raw7((const bf16_t*)(p.ws + WS_Q) + hd * 256 + d0, 1024, rbase, n0 + i0 - 2, len, raw);
      conv8x4(raw, cw, cb, hd * 256 + d0, 1.0f, o);
#pragma unroll
      for (int pp = 0; pp < 4; ++pp) *(u32x4*)((bf16_t*)(p.ws + WS_QC) + (size_t)(rbase + n0 + i0 + pp) * 1024 + hd * 256 + d0) = o[pp];
      load_raw7((const bf16_t*)(p.ws + WS_K) + hd * 256 + d0, 1024, rbase, n0 + i0 - 2, len, raw);
      conv8x4(raw, cw, cb, 1024 + hd * 256 + d0, 0.0625f, o);
#pragma unroll
      for (int pp = 0; pp < 4; ++pp) { *(u32x4*)((bf16_t*)(p.ws + WS_KC) + (size_t)(rbase + n0 + i0 + pp) * 1024 + hd * 256 + d0) = o[pp];
          *(LAS u32x4*)((LAS unsigned char*)Kl + (i0 + pp) * 528 + d0 * 2) = o[pp]; } }
#pragma unroll
    for (int j = 0; j < 4; ++j) { const int q = tid + NTHR * j, row = q >> 5, ch = q & 31;
        *(LAS u32x4*)((LAS unsigned char*)Vl + row * 528 + ch * 16) = *(const u32x4*)((const bf16_t*)(p.ws + WS_V) + (size_t)(rbase + n0 + row) * 1024 + hd * 256 + ch * 8); }
    __syncthreads();
    bf16_t* kct = (bf16_t*)(p.ws + WS_KCT) + (size_t)(gc * 4 + hd) * 16384; bf16_t* vt = (bf16_t*)(p.ws + WS_VT) + (size_t)(gc * 4 + hd) * 16384;
    tile_transpose_out(Kl, 264, 256, tid, [&](int c) { return kct + c * 64; });
    tile_transpose_out(Vl, 264, 256, tid, [&](int c) { return vt + c * 64; });
}

__device__ __forceinline__ void conv_s_item(const Params& p, int l, int item, LAS unsigned char* lds) {
    const int tid = tid_fresh(), gc = item >> 2, grp = item & 3;
    int rbase, n0, len; chunk_geom(gc, rbase, n0, len);
    const int cs = tid & 31, tg = tid >> 5, i0 = tg * 4;
    const float* cw = p.sconv_w + (size_t)l * 4 * 2048; const float* cb = p.sconv_b + (size_t)l * 2048;
    LAS bf16_t* Bl = (LAS bf16_t*)lds; LAS bf16_t* Xl = (LAS bf16_t*)(lds + 64 * 272);
    __syncthreads();
    { u32x4 raw[7], o[4];
      const int isC = cs >> 4, nn = (cs & 15) * 8;
      load_raw7((const bf16_t*)(p.ws + (isC ? WS_SC : WS_SB)) + grp * 128 + nn, 512, rbase, n0 + i0 - 2, len, raw);
      conv8x4(raw, cw, cb, 1024 + isC * 512 + grp * 128 + nn, 1.0f, o);
      bf16_t* dst = (bf16_t*)(p.ws + (isC ? WS_CC : WS_BC)) + grp * 128 + nn;
#pragma unroll
      for (int pp = 0; pp < 4; ++pp) { *(u32x4*)(dst + (size_t)(rbase + n0 + i0 + pp) * 512) = o[pp];
          if (!isC) *(LAS u32x4*)((LAS unsigned char*)Bl + (i0 + pp) * 272 + nn * 2) = o[pp]; }
      load_raw7((const bf16_t*)(p.ws + WS_SX) + grp * 256 + cs * 8, 1024, rbase, n0 + i0 - 2, len, raw);
      conv8x4(raw, cw, cb, grp * 256 + cs * 8, 1.0f, o);
#pragma unroll
      for (int pp = 0; pp < 4; ++pp) *(LAS u32x4*)((LAS unsigned char*)Xl + (i0 + pp) * 528 + cs * 16) = o[pp]; }
    __syncthreads();
    bf16_t* bct = (bf16_t*)(p.ws + WS_BCT) + (size_t)(gc * 4 + grp) * 8192; bf16_t* xct = (bf16_t*)(p.ws + WS_XCT) + (size_t)(gc * 16 + grp * 4) * 4096;
    tile_transpose_out(Bl, 136, 128, tid, [&](int c) { return bct + c * 64; });
    tile_transpose_out(Xl, 264, 256, tid, [&](int c) { return xct + c * 64; });
}

__device__ __forceinline__ void pool_window_item(const Params& p, int it, LAS unsigned char* lds) {
    const int tid = tid_fresh();
    bf16_t* BR = (bf16_t*)(p.ws + WS_BR);
    __syncthreads();
    if (it < 256) {
        const int row0 = MC + it * 64;
        for (int q = tid; q < 64 * 128; q += NTHR) { const int r = q >> 7, ch = q & 127;
            *(LAS u32x4*)(lds + q * 16) = *(const u32x4*)(BR + (size_t)(row0 + r) * 3072 + ch * 8); }
        __syncthreads();
        for (int q = tid; q < 64 * 128; q += NTHR) { const int r = q >> 7, ch = q & 127, w = 2 << (ch >> 5);
            int lo = r - (w >> 1), hi = lo + w - 1; lo = lo < 0 ? 0 : lo; hi = hi > 63 ? 63 : hi;
            float s[8] = {0, 0, 0, 0, 0, 0, 0, 0}, self[8];
            for (int rr = lo; rr <= hi; ++rr) { float f[8]; unpack8(*(const LAS u32x4*)(lds + (rr * 128 + ch) * 16), f);
#pragma unroll
                for (int j = 0; j < 8; ++j) s[j] += f[j]; }
            unpack8(*(const LAS u32x4*)(lds + q * 16), self);
            const float inv = 1.f / (float)(hi - lo + 1); f32x4 a, b;
#pragma unroll
            for (int j = 0; j < 4; ++j) { a[j] = s[j] * inv - self[j]; b[j] = s[4 + j] * inv - self[4 + j]; }
            *(u32x4*)(BR + (size_t)(row0 + r) * 3072 + ch * 8) = pack8(a, b); }
    } else {
        const int bb = (it - 256) >> 2, g = (it - 256) & 3, row0 = bb * 256, w = 2 << g;
        for (int q = tid; q < 256 * 32; q += NTHR) { const int r = q >> 5, ch = q & 31;
            *(LAS u32x4*)(lds + q * 16) = *(const u32x4*)(BR + (size_t)(row0 + r) * 3072 + g * 256 + ch * 8); }
        __syncthreads();
        for (int q = tid; q < 256 * 32; q += NTHR) { const int r = q >> 5, ch = q & 31;
            int lo = r - (w >> 1), hi = lo + w - 1; lo = lo < 0 ? 0 : lo; hi = hi > 255 ? 255 : hi;
            float s[8] = {0, 0, 0, 0, 0, 0, 0, 0}, self[8];
            for (int rr = lo; rr <= hi; ++rr) { float f[8]; unpack8(*(const LAS u32x4*)(lds + (rr * 32 + ch) * 16), f);
#pragma unroll
                for (int j = 0; j < 8; ++j) s[j] += f[j]; }
            unpack8(*(const LAS u32x4*)(lds + q * 16), self);
            const float inv = 1.f / (float)(hi - lo + 1); f32x4 a, b;
#pragma unroll
            for (int j = 0; j < 4; ++j) { a[j] = s[j] * inv - self[j]; b[j] = s[4 + j] * inv - self[4 + j]; }
            *(u32x4*)(BR + (size_t)(row0 + r) * 3072 + g * 256 + ch * 8) = pack8(a, b); }
    }
    __syncthreads();
}

constexpr int ML_VT = 0, ML_VWT = 5280, ML_CT = 10560, ML_Q = 28512, ML_K = 63328, ML_KT = 98144, ML_A = 139104, ML_MISC = 149344;
__device__ __forceinline__ void mlstm_chunk_item(const Params& p, int l, int item, LAS unsigned char* lds) {
    const int tid = tid_fresh(), lane = tid & 63, wid = __builtin_amdgcn_readfirstlane(tid >> 6), fr = lane & 15, fq = lane >> 4;
    const int b = item >> 6, hd = (item >> 4) & 3, dir = (item >> 3) & 1, eg = item & 7;
    const bf16_t* QC = (const bf16_t*)(p.ws + WS_QC); const bf16_t* KC = (const bf16_t*)(p.ws + WS_KC);
    const bf16_t* KCT = (const bf16_t*)(p.ws + WS_KCT); const bf16_t* VT = (const bf16_t*)(p.ws + WS_VT);
    const float* GA = (const float*)(p.ws + WS_GA);
    bf16_t* OUT = (bf16_t*)(p.ws + (dir ? WS_HB2 : WS_HF2));
    LAS float* misc = (LAS float*)(lds + ML_MISC);
    const float gb_i = p.mgate_b[l * 16 + dir * 4 + hd], gb_f = p.mgate_b[l * 16 + (2 + dir) * 4 + hd];
    const int ti = wid >> 1, wh = wid & 1;
    __syncthreads();
    for (int i = tid; i < 17952 / 4; i += NTHR) ((LAS unsigned*)(lds + ML_CT))[i] = 0u;
    if (tid < 64) ((LAS bf16_t*)(lds + ML_VT + 32 * 160))[tid] = (bf16_t)0x3F80;
    f32x4 Cacc[2][3];
#pragma unroll
    for (int j = 0; j < 2; ++j)
#pragma unroll
        for (int e = 0; e < 3; ++e) Cacc[j][e] = (f32x4){0.f, 0.f, 0.f, 0.f};
    float m_st = 0.f;
    __syncthreads();
    for (int c = -1; c < 68; ++c) {
        const int cn = c + 1;
        u32x4 rq[4], rk[4], rt[4], rv = (u32x4){0u, 0u, 0u, 0u}; float g_i = 0.f, g_f = 0.f;
#pragma unroll
        for (int j = 0; j < 4; ++j) { rq[j] = (u32x4){0u, 0u, 0u, 0u}; rk[j] = rq[j]; rt[j] = rq[j]; }
        if (cn < 68) {
            const int cin = cn < 4 ? (dir ? 3 - cn : cn) : 4 + (dir ? 67 - cn : cn - 4), gc = b * 68 + cin;
            int rbase, n0, len; chunk_geom(gc, rbase, n0, len);
#pragma unroll
            for (int j = 0; j < 4; ++j) { const int q = tid + NTHR * j;
                const size_t ro = (size_t)(rbase + n0 + (q >> 5)) * 1024 + hd * 256 + (q & 31) * 8;
                rq[j] = *(const u32x4*)(QC + ro); rk[j] = *(const u32x4*)(KC + ro);
                rt[j] = *(const u32x4*)(KCT + (size_t)(gc * 4 + hd) * 16384 + (size_t)q * 8); }
            if (tid < 256) rv = *(const u32x4*)(VT + ((size_t)(gc * 4 + hd) * 256 + eg * 32) * 64 + (size_t)tid * 8);
            { const int j = dir ? 63 - lane : lane; const float* g = GA + (size_t)(rbase + n0 + j) * 16; g_i = g[dir * 4 + hd]; g_f = g[(2 + dir) * 4 + hd]; }
        }
        if (c >= 0) {
            const int cin = c < 4 ? (dir ? 3 - c : c) : 4 + (dir ? 67 - c : c - 4), gc = b * 68 + cin;
            int rbase, n0, len; chunk_geom(gc, rbase, n0, len);
            {
                f32x4 st[2] = {(f32x4){0.f, 0.f, 0.f, 0.f}, (f32x4){0.f, 0.f, 0.f, 0.f}};
                const LAS unsigned char* qb = lds + ML_Q + (16 * ti + fr) * 544 + fq * 16;
                const LAS unsigned char* kb0 = lds + ML_K + (16 * (2 * wh) + fr) * 544 + fq * 16;
#pragma unroll
                for (int kd = 0; kd < 8; ++kd) {
                    const bf16x8 qf = *(const LAS bf16x8*)(qb + kd * 64);
                    const bf16x8 k0 = *(const LAS bf16x8*)(kb0 + kd * 64), k1 = *(const LAS bf16x8*)(kb0 + 16 * 544 + kd * 64);
                    st[0] = __builtin_amdgcn_mfma_f32_16x16x32_bf16(k0, qf, st[0], 0, 0, 0);
                    st[1] = __builtin_amdgcn_mfma_f32_16x16x32_bf16(k1, qf, st[1], 0, 0, 0);
                }
                const int t = 16 * ti + fr; const float Mt = misc[64 + t];
#pragma unroll
                for (int j = 0; j < 2; ++j) { const int s0 = 16 * (2 * wh + j) + 4 * fq; const f32x4 av = *(const LAS f32x4*)(misc + s0);
                    f32x4 o;
#pragma unroll
                    for (int r = 0; r < 4; ++r) { const bool keep = dir ? (s0 + r >= t) : (s0 + r <= t); o[r] = keep ? st[j][r] * __expf(av[r] - Mt) : 0.f; }
                    *(LAS u32x2*)(lds + ML_A + t * 160 + s0 * 2) = pack4(o); }
                { const int e = tid >> 4, s4 = (tid & 15) * 4; const u32x2 v = *(const LAS u32x2*)(lds + ML_VT + e * 160 + s4 * 2); const f32x4 w = *(const LAS f32x4*)(misc + 256 + s4);
                  f32x4 o; o[0] = lo16(v.x) * w[0]; o[1] = hi16(v.x) * w[1]; o[2] = lo16(v.y) * w[2]; o[3] = hi16(v.y) * w[3];
                  *(LAS u32x2*)(lds + ML_VWT + e * 160 + s4 * 2) = pack4(o);
                  if (tid < 16) *(LAS u32x2*)(lds + ML_VWT + 32 * 160 + s4 * 2) = pack4(w); }
            }
            __syncthreads();
            {
                f32x4 n1o = (f32x4){0.f, 0.f, 0.f, 0.f}, n1a = n1o, n2o = n1o, n2a = n1o;
                const LAS unsigned char* ab = lds + ML_A + (16 * ti + fr) * 160 + fq * 16;
                const LAS unsigned char* vo = lds + ML_VT + (16 * wh + fr) * 160 + fq * 16;
                const LAS unsigned char* va = lds + ML_VT + (32 + fr) * 160 + fq * 16;
#pragma unroll
                for (int ks = 0; ks < 2; ++ks) { const bf16x8 af = *(const LAS bf16x8*)(ab + ks * 64);
                    n1o = __builtin_amdgcn_mfma_f32_16x16x32_bf16(af, *(const LAS bf16x8*)(vo + ks * 64), n1o, 0, 0, 0);
                    n1a = __builtin_amdgcn_mfma_f32_16x16x32_bf16(af, *(const LAS bf16x8*)(va + ks * 64), n1a, 0, 0, 0); }
                const LAS unsigned char* qb = lds + ML_Q + (16 * ti + fr) * 544 + fq * 16;
                const LAS unsigned char* co = lds + ML_CT + (16 * wh + fr) * 544 + fq * 16;
                const LAS unsigned char* ca = lds + ML_CT + (32 + fr) * 544 + fq * 16;
#pragma unroll
                for (int kd = 0; kd < 8; ++kd) { const bf16x8 qf = *(const LAS bf16x8*)(qb + kd * 64);
                    n2o = __builtin_amdgcn_mfma_f32_16x16x32_bf16(qf, *(const LAS bf16x8*)(co + kd * 64), n2o, 0, 0, 0);
                    n2a = __builtin_amdgcn_mfma_f32_16x16x32_bf16(qf, *(const LAS bf16x8*)(ca + kd * 64), n2a, 0, 0, 0); }
                const int t0 = 16 * ti + 4 * fq;
                const f32x4 sgv = *(const LAS f32x4*)(misc + 128 + t0), emv = *(const LAS f32x4*)(misc + 192 + t0);
                const bool wr_out = !(l == 1 && cin < 4);
#pragma unroll
                for (int r = 0; r < 4; ++r) {
                    const float den = __shfl(n1a[r] + sgv[r] * n2a[r], lane & 48);
                    const float hv = (n1o[r] + sgv[r] * n2o[r]) / fmaxf(fabsf(den), emv[r]);
                    if (wr_out) OUT[(size_t)(rbase + n0 + t0 + r) * 1024 + hd * 256 + eg * 32 + 16 * wh + fr] = (bf16_t)f2bf(hv);
                }
                const float decay = misc[320];
#pragma unroll
                for (int j = 0; j < 2; ++j)
#pragma unroll
                    for (int e = 0; e < 3; ++e) Cacc[j][e] = Cacc[j][e] * decay;
                const LAS unsigned char* kt = lds + ML_KT + (16 * (2 * wid) + fr) * 160 + fq * 16;
                const LAS unsigned char* vw = lds + ML_VWT + fr * 160 + fq * 16;
#pragma unroll
                for (int ks = 0; ks < 2; ++ks) {
                    const bf16x8 k0 = *(const LAS bf16x8*)(kt + ks * 64), k1 = *(const LAS bf16x8*)(kt + 16 * 160 + ks * 64);
                    const bf16x8 v0 = *(const LAS bf16x8*)(vw + ks * 64), v1 = *(const LAS bf16x8*)(vw + 16 * 160 + ks * 64), v2 = *(const LAS bf16x8*)(vw + 32 * 160 + ks * 64);
                    Cacc[0][0] = __builtin_amdgcn_mfma_f32_16x16x32_bf16(k0, v0, Cacc[0][0], 0, 0, 0);
                    Cacc[0][1] = __builtin_amdgcn_mfma_f32_16x16x32_bf16(k0, v1, Cacc[0][1], 0, 0, 0);
                    Cacc[0][2] = __builtin_amdgcn_mfma_f32_16x16x32_bf16(k0, v2, Cacc[0][2], 0, 0, 0);
                    Cacc[1][0] = __builtin_amdgcn_mfma_f32_16x16x32_bf16(k1, v0, Cacc[1][0], 0, 0, 0);
                    Cacc[1][1] = __builtin_amdgcn_mfma_f32_16x16x32_bf16(k1, v1, Cacc[1][1], 0, 0, 0);
                    Cacc[1][2] = __builtin_amdgcn_mfma_f32_16x16x32_bf16(k1, v2, Cacc[1][2], 0, 0, 0);
                }
            }
            __syncthreads();
#pragma unroll
            for (int j = 0; j < 2; ++j) { const int dcol = (16 * (2 * wid + j) + 4 * fq) * 2;
                *(LAS u32x2*)(lds + ML_CT + fr * 544 + dcol) = pack4(Cacc[j][0]);
                *(LAS u32x2*)(lds + ML_CT + (16 + fr) * 544 + dcol) = pack4(Cacc[j][1]);
                if (fr == 0) *(LAS u32x2*)(lds + ML_CT + 32 * 544 + dcol) = pack4(Cacc[j][2]); }
        }
        if (cn < 68) {
#pragma unroll
            for (int j = 0; j < 4; ++j) { const int q = tid + NTHR * j;
                *(LAS u32x4*)(lds + ML_Q + (q >> 5) * 544 + (q & 31) * 16) = rq[j];
                *(LAS u32x4*)(lds + ML_K + (q >> 5) * 544 + (q & 31) * 16) = rk[j];
                *(LAS u32x4*)(lds + ML_KT + (q >> 3) * 160 + (q & 7) * 16) = rt[j]; }
            if (tid < 256) *(LAS u32x4*)(lds + ML_VT + (tid >> 3) * 160 + (tid & 7) * 16) = rv;
            if (wid == 0) {
                const int j = dir ? 63 - lane : lane;
                const float ig = g_i + gb_i, lf = logsigmoid_f(g_f + gb_f);
                const float cum = wave_incl_sum(lf, lane), a = ig - cum, pm = wave_incl_max(a, lane);
                const float M = fmaxf(m_st, pm), sg = __expf(m_st - M), mt = cum + M;
                const float M63 = __shfl(M, 63), cum63 = __shfl(cum, 63);
                misc[j] = a; misc[64 + j] = M; misc[128 + j] = sg; misc[192 + j] = __expf(-mt); misc[256 + j] = __expf(a - M63);
                if (lane == 0) misc[320] = __expf(m_st - M63);
                m_st = cum63 + M63;
            }
        }
        __syncthreads();
    }
}

constexpr int SS_C = 0, SS_B = 18432, SS_BT = 36864, SS_XT = 57344, SS_XWT = 62464, SS_G = 67584, SS_S = 77824, SS_XRT = 87040, SS_MISC = 92160;
__device__ __forceinline__ void ssd_chunk_item(const Params& p, int l, int item, LAS unsigned char* lds) {
    const int tid = tid_fresh(), lane = tid & 63, wid = __builtin_amdgcn_readfirstlane(tid >> 6), fr = lane & 15, fq = lane >> 4;
    const int b = item >> 6, hd = (item >> 2) & 15, dir = (item >> 1) & 1, ps = item & 1, grp = hd >> 2;
    const bf16_t* BC = (const bf16_t*)(p.ws + WS_BC); const bf16_t* CC = (const bf16_t*)(p.ws + WS_CC);
    const bf16_t* BCT = (const bf16_t*)(p.ws + WS_BCT); const bf16_t* XCT = (const bf16_t*)(p.ws + WS_XCT);
    const float* DT = (const float*)(p.ws + WS_DT);
    bf16_t* OUT = (bf16_t*)(p.ws + (dir ? WS_YB : WS_YF));
    LAS float* misc = (LAS float*)(lds + SS_MISC);
    const float dtb = p.sdt_bias[l * 32 + dir * 16 + hd], aneg = -__expf(p.sa_log[l * 32 + dir * 16 + hd]), dskip = p.sd[l * 16 + hd];
    const int ti = wid >> 1, wh = wid & 1;
    __syncthreads();
    for (int i = tid; i < 9216 / 4; i += NTHR) ((LAS unsigned*)(lds + SS_S))[i] = 0u;
    f32x4 Sacc[2] = {(f32x4){0.f, 0.f, 0.f, 0.f}, (f32x4){0.f, 0.f, 0.f, 0.f}};
    __syncthreads();
    for (int c = -1; c < 68; ++c) {
        const int cn = c + 1;
        u32x4 rc[2], rb[2], rt[2], rx = (u32x4){0u, 0u, 0u, 0u}; float dtraw = 0.f;
#pragma unroll
        for (int j = 0; j < 2; ++j) { rc[j] = (u32x4){0u, 0u, 0u, 0u}; rb[j] = rc[j]; rt[j] = rc[j]; }
        if (cn < 68) {
            const int cin = cn < 4 ? (dir ? 3 - cn : cn) : 4 + (dir ? 67 - cn : cn - 4), gc = b * 68 + cin;
            int rbase, n0, len; chunk_geom(gc, rbase, n0, len);
#pragma unroll
            for (int j = 0; j < 2; ++j) { const int q = tid + NTHR * j;
                const size_t ro = (size_t)(rbase + n0 + (q >> 4)) * 512 + grp * 128 + (q & 15) * 8;
                rc[j] = *(const u32x4*)(CC + ro); rb[j] = *(const u32x4*)(BC + ro);
                rt[j] = *(const u32x4*)(BCT + (size_t)(gc * 4 + grp) * 8192 + (size_t)q * 8); }
            if (tid < 256) rx = *(const u32x4*)(XCT + ((size_t)(gc * 16 + hd) * 64 + ps * 32) * 64 + (size_t)tid * 8);
            { const int j = dir ? 63 - lane : lane; dtraw = DT[(size_t)(rbase + n0 + j) * 32 + dir * 16 + hd]; }
        }
        if (c >= 0) {
            const int cin = c < 4 ? (dir ? 3 - c : c) : 4 + (dir ? 67 - c : c - 4), gc = b * 68 + cin;
            int rbase, n0, len; chunk_geom(gc, rbase, n0, len);
            {
                f32x4 st[2] = {(f32x4){0.f, 0.f, 0.f, 0.f}, (f32x4){0.f, 0.f, 0.f, 0.f}};
                const LAS unsigned char* cbp = lds + SS_C + (16 * ti + fr) * 288 + fq * 16;
                const LAS unsigned char* bb0 = lds + SS_B + (16 * (2 * wh) + fr) * 288 + fq * 16;
#pragma unroll
                for (int kn = 0; kn < 4; ++kn) {
                    const bf16x8 cf = *(const LAS bf16x8*)(cbp + kn * 64);
                    const bf16x8 b0 = *(const LAS bf16x8*)(bb0 + kn * 64), b1 = *(const LAS bf16x8*)(bb0 + 16 * 288 + kn * 64);
                    st[0] = __builtin_amdgcn_mfma_f32_16x16x32_bf16(b0, cf, st[0], 0, 0, 0);
                    st[1] = __builtin_amdgcn_mfma_f32_16x16x32_bf16(b1, cf, st[1], 0, 0, 0);
                }
                const int t = 16 * ti + fr; const float at = misc[t];
#pragma unroll
                for (int j = 0; j < 2; ++j) { const int s0 = 16 * (2 * wh + j) + 4 * fq; const f32x4 av = *(const LAS f32x4*)(misc + s0);
                    f32x4 o;
#pragma unroll
                    for (int r = 0; r < 4; ++r) { const bool keep = dir ? (s0 + r >= t) : (s0 + r <= t); o[r] = keep ? st[j][r] * __expf(at - av[r]) : 0.f; }
                    *(LAS u32x2*)(lds + SS_G + t * 160 + s0 * 2) = pack4(o); }
                { const int e = tid >> 4, s4 = (tid & 15) * 4; const u32x2 v = *(const LAS u32x2*)(lds + SS_XRT + e * 160 + s4 * 2);
                  const f32x4 w = *(const LAS f32x4*)(misc + 128 + s4), dv = *(const LAS f32x4*)(misc + 192 + s4);
                  f32x4 o; o[0] = lo16(v.x) * dv[0]; o[1] = hi16(v.x) * dv[1]; o[2] = lo16(v.y) * dv[2]; o[3] = hi16(v.y) * dv[3];
                  *(LAS u32x2*)(lds + SS_XT + e * 160 + s4 * 2) = pack4(o);
                  *(LAS u32x2*)(lds + SS_XWT + e * 160 + s4 * 2) = pack4(o * w); }
            }
            __syncthreads();
            {
                f32x4 y1 = (f32x4){0.f, 0.f, 0.f, 0.f}, y2 = y1;
                const LAS unsigned char* gb = lds + SS_G + (16 * ti + fr) * 160 + fq * 16;
                const LAS unsigned char* xb = lds + SS_XT + (16 * wh + fr) * 160 + fq * 16;
#pragma unroll
                for (int ks = 0; ks < 2; ++ks) y1 = __builtin_amdgcn_mfma_f32_16x16x32_bf16(*(const LAS bf16x8*)(gb + ks * 64), *(const LAS bf16x8*)(xb + ks * 64), y1, 0, 0, 0);
                const LAS unsigned char* cbp = lds + SS_C + (16 * ti + fr) * 288 + fq * 16;
                const LAS unsigned char* sb = lds + SS_S + (16 * wh + fr) * 288 + fq * 16;
#pragma unroll
                for (int kn = 0; kn < 4; ++kn) y2 = __builtin_amdgcn_mfma_f32_16x16x32_bf16(*(const LAS bf16x8*)(cbp + kn * 64), *(const LAS bf16x8*)(sb + kn * 64), y2, 0, 0, 0);
                const int t0 = 16 * ti + 4 * fq;
                const f32x4 eav = *(const LAS f32x4*)(misc + 64 + t0);
                const u32x2 xs = *(const LAS u32x2*)(lds + SS_XRT + (16 * wh + fr) * 160 + t0 * 2);
                const float xv[4] = {lo16(xs.x), hi16(xs.x), lo16(xs.y), hi16(xs.y)};
                const bool wr_out = !(l == 1 && cin < 4);
#pragma unroll
                for (int r = 0; r < 4; ++r) {
                    float yv = y1[r] + eav[r] * y2[r];
                    if (dir == 0) yv += dskip * xv[r];
                    if (wr_out) OUT[(size_t)(rbase + n0 + t0 + r) * 1024 + hd * 64 + ps * 32 + 16 * wh + fr] = (bf16_t)f2bf(yv);
                }
                const float dec = misc[256];
                Sacc[0] = Sacc[0] * dec; Sacc[1] = Sacc[1] * dec;
                const LAS unsigned char* bt = lds + SS_BT + (16 * wid + fr) * 160 + fq * 16;
                const LAS unsigned char* xw = lds + SS_XWT + fr * 160 + fq * 16;
#pragma unroll
                for (int ks = 0; ks < 2; ++ks) { const bf16x8 bf = *(const LAS bf16x8*)(bt + ks * 64);
                    Sacc[0] = __builtin_amdgcn_mfma_f32_16x16x32_bf16(bf, *(const LAS bf16x8*)(xw + ks * 64), Sacc[0], 0, 0, 0);
                    Sacc[1] = __builtin_amdgcn_mfma_f32_16x16x32_bf16(bf, *(const LAS bf16x8*)(xw + 16 * 160 + ks * 64), Sacc[1], 0, 0, 0); }
            }
            __syncthreads();
            { const int ncol = (16 * wid + 4 * fq) * 2;
              *(LAS u32x2*)(lds + SS_S + fr * 288 + ncol) = pack4(Sacc[0]);
              *(LAS u32x2*)(lds + SS_S + (16 + fr) * 288 + ncol) = pack4(Sacc[1]); }
        }
        if (cn < 68) {
#pragma unroll
            for (int j = 0; j < 2; ++j) { const int q = tid + NTHR * j;
                *(LAS u32x4*)(lds + SS_C + (q >> 4) * 288 + (q & 15) * 16) = rc[j];
                *(LAS u32x4*)(lds + SS_B + (q >> 4) * 288 + (q & 15) * 16) = rb[j];
                *(LAS u32x4*)(lds + SS_BT + (q >> 3) * 160 + (q & 7) * 16) = rt[j]; }
            if (tid < 256) *(LAS u32x4*)(lds + SS_XRT + (tid >> 3) * 160 + (tid & 7) * 16) = rx;
            if (wid == 0) {
                const int j = dir ? 63 - lane : lane;
                const float dtv = softplus_f(dtraw + dtb);
                const float acs = wave_incl_sum(dtv * aneg, lane);
                const float a63 = __shfl(acs, 63);
                misc[j] = acs; misc[64 + j] = __expf(acs); misc[128 + j] = __expf(a63 - acs); misc[192 + j] = dtv;
                if (lane == 0) misc[256] = __expf(a63);
            }
        }
        __syncthreads();
    }
}

__device__ __forceinline__ void mlstm_finish_rows(const Params& p, int l, int row_lo, int gw, int ngw) {
    if (p.dup) return;
    const int lane = tid_fresh() & 63;
    const bf16_t* HF = (const bf16_t*)(p.ws + WS_HF2); const bf16_t* HB = (const bf16_t*)(p.ws + WS_HB2);
    bf16_t* BR = (bf16_t*)(p.ws + WS_BR);
    const float* ng = p.mnorm_g + l * 1024;
    int row = row_lo + gw;
    u32x2 ca[4], cb[4], co[4], na[4], nbv[4], no[4];
    if (row < MT) { const size_t so = (size_t)scanrow(row) * 1024;
#pragma unroll
        for (int hd = 0; hd < 4; ++hd) { const int c = hd * 256 + 4 * lane; ca[hd] = *(const u32x2*)(HF + so + c); cb[hd] = *(const u32x2*)(HB + so + c); co[hd] = *(const u32x2*)(BR + (size_t)row * 3072 + 1024 + c); } }
    for (; row < MT; row += ngw) {
        const int rn = row + ngw;
        if (rn < MT) { const size_t so = (size_t)scanrow(rn) * 1024;
#pragma unroll
            for (int hd = 0; hd < 4; ++hd) { const int c = hd * 256 + 4 * lane; na[hd] = *(const u32x2*)(HF + so + c); nbv[hd] = *(const u32x2*)(HB + so + c); no[hd] = *(const u32x2*)(BR + (size_t)rn * 3072 + 1024 + c); } }
#pragma unroll
        for (int hd = 0; hd < 4; ++hd) { const int c = hd * 256 + 4 * lane;
            const u32x2 a = ca[hd], b2 = cb[hd], o = co[hd];
            f32x4 h; h[0] = lo16(a.x) + lo16(b2.x); h[1] = hi16(a.x) + hi16(b2.x); h[2] = lo16(a.y) + lo16(b2.y); h[3] = hi16(a.y) + hi16(b2.y);
            const float ss = wave_sum((h[0] * h[0] + h[1] * h[1]) + (h[2] * h[2] + h[3] * h[3]));
            const float rs = 1.0f / sqrtf(ss * (1.f / 256.f) + EPS);
            const f32x4 g = *(const f32x4*)(ng + c);
            f32x4 r; r[0] = sigmoid_f(lo16(o.x)) * (h[0] * rs * g[0]); r[1] = sigmoid_f(hi16(o.x)) * (h[1] * rs * g[1]);
            r[2] = sigmoid_f(lo16(o.y)) * (h[2] * rs * g[2]); r[3] = sigmoid_f(hi16(o.y)) * (h[3] * rs * g[3]);
            u32x2 w; w.x = pk2(r[0], r[1]); w.y = pk2(r[2], r[3]);
            *(u32x2*)(BR + (size_t)row * 3072 + 1024 + c) = w; }
#pragma unroll
        for (int hd = 0; hd < 4; ++hd) { ca[hd] = na[hd]; cb[hd] = nbv[hd]; co[hd] = no[hd]; }
    }
}
__device__ __forceinline__ void ssd_finish_rows(const Params& p, int l, int row_lo, int gw, int ngw) {
    if (p.dup) return;
    const int lane = tid_fresh() & 63;
    const bf16_t* YF = (const bf16_t*)(p.ws + WS_YF); const bf16_t* YB = (const bf16_t*)(p.ws + WS_YB);
    bf16_t* BR = (bf16_t*)(p.ws + WS_BR);
    const float* ng = p.snorm_g + l * 1024;
    int row = row_lo + gw;
    u32x2 ca[4], cb[4], cz[4], na[4], nbv[4], nz[4];
    if (row < MT) {
#pragma unroll
        for (int j = 0; j < 4; ++j) { const int c = 4 * lane + 256 * j; ca[j] = *(const u32x2*)(YF + (size_t)row * 1024 + c); cb[j] = *(const u32x2*)(YB + (size_t)row * 1024 + c); cz[j] = *(const u32x2*)(BR + (size_t)row * 3072 + 2048 + c); } }
    for (; row < MT; row += ngw) {
        const int rn = row + ngw;
        if (rn < MT) {
#pragma unroll
            for (int j = 0; j < 4; ++j) { const int c = 4 * lane + 256 * j; na[j] = *(const u32x2*)(YF + (size_t)rn * 1024 + c); nbv[j] = *(const u32x2*)(YB + (size_t)rn * 1024 + c); nz[j] = *(const u32x2*)(BR + (size_t)rn * 3072 + 2048 + c); } }
        f32x4 v[4]; float ss = 0.f;
#pragma unroll
        for (int j = 0; j < 4; ++j) { const u32x2 a = ca[j], b2 = cb[j], z = cz[j];
            v[j][0] = (lo16(a.x) + lo16(b2.x)) * silu_f(lo16(z.x)); v[j][1] = (hi16(a.x) + hi16(b2.x)) * silu_f(hi16(z.x));
            v[j][2] = (lo16(a.y) + lo16(b2.y)) * silu_f(lo16(z.y)); v[j][3] = (hi16(a.y) + hi16(b2.y)) * silu_f(hi16(z.y));
            ss += (v[j][0] * v[j][0] + v[j][1] * v[j][1]) + (v[j][2] * v[j][2] + v[j][3] * v[j][3]); }
        const float rs = 1.0f / sqrtf(wave_sum(ss) * (1.f / 1024.f) + EPS);
#pragma unroll
        for (int j = 0; j < 4; ++j) { const int c = 4 * lane + 256 * j; const f32x4 g = *(const f32x4*)(ng + c);
            u32x2 w; w.x = pk2(v[j][0] * rs * g[0], v[j][1] * rs * g[1]); w.y = pk2(v[j][2] * rs * g[2], v[j][3] * rs * g[3]);
            *(u32x2*)(BR + (size_t)row * 3072 + 2048 + c) = w; }
#pragma unroll
        for (int j = 0; j < 4; ++j) { ca[j] = na[j]; cb[j] = nbv[j]; cz[j] = nz[j]; }
    }
}

__device__ __forceinline__ void phase_route(const Params& p, int l, unsigned char* ldsb, int bid, int nb) {
    float* lds = reinterpret_cast<float*>(ldsb);
    float* Wt = lds;
    int* hist = reinterpret_cast<int*>(lds + 36 * 1024);
    const int tid = tid_fresh(), lane = tid & 63, wave = tid >> 6;
    const int row_lo = l == 0 ? 0 : MC, rpb = l == 0 ? 68 : 64;
    const float* wrg = p.w_rg + (size_t)l * 1024 * 4; const float* wre = p.w_re + (size_t)l * 1024 * 32;
    for (int i = tid; i < 1024 * 4; i += NTHR) { const int k = i >> 2, g = i & 3; Wt[g * 1024 + (k ^ ((g & 7) << 2))] = wrg[i]; }
    for (int i = tid; i < 1024 * 32; i += NTHR) { const int k = i >> 5, e = i & 31; Wt[(4 + e) * 1024 + (k ^ (((4 + e) & 7) << 2))] = wre[i]; }
    const float* mod = (const float*)(p.ws + WS_MOD) + l * 5 * 6144;
    const float* XL = (const float*)(p.ws + WS_XL);
    int* EID = (int*)(p.ws + WS_EID); float* EWT = (float*)(p.ws + WS_EWT);
    for (int vb = bid; vb < 256; vb += nb) {
        if (tid < 32) hist[tid] = 0;
        __syncthreads();
        for (int rr = wave; rr < rpb; rr += 8) {
            const int row = row_lo + vb * rpb + rr;
            f32x4 v[4];
#pragma unroll
            for (int j = 0; j < 4; ++j) v[j] = *(const f32x4*)(XL + (size_t)row * 1024 + 4 * lane + 256 * j);
            const float* mr = mod + modrow(row) * 6144;
            norm_mod_row(v, p.g_ffn + l * 1024, mr + 3 * 1024, mr + 4 * 1024, lane);
            store_row_bf16((bf16_t*)(p.ws + WS_H) + (size_t)row * 1024, v, lane);
            float lg[36];
#pragma unroll
            for (int e = 0; e < 36; ++e) { float s = 0.f;
#pragma unroll
                for (int j = 0; j < 4; ++j) { const f32x4 w = *(const f32x4*)(Wt + e * 1024 + ((4 * lane + 256 * j) ^ ((e & 7) << 2))); s += (v[j][0] * w[0] + v[j][1] * w[1]) + (v[j][2] * w[2] + v[j][3] * w[3]); }
                lg[e] = wave_sum(s); }
            float gl[4]; int gi = 0; float gmax;
#pragma unroll
            for (int g = 0; g < 4; ++g) gl[g] = lg[g] + p.b_rg[l * 4 + g];
            gmax = gl[0];
#pragma unroll
            for (int g = 1; g < 4; ++g) if (gl[g] > gmax) { gmax = gl[g]; gi = g; }
            float den = 0.f;
#pragma unroll
            for (int g = 0; g < 4; ++g) den += __expf(gl[g] - gmax);
            const float pg = 1.f / den;
            float v1 = -3.0e38f, v2 = -3.0e38f; int i1 = 0, i2 = 0;
#pragma unroll
            for (int g = 0; g < 4; ++g) if (g == gi) {
#pragma unroll
                for (int j = 0; j < 8; ++j) { const float x = lg[4 + g * 8 + j] + p.b_re[l * 32 + g * 8 + j];
                    if (x > v1) { v2 = v1; i2 = i1; v1 = x; i1 = j; } else if (x > v2) { v2 = x; i2 = j; } } }
            const float e2 = __expf(v2 - v1), w1 = pg / (1.f + e2), w2 = pg * e2 / (1.f + e2);
            if (lane == 0) { EID[row * 2] = gi * 8 + i1; EID[row * 2 + 1] = gi * 8 + i2; EWT[row * 2] = w1; EWT[row * 2 + 1] = w2;
                atomicAdd(&hist[gi * 8 + i1], 1); atomicAdd(&hist[gi * 8 + i2], 1); }
        }
        __syncthreads();
        if (tid < 32) ((int*)(p.ws + WS_HIST))[vb * 32 + tid] = hist[tid];
        __syncthreads();
    }
    __syncthreads();
    float* scr = lds + wave * (64 * 65);
    convert_run(p, l, l + 1 < 2 ? l + 1 : -1, bid * 8 + wave, nb * 8, scr, lane);
}

__device__ __forceinline__ void phase_scatter(const Params& p, int l, unsigned char* ldsb, int bid, int nb) {
    int* li = reinterpret_cast<int*>(ldsb);
    int* tot = li; int* pre = li + 32; int* pst = li + 64; int* ea = li + 128; int* pos = li + 384;
    const int tid = tid_fresh(), lane = tid & 63, wave = tid >> 6;
    const int row_lo = l == 0 ? 0 : MC, rpb = l == 0 ? 68 : 64;
    const int* HIST = (const int*)(p.ws + WS_HIST); const int* EID = (const int*)(p.ws + WS_EID);
    int* SLOT = (int*)(p.ws + WS_SLOT);
    for (int vb = bid; vb < 256; vb += nb) {
        __syncthreads();
        if (tid < 32) { int t = 0, pr = 0; for (int j = 0; j < 256; ++j) { const int hv = HIST[j * 32 + tid]; t += hv; if (j < vb) pr += hv; } tot[tid] = t; pre[tid] = pr; }
        __syncthreads();
        if (tid == 0) { int s = 0; for (int e = 0; e < 32; ++e) { pst[e] = s; s += ((tot[e] + 255) >> 8) << 8; }
            if (vb == 0) { int* BE = (int*)(p.ws + WS_BLKEXP); int nblk = 0;
                for (int e = 0; e < 32; ++e) { const int nbk = (tot[e] + 255) >> 8; for (int j = 0; j < nbk; ++j) BE[nblk++] = e; }
                BE[200] = nblk; } }
        if (tid < rpb * 2) ea[tid] = EID[(row_lo + vb * rpb) * 2 + tid];
        __syncthreads();
        if (tid < rpb * 2) { const int e = ea[tid]; int rk = 0; for (int j = 0; j < tid; ++j) rk += (ea[j] == e) ? 1 : 0;
            const int ps = pst[e] + pre[e] + rk; SLOT[(row_lo + vb * rpb) * 2 + tid] = ps; ((int*)(p.ws + WS_TOK))[ps] = row_lo + vb * rpb + (tid >> 1); }
        if (vb == 0 && tid < 32) { int* TOK = (int*)(p.ws + WS_TOK); const int e0 = pst[tid] + tot[tid], e1 = pst[tid] + (((tot[tid] + 255) >> 8) << 8);
            for (int q = e0; q < e1; ++q) TOK[q] = row_lo; }
    }
    __syncthreads();
}

__device__ __forceinline__ void phase_combine(const Params& p, int l, int bid, int nb) {
    if (p.dup && l == 0) return;
    const int lane = tid_fresh() & 63, wave = tid_fresh() >> 6;
    const float* mod = (const float*)(p.ws + WS_MOD);
    const int* SLOT = (const int*)(p.ws + WS_SLOT); const float* EWT = (const float*)(p.ws + WS_EWT);
    const bf16_t* Y = (const bf16_t*)(p.ws + WS_Y);
    float* XL = (float*)(p.ws + WS_XL);
    const int row_lo = l == 0 ? 0 : MC, stride = nb * 8;
    for (int rowA = row_lo + bid * 8 + wave; rowA < MT; rowA += 2 * stride) {
        const int rowB = rowA + stride; const bool hasB = rowB < MT; const int rb = hasB ? rowB : rowA;
        const int sA0 = SLOT[rowA * 2], sA1 = SLOT[rowA * 2 + 1], sB0 = SLOT[rb * 2], sB1 = SLOT[rb * 2 + 1];
        const float wA0 = EWT[rowA * 2], wA1 = EWT[rowA * 2 + 1], wB0 = EWT[rb * 2], wB1 = EWT[rb * 2 + 1];
        u32x2 yA0[4], yA1[4], yB0[4], yB1[4]; f32x4 xA[4], xB[4];
#pragma unroll
        for (int j = 0; j < 4; ++j) { const int c = 4 * lane + 256 * j;
            yA0[j] = *(const u32x2*)(Y + (size_t)sA0 * 1024 + c); yA1[j] = *(const u32x2*)(Y + (size_t)sA1 * 1024 + c); xA[j] = *(const f32x4*)(XL + (size_t)rowA * 1024 + c);
            yB0[j] = *(const u32x2*)(Y + (size_t)sB0 * 1024 + c); yB1[j] = *(const u32x2*)(Y + (size_t)sB1 * 1024 + c); xB[j] = *(const f32x4*)(XL + (size_t)rb * 1024 + c); }
#pragma unroll
        for (int half = 0; half < 2; ++half) {
            if (half == 1 && !hasB) break;
            const int row = half ? rowB : rowA; const float w0 = half ? wB0 : wA0, w1 = half ? wB1 : wA1;
            const float* g5 = mod + (l * 5 + modrow(row)) * 6144 + 5 * 1024;
            f32x4 v[4];
#pragma unroll
            for (int j = 0; j < 4; ++j) { const int c = 4 * lane + 256 * j;
                const u32x2 a = half ? yB0[j] : yA0[j], b2 = half ? yB1[j] : yA1[j];
                f32x4 y; y[0] = w0 * lo16(a.x) + w1 * lo16(b2.x); y[1] = w0 * hi16(a.x) + w1 * hi16(b2.x); y[2] = w0 * lo16(a.y) + w1 * lo16(b2.y); y[3] = w0 * hi16(a.y) + w1 * hi16(b2.y);
                v[j] = (half ? xB[j] : xA[j]) + *(const f32x4*)(g5 + c) * y; }
            if (l == 0) {
#pragma unroll
                for (int j = 0; j < 4; ++j) *(f32x4*)(XL + (size_t)row * 1024 + 4 * lane + 256 * j) = v[j];
                const float* mr = mod + (5 + modrow(row)) * 6144;
                norm_mod_row(v, p.g_mix + 1024, mr, mr + 1024, lane);
                store_row_bf16((bf16_t*)(p.ws + WS_H) + (size_t)row * 1024, v, lane);
            } else {
                norm_mod_row(v, p.g_final, nullptr, nullptr, lane);
                float* o = p.out + (size_t)(row - MC) * 1024;
#pragma unroll
                for (int j = 0; j < 4; ++j) *(f32x4*)(o + 4 * lane + 256 * j) = v[j];
            }
        }
    }
}

constexpr int NPH_L = 14, NPHASES = 1 + 2 * NPH_L;
__device__ __forceinline__ void run_phase(const Params& p, int ph, unsigned char* lds) {
    const int bid = blockIdx.x, nb = gridDim.x;
    const int wave = tid_fresh() >> 6;
#ifndef ONLY_S
    if (ph == 0) { phase_pre(p, lds, bid, nb); return; }
#else
    if (ph == 0) { if (ONLY_S == 99) phase_pre(p, lds, bid, nb); return; }
#endif
    const int l = (ph - 1) / NPH_L, s = (ph - 1) % NPH_L;
    unsigned char* ws = p.ws;
    const int pm0 = l == 0 ? 0 : 4, nMrows = l == 0 ? 68 : 64, row_lo = l == 0 ? 0 : MC;
#ifdef ONLY_S
    if (s != ONLY_S) return;
#endif
    switch (s) {
    case 0: if (l == 0) phase_norm1(p, bid, nb); break;
    case 1: { SchedGrid S{(const bf16_t*)(ws + WS_H), (const bf16_t*)(ws + WS_WIN), 1024, 1024, 0, 68, 45, nb, bid}; EpiInproj E{ws};
              gemm_run(lds, S, E, 1024, 1024, 1024, 1); } break;
    case 2: { for (int it = bid; it < 1088; it += nb) conv_m_item(p, l, it, (LAS unsigned char*)lds);
              if (!p.dup) for (int it = bid; it < (l == 0 ? 272 : 256); it += nb) pool_window_item(p, it, (LAS unsigned char*)lds); } break;
    case 3: { for (int it = bid; it < 256; it += nb) mlstm_chunk_item(p, l, it, (LAS unsigned char*)lds);
              SchedPool S{(const bf16_t*)(ws + WS_BR), (const bf16_t*)(ws + WS_WPOOL), pm0, nMrows, nb, bid}; EpiPool E{(bf16_t*)(ws + WS_BR)};
              if (!p.dup) gemm_run(lds, S, E, 256, 3072, 256, 1); } break;
    case 4: { for (int it = bid; it < 1088; it += nb) conv_s_item(p, l, it, (LAS unsigned char*)lds);
              mlstm_finish_rows(p, l, row_lo, bid * 8 + wave, nb * 8); } break;
    case 5: for (int it = bid; it < 256; it += nb) ssd_chunk_item(p, l, it, (LAS unsigned char*)lds); break;
    case 6: ssd_finish_rows(p, l, row_lo, bid * 8 + wave, nb * 8); break;
    case 7: { SchedGrid S{(const bf16_t*)(ws + WS_BR), (const bf16_t*)(ws + WS_WBR), 3072, 3072, pm0, nMrows, 4, nb, bid}; EpiBranch E{(const bf16_t*)(ws + WS_MG), (bf16_t*)(ws + WS_MERGED)};
              gemm_run(lds, S, E, 3072, 3072, 3072, 3); } break;
    case 8: { SchedGrid S{(const bf16_t*)(ws + WS_MERGED), (const bf16_t*)(ws + WS_WOUT), 1024, 1024, pm0, nMrows, 4, nb, bid}; EpiOut E{(float*)(ws + WS_XL), (const float*)(ws + WS_MOD) + l * 5 * 6144, l == 0 ? p.x : nullptr, l == 0 ? p.ctx : nullptr, p.dup};
              gemm_run(lds, S, E, 1024, 1024, 1024, 1); } break;
    case 9: phase_route(p, l, lds, bid, nb); break;
    case 10: phase_scatter(p, l, lds, bid, nb); break;
    case 11: { const int* BE = (const int*)(ws + WS_BLKEXP);
              SchedMoe S{(const bf16_t*)(ws + WS_H), (const bf16_t*)(ws + WS_EW1), BE, (const int*)(ws + WS_TOK), 1024, BE[200], nb, bid, (size_t)1048576, (size_t)1024}; EpiMoe1 E{(bf16_t*)(ws + WS_ACT)};
              gemm_run<true>(lds, S, E, 1024, 1024, 1024, 1); } break;
    case 12: { const int* BE = (const int*)(ws + WS_BLKEXP);
              SchedMoe S{(const bf16_t*)(ws + WS_ACT), (const bf16_t*)(ws + WS_EW2), BE, nullptr, 512, BE[200], nb, bid, (size_t)524288, (size_t)512}; EpiMoe2 E{(bf16_t*)(ws + WS_Y)};
              gemm_run(lds, S, E, 512, 512, 512, 1); } break;
    case 13: phase_combine(p, l, bid, nb); break;
    }
}

#define XB_TMO      128
#define XB_XCNT(j)  (256  + 64 * (j))
#define XB_XSUB(j)  (1280 + 64 * (j))
#define XB_XGEN(j)  (2304 + 64 * (j))
#define XB_TOP      3328
#define XB_TOPGEN   3392
#define XCD_BAR_WORDS 3456
#define XB_SPIN_CAP (1u << 18)
__device__ __forceinline__ unsigned xb_ld(unsigned* p)              { return __hip_atomic_load(p, __ATOMIC_RELAXED, __HIP_MEMORY_SCOPE_AGENT); }
__device__ __forceinline__ unsigned xb_add(unsigned* p, unsigned v) { return __hip_atomic_fetch_add(p, v, __ATOMIC_RELAXED, __HIP_MEMORY_SCOPE_AGENT); }
__device__ __forceinline__ unsigned xb_xcc_id() { return (unsigned)__builtin_amdgcn_s_getreg((3 << 11) | 20) & 0xFu; }
#define XB_SPIN(cond, bar) do { unsigned _sp = 0; while (cond) { __builtin_amdgcn_s_sleep(1); \
    if ((++_sp & 255u) == 0u) { if (xb_ld(&(bar)[XB_TMO])) break; if (_sp > XB_SPIN_CAP) { atomicAdd(&(bar)[XB_TMO], 1u); break; } } } } while (0)
__device__ __forceinline__ void xcd_barrier_complete(unsigned* bar, unsigned x, unsigned& nloc, unsigned& nx) {
    const unsigned G = gridDim.x * gridDim.y * gridDim.z;
    unsigned sum, cnt, mine, sp = 0u;
    for (;;) {
        sum = 0u; cnt = 0u; mine = 0u;
#pragma unroll
        for (unsigned j = 0; j < 16; ++j) { const unsigned c = xb_ld(&bar[XB_XCNT(j)]); sum += c; cnt += (c > 0u) ? 1u : 0u; mine = (j == x) ? c : mine; }
        if (sum == G) break;
        __builtin_amdgcn_s_sleep(1);
        if ((++sp & 255u) == 0u) { if (xb_ld(&bar[XB_TMO])) break; if (sp > XB_SPIN_CAP) { atomicAdd(&bar[XB_TMO], 1u); break; } }
    }
    nloc = mine > 0u ? mine : 1u; nx = cnt > 0u ? cnt : 1u;
}
__device__ __forceinline__ void xcd_barrier(unsigned* bar, volatile LAS unsigned* st) {
    asm volatile("s_waitcnt vmcnt(0)" ::: "memory");
    __syncthreads();
    if (threadIdx.x == 0) {
        __builtin_amdgcn_s_waitcnt(0);
        const unsigned x = xb_xcc_id();
        unsigned nloc = st[0], nx = st[1];
        if (nloc == 0u) { xcd_barrier_complete(bar, x, nloc, nx); st[0] = nloc; st[1] = nx; }
        const unsigned old = xb_add(&bar[XB_XSUB(x)], 1u);
        const unsigned gen = old / nloc;
        if (old + 1u == (gen + 1u) * nloc) {
            __builtin_amdgcn_fence(__ATOMIC_RELEASE, "agent");
            asm volatile("s_waitcnt vmcnt(0)" ::: "memory");
            const unsigned og = xb_add(&bar[XB_TOP], 1u);
            const unsigned tg = og / nx;
            if (og + 1u == (tg + 1u) * nx) xb_add(&bar[XB_TOPGEN], 1u);
            else XB_SPIN(xb_ld(&bar[XB_TOPGEN]) == tg, bar);
            __builtin_amdgcn_fence(__ATOMIC_ACQUIRE, "agent");
            xb_add(&bar[XB_XGEN(x)], 1u);
            asm volatile("s_waitcnt vmcnt(0)" ::: "memory");
        } else {
            XB_SPIN(xb_ld(&bar[XB_XGEN(x)]) == gen, bar);
            __builtin_amdgcn_fence(__ATOMIC_ACQUIRE, "agent");
            asm volatile("s_waitcnt vmcnt(0)" ::: "memory");
        }
    }
    __syncthreads();
}

constexpr int BAR_LDS_OFF = LDS_BYTES - 16;
__global__ void __launch_bounds__(NTHR, 2) fwd_kernel(Params pk) {
    extern __shared__ __attribute__((aligned(16))) unsigned char lds[];
    const Params& p = pk;
    const int lo = pk.ph_lo, hi = pk.ph_hi;
    unsigned* bar = (unsigned*)(pk.ws + WS_BAR);
    volatile LAS unsigned* bst = (volatile LAS unsigned*)((LAS unsigned char*)lds + BAR_LDS_OFF);
    if (hi - lo > 1) {
        if (threadIdx.x == 0) { bst[0] = 0u; bst[1] = 0u; (void)xb_add(&bar[XB_XCNT(xb_xcc_id())], 1u); }
        __syncthreads();
    }
#define STEP(k) if (lo <= (k) && (k) < hi) { run_phase(p, (k), lds); if ((k) + 1 < hi) { if (pk.dup < 0) cg::this_grid().sync(); else xcd_barrier(bar, bst); } }
    STEP(0) STEP(1) STEP(2) STEP(3) STEP(4) STEP(5) STEP(6) STEP(7) STEP(8) STEP(9) STEP(10) STEP(11) STEP(12) STEP(13) STEP(14)
    STEP(16) STEP(17) STEP(18) STEP(19) STEP(20) STEP(21) STEP(22) STEP(23) STEP(24) STEP(25) STEP(26) STEP(27) STEP(28)
#undef STEP
}

extern "C" void kernel_launch(void* const* d_in, const int* in_sizes, int n_in, void* d_out, int out_size, void* d_ws, size_t ws_size, hipStream_t stream) {
    static int grid_blocks = 0;
    if (!grid_blocks) {
        if (n_in != 31 || ws_size < WS_END) { fprintf(stderr, "kernel_launch: unexpected n_in %d / ws_size %zu (need %zu)\n", n_in, ws_size, (size_t)WS_END); grid_blocks = -1; return; }
        int dev = 0, cus = 0, per_cu = 0;
        hipGetDevice(&dev);
        hipDeviceGetAttribute(&cus, hipDeviceAttributeMultiprocessorCount, dev);
        if (hipFuncSetAttribute((const void*)fwd_kernel, hipFuncAttributeMaxDynamicSharedMemorySize, LDS_BYTES) != hipSuccess) fprintf(stderr, "kernel_launch: hipFuncSetAttribute failed\n");
        hipOccupancyMaxActiveBlocksPerMultiprocessor(&per_cu, (const void*)fwd_kernel, NTHR, LDS_BYTES);
        if (per_cu < 1) { fprintf(stderr, "kernel_launch: occupancy query says %d blocks per CU\n", per_cu); per_cu = 1; }
        grid_blocks = cus * per_cu;
        (void)hipGetLastError();
    }
    if (grid_blocks < 0) return;
    Params p{};
    const float** dst = (const float**)&p;
    for (int i = 0; i < 31; ++i) dst[i] = (const float*)d_in[i];
    p.out = (float*)d_out; p.ws = (unsigned char*)d_ws;
#if SINGLE_LAUNCH
    if (hipMemsetAsync((char*)d_ws + WS_BAR, 0, 16384, stream) != hipSuccess) fprintf(stderr, "kernel_launch: hipMemsetAsync failed\n");
    p.ph_lo = 0; p.ph_hi = NPHASES;
    void* args[] = {&p};
    hipError_t e = hipLaunchCooperativeKernel((const void*)fwd_kernel, dim3(grid_blocks), dim3(NTHR), args, LDS_BYTES, stream);
    if (e != hipSuccess) fprintf(stderr, "cooperative launch failed: %s (grid %d)\n", hipGetErrorString(e), grid_blocks);
#else
    for (int ph = 0; ph < NPHASES; ++ph) {
        if (ph == 1 + NPH_L) continue;
        p.ph_lo = ph; p.ph_hi = ph + 1;
        hipLaunchKernelGGL(fwd_kernel, dim3(grid_blocks), dim3(NTHR), LDS_BYTES, stream, p);
        const int sidx = ph == 0 ? 14 : (ph - 1) % NPH_L;
        if ((PROBE_DUP_MASK >> sidx) & 1) { p.dup = 1; for (int r = 0; r < PROBE_DUP_N; ++r) hipLaunchKernelGGL(fwd_kernel, dim3(grid_blocks), dim3(NTHR), LDS_BYTES, stream, p); p.dup = 0; }
    }
#endif
}
```

```cpp
#include <hip/hip_runtime.h>
#include <hip/hip_cooperative_groups.h>
#include <cstdio>
namespace cg = cooperative_groups;

#ifndef SINGLE_LAUNCH
#define SINGLE_LAUNCH 1
#endif
#ifndef PROBE_DUP_MASK
#define PROBE_DUP_MASK 0
#endif
#ifndef PROBE_DUP_N
#define PROBE_DUP_N 1
#endif
#ifndef USE_MLSTM_CHUNK
#define USE_MLSTM_CHUNK 1
#endif
#ifndef USE_SSD_CHUNK
#define USE_SSD_CHUNK 1
#endif
#ifndef USE_MFMA_GEMM
#define USE_MFMA_GEMM 1
#endif

typedef unsigned short bf16_t;
typedef float f32x4 __attribute__((ext_vector_type(4)));
typedef unsigned u32x4 __attribute__((ext_vector_type(4)));
typedef unsigned u32x2 __attribute__((ext_vector_type(2)));

constexpr int NTHR = 512;
constexpr int D = 1024, NB = 4, SEQ = 4096, CTXL = 256;
constexpr int MC = NB * CTXL;
constexpr int ML = NB * SEQ;
constexpr int MT = MC + ML;
constexpr int DIN = 11312, NPAD = 11520;
constexpr int NE = 32, DE = 512;
constexpr int CAP = 43008;
constexpr float EPS = 1e-6f;
constexpr int LDS_BYTES = 163840;

constexpr size_t MiB = 1u << 20;
constexpr size_t WS_HIST = 0;
constexpr size_t WS_BLKEXP = 64 * 1024;
constexpr size_t WS_BAR = 128 * 1024;
constexpr size_t WS_TOK = 256 * 1024;
constexpr size_t WS_MOD = 1 * MiB;
constexpr size_t WS_GA = 2 * MiB;
constexpr size_t WS_DT = 4 * MiB;
constexpr size_t WS_EID = 7 * MiB;
constexpr size_t WS_EWT = 7 * MiB + 256 * 1024;
constexpr size_t WS_SLOT = 7 * MiB + 512 * 1024;
constexpr size_t WS_WIN = 8 * MiB;
constexpr size_t WS_WPOOL = 31 * MiB;
constexpr size_t WS_WBR = 32 * MiB;
constexpr size_t WS_WOUT = 38 * MiB;
constexpr size_t WS_XL = 40 * MiB;
constexpr size_t WS_H = 108 * MiB;
constexpr size_t WS_BR = 142 * MiB;
constexpr size_t WS_Q = 244 * MiB, WS_K = 278 * MiB, WS_V = 312 * MiB;
constexpr size_t WS_SX = 346 * MiB, WS_SB = 380 * MiB, WS_SC = 397 * MiB;
constexpr size_t WS_MG = 414 * MiB;
constexpr size_t WS_HF = 516 * MiB, WS_HB = 550 * MiB;
constexpr size_t WS_VT = 584 * MiB;
constexpr size_t WS_END = 618 * MiB;
constexpr size_t WS_QC = WS_H, WS_KC = WS_HF, WS_KCT = WS_HB;
constexpr size_t WS_HF2 = WS_Q, WS_HB2 = WS_K;
constexpr size_t WS_XCT = WS_HF;
constexpr size_t WS_BC = WS_H, WS_CC = WS_H + 17 * MiB, WS_BCT = WS_HB;
constexpr size_t WS_YF = WS_SX, WS_YB = WS_SB;
constexpr size_t WS_MERGED = WS_Q;
constexpr size_t WS_EW1 = 244 * MiB;
constexpr size_t WS_EW2 = 308 * MiB;
constexpr size_t WS_XB = WS_BR;
constexpr size_t WS_ACT = WS_SX;
constexpr size_t WS_Y = WS_MG;

struct Params {
    const float *x, *c, *ctx, *c_ctx, *w_ada, *b_ada, *g_mix, *g_ffn, *w_in, *pool_w, *pool_scale,
        *mconv_w, *mconv_b, *mgate_b, *mnorm_g, *sconv_w, *sconv_b, *sdt_bias, *sa_log, *sd, *snorm_g,
        *w_branch, *w_out, *w_rg, *b_rg, *w_re, *b_re, *w_eg, *w_eu, *w_ed, *g_final;
    float* out; unsigned char* ws; int ph_lo, ph_hi, dup, pad;
};

__device__ __forceinline__ int tid_fresh() { int t = threadIdx.x; asm volatile("" : "+v"(t)); return t; }
__device__ __forceinline__ float bf2f(unsigned b) { return __uint_as_float(b << 16); }
__device__ __forceinline__ unsigned f2bf(float f) { unsigned u = __float_as_uint(f); return (u + 0x7fffu + ((u >> 16) & 1u)) >> 16; }
typedef __bf16 bf16x2_t __attribute__((ext_vector_type(2)));
typedef float f32x2_t __attribute__((ext_vector_type(2)));
__device__ __forceinline__ unsigned pk2(float lo, float hi) { const f32x2_t v = {lo, hi}; return __builtin_bit_cast(unsigned, __builtin_convertvector(v, bf16x2_t)); }
__device__ __forceinline__ float lo16(unsigned w) { return __uint_as_float(w << 16); }
__device__ __forceinline__ float hi16(unsigned w) { return __uint_as_float(w & 0xffff0000u); }
__device__ __forceinline__ float wave_sum(float v) {
#pragma unroll
    for (int o = 1; o < 64; o <<= 1) v += __shfl_xor(v, o);
    return v;
}
__device__ __forceinline__ float sigmoid_f(float x) { return __builtin_amdgcn_rcpf(1.f + __expf(-x)); }
__device__ __forceinline__ float silu_f(float x) { return x * __builtin_amdgcn_rcpf(1.f + __expf(-x)); }
__device__ __forceinline__ float softplus_f(float x) { return fmaxf(x, 0.f) + log1pf(__expf(-fabsf(x))); }
__device__ __forceinline__ float logsigmoid_f(float x) { return fminf(x, 0.f) - log1pf(__expf(-fabsf(x))); }
__device__ __forceinline__ void unpack8(u32x4 w, float* f) {
    f[0] = lo16(w.x); f[1] = hi16(w.x); f[2] = lo16(w.y); f[3] = hi16(w.y);
    f[4] = lo16(w.z); f[5] = hi16(w.z); f[6] = lo16(w.w); f[7] = hi16(w.w);
}
__device__ __forceinline__ u32x4 pack8(f32x4 a, f32x4 b) {
    u32x4 w; w.x = pk2(a[0], a[1]); w.y = pk2(a[2], a[3]); w.z = pk2(b[0], b[1]); w.w = pk2(b[2], b[3]); return w;
}
__device__ __forceinline__ int scanrow(int row) {
    if (row < MC) return row;
    const int r = row - MC, b = r >> 12, t = r & 4095;
    return MC + (b << 12) + ((t & 63) << 6) + (t >> 6);
}
__device__ __forceinline__ int modrow(int row) { return row < MC ? 4 : ((row - MC) >> 12); }

struct Unit { const bf16_t* A; const bf16_t* B; const int* tok; int pm, pn; };

__device__ __forceinline__ void tile_order(int L, int nM, int nN, int& pm, int& pn) {
    const int nwg = nM * nN; int wgid = L;
    { const int q = nwg / 8, r = nwg % 8, xcd = wgid % 8, off = wgid / 8; wgid = (xcd < r ? xcd * (q + 1) : r * (q + 1) + (xcd - r) * q) + off; }
    const int nig = 8 * nN, gid = wgid / nig, fm = gid * 8, gsz = (nM - fm) < 8 ? (nM - fm) : 8;
    pm = fm + ((wgid % nig) % gsz); pn = (wgid % nig) / gsz;
}
struct SchedGrid {
    const bf16_t* A; const bf16_t* B; int lda, ldb, pm0, nM, nN, G, c;
    __device__ __forceinline__ bool next(int i, Unit& u) const {
        const long L = (long)i * G + c; if (L >= (long)nM * nN) return false;
        int pm, pn; tile_order((int)L, nM, nN, pm, pn); pm += pm0;
        u.pm = pm; u.pn = pn; u.tok = nullptr; u.A = A + (size_t)pm * 256 * lda; u.B = B + (size_t)pn * 256 * ldb; return true;
    }
};
struct SchedPool {
    const bf16_t* A; const bf16_t* B; int pm0, nM, G, c;
    __device__ __forceinline__ bool next(int i, Unit& u) const {
        const long L = (long)i * G + c; if (L >= (long)nM * 4) return false;
        const int pm = pm0 + (int)(L >> 2), g = (int)(L & 3);
        u.pm = pm; u.pn = g; u.tok = nullptr; u.A = A + (size_t)pm * 256 * 3072 + g * 256; u.B = B + (size_t)g * 65536; return true;
    }
};
struct SchedMoe {
    const bf16_t* A; const bf16_t* B; const int* blkexp; const int* tok; int lda, nblk, G, c; size_t bexp_stride, ldb;
    __device__ __forceinline__ bool next(int i, Unit& u) const {
        const long L = (long)i * G + c; if (L >= (long)nblk * 4) return false;
        const int blk = (int)(L >> 2), nt = (int)(L & 3); const int e = blkexp[blk];
        u.pm = blk; u.pn = nt; u.tok = tok ? tok + blk * 256 : nullptr; u.A = tok ? A : A + (size_t)blk * 256 * lda;
        u.B = B + (size_t)e * bexp_stride + (size_t)nt * 256 * ldb; return true;
    }
};

struct EpiInproj {
    unsigned char* ws;
    __device__ __forceinline__ void seg(const Unit& u, int, int r, int c0, f32x4& lo0, f32x4& lo1, f32x4& hi0, f32x4& hi1) const {
        const int row = u.pm * 256 + r, t = u.pn;
        bf16_t* dst; size_t ld; int cb;
        if (t < 4) { dst = (bf16_t*)(ws + WS_BR) + (size_t)row * 3072; cb = t * 256; }
        else if (t < 16) { const int w = (t - 4) >> 2; dst = (bf16_t*)(ws + WS_Q + (size_t)w * 34 * MiB) + (size_t)scanrow(row) * 1024; cb = ((t - 4) & 3) * 256; }
        else if (t < 20) { dst = (bf16_t*)(ws + WS_BR) + (size_t)row * 3072 + 1024; cb = (t - 16) * 256; }
        else if (t < 24) { dst = (bf16_t*)(ws + WS_SX) + (size_t)row * 1024; cb = (t - 20) * 256; }
        else if (t < 28) { dst = (bf16_t*)(ws + WS_BR) + (size_t)row * 3072 + 2048; cb = (t - 24) * 256; }
        else if (t < 30) { dst = (bf16_t*)(ws + WS_SB) + (size_t)row * 512; cb = (t - 28) * 256; }
        else if (t < 32) { dst = (bf16_t*)(ws + WS_SC) + (size_t)row * 512; cb = (t - 30) * 256; }
        else if (t < 44) {
            dst = (bf16_t*)(ws + WS_MG) + (size_t)row * 3072; cb = (t - 32) * 256;
#pragma unroll
            for (int j = 0; j < 4; ++j) { lo0[j] = sigmoid_f(lo0[j]); lo1[j] = sigmoid_f(lo1[j]); hi0[j] = sigmoid_f(hi0[j]); hi1[j] = sigmoid_f(hi1[j]); }
        } else {
            if (c0 < 32) { float* d = (float*)(ws + WS_DT) + (size_t)row * 32 + c0; *(f32x4*)d = lo0; *(f32x4*)(d + 4) = lo1; }
            else if (c0 < 48) { float* d = (float*)(ws + WS_GA) + (size_t)scanrow(row) * 16 + (c0 - 32); *(f32x4*)d = lo0; *(f32x4*)(d + 4) = lo1; }
            return;
        }
        *(u32x4*)(dst + cb + c0) = pack8(lo0, lo1);
        *(u32x4*)(dst + cb + 128 + c0) = pack8(hi0, hi1);
    }
};
struct EpiPool {
    bf16_t* BR;
    __device__ __forceinline__ void seg(const Unit& u, int, int r, int c0, f32x4& lo0, f32x4& lo1, f32x4& hi0, f32x4& hi1) const {
        bf16_t* d = BR + (size_t)(u.pm * 256 + r) * 3072 + u.pn * 256 + c0;
        *(u32x4*)d = pack8(lo0, lo1);
        *(u32x4*)(d + 128) = pack8(hi0, hi1);
    }
};
struct EpiBranch {
    const bf16_t* MG; bf16_t* OUT;
    __device__ __forceinline__ void seg(const Unit& u, int sg, int r, int c0, f32x4& lo0, f32x4& lo1, f32x4& hi0, f32x4& hi1) const {
        const int row = u.pm * 256 + r, col = u.pn * 256 + c0;
        const bf16_t* g = MG + (size_t)row * 3072 + sg * 1024 + col;
        const int nx = sg < 2 ? 1024 : 0;
        const u32x4 ga = *(const u32x4*)g, gb = *(const u32x4*)(g + 128), gc = *(const u32x4*)(g + nx), gd = *(const u32x4*)(g + nx + 128);
        float a[8], b[8], a2[8], b2[8]; unpack8(ga, a); unpack8(gb, b); unpack8(gc, a2); unpack8(gd, b2);
        if (sg < 2) {
#pragma unroll
            for (int j = 0; j < 8; ++j) { a[j] = a[j] * __builtin_amdgcn_rcpf(a2[j]); b[j] = b[j] * __builtin_amdgcn_rcpf(b2[j]); } }
#pragma unroll
        for (int j = 0; j < 4; ++j) { lo0[j] *= a[j]; lo1[j] *= a[4 + j]; hi0[j] *= b[j]; hi1[j] *= b[4 + j]; }
        if (sg == 2) { bf16_t* d = OUT + (size_t)row * 1024 + col; *(u32x4*)d = pack8(lo0, lo1); *(u32x4*)(d + 128) = pack8(hi0, hi1); }
    }
};
struct EpiOut {
    float* XL; const float* mod; const float* x_in; const float* ctx_in; int dup;
    __device__ __forceinline__ void seg(const Unit& u, int, int r, int c0, f32x4& lo0, f32x4& lo1, f32x4& hi0, f32x4& hi1) const {
        const int row = u.pm * 256 + r, col = u.pn * 256 + c0;
        const float* g = mod + modrow(row) * 6144 + 2 * 1024 + col;
        float* x = XL + (size_t)row * 1024 + col;
        const float* rs = x_in ? (row < MC ? ctx_in + (size_t)row * 1024 + col : x_in + (size_t)(row - MC) * 1024 + col) : x;
        const f32x4 x0 = *(const f32x4*)rs, x1 = *(const f32x4*)(rs + 4), x2 = *(const f32x4*)(rs + 128), x3 = *(const f32x4*)(rs + 132);
        const f32x4 g0 = *(const f32x4*)g, g1 = *(const f32x4*)(g + 4), g2 = *(const f32x4*)(g + 128), g3 = *(const f32x4*)(g + 132);
        if (dup) return;
        *(f32x4*)x = x0 + g0 * lo0; *(f32x4*)(x + 4) = x1 + g1 * lo1; *(f32x4*)(x + 128) = x2 + g2 * hi0; *(f32x4*)(x + 132) = x3 + g3 * hi1;
    }
};
struct EpiMoe1 {
    bf16_t* ACT;
    __device__ __forceinline__ void seg(const Unit& u, int, int r, int c0, f32x4& lo0, f32x4& lo1, f32x4& hi0, f32x4& hi1) const {
        const int row = u.pm * 256 + r;
        f32x4 a, b;
#pragma unroll
        for (int j = 0; j < 4; ++j) { a[j] = silu_f(lo0[j]) * hi0[j]; b[j] = silu_f(lo1[j]) * hi1[j]; }
        *(u32x4*)(ACT + (size_t)row * 512 + u.pn * 128 + c0) = pack8(a, b);
    }
};
struct EpiMoe2 {
    bf16_t* Y;
    __device__ __forceinline__ void seg(const Unit& u, int, int r, int c0, f32x4& lo0, f32x4& lo1, f32x4& hi0, f32x4& hi1) const {
        bf16_t* d = Y + (size_t)(u.pm * 256 + r) * 1024 + u.pn * 256 + c0;
        *(u32x4*)d = pack8(lo0, lo1); *(u32x4*)(d + 128) = pack8(hi0, hi1);
    }
};

#define LAS __attribute__((address_space(3)))
typedef short bf16x8 __attribute__((ext_vector_type(8)));
constexpr int HTB = 128 * 64 * 2;
__device__ __forceinline__ int lds_byte(int r, int c) { const int st = (r >> 4) * 2 + (c >> 5), rr = r & 15, cc = c & 31, ob = rr * 64 + cc * 2; return st * 1024 + (ob ^ (((ob >> 9) & 1) << 5)); }
__device__ __forceinline__ void stage_rc(int b, int& R, int& C) { const int st = b / 1024, sb = b % 1024, swz = sb ^ (((sb >> 9) & 1) << 5); R = (st >> 1) * 16 + swz / 64; C = (st & 1) * 32 + (swz % 64) / 2; }
__device__ __forceinline__ int perm32(int rho) { const int n = rho >> 4, i = rho & 15; return 8 * (i >> 2) + 4 * n + (i & 3); }

template <bool GATHER, class Sched, class Epi>
__device__ __forceinline__ void gemm_mfma(LAS unsigned char* lds, const Sched& S, const Epi& E, const int K, const int lda, const int ldb, const int nseg) {
    const int tid = tid_fresh(), wid = __builtin_amdgcn_readfirstlane(tid >> 6), lane = tid & 63, wr = wid >> 2, wc = wid & 3, fr = lane & 15, fq = lane >> 4;
    const int nt = K / 64, tseg = nt / nseg;
    unsigned vA0[2], vA1[2], nA0[2], nA1[2], voffB[2]; int rowA[2], colA[2];
#pragma unroll
    for (int i = 0; i < 2; ++i) { int R, C; stage_rc(tid * 16 + i * 8192, R, C); const int Rb = (R & ~31) + perm32(R & 31);
        rowA[i] = R; colA[i] = C;
        vA0[i] = (unsigned)(R * lda + C) * 2u; vA1[i] = vA0[i] + (unsigned)(128 * lda * 2); nA0[i] = vA0[i]; nA1[i] = vA1[i];
        voffB[i] = (unsigned)(Rb * ldb + C) * 2u; }
    const size_t kstep = 128;
    const size_t hstepB = (size_t)128 * ldb * 2;
    const unsigned ldsw = (unsigned)wid * 1024u;
    const int aoff = lds_byte(wr * 64 + fr, fq * 8), boff = lds_byte(wc * 32 + fr, fq * 8);
#define PG8_SA(b, h) (((b) * 2 + (h)) * HTB)
#define PG8_SB(b, h) ((4 + (b) * 2 + (h)) * HTB)
#define PG8_STAGE(bufoff, gbase, voff) do { _Pragma("unroll") for (int _i = 0; _i < 2; ++_i) \
        __builtin_amdgcn_global_load_lds((const unsigned*)((const char*)(gbase) + (voff)[_i]), (LAS unsigned*)(lds + (bufoff) + ldsw + _i * 8192), 16, 0, 0); } while (0)
#define PG8_LDA(dst, b, h) do { _Pragma("unroll") for (int m = 0; m < 4; ++m) _Pragma("unroll") for (int k = 0; k < 2; ++k) dst[m][k] = *(const LAS bf16x8*)(lds + PG8_SA(b, h) + aoff + m * 2048 + k * 1024); } while (0)
#define PG8_LDB(dst, b, h) do { _Pragma("unroll") for (int n = 0; n < 2; ++n) _Pragma("unroll") for (int k = 0; k < 2; ++k) dst[n][k] = *(const LAS bf16x8*)(lds + PG8_SB(b, h) + boff + n * 2048 + k * 1024); } while (0)
#define PG8_MMA(ai, bj, At, Bt) do { __builtin_amdgcn_s_setprio(1); _Pragma("unroll") for (int m = 0; m < 4; ++m) _Pragma("unroll") for (int n = 0; n < 2; ++n) _Pragma("unroll") for (int k = 0; k < 2; ++k) \
        acc[ai][bj][m][n] = __builtin_amdgcn_mfma_f32_16x16x32_bf16(Bt[n][k], At[m][k], acc[ai][bj][m][n], 0, 0, 0); __builtin_amdgcn_s_setprio(0); } while (0)
#define PG8_WAIT_V(n) asm volatile("s_waitcnt vmcnt(" #n ")" ::: "memory")
#define PG8_WAIT_L(n) asm volatile("s_waitcnt lgkmcnt(" #n ")" ::: "memory")
#define PG8_BAR __builtin_amdgcn_s_barrier()
#define PG8_SCHED __builtin_amdgcn_sched_barrier(0)
#define PG8_EPI(sg) do { _Pragma("unroll") for (int ai = 0; ai < 2; ++ai) _Pragma("unroll") for (int m = 0; m < 4; ++m) { \
        int r_ = ai * 128 + wr * 64 + m * 16 + fr; asm volatile("" : "+v"(r_));     \
        E.seg(cur, (sg), r_, wc * 32 + fq * 8, acc[ai][0][m][0], acc[ai][0][m][1], acc[ai][1][m][0], acc[ai][1][m][1]); } } while (0)
    Unit cur, nxt; int ui = 0;
    if (!S.next(0, cur)) return;
    f32x4 acc[2][2][4][2];
#pragma unroll
    for (int a = 0; a < 2; ++a)
#pragma unroll
        for (int b = 0; b < 2; ++b)
#pragma unroll
            for (int m = 0; m < 4; ++m)
#pragma unroll
                for (int n = 0; n < 2; ++n) acc[a][b][m][n] = (f32x4){0.f, 0.f, 0.f, 0.f};
    bf16x8 At[4][2], B0[2][2], B1[2][2];
    const char* cA = (const char*)cur.A; const char* cB = (const char*)cur.B;
    if (GATHER) {
#pragma unroll
        for (int i = 0; i < 2; ++i) { vA0[i] = (unsigned)(cur.tok[rowA[i]] * lda + colA[i]) * 2u; vA1[i] = (unsigned)(cur.tok[128 + rowA[i]] * lda + colA[i]) * 2u; nA0[i] = vA0[i]; nA1[i] = vA1[i]; }
    }
    PG8_STAGE(PG8_SB(0, 0), cB, voffB); PG8_STAGE(PG8_SA(0, 0), cA, vA0); PG8_STAGE(PG8_SB(0, 1), cB + hstepB, voffB); PG8_STAGE(PG8_SA(0, 1), cA, vA1);
    if (wr == 1) PG8_BAR;
    PG8_WAIT_V(4); PG8_BAR;
    PG8_STAGE(PG8_SB(1, 0), cB + kstep, voffB); PG8_STAGE(PG8_SA(1, 0), cA + kstep, vA0); PG8_STAGE(PG8_SB(1, 1), cB + hstepB + kstep, voffB);
    PG8_WAIT_V(6); PG8_BAR;
    for (;;) {
        const bool has_next = S.next(ui + 1, nxt);
        const char* nA = has_next ? (const char*)nxt.A : cA; const char* nB = has_next ? (const char*)nxt.B : cB;
        if (GATHER) {
            const int* tk = has_next ? nxt.tok : cur.tok;
#pragma unroll
            for (int i = 0; i < 2; ++i) { nA0[i] = (unsigned)(tk[rowA[i]] * lda + colA[i]) * 2u; nA1[i] = (unsigned)(tk[128 + rowA[i]] * lda + colA[i]) * 2u; }
        }
#pragma nounroll
        for (int sg = 0; sg < nseg; ++sg) {
#pragma nounroll
        for (int tt = 0; tt < tseg; tt += 2) {
            const int t = sg * tseg + tt;
            const bool last = (t == nt - 2);
            const char* a1 = cA + (size_t)(t + 1) * kstep;
            const char* a2 = last ? nA : cA + (size_t)(t + 2) * kstep; const char* b2 = last ? nB : cB + (size_t)(t + 2) * kstep;
            const char* a3 = a2 + kstep; const char* b3 = b2 + kstep;
            unsigned w0[2], w1[2];
#pragma unroll
            for (int i = 0; i < 2; ++i) { w0[i] = last ? nA0[i] : vA0[i]; w1[i] = last ? nA1[i] : vA1[i]; }
            PG8_LDB(B0, 0, 0); PG8_SCHED; PG8_LDA(At, 0, 0); PG8_STAGE(PG8_SA(1, 1), a1, vA1);
            PG8_WAIT_L(8); PG8_BAR; PG8_WAIT_L(0); PG8_MMA(0, 0, At, B0); PG8_BAR; PG8_SCHED;
            PG8_LDB(B1, 0, 1); PG8_STAGE(PG8_SB(0, 0), b2, voffB);
            PG8_BAR; PG8_WAIT_L(0); PG8_MMA(0, 1, At, B1); PG8_BAR;
            PG8_LDA(At, 0, 1); PG8_STAGE(PG8_SA(0, 0), a2, w0);
            PG8_BAR; PG8_WAIT_L(0); PG8_MMA(1, 0, At, B0); PG8_BAR; PG8_SCHED;
            PG8_STAGE(PG8_SB(0, 1), b2 + hstepB, voffB);
            PG8_WAIT_V(6); PG8_BAR; PG8_MMA(1, 1, At, B1); PG8_BAR;
            PG8_LDB(B0, 1, 0); PG8_SCHED; PG8_LDA(At, 1, 0); PG8_STAGE(PG8_SA(0, 1), a2, w1);
            PG8_WAIT_L(8); PG8_BAR; PG8_WAIT_L(0); PG8_MMA(0, 0, At, B0); PG8_BAR; PG8_SCHED;
            PG8_LDB(B1, 1, 1); PG8_STAGE(PG8_SB(1, 0), b3, voffB);
            PG8_BAR; PG8_WAIT_L(0); PG8_MMA(0, 1, At, B1); PG8_BAR;
            PG8_LDA(At, 1, 1); PG8_STAGE(PG8_SA(1, 0), a3, w0);
            PG8_BAR; PG8_WAIT_L(0); PG8_MMA(1, 0, At, B0); PG8_BAR; PG8_SCHED;
            PG8_STAGE(PG8_SB(1, 1), b3 + hstepB, voffB);
            PG8_WAIT_V(6); PG8_BAR; PG8_MMA(1, 1, At, B1); PG8_BAR;
        }
        PG8_EPI(sg);
        }
        if (!has_next) break;
#pragma unroll
        for (int a = 0; a < 2; ++a)
#pragma unroll
            for (int b = 0; b < 2; ++b)
#pragma unroll
                for (int m = 0; m < 4; ++m)
#pragma unroll
                    for (int n = 0; n < 2; ++n) acc[a][b][m][n] = (f32x4){0.f, 0.f, 0.f, 0.f};
        cur = nxt; cA = nA; cB = nB; ++ui;
#pragma unroll
        for (int i = 0; i < 2; ++i) { vA0[i] = nA0[i]; vA1[i] = nA1[i]; }
    }
    PG8_WAIT_V(0);
    if (wr == 0) PG8_BAR;
    PG8_BAR;
#undef PG8_SA
#undef PG8_SB
#undef PG8_STAGE
#undef PG8_LDA
#undef PG8_LDB
#undef PG8_MMA
#undef PG8_WAIT_V
#undef PG8_WAIT_L
#undef PG8_BAR
#undef PG8_SCHED
#undef PG8_EPI
}

template <bool GATHER = false, class Sched, class Epi>
__device__ __forceinline__ void gemm_run(unsigned char* lds, const Sched& S, const Epi& E, int K, int lda, int ldb, int nseg) {
    __syncthreads();
    gemm_mfma<GATHER>((LAS unsigned char*)lds, S, E, K, lda, ldb, nseg);
    __syncthreads();
}

struct TrDesc { const float* src; const float* cscale; bf16_t* dst; int ld_src, ld_dst, valid; };
__device__ __forceinline__ void tr_load(const TrDesc& d, f32x4 (&v)[16]) {
    if (d.src) {
#pragma unroll
        for (int i = 0; i < 16; ++i) v[i] = *(const f32x4*)(d.src + (size_t)(4 * i) * d.ld_src);
    } else {
#pragma unroll
        for (int i = 0; i < 16; ++i) v[i] = (f32x4){0.f, 0.f, 0.f, 0.f};
    }
}
__device__ __forceinline__ void tr_store(const TrDesc& d, f32x4 (&v)[16], float* scr, int lane) {
    const int c4 = (lane & 15) * 4, kr = lane >> 4;
    if (d.cscale) { const f32x4 s = *(const f32x4*)d.cscale;
#pragma unroll
        for (int i = 0; i < 16; ++i) v[i] = v[i] * s; }
#pragma unroll
    for (int i = 0; i < 16; ++i) { float* q = scr + (kr + 4 * i) * 65 + c4; q[0] = v[i][0]; q[1] = v[i][1]; q[2] = v[i][2]; q[3] = v[i][3]; }
    asm volatile("s_waitcnt lgkmcnt(0)" ::: "memory");
    const int c = lane & 7;
#pragma unroll
    for (int j = 0; j < 8; ++j) { const int n = (lane >> 3) + 8 * j; const float* s = scr + (8 * c) * 65 + n;
        u32x4 o; o.x = pk2(s[0 * 65], s[1 * 65]); o.y = pk2(s[2 * 65], s[3 * 65]); o.z = pk2(s[4 * 65], s[5 * 65]); o.w = pk2(s[6 * 65], s[7 * 65]);
        *(u32x4*)(d.dst + (size_t)n * d.ld_dst + 8 * c) = o; }
    asm volatile("s_waitcnt lgkmcnt(0)" ::: "memory");
}
__device__ __forceinline__ TrDesc tr_desc(const float* W, int ld_src, int srcq, bf16_t* WT, int ld_dst, int n_dst, int kdst0, int k0, int lane, const float* cscale = nullptr) {
    TrDesc d; d.ld_src = ld_src; d.ld_dst = ld_dst; d.valid = 1;
    d.src = srcq >= 0 ? W + (size_t)(k0 + (lane >> 4)) * ld_src + srcq : nullptr;
    d.cscale = (cscale && srcq >= 0) ? cscale + srcq : nullptr;
    d.dst = WT + (size_t)n_dst * ld_dst + kdst0 + k0; return d;
}
constexpr int CV_MIX_ITEMS = 2880 + 64 + 768 + 256;
constexpr int CV_EXP_ITEMS = 32 * 384;
__device__ __forceinline__ TrDesc convert_desc(const Params& p, int le, int lm, int it, int lane) {
    unsigned char* ws = p.ws;
    const int c4 = (lane & 15) * 4;
    if (le >= 0) {
        if (it < CV_EXP_ITEMS) {
            const int e = it / 384, r = it % 384;
            if (r < 256) { const int up = r >> 7, q = r & 127, kb = q >> 3, nb = q & 7; const int c = nb * 64;
                const float* src = (up ? p.w_eu : p.w_eg) + (size_t)(le * 32 + e) * 1024 * 512;
                return tr_desc(src, 512, c + c4, (bf16_t*)(ws + WS_EW1) + (size_t)e * 1048576, 1024, (c >> 7) * 256 + up * 128 + (c & 127), 0, kb * 64, lane); }
            const int q = r - 256, kb = q >> 4, nb = q & 15;
            return tr_desc(p.w_ed + (size_t)(le * 32 + e) * 512 * 1024, 1024, nb * 64 + c4, (bf16_t*)(ws + WS_EW2) + (size_t)e * 524288, 512, nb * 64, 0, kb * 64, lane);
        }
        it -= CV_EXP_ITEMS;
    }
    const int l = lm;
    if (it < 2880) { const int R = it >> 4, kb = it & 15, dstn = R * 64; int srcq;
        if (R < 80) srcq = dstn + c4; else if (R < 128) srcq = dstn + 16 + c4; else if (R < 176) srcq = dstn + 48 + c4;
        else if (R == 176) srcq = c4 < 32 ? 8208 + c4 : (c4 < 48 ? 5120 + (c4 - 32) : -1); else srcq = -1;
        return tr_desc(p.w_in + (size_t)l * 1024 * DIN, DIN, srcq, (bf16_t*)(ws + WS_WIN), 1024, dstn, 0, kb * 64, lane); }
    it -= 2880;
    if (it < 64) { const int g = it >> 4, r = it & 15, kb = r >> 2, nb = r & 3;
        return tr_desc(p.pool_w + (size_t)(l * 4 + g) * 65536, 256, nb * 64 + c4, (bf16_t*)(ws + WS_WPOOL) + (size_t)g * 65536, 256, nb * 64, 0, kb * 64, lane, p.pool_scale + l * 1024 + g * 256); }
    it -= 64;
    if (it < 768) { const int br = it >> 8, r = it & 255, kb = r >> 4, nb = r & 15;
        return tr_desc(p.w_branch + (size_t)(l * 3 + br) * 1048576, 1024, nb * 64 + c4, (bf16_t*)(ws + WS_WBR), 3072, nb * 64, br * 1024, kb * 64, lane); }
    it -= 768;
    { const int kb = it >> 4, nb = it & 15;
      return tr_desc(p.w_out + (size_t)l * 1048576, 1024, nb * 64 + c4, (bf16_t*)(ws + WS_WOUT), 1024, nb * 64, 0, kb * 64, lane); }
}
__device__ __forceinline__ void convert_run(const Params& p, int le, int lm, int first, int step, float* scr, int lane) {
    const int nitems = (le >= 0 ? CV_EXP_ITEMS : 0) + (lm >= 0 ? CV_MIX_ITEMS : 0);
    if (first >= nitems) return;
    f32x4 va[16], vb[16];
    TrDesc da = convert_desc(p, le, lm, first, lane), db;
    tr_load(da, va);
    for (int it = first; it < nitems; it += 2 * step) {
        const int i1 = it + step, i2 = it + 2 * step;
        if (i1 < nitems) { db = convert_desc(p, le, lm, i1, lane); tr_load(db, vb); }
        tr_store(da, va, scr, lane);
        if (i1 >= nitems) break;
        if (i2 < nitems) { da = convert_desc(p, le, lm, i2, lane); tr_load(da, va); }
        tr_store(db, vb, scr, lane);
    }
}

__device__ __forceinline__ void phase_pre(const Params& p, unsigned char* ldsb, int bid, int nb) {
    float* lds = reinterpret_cast<float*>(ldsb);
    const int tid = tid_fresh(), lane = tid & 63, wave = tid >> 6;
    for (int i = tid; i < 5 * 1024; i += NTHR) { const float v = i < 4096 ? p.c[i] : p.c_ctx[i - 4096]; lds[i] = silu_f(v); }
    __syncthreads();
    float* red = lds + 5120;
    for (int it = bid; it < 2 * 96; it += nb) {
        const int l = it / 96, j = (it % 96) * 64 + lane;
        const float* w = p.w_ada + (size_t)l * 1024 * 6144 + j;
        float a0 = 0, a1 = 0, a2 = 0, a3 = 0, a4 = 0;
        for (int k = wave * 128; k < wave * 128 + 128; ++k) { const float wv = w[(size_t)k * 6144];
            a0 += lds[k] * wv; a1 += lds[1024 + k] * wv; a2 += lds[2048 + k] * wv; a3 += lds[3072 + k] * wv; a4 += lds[4096 + k] * wv; }
        red[(wave * 5 + 0) * 64 + lane] = a0; red[(wave * 5 + 1) * 64 + lane] = a1; red[(wave * 5 + 2) * 64 + lane] = a2;
        red[(wave * 5 + 3) * 64 + lane] = a3; red[(wave * 5 + 4) * 64 + lane] = a4;
        __syncthreads();
        if (tid < 320) { const int r = tid >> 6, jj = tid & 63; float s = 0;
            for (int w8 = 0; w8 < 8; ++w8) s += red[(w8 * 5 + r) * 64 + jj];
            const int col = (it % 96) * 64 + jj;
            ((float*)(p.ws + WS_MOD))[(size_t)(l * 5 + r) * 6144 + col] = s + p.b_ada[l * 6144 + col]; }
        __syncthreads();
    }
    __syncthreads();
    float* scr = lds + wave * (64 * 65);
    convert_run(p, -1, 0, bid * 8 + wave, nb * 8, scr, lane);
}

__device__ __forceinline__ void norm_mod_row(f32x4 (&v)[4], const float* g, const float* shift, const float* scale, int lane) {
    float s = 0.f;
#pragma unroll
    for (int j = 0; j < 4; ++j) s += (v[j][0] * v[j][0] + v[j][1] * v[j][1]) + (v[j][2] * v[j][2] + v[j][3] * v[j][3]);
    const float rs = __builtin_amdgcn_rsqf(wave_sum(s) * (1.f / 1024.f) + EPS);
#pragma unroll
    for (int j = 0; j < 4; ++j) { const int c = 4 * lane + 256 * j; const f32x4 gg = *(const f32x4*)(g + c);
        f32x4 y = v[j] * rs * gg;
        if (shift) { const f32x4 sh = *(const f32x4*)(shift + c), sc = *(const f32x4*)(scale + c); y = y * (1.f + sc) + sh; }
        v[j] = y; }
}
__device__ __forceinline__ void store_row_bf16(bf16_t* dst, const f32x4 (&v)[4], int lane) {
#pragma unroll
    for (int j = 0; j < 4; ++j) { u32x2 w; w.x = pk2(v[j][0], v[j][1]); w.y = pk2(v[j][2], v[j][3]); *(u32x2*)(dst + 4 * lane + 256 * j) = w; }
}

__device__ __forceinline__ void phase_norm1(const Params& p, int bid, int nb) {
    const int lane = tid_fresh() & 63, wave = tid_fresh() >> 6;
    const float* mod = (const float*)(p.ws + WS_MOD);
    const int stride = nb * 8;
    int m = bid * 8 + wave;
    f32x4 v[4], w[4];
    if (m < MT) { const float* src = m < MC ? p.ctx + (size_t)m * 1024 : p.x + (size_t)(m - MC) * 1024;
#pragma unroll
        for (int j = 0; j < 4; ++j) v[j] = *(const f32x4*)(src + 4 * lane + 256 * j); }
    for (; m < MT; m += stride) {
        const int mn = m + stride;
        if (mn < MT) { const float* src = mn < MC ? p.ctx + (size_t)mn * 1024 : p.x + (size_t)(mn - MC) * 1024;
#pragma unroll
            for (int j = 0; j < 4; ++j) w[j] = *(const f32x4*)(src + 4 * lane + 256 * j); }
        const float* mr = mod + modrow(m) * 6144;
        norm_mod_row(v, p.g_mix, mr, mr + 1024, lane);
        store_row_bf16((bf16_t*)(p.ws + WS_H) + (size_t)m * 1024, v, lane);
#pragma unroll
        for (int j = 0; j < 4; ++j) v[j] = w[j];
    }
}

__device__ __forceinline__ float wave_incl_sum(float v, int lane) {
#pragma unroll
    for (int o = 1; o < 64; o <<= 1) { const float u = __shfl_up(v, o); if (lane >= o) v += u; }
    return v;
}
__device__ __forceinline__ float wave_incl_max(float v, int lane) {
#pragma unroll
    for (int o = 1; o < 64; o <<= 1) { const float u = __shfl_up(v, o); if (lane >= o) v = fmaxf(v, u); }
    return v;
}
__device__ __forceinline__ u32x2 pack4(f32x4 a) { u32x2 w; w.x = pk2(a[0], a[1]); w.y = pk2(a[2], a[3]); return w; }

__device__ __forceinline__ void chunk_geom(int gc, int& rbase, int& n0, int& len) {
    const int b = gc / 68, cin = gc % 68;
    if (cin < 4) { rbase = b * 256; n0 = cin * 64; len = 256; } else { rbase = MC + b * 4096; n0 = (cin - 4) * 64; len = 4096; }
}
__device__ __forceinline__ void conv8x4(const u32x4 (&raw)[7], const float* cw, const float* cb, int ch0, float scale, u32x4 (&out)[4]) {
    float w[4][8], bs[8];
#pragma unroll
    for (int j = 0; j < 4; ++j) { const f32x4 a = *(const f32x4*)(cw + j * 2048 + ch0), b2 = *(const f32x4*)(cw + j * 2048 + ch0 + 4);
#pragma unroll
        for (int i = 0; i < 4; ++i) { w[j][i] = a[i]; w[j][4 + i] = b2[i]; } }
    { const f32x4 a = *(const f32x4*)(cb + ch0), b2 = *(const f32x4*)(cb + ch0 + 4);
#pragma unroll
      for (int i = 0; i < 4; ++i) { bs[i] = a[i]; bs[4 + i] = b2[i]; } }
    float f[7][8];
#pragma unroll
    for (int k = 0; k < 7; ++k) unpack8(raw[k], f[k]);
#pragma unroll
    for (int pp = 0; pp < 4; ++pp) { f32x4 o0, o1;
#pragma unroll
        for (int i = 0; i < 8; ++i) { float a = bs[i];
#pragma unroll
            for (int j = 0; j < 4; ++j) a += w[j][i] * f[pp + j][i];
            a = silu_f(a) * scale; if (i < 4) o0[i] = a; else o1[i - 4] = a; }
        out[pp] = pack8(o0, o1); }
}
__device__ __forceinline__ void load_raw7(const bf16_t* src, size_t ld, int rbase, int tbase, int len, u32x4 (&raw)[7]) {
#pragma unroll
    for (int k = 0; k < 7; ++k) { const int t = tbase + k; const bool ok = (t >= 0) && (t < len); const int tc = t < 0 ? 0 : (t >= len ? len - 1 : t);
        u32x4 a = *(const u32x4*)(src + (size_t)(rbase + tc) * ld);
        if (!ok) a = (u32x4){0u, 0u, 0u, 0u};
        raw[k] = a; }
}
template <class F>
__device__ __forceinline__ void tile_transpose_out(const LAS bf16_t* tile, int ldsw, int ncol, int tid, F rowptr) {
    for (int q = tid; q < ncol * 8; q += NTHR) { const int c = q % ncol, sc = q / ncol;
        unsigned v[8];
#pragma unroll
        for (int i = 0; i < 8; ++i) v[i] = tile[(sc * 8 + i) * ldsw + c];
        u32x4 w; w.x = v[0] | (v[1] << 16); w.y = v[2] | (v[3] << 16); w.z = v[4] | (v[5] << 16); w.w = v[6] | (v[7] << 16);
        *(u32x4*)(rowptr(c) + sc * 8) = w; }
}

__device__ __forceinline__ void conv_m_item(const Params& p, int l, int item, LAS unsigned char* lds) {
    const int tid = tid_fresh(), gc = item >> 2, hd = item & 3;
    int rbase, n0, len; chunk_geom(gc, rbase, n0, len);
    const int cs = tid & 31, tg = tid >> 5, d0 = cs * 8, i0 = tg * 4;
    const float* cw = p.mconv_w + (size_t)l * 4 * 2048; const float* cb = p.mconv_b + (size_t)l * 2048;
    LAS bf16_t* Kl = (LAS bf16_t*)lds; LAS bf16_t* Vl = (LAS bf16_t*)(lds + 64 * 528);
    __syncthreads();
    { u32x4 raw[7], o[4];
      load_raw7((const bf16_t*)(p.ws + WS_Q) + hd * 256 + d0, 1024, rbase, n0 + i0 - 2, len, raw);
      conv8x4(raw, cw, cb, hd * 256 + d0, 1.0f, o);
#pragma unroll
      for (int pp = 0; pp < 4; ++pp) *(u32x4*)((bf16_t*)(p.ws + WS_QC) + (size_t)(rbase + n0 + i0 + pp) * 1024 + hd * 256 + d0) = o[pp];
      load_raw7((const bf16_t*)(p.ws + WS_K) + hd * 256 + d0, 1024, rbase, n0 + i0 - 2, len, raw);
      conv8x4(raw, cw, cb, 1024 + hd * 256 + d0, 0.0625f, o);
#pragma unroll
      for (int pp = 0; pp < 4; ++pp) { *(u32x4*)((bf16_t*)(p.ws + WS_KC) + (size_t)(rbase + n0 + i0 + pp) * 1024 + hd * 256 + d0) = o[pp];
          *(LAS u32x4*)((LAS unsigned char*)Kl + (i0 + pp) * 528 + d0 * 2) = o[pp]; } }
#pragma unroll
    for (int j = 0; j < 4; ++j) { const int q = tid + NTHR * j, row = q >> 5, ch = q & 31;
        *(LAS u32x4*)((LAS unsigned char*)Vl + row * 528 + ch * 16) = *(const u32x4*)((const bf16_t*)(p.ws + WS_V) + (size_t)(rbase + n0 + row) * 1024 + hd * 256 + ch * 8); }
    __syncthreads();
    bf16_t* kct = (bf16_t*)(p.ws + WS_KCT) + (size_t)(gc * 4 + hd) * 16384; bf16_t* vt = (bf16_t*)(p.ws + WS_VT) + (size_t)(gc * 4 + hd) * 16384;
    tile_transpose_out(Kl, 264, 256, tid, [&](int c) { return kct + c * 64; });
    tile_transpose_out(Vl, 264, 256, tid, [&](int c) { return vt + c * 64; });
}

__device__ __forceinline__ void conv_s_item(const Params& p, int l, int item, LAS unsigned char* lds) {
    const int tid = tid_fresh(), gc = item >> 2, grp = item & 3;
    int rbase, n0, len; chunk_geom(gc, rbase, n0, len);
    const int cs = tid & 31, tg = tid >> 5, i0 = tg * 4;
    const float* cw = p.sconv_w + (size_t)l * 4 * 2048; const float* cb = p.sconv_b + (size_t)l * 2048;
    LAS bf16_t* Bl = (LAS bf16_t*)lds; LAS bf16_t* Xl = (LAS bf16_t*)(lds + 64 * 272);
    __syncthreads();
    { u32x4 raw[7], o[4];
      const int isC = cs >> 4, nn = (cs & 15) * 8;
      load_raw7((const bf16_t*)(p.ws + (isC ? WS_SC : WS_SB)) + grp * 128 + nn, 512, rbase, n0 + i0 - 2, len, raw);
      conv8x4(raw, cw, cb, 1024 + isC * 512 + grp * 128 + nn, 1.0f, o);
      bf16_t* dst = (bf16_t*)(p.ws + (isC ? WS_CC : WS_BC)) + grp * 128 + nn;
#pragma unroll
      for (int pp = 0; pp < 4; ++pp) { *(u32x4*)(dst + (size_t)(rbase + n0 + i0 + pp) * 512) = o[pp];
          if (!isC) *(LAS u32x4*)((LAS unsigned char*)Bl + (i0 + pp) * 272 + nn * 2) = o[pp]; }
      load_raw7((const bf16_t*)(p.ws + WS_SX) + grp * 256 + cs * 8, 1024, rbase, n0 + i0 - 2, len, raw);
      conv8x4(raw, cw, cb, grp * 256 + cs * 8, 1.0f, o);
#pragma unroll
      for (int pp = 0; pp < 4; ++pp) *(LAS u32x4*)((LAS unsigned char*)Xl + (i0 + pp) * 528 + cs * 16) = o[pp]; }
    __syncthreads();
    bf16_t* bct = (bf16_t*)(p.ws + WS_BCT) + (size_t)(gc * 4 + grp) * 8192; bf16_t* xct = (bf16_t*)(p.ws + WS_XCT) + (size_t)(gc * 16 + grp * 4) * 4096;
    tile_transpose_out(Bl, 136, 128, tid, [&](int c) { return bct + c * 64; });
    tile_transpose_out(Xl, 264, 256, tid, [&](int c) { return xct + c * 64; });
}

__device__ __forceinline__ void pool_window_item(const Params& p, int it, LAS unsigned char* lds) {
    const int tid = tid_fresh();
    bf16_t* BR = (bf16_t*)(p.ws + WS_BR);
    __syncthreads();
    if (it < 256) {
        const int row0 = MC + it * 64;
        for (int q = tid; q < 64 * 128; q += NTHR) { const int r = q >> 7, ch = q & 127;
            *(LAS u32x4*)(lds + q * 16) = *(const u32x4*)(BR + (size_t)(row0 + r) * 3072 + ch * 8); }
        __syncthreads();
        for (int q = tid; q < 64 * 128; q += NTHR) { const int r = q >> 7, ch = q & 127, w = 2 << (ch >> 5);
            int lo = r - (w >> 1), hi = lo + w - 1; lo = lo < 0 ? 0 : lo; hi = hi > 63 ? 63 : hi;
            float s[8] = {0, 0, 0, 0, 0, 0, 0, 0}, self[8];
            for (int rr = lo; rr <= hi; ++rr) { float f[8]; unpack8(*(const LAS u32x4*)(lds + (rr * 128 + ch) * 16), f);
#pragma unroll
                for (int j = 0; j < 8; ++j) s[j] += f[j]; }
            unpack8(*(const LAS u32x4*)(lds + q * 16), self);
            const float inv = __builtin_amdgcn_rcpf((float)(hi - lo + 1)); f32x4 a, b;
#pragma unroll
            for (int j = 0; j < 4; ++j) { a[j] = s[j] * inv - self[j]; b[j] = s[4 + j] * inv - self[4 + j]; }
            *(u32x4*)(BR + (size_t)(row0 + r) * 3072 + ch * 8) = pack8(a, b); }
    } else {
        const int bb = (it - 256) >> 2, g = (it - 256) & 3, row0 = bb * 256, w = 2 << g;
        for (int q = tid; q < 256 * 32; q += NTHR) { const int r = q >> 5, ch = q & 31;
            *(LAS u32x4*)(lds + q * 16) = *(const u32x4*)(BR + (size_t)(row0 + r) * 3072 + g * 256 + ch * 8); }
        __syncthreads();
        for (int q = tid; q < 256 * 32; q += NTHR) { const int r = q >> 5, ch = q & 31;
            int lo = r - (w >> 1), hi = lo + w - 1; lo = lo < 0 ? 0 : lo; hi = hi > 255 ? 255 : hi;
            float s[8] = {0, 0, 0, 0, 0, 0, 0, 0}, self[8];
            for (int rr = lo; rr <= hi; ++rr) { float f[8]; unpack8(*(const LAS u32x4*)(lds + (rr * 32 + ch) * 16), f);
#pragma unroll
                for (int j = 0; j < 8; ++j) s[j] += f[j]; }
            unpack8(*(const LAS u32x4*)(lds + q * 16), self);
            const float inv = __builtin_amdgcn_rcpf((float)(hi - lo + 1)); f32x4 a, b;
#pragma unroll
            for (int j = 0; j < 4; ++j) { a[j] = s[j] * inv - self[j]; b[j] = s[4 + j] * inv - self[4 + j]; }
            *(u32x4*)(BR + (size_t)(row0 + r) * 3072 + g * 256 + ch * 8) = pack8(a, b); }
    }
    __syncthreads();
}

constexpr int ML_VT = 0, ML_VWT = 5280, ML_CT = 10560, ML_Q = 28512, ML_K = 63328, ML_KT = 98144, ML_A = 139104, ML_MISC = 149344;
__device__ __forceinline__ void mlstm_chunk_item(const Params& p, int l, int item, LAS unsigned char* lds) {
    const int tid = tid_fresh(), lane = tid & 63, wid = __builtin_amdgcn_readfirstlane(tid >> 6), fr = lane & 15, fq = lane >> 4;
    const int b = item >> 6, hd = (item >> 4) & 3, dir = (item >> 3) & 1, eg = item & 7;
    const bf16_t* QC = (const bf16_t*)(p.ws + WS_QC); const bf16_t* KC = (const bf16_t*)(p.ws + WS_KC);
    const bf16_t* KCT = (const bf16_t*)(p.ws + WS_KCT); const bf16_t* VT = (const bf16_t*)(p.ws + WS_VT);
    const float* GA = (const float*)(p.ws + WS_GA);
    bf16_t* OUT = (bf16_t*)(p.ws + (dir ? WS_HB2 : WS_HF2));
    LAS float* misc = (LAS float*)(lds + ML_MISC);
    const float gb_i = p.mgate_b[l * 16 + dir * 4 + hd], gb_f = p.mgate_b[l * 16 + (2 + dir) * 4 + hd];
    const int ti = wid >> 1, wh = wid & 1;
    __syncthreads();
    for (int i = tid; i < 17952 / 4; i += NTHR) ((LAS unsigned*)(lds + ML_CT))[i] = 0u;
    if (tid < 64) ((LAS bf16_t*)(lds + ML_VT + 32 * 160))[tid] = (bf16_t)0x3F80;
    f32x4 Cacc[2][3];
#pragma unroll
    for (int j = 0; j < 2; ++j)
#pragma unroll
        for (int e = 0; e < 3; ++e) Cacc[j][e] = (f32x4){0.f, 0.f, 0.f, 0.f};
    float m_st = 0.f;
    __syncthreads();
    for (int c = -1; c < 68; ++c) {
        const int cn = c + 1;
        u32x4 rq[4], rk[4], rt[4], rv = (u32x4){0u, 0u, 0u, 0u}; float g_i = 0.f, g_f = 0.f;
#pragma unroll
        for (int j = 0; j < 4; ++j) { rq[j] = (u32x4){0u, 0u, 0u, 0u}; rk[j] = rq[j]; rt[j] = rq[j]; }
        if (cn < 68) {
            const int cin = cn < 4 ? (dir ? 3 - cn : cn) : 4 + (dir ? 67 - cn : cn - 4), gc = b * 68 + cin;
            int rbase, n0, len; chunk_geom(gc, rbase, n0, len);
#pragma unroll
            for (int j = 0; j < 4; ++j) { const int q = tid + NTHR * j;
                const size_t ro = (size_t)(rbase + n0 + (q >> 5)) * 1024 + hd * 256 + (q & 31) * 8;
                rq[j] = *(const u32x4*)(QC + ro); rk[j] = *(const u32x4*)(KC + ro);
                rt[j] = *(const u32x4*)(KCT + (size_t)(gc * 4 + hd) * 16384 + (size_t)q * 8); }
            if (tid < 256) rv = *(const u32x4*)(VT + ((size_t)(gc * 4 + hd) * 256 + eg * 32) * 64 + (size_t)tid * 8);
            { const int j = dir ? 63 - lane : lane; const float* g = GA + (size_t)(rbase + n0 + j) * 16; g_i = g[dir * 4 + hd]; g_f = g[(2 + dir) * 4 + hd]; }
        }
        if (c >= 0) {
            const int cin = c < 4 ? (dir ? 3 - c : c) : 4 + (dir ? 67 - c : c - 4), gc = b * 68 + cin;
            int rbase, n0, len; chunk_geom(gc, rbase, n0, len);
            {
                f32x4 st[2] = {(f32x4){0.f, 0.f, 0.f, 0.f}, (f32x4){0.f, 0.f, 0.f, 0.f}};
                const LAS unsigned char* qb = lds + ML_Q + (16 * ti + fr) * 544 + fq * 16;
                const LAS unsigned char* kb0 = lds + ML_K + (16 * (2 * wh) + fr) * 544 + fq * 16;
#pragma unroll
                for (int kd = 0; kd < 8; ++kd) {
                    const bf16x8 qf = *(const LAS bf16x8*)(qb + kd * 64);
                    const bf16x8 k0 = *(const LAS bf16x8*)(kb0 + kd * 64), k1 = *(const LAS bf16x8*)(kb0 + 16 * 544 + kd * 64);
                    st[0] = __builtin_amdgcn_mfma_f32_16x16x32_bf16(k0, qf, st[0], 0, 0, 0);
                    st[1] = __builtin_amdgcn_mfma_f32_16x16x32_bf16(k1, qf, st[1], 0, 0, 0);
                }
                const int t = 16 * ti + fr; const float Mt = misc[64 + t];
#pragma unroll
                for (int j = 0; j < 2; ++j) { const int s0 = 16 * (2 * wh + j) + 4 * fq; const f32x4 av = *(const LAS f32x4*)(misc + s0);
                    f32x4 o;
#pragma unroll
                    for (int r = 0; r < 4; ++r) { const bool keep = dir ? (s0 + r >= t) : (s0 + r <= t); o[r] = keep ? st[j][r] * __expf(av[r] - Mt) : 0.f; }
                    *(LAS u32x2*)(lds + ML_A + t * 160 + s0 * 2) = pack4(o); }
                { const int e = tid >> 4, s4 = (tid & 15) * 4; const u32x2 v = *(const LAS u32x2*)(lds + ML_VT + e * 160 + s4 * 2); const f32x4 w = *(const LAS f32x4*)(misc + 256 + s4);
                  f32x4 o; o[0] = lo16(v.x) * w[0]; o[1] = hi16(v.x) * w[1]; o[2] = lo16(v.y) * w[2]; o[3] = hi16(v.y) * w[3];
                  *(LAS u32x2*)(lds + ML_VWT + e * 160 + s4 * 2) = pack4(o);
                  if (tid < 16) *(LAS u32x2*)(lds + ML_VWT + 32 * 160 + s4 * 2) = pack4(w); }
            }
            __syncthreads();
            {
                f32x4 n1o = (f32x4){0.f, 0.f, 0.f, 0.f}, n1a = n1o, n2o = n1o, n2a = n1o;
                const LAS unsigned char* ab = lds + ML_A + (16 * ti + fr) * 160 + fq * 16;
                const LAS unsigned char* vo = lds + ML_VT + (16 * wh + fr) * 160 + fq * 16;
                const LAS unsigned char* va = lds + ML_VT + (32 + fr) * 160 + fq * 16;
#pragma unroll
                for (int ks = 0; ks < 2; ++ks) { const bf16x8 af = *(const LAS bf16x8*)(ab + ks * 64);
                    n1o = __builtin_amdgcn_mfma_f32_16x16x32_bf16(af, *(const LAS bf16x8*)(vo + ks * 64), n1o, 0, 0, 0);
                    n1a = __builtin_amdgcn_mfma_f32_16x16x32_bf16(af, *(const LAS bf16x8*)(va + ks * 64), n1a, 0, 0, 0); }
                const LAS unsigned char* qb = lds + ML_Q + (16 * ti + fr) * 544 + fq * 16;
                const LAS unsigned char* co = lds + ML_CT + (16 * wh + fr) * 544 + fq * 16;
                const LAS unsigned char* ca = lds + ML_CT + (32 + fr) * 544 + fq * 16;
#pragma unroll
                for (int kd = 0; kd < 8; ++kd) { const bf16x8 qf = *(const LAS bf16x8*)(qb + kd * 64);
                    n2o = __builtin_amdgcn_mfma_f32_16x16x32_bf16(qf, *(const LAS bf16x8*)(co + kd * 64), n2o, 0, 0, 0);
                    n2a = __builtin_amdgcn_mfma_f32_16x16x32_bf16(qf, *(const LAS bf16x8*)(ca + kd * 64), n2a, 0, 0, 0); }
                const int t0 = 16 * ti + 4 * fq;
                const f32x4 sgv = *(const LAS f32x4*)(misc + 128 + t0), emv = *(const LAS f32x4*)(misc + 192 + t0);
                const bool wr_out = !(l == 1 && cin < 4);
#pragma unroll
                for (int r = 0; r < 4; ++r) {
                    const float den = __shfl(n1a[r] + sgv[r] * n2a[r], lane & 48);
                    const float hv = (n1o[r] + sgv[r] * n2o[r]) * __builtin_amdgcn_rcpf(fmaxf(fabsf(den), emv[r]));
                    if (wr_out) OUT[(size_t)(rbase + n0 + t0 + r) * 1024 + hd * 256 + eg * 32 + 16 * wh + fr] = (bf16_t)f2bf(hv);
                }
                const float decay = misc[320];
#pragma unroll
                for (int j = 0; j < 2; ++j)
#pragma unroll
                    for (int e = 0; e < 3; ++e) Cacc[j][e] = Cacc[j][e] * decay;
                const LAS unsigned char* kt = lds + ML_KT + (16 * (2 * wid) + fr) * 160 + fq * 16;
                const LAS unsigned char* vw = lds + ML_VWT + fr * 160 + fq * 16;
#pragma unroll
                for (int ks = 0; ks < 2; ++ks) {
                    const bf16x8 k0 = *(const LAS bf16x8*)(kt + ks * 64), k1 = *(const LAS bf16x8*)(kt + 16 * 160 + ks * 64);
                    const bf16x8 v0 = *(const LAS bf16x8*)(vw + ks * 64), v1 = *(const LAS bf16x8*)(vw + 16 * 160 + ks * 64), v2 = *(const LAS bf16x8*)(vw + 32 * 160 + ks * 64);
                    Cacc[0][0] = __builtin_amdgcn_mfma_f32_16x16x32_bf16(k0, v0, Cacc[0][0], 0, 0, 0);
                    Cacc[0][1] = __builtin_amdgcn_mfma_f32_16x16x32_bf16(k0, v1, Cacc[0][1], 0, 0, 0);
                    Cacc[0][2] = __builtin_amdgcn_mfma_f32_16x16x32_bf16(k0, v2, Cacc[0][2], 0, 0, 0);
                    Cacc[1][0] = __builtin_amdgcn_mfma_f32_16x16x32_bf16(k1, v0, Cacc[1][0], 0, 0, 0);
                    Cacc[1][1] = __builtin_amdgcn_mfma_f32_16x16x32_bf16(k1, v1, Cacc[1][1], 0, 0, 0);
                    Cacc[1][2] = __builtin_amdgcn_mfma_f32_16x16x32_bf16(k1, v2, Cacc[1][2], 0, 0, 0);
                }
            }
            __syncthreads();
#pragma unroll
            for (int j = 0; j < 2; ++j) { const int dcol = (16 * (2 * wid + j) + 4 * fq) * 2;
                *(LAS u32x2*)(lds + ML_CT + fr * 544 + dcol) = pack4(Cacc[j][0]);
                *(LAS u32x2*)(lds + ML_CT + (16 + fr) * 544 + dcol) = pack4(Cacc[j][1]);
                if (fr == 0) *(LAS u32x2*)(lds + ML_CT + 32 * 544 + dcol) = pack4(Cacc[j][2]); }
        }
        if (cn < 68) {
#pragma unroll
            for (int j = 0; j < 4; ++j) { const int q = tid + NTHR * j;
                *(LAS u32x4*)(lds + ML_Q + (q >> 5) * 544 + (q & 31) * 16) = rq[j];
                *(LAS u32x4*)(lds + ML_K + (q >> 5) * 544 + (q & 31) * 16) = rk[j];
                *(LAS u32x4*)(lds + ML_KT + (q >> 3) * 160 + (q & 7) * 16) = rt[j]; }
            if (tid < 256) *(LAS u32x4*)(lds + ML_VT + (tid >> 3) * 160 + (tid & 7) * 16) = rv;
            if (wid == 0) {
                const int j = dir ? 63 - lane : lane;
                const float ig = g_i + gb_i, lf = logsigmoid_f(g_f + gb_f);
                const float cum = wave_incl_sum(lf, lane), a = ig - cum, pm = wave_incl_max(a, lane);
                const float M = fmaxf(m_st, pm), sg = __expf(m_st - M), mt = cum + M;
                const float M63 = __shfl(M, 63), cum63 = __shfl(cum, 63);
                misc[j] = a; misc[64 + j] = M; misc[128 + j] = sg; misc[192 + j] = __expf(-mt); misc[256 + j] = __expf(a - M63);
                if (lane == 0) misc[320] = __expf(m_st - M63);
                m_st = cum63 + M63;
            }
        }
        __syncthreads();
    }
}

constexpr int SS_C = 0, SS_B = 18432, SS_BT = 36864, SS_XT = 57344, SS_XWT = 62464, SS_G = 67584, SS_S = 77824, SS_XRT = 87040, SS_MISC = 92160;
__device__ __forceinline__ void ssd_chunk_item(const Params& p, int l, int item, LAS unsigned char* lds) {
    const int tid = tid_fresh(), lane = tid & 63, wid = __builtin_amdgcn_readfirstlane(tid >> 6), fr = lane & 15, fq = lane >> 4;
    const int b = item >> 6, hd = (item >> 2) & 15, dir = (item >> 1) & 1, ps = item & 1, grp = hd >> 2;
    const bf16_t* BC = (const bf16_t*)(p.ws + WS_BC); const bf16_t* CC = (const bf16_t*)(p.ws + WS_CC);
    const bf16_t* BCT = (const bf16_t*)(p.ws + WS_BCT); const bf16_t* XCT = (const bf16_t*)(p.ws + WS_XCT);
    const float* DT = (const float*)(p.ws + WS_DT);
    bf16_t* OUT = (bf16_t*)(p.ws + (dir ? WS_YB : WS_YF));
    LAS float* misc = (LAS float*)(lds + SS_MISC);
    const float dtb = p.sdt_bias[l * 32 + dir * 16 + hd], aneg = -__expf(p.sa_log[l * 32 + dir * 16 + hd]), dskip = p.sd[l * 16 + hd];
    const int ti = wid >> 1, wh = wid & 1;
    __syncthreads();
    for (int i = tid; i < 9216 / 4; i += NTHR) ((LAS unsigned*)(lds + SS_S))[i] = 0u;
    f32x4 Sacc[2] = {(f32x4){0.f, 0.f, 0.f, 0.f}, (f32x4){0.f, 0.f, 0.f, 0.f}};
    __syncthreads();
    for (int c = -1; c < 68; ++c) {
        const int cn = c + 1;
        u32x4 rc[2], rb[2], rt[2], rx = (u32x4){0u, 0u, 0u, 0u}; float dtraw = 0.f;
#pragma unroll
        for (int j = 0; j < 2; ++j) { rc[j] = (u32x4){0u, 0u, 0u, 0u}; rb[j] = rc[j]; rt[j] = rc[j]; }
        if (cn < 68) {
            const int cin = cn < 4 ? (dir ? 3 - cn : cn) : 4 + (dir ? 67 - cn : cn - 4), gc = b * 68 + cin;
            int rbase, n0, len; chunk_geom(gc, rbase, n0, len);
#pragma unroll
            for (int j = 0; j < 2; ++j) { const int q = tid + NTHR * j;
                const size_t ro = (size_t)(rbase + n0 + (q >> 4)) * 512 + grp * 128 + (q & 15) * 8;
                rc[j] = *(const u32x4*)(CC + ro); rb[j] = *(const u32x4*)(BC + ro);
                rt[j] = *(const u32x4*)(BCT + (size_t)(gc * 4 + grp) * 8192 + (size_t)q * 8); }
            if (tid < 256) rx = *(const u32x4*)(XCT + ((size_t)(gc * 16 + hd) * 64 + ps * 32) * 64 + (size_t)tid * 8);
            { const int j = dir ? 63 - lane : lane; dtraw = DT[(size_t)(rbase + n0 + j) * 32 + dir * 16 + hd]; }
        }
        if (c >= 0) {
            const int cin = c < 4 ? (dir ? 3 - c : c) : 4 + (dir ? 67 - c : c - 4), gc = b * 68 + cin;
            int rbase, n0, len; chunk_geom(gc, rbase, n0, len);
            {
                f32x4 st[2] = {(f32x4){0.f, 0.f, 0.f, 0.f}, (f32x4){0.f, 0.f, 0.f, 0.f}};
                const LAS unsigned char* cbp = lds + SS_C + (16 * ti + fr) * 288 + fq * 16;
                const LAS unsigned char* bb0 = lds + SS_B + (16 * (2 * wh) + fr) * 288 + fq * 16;
#pragma unroll
                for (int kn = 0; kn < 4; ++kn) {
                    const bf16x8 cf = *(const LAS bf16x8*)(cbp + kn * 64);
                    const bf16x8 b0 = *(const LAS bf16x8*)(bb0 + kn * 64), b1 = *(const LAS bf16x8*)(bb0 + 16 * 288 + kn * 64);
                    st[0] = __builtin_amdgcn_mfma_f32_16x16x32_bf16(b0, cf, st[0], 0, 0, 0);
                    st[1] = __builtin_amdgcn_mfma_f32_16x16x32_bf16(b1, cf, st[1], 0, 0, 0);
                }
                const int t = 16 * ti + fr; const float at = misc[t];
#pragma unroll
                for (int j = 0; j < 2; ++j) { const int s0 = 16 * (2 * wh + j) + 4 * fq; const f32x4 av = *(const LAS f32x4*)(misc + s0);
                    f32x4 o;
#pragma unroll
                    for (int r = 0; r < 4; ++r) { const bool keep = dir ? (s0 + r >= t) : (s0 + r <= t); o[r] = keep ? st[j][r] * __expf(at - av[r]) : 0.f; }
                    *(LAS u32x2*)(lds + SS_G + t * 160 + s0 * 2) = pack4(o); }
                { const int e = tid >> 4, s4 = (tid & 15) * 4; const u32x2 v = *(const LAS u32x2*)(lds + SS_XRT + e * 160 + s4 * 2);
                  const f32x4 w = *(const LAS f32x4*)(misc + 128 + s4), dv = *(const LAS f32x4*)(misc + 192 + s4);
                  f32x4 o; o[0] = lo16(v.x) * dv[0]; o[1] = hi16(v.x) * dv[1]; o[2] = lo16(v.y) * dv[2]; o[3] = hi16(v.y) * dv[3];
                  *(LAS u32x2*)(lds + SS_XT + e * 160 + s4 * 2) = pack4(o);
                  *(LAS u32x2*)(lds + SS_XWT + e * 160 + s4 * 2) = pack4(o * w); }
            }
            __syncthreads();
            {
                f32x4 y1 = (f32x4){0.f, 0.f, 0.f, 0.f}, y2 = y1;
                const LAS unsigned char* gb = lds + SS_G + (16 * ti + fr) * 160 + fq * 16;
                const LAS unsigned char* xb = lds + SS_XT + (16 * wh + fr) * 160 + fq * 16;
#pragma unroll
                for (int ks = 0; ks < 2; ++ks) y1 = __builtin_amdgcn_mfma_f32_16x16x32_bf16(*(const LAS bf16x8*)(gb + ks * 64), *(const LAS bf16x8*)(xb + ks * 64), y1, 0, 0, 0);
                const LAS unsigned char* cbp = lds + SS_C + (16 * ti + fr) * 288 + fq * 16;
                const LAS unsigned char* sb = lds + SS_S + (16 * wh + fr) * 288 + fq * 16;
#pragma unroll
                for (int kn = 0; kn < 4; ++kn) y2 = __builtin_amdgcn_mfma_f32_16x16x32_bf16(*(const LAS bf16x8*)(cbp + kn * 64), *(const LAS bf16x8*)(sb + kn * 64), y2, 0, 0, 0);
                const int t0 = 16 * ti + 4 * fq;
                const f32x4 eav = *(const LAS f32x4*)(misc + 64 + t0);
                const u32x2 xs = *(const LAS u32x2*)(lds + SS_XRT + (16 * wh + fr) * 160 + t0 * 2);
                const float xv[4] = {lo16(xs.x), hi16(xs.x), lo16(xs.y), hi16(xs.y)};
                const bool wr_out = !(l == 1 && cin < 4);
#pragma unroll
                for (int r = 0; r < 4; ++r) {
                    float yv = y1[r] + eav[r] * y2[r];
                    if (dir == 0) yv += dskip * xv[r];
                    if (wr_out) OUT[(size_t)(rbase + n0 + t0 + r) * 1024 + hd * 64 + ps * 32 + 16 * wh + fr] = (bf16_t)f2bf(yv);
                }
                const float dec = misc[256];
                Sacc[0] = Sacc[0] * dec; Sacc[1] = Sacc[1] * dec;
                const LAS unsigned char* bt = lds + SS_BT + (16 * wid + fr) * 160 + fq * 16;
                const LAS unsigned char* xw = lds + SS_XWT + fr * 160 + fq * 16;
#pragma unroll
                for (int ks = 0; ks < 2; ++ks) { const bf16x8 bf = *(const LAS bf16x8*)(bt + ks * 64);
                    Sacc[0] = __builtin_amdgcn_mfma_f32_16x16x32_bf16(bf, *(const LAS bf16x8*)(xw + ks * 64), Sacc[0], 0, 0, 0);
                    Sacc[1] = __builtin_amdgcn_mfma_f32_16x16x32_bf16(bf, *(const LAS bf16x8*)(xw + 16 * 160 + ks * 64), Sacc[1], 0, 0, 0); }
            }
            __syncthreads();
            { const int ncol = (16 * wid + 4 * fq) * 2;
              *(LAS u32x2*)(lds + SS_S + fr * 288 + ncol) = pack4(Sacc[0]);
              *(LAS u32x2*)(lds + SS_S + (16 + fr) * 288 + ncol) = pack4(Sacc[1]); }
        }
        if (cn < 68) {
#pragma unroll
            for (int j = 0; j < 2; ++j) { const int q = tid + NTHR * j;
                *(LAS u32x4*)(lds + SS_C + (q >> 4) * 288 + (q & 15) * 16) = rc[j];
                *(LAS u32x4*)(lds + SS_B + (q >> 4) * 288 + (q & 15) * 16) = rb[j];
                *(LAS u32x4*)(lds + SS_BT + (q >> 3) * 160 + (q & 7) * 16) = rt[j]; }
            if (tid < 256) *(LAS u32x4*)(lds + SS_XRT + (tid >> 3) * 160 + (tid & 7) * 16) = rx;
            if (wid == 0) {
                const int j = dir ? 63 - lane : lane;
                const float dtv = softplus_f(dtraw + dtb);
                const float acs = wave_incl_sum(dtv * aneg, lane);
                const float a63 = __shfl(acs, 63);
                misc[j] = acs; misc[64 + j] = __expf(acs); misc[128 + j] = __expf(a63 - acs); misc[192 + j] = dtv;
                if (lane == 0) misc[256] = __expf(a63);
            }
        }
        __syncthreads();
    }
}

__device__ __forceinline__ void mlstm_finish_rows(const Params& p, int l, int row_lo, int gw, int ngw) {
    if (p.dup) return;
    const int lane = tid_fresh() & 63;
    const bf16_t* HF = (const bf16_t*)(p.ws + WS_HF2); const bf16_t* HB = (const bf16_t*)(p.ws + WS_HB2);
    bf16_t* BR = (bf16_t*)(p.ws + WS_BR);
    const float* ng = p.mnorm_g + l * 1024;
    int row = row_lo + gw;
    u32x2 ca[4], cb[4], co[4], na[4], nbv[4], no[4];
    if (row < MT) { const size_t so = (size_t)scanrow(row) * 1024;
#pragma unroll
        for (int hd = 0; hd < 4; ++hd) { const int c = hd * 256 + 4 * lane; ca[hd] = *(const u32x2*)(HF + so + c); cb[hd] = *(const u32x2*)(HB + so + c); co[hd] = *(const u32x2*)(BR + (size_t)row * 3072 + 1024 + c); } }
    for (; row < MT; row += ngw) {
        const int rn = row + ngw;
        if (rn < MT) { const size_t so = (size_t)scanrow(rn) * 1024;
#pragma unroll
            for (int hd = 0; hd < 4; ++hd) { const int c = hd * 256 + 4 * lane; na[hd] = *(const u32x2*)(HF + so + c); nbv[hd] = *(const u32x2*)(HB + so + c); no[hd] = *(const u32x2*)(BR + (size_t)rn * 3072 + 1024 + c); } }
#pragma unroll
        for (int hd = 0; hd < 4; ++hd) { const int c = hd * 256 + 4 * lane;
            const u32x2 a = ca[hd], b2 = cb[hd], o = co[hd];
            f32x4 h; h[0] = lo16(a.x) + lo16(b2.x); h[1] = hi16(a.x) + hi16(b2.x); h[2] = lo16(a.y) + lo16(b2.y); h[3] = hi16(a.y) + hi16(b2.y);
            const float ss = wave_sum((h[0] * h[0] + h[1] * h[1]) + (h[2] * h[2] + h[3] * h[3]));
            const float rs = __builtin_amdgcn_rsqf(ss * (1.f / 256.f) + EPS);
            const f32x4 g = *(const f32x4*)(ng + c);
            f32x4 r; r[0] = sigmoid_f(lo16(o.x)) * (h[0] * rs * g[0]); r[1] = sigmoid_f(hi16(o.x)) * (h[1] * rs * g[1]);
            r[2] = sigmoid_f(lo16(o.y)) * (h[2] * rs * g[2]); r[3] = sigmoid_f(hi16(o.y)) * (h[3] * rs * g[3]);
            u32x2 w; w.x = pk2(r[0], r[1]); w.y = pk2(r[2], r[3]);
            *(u32x2*)(BR + (size_t)row * 3072 + 1024 + c) = w; }
#pragma unroll
        for (int hd = 0; hd < 4; ++hd) { ca[hd] = na[hd]; cb[hd] = nbv[hd]; co[hd] = no[hd]; }
    }
}
__device__ __forceinline__ void ssd_finish_rows(const Params& p, int l, int row_lo, int gw, int ngw) {
    if (p.dup) return;
    const int lane = tid_fresh() & 63;
    const bf16_t* YF = (const bf16_t*)(p.ws + WS_YF); const bf16_t* YB = (const bf16_t*)(p.ws + WS_YB);
    bf16_t* BR = (bf16_t*)(p.ws + WS_BR);
    const float* ng = p.snorm_g + l * 1024;
    int row = row_lo + gw;
    u32x2 ca[4], cb[4], cz[4], na[4], nbv[4], nz[4];
    if (row < MT) {
#pragma unroll
        for (int j = 0; j < 4; ++j) { const int c = 4 * lane + 256 * j; ca[j] = *(const u32x2*)(YF + (size_t)row * 1024 + c); cb[j] = *(const u32x2*)(YB + (size_t)row * 1024 + c); cz[j] = *(const u32x2*)(BR + (size_t)row * 3072 + 2048 + c); } }
    for (; row < MT; row += ngw) {
        const int rn = row + ngw;
        if (rn < MT) {
#pragma unroll
            for (int j = 0; j < 4; ++j) { const int c = 4 * lane + 256 * j; na[j] = *(const u32x2*)(YF + (size_t)rn * 1024 + c); nbv[j] = *(const u32x2*)(YB + (size_t)rn * 1024 + c); nz[j] = *(const u32x2*)(BR + (size_t)rn * 3072 + 2048 + c); } }
        f32x4 v[4]; float ss = 0.f;
#pragma unroll
        for (int j = 0; j < 4; ++j) { const u32x2 a = ca[j], b2 = cb[j], z = cz[j];
            v[j][0] = (lo16(a.x) + lo16(b2.x)) * silu_f(lo16(z.x)); v[j][1] = (hi16(a.x) + hi16(b2.x)) * silu_f(hi16(z.x));
            v[j][2] = (lo16(a.y) + lo16(b2.y)) * silu_f(lo16(z.y)); v[j][3] = (hi16(a.y) + hi16(b2.y)) * silu_f(hi16(z.y));
            ss += (v[j][0] * v[j][0] + v[j][1] * v[j][1]) + (v[j][2] * v[j][2] + v[j][3] * v[j][3]); }
        const float rs = __builtin_amdgcn_rsqf(wave_sum(ss) * (1.f / 1024.f) + EPS);
#pragma unroll
        for (int j = 0; j < 4; ++j) { const int c = 4 * lane + 256 * j; const f32x4 g = *(const f32x4*)(ng + c);
            u32x2 w; w.x = pk2(v[j][0] * rs * g[0], v[j][1] * rs * g[1]); w.y = pk2(v[j][2] * rs * g[2], v[j][3] * rs * g[3]);
            *(u32x2*)(BR + (size_t)row * 3072 + 2048 + c) = w; }
#pragma unroll
        for (int j = 0; j < 4; ++j) { ca[j] = na[j]; cb[j] = nbv[j]; cz[j] = nz[j]; }
    }
}

__device__ __forceinline__ void phase_route(const Params& p, int l, unsigned char* ldsb, int bid, int nb) {
    float* lds = reinterpret_cast<float*>(ldsb);
    float* Wt = lds;
    int* hist = reinterpret_cast<int*>(lds + 36 * 1024);
    const int tid = tid_fresh(), lane = tid & 63, wave = tid >> 6;
    const int row_lo = l == 0 ? 0 : MC, rpb = l == 0 ? 68 : 64;
    const float* wrg = p.w_rg + (size_t)l * 1024 * 4; const float* wre = p.w_re + (size_t)l * 1024 * 32;
    for (int i = tid; i < 1024 * 4; i += NTHR) { const int k = i >> 2, g = i & 3; Wt[g * 1024 + (k ^ ((g & 7) << 2))] = wrg[i]; }
    for (int i = tid; i < 1024 * 32; i += NTHR) { const int k = i >> 5, e = i & 31; Wt[(4 + e) * 1024 + (k ^ (((4 + e) & 7) << 2))] = wre[i]; }
    const float* mod = (const float*)(p.ws + WS_MOD) + l * 5 * 6144;
    const float* XL = (const float*)(p.ws + WS_XL);
    int* EID = (int*)(p.ws + WS_EID); float* EWT = (float*)(p.ws + WS_EWT);
    for (int vb = bid; vb < 256; vb += nb) {
        if (tid < 32) hist[tid] = 0;
        __syncthreads();
        for (int rr = wave; rr < rpb; rr += 8) {
            const int row = row_lo + vb * rpb + rr;
            f32x4 v[4];
#pragma unroll
            for (int j = 0; j < 4; ++j) v[j] = *(const f32x4*)(XL + (size_t)row * 1024 + 4 * lane + 256 * j);
            const float* mr = mod + modrow(row) * 6144;
            norm_mod_row(v, p.g_ffn + l * 1024, mr + 3 * 1024, mr + 4 * 1024, lane);
            store_row_bf16((bf16_t*)(p.ws + WS_H) + (size_t)row * 1024, v, lane);
            float lg[36];
#pragma unroll
            for (int e = 0; e < 36; ++e) { float s = 0.f;
#pragma unroll
                for (int j = 0; j < 4; ++j) { const f32x4 w = *(const f32x4*)(Wt + e * 1024 + ((4 * lane + 256 * j) ^ ((e & 7) << 2))); s += (v[j][0] * w[0] + v[j][1] * w[1]) + (v[j][2] * w[2] + v[j][3] * w[3]); }
                lg[e] = wave_sum(s); }
            float gl[4]; int gi = 0; float gmax;
#pragma unroll
            for (int g = 0; g < 4; ++g) gl[g] = lg[g] + p.b_rg[l * 4 + g];
            gmax = gl[0];
#pragma unroll
            for (int g = 1; g < 4; ++g) if (gl[g] > gmax) { gmax = gl[g]; gi = g; }
            float den = 0.f;
#pragma unroll
            for (int g = 0; g < 4; ++g) den += __expf(gl[g] - gmax);
            const float pg = 1.f / den;
            float v1 = -3.0e38f, v2 = -3.0e38f; int i1 = 0, i2 = 0;
#pragma unroll
            for (int g = 0; g < 4; ++g) if (g == gi) {
#pragma unroll
                for (int j = 0; j < 8; ++j) { const float x = lg[4 + g * 8 + j] + p.b_re[l * 32 + g * 8 + j];
                    if (x > v1) { v2 = v1; i2 = i1; v1 = x; i1 = j; } else if (x > v2) { v2 = x; i2 = j; } } }
            const float e2 = __expf(v2 - v1), w1 = pg / (1.f + e2), w2 = pg * e2 / (1.f + e2);
            if (lane == 0) { EID[row * 2] = gi * 8 + i1; EID[row * 2 + 1] = gi * 8 + i2; EWT[row * 2] = w1; EWT[row * 2 + 1] = w2;
                atomicAdd(&hist[gi * 8 + i1], 1); atomicAdd(&hist[gi * 8 + i2], 1); }
        }
        __syncthreads();
        if (tid < 32) ((int*)(p.ws + WS_HIST))[vb * 32 + tid] = hist[tid];
        __syncthreads();
    }
    __syncthreads();
    float* scr = lds + wave * (64 * 65);
    convert_run(p, l, l + 1 < 2 ? l + 1 : -1, bid * 8 + wave, nb * 8, scr, lane);
}

__device__ __forceinline__ void phase_scatter(const Params& p, int l, unsigned char* ldsb, int bid, int nb) {
    int* li = reinterpret_cast<int*>(ldsb);
    int* tot = li; int* pre = li + 32; int* pst = li + 64; int* ea = li + 128; int* pos = li + 384;
    const int tid = tid_fresh(), lane = tid & 63, wave = tid >> 6;
    const int row_lo = l == 0 ? 0 : MC, rpb = l == 0 ? 68 : 64;
    const int* HIST = (const int*)(p.ws + WS_HIST); const int* EID = (const int*)(p.ws + WS_EID);
    int* SLOT = (int*)(p.ws + WS_SLOT);
    for (int vb = bid; vb < 256; vb += nb) {
        __syncthreads();
        if (tid < 32) { int t = 0, pr = 0; for (int j = 0; j < 256; ++j) { const int hv = HIST[j * 32 + tid]; t += hv; if (j < vb) pr += hv; } tot[tid] = t; pre[tid] = pr; }
        __syncthreads();
        if (tid == 0) { int s = 0; for (int e = 0; e < 32; ++e) { pst[e] = s; s += ((tot[e] + 255) >> 8) << 8; }
            if (vb == 0) { int* BE = (int*)(p.ws + WS_BLKEXP); int nblk = 0;
                for (int e = 0; e < 32; ++e) { const int nbk = (tot[e] + 255) >> 8; for (int j = 0; j < nbk; ++j) BE[nblk++] = e; }
                BE[200] = nblk; } }
        if (tid < rpb * 2) ea[tid] = EID[(row_lo + vb * rpb) * 2 + tid];
        __syncthreads();
        if (tid < rpb * 2) { const int e = ea[tid]; int rk = 0; for (int j = 0; j < tid; ++j) rk += (ea[j] == e) ? 1 : 0;
            const int ps = pst[e] + pre[e] + rk; SLOT[(row_lo + vb * rpb) * 2 + tid] = ps; ((int*)(p.ws + WS_TOK))[ps] = row_lo + vb * rpb + (tid >> 1); }
        if (vb == 0 && tid < 32) { int* TOK = (int*)(p.ws + WS_TOK); const int e0 = pst[tid] + tot[tid], e1 = pst[tid] + (((tot[tid] + 255) >> 8) << 8);
            for (int q = e0; q < e1; ++q) TOK[q] = row_lo; }
    }
    __syncthreads();
}

__device__ __forceinline__ void phase_combine(const Params& p, int l, int bid, int nb) {
    if (p.dup && l == 0) return;
    const int lane = tid_fresh() & 63, wave = tid_fresh() >> 6;
    const float* mod = (const float*)(p.ws + WS_MOD);
    const int* SLOT = (const int*)(p.ws + WS_SLOT); const float* EWT = (const float*)(p.ws + WS_EWT);
    const bf16_t* Y = (const bf16_t*)(p.ws + WS_Y);
    float* XL = (float*)(p.ws + WS_XL);
    const int row_lo = l == 0 ? 0 : MC, stride = nb * 8;
    for (int rowA = row_lo + bid * 8 + wave; rowA < MT; rowA += 2 * stride) {
        const int rowB = rowA + stride; const bool hasB = rowB < MT; const int rb = hasB ? rowB : rowA;
        const int sA0 = SLOT[rowA * 2], sA1 = SLOT[rowA * 2 + 1], sB0 = SLOT[rb * 2], sB1 = SLOT[rb * 2 + 1];
        const float wA0 = EWT[rowA * 2], wA1 = EWT[rowA * 2 + 1], wB0 = EWT[rb * 2], wB1 = EWT[rb * 2 + 1];
        u32x2 yA0[4], yA1[4], yB0[4], yB1[4]; f32x4 xA[4], xB[4];
#pragma unroll
        for (int j = 0; j < 4; ++j) { const int c = 4 * lane + 256 * j;
            yA0[j] = *(const u32x2*)(Y + (size_t)sA0 * 1024 + c); yA1[j] = *(const u32x2*)(Y + (size_t)sA1 * 1024 + c); xA[j] = *(const f32x4*)(XL + (size_t)rowA * 1024 + c);
            yB0[j] = *(const u32x2*)(Y + (size_t)sB0 * 1024 + c); yB1[j] = *(const u32x2*)(Y + (size_t)sB1 * 1024 + c); xB[j] = *(const f32x4*)(XL + (size_t)rb * 1024 + c); }
#pragma unroll
        for (int half = 0; half < 2; ++half) {
            if (half == 1 && !hasB) break;
            const int row = half ? rowB : rowA; const float w0 = half ? wB0 : wA0, w1 = half ? wB1 : wA1;
            const float* g5 = mod + (l * 5 + modrow(row)) * 6144 + 5 * 1024;
            f32x4 v[4];
#pragma unroll
            for (int j = 0; j < 4; ++j) { const int c = 4 * lane + 256 * j;
                const u32x2 a = half ? yB0[j] : yA0[j], b2 = half ? yB1[j] : yA1[j];
                f32x4 y; y[0] = w0 * lo16(a.x) + w1 * lo16(b2.x); y[1] = w0 * hi16(a.x) + w1 * hi16(b2.x); y[2] = w0 * lo16(a.y) + w1 * lo16(b2.y); y[3] = w0 * hi16(a.y) + w1 * hi16(b2.y);
                v[j] = (half ? xB[j] : xA[j]) + *(const f32x4*)(g5 + c) * y; }
            if (l == 0) {
#pragma unroll
                for (int j = 0; j < 4; ++j) *(f32x4*)(XL + (size_t)row * 1024 + 4 * lane + 256 * j) = v[j];
                const float* mr = mod + (5 + modrow(row)) * 6144;
                norm_mod_row(v, p.g_mix + 1024, mr, mr + 1024, lane);
                store_row_bf16((bf16_t*)(p.ws + WS_H) + (size_t)row * 1024, v, lane);
            } else {
                norm_mod_row(v, p.g_final, nullptr, nullptr, lane);
                float* o = p.out + (size_t)(row - MC) * 1024;
#pragma unroll
                for (int j = 0; j < 4; ++j) *(f32x4*)(o + 4 * lane + 256 * j) = v[j];
            }
        }
    }
}

constexpr int NPH_L = 14, NPHASES = 1 + 2 * NPH_L;
__device__ __forceinline__ void run_phase(const Params& p, int ph, unsigned char* lds) {
    const int bid = blockIdx.x, nb = gridDim.x;
    const int wave = tid_fresh() >> 6;
#ifndef ONLY_S
    if (ph == 0) { phase_pre(p, lds, bid, nb); return; }
#else
    if (ph == 0) { if (ONLY_S == 99) phase_pre(p, lds, bid, nb); return; }
#endif
    const int l = (ph - 1) / NPH_L, s = (ph - 1) % NPH_L;
    unsigned char* ws = p.ws;
    const int pm0 = l == 0 ? 0 : 4, nMrows = l == 0 ? 68 : 64, row_lo = l == 0 ? 0 : MC;
#ifdef ONLY_S
    if (s != ONLY_S) return;
#endif
    switch (s) {
    case 0: if (l == 0) phase_norm1(p, bid, nb); break;
    case 1: { SchedGrid S{(const bf16_t*)(ws + WS_H), (const bf16_t*)(ws + WS_WIN), 1024, 1024, 0, 68, 45, nb, bid}; EpiInproj E{ws};
              gemm_run(lds, S, E, 1024, 1024, 1024, 1); } break;
    case 2: { for (int it = bid; it < 1088; it += nb) conv_m_item(p, l, it, (LAS unsigned char*)lds);
              if (!p.dup) for (int it = bid; it < (l == 0 ? 272 : 256); it += nb) pool_window_item(p, it, (LAS unsigned char*)lds); } break;
    case 3: { for (int it = bid; it < 256; it += nb) mlstm_chunk_item(p, l, it, (LAS unsigned char*)lds);
              SchedPool S{(const bf16_t*)(ws + WS_BR), (const bf16_t*)(ws + WS_WPOOL), pm0, nMrows, nb, bid}; EpiPool E{(bf16_t*)(ws + WS_BR)};
              if (!p.dup) gemm_run(lds, S, E, 256, 3072, 256, 1); } break;
    case 4: { for (int it = bid; it < 1088; it += nb) conv_s_item(p, l, it, (LAS unsigned char*)lds);
              mlstm_finish_rows(p, l, row_lo, bid * 8 + wave, nb * 8); } break;
    case 5: for (int it = bid; it < 256; it += nb) ssd_chunk_item(p, l, it, (LAS unsigned char*)lds); break;
    case 6: ssd_finish_rows(p, l, row_lo, bid * 8 + wave, nb * 8); break;
    case 7: { SchedGrid S{(const bf16_t*)(ws + WS_BR), (const bf16_t*)(ws + WS_WBR), 3072, 3072, pm0, nMrows, 4, nb, bid}; EpiBranch E{(const bf16_t*)(ws + WS_MG), (bf16_t*)(ws + WS_MERGED)};
              gemm_run(lds, S, E, 3072, 3072, 3072, 3); } break;
    case 8: { SchedGrid S{(const bf16_t*)(ws + WS_MERGED), (const bf16_t*)(ws + WS_WOUT), 1024, 1024, pm0, nMrows, 4, nb, bid}; EpiOut E{(float*)(ws + WS_XL), (const float*)(ws + WS_MOD) + l * 5 * 6144, l == 0 ? p.x : nullptr, l == 0 ? p.ctx : nullptr, p.dup};
              gemm_run(lds, S, E, 1024, 1024, 1024, 1); } break;
    case 9: phase_route(p, l, lds, bid, nb); break;
    case 10: phase_scatter(p, l, lds, bid, nb); break;
    case 11: { const int* BE = (const int*)(ws + WS_BLKEXP);
              SchedMoe S{(const bf16_t*)(ws + WS_H), (const bf16_t*)(ws + WS_EW1), BE, (const int*)(ws + WS_TOK), 1024, BE[200], nb, bid, (size_t)1048576, (size_t)1024}; EpiMoe1 E{(bf16_t*)(ws + WS_ACT)};
              gemm_run<true>(lds, S, E, 1024, 1024, 1024, 1); } break;
    case 12: { const int* BE = (const int*)(ws + WS_BLKEXP);
              SchedMoe S{(const bf16_t*)(ws + WS_ACT), (const bf16_t*)(ws + WS_EW2), BE, nullptr, 512, BE[200], nb, bid, (size_t)524288, (size_t)512}; EpiMoe2 E{(bf16_t*)(ws + WS_Y)};
              gemm_run(lds, S, E, 512, 512, 512, 1); } break;
    case 13: phase_combine(p, l, bid, nb); break;
    }
}

#define XB_TMO      128
#define XB_XCNT(j)  (256  + 64 * (j))
#define XB_XSUB(j)  (1280 + 64 * (j))
#define XB_XGEN(j)  (2304 + 64 * (j))
#define XB_TOP      3328
#define XB_TOPGEN   3392
#define XCD_BAR_WORDS 3456
#define XB_SPIN_CAP (1u << 18)
__device__ __forceinline__ unsigned xb_ld(unsigned* p)              { return __hip_atomic_load(p, __ATOMIC_RELAXED, __HIP_MEMORY_SCOPE_AGENT); }
__device__ __forceinline__ unsigned xb_add(unsigned* p, unsigned v) { return __hip_atomic_fetch_add(p, v, __ATOMIC_RELAXED, __HIP_MEMORY_SCOPE_AGENT); }
__device__ __forceinline__ unsigned xb_xcc_id() { return (unsigned)__builtin_amdgcn_s_getreg((3 << 11) | 20) & 0xFu; }
#define XB_SPIN(cond, bar) do { unsigned _sp = 0; while (cond) { __builtin_amdgcn_s_sleep(1); \
    if ((++_sp & 255u) == 0u) { if (xb_ld(&(bar)[XB_TMO])) break; if (_sp > XB_SPIN_CAP) { atomicAdd(&(bar)[XB_TMO], 1u); break; } } } } while (0)
__device__ __forceinline__ void xcd_barrier_complete(unsigned* bar, unsigned x, unsigned& nloc, unsigned& nx) {
    const unsigned G = gridDim.x * gridDim.y * gridDim.z;
    unsigned sum, cnt, mine, sp = 0u;
    for (;;) {
        sum = 0u; cnt = 0u; mine = 0u;
#pragma unroll
        for (unsigned j = 0; j < 16; ++j) { const unsigned c = xb_ld(&bar[XB_XCNT(j)]); sum += c; cnt += (c > 0u) ? 1u : 0u; mine = (j == x) ? c : mine; }
        if (sum == G) break;
        __builtin_amdgcn_s_sleep(1);
        if ((++sp & 255u) == 0u) { if (xb_ld(&bar[XB_TMO])) break; if (sp > XB_SPIN_CAP) { atomicAdd(&bar[XB_TMO], 1u); break; } }
    }
    nloc = mine > 0u ? mine : 1u; nx = cnt > 0u ? cnt : 1u;
}
__device__ __forceinline__ void xcd_barrier(unsigned* bar, volatile LAS unsigned* st) {
    asm volatile("s_waitcnt vmcnt(0)" ::: "memory");
    __syncthreads();
    if (threadIdx.x == 0) {
        __builtin_amdgcn_s_waitcnt(0);
        const unsigned x = xb_xcc_id();
        unsigned nloc = st[0], nx = st[1];
        if (nloc == 0u) { xcd_barrier_complete(bar, x, nloc, nx); st[0] = nloc; st[1] = nx; }
        const unsigned old = xb_add(&bar[XB_XSUB(x)], 1u);
        const unsigned gen = old / nloc;
        if (old + 1u == (gen + 1u) * nloc) {
            __builtin_amdgcn_fence(__ATOMIC_RELEASE, "agent");
            asm volatile("s_waitcnt vmcnt(0)" ::: "memory");
            const unsigned og = xb_add(&bar[XB_TOP], 1u);
            const unsigned tg = og / nx;
            if (og + 1u == (tg + 1u) * nx) xb_add(&bar[XB_TOPGEN], 1u);
            else XB_SPIN(xb_ld(&bar[XB_TOPGEN]) == tg, bar);
            __builtin_amdgcn_fence(__ATOMIC_ACQUIRE, "agent");
            xb_add(&bar[XB_XGEN(x)], 1u);
            asm volatile("s_waitcnt vmcnt(0)" ::: "memory");
        } else {
            XB_SPIN(xb_ld(&bar[XB_XGEN(x)]) == gen, bar);
            __builtin_amdgcn_fence(__ATOMIC_ACQUIRE, "agent");
            asm volatile("s_waitcnt vmcnt(0)" ::: "memory");
        }
    }
    __syncthreads();
}

constexpr int BAR_LDS_OFF = LDS_BYTES - 16;
__global__ void __launch_bounds__(NTHR, 2) fwd_kernel(Params pk) {
    extern __shared__ __attribute__((aligned(16))) unsigned char lds[];
    const Params& p = pk;
    const int lo = pk.ph_lo, hi = pk.ph_hi;
    unsigned* bar = (unsigned*)(pk.ws + WS_BAR);
    volatile LAS unsigned* bst = (volatile LAS unsigned*)((LAS unsigned char*)lds + BAR_LDS_OFF);
    if (hi - lo > 1) {
        if (threadIdx.x == 0) { bst[0] = 0u; bst[1] = 0u; (void)xb_add(&bar[XB_XCNT(xb_xcc_id())], 1u); }
        __syncthreads();
    }
#define STEP(k) if (lo <= (k) && (k) < hi) { run_phase(p, (k), lds); if ((k) + 1 < hi) { if (pk.dup < 0) cg::this_grid().sync(); else xcd_barrier(bar, bst); } }
    STEP(0) STEP(1) STEP(2) STEP(3) STEP(4) STEP(5) STEP(6) STEP(7) STEP(8) STEP(9) STEP(10) STEP(11) STEP(12) STEP(13) STEP(14)
    STEP(16) STEP(17) STEP(18) STEP(19) STEP(20) STEP(21) STEP(22) STEP(23) STEP(24) STEP(25) STEP(26) STEP(27) STEP(28)
#undef STEP
}

extern "C" void kernel_launch(void* const* d_in, const int* in_sizes, int n_in, void* d_out, int out_size, void* d_ws, size_t ws_size, hipStream_t stream) {
    static int grid_blocks = 0;
    if (!grid_blocks) {
        if (n_in != 31 || ws_size < WS_END) { fprintf(stderr, "kernel_launch: unexpected n_in %d / ws_size %zu (need %zu)\n", n_in, ws_size, (size_t)WS_END); grid_blocks = -1; return; }
        int dev = 0, cus = 0, per_cu = 0;
        hipGetDevice(&dev);
        hipDeviceGetAttribute(&cus, hipDeviceAttributeMultiprocessorCount, dev);
        if (hipFuncSetAttribute((const void*)fwd_kernel, hipFuncAttributeMaxDynamicSharedMemorySize, LDS_BYTES) != hipSuccess) fprintf(stderr, "kernel_launch: hipFuncSetAttribute failed\n");
        hipOccupancyMaxActiveBlocksPerMultiprocessor(&per_cu, (const void*)fwd_kernel, NTHR, LDS_BYTES);
        if (per_cu < 1) { fprintf(stderr, "kernel_launch: occupancy query says %d blocks per CU\n", per_cu); per_cu = 1; }
        grid_blocks = cus * per_cu;
        (void)hipGetLastError();
    }
    if (grid_blocks < 0) return;
    Params p{};
    const float** dst = (const float**)&p;
    for (int i = 0; i < 31; ++i) dst[i] = (const float*)d_in[i];
    p.out = (float*)d_out; p.ws = (unsigned char*)d_ws;
#if SINGLE_LAUNCH
    if (hipMemsetAsync((char*)d_ws + WS_BAR, 0, 16384, stream) != hipSuccess) fprintf(stderr, "kernel_launch: hipMemsetAsync failed\n");
    p.ph_lo = 0; p.ph_hi = NPHASES;
    void* args[] = {&p};
    hipError_t e = hipLaunchCooperativeKernel((const void*)fwd_kernel, dim3(grid_blocks), dim3(NTHR), args, LDS_BYTES, stream);
    if (e != hipSuccess) fprintf(stderr, "cooperative launch failed: %s (grid %d)\n", hipGetErrorString(e), grid_blocks);
#else
    for (int ph = 0; ph < NPHASES; ++ph) {
        if (ph == 1 + NPH_L) continue;
        p.ph_lo = ph; p.ph_hi = ph + 1;
        hipLaunchKernelGGL(fwd_kernel, dim3(grid_blocks), dim3(NTHR), LDS_BYTES, stream, p);
        const int sidx = ph == 0 ? 14 : (ph - 1) % NPH_L;
        if ((PROBE_DUP_MASK >> sidx) & 1) { p.dup = 1; for (int r = 0; r < PROBE_DUP_N; ++r) hipLaunchKernelGGL(fwd_kernel, dim3(grid_blocks), dim3(NTHR), LDS_BYTES, stream, p); p.dup = 0; }
    }
#endif
}
```

```cpp
#include <hip/hip_runtime.h>
#include <hip/hip_cooperative_groups.h>
#include <cstdio>
namespace cg = cooperative_groups;

#ifndef SINGLE_LAUNCH
#define SINGLE_LAUNCH 1
#endif
#ifndef PROBE_DUP_MASK
#define PROBE_DUP_MASK 0
#endif
#ifndef PROBE_DUP_N
#define PROBE_DUP_N 1
#endif
#ifndef USE_MLSTM_CHUNK
#define USE_MLSTM_CHUNK 1
#endif
#ifndef USE_SSD_CHUNK
#define USE_SSD_CHUNK 1
#endif
#ifndef USE_MFMA_GEMM
#define USE_MFMA_GEMM 1
#endif

typedef unsigned short bf16_t;
typedef float f32x4 __attribute__((ext_vector_type(4)));
typedef unsigned u32x4 __attribute__((ext_vector_type(4)));
typedef unsigned u32x2 __attribute__((ext_vector_type(2)));

constexpr int NTHR = 512;
constexpr int D = 1024, NB = 4, SEQ = 4096, CTXL = 256;
constexpr int MC = NB * CTXL;
constexpr int ML = NB * SEQ;
constexpr int MT = MC + ML;
constexpr int DIN = 11312, NPAD = 11520;
constexpr int NE = 32, DE = 512;
constexpr int CAP = 43008;
constexpr float EPS = 1e-6f;
constexpr int LDS_BYTES = 163840;

constexpr size_t MiB = 1u << 20;
constexpr size_t WS_HIST = 0;
constexpr size_t WS_BLKEXP = 64 * 1024;
constexpr size_t WS_BAR = 128 * 1024;
constexpr size_t WS_TOK = 256 * 1024;
constexpr size_t WS_MOD = 1 * MiB;
constexpr size_t WS_GA = 2 * MiB;
constexpr size_t WS_DT = 4 * MiB;
constexpr size_t WS_EID = 7 * MiB;
constexpr size_t WS_EWT = 7 * MiB + 256 * 1024;
constexpr size_t WS_SLOT = 7 * MiB + 512 * 1024;
constexpr size_t WS_WIN = 8 * MiB;
constexpr size_t WS_WPOOL = 31 * MiB;
constexpr size_t WS_WBR = 32 * MiB;
constexpr size_t WS_WOUT = 38 * MiB;
constexpr size_t WS_XL = 40 * MiB;
constexpr size_t WS_H = 108 * MiB;
constexpr size_t WS_BR = 142 * MiB;
constexpr size_t WS_Q = 244 * MiB, WS_K = 278 * MiB, WS_V = 312 * MiB;
constexpr size_t WS_SX = 346 * MiB, WS_SB = 380 * MiB, WS_SC = 397 * MiB;
constexpr size_t WS_MG = 414 * MiB;
constexpr size_t WS_HF = 516 * MiB, WS_HB = 550 * MiB;
constexpr size_t WS_VT = 584 * MiB;
constexpr size_t WS_END = 618 * MiB;
constexpr size_t WS_MGA = WS_WIN, WS_MGC = WS_WIN + 576 * 1024, WS_MGP = WS_WIN + 1152 * 1024;
constexpr size_t WS_SACS = WS_WIN + 2 * MiB, WS_SDT = WS_WIN + 5 * MiB;
constexpr size_t WS_QC = WS_H, WS_KC = WS_HF, WS_KCT = WS_HB;
constexpr size_t WS_HF2 = WS_Q, WS_HB2 = WS_K;
constexpr size_t WS_XCT = WS_HF;
constexpr size_t WS_BC = WS_H, WS_CC = WS_H + 17 * MiB, WS_BCT = WS_HB;
constexpr size_t WS_YF = WS_SX, WS_YB = WS_SB;
constexpr size_t WS_MERGED = WS_Q;
constexpr size_t WS_EW1 = 244 * MiB;
constexpr size_t WS_EW2 = 308 * MiB;
constexpr size_t WS_XB = WS_BR;
constexpr size_t WS_ACT = WS_SX;
constexpr size_t WS_Y = WS_MG;

struct Params {
    const float *x, *c, *ctx, *c_ctx, *w_ada, *b_ada, *g_mix, *g_ffn, *w_in, *pool_w, *pool_scale,
        *mconv_w, *mconv_b, *mgate_b, *mnorm_g, *sconv_w, *sconv_b, *sdt_bias, *sa_log, *sd, *snorm_g,
        *w_branch, *w_out, *w_rg, *b_rg, *w_re, *b_re, *w_eg, *w_eu, *w_ed, *g_final;
    float* out; unsigned char* ws; int ph_lo, ph_hi, dup, pad;
};

__device__ __forceinline__ int tid_fresh() { int t = threadIdx.x; asm volatile("" : "+v"(t)); return t; }
__device__ __forceinline__ float bf2f(unsigned b) { return __uint_as_float(b << 16); }
__device__ __forceinline__ unsigned f2bf(float f) { unsigned u = __float_as_uint(f); return (u + 0x7fffu + ((u >> 16) & 1u)) >> 16; }
typedef __bf16 bf16x2_t __attribute__((ext_vector_type(2)));
typedef float f32x2_t __attribute__((ext_vector_type(2)));
__device__ __forceinline__ unsigned pk2(float lo, float hi) { const f32x2_t v = {lo, hi}; return __builtin_bit_cast(unsigned, __builtin_convertvector(v, bf16x2_t)); }
__device__ __forceinline__ float lo16(unsigned w) { return __uint_as_float(w << 16); }
__device__ __forceinline__ float hi16(unsigned w) { return __uint_as_float(w & 0xffff0000u); }
__device__ __forceinline__ float wave_sum(float v) {
#pragma unroll
    for (int o = 1; o < 64; o <<= 1) v += __shfl_xor(v, o);
    return v;
}
__device__ __forceinline__ float sigmoid_f(float x) { return __builtin_amdgcn_rcpf(1.f + __expf(-x)); }
__device__ __forceinline__ float silu_f(float x) { return x * __builtin_amdgcn_rcpf(1.f + __expf(-x)); }
__device__ __forceinline__ float softplus_f(float x) { return fmaxf(x, 0.f) + log1pf(__expf(-fabsf(x))); }
__device__ __forceinline__ float logsigmoid_f(float x) { return fminf(x, 0.f) - log1pf(__expf(-fabsf(x))); }
__device__ __forceinline__ void unpack8(u32x4 w, float* f) {
    f[0] = lo16(w.x); f[1] = hi16(w.x); f[2] = lo16(w.y); f[3] = hi16(w.y);
    f[4] = lo16(w.z); f[5] = hi16(w.z); f[6] = lo16(w.w); f[7] = hi16(w.w);
}
__device__ __forceinline__ u32x4 pack8(f32x4 a, f32x4 b) {
    u32x4 w; w.x = pk2(a[0], a[1]); w.y = pk2(a[2], a[3]); w.z = pk2(b[0], b[1]); w.w = pk2(b[2], b[3]); return w;
}
__device__ __forceinline__ int scanrow(int row) {
    if (row < MC) return row;
    const int r = row - MC, b = r >> 12, t = r & 4095;
    return MC + (b << 12) + ((t & 63) << 6) + (t >> 6);
}
__device__ __forceinline__ int modrow(int row) { return row < MC ? 4 : ((row - MC) >> 12); }

struct Unit { const bf16_t* A; const bf16_t* B; const int* tok; int pm, pn; };

__device__ __forceinline__ void tile_order(int L, int nM, int nN, int& pm, int& pn) {
    const int nwg = nM * nN; int wgid = L;
    { const int q = nwg / 8, r = nwg % 8, xcd = wgid % 8, off = wgid / 8; wgid = (xcd < r ? xcd * (q + 1) : r * (q + 1) + (xcd - r) * q) + off; }
    const int nig = 8 * nN, gid = wgid / nig, fm = gid * 8, gsz = (nM - fm) < 8 ? (nM - fm) : 8;
    pm = fm + ((wgid % nig) % gsz); pn = (wgid % nig) / gsz;
}
struct SchedGrid {
    const bf16_t* A; const bf16_t* B; int lda, ldb, pm0, nM, nN, G, c;
    __device__ __forceinline__ bool next(int i, Unit& u) const {
        const long L = (long)i * G + c; if (L >= (long)nM * nN) return false;
        int pm, pn; tile_order((int)L, nM, nN, pm, pn); pm += pm0;
        u.pm = pm; u.pn = pn; u.tok = nullptr; u.A = A + (size_t)pm * 256 * lda; u.B = B + (size_t)pn * 256 * ldb; return true;
    }
};
struct SchedPool {
    const bf16_t* A; const bf16_t* B; int pm0, nM, G, c;
    __device__ __forceinline__ bool next(int i, Unit& u) const {
        const long L = (long)i * G + c; if (L >= (long)nM * 4) return false;
        const int pm = pm0 + (int)(L >> 2), g = (int)(L & 3);
        u.pm = pm; u.pn = g; u.tok = nullptr; u.A = A + (size_t)pm * 256 * 3072 + g * 256; u.B = B + (size_t)g * 65536; return true;
    }
};
struct SchedMoe {
    const bf16_t* A; const bf16_t* B; const int* blkexp; const int* tok; int lda, nblk, G, c; size_t bexp_stride, ldb;
    __device__ __forceinline__ bool next(int i, Unit& u) const {
        const long L = (long)i * G + c; if (L >= (long)nblk * 4) return false;
        const int blk = (int)(L >> 2), nt = (int)(L & 3); const int e = blkexp[blk];
        u.pm = blk; u.pn = nt; u.tok = tok ? tok + blk * 256 : nullptr; u.A = tok ? A : A + (size_t)blk * 256 * lda;
        u.B = B + (size_t)e * bexp_stride + (size_t)nt * 256 * ldb; return true;
    }
};

struct EpiInproj {
    unsigned char* ws;
    __device__ __forceinline__ void seg(const Unit& u, int, int r, int c0, f32x4& lo0, f32x4& lo1, f32x4& hi0, f32x4& hi1) const {
        const int row = u.pm * 256 + r, t = u.pn;
        bf16_t* dst; size_t ld; int cb;
        if (t < 4) { dst = (bf16_t*)(ws + WS_BR) + (size_t)row * 3072; cb = t * 256; }
        else if (t < 16) { const int w = (t - 4) >> 2; dst = (bf16_t*)(ws + WS_Q + (size_t)w * 34 * MiB) + (size_t)scanrow(row) * 1024; cb = ((t - 4) & 3) * 256; }
        else if (t < 20) { dst = (bf16_t*)(ws + WS_BR) + (size_t)row * 3072 + 1024; cb = (t - 16) * 256; }
        else if (t < 24) { dst = (bf16_t*)(ws + WS_SX) + (size_t)row * 1024; cb = (t - 20) * 256; }
        else if (t < 28) { dst = (bf16_t*)(ws + WS_BR) + (size_t)row * 3072 + 2048; cb = (t - 24) * 256; }
        else if (t < 30) { dst = (bf16_t*)(ws + WS_SB) + (size_t)row * 512; cb = (t - 28) * 256; }
        else if (t < 32) { dst = (bf16_t*)(ws + WS_SC) + (size_t)row * 512; cb = (t - 30) * 256; }
        else if (t < 44) {
            dst = (bf16_t*)(ws + WS_MG) + (size_t)row * 3072; cb = (t - 32) * 256;
#pragma unroll
            for (int j = 0; j < 4; ++j) { lo0[j] = sigmoid_f(lo0[j]); lo1[j] = sigmoid_f(lo1[j]); hi0[j] = sigmoid_f(hi0[j]); hi1[j] = sigmoid_f(hi1[j]); }
        } else {
            if (c0 < 32) { float* d = (float*)(ws + WS_DT) + (size_t)row * 32 + c0; *(f32x4*)d = lo0; *(f32x4*)(d + 4) = lo1; }
            else if (c0 < 48) { float* d = (float*)(ws + WS_GA) + (size_t)scanrow(row) * 16 + (c0 - 32); *(f32x4*)d = lo0; *(f32x4*)(d + 4) = lo1; }
            return;
        }
        *(u32x4*)(dst + cb + c0) = pack8(lo0, lo1);
        *(u32x4*)(dst + cb + 128 + c0) = pack8(hi0, hi1);
    }
};
struct EpiPool {
    bf16_t* BR;
    __device__ __forceinline__ void seg(const Unit& u, int, int r, int c0, f32x4& lo0, f32x4& lo1, f32x4& hi0, f32x4& hi1) const {
        bf16_t* d = BR + (size_t)(u.pm * 256 + r) * 3072 + u.pn * 256 + c0;
        *(u32x4*)d = pack8(lo0, lo1);
        *(u32x4*)(d + 128) = pack8(hi0, hi1);
    }
};
struct EpiBranch {
    const bf16_t* MG; bf16_t* OUT;
    __device__ __forceinline__ void seg(const Unit& u, int sg, int r, int c0, f32x4& lo0, f32x4& lo1, f32x4& hi0, f32x4& hi1) const {
        const int row = u.pm * 256 + r, col = u.pn * 256 + c0;
        const bf16_t* g = MG + (size_t)row * 3072 + sg * 1024 + col;
        const int nx = sg < 2 ? 1024 : 0;
        const u32x4 ga = *(const u32x4*)g, gb = *(const u32x4*)(g + 128), gc = *(const u32x4*)(g + nx), gd = *(const u32x4*)(g + nx + 128);
        float a[8], b[8], a2[8], b2[8]; unpack8(ga, a); unpack8(gb, b); unpack8(gc, a2); unpack8(gd, b2);
        if (sg < 2) {
#pragma unroll
            for (int j = 0; j < 8; ++j) { a[j] = a[j] * __builtin_amdgcn_rcpf(a2[j]); b[j] = b[j] * __builtin_amdgcn_rcpf(b2[j]); } }
#pragma unroll
        for (int j = 0; j < 4; ++j) { lo0[j] *= a[j]; lo1[j] *= a[4 + j]; hi0[j] *= b[j]; hi1[j] *= b[4 + j]; }
        if (sg == 2) { bf16_t* d = OUT + (size_t)row * 1024 + col; *(u32x4*)d = pack8(lo0, lo1); *(u32x4*)(d + 128) = pack8(hi0, hi1); }
    }
};
struct EpiOut {
    float* XL; const float* mod; const float* x_in; const float* ctx_in; int dup;
    __device__ __forceinline__ void seg(const Unit& u, int, int r, int c0, f32x4& lo0, f32x4& lo1, f32x4& hi0, f32x4& hi1) const {
        const int row = u.pm * 256 + r, col = u.pn * 256 + c0;
        const float* g = mod + modrow(row) * 6144 + 2 * 1024 + col;
        float* x = XL + (size_t)row * 1024 + col;
        const float* rs = x_in ? (row < MC ? ctx_in + (size_t)row * 1024 + col : x_in + (size_t)(row - MC) * 1024 + col) : x;
        const f32x4 x0 = *(const f32x4*)rs, x1 = *(const f32x4*)(rs + 4), x2 = *(const f32x4*)(rs + 128), x3 = *(const f32x4*)(rs + 132);
        const f32x4 g0 = *(const f32x4*)g, g1 = *(const f32x4*)(g + 4), g2 = *(const f32x4*)(g + 128), g3 = *(const f32x4*)(g + 132);
        if (dup) return;
        *(f32x4*)x = x0 + g0 * lo0; *(f32x4*)(x + 4) = x1 + g1 * lo1; *(f32x4*)(x + 128) = x2 + g2 * hi0; *(f32x4*)(x + 132) = x3 + g3 * hi1;
    }
};
struct EpiMoe1 {
    bf16_t* ACT;
    __device__ __forceinline__ void seg(const Unit& u, int, int r, int c0, f32x4& lo0, f32x4& lo1, f32x4& hi0, f32x4& hi1) const {
        const int row = u.pm * 256 + r;
        f32x4 a, b;
#pragma unroll
        for (int j = 0; j < 4; ++j) { a[j] = silu_f(lo0[j]) * hi0[j]; b[j] = silu_f(lo1[j]) * hi1[j]; }
        *(u32x4*)(ACT + (size_t)row * 512 + u.pn * 128 + c0) = pack8(a, b);
    }
};
struct EpiMoe2 {
    bf16_t* Y;
    __device__ __forceinline__ void seg(const Unit& u, int, int r, int c0, f32x4& lo0, f32x4& lo1, f32x4& hi0, f32x4& hi1) const {
        bf16_t* d = Y + (size_t)(u.pm * 256 + r) * 1024 + u.pn * 256 + c0;
        *(u32x4*)d = pack8(lo0, lo1); *(u32x4*)(d + 128) = pack8(hi0, hi1);
    }
};

#define LAS __attribute__((address_space(3)))
typedef short bf16x8 __attribute__((ext_vector_type(8)));
constexpr int HTB = 128 * 64 * 2;
__device__ __forceinline__ int lds_byte(int r, int c) { const int st = (r >> 4) * 2 + (c >> 5), rr = r & 15, cc = c & 31, ob = rr * 64 + cc * 2; return st * 1024 + (ob ^ (((ob >> 9) & 1) << 5)); }
__device__ __forceinline__ void stage_rc(int b, int& R, int& C) { const int st = b / 1024, sb = b % 1024, swz = sb ^ (((sb >> 9) & 1) << 5); R = (st >> 1) * 16 + swz / 64; C = (st & 1) * 32 + (swz % 64) / 2; }
__device__ __forceinline__ int perm32(int rho) { const int n = rho >> 4, i = rho & 15; return 8 * (i >> 2) + 4 * n + (i & 3); }

template <bool GATHER, class Sched, class Epi>
__device__ __forceinline__ void gemm_mfma(LAS unsigned char* lds, const Sched& S, const Epi& E, const int K, const int lda, const int ldb, const int nseg) {
    const int tid = tid_fresh(), wid = __builtin_amdgcn_readfirstlane(tid >> 6), lane = tid & 63, wr = wid >> 2, wc = wid & 3, fr = lane & 15, fq = lane >> 4;
    const int nt = K / 64, tseg = nt / nseg;
    unsigned vA0[2], vA1[2], nA0[2], nA1[2], voffB[2]; int rowA[2], colA[2];
#pragma unroll
    for (int i = 0; i < 2; ++i) { int R, C; stage_rc(tid * 16 + i * 8192, R, C); const int Rb = (R & ~31) + perm32(R & 31);
        rowA[i] = R; colA[i] = C;
        vA0[i] = (unsigned)(R * lda + C) * 2u; vA1[i] = vA0[i] + (unsigned)(128 * lda * 2); nA0[i] = vA0[i]; nA1[i] = vA1[i];
        voffB[i] = (unsigned)(Rb * ldb + C) * 2u; }
    const size_t kstep = 128;
    const size_t hstepB = (size_t)128 * ldb * 2;
    const unsigned ldsw = (unsigned)wid * 1024u;
    const int aoff = lds_byte(wr * 64 + fr, fq * 8), boff = lds_byte(wc * 32 + fr, fq * 8);
#define PG8_SA(b, h) (((b) * 2 + (h)) * HTB)
#define PG8_SB(b, h) ((4 + (b) * 2 + (h)) * HTB)
#define PG8_STAGE(bufoff, gbase, voff) do { _Pragma("unroll") for (int _i = 0; _i < 2; ++_i) \
        __builtin_amdgcn_global_load_lds((const unsigned*)((const char*)(gbase) + (voff)[_i]), (LAS unsigned*)(lds + (bufoff) + ldsw + _i * 8192), 16, 0, 0); } while (0)
#define PG8_LDA(dst, b, h) do { _Pragma("unroll") for (int m = 0; m < 4; ++m) _Pragma("unroll") for (int k = 0; k < 2; ++k) dst[m][k] = *(const LAS bf16x8*)(lds + PG8_SA(b, h) + aoff + m * 2048 + k * 1024); } while (0)
#define PG8_LDB(dst, b, h) do { _Pragma("unroll") for (int n = 0; n < 2; ++n) _Pragma("unroll") for (int k = 0; k < 2; ++k) dst[n][k] = *(const LAS bf16x8*)(lds + PG8_SB(b, h) + boff + n * 2048 + k * 1024); } while (0)
#define PG8_MMA(ai, bj, At, Bt) do { __builtin_amdgcn_s_setprio(1); _Pragma("unroll") for (int m = 0; m < 4; ++m) _Pragma("unroll") for (int n = 0; n < 2; ++n) _Pragma("unroll") for (int k = 0; k < 2; ++k) \
        acc[ai][bj][m][n] = __builtin_amdgcn_mfma_f32_16x16x32_bf16(Bt[n][k], At[m][k], acc[ai][bj][m][n], 0, 0, 0); __builtin_amdgcn_s_setprio(0); } while (0)
#define PG8_WAIT_V(n) asm volatile("s_waitcnt vmcnt(" #n ")" ::: "memory")
#define PG8_WAIT_L(n) asm volatile("s_waitcnt lgkmcnt(" #n ")" ::: "memory")
#define PG8_BAR __builtin_amdgcn_s_barrier()
#define PG8_SCHED __builtin_amdgcn_sched_barrier(0)
#define PG8_EPI(sg) do { _Pragma("unroll") for (int ai = 0; ai < 2; ++ai) _Pragma("unroll") for (int m = 0; m < 4; ++m) { \
        int r_ = ai * 128 + wr * 64 + m * 16 + fr; asm volatile("" : "+v"(r_));     \
        E.seg(cur, (sg), r_, wc * 32 + fq * 8, acc[ai][0][m][0], acc[ai][0][m][1], acc[ai][1][m][0], acc[ai][1][m][1]); } } while (0)
    Unit cur, nxt; int ui = 0;
    if (!S.next(0, cur)) return;
    f32x4 acc[2][2][4][2];
#pragma unroll
    for (int a = 0; a < 2; ++a)
#pragma unroll
        for (int b = 0; b < 2; ++b)
#pragma unroll
            for (int m = 0; m < 4; ++m)
#pragma unroll
                for (int n = 0; n < 2; ++n) acc[a][b][m][n] = (f32x4){0.f, 0.f, 0.f, 0.f};
    bf16x8 At[4][2], B0[2][2], B1[2][2];
    const char* cA = (const char*)cur.A; const char* cB = (const char*)cur.B;
    if (GATHER) {
#pragma unroll
        for (int i = 0; i < 2; ++i) { vA0[i] = (unsigned)(cur.tok[rowA[i]] * lda + colA[i]) * 2u; vA1[i] = (unsigned)(cur.tok[128 + rowA[i]] * lda + colA[i]) * 2u; nA0[i] = vA0[i]; nA1[i] = vA1[i]; }
    }
    PG8_STAGE(PG8_SB(0, 0), cB, voffB); PG8_STAGE(PG8_SA(0, 0), cA, vA0); PG8_STAGE(PG8_SB(0, 1), cB + hstepB, voffB); PG8_STAGE(PG8_SA(0, 1), cA, vA1);
    if (wr == 1) PG8_BAR;
    PG8_WAIT_V(4); PG8_BAR;
    PG8_STAGE(PG8_SB(1, 0), cB + kstep, voffB); PG8_STAGE(PG8_SA(1, 0), cA + kstep, vA0); PG8_STAGE(PG8_SB(1, 1), cB + hstepB + kstep, voffB);
    PG8_WAIT_V(6); PG8_BAR;
    for (;;) {
        const bool has_next = S.next(ui + 1, nxt);
        const char* nA = has_next ? (const char*)nxt.A : cA; const char* nB = has_next ? (const char*)nxt.B : cB;
        if (GATHER) {
            const int* tk = has_next ? nxt.tok : cur.tok;
#pragma unroll
            for (int i = 0; i < 2; ++i) { nA0[i] = (unsigned)(tk[rowA[i]] * lda + colA[i]) * 2u; nA1[i] = (unsigned)(tk[128 + rowA[i]] * lda + colA[i]) * 2u; }
        }
#pragma nounroll
        for (int sg = 0; sg < nseg; ++sg) {
#pragma nounroll
        for (int tt = 0; tt < tseg; tt += 2) {
            const int t = sg * tseg + tt;
            const bool last = (t == nt - 2);
            const char* a1 = cA + (size_t)(t + 1) * kstep;
            const char* a2 = last ? nA : cA + (size_t)(t + 2) * kstep; const char* b2 = last ? nB : cB + (size_t)(t + 2) * kstep;
            const char* a3 = a2 + kstep; const char* b3 = b2 + kstep;
            unsigned w0[2], w1[2];
#pragma unroll
            for (int i = 0; i < 2; ++i) { w0[i] = last ? nA0[i] : vA0[i]; w1[i] = last ? nA1[i] : vA1[i]; }
            PG8_LDB(B0, 0, 0); PG8_SCHED; PG8_LDA(At, 0, 0); PG8_STAGE(PG8_SA(1, 1), a1, vA1);
            PG8_WAIT_L(8); PG8_BAR; PG8_WAIT_L(0); PG8_MMA(0, 0, At, B0); PG8_BAR; PG8_SCHED;
            PG8_LDB(B1, 0, 1); PG8_STAGE(PG8_SB(0, 0), b2, voffB);
            PG8_BAR; PG8_WAIT_L(0); PG8_MMA(0, 1, At, B1); PG8_BAR;
            PG8_LDA(At, 0, 1); PG8_STAGE(PG8_SA(0, 0), a2, w0);
            PG8_BAR; PG8_WAIT_L(0); PG8_MMA(1, 0, At, B0); PG8_BAR; PG8_SCHED;
            PG8_STAGE(PG8_SB(0, 1), b2 + hstepB, voffB);
            PG8_WAIT_V(6); PG8_BAR; PG8_MMA(1, 1, At, B1); PG8_BAR;
            PG8_LDB(B0, 1, 0); PG8_SCHED; PG8_LDA(At, 1, 0); PG8_STAGE(PG8_SA(0, 1), a2, w1);
            PG8_WAIT_L(8); PG8_BAR; PG8_WAIT_L(0); PG8_MMA(0, 0, At, B0); PG8_BAR; PG8_SCHED;
            PG8_LDB(B1, 1, 1); PG8_STAGE(PG8_SB(1, 0), b3, voffB);
            PG8_BAR; PG8_WAIT_L(0); PG8_MMA(0, 1, At, B1); PG8_BAR;
            PG8_LDA(At, 1, 1); PG8_STAGE(PG8_SA(1, 0), a3, w0);
            PG8_BAR; PG8_WAIT_L(0); PG8_MMA(1, 0, At, B0); PG8_BAR; PG8_SCHED;
            PG8_STAGE(PG8_SB(1, 1), b3 + hstepB, voffB);
            PG8_WAIT_V(6); PG8_BAR; PG8_MMA(1, 1, At, B1); PG8_BAR;
        }
        PG8_EPI(sg);
        }
        if (!has_next) break;
#pragma unroll
        for (int a = 0; a < 2; ++a)
#pragma unroll
            for (int b = 0; b < 2; ++b)
#pragma unroll
                for (int m = 0; m < 4; ++m)
#pragma unroll
                    for (int n = 0; n < 2; ++n) acc[a][b][m][n] = (f32x4){0.f, 0.f, 0.f, 0.f};
        cur = nxt; cA = nA; cB = nB; ++ui;
#pragma unroll
        for (int i = 0; i < 2; ++i) { vA0[i] = nA0[i]; vA1[i] = nA1[i]; }
    }
    PG8_WAIT_V(0);
    if (wr == 0) PG8_BAR;
    PG8_BAR;
#undef PG8_SA
#undef PG8_SB
#undef PG8_STAGE
#undef PG8_LDA
#undef PG8_LDB
#undef PG8_MMA
#undef PG8_WAIT_V
#undef PG8_WAIT_L
#undef PG8_BAR
#undef PG8_SCHED
#undef PG8_EPI
}

template <bool GATHER = false, class Sched, class Epi>
__device__ __forceinline__ void gemm_run(unsigned char* lds, const Sched& S, const Epi& E, int K, int lda, int ldb, int nseg) {
    __syncthreads();
    gemm_mfma<GATHER>((LAS unsigned char*)lds, S, E, K, lda, ldb, nseg);
    __syncthreads();
}

struct TrDesc { const float* src; const float* cscale; bf16_t* dst; int ld_src, ld_dst, valid; };
__device__ __forceinline__ void tr_load(const TrDesc& d, f32x4 (&v)[16]) {
    if (d.src) {
#pragma unroll
        for (int i = 0; i < 16; ++i) v[i] = *(const f32x4*)(d.src + (size_t)(4 * i) * d.ld_src);
    } else {
#pragma unroll
        for (int i = 0; i < 16; ++i) v[i] = (f32x4){0.f, 0.f, 0.f, 0.f};
    }
}
__device__ __forceinline__ void tr_store(const TrDesc& d, f32x4 (&v)[16], float* scr, int lane) {
    const int c4 = (lane & 15) * 4, kr = lane >> 4;
    if (d.cscale) { const f32x4 s = *(const f32x4*)d.cscale;
#pragma unroll
        for (int i = 0; i < 16; ++i) v[i] = v[i] * s; }
#pragma unroll
    for (int i = 0; i < 16; ++i) { float* q = scr + (kr + 4 * i) * 65 + c4; q[0] = v[i][0]; q[1] = v[i][1]; q[2] = v[i][2]; q[3] = v[i][3]; }
    asm volatile("s_waitcnt lgkmcnt(0)" ::: "memory");
    const int c = lane & 7;
#pragma unroll
    for (int j = 0; j < 8; ++j) { const int n = (lane >> 3) + 8 * j; const float* s = scr + (8 * c) * 65 + n;
        u32x4 o; o.x = pk2(s[0 * 65], s[1 * 65]); o.y = pk2(s[2 * 65], s[3 * 65]); o.z = pk2(s[4 * 65], s[5 * 65]); o.w = pk2(s[6 * 65], s[7 * 65]);
        *(u32x4*)(d.dst + (size_t)n * d.ld_dst + 8 * c) = o; }
    asm volatile("s_waitcnt lgkmcnt(0)" ::: "memory");
}
__device__ __forceinline__ TrDesc tr_desc(const float* W, int ld_src, int srcq, bf16_t* WT, int ld_dst, int n_dst, int kdst0, int k0, int lane, const float* cscale = nullptr) {
    TrDesc d; d.ld_src = ld_src; d.ld_dst = ld_dst; d.valid = 1;
    d.src = srcq >= 0 ? W + (size_t)(k0 + (lane >> 4)) * ld_src + srcq : nullptr;
    d.cscale = (cscale && srcq >= 0) ? cscale + srcq : nullptr;
    d.dst = WT + (size_t)n_dst * ld_dst + kdst0 + k0; return d;
}
constexpr int CV_MIX_ITEMS = 2880 + 64 + 768 + 256;
constexpr int CV_EXP_ITEMS = 32 * 384;
__device__ __forceinline__ TrDesc convert_desc(const Params& p, int le, int lm, int it, int lane) {
    unsigned char* ws = p.ws;
    const int c4 = (lane & 15) * 4;
    if (le >= 0) {
        if (it < CV_EXP_ITEMS) {
            const int e = it / 384, r = it % 384;
            if (r < 256) { const int up = r >> 7, q = r & 127, kb = q >> 3, nb = q & 7; const int c = nb * 64;
                const float* src = (up ? p.w_eu : p.w_eg) + (size_t)(le * 32 + e) * 1024 * 512;
                return tr_desc(src, 512, c + c4, (bf16_t*)(ws + WS_EW1) + (size_t)e * 1048576, 1024, (c >> 7) * 256 + up * 128 + (c & 127), 0, kb * 64, lane); }
            const int q = r - 256, kb = q >> 4, nb = q & 15;
            return tr_desc(p.w_ed + (size_t)(le * 32 + e) * 512 * 1024, 1024, nb * 64 + c4, (bf16_t*)(ws + WS_EW2) + (size_t)e * 524288, 512, nb * 64, 0, kb * 64, lane);
        }
        it -= CV_EXP_ITEMS;
    }
    const int l = lm;
    if (it < 2880) { const int R = it >> 4, kb = it & 15, dstn = R * 64; int srcq;
        if (R < 80) srcq = dstn + c4; else if (R < 128) srcq = dstn + 16 + c4; else if (R < 176) srcq = dstn + 48 + c4;
        else if (R == 176) srcq = c4 < 32 ? 8208 + c4 : (c4 < 48 ? 5120 + (c4 - 32) : -1); else srcq = -1;
        return tr_desc(p.w_in + (size_t)l * 1024 * DIN, DIN, srcq, (bf16_t*)(ws + WS_WIN), 1024, dstn, 0, kb * 64, lane); }
    it -= 2880;
    if (it < 64) { const int g = it >> 4, r = it & 15, kb = r >> 2, nb = r & 3;
        return tr_desc(p.pool_w + (size_t)(l * 4 + g) * 65536, 256, nb * 64 + c4, (bf16_t*)(ws + WS_WPOOL) + (size_t)g * 65536, 256, nb * 64, 0, kb * 64, lane, p.pool_scale + l * 1024 + g * 256); }
    it -= 64;
    if (it < 768) { const int br = it >> 8, r = it & 255, kb = r >> 4, nb = r & 15;
        return tr_desc(p.w_branch + (size_t)(l * 3 + br) * 1048576, 1024, nb * 64 + c4, (bf16_t*)(ws + WS_WBR), 3072, nb * 64, br * 1024, kb * 64, lane); }
    it -= 768;
    { const int kb = it >> 4, nb = it & 15;
      return tr_desc(p.w_out + (size_t)l * 1048576, 1024, nb * 64 + c4, (bf16_t*)(ws + WS_WOUT), 1024, nb * 64, 0, kb * 64, lane); }
}
__device__ __forceinline__ void convert_run(const Params& p, int le, int lm, int first, int step, float* scr, int lane) {
    const int nitems = (le >= 0 ? CV_EXP_ITEMS : 0) + (lm >= 0 ? CV_MIX_ITEMS : 0);
    if (first >= nitems) return;
    f32x4 va[16], vb[16];
    TrDesc da = convert_desc(p, le, lm, first, lane), db;
    tr_load(da, va);
    for (int it = first; it < nitems; it += 2 * step) {
        const int i1 = it + step, i2 = it + 2 * step;
        if (i1 < nitems) { db = convert_desc(p, le, lm, i1, lane); tr_load(db, vb); }
        tr_store(da, va, scr, lane);
        if (i1 >= nitems) break;
        if (i2 < nitems) { da = convert_desc(p, le, lm, i2, lane); tr_load(da, va); }
        tr_store(db, vb, scr, lane);
    }
}

__device__ __forceinline__ void phase_pre(const Params& p, unsigned char* ldsb, int bid, int nb) {
    float* lds = reinterpret_cast<float*>(ldsb);
    const int tid = tid_fresh(), lane = tid & 63, wave = tid >> 6;
    for (int i = tid; i < 5 * 1024; i += NTHR) { const float v = i < 4096 ? p.c[i] : p.c_ctx[i - 4096]; lds[i] = silu_f(v); }
    __syncthreads();
    float* red = lds + 5120;
    for (int it = bid; it < 2 * 96; it += nb) {
        const int l = it / 96, j = (it % 96) * 64 + lane;
        const float* w = p.w_ada + (size_t)l * 1024 * 6144 + j;
        float a0 = 0, a1 = 0, a2 = 0, a3 = 0, a4 = 0;
        for (int k = wave * 128; k < wave * 128 + 128; ++k) { const float wv = w[(size_t)k * 6144];
            a0 += lds[k] * wv; a1 += lds[1024 + k] * wv; a2 += lds[2048 + k] * wv; a3 += lds[3072 + k] * wv; a4 += lds[4096 + k] * wv; }
        red[(wave * 5 + 0) * 64 + lane] = a0; red[(wave * 5 + 1) * 64 + lane] = a1; red[(wave * 5 + 2) * 64 + lane] = a2;
        red[(wave * 5 + 3) * 64 + lane] = a3; red[(wave * 5 + 4) * 64 + lane] = a4;
        __syncthreads();
        if (tid < 320) { const int r = tid >> 6, jj = tid & 63; float s = 0;
            for (int w8 = 0; w8 < 8; ++w8) s += red[(w8 * 5 + r) * 64 + jj];
            const int col = (it % 96) * 64 + jj;
            ((float*)(p.ws + WS_MOD))[(size_t)(l * 5 + r) * 6144 + col] = s + p.b_ada[l * 6144 + col]; }
        __syncthreads();
    }
    __syncthreads();
    float* scr = lds + wave * (64 * 65);
    convert_run(p, -1, 0, bid * 8 + wave, nb * 8, scr, lane);
}

__device__ __forceinline__ void norm_mod_row(f32x4 (&v)[4], const float* g, const float* shift, const float* scale, int lane) {
    float s = 0.f;
#pragma unroll
    for (int j = 0; j < 4; ++j) s += (v[j][0] * v[j][0] + v[j][1] * v[j][1]) + (v[j][2] * v[j][2] + v[j][3] * v[j][3]);
    const float rs = __builtin_amdgcn_rsqf(wave_sum(s) * (1.f / 1024.f) + EPS);
#pragma unroll
    for (int j = 0; j < 4; ++j) { const int c = 4 * lane + 256 * j; const f32x4 gg = *(const f32x4*)(g + c);
        f32x4 y = v[j] * rs * gg;
        if (shift) { const f32x4 sh = *(const f32x4*)(shift + c), sc = *(const f32x4*)(scale + c); y = y * (1.f + sc) + sh; }
        v[j] = y; }
}
__device__ __forceinline__ void store_row_bf16(bf16_t* dst, const f32x4 (&v)[4], int lane) {
#pragma unroll
    for (int j = 0; j < 4; ++j) { u32x2 w; w.x = pk2(v[j][0], v[j][1]); w.y = pk2(v[j][2], v[j][3]); *(u32x2*)(dst + 4 * lane + 256 * j) = w; }
}

__device__ __forceinline__ void phase_norm1(const Params& p, int bid, int nb) {
    const int lane = tid_fresh() & 63, wave = tid_fresh() >> 6;
    const float* mod = (const float*)(p.ws + WS_MOD);
    const int stride = nb * 8;
    int m = bid * 8 + wave;
    f32x4 v[4], w[4];
    if (m < MT) { const float* src = m < MC ? p.ctx + (size_t)m * 1024 : p.x + (size_t)(m - MC) * 1024;
#pragma unroll
        for (int j = 0; j < 4; ++j) v[j] = *(const f32x4*)(src + 4 * lane + 256 * j); }
    for (; m < MT; m += stride) {
        const int mn = m + stride;
        if (mn < MT) { const float* src = mn < MC ? p.ctx + (size_t)mn * 1024 : p.x + (size_t)(mn - MC) * 1024;
#pragma unroll
            for (int j = 0; j < 4; ++j) w[j] = *(const f32x4*)(src + 4 * lane + 256 * j); }
        const float* mr = mod + modrow(m) * 6144;
        norm_mod_row(v, p.g_mix, mr, mr + 1024, lane);
        store_row_bf16((bf16_t*)(p.ws + WS_H) + (size_t)m * 1024, v, lane);
#pragma unroll
        for (int j = 0; j < 4; ++j) v[j] = w[j];
    }
}

__device__ __forceinline__ float wave_incl_sum(float v, int lane) {
#pragma unroll
    for (int o = 1; o < 64; o <<= 1) { const float u = __shfl_up(v, o); if (lane >= o) v += u; }
    return v;
}
__device__ __forceinline__ float wave_incl_max(float v, int lane) {
#pragma unroll
    for (int o = 1; o < 64; o <<= 1) { const float u = __shfl_up(v, o); if (lane >= o) v = fmaxf(v, u); }
    return v;
}
__device__ __forceinline__ u32x2 pack4(f32x4 a) { u32x2 w; w.x = pk2(a[0], a[1]); w.y = pk2(a[2], a[3]); return w; }

__device__ __forceinline__ void chunk_geom(int gc, int& rbase, int& n0, int& len) {
    const int b = gc / 68, cin = gc % 68;
    if (cin < 4) { rbase = b * 256; n0 = cin * 64; len = 256; } else { rbase = MC + b * 4096; n0 = (cin - 4) * 64; len = 4096; }
}
__device__ __forceinline__ void conv8x4(const u32x4 (&raw)[7], const float* cw, const float* cb, int ch0, float scale, u32x4 (&out)[4]) {
    float w[4][8], bs[8];
#pragma unroll
    for (int j = 0; j < 4; ++j) { const f32x4 a = *(const f32x4*)(cw + j * 2048 + ch0), b2 = *(const f32x4*)(cw + j * 2048 + ch0 + 4);
#pragma unroll
        for (int i = 0; i < 4; ++i) { w[j][i] = a[i]; w[j][4 + i] = b2[i]; } }
    { const f32x4 a = *(const f32x4*)(cb + ch0), b2 = *(const f32x4*)(cb + ch0 + 4);
#pragma unroll
      for (int i = 0; i < 4; ++i) { bs[i] = a[i]; bs[4 + i] = b2[i]; } }
    float f[7][8];
#pragma unroll
    for (int k = 0; k < 7; ++k) unpack8(raw[k], f[k]);
#pragma unroll
    for (int pp = 0; pp < 4; ++pp) { f32x4 o0, o1;
#pragma unroll
        for (int i = 0; i < 8; ++i) { float a = bs[i];
#pragma unroll
            for (int j = 0; j < 4; ++j) a += w[j][i] * f[pp + j][i];
            a = silu_f(a) * scale; if (i < 4) o0[i] = a; else o1[i - 4] = a; }
        out[pp] = pack8(o0, o1); }
}
__device__ __forceinline__ void load_raw7(const bf16_t* src, size_t ld, int rbase, int tbase, int len, u32x4 (&raw)[7]) {
#pragma unroll
    for (int k = 0; k < 7; ++k) { const int t = tbase + k; const bool ok = (t >= 0) && (t < len); const int tc = t < 0 ? 0 : (t >= len ? len - 1 : t);
        u32x4 a = *(const u32x4*)(src + (size_t)(rbase + tc) * ld);
        if (!ok) a = (u32x4){0u, 0u, 0u, 0u};
        raw[k] = a; }
}
template <class F>
__device__ __forceinline__ void tile_transpose_out(const LAS bf16_t* tile, int ldsw, int ncol, int tid, F rowptr) {
    for (int q = tid; q < ncol * 8; q += NTHR) { const int c = q % ncol, sc = q / ncol;
        unsigned v[8];
#pragma unroll
        for (int i = 0; i < 8; ++i) v[i] = tile[(sc * 8 + i) * ldsw + c];
        u32x4 w; w.x = v[0] | (v[1] << 16); w.y = v[2] | (v[3] << 16); w.z = v[4] | (v[5] << 16); w.w = v[6] | (v[7] << 16);
        *(u32x4*)(rowptr(c) + sc * 8) = w; }
}

__device__ __forceinline__ void conv_m_item(const Params& p, int l, int item, LAS unsigned char* lds) {
    const int tid = tid_fresh(), gc = item >> 2, hd = item & 3;
    int rbase, n0, len; chunk_geom(gc, rbase, n0, len);
    const int cs = tid & 31, tg = tid >> 5, d0 = cs * 8, i0 = tg * 4;
    const float* cw = p.mconv_w + (size_t)l * 4 * 2048; const float* cb = p.mconv_b + (size_t)l * 2048;
    LAS bf16_t* Kl = (LAS bf16_t*)lds; LAS bf16_t* Vl = (LAS bf16_t*)(lds + 64 * 528);
    __syncthreads();
    { u32x4 raw[7], o[4];
      load_raw7((const bf16_t*)(p.ws + WS_Q) + hd * 256 + d0, 1024, rbase, n0 + i0 - 2, len, raw);
      conv8x4(raw, cw, cb, hd * 256 + d0, 1.0f, o);
#pragma unroll
      for (int pp = 0; pp < 4; ++pp) *(u32x4*)((bf16_t*)(p.ws + WS_QC) + (size_t)(rbase + n0 + i0 + pp) * 1024 + hd * 256 + d0) = o[pp];
      load_raw7((const bf16_t*)(p.ws + WS_K) + hd * 256 + d0, 1024, rbase, n0 + i0 - 2, len, raw);
      conv8x4(raw, cw, cb, 1024 + hd * 256 + d0, 0.0625f, o);
#pragma unroll
      for (int pp = 0; pp < 4; ++pp) { *(u32x4*)((bf16_t*)(p.ws + WS_KC) + (size_t)(rbase + n0 + i0 + pp) * 1024 + hd * 256 + d0) = o[pp];
          *(LAS u32x4*)((LAS unsigned char*)Kl + (i0 + pp) * 528 + d0 * 2) = o[pp]; } }
#pragma unroll
    for (int j = 0; j < 4; ++j) { const int q = tid + NTHR * j, row = q >> 5, ch = q & 31;
        *(LAS u32x4*)((LAS unsigned char*)Vl + row * 528 + ch * 16) = *(const u32x4*)((const bf16_t*)(p.ws + WS_V) + (size_t)(rbase + n0 + row) * 1024 + hd * 256 + ch * 8); }
    __syncthreads();
    if ((tid >> 6) < 2) {
        const int dir = tid >> 6, lane = tid & 63, j = dir ? 63 - lane : lane;
        const float* g = (const float*)(p.ws + WS_GA) + (size_t)(rbase + n0 + j) * 16;
        const float ig = g[dir * 4 + hd] + p.mgate_b[l * 16 + dir * 4 + hd], lf = logsigmoid_f(g[(2 + dir) * 4 + hd] + p.mgate_b[l * 16 + (2 + dir) * 4 + hd]);
        const float cum = wave_incl_sum(lf, lane), a = ig - cum, pm = wave_incl_max(a, lane);
        const size_t o = (size_t)(gc * 8 + dir * 4 + hd) * 64 + j;
        ((float*)(p.ws + WS_MGA))[o] = a; ((float*)(p.ws + WS_MGC))[o] = cum; ((float*)(p.ws + WS_MGP))[o] = pm;
    }
    bf16_t* kct = (bf16_t*)(p.ws + WS_KCT) + (size_t)(gc * 4 + hd) * 16384; bf16_t* vt = (bf16_t*)(p.ws + WS_VT) + (size_t)(gc * 4 + hd) * 16384;
    tile_transpose_out(Kl, 264, 256, tid, [&](int c) { return kct + c * 64; });
    tile_transpose_out(Vl, 264, 256, tid, [&](int c) { return vt + c * 64; });
}

__device__ __forceinline__ void conv_s_item(const Params& p, int l, int item, LAS unsigned char* lds) {
    const int tid = tid_fresh(), gc = item >> 2, grp = item & 3;
    int rbase, n0, len; chunk_geom(gc, rbase, n0, len);
    const int cs = tid & 31, tg = tid >> 5, i0 = tg * 4;
    const float* cw = p.sconv_w + (size_t)l * 4 * 2048; const float* cb = p.sconv_b + (size_t)l * 2048;
    LAS bf16_t* Bl = (LAS bf16_t*)lds; LAS bf16_t* Xl = (LAS bf16_t*)(lds + 64 * 272);
    __syncthreads();
    { u32x4 raw[7], o[4];
      const int isC = cs >> 4, nn = (cs & 15) * 8;
      load_raw7((const bf16_t*)(p.ws + (isC ? WS_SC : WS_SB)) + grp * 128 + nn, 512, rbase, n0 + i0 - 2, len, raw);
      conv8x4(raw, cw, cb, 1024 + isC * 512 + grp * 128 + nn, 1.0f, o);
      bf16_t* dst = (bf16_t*)(p.ws + (isC ? WS_CC : WS_BC)) + grp * 128 + nn;
#pragma unroll
      for (int pp = 0; pp < 4; ++pp) { *(u32x4*)(dst + (size_t)(rbase + n0 + i0 + pp) * 512) = o[pp];
          if (!isC) *(LAS u32x4*)((LAS unsigned char*)Bl + (i0 + pp) * 272 + nn * 2) = o[pp]; }
      load_raw7((const bf16_t*)(p.ws + WS_SX) + grp * 256 + cs * 8, 1024, rbase, n0 + i0 - 2, len, raw);
      conv8x4(raw, cw, cb, grp * 256 + cs * 8, 1.0f, o);
#pragma unroll
      for (int pp = 0; pp < 4; ++pp) *(LAS u32x4*)((LAS unsigned char*)Xl + (i0 + pp) * 528 + cs * 16) = o[pp]; }
    __syncthreads();
    { const int wv = tid >> 6, lane = tid & 63, dir = wv >> 2, hd = grp * 4 + (wv & 3), j = dir ? 63 - lane : lane;
      const float dtv = softplus_f(((const float*)(p.ws + WS_DT))[(size_t)(rbase + n0 + j) * 32 + dir * 16 + hd] + p.sdt_bias[l * 32 + dir * 16 + hd]);
      const float acs = wave_incl_sum(dtv * -__expf(p.sa_log[l * 32 + dir * 16 + hd]), lane);
      const size_t o = (size_t)(gc * 32 + dir * 16 + hd) * 64 + j;
      ((float*)(p.ws + WS_SACS))[o] = acs; ((float*)(p.ws + WS_SDT))[o] = dtv; }
    bf16_t* bct = (bf16_t*)(p.ws + WS_BCT) + (size_t)(gc * 4 + grp) * 8192; bf16_t* xct = (bf16_t*)(p.ws + WS_XCT) + (size_t)(gc * 16 + grp * 4) * 4096;
    tile_transpose_out(Bl, 136, 128, tid, [&](int c) { return bct + c * 64; });
    tile_transpose_out(Xl, 264, 256, tid, [&](int c) { return xct + c * 64; });
}

__device__ __forceinline__ void pool_window_item(const Params& p, int it, LAS unsigned char* lds) {
    const int tid = tid_fresh();
    bf16_t* BR = (bf16_t*)(p.ws + WS_BR);
    __syncthreads();
    if (it < 256) {
        const int row0 = MC + it * 64;
        for (int q = tid; q < 64 * 128; q += NTHR) { const int r = q >> 7, ch = q & 127;
            *(LAS u32x4*)(lds + q * 16) = *(const u32x4*)(BR + (size_t)(row0 + r) * 3072 + ch * 8); }
        __syncthreads();
        for (int q = tid; q < 64 * 128; q += NTHR) { const int r = q >> 7, ch = q & 127, w = 2 << (ch >> 5);
            int lo = r - (w >> 1), hi = lo + w - 1; lo = lo < 0 ? 0 : lo; hi = hi > 63 ? 63 : hi;
            float s[8] = {0, 0, 0, 0, 0, 0, 0, 0}, self[8];
            for (int rr = lo; rr <= hi; ++rr) { float f[8]; unpack8(*(const LAS u32x4*)(lds + (rr * 128 + ch) * 16), f);
#pragma unroll
                for (int j = 0; j < 8; ++j) s[j] += f[j]; }
            unpack8(*(const LAS u32x4*)(lds + q * 16), self);
            const float inv = __builtin_amdgcn_rcpf((float)(hi - lo + 1)); f32x4 a, b;
#pragma unroll
            for (int j = 0; j < 4; ++j) { a[j] = s[j] * inv - self[j]; b[j] = s[4 + j] * inv - self[4 + j]; }
            *(u32x4*)(BR + (size_t)(row0 + r) * 3072 + ch * 8) = pack8(a, b); }
    } else {
        const int bb = (it - 256) >> 2, g = (it - 256) & 3, row0 = bb * 256, w = 2 << g;
        for (int q = tid; q < 256 * 32; q += NTHR) { const int r = q >> 5, ch = q & 31;
            *(LAS u32x4*)(lds + q * 16) = *(const u32x4*)(BR + (size_t)(row0 + r) * 3072 + g * 256 + ch * 8); }
        __syncthreads();
        for (int q = tid; q < 256 * 32; q += NTHR) { const int r = q >> 5, ch = q & 31;
            int lo = r - (w >> 1), hi = lo + w - 1; lo = lo < 0 ? 0 : lo; hi = hi > 255 ? 255 : hi;
            float s[8] = {0, 0, 0, 0, 0, 0, 0, 0}, self[8];
            for (int rr = lo; rr <= hi; ++rr) { float f[8]; unpack8(*(const LAS u32x4*)(lds + (rr * 32 + ch) * 16), f);
#pragma unroll
                for (int j = 0; j < 8; ++j) s[j] += f[j]; }
            unpack8(*(const LAS u32x4*)(lds + q * 16), self);
            const float inv = __builtin_amdgcn_rcpf((float)(hi - lo + 1)); f32x4 a, b;
#pragma unroll
            for (int j = 0; j < 4; ++j) { a[j] = s[j] * inv - self[j]; b[j] = s[4 + j] * inv - self[4 + j]; }
            *(u32x4*)(BR + (size_t)(row0 + r) * 3072 + g * 256 + ch * 8) = pack8(a, b); }
    }
    __syncthreads();
}

constexpr int ML_VT = 0, ML_VWT = 5280, ML_CT = 10560, ML_Q = 28512, ML_K = 63328, ML_KT = 98144, ML_A = 139104, ML_MISC = 149344;
__device__ __forceinline__ void mlstm_chunk_item(const Params& p, int l, int item, LAS unsigned char* lds) {
    const int tid = tid_fresh(), lane = tid & 63, wid = __builtin_amdgcn_readfirstlane(tid >> 6), fr = lane & 15, fq = lane >> 4;
    const int b = item >> 6, hd = (item >> 4) & 3, dir = (item >> 3) & 1, eg = item & 7;
    const bf16_t* QC = (const bf16_t*)(p.ws + WS_QC); const bf16_t* KC = (const bf16_t*)(p.ws + WS_KC);
    const bf16_t* KCT = (const bf16_t*)(p.ws + WS_KCT); const bf16_t* VT = (const bf16_t*)(p.ws + WS_VT);
    const float* GAa = (const float*)(p.ws + WS_MGA); const float* GCc = (const float*)(p.ws + WS_MGC); const float* GPp = (const float*)(p.ws + WS_MGP);
    bf16_t* OUT = (bf16_t*)(p.ws + (dir ? WS_HB2 : WS_HF2));
    const int ti = wid >> 1, wh = wid & 1;
    __syncthreads();
    for (int i = tid; i < 17952 / 4; i += NTHR) ((LAS unsigned*)(lds + ML_CT))[i] = 0u;
    if (tid < 64) ((LAS bf16_t*)(lds + ML_VT + 32 * 160))[tid] = (bf16_t)0x3F80;
    f32x4 Cacc[2][3];
#pragma unroll
    for (int j = 0; j < 2; ++j)
#pragma unroll
        for (int e = 0; e < 3; ++e) Cacc[j][e] = (f32x4){0.f, 0.f, 0.f, 0.f};
    float m_st = 0.f;
    f32x4 ca0 = (f32x4){0.f, 0.f, 0.f, 0.f}, ca1 = ca0, caw = ca0, cP4 = ca0, cC4 = ca0; float cPt = 0.f, cPl = 0.f, cCl = 0.f;
    const int gs0 = 16 * (2 * wh) + 4 * fq, gs4 = (tid & 15) * 4, gt = 16 * ti + fr, gt0 = 16 * ti + 4 * fq, jl = dir ? 0 : 63;
    __syncthreads();
    for (int c = -1; c < 68; ++c) {
        const int cn = c + 1;
        u32x4 rq[4], rk[4], rt[4], rv = (u32x4){0u, 0u, 0u, 0u};
        f32x4 na0 = (f32x4){0.f, 0.f, 0.f, 0.f}, na1 = na0, naw = na0, nP4 = na0, nC4 = na0; float nPt = 0.f, nPl = 0.f, nCl = 0.f;
#pragma unroll
        for (int j = 0; j < 4; ++j) { rq[j] = (u32x4){0u, 0u, 0u, 0u}; rk[j] = rq[j]; rt[j] = rq[j]; }
        if (cn < 68) {
            const int cin = cn < 4 ? (dir ? 3 - cn : cn) : 4 + (dir ? 67 - cn : cn - 4), gc = b * 68 + cin;
            int rbase, n0, len; chunk_geom(gc, rbase, n0, len);
#pragma unroll
            for (int j = 0; j < 4; ++j) { const int q = tid + NTHR * j;
                const size_t ro = (size_t)(rbase + n0 + (q >> 5)) * 1024 + hd * 256 + (q & 31) * 8;
                rq[j] = *(const u32x4*)(QC + ro); rk[j] = *(const u32x4*)(KC + ro);
                rt[j] = *(const u32x4*)(KCT + (size_t)(gc * 4 + hd) * 16384 + (size_t)q * 8); }
            if (tid < 256) rv = *(const u32x4*)(VT + ((size_t)(gc * 4 + hd) * 256 + eg * 32) * 64 + (size_t)tid * 8);
            { const size_t gb = (size_t)(gc * 8 + dir * 4 + hd) * 64;
              na0 = *(const f32x4*)(GAa + gb + gs0); na1 = *(const f32x4*)(GAa + gb + gs0 + 16); naw = *(const f32x4*)(GAa + gb + gs4);
              nP4 = *(const f32x4*)(GPp + gb + gt0); nC4 = *(const f32x4*)(GCc + gb + gt0); nPt = GPp[gb + gt]; nPl = GPp[gb + jl]; nCl = GCc[gb + jl]; }
        }
        if (c >= 0) {
            const int cin = c < 4 ? (dir ? 3 - c : c) : 4 + (dir ? 67 - c : c - 4), gc = b * 68 + cin;
            int rbase, n0, len; chunk_geom(gc, rbase, n0, len);
            {
                f32x4 st[2] = {(f32x4){0.f, 0.f, 0.f, 0.f}, (f32x4){0.f, 0.f, 0.f, 0.f}};
                const LAS unsigned char* qb = lds + ML_Q + (16 * ti + fr) * 544 + fq * 16;
                const LAS unsigned char* kb0 = lds + ML_K + (16 * (2 * wh) + fr) * 544 + fq * 16;
#pragma unroll
                for (int kd = 0; kd < 8; ++kd) {
                    const bf16x8 qf = *(const LAS bf16x8*)(qb + kd * 64);
                    const bf16x8 k0 = *(const LAS bf16x8*)(kb0 + kd * 64), k1 = *(const LAS bf16x8*)(kb0 + 16 * 544 + kd * 64);
                    st[0] = __builtin_amdgcn_mfma_f32_16x16x32_bf16(k0, qf, st[0], 0, 0, 0);
                    st[1] = __builtin_amdgcn_mfma_f32_16x16x32_bf16(k1, qf, st[1], 0, 0, 0);
                }
                const int t = 16 * ti + fr; const float Mt = fmaxf(m_st, cPt), M63 = fmaxf(m_st, cPl);
#pragma unroll
                for (int j = 0; j < 2; ++j) { const int s0 = 16 * (2 * wh + j) + 4 * fq; const f32x4 av = j ? ca1 : ca0;
                    f32x4 o;
#pragma unroll
                    for (int r = 0; r < 4; ++r) { const bool keep = dir ? (s0 + r >= t) : (s0 + r <= t); o[r] = keep ? st[j][r] * __expf(av[r] - Mt) : 0.f; }
                    *(LAS u32x2*)(lds + ML_A + t * 160 + s0 * 2) = pack4(o); }
                { const int e = tid >> 4, s4 = (tid & 15) * 4; const u32x2 v = *(const LAS u32x2*)(lds + ML_VT + e * 160 + s4 * 2);
                  f32x4 w; w[0] = __expf(caw[0] - M63); w[1] = __expf(caw[1] - M63); w[2] = __expf(caw[2] - M63); w[3] = __expf(caw[3] - M63);
                  f32x4 o; o[0] = lo16(v.x) * w[0]; o[1] = hi16(v.x) * w[1]; o[2] = lo16(v.y) * w[2]; o[3] = hi16(v.y) * w[3];
                  *(LAS u32x2*)(lds + ML_VWT + e * 160 + s4 * 2) = pack4(o);
                  if (tid < 16) *(LAS u32x2*)(lds + ML_VWT + 32 * 160 + s4 * 2) = pack4(w); }
            }
            __syncthreads();
            {
                f32x4 n1o = (f32x4){0.f, 0.f, 0.f, 0.f}, n1a = n1o, n2o = n1o, n2a = n1o;
                const LAS unsigned char* ab = lds + ML_A + (16 * ti + fr) * 160 + fq * 16;
                const LAS unsigned char* vo = lds + ML_VT + (16 * wh + fr) * 160 + fq * 16;
                const LAS unsigned char* va = lds + ML_VT + (32 + fr) * 160 + fq * 16;
#pragma unroll
                for (int ks = 0; ks < 2; ++ks) { const bf16x8 af = *(const LAS bf16x8*)(ab + ks * 64);
                    n1o = __builtin_amdgcn_mfma_f32_16x16x32_bf16(af, *(const LAS bf16x8*)(vo + ks * 64), n1o, 0, 0, 0);
                    n1a = __builtin_amdgcn_mfma_f32_16x16x32_bf16(af, *(const LAS bf16x8*)(va + ks * 64), n1a, 0, 0, 0); }
                const LAS unsigned char* qb = lds + ML_Q + (16 * ti + fr) * 544 + fq * 16;
                const LAS unsigned char* co = lds + ML_CT + (16 * wh + fr) * 544 + fq * 16;
                const LAS unsigned char* ca = lds + ML_CT + (32 + fr) * 544 + fq * 16;
#pragma unroll
                for (int kd = 0; kd < 8; ++kd) { const bf16x8 qf = *(const LAS bf16x8*)(qb + kd * 64);
                    n2o = __builtin_amdgcn_mfma_f32_16x16x32_bf16(qf, *(const LAS bf16x8*)(co + kd * 64), n2o, 0, 0, 0);
                    n2a = __builtin_amdgcn_mfma_f32_16x16x32_bf16(qf, *(const LAS bf16x8*)(ca + kd * 64), n2a, 0, 0, 0); }
                const int t0 = 16 * ti + 4 * fq;
                f32x4 sgv, emv;
#pragma unroll
                for (int r = 0; r < 4; ++r) { const float Mr = fmaxf(m_st, cP4[r]); sgv[r] = __expf(m_st - Mr); emv[r] = __expf(-(cC4[r] + Mr)); }
                const bool wr_out = !(l == 1 && cin < 4);
#pragma unroll
                for (int r = 0; r < 4; ++r) {
                    const float den = __shfl(n1a[r] + sgv[r] * n2a[r], lane & 48);
                    const float hv = (n1o[r] + sgv[r] * n2o[r]) * __builtin_amdgcn_rcpf(fmaxf(fabsf(den), emv[r]));
                    if (wr_out) OUT[(size_t)(rbase + n0 + t0 + r) * 1024 + hd * 256 + eg * 32 + 16 * wh + fr] = (bf16_t)f2bf(hv);
                }
                const float decay = __expf(m_st - fmaxf(m_st, cPl));
#pragma unroll
                for (int j = 0; j < 2; ++j)
#pragma unroll
                    for (int e = 0; e < 3; ++e) Cacc[j][e] = Cacc[j][e] * decay;
                const LAS unsigned char* kt = lds + ML_KT + (16 * (2 * wid) + fr) * 160 + fq * 16;
                const LAS unsigned char* vw = lds + ML_VWT + fr * 160 + fq * 16;
#pragma unroll
                for (int ks = 0; ks < 2; ++ks) {
                    const bf16x8 k0 = *(const LAS bf16x8*)(kt + ks * 64), k1 = *(const LAS bf16x8*)(kt + 16 * 160 + ks * 64);
                    const bf16x8 v0 = *(const LAS bf16x8*)(vw + ks * 64), v1 = *(const LAS bf16x8*)(vw + 16 * 160 + ks * 64), v2 = *(const LAS bf16x8*)(vw + 32 * 160 + ks * 64);
                    Cacc[0][0] = __builtin_amdgcn_mfma_f32_16x16x32_bf16(k0, v0, Cacc[0][0], 0, 0, 0);
                    Cacc[0][1] = __builtin_amdgcn_mfma_f32_16x16x32_bf16(k0, v1, Cacc[0][1], 0, 0, 0);
                    Cacc[0][2] = __builtin_amdgcn_mfma_f32_16x16x32_bf16(k0, v2, Cacc[0][2], 0, 0, 0);
                    Cacc[1][0] = __builtin_amdgcn_mfma_f32_16x16x32_bf16(k1, v0, Cacc[1][0], 0, 0, 0);
                    Cacc[1][1] = __builtin_amdgcn_mfma_f32_16x16x32_bf16(k1, v1, Cacc[1][1], 0, 0, 0);
                    Cacc[1][2] = __builtin_amdgcn_mfma_f32_16x16x32_bf16(k1, v2, Cacc[1][2], 0, 0, 0);
                }
            }
            __syncthreads();
#pragma unroll
            for (int j = 0; j < 2; ++j) { const int dcol = (16 * (2 * wid + j) + 4 * fq) * 2;
                *(LAS u32x2*)(lds + ML_CT + fr * 544 + dcol) = pack4(Cacc[j][0]);
                *(LAS u32x2*)(lds + ML_CT + (16 + fr) * 544 + dcol) = pack4(Cacc[j][1]);
                if (fr == 0) *(LAS u32x2*)(lds + ML_CT + 32 * 544 + dcol) = pack4(Cacc[j][2]); }
        }
        if (c >= 0) m_st = cCl + fmaxf(m_st, cPl);
        ca0 = na0; ca1 = na1; caw = naw; cP4 = nP4; cC4 = nC4; cPt = nPt; cPl = nPl; cCl = nCl;
        if (cn < 68) {
#pragma unroll
            for (int j = 0; j < 4; ++j) { const int q = tid + NTHR * j;
                *(LAS u32x4*)(lds + ML_Q + (q >> 5) * 544 + (q & 31) * 16) = rq[j];
                *(LAS u32x4*)(lds + ML_K + (q >> 5) * 544 + (q & 31) * 16) = rk[j];
                *(LAS u32x4*)(lds + ML_KT + (q >> 3) * 160 + (q & 7) * 16) = rt[j]; }
            if (tid < 256) *(LAS u32x4*)(lds + ML_VT + (tid >> 3) * 160 + (tid & 7) * 16) = rv;
        }
        __syncthreads();
    }
}

constexpr int SS_C = 0, SS_B = 18432, SS_BT = 36864, SS_XT = 57344, SS_XWT = 62464, SS_G = 67584, SS_S = 77824, SS_XRT = 87040, SS_MISC = 92160;
__device__ __forceinline__ void ssd_chunk_item(const Params& p, int l, int item, LAS unsigned char* lds) {
    const int tid = tid_fresh(), lane = tid & 63, wid = __builtin_amdgcn_readfirstlane(tid >> 6), fr = lane & 15, fq = lane >> 4;
    const int b = item >> 6, hd = (item >> 2) & 15, dir = (item >> 1) & 1, ps = item & 1, grp = hd >> 2;
    const bf16_t* BC = (const bf16_t*)(p.ws + WS_BC); const bf16_t* CC = (const bf16_t*)(p.ws + WS_CC);
    const bf16_t* BCT = (const bf16_t*)(p.ws + WS_BCT); const bf16_t* XCT = (const bf16_t*)(p.ws + WS_XCT);
    const float* ACS = (const float*)(p.ws + WS_SACS); const float* SDT = (const float*)(p.ws + WS_SDT);
    bf16_t* OUT = (bf16_t*)(p.ws + (dir ? WS_YB : WS_YF));
    const float dskip = p.sd[l * 16 + hd];
    const int ti = wid >> 1, wh = wid & 1;
    __syncthreads();
    for (int i = tid; i < 9216 / 4; i += NTHR) ((LAS unsigned*)(lds + SS_S))[i] = 0u;
    f32x4 Sacc[2] = {(f32x4){0.f, 0.f, 0.f, 0.f}, (f32x4){0.f, 0.f, 0.f, 0.f}};
    f32x4 cs0 = (f32x4){0.f, 0.f, 0.f, 0.f}, cs1 = cs0, csw = cs0, cdw = cs0, ct4 = cs0; float cat = 0.f, cal = 0.f;
    const int gs0 = 16 * (2 * wh) + 4 * fq, gs4 = (tid & 15) * 4, gt = 16 * ti + fr, gt0 = 16 * ti + 4 * fq, jl = dir ? 0 : 63;
    __syncthreads();
    for (int c = -1; c < 68; ++c) {
        const int cn = c + 1;
        u32x4 rc[2], rb[2], rt[2], rx = (u32x4){0u, 0u, 0u, 0u};
        f32x4 ns0 = (f32x4){0.f, 0.f, 0.f, 0.f}, ns1 = ns0, nsw = ns0, ndw = ns0, nt4 = ns0; float nat = 0.f, nal = 0.f;
#pragma unroll
        for (int j = 0; j < 2; ++j) { rc[j] = (u32x4){0u, 0u, 0u, 0u}; rb[j] = rc[j]; rt[j] = rc[j]; }
        if (cn < 68) {
            const int cin = cn < 4 ? (dir ? 3 - cn : cn) : 4 + (dir ? 67 - cn : cn - 4), gc = b * 68 + cin;
            int rbase, n0, len; chunk_geom(gc, rbase, n0, len);
#pragma unroll
            for (int j = 0; j < 2; ++j) { const int q = tid + NTHR * j;
                const size_t ro = (size_t)(rbase + n0 + (q >> 4)) * 512 + grp * 128 + (q & 15) * 8;
                rc[j] = *(const u32x4*)(CC + ro); rb[j] = *(const u32x4*)(BC + ro);
                rt[j] = *(const u32x4*)(BCT + (size_t)(gc * 4 + grp) * 8192 + (size_t)q * 8); }
            if (tid < 256) rx = *(const u32x4*)(XCT + ((size_t)(gc * 16 + hd) * 64 + ps * 32) * 64 + (size_t)tid * 8);
            { const size_t gb = (size_t)(gc * 32 + dir * 16 + hd) * 64;
              ns0 = *(const f32x4*)(ACS + gb + gs0); ns1 = *(const f32x4*)(ACS + gb + gs0 + 16); nsw = *(const f32x4*)(ACS + gb + gs4); ndw = *(const f32x4*)(SDT + gb + gs4);
              nt4 = *(const f32x4*)(ACS + gb + gt0); nat = ACS[gb + gt]; nal = ACS[gb + jl]; }
        }
        if (c >= 0) {
            const int cin = c < 4 ? (dir ? 3 - c : c) : 4 + (dir ? 67 - c : c - 4), gc = b * 68 + cin;
            int rbase, n0, len; chunk_geom(gc, rbase, n0, len);
            {
                f32x4 st[2] = {(f32x4){0.f, 0.f, 0.f, 0.f}, (f32x4){0.f, 0.f, 0.f, 0.f}};
                const LAS unsigned char* cbp = lds + SS_C + (16 * ti + fr) * 288 + fq * 16;
                const LAS unsigned char* bb0 = lds + SS_B + (16 * (2 * wh) + fr) * 288 + fq * 16;
#pragma unroll
                for (int kn = 0; kn < 4; ++kn) {
                    const bf16x8 cf = *(const LAS bf16x8*)(cbp + kn * 64);
                    const bf16x8 b0 = *(const LAS bf16x8*)(bb0 + kn * 64), b1 = *(const LAS bf16x8*)(bb0 + 16 * 288 + kn * 64);
                    st[0] = __builtin_amdgcn_mfma_f32_16x16x32_bf16(b0, cf, st[0], 0, 0, 0);
                    st[1] = __builtin_amdgcn_mfma_f32_16x16x32_bf16(b1, cf, st[1], 0, 0, 0);
                }
                const int t = 16 * ti + fr; const float at = cat;
#pragma unroll
                for (int j = 0; j < 2; ++j) { const int s0 = 16 * (2 * wh + j) + 4 * fq; const f32x4 av = j ? cs1 : cs0;
                    f32x4 o;
#pragma unroll
                    for (int r = 0; r < 4; ++r) { const bool keep = dir ? (s0 + r >= t) : (s0 + r <= t); o[r] = keep ? st[j][r] * __expf(at - av[r]) : 0.f; }
                    *(LAS u32x2*)(lds + SS_G + t * 160 + s0 * 2) = pack4(o); }
                { const int e = tid >> 4, s4 = (tid & 15) * 4; const u32x2 v = *(const LAS u32x2*)(lds + SS_XRT + e * 160 + s4 * 2);
                  const f32x4 dv = cdw; f32x4 w; w[0] = __expf(cal - csw[0]); w[1] = __expf(cal - csw[1]); w[2] = __expf(cal - csw[2]); w[3] = __expf(cal - csw[3]);
                  f32x4 o; o[0] = lo16(v.x) * dv[0]; o[1] = hi16(v.x) * dv[1]; o[2] = lo16(v.y) * dv[2]; o[3] = hi16(v.y) * dv[3];
                  *(LAS u32x2*)(lds + SS_XT + e * 160 + s4 * 2) = pack4(o);
                  *(LAS u32x2*)(lds + SS_XWT + e * 160 + s4 * 2) = pack4(o * w); }
            }
            __syncthreads();
            {
                f32x4 y1 = (f32x4){0.f, 0.f, 0.f, 0.f}, y2 = y1;
                const LAS unsigned char* gb = lds + SS_G + (16 * ti + fr) * 160 + fq * 16;
                const LAS unsigned char* xb = lds + SS_XT + (16 * wh + fr) * 160 + fq * 16;
#pragma unroll
                for (int ks = 0; ks < 2; ++ks) y1 = __builtin_amdgcn_mfma_f32_16x16x32_bf16(*(const LAS bf16x8*)(gb + ks * 64), *(const LAS bf16x8*)(xb + ks * 64), y1, 0, 0, 0);
                const LAS unsigned char* cbp = lds + SS_C + (16 * ti + fr) * 288 + fq * 16;
                const LAS unsigned char* sb = lds + SS_S + (16 * wh + fr) * 288 + fq * 16;
#pragma unroll
                for (int kn = 0; kn < 4; ++kn) y2 = __builtin_amdgcn_mfma_f32_16x16x32_bf16(*(const LAS bf16x8*)(cbp + kn * 64), *(const LAS bf16x8*)(sb + kn * 64), y2, 0, 0, 0);
                const int t0 = 16 * ti + 4 * fq;
                f32x4 eav; eav[0] = __expf(ct4[0]); eav[1] = __expf(ct4[1]); eav[2] = __expf(ct4[2]); eav[3] = __expf(ct4[3]);
                const u32x2 xs = *(const LAS u32x2*)(lds + SS_XRT + (16 * wh + fr) * 160 + t0 * 2);
                const float xv[4] = {lo16(xs.x), hi16(xs.x), lo16(xs.y), hi16(xs.y)};
                const bool wr_out = !(l == 1 && cin < 4);
#pragma unroll
                for (int r = 0; r < 4; ++r) {
                    float yv = y1[r] + eav[r] * y2[r];
                    if (dir == 0) yv += dskip * xv[r];
                    if (wr_out) OUT[(size_t)(rbase + n0 + t0 + r) * 1024 + hd * 64 + ps * 32 + 16 * wh + fr] = (bf16_t)f2bf(yv);
                }
                const float dec = __expf(cal);
                Sacc[0] = Sacc[0] * dec; Sacc[1] = Sacc[1] * dec;
                const LAS unsigned char* bt = lds + SS_BT + (16 * wid + fr) * 160 + fq * 16;
                const LAS unsigned char* xw = lds + SS_XWT + fr * 160 + fq * 16;
#pragma unroll
                for (int ks = 0; ks < 2; ++ks) { const bf16x8 bf = *(const LAS bf16x8*)(bt + ks * 64);
                    Sacc[0] = __builtin_amdgcn_mfma_f32_16x16x32_bf16(bf, *(const LAS bf16x8*)(xw + ks * 64), Sacc[0], 0, 0, 0);
                    Sacc[1] = __builtin_amdgcn_mfma_f32_16x16x32_bf16(bf, *(const LAS bf16x8*)(xw + 16 * 160 + ks * 64), Sacc[1], 0, 0, 0); }
            }
            __syncthreads();
            { const int ncol = (16 * wid + 4 * fq) * 2;
              *(LAS u32x2*)(lds + SS_S + fr * 288 + ncol) = pack4(Sacc[0]);
              *(LAS u32x2*)(lds + SS_S + (16 + fr) * 288 + ncol) = pack4(Sacc[1]); }
        }
        cs0 = ns0; cs1 = ns1; csw = nsw; cdw = ndw; ct4 = nt4; cat = nat; cal = nal;
        if (cn < 68) {
#pragma unroll
            for (int j = 0; j < 2; ++j) { const int q = tid + NTHR * j;
                *(LAS u32x4*)(lds + SS_C + (q >> 4) * 288 + (q & 15) * 16) = rc[j];
                *(LAS u32x4*)(lds + SS_B + (q >> 4) * 288 + (q & 15) * 16) = rb[j];
                *(LAS u32x4*)(lds + SS_BT + (q >> 3) * 160 + (q & 7) * 16) = rt[j]; }
            if (tid < 256) *(LAS u32x4*)(lds + SS_XRT + (tid >> 3) * 160 + (tid & 7) * 16) = rx;
        }
        __syncthreads();
    }
}

__device__ __forceinline__ void mlstm_finish_rows(const Params& p, int l, int row_lo, int gw, int ngw) {
    if (p.dup) return;
    const int lane = tid_fresh() & 63;
    const bf16_t* HF = (const bf16_t*)(p.ws + WS_HF2); const bf16_t* HB = (const bf16_t*)(p.ws + WS_HB2);
    bf16_t* BR = (bf16_t*)(p.ws + WS_BR);
    const float* ng = p.mnorm_g + l * 1024;
    int row = row_lo + gw;
    u32x2 ca[4], cb[4], co[4], na[4], nbv[4], no[4];
    if (row < MT) { const size_t so = (size_t)scanrow(row) * 1024;
#pragma unroll
        for (int hd = 0; hd < 4; ++hd) { const int c = hd * 256 + 4 * lane; ca[hd] = *(const u32x2*)(HF + so + c); cb[hd] = *(const u32x2*)(HB + so + c); co[hd] = *(const u32x2*)(BR + (size_t)row * 3072 + 1024 + c); } }
    for (; row < MT; row += ngw) {
        const int rn = row + ngw;
        if (rn < MT) { const size_t so = (size_t)scanrow(rn) * 1024;
#pragma unroll
            for (int hd = 0; hd < 4; ++hd) { const int c = hd * 256 + 4 * lane; na[hd] = *(const u32x2*)(HF + so + c); nbv[hd] = *(const u32x2*)(HB + so + c); no[hd] = *(const u32x2*)(BR + (size_t)rn * 3072 + 1024 + c); } }
#pragma unroll
        for (int hd = 0; hd < 4; ++hd) { const int c = hd * 256 + 4 * lane;
            const u32x2 a = ca[hd], b2 = cb[hd], o = co[hd];
            f32x4 h; h[0] = lo16(a.x) + lo16(b2.x); h[1] = hi16(a.x) + hi16(b2.x); h[2] = lo16(a.y) + lo16(b2.y); h[3] = hi16(a.y) + hi16(b2.y);
            const float ss = wave_sum((h[0] * h[0] + h[1] * h[1]) + (h[2] * h[2] + h[3] * h[3]));
            const float rs = __builtin_amdgcn_rsqf(ss * (1.f / 256.f) + EPS);
            const f32x4 g = *(const f32x4*)(ng + c);
            f32x4 r; r[0] = sigmoid_f(lo16(o.x)) * (h[0] * rs * g[0]); r[1] = sigmoid_f(hi16(o.x)) * (h[1] * rs * g[1]);
            r[2] = sigmoid_f(lo16(o.y)) * (h[2] * rs * g[2]); r[3] = sigmoid_f(hi16(o.y)) * (h[3] * rs * g[3]);
            u32x2 w; w.x = pk2(r[0], r[1]); w.y = pk2(r[2], r[3]);
            *(u32x2*)(BR + (size_t)row * 3072 + 1024 + c) = w; }
#pragma unroll
        for (int hd = 0; hd < 4; ++hd) { ca[hd] = na[hd]; cb[hd] = nbv[hd]; co[hd] = no[hd]; }
    }
}
__device__ __forceinline__ void ssd_finish_rows(const Params& p, int l, int row_lo, int gw, int ngw) {
    if (p.dup) return;
    const int lane = tid_fresh() & 63;
    const bf16_t* YF = (const bf16_t*)(p.ws + WS_YF); const bf16_t* YB = (const bf16_t*)(p.ws + WS_YB);
    bf16_t* BR = (bf16_t*)(p.ws + WS_BR);
    const float* ng = p.snorm_g + l * 1024;
    int row = row_lo + gw;
    u32x2 ca[4], cb[4], cz[4], na[4], nbv[4], nz[4];
    if (row < MT) {
#pragma unroll
        for (int j = 0; j < 4; ++j) { const int c = 4 * lane + 256 * j; ca[j] = *(const u32x2*)(YF + (size_t)row * 1024 + c); cb[j] = *(const u32x2*)(YB + (size_t)row * 1024 + c); cz[j] = *(const u32x2*)(BR + (size_t)row * 3072 + 2048 + c); } }
    for (; row < MT; row += ngw) {
        const int rn = row + ngw;
        if (rn < MT) {
#pragma unroll
            for (int j = 0; j < 4; ++j) { const int c = 4 * lane + 256 * j; na[j] = *(const u32x2*)(YF + (size_t)rn * 1024 + c); nbv[j] = *(const u32x2*)(YB + (size_t)rn * 1024 + c); nz[j] = *(const u32x2*)(BR + (size_t)rn * 3072 + 2048 + c); } }
        f32x4 v[4]; float ss = 0.f;
#pragma unroll
        for (int j = 0; j < 4; ++j) { const u32x2 a = ca[j], b2 = cb[j], z = cz[j];
            v[j][0] = (lo16(a.x) + lo16(b2.x)) * silu_f(lo16(z.x)); v[j][1] = (hi16(a.x) + hi16(b2.x)) * silu_f(hi16(z.x));
            v[j][2] = (lo16(a.y) + lo16(b2.y)) * silu_f(lo16(z.y)); v[j][3] = (hi16(a.y) + hi16(b2.y)) * silu_f(hi16(z.y));
            ss += (v[j][0] * v[j][0] + v[j][1] * v[j][1]) + (v[j][2] * v[j][2] + v[j][3] * v[j][3]); }
        const float rs = __builtin_amdgcn_rsqf(wave_sum(ss) * (1.f / 1024.f) + EPS);
#pragma unroll
        for (int j = 0; j < 4; ++j) { const int c = 4 * lane + 256 * j; const f32x4 g = *(const f32x4*)(ng + c);
            u32x2 w; w.x = pk2(v[j][0] * rs * g[0], v[j][1] * rs * g[1]); w.y = pk2(v[j][2] * rs * g[2], v[j][3] * rs * g[3]);
            *(u32x2*)(BR + (size_t)row * 3072 + 2048 + c) = w; }
#pragma unroll
        for (int j = 0; j < 4; ++j) { ca[j] = na[j]; cb[j] = nbv[j]; cz[j] = nz[j]; }
    }
}

__device__ __forceinline__ void phase_route(const Params& p, int l, unsigned char* ldsb, int bid, int nb) {
    float* lds = reinterpret_cast<float*>(ldsb);
    float* Wt = lds;
    int* hist = reinterpret_cast<int*>(lds + 36 * 1024);
    const int tid = tid_fresh(), lane = tid & 63, wave = tid >> 6;
    const int row_lo = l == 0 ? 0 : MC, rpb = l == 0 ? 68 : 64;
    const float* wrg = p.w_rg + (size_t)l * 1024 * 4; const float* wre = p.w_re + (size_t)l * 1024 * 32;
    for (int i = tid; i < 1024 * 4; i += NTHR) { const int k = i >> 2, g = i & 3; Wt[g * 1024 + (k ^ ((g & 7) << 2))] = wrg[i]; }
    for (int i = tid; i < 1024 * 32; i += NTHR) { const int k = i >> 5, e = i & 31; Wt[(4 + e) * 1024 + (k ^ (((4 + e) & 7) << 2))] = wre[i]; }
    const float* mod = (const float*)(p.ws + WS_MOD) + l * 5 * 6144;
    const float* XL = (const float*)(p.ws + WS_XL);
    int* EID = (int*)(p.ws + WS_EID); float* EWT = (float*)(p.ws + WS_EWT);
    for (int vb = bid; vb < 256; vb += nb) {
        if (tid < 32) hist[tid] = 0;
        __syncthreads();
        for (int rr = wave; rr < rpb; rr += 8) {
            const int row = row_lo + vb * rpb + rr;
            f32x4 v[4];
#pragma unroll
            for (int j = 0; j < 4; ++j) v[j] = *(const f32x4*)(XL + (size_t)row * 1024 + 4 * lane + 256 * j);
            const float* mr = mod + modrow(row) * 6144;
            norm_mod_row(v, p.g_ffn + l * 1024, mr + 3 * 1024, mr + 4 * 1024, lane);
            store_row_bf16((bf16_t*)(p.ws + WS_H) + (size_t)row * 1024, v, lane);
            float lg[36];
#pragma unroll
            for (int e = 0; e < 36; ++e) { float s = 0.f;
#pragma unroll
                for (int j = 0; j < 4; ++j) { const f32x4 w = *(const f32x4*)(Wt + e * 1024 + ((4 * lane + 256 * j) ^ ((e & 7) << 2))); s += (v[j][0] * w[0] + v[j][1] * w[1]) + (v[j][2] * w[2] + v[j][3] * w[3]); }
                lg[e] = wave_sum(s); }
            float gl[4]; int gi = 0; float gmax;
#pragma unroll
            for (int g = 0; g < 4; ++g) gl[g] = lg[g] + p.b_rg[l * 4 + g];
            gmax = gl[0];
#pragma unroll
            for (int g = 1; g < 4; ++g) if (gl[g] > gmax) { gmax = gl[g]; gi = g; }
            float den = 0.f;
#pragma unroll
            for (int g = 0; g < 4; ++g) den += __expf(gl[g] - gmax);
            const float pg = 1.f / den;
            float v1 = -3.0e38f, v2 = -3.0e38f; int i1 = 0, i2 = 0;
#pragma unroll
            for (int g = 0; g < 4; ++g) if (g == gi) {
#pragma unroll
                for (int j = 0; j < 8; ++j) { const float x = lg[4 + g * 8 + j] + p.b_re[l * 32 + g * 8 + j];
                    if (x > v1) { v2 = v1; i2 = i1; v1 = x; i1 = j; } else if (x > v2) { v2 = x; i2 = j; } } }
            const float e2 = __expf(v2 - v1), w1 = pg / (1.f + e2), w2 = pg * e2 / (1.f + e2);
            if (lane == 0) { EID[row * 2] = gi * 8 + i1; EID[row * 2 + 1] = gi * 8 + i2; EWT[row * 2] = w1; EWT[row * 2 + 1] = w2;
                atomicAdd(&hist[gi * 8 + i1], 1); atomicAdd(&hist[gi * 8 + i2], 1); }
        }
        __syncthreads();
        if (tid < 32) ((int*)(p.ws + WS_HIST))[vb * 32 + tid] = hist[tid];
        __syncthreads();
    }
    __syncthreads();
    float* scr = lds + wave * (64 * 65);
    convert_run(p, l, l + 1 < 2 ? l + 1 : -1, bid * 8 + wave, nb * 8, scr, lane);
}

__device__ __forceinline__ void phase_scatter(const Params& p, int l, unsigned char* ldsb, int bid, int nb) {
    int* li = reinterpret_cast<int*>(ldsb);
    int* tot = li; int* pre = li + 32; int* pst = li + 64; int* ea = li + 128; int* pos = li + 384;
    const int tid = tid_fresh(), lane = tid & 63, wave = tid >> 6;
    const int row_lo = l == 0 ? 0 : MC, rpb = l == 0 ? 68 : 64;
    const int* HIST = (const int*)(p.ws + WS_HIST); const int* EID = (const int*)(p.ws + WS_EID);
    int* SLOT = (int*)(p.ws + WS_SLOT);
    for (int vb = bid; vb < 256; vb += nb) {
        __syncthreads();
        if (tid < 32) { int t = 0, pr = 0; for (int j = 0; j < 256; ++j) { const int hv = HIST[j * 32 + tid]; t += hv; if (j < vb) pr += hv; } tot[tid] = t; pre[tid] = pr; }
        __syncthreads();
        if (tid == 0) { int s = 0; for (int e = 0; e < 32; ++e) { pst[e] = s; s += ((tot[e] + 255) >> 8) << 8; }
            if (vb == 0) { int* BE = (int*)(p.ws + WS_BLKEXP); int nblk = 0;
                for (int e = 0; e < 32; ++e) { const int nbk = (tot[e] + 255) >> 8; for (int j = 0; j < nbk; ++j) BE[nblk++] = e; }
                BE[200] = nblk; } }
        if (tid < rpb * 2) ea[tid] = EID[(row_lo + vb * rpb) * 2 + tid];
        __syncthreads();
        if (tid < rpb * 2) { const int e = ea[tid]; int rk = 0; for (int j = 0; j < tid; ++j) rk += (ea[j] == e) ? 1 : 0;
            const int ps = pst[e] + pre[e] + rk; SLOT[(row_lo + vb * rpb) * 2 + tid] = ps; ((int*)(p.ws + WS_TOK))[ps] = row_lo + vb * rpb + (tid >> 1); }
        if (vb == 0 && tid < 32) { int* TOK = (int*)(p.ws + WS_TOK); const int e0 = pst[tid] + tot[tid], e1 = pst[tid] + (((tot[tid] + 255) >> 8) << 8);
            for (int q = e0; q < e1; ++q) TOK[q] = row_lo; }
    }
    __syncthreads();
}

__device__ __forceinline__ void phase_combine(const Params& p, int l, int bid, int nb) {
    if (p.dup && l == 0) return;
    const int lane = tid_fresh() & 63, wave = tid_fresh() >> 6;
    const float* mod = (const float*)(p.ws + WS_MOD);
    const int* SLOT = (const int*)(p.ws + WS_SLOT); const float* EWT = (const float*)(p.ws + WS_EWT);
    const bf16_t* Y = (const bf16_t*)(p.ws + WS_Y);
    float* XL = (float*)(p.ws + WS_XL);
    const int row_lo = l == 0 ? 0 : MC, stride = nb * 8;
    for (int rowA = row_lo + bid * 8 + wave; rowA < MT; rowA += 2 * stride) {
        const int rowB = rowA + stride; const bool hasB = rowB < MT; const int rb = hasB ? rowB : rowA;
        const int sA0 = SLOT[rowA * 2], sA1 = SLOT[rowA * 2 + 1], sB0 = SLOT[rb * 2], sB1 = SLOT[rb * 2 + 1];
        const float wA0 = EWT[rowA * 2], wA1 = EWT[rowA * 2 + 1], wB0 = EWT[rb * 2], wB1 = EWT[rb * 2 + 1];
        u32x2 yA0[4], yA1[4], yB0[4], yB1[4]; f32x4 xA[4], xB[4];
#pragma unroll
        for (int j = 0; j < 4; ++j) { const int c = 4 * lane + 256 * j;
            yA0[j] = *(const u32x2*)(Y + (size_t)sA0 * 1024 + c); yA1[j] = *(const u32x2*)(Y + (size_t)sA1 * 1024 + c); xA[j] = *(const f32x4*)(XL + (size_t)rowA * 1024 + c);
            yB0[j] = *(const u32x2*)(Y + (size_t)sB0 * 1024 + c); yB1[j] = *(const u32x2*)(Y + (size_t)sB1 * 1024 + c); xB[j] = *(const f32x4*)(XL + (size_t)rb * 1024 + c); }
#pragma unroll
        for (int half = 0; half < 2; ++half) {
            if (half == 1 && !hasB) break;
            const int row = half ? rowB : rowA; const float w0 = half ? wB0 : wA0, w1 = half ? wB1 : wA1;
            const float* g5 = mod + (l * 5 + modrow(row)) * 6144 + 5 * 1024;
            f32x4 v[4];
#pragma unroll
            for (int j = 0; j < 4; ++j) { const int c = 4 * lane + 256 * j;
                const u32x2 a = half ? yB0[j] : yA0[j], b2 = half ? yB1[j] : yA1[j];
                f32x4 y; y[0] = w0 * lo16(a.x) + w1 * lo16(b2.x); y[1] = w0 * hi16(a.x) + w1 * hi16(b2.x); y[2] = w0 * lo16(a.y) + w1 * lo16(b2.y); y[3] = w0 * hi16(a.y) + w1 * hi16(b2.y);
                v[j] = (half ? xB[j] : xA[j]) + *(const f32x4*)(g5 + c) * y; }
            if (l == 0) {
#pragma unroll
                for (int j = 0; j < 4; ++j) *(f32x4*)(XL + (size_t)row * 1024 + 4 * lane + 256 * j) = v[j];
                const float* mr = mod + (5 + modrow(row)) * 6144;
                norm_mod_row(v, p.g_mix + 1024, mr, mr + 1024, lane);
                store_row_bf16((bf16_t*)(p.ws + WS_H) + (size_t)row * 1024, v, lane);
            } else {
                norm_mod_row(v, p.g_final, nullptr, nullptr, lane);
                float* o = p.out + (size_t)(row - MC) * 1024;
#pragma unroll
                for (int j = 0; j < 4; ++j) *(f32x4*)(o + 4 * lane + 256 * j) = v[j];
            }
        }
    }
}

constexpr int NPH_L = 14, NPHASES = 1 + 2 * NPH_L;
__device__ __forceinline__ void run_phase(const Params& p, int ph, unsigned char* lds) {
    const int bid = blockIdx.x, nb = gridDim.x;
    const int wave = tid_fresh() >> 6;
#ifndef ONLY_S
    if (ph == 0) { phase_pre(p, lds, bid, nb); return; }
#else
    if (ph == 0) { if (ONLY_S == 99) phase_pre(p, lds, bid, nb); return; }
#endif
    const int l = (ph - 1) / NPH_L, s = (ph - 1) % NPH_L;
    unsigned char* ws = p.ws;
    const int pm0 = l == 0 ? 0 : 4, nMrows = l == 0 ? 68 : 64, row_lo = l == 0 ? 0 : MC;
#ifdef ONLY_S
    if (s != ONLY_S) return;
#endif
    switch (s) {
    case 0: if (l == 0) phase_norm1(p, bid, nb); break;
    case 1: { SchedGrid S{(const bf16_t*)(ws + WS_H), (const bf16_t*)(ws + WS_WIN), 1024, 1024, 0, 68, 45, nb, bid}; EpiInproj E{ws};
              gemm_run(lds, S, E, 1024, 1024, 1024, 1); } break;
    case 2: { for (int it = bid; it < 1088; it += nb) conv_m_item(p, l, it, (LAS unsigned char*)lds);
              if (!p.dup) for (int it = bid; it < (l == 0 ? 272 : 256); it += nb) pool_window_item(p, it, (LAS unsigned char*)lds); } break;
    case 3: { for (int it = bid; it < 256; it += nb) mlstm_chunk_item(p, l, it, (LAS unsigned char*)lds);
              SchedPool S{(const bf16_t*)(ws + WS_BR), (const bf16_t*)(ws + WS_WPOOL), pm0, nMrows, nb, bid}; EpiPool E{(bf16_t*)(ws + WS_BR)};
              if (!p.dup) gemm_run(lds, S, E, 256, 3072, 256, 1); } break;
    case 4: { for (int it = bid; it < 1088; it += nb) conv_s_item(p, l, it, (LAS unsigned char*)lds);
              mlstm_finish_rows(p, l, row_lo, bid * 8 + wave, nb * 8); } break;
    case 5: for (int it = bid; it < 256; it += nb) ssd_chunk_item(p, l, it, (LAS unsigned char*)lds); break;
    case 6: ssd_finish_rows(p, l, row_lo, bid * 8 + wave, nb * 8); break;
    case 7: { SchedGrid S{(const bf16_t*)(ws + WS_BR), (const bf16_t*)(ws + WS_WBR), 3072, 3072, pm0, nMrows, 4, nb, bid}; EpiBranch E{(const bf16_t*)(ws + WS_MG), (bf16_t*)(ws + WS_MERGED)};
              gemm_run(lds, S, E, 3072, 3072, 3072, 3); } break;
    case 8: { SchedGrid S{(const bf16_t*)(ws + WS_MERGED), (const bf16_t*)(ws + WS_WOUT), 1024, 1024, pm0, nMrows, 4, nb, bid}; EpiOut E{(float*)(ws + WS_XL), (const float*)(ws + WS_MOD) + l * 5 * 6144, l == 0 ? p.x : nullptr, l == 0 ? p.ctx : nullptr, p.dup};
              gemm_run(lds, S, E, 1024, 1024, 1024, 1); } break;
    case 9: phase_route(p, l, lds, bid, nb); break;
    case 10: phase_scatter(p, l, lds, bid, nb); break;
    case 11: { const int* BE = (const int*)(ws + WS_BLKEXP);
              SchedMoe S{(const bf16_t*)(ws + WS_H), (const bf16_t*)(ws + WS_EW1), BE, (const int*)(ws + WS_TOK), 1024, BE[200], nb, bid, (size_t)1048576, (size_t)1024}; EpiMoe1 E{(bf16_t*)(ws + WS_ACT)};
              gemm_run<true>(lds, S, E, 1024, 1024, 1024, 1); } break;
    case 12: { const int* BE = (const int*)(ws + WS_BLKEXP);
              SchedMoe S{(const bf16_t*)(ws + WS_ACT), (const bf16_t*)(ws + WS_EW2), BE, nullptr, 512, BE[200], nb, bid, (size_t)524288, (size_t)512}; EpiMoe2 E{(bf16_t*)(ws + WS_Y)};
              gemm_run(lds, S, E, 512, 512, 512, 1); } break;
    case 13: phase_combine(p, l, bid, nb); break;
    }
}

#define XB_TMO      128
#define XB_XCNT(j)  (256  + 64 * (j))
#define XB_XSUB(j)  (1280 + 64 * (j))
#define XB_XGEN(j)  (2304 + 64 * (j))
#define XB_TOP      3328
#define XB_TOPGEN   3392
#define XCD_BAR_WORDS 3456
#define XB_SPIN_CAP (1u << 18)
__device__ __forceinline__ unsigned xb_ld(unsigned* p)              { return __hip_atomic_load(p, __ATOMIC_RELAXED, __HIP_MEMORY_SCOPE_AGENT); }
__device__ __forceinline__ unsigned xb_add(unsigned* p, unsigned v) { return __hip_atomic_fetch_add(p, v, __ATOMIC_RELAXED, __HIP_MEMORY_SCOPE_AGENT); }
__device__ __forceinline__ unsigned xb_xcc_id() { return (unsigned)__builtin_amdgcn_s_getreg((3 << 11) | 20) & 0xFu; }
#define XB_SPIN(cond, bar) do { unsigned _sp = 0; while (cond) { __builtin_amdgcn_s_sleep(1); \
    if ((++_sp & 255u) == 0u) { if (xb_ld(&(bar)[XB_TMO])) break; if (_sp > XB_SPIN_CAP) { atomicAdd(&(bar)[XB_TMO], 1u); break; } } } } while (0)
__device__ __forceinline__ void xcd_barrier_complete(unsigned* bar, unsigned x, unsigned& nloc, unsigned& nx) {
    const unsigned G = gridDim.x * gridDim.y * gridDim.z;
    unsigned sum, cnt, mine, sp = 0u;
    for (;;) {
        sum = 0u; cnt = 0u; mine = 0u;
#pragma unroll
        for (unsigned j = 0; j < 16; ++j) { const unsigned c = xb_ld(&bar[XB_XCNT(j)]); sum += c; cnt += (c > 0u) ? 1u : 0u; mine = (j == x) ? c : mine; }
        if (sum == G) break;
        __builtin_amdgcn_s_sleep(1);
        if ((++sp & 255u) == 0u) { if (xb_ld(&bar[XB_TMO])) break; if (sp > XB_SPIN_CAP) { atomicAdd(&bar[XB_TMO], 1u); break; } }
    }
    nloc = mine > 0u ? mine : 1u; nx = cnt > 0u ? cnt : 1u;
}
__device__ __forceinline__ void xcd_barrier(unsigned* bar, volatile LAS unsigned* st) {
    asm volatile("s_waitcnt vmcnt(0)" ::: "memory");
    __syncthreads();
    if (threadIdx.x == 0) {
        __builtin_amdgcn_s_waitcnt(0);
        const unsigned x = xb_xcc_id();
        unsigned nloc = st[0], nx = st[1];
        if (nloc == 0u) { xcd_barrier_complete(bar, x, nloc, nx); st[0] = nloc; st[1] = nx; }
        const unsigned old = xb_add(&bar[XB_XSUB(x)], 1u);
        const unsigned gen = old / nloc;
        if (old + 1u == (gen + 1u) * nloc) {
            __builtin_amdgcn_fence(__ATOMIC_RELEASE, "agent");
            asm volatile("s_waitcnt vmcnt(0)" ::: "memory");
            const unsigned og = xb_add(&bar[XB_TOP], 1u);
            const unsigned tg = og / nx;
            if (og + 1u == (tg + 1u) * nx) xb_add(&bar[XB_TOPGEN], 1u);
            else XB_SPIN(xb_ld(&bar[XB_TOPGEN]) == tg, bar);
            __builtin_amdgcn_fence(__ATOMIC_ACQUIRE, "agent");
            xb_add(&bar[XB_XGEN(x)], 1u);
            asm volatile("s_waitcnt vmcnt(0)" ::: "memory");
        } else {
            XB_SPIN(xb_ld(&bar[XB_XGEN(x)]) == gen, bar);
            __builtin_amdgcn_fence(__ATOMIC_ACQUIRE, "agent");
            asm volatile("s_waitcnt vmcnt(0)" ::: "memory");
        }
    }
    __syncthreads();
}

constexpr int BAR_LDS_OFF = LDS_BYTES - 16;
__global__ void __launch_bounds__(NTHR, 2) fwd_kernel(Params pk) {
    extern __shared__ __attribute__((aligned(16))) unsigned char lds[];
    const Params& p = pk;
    const int lo = pk.ph_lo, hi = pk.ph_hi;
    unsigned* bar = (unsigned*)(pk.ws + WS_BAR);
    volatile LAS unsigned* bst = (volatile LAS unsigned*)((LAS unsigned char*)lds + BAR_LDS_OFF);
    if (hi - lo > 1) {
        if (threadIdx.x == 0) { bst[0] = 0u; bst[1] = 0u; (void)xb_add(&bar[XB_XCNT(xb_xcc_id())], 1u); }
        __syncthreads();
    }
#define STEP(k) if (lo <= (k) && (k) < hi) { run_phase(p, (k), lds); if ((k) + 1 < hi) { if (pk.dup < 0) cg::this_grid().sync(); else xcd_barrier(bar, bst); } }
    STEP(0) STEP(1) STEP(2) STEP(3) STEP(4) STEP(5) STEP(6) STEP(7) STEP(8) STEP(9) STEP(10) STEP(11) STEP(12) STEP(13) STEP(14)
    STEP(16) STEP(17) STEP(18) STEP(19) STEP(20) STEP(21) STEP(22) STEP(23) STEP(24) STEP(25) STEP(26) STEP(27) STEP(28)
#undef STEP
}

extern "C" void kernel_launch(void* const* d_in, const int* in_sizes, int n_in, void* d_out, int out_size, void* d_ws, size_t ws_size, hipStream_t stream) {
    static int grid_blocks = 0;
    if (!grid_blocks) {
        if (n_in != 31 || ws_size < WS_END) { fprintf(stderr, "kernel_launch: unexpected n_in %d / ws_size %zu (need %zu)\n", n_in, ws_size, (size_t)WS_END); grid_blocks = -1; return; }
        int dev = 0, cus = 0, per_cu = 0;
        hipGetDevice(&dev);
        hipDeviceGetAttribute(&cus, hipDeviceAttributeMultiprocessorCount, dev);
        if (hipFuncSetAttribute((const void*)fwd_kernel, hipFuncAttributeMaxDynamicSharedMemorySize, LDS_BYTES) != hipSuccess) fprintf(stderr, "kernel_launch: hipFuncSetAttribute failed\n");
        hipOccupancyMaxActiveBlocksPerMultiprocessor(&per_cu, (const void*)fwd_kernel, NTHR, LDS_BYTES);
        if (per_cu < 1) { fprintf(stderr, "kernel_launch: occupancy query says %d blocks per CU\n", per_cu); per_cu = 1; }
        grid_blocks = cus * per_cu;
        (void)hipGetLastError();
    }
    if (grid_blocks < 0) return;
    Params p{};
    const float** dst = (const float**)&p;
    for (int i = 0; i < 31; ++i) dst[i] = (const float*)d_in[i];
    p.out = (float*)d_out; p.ws = (unsigned char*)d_ws;
#if SINGLE_LAUNCH
    if (hipMemsetAsync((char*)d_ws + WS_BAR, 0, 16384, stream) != hipSuccess) fprintf(stderr, "kernel_launch: hipMemsetAsync failed\n");
    p.ph_lo = 0; p.ph_hi = NPHASES;
    void* args[] = {&p};
    hipError_t e = hipLaunchCooperativeKernel((const void*)fwd_kernel, dim3(grid_blocks), dim3(NTHR), args, LDS_BYTES, stream);
    if (e != hipSuccess) fprintf(stderr, "cooperative launch failed: %s (grid %d)\n", hipGetErrorString(e), grid_blocks);
#else
    for (int ph = 0; ph < NPHASES; ++ph) {
        if (ph == 1 + NPH_L) continue;
        p.ph_lo = ph; p.ph_hi = ph + 1;
        hipLaunchKernelGGL(fwd_kernel, dim3(grid_blocks), dim3(NTHR), LDS_BYTES, stream, p);
        const int sidx = ph == 0 ? 14 : (ph - 1) % NPH_L;
        if ((PROBE_DUP_MASK >> sidx) & 1) { p.dup = 1; for (int r = 0; r < PROBE_DUP_N; ++r) hipLaunchKernelGGL(fwd_kernel, dim3(grid_blocks), dim3(NTHR), LDS_BYTES, stream, p); p.dup = 0; }
    }
#endif
}
```

```cpp
#include <hip/hip_runtime.h>
#include <hip/hip_cooperative_groups.h>
#include <cstdio>
namespace cg = cooperative_groups;

#ifndef SINGLE_LAUNCH
#define SINGLE_LAUNCH 1
#endif
#ifndef PROBE_DUP_MASK
#define PROBE_DUP_MASK 0
#endif
#ifndef PROBE_DUP_N
#define PROBE_DUP_N 1
#endif
#ifndef USE_MLSTM_CHUNK
#define USE_MLSTM_CHUNK 1
#endif
#ifndef USE_SSD_CHUNK
#define USE_SSD_CHUNK 1
#endif
#ifndef USE_MFMA_GEMM
#define USE_MFMA_GEMM 1
#endif

typedef unsigned short bf16_t;
typedef float f32x4 __attribute__((ext_vector_type(4)));
typedef unsigned u32x4 __attribute__((ext_vector_type(4)));
typedef unsigned u32x2 __attribute__((ext_vector_type(2)));

constexpr int NTHR = 512;
constexpr int D = 1024, NB = 4, SEQ = 4096, CTXL = 256;
constexpr int MC = NB * CTXL;
constexpr int ML = NB * SEQ;
constexpr int MT = MC + ML;
constexpr int DIN = 11312, NPAD = 11520;
constexpr int NE = 32, DE = 512;
constexpr int CAP = 43008;
constexpr float EPS = 1e-6f;
constexpr int LDS_BYTES = 163840;

constexpr size_t MiB = 1u << 20;
constexpr size_t WS_HIST = 0;
constexpr size_t WS_BLKEXP = 64 * 1024;
constexpr size_t WS_BAR = 128 * 1024;
constexpr size_t WS_TOK = 256 * 1024;
constexpr size_t WS_MOD = 1 * MiB;
constexpr size_t WS_GA = 2 * MiB;
constexpr size_t WS_DT = 4 * MiB;
constexpr size_t WS_EID = 7 * MiB;
constexpr size_t WS_EWT = 7 * MiB + 256 * 1024;
constexpr size_t WS_SLOT = 7 * MiB + 512 * 1024;
constexpr size_t WS_WIN = 8 * MiB;
constexpr size_t WS_WPOOL = 31 * MiB;
constexpr size_t WS_WBR = 32 * MiB;
constexpr size_t WS_WOUT = 38 * MiB;
constexpr size_t WS_XL = 40 * MiB;
constexpr size_t WS_H = 108 * MiB;
constexpr size_t WS_BR = 142 * MiB;
constexpr size_t WS_Q = 244 * MiB, WS_K = 278 * MiB, WS_V = 312 * MiB;
constexpr size_t WS_SX = 346 * MiB, WS_SB = 380 * MiB, WS_SC = 397 * MiB;
constexpr size_t WS_MG = 414 * MiB;
constexpr size_t WS_HF = 516 * MiB, WS_HB = 550 * MiB;
constexpr size_t WS_VT = 584 * MiB;
constexpr size_t WS_END = 618 * MiB;
constexpr size_t WS_MGA = WS_WIN, WS_MGC = WS_WIN + 576 * 1024, WS_MGP = WS_WIN + 1152 * 1024;
constexpr size_t WS_SACS = WS_WIN + 2 * MiB, WS_SDT = WS_WIN + 5 * MiB;
constexpr size_t WS_QC = WS_H, WS_KC = WS_HF, WS_KCT = WS_HB;
constexpr size_t WS_HF2 = WS_Q, WS_HB2 = WS_K;
constexpr size_t WS_XCT = WS_HF;
constexpr size_t WS_BC = WS_H, WS_CC = WS_H + 17 * MiB, WS_BCT = WS_HB;
constexpr size_t WS_YF = WS_SX, WS_YB = WS_SB;
constexpr size_t WS_MERGED = WS_Q;
constexpr size_t WS_EW1 = 244 * MiB;
constexpr size_t WS_EW2 = 308 * MiB;
constexpr size_t WS_XB = WS_BR;
constexpr size_t WS_ACT = WS_SX;
constexpr size_t WS_Y = WS_MG;

struct Params {
    const float *x, *c, *ctx, *c_ctx, *w_ada, *b_ada, *g_mix, *g_ffn, *w_in, *pool_w, *pool_scale,
        *mconv_w, *mconv_b, *mgate_b, *mnorm_g, *sconv_w, *sconv_b, *sdt_bias, *sa_log, *sd, *snorm_g,
        *w_branch, *w_out, *w_rg, *b_rg, *w_re, *b_re, *w_eg, *w_eu, *w_ed, *g_final;
    float* out; unsigned char* ws; int ph_lo, ph_hi, dup, pad;
};

__device__ __forceinline__ int tid_fresh() { int t = threadIdx.x; asm volatile("" : "+v"(t)); return t; }
__device__ __forceinline__ float bf2f(unsigned b) { return __uint_as_float(b << 16); }
__device__ __forceinline__ unsigned f2bf(float f) { unsigned u = __float_as_uint(f); return (u + 0x7fffu + ((u >> 16) & 1u)) >> 16; }
typedef __bf16 bf16x2_t __attribute__((ext_vector_type(2)));
typedef float f32x2_t __attribute__((ext_vector_type(2)));
__device__ __forceinline__ unsigned pk2(float lo, float hi) { const f32x2_t v = {lo, hi}; return __builtin_bit_cast(unsigned, __builtin_convertvector(v, bf16x2_t)); }
__device__ __forceinline__ float lo16(unsigned w) { return __uint_as_float(w << 16); }
__device__ __forceinline__ float hi16(unsigned w) { return __uint_as_float(w & 0xffff0000u); }
__device__ __forceinline__ float wave_sum(float v) {
#pragma unroll
    for (int o = 1; o < 64; o <<= 1) v += __shfl_xor(v, o);
    return v;
}
__device__ __forceinline__ float sigmoid_f(float x) { return __builtin_amdgcn_rcpf(1.f + __expf(-x)); }
__device__ __forceinline__ float silu_f(float x) { return x * __builtin_amdgcn_rcpf(1.f + __expf(-x)); }
__device__ __forceinline__ float softplus_f(float x) { return fmaxf(x, 0.f) + log1pf(__expf(-fabsf(x))); }
__device__ __forceinline__ float logsigmoid_f(float x) { return fminf(x, 0.f) - log1pf(__expf(-fabsf(x))); }
__device__ __forceinline__ void unpack8(u32x4 w, float* f) {
    f[0] = lo16(w.x); f[1] = hi16(w.x); f[2] = lo16(w.y); f[3] = hi16(w.y);
    f[4] = lo16(w.z); f[5] = hi16(w.z); f[6] = lo16(w.w); f[7] = hi16(w.w);
}
__device__ __forceinline__ u32x4 pack8(f32x4 a, f32x4 b) {
    u32x4 w; w.x = pk2(a[0], a[1]); w.y = pk2(a[2], a[3]); w.z = pk2(b[0], b[1]); w.w = pk2(b[2], b[3]); return w;
}
__device__ __forceinline__ int scanrow(int row) {
    if (row < MC) return row;
    const int r = row - MC, b = r >> 12, t = r & 4095;
    return MC + (b << 12) + ((t & 63) << 6) + (t >> 6);
}
__device__ __forceinline__ int modrow(int row) { return row < MC ? 4 : ((row - MC) >> 12); }

struct Unit { const bf16_t* A; const bf16_t* B; const int* tok; int pm, pn; };

__device__ __forceinline__ void tile_order(int L, int nM, int nN, int& pm, int& pn) {
    const int nwg = nM * nN; int wgid = L;
    { const int q = nwg / 8, r = nwg % 8, xcd = wgid % 8, off = wgid / 8; wgid = (xcd < r ? xcd * (q + 1) : r * (q + 1) + (xcd - r) * q) + off; }
    const int nig = 8 * nN, gid = wgid / nig, fm = gid * 8, gsz = (nM - fm) < 8 ? (nM - fm) : 8;
    pm = fm + ((wgid % nig) % gsz); pn = (wgid % nig) / gsz;
}
struct SchedGrid {
    const bf16_t* A; const bf16_t* B; int lda, ldb, pm0, nM, nN, G, c;
    __device__ __forceinline__ bool next(int i, Unit& u) const {
        const long L = (long)i * G + c; if (L >= (long)nM * nN) return false;
        int pm, pn; tile_order((int)L, nM, nN, pm, pn); pm += pm0;
        u.pm = pm; u.pn = pn; u.tok = nullptr; u.A = A + (size_t)pm * 256 * lda; u.B = B + (size_t)pn * 256 * ldb; return true;
    }
};
struct SchedInproj1 {
    const bf16_t* A; const bf16_t* B; int G, c;
    __device__ __forceinline__ bool next(int i, Unit& u) const {
        const long L = (long)i * G + c; if (L >= 2880 + 84) return false;
        int pm, pn;
        if (L < 2880) { tile_order((int)L, 64, 45, pm, pn); pm += 4; }
        else { const int idx = (int)L - 2880, k = idx % 21; pm = idx / 21; pn = k < 12 ? 4 + k : (k < 16 ? 20 + (k - 12) : (k < 20 ? 28 + (k - 16) : 44)); }
        u.pm = pm; u.pn = pn; u.tok = nullptr; u.A = A + (size_t)pm * 256 * 1024; u.B = B + (size_t)pn * 256 * 1024; return true;
    }
};
struct SchedPool {
    const bf16_t* A; const bf16_t* B; int pm0, nM, G, c;
    __device__ __forceinline__ bool next(int i, Unit& u) const {
        const long L = (long)i * G + c; if (L >= (long)nM * 4) return false;
        const int pm = pm0 + (int)(L >> 2), g = (int)(L & 3);
        u.pm = pm; u.pn = g; u.tok = nullptr; u.A = A + (size_t)pm * 256 * 3072 + g * 256; u.B = B + (size_t)g * 65536; return true;
    }
};
struct SchedMoe {
    const bf16_t* A; const bf16_t* B; const int* blkexp; const int* tok; int lda, nblk, G, c; size_t bexp_stride, ldb;
    __device__ __forceinline__ bool next(int i, Unit& u) const {
        const long L = (long)i * G + c; if (L >= (long)nblk * 4) return false;
        const int blk = (int)(L >> 2), nt = (int)(L & 3); const int e = blkexp[blk];
        u.pm = blk; u.pn = nt; u.tok = tok ? tok + blk * 256 : nullptr; u.A = tok ? A : A + (size_t)blk * 256 * lda;
        u.B = B + (size_t)e * bexp_stride + (size_t)nt * 256 * ldb; return true;
    }
};

struct EpiInproj {
    unsigned char* ws;
    __device__ __forceinline__ void seg(const Unit& u, int, int r, int c0, f32x4& lo0, f32x4& lo1, f32x4& hi0, f32x4& hi1) const {
        const int row = u.pm * 256 + r, t = u.pn;
        bf16_t* dst; size_t ld; int cb;
        if (t < 4) { dst = (bf16_t*)(ws + WS_BR) + (size_t)row * 3072; cb = t * 256; }
        else if (t < 16) { const int w = (t - 4) >> 2; dst = (bf16_t*)(ws + WS_Q + (size_t)w * 34 * MiB) + (size_t)scanrow(row) * 1024; cb = ((t - 4) & 3) * 256; }
        else if (t < 20) { dst = (bf16_t*)(ws + WS_BR) + (size_t)row * 3072 + 1024; cb = (t - 16) * 256; }
        else if (t < 24) { dst = (bf16_t*)(ws + WS_SX) + (size_t)row * 1024; cb = (t - 20) * 256; }
        else if (t < 28) { dst = (bf16_t*)(ws + WS_BR) + (size_t)row * 3072 + 2048; cb = (t - 24) * 256; }
        else if (t < 30) { dst = (bf16_t*)(ws + WS_SB) + (size_t)row * 512; cb = (t - 28) * 256; }
        else if (t < 32) { dst = (bf16_t*)(ws + WS_SC) + (size_t)row * 512; cb = (t - 30) * 256; }
        else if (t < 44) {
            dst = (bf16_t*)(ws + WS_MG) + (size_t)row * 3072; cb = (t - 32) * 256;
#pragma unroll
            for (int j = 0; j < 4; ++j) { lo0[j] = sigmoid_f(lo0[j]); lo1[j] = sigmoid_f(lo1[j]); hi0[j] = sigmoid_f(hi0[j]); hi1[j] = sigmoid_f(hi1[j]); }
        } else {
            if (c0 < 32) { float* d = (float*)(ws + WS_DT) + (size_t)row * 32 + c0; *(f32x4*)d = lo0; *(f32x4*)(d + 4) = lo1; }
            else if (c0 < 48) { float* d = (float*)(ws + WS_GA) + (size_t)scanrow(row) * 16 + (c0 - 32); *(f32x4*)d = lo0; *(f32x4*)(d + 4) = lo1; }
            return;
        }
        *(u32x4*)(dst + cb + c0) = pack8(lo0, lo1);
        *(u32x4*)(dst + cb + 128 + c0) = pack8(hi0, hi1);
    }
};
struct EpiPool {
    bf16_t* BR;
    __device__ __forceinline__ void seg(const Unit& u, int, int r, int c0, f32x4& lo0, f32x4& lo1, f32x4& hi0, f32x4& hi1) const {
        bf16_t* d = BR + (size_t)(u.pm * 256 + r) * 3072 + u.pn * 256 + c0;
        *(u32x4*)d = pack8(lo0, lo1);
        *(u32x4*)(d + 128) = pack8(hi0, hi1);
    }
};
struct EpiBranch {
    const bf16_t* MG; bf16_t* OUT;
    __device__ __forceinline__ void seg(const Unit& u, int sg, int r, int c0, f32x4& lo0, f32x4& lo1, f32x4& hi0, f32x4& hi1) const {
        const int row = u.pm * 256 + r, col = u.pn * 256 + c0;
        const bf16_t* g = MG + (size_t)row * 3072 + sg * 1024 + col;
        const int nx = sg < 2 ? 1024 : 0;
        const u32x4 ga = *(const u32x4*)g, gb = *(const u32x4*)(g + 128), gc = *(const u32x4*)(g + nx), gd = *(const u32x4*)(g + nx + 128);
        float a[8], b[8], a2[8], b2[8]; unpack8(ga, a); unpack8(gb, b); unpack8(gc, a2); unpack8(gd, b2);
        if (sg < 2) {
#pragma unroll
            for (int j = 0; j < 8; ++j) { a[j] = a[j] * __builtin_amdgcn_rcpf(a2[j]); b[j] = b[j] * __builtin_amdgcn_rcpf(b2[j]); } }
#pragma unroll
        for (int j = 0; j < 4; ++j) { lo0[j] *= a[j]; lo1[j] *= a[4 + j]; hi0[j] *= b[j]; hi1[j] *= b[4 + j]; }
        if (sg == 2) { bf16_t* d = OUT + (size_t)row * 1024 + col; *(u32x4*)d = pack8(lo0, lo1); *(u32x4*)(d + 128) = pack8(hi0, hi1); }
    }
};
struct EpiOut {
    float* XL; const float* mod; const float* x_in; const float* ctx_in; int dup;
    __device__ __forceinline__ void seg(const Unit& u, int, int r, int c0, f32x4& lo0, f32x4& lo1, f32x4& hi0, f32x4& hi1) const {
        const int row = u.pm * 256 + r, col = u.pn * 256 + c0;
        const float* g = mod + modrow(row) * 6144 + 2 * 1024 + col;
        float* x = XL + (size_t)row * 1024 + col;
        const float* rs = x_in ? (row < MC ? ctx_in + (size_t)row * 1024 + col : x_in + (size_t)(row - MC) * 1024 + col) : x;
        const f32x4 x0 = *(const f32x4*)rs, x1 = *(const f32x4*)(rs + 4), x2 = *(const f32x4*)(rs + 128), x3 = *(const f32x4*)(rs + 132);
        const f32x4 g0 = *(const f32x4*)g, g1 = *(const f32x4*)(g + 4), g2 = *(const f32x4*)(g + 128), g3 = *(const f32x4*)(g + 132);
        if (dup) return;
        *(f32x4*)x = x0 + g0 * lo0; *(f32x4*)(x + 4) = x1 + g1 * lo1; *(f32x4*)(x + 128) = x2 + g2 * hi0; *(f32x4*)(x + 132) = x3 + g3 * hi1;
    }
};
struct EpiMoe1 {
    bf16_t* ACT;
    __device__ __forceinline__ void seg(const Unit& u, int, int r, int c0, f32x4& lo0, f32x4& lo1, f32x4& hi0, f32x4& hi1) const {
        const int row = u.pm * 256 + r;
        f32x4 a, b;
#pragma unroll
        for (int j = 0; j < 4; ++j) { a[j] = silu_f(lo0[j]) * hi0[j]; b[j] = silu_f(lo1[j]) * hi1[j]; }
        *(u32x4*)(ACT + (size_t)row * 512 + u.pn * 128 + c0) = pack8(a, b);
    }
};
struct EpiMoe2 {
    bf16_t* Y;
    __device__ __forceinline__ void seg(const Unit& u, int, int r, int c0, f32x4& lo0, f32x4& lo1, f32x4& hi0, f32x4& hi1) const {
        bf16_t* d = Y + (size_t)(u.pm * 256 + r) * 1024 + u.pn * 256 + c0;
        *(u32x4*)d = pack8(lo0, lo1); *(u32x4*)(d + 128) = pack8(hi0, hi1);
    }
};

#define LAS __attribute__((address_space(3)))
typedef short bf16x8 __attribute__((ext_vector_type(8)));
constexpr int HTB = 128 * 64 * 2;
__device__ __forceinline__ int lds_byte(int r, int c) { const int st = (r >> 4) * 2 + (c >> 5), rr = r & 15, cc = c & 31, ob = rr * 64 + cc * 2; return st * 1024 + (ob ^ (((ob >> 9) & 1) << 5)); }
__device__ __forceinline__ void stage_rc(int b, int& R, int& C) { const int st = b / 1024, sb = b % 1024, swz = sb ^ (((sb >> 9) & 1) << 5); R = (st >> 1) * 16 + swz / 64; C = (st & 1) * 32 + (swz % 64) / 2; }
__device__ __forceinline__ int perm32(int rho) { const int n = rho >> 4, i = rho & 15; return 8 * (i >> 2) + 4 * n + (i & 3); }

template <bool GATHER, class Sched, class Epi>
__device__ __forceinline__ void gemm_mfma(LAS unsigned char* lds, const Sched& S, const Epi& E, const int K, const int lda, const int ldb, const int nseg) {
    const int tid = tid_fresh(), wid = __builtin_amdgcn_readfirstlane(tid >> 6), lane = tid & 63, wr = wid >> 2, wc = wid & 3, fr = lane & 15, fq = lane >> 4;
    const int nt = K / 64, tseg = nt / nseg;
    unsigned vA0[2], vA1[2], nA0[2], nA1[2], voffB[2]; int rowA[2], colA[2];
#pragma unroll
    for (int i = 0; i < 2; ++i) { int R, C; stage_rc(tid * 16 + i * 8192, R, C); const int Rb = (R & ~31) + perm32(R & 31);
        rowA[i] = R; colA[i] = C;
        vA0[i] = (unsigned)(R * lda + C) * 2u; vA1[i] = vA0[i] + (unsigned)(128 * lda * 2); nA0[i] = vA0[i]; nA1[i] = vA1[i];
        voffB[i] = (unsigned)(Rb * ldb + C) * 2u; }
    const size_t kstep = 128;
    const size_t hstepB = (size_t)128 * ldb * 2;
    const unsigned ldsw = (unsigned)wid * 1024u;
    const int aoff = lds_byte(wr * 64 + fr, fq * 8), boff = lds_byte(wc * 32 + fr, fq * 8);
#define PG8_SA(b, h) (((b) * 2 + (h)) * HTB)
#define PG8_SB(b, h) ((4 + (b) * 2 + (h)) * HTB)
#define PG8_STAGE(bufoff, gbase, voff) do { _Pragma("unroll") for (int _i = 0; _i < 2; ++_i) \
        __builtin_amdgcn_global_load_lds((const unsigned*)((const char*)(gbase) + (voff)[_i]), (LAS unsigned*)(lds + (bufoff) + ldsw + _i * 8192), 16, 0, 0); } while (0)
#define PG8_LDA(dst, b, h) do { _Pragma("unroll") for (int m = 0; m < 4; ++m) _Pragma("unroll") for (int k = 0; k < 2; ++k) dst[m][k] = *(const LAS bf16x8*)(lds + PG8_SA(b, h) + aoff + m * 2048 + k * 1024); } while (0)
#define PG8_LDB(dst, b, h) do { _Pragma("unroll") for (int n = 0; n < 2; ++n) _Pragma("unroll") for (int k = 0; k < 2; ++k) dst[n][k] = *(const LAS bf16x8*)(lds + PG8_SB(b, h) + boff + n * 2048 + k * 1024); } while (0)
#define PG8_MMA(ai, bj, At, Bt) do { __builtin_amdgcn_s_setprio(1); _Pragma("unroll") for (int m = 0; m < 4; ++m) _Pragma("unroll") for (int n = 0; n < 2; ++n) _Pragma("unroll") for (int k = 0; k < 2; ++k) \
        acc[ai][bj][m][n] = __builtin_amdgcn_mfma_f32_16x16x32_bf16(Bt[n][k], At[m][k], acc[ai][bj][m][n], 0, 0, 0); __builtin_amdgcn_s_setprio(0); } while (0)
#define PG8_WAIT_V(n) asm volatile("s_waitcnt vmcnt(" #n ")" ::: "memory")
#define PG8_WAIT_L(n) asm volatile("s_waitcnt lgkmcnt(" #n ")" ::: "memory")
#define PG8_BAR __builtin_amdgcn_s_barrier()
#define PG8_SCHED __builtin_amdgcn_sched_barrier(0)
#define PG8_EPI(sg) do { _Pragma("unroll") for (int ai = 0; ai < 2; ++ai) _Pragma("unroll") for (int m = 0; m < 4; ++m) { \
        int r_ = ai * 128 + wr * 64 + m * 16 + fr; asm volatile("" : "+v"(r_));     \
        E.seg(cur, (sg), r_, wc * 32 + fq * 8, acc[ai][0][m][0], acc[ai][0][m][1], acc[ai][1][m][0], acc[ai][1][m][1]); } } while (0)
    Unit cur, nxt; int ui = 0;
    if (!S.next(0, cur)) return;
    f32x4 acc[2][2][4][2];
#pragma unroll
    for (int a = 0; a < 2; ++a)
#pragma unroll
        for (int b = 0; b < 2; ++b)
#pragma unroll
            for (int m = 0; m < 4; ++m)
#pragma unroll
                for (int n = 0; n < 2; ++n) acc[a][b][m][n] = (f32x4){0.f, 0.f, 0.f, 0.f};
    bf16x8 At[4][2], B0[2][2], B1[2][2];
    const char* cA = (const char*)cur.A; const char* cB = (const char*)cur.B;
    if (GATHER) {
#pragma unroll
        for (int i = 0; i < 2; ++i) { vA0[i] = (unsigned)(cur.tok[rowA[i]] * lda + colA[i]) * 2u; vA1[i] = (unsigned)(cur.tok[128 + rowA[i]] * lda + colA[i]) * 2u; nA0[i] = vA0[i]; nA1[i] = vA1[i]; }
    }
    PG8_STAGE(PG8_SB(0, 0), cB, voffB); PG8_STAGE(PG8_SA(0, 0), cA, vA0); PG8_STAGE(PG8_SB(0, 1), cB + hstepB, voffB); PG8_STAGE(PG8_SA(0, 1), cA, vA1);
    if (wr == 1) PG8_BAR;
    PG8_WAIT_V(4); PG8_BAR;
    PG8_STAGE(PG8_SB(1, 0), cB + kstep, voffB); PG8_STAGE(PG8_SA(1, 0), cA + kstep, vA0); PG8_STAGE(PG8_SB(1, 1), cB + hstepB + kstep, voffB);
    PG8_WAIT_V(6); PG8_BAR;
    for (;;) {
        const bool has_next = S.next(ui + 1, nxt);
        const char* nA = has_next ? (const char*)nxt.A : cA; const char* nB = has_next ? (const char*)nxt.B : cB;
        if (GATHER) {
            const int* tk = has_next ? nxt.tok : cur.tok;
#pragma unroll
            for (int i = 0; i < 2; ++i) { nA0[i] = (unsigned)(tk[rowA[i]] * lda + colA[i]) * 2u; nA1[i] = (unsigned)(tk[128 + rowA[i]] * lda + colA[i]) * 2u; }
        }
#pragma nounroll
        for (int sg = 0; sg < nseg; ++sg) {
#pragma nounroll
        for (int tt = 0; tt < tseg; tt += 2) {
            const int t = sg * tseg + tt;
            const bool last = (t == nt - 2);
            const char* a1 = cA + (size_t)(t + 1) * kstep;
            const char* a2 = last ? nA : cA + (size_t)(t + 2) * kstep; const char* b2 = last ? nB : cB + (size_t)(t + 2) * kstep;
            const char* a3 = a2 + kstep; const char* b3 = b2 + kstep;
            unsigned w0[2], w1[2];
#pragma unroll
            for (int i = 0; i < 2; ++i) { w0[i] = last ? nA0[i] : vA0[i]; w1[i] = last ? nA1[i] : vA1[i]; }
            PG8_LDB(B0, 0, 0); PG8_SCHED; PG8_LDA(At, 0, 0); PG8_STAGE(PG8_SA(1, 1), a1, vA1);
            PG8_WAIT_L(8); PG8_BAR; PG8_WAIT_L(0); PG8_MMA(0, 0, At, B0); PG8_BAR; PG8_SCHED;
            PG8_LDB(B1, 0, 1); PG8_STAGE(PG8_SB(0, 0), b2, voffB);
            PG8_BAR; PG8_WAIT_L(0); PG8_MMA(0, 1, At, B1); PG8_BAR;
            PG8_LDA(At, 0, 1); PG8_STAGE(PG8_SA(0, 0), a2, w0);
            PG8_BAR; PG8_WAIT_L(0); PG8_MMA(1, 0, At, B0); PG8_BAR; PG8_SCHED;
            PG8_STAGE(PG8_SB(0, 1), b2 + hstepB, voffB);
            PG8_WAIT_V(6); PG8_BAR; PG8_MMA(1, 1, At, B1); PG8_BAR;
            PG8_LDB(B0, 1, 0); PG8_SCHED; PG8_LDA(At, 1, 0); PG8_STAGE(PG8_SA(0, 1), a2, w1);
            PG8_WAIT_L(8); PG8_BAR; PG8_WAIT_L(0); PG8_MMA(0, 0, At, B0); PG8_BAR; PG8_SCHED;
            PG8_LDB(B1, 1, 1); PG8_STAGE(PG8_SB(1, 0), b3, voffB);
            PG8_BAR; PG8_WAIT_L(0); PG8_MMA(0, 1, At, B1); PG8_BAR;
            PG8_LDA(At, 1, 1); PG8_STAGE(PG8_SA(1, 0), a3, w0);
            PG8_BAR; PG8_WAIT_L(0); PG8_MMA(1, 0, At, B0); PG8_BAR; PG8_SCHED;
            PG8_STAGE(PG8_SB(1, 1), b3 + hstepB, voffB);
            PG8_WAIT_V(6); PG8_BAR; PG8_MMA(1, 1, At, B1); PG8_BAR;
        }
        PG8_EPI(sg);
        }
        if (!has_next) break;
#pragma unroll
        for (int a = 0; a < 2; ++a)
#pragma unroll
            for (int b = 0; b < 2; ++b)
#pragma unroll
                for (int m = 0; m < 4; ++m)
#pragma unroll
                    for (int n = 0; n < 2; ++n) acc[a][b][m][n] = (f32x4){0.f, 0.f, 0.f, 0.f};
        cur = nxt; cA = nA; cB = nB; ++ui;
#pragma unroll
        for (int i = 0; i < 2; ++i) { vA0[i] = nA0[i]; vA1[i] = nA1[i]; }
    }
    PG8_WAIT_V(0);
    if (wr == 0) PG8_BAR;
    PG8_BAR;
#undef PG8_SA
#undef PG8_SB
#undef PG8_STAGE
#undef PG8_LDA
#undef PG8_LDB
#undef PG8_MMA
#undef PG8_WAIT_V
#undef PG8_WAIT_L
#undef PG8_BAR
#undef PG8_SCHED
#undef PG8_EPI
}

template <bool GATHER = false, class Sched, class Epi>
__device__ __forceinline__ void gemm_run(unsigned char* lds, const Sched& S, const Epi& E, int K, int lda, int ldb, int nseg) {
    __syncthreads();
    gemm_mfma<GATHER>((LAS unsigned char*)lds, S, E, K, lda, ldb, nseg);
    __syncthreads();
}

struct TrDesc { const float* src; const float* cscale; bf16_t* dst; int ld_src, ld_dst, valid; };
__device__ __forceinline__ void tr_load(const TrDesc& d, f32x4 (&v)[16]) {
    if (d.src) {
#pragma unroll
        for (int i = 0; i < 16; ++i) v[i] = *(const f32x4*)(d.src + (size_t)(4 * i) * d.ld_src);
    } else {
#pragma unroll
        for (int i = 0; i < 16; ++i) v[i] = (f32x4){0.f, 0.f, 0.f, 0.f};
    }
}
__device__ __forceinline__ void tr_store(const TrDesc& d, f32x4 (&v)[16], float* scr, int lane) {
    const int c4 = (lane & 15) * 4, kr = lane >> 4;
    if (d.cscale) { const f32x4 s = *(const f32x4*)d.cscale;
#pragma unroll
        for (int i = 0; i < 16; ++i) v[i] = v[i] * s; }
#pragma unroll
    for (int i = 0; i < 16; ++i) { float* q = scr + (kr + 4 * i) * 65 + c4; q[0] = v[i][0]; q[1] = v[i][1]; q[2] = v[i][2]; q[3] = v[i][3]; }
    asm volatile("s_waitcnt lgkmcnt(0)" ::: "memory");
    const int c = lane & 7;
#pragma unroll
    for (int j = 0; j < 8; ++j) { const int n = (lane >> 3) + 8 * j; const float* s = scr + (8 * c) * 65 + n;
        u32x4 o; o.x = pk2(s[0 * 65], s[1 * 65]); o.y = pk2(s[2 * 65], s[3 * 65]); o.z = pk2(s[4 * 65], s[5 * 65]); o.w = pk2(s[6 * 65], s[7 * 65]);
        *(u32x4*)(d.dst + (size_t)n * d.ld_dst + 8 * c) = o; }
    asm volatile("s_waitcnt lgkmcnt(0)" ::: "memory");
}
__device__ __forceinline__ TrDesc tr_desc(const float* W, int ld_src, int srcq, bf16_t* WT, int ld_dst, int n_dst, int kdst0, int k0, int lane, const float* cscale = nullptr) {
    TrDesc d; d.ld_src = ld_src; d.ld_dst = ld_dst; d.valid = 1;
    d.src = srcq >= 0 ? W + (size_t)(k0 + (lane >> 4)) * ld_src + srcq : nullptr;
    d.cscale = (cscale && srcq >= 0) ? cscale + srcq : nullptr;
    d.dst = WT + (size_t)n_dst * ld_dst + kdst0 + k0; return d;
}
constexpr int CV_MIX_ITEMS = 2880 + 64 + 768 + 256;
constexpr int CV_EXP_ITEMS = 32 * 384;
__device__ __forceinline__ TrDesc convert_desc(const Params& p, int le, int lm, int it, int lane) {
    unsigned char* ws = p.ws;
    const int c4 = (lane & 15) * 4;
    if (le >= 0) {
        if (it < CV_EXP_ITEMS) {
            const int e = it / 384, r = it % 384;
            if (r < 256) { const int up = r >> 7, q = r & 127, kb = q >> 3, nb = q & 7; const int c = nb * 64;
                const float* src = (up ? p.w_eu : p.w_eg) + (size_t)(le * 32 + e) * 1024 * 512;
                return tr_desc(src, 512, c + c4, (bf16_t*)(ws + WS_EW1) + (size_t)e * 1048576, 1024, (c >> 7) * 256 + up * 128 + (c & 127), 0, kb * 64, lane); }
            const int q = r - 256, kb = q >> 4, nb = q & 15;
            return tr_desc(p.w_ed + (size_t)(le * 32 + e) * 512 * 1024, 1024, nb * 64 + c4, (bf16_t*)(ws + WS_EW2) + (size_t)e * 524288, 512, nb * 64, 0, kb * 64, lane);
        }
        it -= CV_EXP_ITEMS;
    }
    const int l = lm;
    if (it < 2880) { const int R = it >> 4, kb = it & 15, dstn = R * 64; int srcq;
        if (R < 80) srcq = dstn + c4; else if (R < 128) srcq = dstn + 16 + c4; else if (R < 176) srcq = dstn + 48 + c4;
        else if (R == 176) srcq = c4 < 32 ? 8208 + c4 : (c4 < 48 ? 5120 + (c4 - 32) : -1); else srcq = -1;
        return tr_desc(p.w_in + (size_t)l * 1024 * DIN, DIN, srcq, (bf16_t*)(ws + WS_WIN), 1024, dstn, 0, kb * 64, lane); }
    it -= 2880;
    if (it < 64) { const int g = it >> 4, r = it & 15, kb = r >> 2, nb = r & 3;
        return tr_desc(p.pool_w + (size_t)(l * 4 + g) * 65536, 256, nb * 64 + c4, (bf16_t*)(ws + WS_WPOOL) + (size_t)g * 65536, 256, nb * 64, 0, kb * 64, lane, p.pool_scale + l * 1024 + g * 256); }
    it -= 64;
    if (it < 768) { const int br = it >> 8, r = it & 255, kb = r >> 4, nb = r & 15;
        return tr_desc(p.w_branch + (size_t)(l * 3 + br) * 1048576, 1024, nb * 64 + c4, (bf16_t*)(ws + WS_WBR), 3072, nb * 64, br * 1024, kb * 64, lane); }
    it -= 768;
    { const int kb = it >> 4, nb = it & 15;
      return tr_desc(p.w_out + (size_t)l * 1048576, 1024, nb * 64 + c4, (bf16_t*)(ws + WS_WOUT), 1024, nb * 64, 0, kb * 64, lane); }
}
__device__ __forceinline__ void convert_run(const Params& p, int le, int lm, int first, int step, float* scr, int lane) {
    const int nitems = (le >= 0 ? CV_EXP_ITEMS : 0) + (lm >= 0 ? CV_MIX_ITEMS : 0);
    if (first >= nitems) return;
    f32x4 va[16], vb[16];
    TrDesc da = convert_desc(p, le, lm, first, lane), db;
    tr_load(da, va);
    for (int it = first; it < nitems; it += 2 * step) {
        const int i1 = it + step, i2 = it + 2 * step;
        if (i1 < nitems) { db = convert_desc(p, le, lm, i1, lane); tr_load(db, vb); }
        tr_store(da, va, scr, lane);
        if (i1 >= nitems) break;
        if (i2 < nitems) { da = convert_desc(p, le, lm, i2, lane); tr_load(da, va); }
        tr_store(db, vb, scr, lane);
    }
}

__device__ __forceinline__ void phase_pre(const Params& p, unsigned char* ldsb, int bid, int nb) {
    float* lds = reinterpret_cast<float*>(ldsb);
    const int tid = tid_fresh(), lane = tid & 63, wave = tid >> 6;
    for (int i = tid; i < 5 * 1024; i += NTHR) { const float v = i < 4096 ? p.c[i] : p.c_ctx[i - 4096]; lds[i] = silu_f(v); }
    __syncthreads();
    float* red = lds + 5120;
    for (int it = bid; it < 2 * 96; it += nb) {
        const int l = it / 96, j = (it % 96) * 64 + lane;
        const float* w = p.w_ada + (size_t)l * 1024 * 6144 + j;
        float a0 = 0, a1 = 0, a2 = 0, a3 = 0, a4 = 0;
#pragma unroll 16
        for (int k = wave * 128; k < wave * 128 + 128; ++k) { const float wv = w[(size_t)k * 6144];
            a0 += lds[k] * wv; a1 += lds[1024 + k] * wv; a2 += lds[2048 + k] * wv; a3 += lds[3072 + k] * wv; a4 += lds[4096 + k] * wv; }
        red[(wave * 5 + 0) * 64 + lane] = a0; red[(wave * 5 + 1) * 64 + lane] = a1; red[(wave * 5 + 2) * 64 + lane] = a2;
        red[(wave * 5 + 3) * 64 + lane] = a3; red[(wave * 5 + 4) * 64 + lane] = a4;
        __syncthreads();
        if (tid < 320) { const int r = tid >> 6, jj = tid & 63; float s = 0;
            for (int w8 = 0; w8 < 8; ++w8) s += red[(w8 * 5 + r) * 64 + jj];
            const int col = (it % 96) * 64 + jj;
            ((float*)(p.ws + WS_MOD))[(size_t)(l * 5 + r) * 6144 + col] = s + p.b_ada[l * 6144 + col]; }
        __syncthreads();
    }
    __syncthreads();
    float* scr = lds + wave * (64 * 65);
    convert_run(p, -1, 0, bid * 8 + wave, nb * 8, scr, lane);
}

__device__ __forceinline__ void norm_mod_row(f32x4 (&v)[4], const float* g, const float* shift, const float* scale, int lane) {
    float s = 0.f;
#pragma unroll
    for (int j = 0; j < 4; ++j) s += (v[j][0] * v[j][0] + v[j][1] * v[j][1]) + (v[j][2] * v[j][2] + v[j][3] * v[j][3]);
    const float rs = __builtin_amdgcn_rsqf(wave_sum(s) * (1.f / 1024.f) + EPS);
#pragma unroll
    for (int j = 0; j < 4; ++j) { const int c = 4 * lane + 256 * j; const f32x4 gg = *(const f32x4*)(g + c);
        f32x4 y = v[j] * rs * gg;
        if (shift) { const f32x4 sh = *(const f32x4*)(shift + c), sc = *(const f32x4*)(scale + c); y = y * (1.f + sc) + sh; }
        v[j] = y; }
}
__device__ __forceinline__ void store_row_bf16(bf16_t* dst, const f32x4 (&v)[4], int lane) {
#pragma unroll
    for (int j = 0; j < 4; ++j) { u32x2 w; w.x = pk2(v[j][0], v[j][1]); w.y = pk2(v[j][2], v[j][3]); *(u32x2*)(dst + 4 * lane + 256 * j) = w; }
}

__device__ __forceinline__ void phase_norm1(const Params& p, int bid, int nb) {
    const int lane = tid_fresh() & 63, wave = tid_fresh() >> 6;
    const float* mod = (const float*)(p.ws + WS_MOD);
    const int stride = nb * 8;
    int m = bid * 8 + wave;
    f32x4 v[4], w[4];
    if (m < MT) { const float* src = m < MC ? p.ctx + (size_t)m * 1024 : p.x + (size_t)(m - MC) * 1024;
#pragma unroll
        for (int j = 0; j < 4; ++j) v[j] = *(const f32x4*)(src + 4 * lane + 256 * j); }
    for (; m < MT; m += stride) {
        const int mn = m + stride;
        if (mn < MT) { const float* src = mn < MC ? p.ctx + (size_t)mn * 1024 : p.x + (size_t)(mn - MC) * 1024;
#pragma unroll
            for (int j = 0; j < 4; ++j) w[j] = *(const f32x4*)(src + 4 * lane + 256 * j); }
        const float* mr = mod + modrow(m) * 6144;
        norm_mod_row(v, p.g_mix, mr, mr + 1024, lane);
        store_row_bf16((bf16_t*)(p.ws + WS_H) + (size_t)m * 1024, v, lane);
#pragma unroll
        for (int j = 0; j < 4; ++j) v[j] = w[j];
    }
}

__device__ __forceinline__ float wave_incl_sum(float v, int lane) {
#pragma unroll
    for (int o = 1; o < 64; o <<= 1) { const float u = __shfl_up(v, o); if (lane >= o) v += u; }
    return v;
}
__device__ __forceinline__ float wave_incl_max(float v, int lane) {
#pragma unroll
    for (int o = 1; o < 64; o <<= 1) { const float u = __shfl_up(v, o); if (lane >= o) v = fmaxf(v, u); }
    return v;
}
__device__ __forceinline__ u32x2 pack4(f32x4 a) { u32x2 w; w.x = pk2(a[0], a[1]); w.y = pk2(a[2], a[3]); return w; }

__device__ __forceinline__ void chunk_geom(int gc, int& rbase, int& n0, int& len) {
    const int b = gc / 68, cin = gc % 68;
    if (cin < 4) { rbase = b * 256; n0 = cin * 64; len = 256; } else { rbase = MC + b * 4096; n0 = (cin - 4) * 64; len = 4096; }
}
__device__ __forceinline__ void conv8x4(const u32x4 (&raw)[7], const float* cw, const float* cb, int ch0, float scale, u32x4 (&out)[4]) {
    float w[4][8], bs[8];
#pragma unroll
    for (int j = 0; j < 4; ++j) { const f32x4 a = *(const f32x4*)(cw + j * 2048 + ch0), b2 = *(const f32x4*)(cw + j * 2048 + ch0 + 4);
#pragma unroll
        for (int i = 0; i < 4; ++i) { w[j][i] = a[i]; w[j][4 + i] = b2[i]; } }
    { const f32x4 a = *(const f32x4*)(cb + ch0), b2 = *(const f32x4*)(cb + ch0 + 4);
#pragma unroll
      for (int i = 0; i < 4; ++i) { bs[i] = a[i]; bs[4 + i] = b2[i]; } }
    float f[7][8];
#pragma unroll
    for (int k = 0; k < 7; ++k) unpack8(raw[k], f[k]);
#pragma unroll
    for (int pp = 0; pp < 4; ++pp) { f32x4 o0, o1;
#pragma unroll
        for (int i = 0; i < 8; ++i) { float a = bs[i];
#pragma unroll
            for (int j = 0; j < 4; ++j) a += w[j][i] * f[pp + j][i];
            a = silu_f(a) * scale; if (i < 4) o0[i] = a; else o1[i - 4] = a; }
        out[pp] = pack8(o0, o1); }
}
__device__ __forceinline__ void load_raw7(const bf16_t* src, size_t ld, int rbase, int tbase, int len, u32x4 (&raw)[7]) {
#pragma unroll
    for (int k = 0; k < 7; ++k) { const int t = tbase + k; const bool ok = (t >= 0) && (t < len); const int tc = t < 0 ? 0 : (t >= len ? len - 1 : t);
        u32x4 a = *(const u32x4*)(src + (size_t)(rbase + tc) * ld);
        if (!ok) a = (u32x4){0u, 0u, 0u, 0u};
        raw[k] = a; }
}
template <class F>
__device__ __forceinline__ void tile_transpose_out(const LAS bf16_t* tile, int ldsw, int ncol, int tid, F rowptr) {
    for (int q = tid; q < ncol * 8; q += NTHR) { const int c = q % ncol, sc = q / ncol;
        unsigned v[8];
#pragma unroll
        for (int i = 0; i < 8; ++i) v[i] = tile[(sc * 8 + i) * ldsw + c];
        u32x4 w; w.x = v[0] | (v[1] << 16); w.y = v[2] | (v[3] << 16); w.z = v[4] | (v[5] << 16); w.w = v[6] | (v[7] << 16);
        *(u32x4*)(rowptr(c) + sc * 8) = w; }
}

__device__ __forceinline__ void conv_m_item(const Params& p, int l, int item, LAS unsigned char* lds) {
    const int tid = tid_fresh(), gc = item >> 2, hd = item & 3;
    int rbase, n0, len; chunk_geom(gc, rbase, n0, len);
    const int cs = tid & 31, tg = tid >> 5, d0 = cs * 8, i0 = tg * 4;
    const float* cw = p.mconv_w + (size_t)l * 4 * 2048; const float* cb = p.mconv_b + (size_t)l * 2048;
    LAS bf16_t* Kl = (LAS bf16_t*)lds; LAS bf16_t* Vl = (LAS bf16_t*)(lds + 64 * 528);
    __syncthreads();
    { u32x4 raw[7], o[4];
      load_raw7((const bf16_t*)(p.ws + WS_Q) + hd * 256 + d0, 1024, rbase, n0 + i0 - 2, len, raw);
      conv8x4(raw, cw, cb, hd * 256 + d0, 1.0f, o);
#pragma unroll
      for (int pp = 0; pp < 4; ++pp) *(u32x4*)((bf16_t*)(p.ws + WS_QC) + (size_t)(rbase + n0 + i0 + pp) * 1024 + hd * 256 + d0) = o[pp];
      load_raw7((const bf16_t*)(p.ws + WS_K) + hd * 256 + d0, 1024, rbase, n0 + i0 - 2, len, raw);
      conv8x4(raw, cw, cb, 1024 + hd * 256 + d0, 0.0625f, o);
#pragma unroll
      for (int pp = 0; pp < 4; ++pp) { *(u32x4*)((bf16_t*)(p.ws + WS_KC) + (size_t)(rbase + n0 + i0 + pp) * 1024 + hd * 256 + d0) = o[pp];
          *(LAS u32x4*)((LAS unsigned char*)Kl + (i0 + pp) * 528 + d0 * 2) = o[pp]; } }
#pragma unroll
    for (int j = 0; j < 4; ++j) { const int q = tid + NTHR * j, row = q >> 5, ch = q & 31;
        *(LAS u32x4*)((LAS unsigned char*)Vl + row * 528 + ch * 16) = *(const u32x4*)((const bf16_t*)(p.ws + WS_V) + (size_t)(rbase + n0 + row) * 1024 + hd * 256 + ch * 8); }
    __syncthreads();
    if ((tid >> 6) < 2) {
        const int dir = tid >> 6, lane = tid & 63, j = dir ? 63 - lane : lane;
        const float* g = (const float*)(p.ws + WS_GA) + (size_t)(rbase + n0 + j) * 16;
        const float ig = g[dir * 4 + hd] + p.mgate_b[l * 16 + dir * 4 + hd], lf = logsigmoid_f(g[(2 + dir) * 4 + hd] + p.mgate_b[l * 16 + (2 + dir) * 4 + hd]);
        const float cum = wave_incl_sum(lf, lane), a = ig - cum, pm = wave_incl_max(a, lane);
        const size_t o = (size_t)(gc * 8 + dir * 4 + hd) * 64 + j;
        ((float*)(p.ws + WS_MGA))[o] = a; ((float*)(p.ws + WS_MGC))[o] = cum; ((float*)(p.ws + WS_MGP))[o] = pm;
    }
    bf16_t* kct = (bf16_t*)(p.ws + WS_KCT) + (size_t)(gc * 4 + hd) * 16384; bf16_t* vt = (bf16_t*)(p.ws + WS_VT) + (size_t)(gc * 4 + hd) * 16384;
    tile_transpose_out(Kl, 264, 256, tid, [&](int c) { return kct + c * 64; });
    tile_transpose_out(Vl, 264, 256, tid, [&](int c) { return vt + c * 64; });
}

__device__ __forceinline__ void conv_s_item(const Params& p, int l, int item, LAS unsigned char* lds) {
    const int tid = tid_fresh(), gc = item >> 2, grp = item & 3;
    int rbase, n0, len; chunk_geom(gc, rbase, n0, len);
    const int cs = tid & 31, tg = tid >> 5, i0 = tg * 4;
    const float* cw = p.sconv_w + (size_t)l * 4 * 2048; const float* cb = p.sconv_b + (size_t)l * 2048;
    LAS bf16_t* Bl = (LAS bf16_t*)lds; LAS bf16_t* Xl = (LAS bf16_t*)(lds + 64 * 272);
    __syncthreads();
    { u32x4 raw[7], o[4];
      const int isC = cs >> 4, nn = (cs & 15) * 8;
      load_raw7((const bf16_t*)(p.ws + (isC ? WS_SC : WS_SB)) + grp * 128 + nn, 512, rbase, n0 + i0 - 2, len, raw);
      conv8x4(raw, cw, cb, 1024 + isC * 512 + grp * 128 + nn, 1.0f, o);
      bf16_t* dst = (bf16_t*)(p.ws + (isC ? WS_CC : WS_BC)) + grp * 128 + nn;
#pragma unroll
      for (int pp = 0; pp < 4; ++pp) { *(u32x4*)(dst + (size_t)(rbase + n0 + i0 + pp) * 512) = o[pp];
          if (!isC) *(LAS u32x4*)((LAS unsigned char*)Bl + (i0 + pp) * 272 + nn * 2) = o[pp]; }
      load_raw7((const bf16_t*)(p.ws + WS_SX) + grp * 256 + cs * 8, 1024, rbase, n0 + i0 - 2, len, raw);
      conv8x4(raw, cw, cb, grp * 256 + cs * 8, 1.0f, o);
#pragma unroll
      for (int pp = 0; pp < 4; ++pp) *(LAS u32x4*)((LAS unsigned char*)Xl + (i0 + pp) * 528 + cs * 16) = o[pp]; }
    __syncthreads();
    { const int wv = tid >> 6, lane = tid & 63, dir = wv >> 2, hd = grp * 4 + (wv & 3), j = dir ? 63 - lane : lane;
      const float dtv = softplus_f(((const float*)(p.ws + WS_DT))[(size_t)(rbase + n0 + j) * 32 + dir * 16 + hd] + p.sdt_bias[l * 32 + dir * 16 + hd]);
      const float acs = wave_incl_sum(dtv * -__expf(p.sa_log[l * 32 + dir * 16 + hd]), lane);
      const size_t o = (size_t)(gc * 32 + dir * 16 + hd) * 64 + j;
      ((float*)(p.ws + WS_SACS))[o] = acs; ((float*)(p.ws + WS_SDT))[o] = dtv; }
    bf16_t* bct = (bf16_t*)(p.ws + WS_BCT) + (size_t)(gc * 4 + grp) * 8192; bf16_t* xct = (bf16_t*)(p.ws + WS_XCT) + (size_t)(gc * 16 + grp * 4) * 4096;
    tile_transpose_out(Bl, 136, 128, tid, [&](int c) { return bct + c * 64; });
    tile_transpose_out(Xl, 264, 256, tid, [&](int c) { return xct + c * 64; });
}

__device__ __forceinline__ void pool_window_item(const Params& p, int it, LAS unsigned char* lds) {
    const int tid = tid_fresh();
    bf16_t* BR = (bf16_t*)(p.ws + WS_BR);
    __syncthreads();
    if (it < 256) {
        const int row0 = MC + it * 64;
        for (int q = tid; q < 64 * 128; q += NTHR) { const int r = q >> 7, ch = q & 127;
            *(LAS u32x4*)(lds + q * 16) = *(const u32x4*)(BR + (size_t)(row0 + r) * 3072 + ch * 8); }
        __syncthreads();
        for (int q = tid; q < 64 * 128; q += NTHR) { const int r = q >> 7, ch = q & 127, w = 2 << (ch >> 5);
            int lo = r - (w >> 1), hi = lo + w - 1; lo = lo < 0 ? 0 : lo; hi = hi > 63 ? 63 : hi;
            float s[8] = {0, 0, 0, 0, 0, 0, 0, 0}, self[8];
            for (int rr = lo; rr <= hi; ++rr) { float f[8]; unpack8(*(const LAS u32x4*)(lds + (rr * 128 + ch) * 16), f);
#pragma unroll
                for (int j = 0; j < 8; ++j) s[j] += f[j]; }
            unpack8(*(const LAS u32x4*)(lds + q * 16), self);
            const float inv = __builtin_amdgcn_rcpf((float)(hi - lo + 1)); f32x4 a, b;
#pragma unroll
            for (int j = 0; j < 4; ++j) { a[j] = s[j] * inv - self[j]; b[j] = s[4 + j] * inv - self[4 + j]; }
            *(u32x4*)(BR + (size_t)(row0 + r) * 3072 + ch * 8) = pack8(a, b); }
    } else {
        const int bb = (it - 256) >> 2, g = (it - 256) & 3, row0 = bb * 256, w = 2 << g;
        for (int q = tid; q < 256 * 32; q += NTHR) { const int r = q >> 5, ch = q & 31;
            *(LAS u32x4*)(lds + q * 16) = *(const u32x4*)(BR + (size_t)(row0 + r) * 3072 + g * 256 + ch * 8); }
        __syncthreads();
        for (int q = tid; q < 256 * 32; q += NTHR) { const int r = q >> 5, ch = q & 31;
            int lo = r - (w >> 1), hi = lo + w - 1; lo = lo < 0 ? 0 : lo; hi = hi > 255 ? 255 : hi;
            float s[8] = {0, 0, 0, 0, 0, 0, 0, 0}, self[8];
            for (int rr = lo; rr <= hi; ++rr) { float f[8]; unpack8(*(const LAS u32x4*)(lds + (rr * 32 + ch) * 16), f);
#pragma unroll
                for (int j = 0; j < 8; ++j) s[j] += f[j]; }
            unpack8(*(const LAS u32x4*)(lds + q * 16), self);
            const float inv = __builtin_amdgcn_rcpf((float)(hi - lo + 1)); f32x4 a, b;
#pragma unroll
            for (int j = 0; j < 4; ++j) { a[j] = s[j] * inv - self[j]; b[j] = s[4 + j] * inv - self[4 + j]; }
            *(u32x4*)(BR + (size_t)(row0 + r) * 3072 + g * 256 + ch * 8) = pack8(a, b); }
    }
    __syncthreads();
}

constexpr int ML_VT = 0, ML_VWT = 5280, ML_CT = 10560, ML_Q = 28512, ML_K = 63328, ML_KT = 98144, ML_A = 139104, ML_MISC = 149344;
__device__ __forceinline__ void mlstm_chunk_item(const Params& p, int l, int item, LAS unsigned char* lds) {
    const int tid = tid_fresh(), lane = tid & 63, wid = __builtin_amdgcn_readfirstlane(tid >> 6), fr = lane & 15, fq = lane >> 4;
    const int b = item >> 6, hd = (item >> 4) & 3, dir = (item >> 3) & 1, eg = item & 7;
    const bf16_t* QC = (const bf16_t*)(p.ws + WS_QC); const bf16_t* KC = (const bf16_t*)(p.ws + WS_KC);
    const bf16_t* KCT = (const bf16_t*)(p.ws + WS_KCT); const bf16_t* VT = (const bf16_t*)(p.ws + WS_VT);
    const float* GAa = (const float*)(p.ws + WS_MGA); const float* GCc = (const float*)(p.ws + WS_MGC); const float* GPp = (const float*)(p.ws + WS_MGP);
    bf16_t* OUT = (bf16_t*)(p.ws + (dir ? WS_HB2 : WS_HF2));
    const int ti = wid >> 1, wh = wid & 1;
    __syncthreads();
    for (int i = tid; i < 17952 / 4; i += NTHR) ((LAS unsigned*)(lds + ML_CT))[i] = 0u;
    if (tid < 64) ((LAS bf16_t*)(lds + ML_VT + 32 * 160))[tid] = (bf16_t)0x3F80;
    f32x4 Cacc[2][3];
#pragma unroll
    for (int j = 0; j < 2; ++j)
#pragma unroll
        for (int e = 0; e < 3; ++e) Cacc[j][e] = (f32x4){0.f, 0.f, 0.f, 0.f};
    float m_st = 0.f;
    f32x4 ca0 = (f32x4){0.f, 0.f, 0.f, 0.f}, ca1 = ca0, caw = ca0, cP4 = ca0, cC4 = ca0; float cPt = 0.f, cPl = 0.f, cCl = 0.f;
    const int gs0 = 16 * (2 * wh) + 4 * fq, gs4 = (tid & 15) * 4, gt = 16 * ti + fr, gt0 = 16 * ti + 4 * fq, jl = dir ? 0 : 63;
    __syncthreads();
    for (int c = -1; c < 68; ++c) {
        const int cn = c + 1;
        u32x4 rq[4], rk[4], rt[4], rv = (u32x4){0u, 0u, 0u, 0u};
        f32x4 na0 = (f32x4){0.f, 0.f, 0.f, 0.f}, na1 = na0, naw = na0, nP4 = na0, nC4 = na0; float nPt = 0.f, nPl = 0.f, nCl = 0.f;
#pragma unroll
        for (int j = 0; j < 4; ++j) { rq[j] = (u32x4){0u, 0u, 0u, 0u}; rk[j] = rq[j]; rt[j] = rq[j]; }
        if (cn < 68) {
            const int cin = cn < 4 ? (dir ? 3 - cn : cn) : 4 + (dir ? 67 - cn : cn - 4), gc = b * 68 + cin;
            int rbase, n0, len; chunk_geom(gc, rbase, n0, len);
#pragma unroll
            for (int j = 0; j < 4; ++j) { const int q = tid + NTHR * j;
                const size_t ro = (size_t)(rbase + n0 + (q >> 5)) * 1024 + hd * 256 + (q & 31) * 8;
                rq[j] = *(const u32x4*)(QC + ro); rk[j] = *(const u32x4*)(KC + ro);
                rt[j] = *(const u32x4*)(KCT + (size_t)(gc * 4 + hd) * 16384 + (size_t)q * 8); }
            if (tid < 256) rv = *(const u32x4*)(VT + ((size_t)(gc * 4 + hd) * 256 + eg * 32) * 64 + (size_t)tid * 8);
            { const size_t gb = (size_t)(gc * 8 + dir * 4 + hd) * 64;
              na0 = *(const f32x4*)(GAa + gb + gs0); na1 = *(const f32x4*)(GAa + gb + gs0 + 16); naw = *(const f32x4*)(GAa + gb + gs4);
              nP4 = *(const f32x4*)(GPp + gb + gt0); nC4 = *(const f32x4*)(GCc + gb + gt0); nPt = GPp[gb + gt]; nPl = GPp[gb + jl]; nCl = GCc[gb + jl]; }
        }
        if (c >= 0) {
            const int cin = c < 4 ? (dir ? 3 - c : c) : 4 + (dir ? 67 - c : c - 4), gc = b * 68 + cin;
            int rbase, n0, len; chunk_geom(gc, rbase, n0, len);
            {
                f32x4 st[2] = {(f32x4){0.f, 0.f, 0.f, 0.f}, (f32x4){0.f, 0.f, 0.f, 0.f}};
                const LAS unsigned char* qb = lds + ML_Q + (16 * ti + fr) * 544 + fq * 16;
                const LAS unsigned char* kb0 = lds + ML_K + (16 * (2 * wh) + fr) * 544 + fq * 16;
#pragma unroll
                for (int kd = 0; kd < 8; ++kd) {
                    const bf16x8 qf = *(const LAS bf16x8*)(qb + kd * 64);
                    const bf16x8 k0 = *(const LAS bf16x8*)(kb0 + kd * 64), k1 = *(const LAS bf16x8*)(kb0 + 16 * 544 + kd * 64);
                    st[0] = __builtin_amdgcn_mfma_f32_16x16x32_bf16(k0, qf, st[0], 0, 0, 0);
                    st[1] = __builtin_amdgcn_mfma_f32_16x16x32_bf16(k1, qf, st[1], 0, 0, 0);
                }
                const int t = 16 * ti + fr; const float Mt = fmaxf(m_st, cPt), M63 = fmaxf(m_st, cPl);
#pragma unroll
                for (int j = 0; j < 2; ++j) { const int s0 = 16 * (2 * wh + j) + 4 * fq; const f32x4 av = j ? ca1 : ca0;
                    f32x4 o;
#pragma unroll
                    for (int r = 0; r < 4; ++r) { const bool keep = dir ? (s0 + r >= t) : (s0 + r <= t); o[r] = keep ? st[j][r] * __expf(av[r] - Mt) : 0.f; }
                    *(LAS u32x2*)(lds + ML_A + t * 160 + s0 * 2) = pack4(o); }
                { const int e = tid >> 4, s4 = (tid & 15) * 4; const u32x2 v = *(const LAS u32x2*)(lds + ML_VT + e * 160 + s4 * 2);
                  f32x4 w; w[0] = __expf(caw[0] - M63); w[1] = __expf(caw[1] - M63); w[2] = __expf(caw[2] - M63); w[3] = __expf(caw[3] - M63);
                  f32x4 o; o[0] = lo16(v.x) * w[0]; o[1] = hi16(v.x) * w[1]; o[2] = lo16(v.y) * w[2]; o[3] = hi16(v.y) * w[3];
                  *(LAS u32x2*)(lds + ML_VWT + e * 160 + s4 * 2) = pack4(o);
                  if (tid < 16) *(LAS u32x2*)(lds + ML_VWT + 32 * 160 + s4 * 2) = pack4(w); }
            }
            __syncthreads();
            {
                f32x4 n1o = (f32x4){0.f, 0.f, 0.f, 0.f}, n1a = n1o, n2o = n1o, n2a = n1o;
                const LAS unsigned char* ab = lds + ML_A + (16 * ti + fr) * 160 + fq * 16;
                const LAS unsigned char* vo = lds + ML_VT + (16 * wh + fr) * 160 + fq * 16;
                const LAS unsigned char* va = lds + ML_VT + (32 + fr) * 160 + fq * 16;
#pragma unroll
                for (int ks = 0; ks < 2; ++ks) { const bf16x8 af = *(const LAS bf16x8*)(ab + ks * 64);
                    n1o = __builtin_amdgcn_mfma_f32_16x16x32_bf16(af, *(const LAS bf16x8*)(vo + ks * 64), n1o, 0, 0, 0);
                    n1a = __builtin_amdgcn_mfma_f32_16x16x32_bf16(af, *(const LAS bf16x8*)(va + ks * 64), n1a, 0, 0, 0); }
                const LAS unsigned char* qb = lds + ML_Q + (16 * ti + fr) * 544 + fq * 16;
                const LAS unsigned char* co = lds + ML_CT + (16 * wh + fr) * 544 + fq * 16;
                const LAS unsigned char* ca = lds + ML_CT + (32 + fr) * 544 + fq * 16;
#pragma unroll
                for (int kd = 0; kd < 8; ++kd) { const bf16x8 qf = *(const LAS bf16x8*)(qb + kd * 64);
                    n2o = __builtin_amdgcn_mfma_f32_16x16x32_bf16(qf, *(const LAS bf16x8*)(co + kd * 64), n2o, 0, 0, 0);
                    n2a = __builtin_amdgcn_mfma_f32_16x16x32_bf16(qf, *(const LAS bf16x8*)(ca + kd * 64), n2a, 0, 0, 0); }
                const int t0 = 16 * ti + 4 * fq;
                f32x4 sgv, emv;
#pragma unroll
                for (int r = 0; r < 4; ++r) { const float Mr = fmaxf(m_st, cP4[r]); sgv[r] = __expf(m_st - Mr); emv[r] = __expf(-(cC4[r] + Mr)); }
                const bool wr_out = !(l == 1 && cin < 4);
#pragma unroll
                for (int r = 0; r < 4; ++r) {
                    const float den = __shfl(n1a[r] + sgv[r] * n2a[r], lane & 48);
                    const float hv = (n1o[r] + sgv[r] * n2o[r]) * __builtin_amdgcn_rcpf(fmaxf(fabsf(den), emv[r]));
                    if (wr_out) OUT[(size_t)(rbase + n0 + t0 + r) * 1024 + hd * 256 + eg * 32 + 16 * wh + fr] = (bf16_t)f2bf(hv);
                }
                const float decay = __expf(m_st - fmaxf(m_st, cPl));
#pragma unroll
                for (int j = 0; j < 2; ++j)
#pragma unroll
                    for (int e = 0; e < 3; ++e) Cacc[j][e] = Cacc[j][e] * decay;
                const LAS unsigned char* kt = lds + ML_KT + (16 * (2 * wid) + fr) * 160 + fq * 16;
                const LAS unsigned char* vw = lds + ML_VWT + fr * 160 + fq * 16;
#pragma unroll
                for (int ks = 0; ks < 2; ++ks) {
                    const bf16x8 k0 = *(const LAS bf16x8*)(kt + ks * 64), k1 = *(const LAS bf16x8*)(kt + 16 * 160 + ks * 64);
                    const bf16x8 v0 = *(const LAS bf16x8*)(vw + ks * 64), v1 = *(const LAS bf16x8*)(vw + 16 * 160 + ks * 64), v2 = *(const LAS bf16x8*)(vw + 32 * 160 + ks * 64);
                    Cacc[0][0] = __builtin_amdgcn_mfma_f32_16x16x32_bf16(k0, v0, Cacc[0][0], 0, 0, 0);
                    Cacc[0][1] = __builtin_amdgcn_mfma_f32_16x16x32_bf16(k0, v1, Cacc[0][1], 0, 0, 0);
                    Cacc[0][2] = __builtin_amdgcn_mfma_f32_16x16x32_bf16(k0, v2, Cacc[0][2], 0, 0, 0);
                    Cacc[1][0] = __builtin_amdgcn_mfma_f32_16x16x32_bf16(k1, v0, Cacc[1][0], 0, 0, 0);
                    Cacc[1][1] = __builtin_amdgcn_mfma_f32_16x16x32_bf16(k1, v1, Cacc[1][1], 0, 0, 0);
                    Cacc[1][2] = __builtin_amdgcn_mfma_f32_16x16x32_bf16(k1, v2, Cacc[1][2], 0, 0, 0);
                }
            }
            __syncthreads();
#pragma unroll
            for (int j = 0; j < 2; ++j) { const int dcol = (16 * (2 * wid + j) + 4 * fq) * 2;
                *(LAS u32x2*)(lds + ML_CT + fr * 544 + dcol) = pack4(Cacc[j][0]);
                *(LAS u32x2*)(lds + ML_CT + (16 + fr) * 544 + dcol) = pack4(Cacc[j][1]);
                if (fr == 0) *(LAS u32x2*)(lds + ML_CT + 32 * 544 + dcol) = pack4(Cacc[j][2]); }
        }
        if (c >= 0) m_st = cCl + fmaxf(m_st, cPl);
        ca0 = na0; ca1 = na1; caw = naw; cP4 = nP4; cC4 = nC4; cPt = nPt; cPl = nPl; cCl = nCl;
        if (cn < 68) {
#pragma unroll
            for (int j = 0; j < 4; ++j) { const int q = tid + NTHR * j;
                *(LAS u32x4*)(lds + ML_Q + (q >> 5) * 544 + (q & 31) * 16) = rq[j];
                *(LAS u32x4*)(lds + ML_K + (q >> 5) * 544 + (q & 31) * 16) = rk[j];
                *(LAS u32x4*)(lds + ML_KT + (q >> 3) * 160 + (q & 7) * 16) = rt[j]; }
            if (tid < 256) *(LAS u32x4*)(lds + ML_VT + (tid >> 3) * 160 + (tid & 7) * 16) = rv;
        }
        __syncthreads();
    }
}

constexpr int SS_C = 0, SS_B = 18432, SS_BT = 36864, SS_XT = 57344, SS_XWT = 62464, SS_G = 67584, SS_S = 77824, SS_XRT = 87040, SS_MISC = 92160;
__device__ __forceinline__ void ssd_chunk_item(const Params& p, int l, int item, LAS unsigned char* lds) {
    const int tid = tid_fresh(), lane = tid & 63, wid = __builtin_amdgcn_readfirstlane(tid >> 6), fr = lane & 15, fq = lane >> 4;
    const int b = item >> 6, hd = (item >> 2) & 15, dir = (item >> 1) & 1, ps = item & 1, grp = hd >> 2;
    const bf16_t* BC = (const bf16_t*)(p.ws + WS_BC); const bf16_t* CC = (const bf16_t*)(p.ws + WS_CC);
    const bf16_t* BCT = (const bf16_t*)(p.ws + WS_BCT); const bf16_t* XCT = (const bf16_t*)(p.ws + WS_XCT);
    const float* ACS = (const float*)(p.ws + WS_SACS); const float* SDT = (const float*)(p.ws + WS_SDT);
    bf16_t* OUT = (bf16_t*)(p.ws + (dir ? WS_YB : WS_YF));
    const float dskip = p.sd[l * 16 + hd];
    const int ti = wid >> 1, wh = wid & 1;
    __syncthreads();
    for (int i = tid; i < 9216 / 4; i += NTHR) ((LAS unsigned*)(lds + SS_S))[i] = 0u;
    f32x4 Sacc[2] = {(f32x4){0.f, 0.f, 0.f, 0.f}, (f32x4){0.f, 0.f, 0.f, 0.f}};
    f32x4 cs0 = (f32x4){0.f, 0.f, 0.f, 0.f}, cs1 = cs0, csw = cs0, cdw = cs0, ct4 = cs0; float cat = 0.f, cal = 0.f;
    const int gs0 = 16 * (2 * wh) + 4 * fq, gs4 = (tid & 15) * 4, gt = 16 * ti + fr, gt0 = 16 * ti + 4 * fq, jl = dir ? 0 : 63;
    __syncthreads();
    for (int c = -1; c < 68; ++c) {
        const int cn = c + 1;
        u32x4 rc[2], rb[2], rt[2], rx = (u32x4){0u, 0u, 0u, 0u};
        f32x4 ns0 = (f32x4){0.f, 0.f, 0.f, 0.f}, ns1 = ns0, nsw = ns0, ndw = ns0, nt4 = ns0; float nat = 0.f, nal = 0.f;
#pragma unroll
        for (int j = 0; j < 2; ++j) { rc[j] = (u32x4){0u, 0u, 0u, 0u}; rb[j] = rc[j]; rt[j] = rc[j]; }
        if (cn < 68) {
            const int cin = cn < 4 ? (dir ? 3 - cn : cn) : 4 + (dir ? 67 - cn : cn - 4), gc = b * 68 + cin;
            int rbase, n0, len; chunk_geom(gc, rbase, n0, len);
#pragma unroll
            for (int j = 0; j < 2; ++j) { const int q = tid + NTHR * j;
                const size_t ro = (size_t)(rbase + n0 + (q >> 4)) * 512 + grp * 128 + (q & 15) * 8;
                rc[j] = *(const u32x4*)(CC + ro); rb[j] = *(const u32x4*)(BC + ro);
                rt[j] = *(const u32x4*)(BCT + (size_t)(gc * 4 + grp) * 8192 + (size_t)q * 8); }
            if (tid < 256) rx = *(const u32x4*)(XCT + ((size_t)(gc * 16 + hd) * 64 + ps * 32) * 64 + (size_t)tid * 8);
            { const size_t gb = (size_t)(gc * 32 + dir * 16 + hd) * 64;
              ns0 = *(const f32x4*)(ACS + gb + gs0); ns1 = *(const f32x4*)(ACS + gb + gs0 + 16); nsw = *(const f32x4*)(ACS + gb + gs4); ndw = *(const f32x4*)(SDT + gb + gs4);
              nt4 = *(const f32x4*)(ACS + gb + gt0); nat = ACS[gb + gt]; nal = ACS[gb + jl]; }
        }
        if (c >= 0) {
            const int cin = c < 4 ? (dir ? 3 - c : c) : 4 + (dir ? 67 - c : c - 4), gc = b * 68 + cin;
            int rbase, n0, len; chunk_geom(gc, rbase, n0, len);
            {
                f32x4 st[2] = {(f32x4){0.f, 0.f, 0.f, 0.f}, (f32x4){0.f, 0.f, 0.f, 0.f}};
                const LAS unsigned char* cbp = lds + SS_C + (16 * ti + fr) * 288 + fq * 16;
                const LAS unsigned char* bb0 = lds + SS_B + (16 * (2 * wh) + fr) * 288 + fq * 16;
#pragma unroll
                for (int kn = 0; kn < 4; ++kn) {
                    const bf16x8 cf = *(const LAS bf16x8*)(cbp + kn * 64);
                    const bf16x8 b0 = *(const LAS bf16x8*)(bb0 + kn * 64), b1 = *(const LAS bf16x8*)(bb0 + 16 * 288 + kn * 64);
                    st[0] = __builtin_amdgcn_mfma_f32_16x16x32_bf16(b0, cf, st[0], 0, 0, 0);
                    st[1] = __builtin_amdgcn_mfma_f32_16x16x32_bf16(b1, cf, st[1], 0, 0, 0);
                }
                const int t = 16 * ti + fr; const float at = cat;
#pragma unroll
                for (int j = 0; j < 2; ++j) { const int s0 = 16 * (2 * wh + j) + 4 * fq; const f32x4 av = j ? cs1 : cs0;
                    f32x4 o;
#pragma unroll
                    for (int r = 0; r < 4; ++r) { const bool keep = dir ? (s0 + r >= t) : (s0 + r <= t); o[r] = keep ? st[j][r] * __expf(at - av[r]) : 0.f; }
                    *(LAS u32x2*)(lds + SS_G + t * 160 + s0 * 2) = pack4(o); }
                { const int e = tid >> 4, s4 = (tid & 15) * 4; const u32x2 v = *(const LAS u32x2*)(lds + SS_XRT + e * 160 + s4 * 2);
                  const f32x4 dv = cdw; f32x4 w; w[0] = __expf(cal - csw[0]); w[1] = __expf(cal - csw[1]); w[2] = __expf(cal - csw[2]); w[3] = __expf(cal - csw[3]);
                  f32x4 o; o[0] = lo16(v.x) * dv[0]; o[1] = hi16(v.x) * dv[1]; o[2] = lo16(v.y) * dv[2]; o[3] = hi16(v.y) * dv[3];
                  *(LAS u32x2*)(lds + SS_XT + e * 160 + s4 * 2) = pack4(o);
                  *(LAS u32x2*)(lds + SS_XWT + e * 160 + s4 * 2) = pack4(o * w); }
            }
            __syncthreads();
            {
                f32x4 y1 = (f32x4){0.f, 0.f, 0.f, 0.f}, y2 = y1;
                const LAS unsigned char* gb = lds + SS_G + (16 * ti + fr) * 160 + fq * 16;
                const LAS unsigned char* xb = lds + SS_XT + (16 * wh + fr) * 160 + fq * 16;
#pragma unroll
                for (int ks = 0; ks < 2; ++ks) y1 = __builtin_amdgcn_mfma_f32_16x16x32_bf16(*(const LAS bf16x8*)(gb + ks * 64), *(const LAS bf16x8*)(xb + ks * 64), y1, 0, 0, 0);
                const LAS unsigned char* cbp = lds + SS_C + (16 * ti + fr) * 288 + fq * 16;
                const LAS unsigned char* sb = lds + SS_S + (16 * wh + fr) * 288 + fq * 16;
#pragma unroll
                for (int kn = 0; kn < 4; ++kn) y2 = __builtin_amdgcn_mfma_f32_16x16x32_bf16(*(const LAS bf16x8*)(cbp + kn * 64), *(const LAS bf16x8*)(sb + kn * 64), y2, 0, 0, 0);
                const int t0 = 16 * ti + 4 * fq;
                f32x4 eav; eav[0] = __expf(ct4[0]); eav[1] = __expf(ct4[1]); eav[2] = __expf(ct4[2]); eav[3] = __expf(ct4[3]);
                const u32x2 xs = *(const LAS u32x2*)(lds + SS_XRT + (16 * wh + fr) * 160 + t0 * 2);
                const float xv[4] = {lo16(xs.x), hi16(xs.x), lo16(xs.y), hi16(xs.y)};
                const bool wr_out = !(l == 1 && cin < 4);
#pragma unroll
                for (int r = 0; r < 4; ++r) {
                    float yv = y1[r] + eav[r] * y2[r];
                    if (dir == 0) yv += dskip * xv[r];
                    if (wr_out) OUT[(size_t)(rbase + n0 + t0 + r) * 1024 + hd * 64 + ps * 32 + 16 * wh + fr] = (bf16_t)f2bf(yv);
                }
                const float dec = __expf(cal);
                Sacc[0] = Sacc[0] * dec; Sacc[1] = Sacc[1] * dec;
                const LAS unsigned char* bt = lds + SS_BT + (16 * wid + fr) * 160 + fq * 16;
                const LAS unsigned char* xw = lds + SS_XWT + fr * 160 + fq * 16;
#pragma unroll
                for (int ks = 0; ks < 2; ++ks) { const bf16x8 bf = *(const LAS bf16x8*)(bt + ks * 64);
                    Sacc[0] = __builtin_amdgcn_mfma_f32_16x16x32_bf16(bf, *(const LAS bf16x8*)(xw + ks * 64), Sacc[0], 0, 0, 0);
                    Sacc[1] = __builtin_amdgcn_mfma_f32_16x16x32_bf16(bf, *(const LAS bf16x8*)(xw + 16 * 160 + ks * 64), Sacc[1], 0, 0, 0); }
            }
            __syncthreads();
            { const int ncol = (16 * wid + 4 * fq) * 2;
              *(LAS u32x2*)(lds + SS_S + fr * 288 + ncol) = pack4(Sacc[0]);
              *(LAS u32x2*)(lds + SS_S + (16 + fr) * 288 + ncol) = pack4(Sacc[1]); }
        }
        cs0 = ns0; cs1 = ns1; csw = nsw; cdw = ndw; ct4 = nt4; cat = nat; cal = nal;
        if (cn < 68) {
#pragma unroll
            for (int j = 0; j < 2; ++j) { const int q = tid + NTHR * j;
                *(LAS u32x4*)(lds + SS_C + (q >> 4) * 288 + (q & 15) * 16) = rc[j];
                *(LAS u32x4*)(lds + SS_B + (q >> 4) * 288 + (q & 15) * 16) = rb[j];
                *(LAS u32x4*)(lds + SS_BT + (q >> 3) * 160 + (q & 7) * 16) = rt[j]; }
            if (tid < 256) *(LAS u32x4*)(lds + SS_XRT + (tid >> 3) * 160 + (tid & 7) * 16) = rx;
        }
        __syncthreads();
    }
}

__device__ __forceinline__ void mlstm_finish_rows(const Params& p, int l, int row_lo, int gw, int ngw) {
    if (p.dup) return;
    const int lane = tid_fresh() & 63;
    const bf16_t* HF = (const bf16_t*)(p.ws + WS_HF2); const bf16_t* HB = (const bf16_t*)(p.ws + WS_HB2);
    bf16_t* BR = (bf16_t*)(p.ws + WS_BR);
    const float* ng = p.mnorm_g + l * 1024;
    int row = row_lo + gw;
    u32x2 ca[4], cb[4], co[4], na[4], nbv[4], no[4];
    if (row < MT) { const size_t so = (size_t)scanrow(row) * 1024;
#pragma unroll
        for (int hd = 0; hd < 4; ++hd) { const int c = hd * 256 + 4 * lane; ca[hd] = *(const u32x2*)(HF + so + c); cb[hd] = *(const u32x2*)(HB + so + c); co[hd] = *(const u32x2*)(BR + (size_t)row * 3072 + 1024 + c); } }
    for (; row < MT; row += ngw) {
        const int rn = row + ngw;
        if (rn < MT) { const size_t so = (size_t)scanrow(rn) * 1024;
#pragma unroll
            for (int hd = 0; hd < 4; ++hd) { const int c = hd * 256 + 4 * lane; na[hd] = *(const u32x2*)(HF + so + c); nbv[hd] = *(const u32x2*)(HB + so + c); no[hd] = *(const u32x2*)(BR + (size_t)rn * 3072 + 1024 + c); } }
#pragma unroll
        for (int hd = 0; hd < 4; ++hd) { const int c = hd * 256 + 4 * lane;
            const u32x2 a = ca[hd], b2 = cb[hd], o = co[hd];
            f32x4 h; h[0] = lo16(a.x) + lo16(b2.x); h[1] = hi16(a.x) + hi16(b2.x); h[2] = lo16(a.y) + lo16(b2.y); h[3] = hi16(a.y) + hi16(b2.y);
            const float ss = wave_sum((h[0] * h[0] + h[1] * h[1]) + (h[2] * h[2] + h[3] * h[3]));
            const float rs = __builtin_amdgcn_rsqf(ss * (1.f / 256.f) + EPS);
            const f32x4 g = *(const f32x4*)(ng + c);
            f32x4 r; r[0] = sigmoid_f(lo16(o.x)) * (h[0] * rs * g[0]); r[1] = sigmoid_f(hi16(o.x)) * (h[1] * rs * g[1]);
            r[2] = sigmoid_f(lo16(o.y)) * (h[2] * rs * g[2]); r[3] = sigmoid_f(hi16(o.y)) * (h[3] * rs * g[3]);
            u32x2 w; w.x = pk2(r[0], r[1]); w.y = pk2(r[2], r[3]);
            *(u32x2*)(BR + (size_t)row * 3072 + 1024 + c) = w; }
#pragma unroll
        for (int hd = 0; hd < 4; ++hd) { ca[hd] = na[hd]; cb[hd] = nbv[hd]; co[hd] = no[hd]; }
    }
}
__device__ __forceinline__ void ssd_finish_rows(const Params& p, int l, int row_lo, int gw, int ngw) {
    if (p.dup) return;
    const int lane = tid_fresh() & 63;
    const bf16_t* YF = (const bf16_t*)(p.ws + WS_YF); const bf16_t* YB = (const bf16_t*)(p.ws + WS_YB);
    bf16_t* BR = (bf16_t*)(p.ws + WS_BR);
    const float* ng = p.snorm_g + l * 1024;
    int row = row_lo + gw;
    u32x2 ca[4], cb[4], cz[4], na[4], nbv[4], nz[4];
    if (row < MT) {
#pragma unroll
        for (int j = 0; j < 4; ++j) { const int c = 4 * lane + 256 * j; ca[j] = *(const u32x2*)(YF + (size_t)row * 1024 + c); cb[j] = *(const u32x2*)(YB + (size_t)row * 1024 + c); cz[j] = *(const u32x2*)(BR + (size_t)row * 3072 + 2048 + c); } }
    for (; row < MT; row += ngw) {
        const int rn = row + ngw;
        if (rn < MT) {
#pragma unroll
            for (int j = 0; j < 4; ++j) { const int c = 4 * lane + 256 * j; na[j] = *(const u32x2*)(YF + (size_t)rn * 1024 + c); nbv[j] = *(const u32x2*)(YB + (size_t)rn * 1024 + c); nz[j] = *(const u32x2*)(BR + (size_t)rn * 3072 + 2048 + c); } }
        f32x4 v[4]; float ss = 0.f;
#pragma unroll
        for (int j = 0; j < 4; ++j) { const u32x2 a = ca[j], b2 = cb[j], z = cz[j];
            v[j][0] = (lo16(a.x) + lo16(b2.x)) * silu_f(lo16(z.x)); v[j][1] = (hi16(a.x) + hi16(b2.x)) * silu_f(hi16(z.x));
            v[j][2] = (lo16(a.y) + lo16(b2.y)) * silu_f(lo16(z.y)); v[j][3] = (hi16(a.y) + hi16(b2.y)) * silu_f(hi16(z.y));
            ss += (v[j][0] * v[j][0] + v[j][1] * v[j][1]) + (v[j][2] * v[j][2] + v[j][3] * v[j][3]); }
        const float rs = __builtin_amdgcn_rsqf(wave_sum(ss) * (1.f / 1024.f) + EPS);
#pragma unroll
        for (int j = 0; j < 4; ++j) { const int c = 4 * lane + 256 * j; const f32x4 g = *(const f32x4*)(ng + c);
            u32x2 w; w.x = pk2(v[j][0] * rs * g[0], v[j][1] * rs * g[1]); w.y = pk2(v[j][2] * rs * g[2], v[j][3] * rs * g[3]);
            *(u32x2*)(BR + (size_t)row * 3072 + 2048 + c) = w; }
#pragma unroll
        for (int j = 0; j < 4; ++j) { ca[j] = na[j]; cb[j] = nbv[j]; cz[j] = nz[j]; }
    }
}

__device__ __forceinline__ void phase_route(const Params& p, int l, unsigned char* ldsb, int bid, int nb) {
    float* lds = reinterpret_cast<float*>(ldsb);
    float* Wt = lds;
    int* hist = reinterpret_cast<int*>(lds + 36 * 1024);
    const int tid = tid_fresh(), lane = tid & 63, wave = tid >> 6;
    const int row_lo = l == 0 ? 0 : MC, rpb = l == 0 ? 68 : 64;
    const float* wrg = p.w_rg + (size_t)l * 1024 * 4; const float* wre = p.w_re + (size_t)l * 1024 * 32;
    for (int i = tid; i < 1024 * 4; i += NTHR) { const int k = i >> 2, g = i & 3; Wt[g * 1024 + (k ^ ((g & 7) << 2))] = wrg[i]; }
    for (int i = tid; i < 1024 * 32; i += NTHR) { const int k = i >> 5, e = i & 31; Wt[(4 + e) * 1024 + (k ^ (((4 + e) & 7) << 2))] = wre[i]; }
    const float* mod = (const float*)(p.ws + WS_MOD) + l * 5 * 6144;
    const float* XL = (const float*)(p.ws + WS_XL);
    int* EID = (int*)(p.ws + WS_EID); float* EWT = (float*)(p.ws + WS_EWT);
    for (int vb = bid; vb < 256; vb += nb) {
        if (tid < 32) hist[tid] = 0;
        __syncthreads();
        for (int rr = wave; rr < rpb; rr += 8) {
            const int row = row_lo + vb * rpb + rr;
            f32x4 v[4];
#pragma unroll
            for (int j = 0; j < 4; ++j) v[j] = *(const f32x4*)(XL + (size_t)row * 1024 + 4 * lane + 256 * j);
            const float* mr = mod + modrow(row) * 6144;
            norm_mod_row(v, p.g_ffn + l * 1024, mr + 3 * 1024, mr + 4 * 1024, lane);
            store_row_bf16((bf16_t*)(p.ws + WS_H) + (size_t)row * 1024, v, lane);
            float lg[36];
#pragma unroll
            for (int e = 0; e < 36; ++e) { float s = 0.f;
#pragma unroll
                for (int j = 0; j < 4; ++j) { const f32x4 w = *(const f32x4*)(Wt + e * 1024 + ((4 * lane + 256 * j) ^ ((e & 7) << 2))); s += (v[j][0] * w[0] + v[j][1] * w[1]) + (v[j][2] * w[2] + v[j][3] * w[3]); }
                lg[e] = wave_sum(s); }
            float gl[4]; int gi = 0; float gmax;
#pragma unroll
            for (int g = 0; g < 4; ++g) gl[g] = lg[g] + p.b_rg[l * 4 + g];
            gmax = gl[0];
#pragma unroll
            for (int g = 1; g < 4; ++g) if (gl[g] > gmax) { gmax = gl[g]; gi = g; }
            float den = 0.f;
#pragma unroll
            for (int g = 0; g < 4; ++g) den += __expf(gl[g] - gmax);
            const float pg = 1.f / den;
            float v1 = -3.0e38f, v2 = -3.0e38f; int i1 = 0, i2 = 0;
#pragma unroll
            for (int g = 0; g < 4; ++g) if (g == gi) {
#pragma unroll
                for (int j = 0; j < 8; ++j) { const float x = lg[4 + g * 8 + j] + p.b_re[l * 32 + g * 8 + j];
                    if (x > v1) { v2 = v1; i2 = i1; v1 = x; i1 = j; } else if (x > v2) { v2 = x; i2 = j; } } }
            const float e2 = __expf(v2 - v1), w1 = pg / (1.f + e2), w2 = pg * e2 / (1.f + e2);
            if (lane == 0) { EID[row * 2] = gi * 8 + i1; EID[row * 2 + 1] = gi * 8 + i2; EWT[row * 2] = w1; EWT[row * 2 + 1] = w2;
                atomicAdd(&hist[gi * 8 + i1], 1); atomicAdd(&hist[gi * 8 + i2], 1); }
        }
        __syncthreads();
        if (tid < 32) ((int*)(p.ws + WS_HIST))[vb * 32 + tid] = hist[tid];
        __syncthreads();
    }
    __syncthreads();
    float* scr = lds + wave * (64 * 65);
    convert_run(p, l, l + 1 < 2 ? l + 1 : -1, bid * 8 + wave, nb * 8, scr, lane);
}

__device__ __forceinline__ void phase_scatter(const Params& p, int l, unsigned char* ldsb, int bid, int nb) {
    int* li = reinterpret_cast<int*>(ldsb);
    int* tot = li; int* pre = li + 32; int* pst = li + 64; int* ea = li + 128; int* pos = li + 384;
    const int tid = tid_fresh(), lane = tid & 63, wave = tid >> 6;
    const int row_lo = l == 0 ? 0 : MC, rpb = l == 0 ? 68 : 64;
    const int* HIST = (const int*)(p.ws + WS_HIST); const int* EID = (const int*)(p.ws + WS_EID);
    int* SLOT = (int*)(p.ws + WS_SLOT);
    for (int vb = bid; vb < 256; vb += nb) {
        __syncthreads();
        if (tid < 32) { int t = 0, pr = 0; for (int j = 0; j < 256; ++j) { const int hv = HIST[j * 32 + tid]; t += hv; if (j < vb) pr += hv; } tot[tid] = t; pre[tid] = pr; }
        __syncthreads();
        if (tid == 0) { int s = 0; for (int e = 0; e < 32; ++e) { pst[e] = s; s += ((tot[e] + 255) >> 8) << 8; }
            if (vb == 0) { int* BE = (int*)(p.ws + WS_BLKEXP); int nblk = 0;
                for (int e = 0; e < 32; ++e) { const int nbk = (tot[e] + 255) >> 8; for (int j = 0; j < nbk; ++j) BE[nblk++] = e; }
                BE[200] = nblk; } }
        if (tid < rpb * 2) ea[tid] = EID[(row_lo + vb * rpb) * 2 + tid];
        __syncthreads();
        if (tid < rpb * 2) { const int e = ea[tid]; int rk = 0; for (int j = 0; j < tid; ++j) rk += (ea[j] == e) ? 1 : 0;
            const int ps = pst[e] + pre[e] + rk; SLOT[(row_lo + vb * rpb) * 2 + tid] = ps; ((int*)(p.ws + WS_TOK))[ps] = row_lo + vb * rpb + (tid >> 1); }
        if (vb == 0 && tid < 32) { int* TOK = (int*)(p.ws + WS_TOK); const int e0 = pst[tid] + tot[tid], e1 = pst[tid] + (((tot[tid] + 255) >> 8) << 8);
            for (int q = e0; q < e1; ++q) TOK[q] = row_lo; }
    }
    __syncthreads();
}

__device__ __forceinline__ void phase_combine(const Params& p, int l, int bid, int nb) {
    if (p.dup && l == 0) return;
    const int lane = tid_fresh() & 63, wave = tid_fresh() >> 6;
    const float* mod = (const float*)(p.ws + WS_MOD);
    const int* SLOT = (const int*)(p.ws + WS_SLOT); const float* EWT = (const float*)(p.ws + WS_EWT);
    const bf16_t* Y = (const bf16_t*)(p.ws + WS_Y);
    float* XL = (float*)(p.ws + WS_XL);
    const int row_lo = l == 0 ? 0 : MC, stride = nb * 8;
    for (int rowA = row_lo + bid * 8 + wave; rowA < MT; rowA += 2 * stride) {
        const int rowB = rowA + stride; const bool hasB = rowB < MT; const int rb = hasB ? rowB : rowA;
        const int sA0 = SLOT[rowA * 2], sA1 = SLOT[rowA * 2 + 1], sB0 = SLOT[rb * 2], sB1 = SLOT[rb * 2 + 1];
        const float wA0 = EWT[rowA * 2], wA1 = EWT[rowA * 2 + 1], wB0 = EWT[rb * 2], wB1 = EWT[rb * 2 + 1];
        u32x2 yA0[4], yA1[4], yB0[4], yB1[4]; f32x4 xA[4], xB[4];
#pragma unroll
        for (int j = 0; j < 4; ++j) { const int c = 4 * lane + 256 * j;
            yA0[j] = *(const u32x2*)(Y + (size_t)sA0 * 1024 + c); yA1[j] = *(const u32x2*)(Y + (size_t)sA1 * 1024 + c); xA[j] = *(const f32x4*)(XL + (size_t)rowA * 1024 + c);
            yB0[j] = *(const u32x2*)(Y + (size_t)sB0 * 1024 + c); yB1[j] = *(const u32x2*)(Y + (size_t)sB1 * 1024 + c); xB[j] = *(const f32x4*)(XL + (size_t)rb * 1024 + c); }
#pragma unroll
        for (int half = 0; half < 2; ++half) {
            if (half == 1 && !hasB) break;
            const int row = half ? rowB : rowA; const float w0 = half ? wB0 : wA0, w1 = half ? wB1 : wA1;
            const float* g5 = mod + (l * 5 + modrow(row)) * 6144 + 5 * 1024;
            f32x4 v[4];
#pragma unroll
            for (int j = 0; j < 4; ++j) { const int c = 4 * lane + 256 * j;
                const u32x2 a = half ? yB0[j] : yA0[j], b2 = half ? yB1[j] : yA1[j];
                f32x4 y; y[0] = w0 * lo16(a.x) + w1 * lo16(b2.x); y[1] = w0 * hi16(a.x) + w1 * hi16(b2.x); y[2] = w0 * lo16(a.y) + w1 * lo16(b2.y); y[3] = w0 * hi16(a.y) + w1 * hi16(b2.y);
                v[j] = (half ? xB[j] : xA[j]) + *(const f32x4*)(g5 + c) * y; }
            if (l == 0) {
#pragma unroll
                for (int j = 0; j < 4; ++j) *(f32x4*)(XL + (size_t)row * 1024 + 4 * lane + 256 * j) = v[j];
                const float* mr = mod + (5 + modrow(row)) * 6144;
                norm_mod_row(v, p.g_mix + 1024, mr, mr + 1024, lane);
                store_row_bf16((bf16_t*)(p.ws + WS_H) + (size_t)row * 1024, v, lane);
            } else {
                norm_mod_row(v, p.g_final, nullptr, nullptr, lane);
                float* o = p.out + (size_t)(row - MC) * 1024;
#pragma unroll
                for (int j = 0; j < 4; ++j) *(f32x4*)(o + 4 * lane + 256 * j) = v[j];
            }
        }
    }
}

constexpr int NPH_L = 14, NPHASES = 1 + 2 * NPH_L;
__device__ __forceinline__ void run_phase(const Params& p, int ph, unsigned char* lds) {
    const int bid = blockIdx.x, nb = gridDim.x;
    const int wave = tid_fresh() >> 6;
#ifndef ONLY_S
    if (ph == 0) { phase_pre(p, lds, bid, nb); return; }
#else
    if (ph == 0) { if (ONLY_S == 99) phase_pre(p, lds, bid, nb); return; }
#endif
    const int l = (ph - 1) / NPH_L, s = (ph - 1) % NPH_L;
    unsigned char* ws = p.ws;
    const int pm0 = l == 0 ? 0 : 4, nMrows = l == 0 ? 68 : 64, row_lo = l == 0 ? 0 : MC;
#ifdef ONLY_S
    if (s != ONLY_S) return;
#endif
    switch (s) {
    case 0: if (l == 0) phase_norm1(p, bid, nb); break;
    case 1: { EpiInproj E{ws};
              if (l == 0) { SchedGrid S{(const bf16_t*)(ws + WS_H), (const bf16_t*)(ws + WS_WIN), 1024, 1024, 0, 68, 45, nb, bid}; gemm_run(lds, S, E, 1024, 1024, 1024, 1); }
              else { SchedInproj1 S{(const bf16_t*)(ws + WS_H), (const bf16_t*)(ws + WS_WIN), nb, bid}; gemm_run(lds, S, E, 1024, 1024, 1024, 1); } } break;
    case 2: { for (int it = bid; it < 1088; it += nb) conv_m_item(p, l, it, (LAS unsigned char*)lds);
              if (!p.dup) for (int it = bid; it < (l == 0 ? 272 : 256); it += nb) pool_window_item(p, it, (LAS unsigned char*)lds); } break;
    case 3: { for (int it = bid; it < 256; it += nb) mlstm_chunk_item(p, l, it, (LAS unsigned char*)lds);
              SchedPool S{(const bf16_t*)(ws + WS_BR), (const bf16_t*)(ws + WS_WPOOL), pm0, nMrows, nb, bid}; EpiPool E{(bf16_t*)(ws + WS_BR)};
              if (!p.dup) gemm_run(lds, S, E, 256, 3072, 256, 1); } break;
    case 4: { for (int it = bid; it < 1088; it += nb) conv_s_item(p, l, it, (LAS unsigned char*)lds);
              mlstm_finish_rows(p, l, row_lo, bid * 8 + wave, nb * 8); } break;
    case 5: for (int it = bid; it < 256; it += nb) ssd_chunk_item(p, l, it, (LAS unsigned char*)lds); break;
    case 6: ssd_finish_rows(p, l, row_lo, bid * 8 + wave, nb * 8); break;
    case 7: { SchedGrid S{(const bf16_t*)(ws + WS_BR), (const bf16_t*)(ws + WS_WBR), 3072, 3072, pm0, nMrows, 4, nb, bid}; EpiBranch E{(const bf16_t*)(ws + WS_MG), (bf16_t*)(ws + WS_MERGED)};
              gemm_run(lds, S, E, 3072, 3072, 3072, 3); } break;
    case 8: { SchedGrid S{(const bf16_t*)(ws + WS_MERGED), (const bf16_t*)(ws + WS_WOUT), 1024, 1024, pm0, nMrows, 4, nb, bid}; EpiOut E{(float*)(ws + WS_XL), (const float*)(ws + WS_MOD) + l * 5 * 6144, l == 0 ? p.x : nullptr, l == 0 ? p.ctx : nullptr, p.dup};
              gemm_run(lds, S, E, 1024, 1024, 1024, 1); } break;
    case 9: phase_route(p, l, lds, bid, nb); break;
    case 10: phase_scatter(p, l, lds, bid, nb); break;
    case 11: { const int* BE = (const int*)(ws + WS_BLKEXP);
              SchedMoe S{(const bf16_t*)(ws + WS_H), (const bf16_t*)(ws + WS_EW1), BE, (const int*)(ws + WS_TOK), 1024, BE[200], nb, bid, (size_t)1048576, (size_t)1024}; EpiMoe1 E{(bf16_t*)(ws + WS_ACT)};
              gemm_run<true>(lds, S, E, 1024, 1024, 1024, 1); } break;
    case 12: { const int* BE = (const int*)(ws + WS_BLKEXP);
              SchedMoe S{(const bf16_t*)(ws + WS_ACT), (const bf16_t*)(ws + WS_EW2), BE, nullptr, 512, BE[200], nb, bid, (size_t)524288, (size_t)512}; EpiMoe2 E{(bf16_t*)(ws + WS_Y)};
              gemm_run(lds, S, E, 512, 512, 512, 1); } break;
    case 13: phase_combine(p, l, bid, nb); break;
    }
}

#define XB_TMO      128
#define XB_XCNT(j)  (256  + 64 * (j))
#define XB_XSUB(j)  (1280 + 64 * (j))
#define XB_XGEN(j)  (2304 + 64 * (j))
#define XB_TOP      3328
#define XB_TOPGEN   3392
#define XCD_BAR_WORDS 3456
#define XB_SPIN_CAP (1u << 18)
__device__ __forceinline__ unsigned xb_ld(unsigned* p)              { return __hip_atomic_load(p, __ATOMIC_RELAXED, __HIP_MEMORY_SCOPE_AGENT); }
__device__ __forceinline__ unsigned xb_add(unsigned* p, unsigned v) { return __hip_atomic_fetch_add(p, v, __ATOMIC_RELAXED, __HIP_MEMORY_SCOPE_AGENT); }
__device__ __forceinline__ unsigned xb_xcc_id() { return (unsigned)__builtin_amdgcn_s_getreg((3 << 11) | 20) & 0xFu; }
#define XB_SPIN(cond, bar) do { unsigned _sp = 0; while (cond) { __builtin_amdgcn_s_sleep(1); \
    if ((++_sp & 255u) == 0u) { if (xb_ld(&(bar)[XB_TMO])) break; if (_sp > XB_SPIN_CAP) { atomicAdd(&(bar)[XB_TMO], 1u); break; } } } } while (0)
__device__ __forceinline__ void xcd_barrier_complete(unsigned* bar, unsigned x, unsigned& nloc, unsigned& nx) {
    const unsigned G = gridDim.x * gridDim.y * gridDim.z;
    unsigned sum, cnt, mine, sp = 0u;
    for (;;) {
        sum = 0u; cnt = 0u; mine = 0u;
#pragma unroll
        for (unsigned j = 0; j < 16; ++j) { const unsigned c = xb_ld(&bar[XB_XCNT(j)]); sum += c; cnt += (c > 0u) ? 1u : 0u; mine = (j == x) ? c : mine; }
        if (sum == G) break;
        __builtin_amdgcn_s_sleep(1);
        if ((++sp & 255u) == 0u) { if (xb_ld(&bar[XB_TMO])) break; if (sp > XB_SPIN_CAP) { atomicAdd(&bar[XB_TMO], 1u); break; } }
    }
    nloc = mine > 0u ? mine : 1u; nx = cnt > 0u ? cnt : 1u;
}
__device__ __forceinline__ void xcd_barrier(unsigned* bar, volatile LAS unsigned* st) {
    asm volatile("s_waitcnt vmcnt(0)" ::: "memory");
    __syncthreads();
    if (threadIdx.x == 0) {
        __builtin_amdgcn_s_waitcnt(0);
        const unsigned x = xb_xcc_id();
        unsigned nloc = st[0], nx = st[1];
        if (nloc == 0u) { xcd_barrier_complete(bar, x, nloc, nx); st[0] = nloc; st[1] = nx; }
        const unsigned old = xb_add(&bar[XB_XSUB(x)], 1u);
        const unsigned gen = old / nloc;
        if (old + 1u == (gen + 1u) * nloc) {
            __builtin_amdgcn_fence(__ATOMIC_RELEASE, "agent");
            asm volatile("s_waitcnt vmcnt(0)" ::: "memory");
            const unsigned og = xb_add(&bar[XB_TOP], 1u);
            const unsigned tg = og / nx;
            if (og + 1u == (tg + 1u) * nx) xb_add(&bar[XB_TOPGEN], 1u);
            else XB_SPIN(xb_ld(&bar[XB_TOPGEN]) == tg, bar);
            __builtin_amdgcn_fence(__ATOMIC_ACQUIRE, "agent");
            xb_add(&bar[XB_XGEN(x)], 1u);
            asm volatile("s_waitcnt vmcnt(0)" ::: "memory");
        } else {
            XB_SPIN(xb_ld(&bar[XB_XGEN(x)]) == gen, bar);
            __builtin_amdgcn_fence(__ATOMIC_ACQUIRE, "agent");
            asm volatile("s_waitcnt vmcnt(0)" ::: "memory");
        }
    }
    __syncthreads();
}

constexpr int BAR_LDS_OFF = LDS_BYTES - 16;
__global__ void __launch_bounds__(NTHR, 2) fwd_kernel(Params pk) {
    extern __shared__ __attribute__((aligned(16))) unsigned char lds[];
    const Params& p = pk;
    const int lo = pk.ph_lo, hi = pk.ph_hi;
    unsigned* bar = (unsigned*)(pk.ws + WS_BAR);
    volatile LAS unsigned* bst = (volatile LAS unsigned*)((LAS unsigned char*)lds + BAR_LDS_OFF);
    if (hi - lo > 1) {
        if (threadIdx.x == 0) { bst[0] = 0u; bst[1] = 0u; (void)xb_add(&bar[XB_XCNT(xb_xcc_id())], 1u); }
        __syncthreads();
    }
#define STEP(k) if (lo <= (k) && (k) < hi) { run_phase(p, (k), lds); if ((k) + 1 < hi) { if (pk.dup < 0) cg::this_grid().sync(); else xcd_barrier(bar, bst); } }
    STEP(0) STEP(1) STEP(2) STEP(3) STEP(4) STEP(5) STEP(6) STEP(7) STEP(8) STEP(9) STEP(10) STEP(11) STEP(12) STEP(13) STEP(14)
    STEP(16) STEP(17) STEP(18) STEP(19) STEP(20) STEP(21) STEP(22) STEP(23) STEP(24) STEP(25) STEP(26) STEP(27) STEP(28)
#undef STEP
}

extern "C" void kernel_launch(void* const* d_in, const int* in_sizes, int n_in, void* d_out, int out_size, void* d_ws, size_t ws_size, hipStream_t stream) {
    static int grid_blocks = 0;
    if (!grid_blocks) {
        if (n_in != 31 || ws_size < WS_END) { fprintf(stderr, "kernel_launch: unexpected n_in %d / ws_size %zu (need %zu)\n", n_in, ws_size, (size_t)WS_END); grid_blocks = -1; return; }
        int dev = 0, cus = 0, per_cu = 0;
        hipGetDevice(&dev);
        hipDeviceGetAttribute(&cus, hipDeviceAttributeMultiprocessorCount, dev);
        if (hipFuncSetAttribute((const void*)fwd_kernel, hipFuncAttributeMaxDynamicSharedMemorySize, LDS_BYTES) != hipSuccess) fprintf(stderr, "kernel_launch: hipFuncSetAttribute failed\n");
        hipOccupancyMaxActiveBlocksPerMultiprocessor(&per_cu, (const void*)fwd_kernel, NTHR, LDS_BYTES);
        if (per_cu < 1) { fprintf(stderr, "kernel_launch: occupancy query says %d blocks per CU\n", per_cu); per_cu = 1; }
        grid_blocks = cus * per_cu;
        (void)hipGetLastError();
    }
    if (grid_blocks < 0) return;
    Params p{};
    const float** dst = (const float**)&p;
    for (int i = 0; i < 31; ++i) dst[i] = (const float*)d_in[i];
    p.out = (float*)d_out; p.ws = (unsigned char*)d_ws;
#if SINGLE_LAUNCH
    if (hipMemsetAsync((char*)d_ws + WS_BAR, 0, 16384, stream) != hipSuccess) fprintf(stderr, "kernel_launch: hipMemsetAsync failed\n");
    p.ph_lo = 0; p.ph_hi = NPHASES;
    void* args[] = {&p};
    hipError_t e = hipLaunchCooperativeKernel((const void*)fwd_kernel, dim3(grid_blocks), dim3(NTHR), args, LDS_BYTES, stream);
    if (e != hipSuccess) fprintf(stderr, "cooperative launch failed: %s (grid %d)\n", hipGetErrorString(e), grid_blocks);
#else
    for (int ph = 0; ph < NPHASES; ++ph) {
        if (ph == 1 + NPH_L) continue;
        p.ph_lo = ph; p.ph_hi = ph + 1;
        hipLaunchKernelGGL(fwd_kernel, dim3(grid_blocks), dim3(NTHR), LDS_BYTES, stream, p);
        const int sidx = ph == 0 ? 14 : (ph - 1) % NPH_L;
        if ((PROBE_DUP_MASK >> sidx) & 1) { p.dup = 1; for (int r = 0; r < PROBE_DUP_N; ++r) hipLaunchKernelGGL(fwd_kernel, dim3(grid_blocks), dim3(NTHR), LDS_BYTES, stream, p); p.dup = 0; }
    }
#endif
}
```

```cpp
#include <hip/hip_runtime.h>
#include <hip/hip_cooperative_groups.h>
#include <cstdio>
namespace cg = cooperative_groups;

#ifndef SINGLE_LAUNCH
#define SINGLE_LAUNCH 1
#endif
#ifndef PROBE_DUP_MASK
#define PROBE_DUP_MASK 0
#endif
#ifndef PROBE_DUP_N
#define PROBE_DUP_N 1
#endif
#ifndef USE_MLSTM_CHUNK
#define USE_MLSTM_CHUNK 1
#endif
#ifndef USE_SSD_CHUNK
#define USE_SSD_CHUNK 1
#endif
#ifndef CV_IN_SCAN
#define CV_IN_SCAN 0
#endif
#ifndef USE_MFMA_GEMM
#define USE_MFMA_GEMM 1
#endif

typedef unsigned short bf16_t;
typedef float f32x4 __attribute__((ext_vector_type(4)));
typedef unsigned u32x4 __attribute__((ext_vector_type(4)));
typedef unsigned u32x2 __attribute__((ext_vector_type(2)));

constexpr int NTHR = 512;
constexpr int D = 1024, NB = 4, SEQ = 4096, CTXL = 256;
constexpr int MC = NB * CTXL;
constexpr int ML = NB * SEQ;
constexpr int MT = MC + ML;
constexpr int DIN = 11312, NPAD = 11520;
constexpr int NE = 32, DE = 512;
constexpr int CAP = 43008;
constexpr float EPS = 1e-6f;
constexpr int LDS_BYTES = 163840;

constexpr size_t MiB = 1u << 20;
constexpr size_t WS_HIST = 0;
constexpr size_t WS_BLKEXP = 64 * 1024;
constexpr size_t WS_BAR = 128 * 1024;
constexpr size_t WS_TOK = 256 * 1024;
constexpr size_t WS_MOD = 1 * MiB;
constexpr size_t WS_GA = 2 * MiB;
constexpr size_t WS_DT = 4 * MiB;
constexpr size_t WS_EID = 7 * MiB;
constexpr size_t WS_EWT = 7 * MiB + 256 * 1024;
constexpr size_t WS_SLOT = 7 * MiB + 512 * 1024;
constexpr size_t WS_WIN = 8 * MiB;
constexpr size_t WS_WPOOL = 31 * MiB;
constexpr size_t WS_WBR = 32 * MiB;
constexpr size_t WS_WOUT = 38 * MiB;
constexpr size_t WS_XL = 40 * MiB;
constexpr size_t WS_H = 108 * MiB;
constexpr size_t WS_BR = 142 * MiB;
constexpr size_t WS_Q = 244 * MiB, WS_K = 278 * MiB, WS_V = 312 * MiB;
constexpr size_t WS_SX = 346 * MiB, WS_SB = 380 * MiB, WS_SC = 397 * MiB;
constexpr size_t WS_MG = 414 * MiB;
constexpr size_t WS_HF = 516 * MiB, WS_HB = 550 * MiB;
constexpr size_t WS_VT = 584 * MiB;
constexpr size_t WS_END = 618 * MiB;
constexpr size_t WS_MGA = WS_WIN, WS_MGC = WS_WIN + 576 * 1024, WS_MGP = WS_WIN + 1152 * 1024;
constexpr size_t WS_SACS = WS_WIN + 2 * MiB, WS_SDT = WS_WIN + 5 * MiB;
constexpr size_t WS_QC = WS_H, WS_KC = WS_HF, WS_KCT = WS_HB;
constexpr size_t WS_HF2 = WS_Q, WS_HB2 = WS_K;
constexpr size_t WS_XCT = WS_HF;
constexpr size_t WS_BC = WS_H, WS_CC = WS_H + 17 * MiB, WS_BCT = WS_HB;
constexpr size_t WS_YF = WS_SX, WS_YB = WS_SB;
constexpr size_t WS_MERGED = WS_H;
constexpr size_t WS_EW1 = 244 * MiB;
constexpr size_t WS_EW2 = 308 * MiB;
constexpr size_t WS_XB = WS_BR;
constexpr size_t WS_ACT = WS_SX;
constexpr size_t WS_Y = WS_MG;

struct Params {
    const float *x, *c, *ctx, *c_ctx, *w_ada, *b_ada, *g_mix, *g_ffn, *w_in, *pool_w, *pool_scale,
        *mconv_w, *mconv_b, *mgate_b, *mnorm_g, *sconv_w, *sconv_b, *sdt_bias, *sa_log, *sd, *snorm_g,
        *w_branch, *w_out, *w_rg, *b_rg, *w_re, *b_re, *w_eg, *w_eu, *w_ed, *g_final;
    float* out; unsigned char* ws; int ph_lo, ph_hi, dup, pad;
};

__device__ __forceinline__ int tid_fresh() { int t = threadIdx.x; asm volatile("" : "+v"(t)); return t; }
__device__ __forceinline__ float bf2f(unsigned b) { return __uint_as_float(b << 16); }
__device__ __forceinline__ unsigned f2bf(float f) { unsigned u = __float_as_uint(f); return (u + 0x7fffu + ((u >> 16) & 1u)) >> 16; }
typedef __bf16 bf16x2_t __attribute__((ext_vector_type(2)));
typedef float f32x2_t __attribute__((ext_vector_type(2)));
__device__ __forceinline__ unsigned pk2(float lo, float hi) { const f32x2_t v = {lo, hi}; return __builtin_bit_cast(unsigned, __builtin_convertvector(v, bf16x2_t)); }
__device__ __forceinline__ float lo16(unsigned w) { return __uint_as_float(w << 16); }
__device__ __forceinline__ float hi16(unsigned w) { return __uint_as_float(w & 0xffff0000u); }
__device__ __forceinline__ float wave_sum(float v) {
#pragma unroll
    for (int o = 1; o < 64; o <<= 1) v += __shfl_xor(v, o);
    return v;
}
__device__ __forceinline__ float sigmoid_f(float x) { return __builtin_amdgcn_rcpf(1.f + __expf(-x)); }
__device__ __forceinline__ float silu_f(float x) { return x * __builtin_amdgcn_rcpf(1.f + __expf(-x)); }
__device__ __forceinline__ float softplus_f(float x) { return fmaxf(x, 0.f) + log1pf(__expf(-fabsf(x))); }
__device__ __forceinline__ float logsigmoid_f(float x) { return fminf(x, 0.f) - log1pf(__expf(-fabsf(x))); }
__device__ __forceinline__ void unpack8(u32x4 w, float* f) {
    f[0] = lo16(w.x); f[1] = hi16(w.x); f[2] = lo16(w.y); f[3] = hi16(w.y);
    f[4] = lo16(w.z); f[5] = hi16(w.z); f[6] = lo16(w.w); f[7] = hi16(w.w);
}
__device__ __forceinline__ u32x4 pack8(f32x4 a, f32x4 b) {
    u32x4 w; w.x = pk2(a[0], a[1]); w.y = pk2(a[2], a[3]); w.z = pk2(b[0], b[1]); w.w = pk2(b[2], b[3]); return w;
}
__device__ __forceinline__ int scanrow(int row) {
    if (row < MC) return row;
    const int r = row - MC, b = r >> 12, t = r & 4095;
    return MC + (b << 12) + ((t & 63) << 6) + (t >> 6);
}
__device__ __forceinline__ int modrow(int row) { return row < MC ? 4 : ((row - MC) >> 12); }

struct Unit { const bf16_t* A; const bf16_t* B; const int* tok; int pm, pn; };

__device__ __forceinline__ void tile_order(int L, int nM, int nN, int& pm, int& pn) {
    const int nwg = nM * nN; int wgid = L;
    { const int q = nwg / 8, r = nwg % 8, xcd = wgid % 8, off = wgid / 8; wgid = (xcd < r ? xcd * (q + 1) : r * (q + 1) + (xcd - r) * q) + off; }
    const int nig = 8 * nN, gid = wgid / nig, fm = gid * 8, gsz = (nM - fm) < 8 ? (nM - fm) : 8;
    pm = fm + ((wgid % nig) % gsz); pn = (wgid % nig) / gsz;
}
struct SchedGrid {
    const bf16_t* A; const bf16_t* B; int lda, ldb, pm0, nM, nN, G, c;
    __device__ __forceinline__ bool next(int i, Unit& u) const {
        const long L = (long)i * G + c; if (L >= (long)nM * nN) return false;
        int pm, pn; tile_order((int)L, nM, nN, pm, pn); pm += pm0;
        u.pm = pm; u.pn = pn; u.tok = nullptr; u.A = A + (size_t)pm * 256 * lda; u.B = B + (size_t)pn * 256 * ldb; return true;
    }
};
struct SchedInproj1 {
    const bf16_t* A; const bf16_t* B; int G, c;
    __device__ __forceinline__ bool next(int i, Unit& u) const {
        const long L = (long)i * G + c; if (L >= 2880 + 84) return false;
        int pm, pn;
        if (L < 2880) { tile_order((int)L, 64, 45, pm, pn); pm += 4; }
        else { const int idx = (int)L - 2880, k = idx % 21; pm = idx / 21; pn = k < 12 ? 4 + k : (k < 16 ? 20 + (k - 12) : (k < 20 ? 28 + (k - 16) : 44)); }
        u.pm = pm; u.pn = pn; u.tok = nullptr; u.A = A + (size_t)pm * 256 * 1024; u.B = B + (size_t)pn * 256 * 1024; return true;
    }
};
struct SchedPool {
    const bf16_t* A; const bf16_t* B; int pm0, nM, G, c;
    __device__ __forceinline__ bool next(int i, Unit& u) const {
        const long L = (long)i * G + c; if (L >= (long)nM * 4) return false;
        const int pm = pm0 + (int)(L >> 2), g = (int)(L & 3);
        u.pm = pm; u.pn = g; u.tok = nullptr; u.A = A + (size_t)pm * 256 * 3072 + g * 256; u.B = B + (size_t)g * 65536; return true;
    }
};
struct SchedMoe {
    const bf16_t* A; const bf16_t* B; const int* blkexp; const int* tok; int lda, nblk, G, c; size_t bexp_stride, ldb;
    __device__ __forceinline__ bool next(int i, Unit& u) const {
        const long L = (long)i * G + c; if (L >= (long)nblk * 4) return false;
        const int blk = (int)(L >> 2), nt = (int)(L & 3); const int e = blkexp[blk];
        u.pm = blk; u.pn = nt; u.tok = tok ? tok + blk * 256 : nullptr; u.A = tok ? A : A + (size_t)blk * 256 * lda;
        u.B = B + (size_t)e * bexp_stride + (size_t)nt * 256 * ldb; return true;
    }
};

struct EpiInproj {
    unsigned char* ws;
    __device__ __forceinline__ void seg(const Unit& u, int, int r, int c0, f32x4& lo0, f32x4& lo1, f32x4& hi0, f32x4& hi1) const {
        const int row = u.pm * 256 + r, t = u.pn;
        bf16_t* dst; size_t ld; int cb;
        if (t < 4) { dst = (bf16_t*)(ws + WS_BR) + (size_t)row * 3072; cb = t * 256; }
        else if (t < 16) { const int w = (t - 4) >> 2; dst = (bf16_t*)(ws + WS_Q + (size_t)w * 34 * MiB) + (size_t)scanrow(row) * 1024; cb = ((t - 4) & 3) * 256; }
        else if (t < 20) { dst = (bf16_t*)(ws + WS_BR) + (size_t)row * 3072 + 1024; cb = (t - 16) * 256; }
        else if (t < 24) { dst = (bf16_t*)(ws + WS_SX) + (size_t)row * 1024; cb = (t - 20) * 256; }
        else if (t < 28) { dst = (bf16_t*)(ws + WS_BR) + (size_t)row * 3072 + 2048; cb = (t - 24) * 256; }
        else if (t < 30) { dst = (bf16_t*)(ws + WS_SB) + (size_t)row * 512; cb = (t - 28) * 256; }
        else if (t < 32) { dst = (bf16_t*)(ws + WS_SC) + (size_t)row * 512; cb = (t - 30) * 256; }
        else if (t < 44) {
            dst = (bf16_t*)(ws + WS_MG) + (size_t)row * 3072; cb = (t - 32) * 256;
#pragma unroll
            for (int j = 0; j < 4; ++j) { lo0[j] = sigmoid_f(lo0[j]); lo1[j] = sigmoid_f(lo1[j]); hi0[j] = sigmoid_f(hi0[j]); hi1[j] = sigmoid_f(hi1[j]); }
        } else {
            if (c0 < 32) { float* d = (float*)(ws + WS_DT) + (size_t)row * 32 + c0; *(f32x4*)d = lo0; *(f32x4*)(d + 4) = lo1; }
            else if (c0 < 48) { float* d = (float*)(ws + WS_GA) + (size_t)scanrow(row) * 16 + (c0 - 32); *(f32x4*)d = lo0; *(f32x4*)(d + 4) = lo1; }
            return;
        }
        *(u32x4*)(dst + cb + c0) = pack8(lo0, lo1);
        *(u32x4*)(dst + cb + 128 + c0) = pack8(hi0, hi1);
    }
};
struct EpiPool {
    bf16_t* BR;
    __device__ __forceinline__ void seg(const Unit& u, int, int r, int c0, f32x4& lo0, f32x4& lo1, f32x4& hi0, f32x4& hi1) const {
        bf16_t* d = BR + (size_t)(u.pm * 256 + r) * 3072 + u.pn * 256 + c0;
        *(u32x4*)d = pack8(lo0, lo1);
        *(u32x4*)(d + 128) = pack8(hi0, hi1);
    }
};
struct EpiBranch {
    const bf16_t* MG; bf16_t* OUT;
    __device__ __forceinline__ void seg(const Unit& u, int sg, int r, int c0, f32x4& lo0, f32x4& lo1, f32x4& hi0, f32x4& hi1) const {
        const int row = u.pm * 256 + r, col = u.pn * 256 + c0;
        const bf16_t* g = MG + (size_t)row * 3072 + sg * 1024 + col;
        const int nx = sg < 2 ? 1024 : 0;
        const u32x4 ga = *(const u32x4*)g, gb = *(const u32x4*)(g + 128), gc = *(const u32x4*)(g + nx), gd = *(const u32x4*)(g + nx + 128);
        float a[8], b[8], a2[8], b2[8]; unpack8(ga, a); unpack8(gb, b); unpack8(gc, a2); unpack8(gd, b2);
        if (sg < 2) {
#pragma unroll
            for (int j = 0; j < 8; ++j) { a[j] = a[j] * __builtin_amdgcn_rcpf(a2[j]); b[j] = b[j] * __builtin_amdgcn_rcpf(b2[j]); } }
#pragma unroll
        for (int j = 0; j < 4; ++j) { lo0[j] *= a[j]; lo1[j] *= a[4 + j]; hi0[j] *= b[j]; hi1[j] *= b[4 + j]; }
        if (sg == 2) { bf16_t* d = OUT + (size_t)row * 1024 + col; *(u32x4*)d = pack8(lo0, lo1); *(u32x4*)(d + 128) = pack8(hi0, hi1); }
    }
};
struct EpiOut {
    float* XL; const float* mod; const float* x_in; const float* ctx_in; int dup;
    __device__ __forceinline__ void seg(const Unit& u, int, int r, int c0, f32x4& lo0, f32x4& lo1, f32x4& hi0, f32x4& hi1) const {
        const int row = u.pm * 256 + r, col = u.pn * 256 + c0;
        const float* g = mod + modrow(row) * 6144 + 2 * 1024 + col;
        float* x = XL + (size_t)row * 1024 + col;
        const float* rs = x_in ? (row < MC ? ctx_in + (size_t)row * 1024 + col : x_in + (size_t)(row - MC) * 1024 + col) : x;
        const f32x4 x0 = *(const f32x4*)rs, x1 = *(const f32x4*)(rs + 4), x2 = *(const f32x4*)(rs + 128), x3 = *(const f32x4*)(rs + 132);
        const f32x4 g0 = *(const f32x4*)g, g1 = *(const f32x4*)(g + 4), g2 = *(const f32x4*)(g + 128), g3 = *(const f32x4*)(g + 132);
        if (dup) return;
        *(f32x4*)x = x0 + g0 * lo0; *(f32x4*)(x + 4) = x1 + g1 * lo1; *(f32x4*)(x + 128) = x2 + g2 * hi0; *(f32x4*)(x + 132) = x3 + g3 * hi1;
    }
};
struct EpiMoe1 {
    bf16_t* ACT;
    __device__ __forceinline__ void seg(const Unit& u, int, int r, int c0, f32x4& lo0, f32x4& lo1, f32x4& hi0, f32x4& hi1) const {
        const int row = u.pm * 256 + r;
        f32x4 a, b;
#pragma unroll
        for (int j = 0; j < 4; ++j) { a[j] = silu_f(lo0[j]) * hi0[j]; b[j] = silu_f(lo1[j]) * hi1[j]; }
        *(u32x4*)(ACT + (size_t)row * 512 + u.pn * 128 + c0) = pack8(a, b);
    }
};
struct EpiMoe2 {
    bf16_t* Y;
    __device__ __forceinline__ void seg(const Unit& u, int, int r, int c0, f32x4& lo0, f32x4& lo1, f32x4& hi0, f32x4& hi1) const {
        bf16_t* d = Y + (size_t)(u.pm * 256 + r) * 1024 + u.pn * 256 + c0;
        *(u32x4*)d = pack8(lo0, lo1); *(u32x4*)(d + 128) = pack8(hi0, hi1);
    }
};

#define LAS __attribute__((address_space(3)))
typedef short bf16x8 __attribute__((ext_vector_type(8)));
constexpr int HTB = 128 * 64 * 2;
__device__ __forceinline__ int lds_byte(int r, int c) { const int st = (r >> 4) * 2 + (c >> 5), rr = r & 15, cc = c & 31, ob = rr * 64 + cc * 2; return st * 1024 + (ob ^ (((ob >> 9) & 1) << 5)); }
__device__ __forceinline__ void stage_rc(int b, int& R, int& C) { const int st = b / 1024, sb = b % 1024, swz = sb ^ (((sb >> 9) & 1) << 5); R = (st >> 1) * 16 + swz / 64; C = (st & 1) * 32 + (swz % 64) / 2; }
__device__ __forceinline__ int perm32(int rho) { const int n = rho >> 4, i = rho & 15; return 8 * (i >> 2) + 4 * n + (i & 3); }

template <bool GATHER, class Sched, class Epi>
__device__ __forceinline__ void gemm_mfma(LAS unsigned char* lds, const Sched& S, const Epi& E, const int K, const int lda, const int ldb, const int nseg) {
    const int tid = tid_fresh(), wid = __builtin_amdgcn_readfirstlane(tid >> 6), lane = tid & 63, wr = wid >> 2, wc = wid & 3, fr = lane & 15, fq = lane >> 4;
    const int nt = K / 64, tseg = nt / nseg;
    unsigned vA0[2], vA1[2], nA0[2], nA1[2], voffB[2]; int rowA[2], colA[2];
#pragma unroll
    for (int i = 0; i < 2; ++i) { int R, C; stage_rc(tid * 16 + i * 8192, R, C); const int Rb = (R & ~31) + perm32(R & 31);
        rowA[i] = R; colA[i] = C;
        vA0[i] = (unsigned)(R * lda + C) * 2u; vA1[i] = vA0[i] + (unsigned)(128 * lda * 2); nA0[i] = vA0[i]; nA1[i] = vA1[i];
        voffB[i] = (unsigned)(Rb * ldb + C) * 2u; }
    const size_t kstep = 128;
    const size_t hstepB = (size_t)128 * ldb * 2;
    const unsigned ldsw = (unsigned)wid * 1024u;
    const int aoff = lds_byte(wr * 64 + fr, fq * 8), boff = lds_byte(wc * 32 + fr, fq * 8);
#define PG8_SA(b, h) (((b) * 2 + (h)) * HTB)
#define PG8_SB(b, h) ((4 + (b) * 2 + (h)) * HTB)
#define PG8_STAGE(bufoff, gbase, voff) do { _Pragma("unroll") for (int _i = 0; _i < 2; ++_i) \
        __builtin_amdgcn_global_load_lds((const unsigned*)((const char*)(gbase) + (voff)[_i]), (LAS unsigned*)(lds + (bufoff) + ldsw + _i * 8192), 16, 0, 0); } while (0)
#define PG8_LDA(dst, b, h) do { _Pragma("unroll") for (int m = 0; m < 4; ++m) _Pragma("unroll") for (int k = 0; k < 2; ++k) dst[m][k] = *(const LAS bf16x8*)(lds + PG8_SA(b, h) + aoff + m * 2048 + k * 1024); } while (0)
#define PG8_LDB(dst, b, h) do { _Pragma("unroll") for (int n = 0; n < 2; ++n) _Pragma("unroll") for (int k = 0; k < 2; ++k) dst[n][k] = *(const LAS bf16x8*)(lds + PG8_SB(b, h) + boff + n * 2048 + k * 1024); } while (0)
#define PG8_MMA(ai, bj, At, Bt) do { __builtin_amdgcn_s_setprio(1); _Pragma("unroll") for (int m = 0; m < 4; ++m) _Pragma("unroll") for (int n = 0; n < 2; ++n) _Pragma("unroll") for (int k = 0; k < 2; ++k) \
        acc[ai][bj][m][n] = __builtin_amdgcn_mfma_f32_16x16x32_bf16(Bt[n][k], At[m][k], acc[ai][bj][m][n], 0, 0, 0); __builtin_amdgcn_s_setprio(0); } while (0)
#define PG8_WAIT_V(n) asm volatile("s_waitcnt vmcnt(" #n ")" ::: "memory")
#define PG8_WAIT_L(n) asm volatile("s_waitcnt lgkmcnt(" #n ")" ::: "memory")
#define PG8_BAR __builtin_amdgcn_s_barrier()
#define PG8_SCHED __builtin_amdgcn_sched_barrier(0)
#define PG8_EPI(sg) do { _Pragma("unroll") for (int ai = 0; ai < 2; ++ai) _Pragma("unroll") for (int m = 0; m < 4; ++m) { \
        int r_ = ai * 128 + wr * 64 + m * 16 + fr; asm volatile("" : "+v"(r_));     \
        E.seg(cur, (sg), r_, wc * 32 + fq * 8, acc[ai][0][m][0], acc[ai][0][m][1], acc[ai][1][m][0], acc[ai][1][m][1]); } } while (0)
    Unit cur, nxt; int ui = 0;
    if (!S.next(0, cur)) return;
    f32x4 acc[2][2][4][2];
#pragma unroll
    for (int a = 0; a < 2; ++a)
#pragma unroll
        for (int b = 0; b < 2; ++b)
#pragma unroll
            for (int m = 0; m < 4; ++m)
#pragma unroll
                for (int n = 0; n < 2; ++n) acc[a][b][m][n] = (f32x4){0.f, 0.f, 0.f, 0.f};
    bf16x8 At[4][2], B0[2][2], B1[2][2];
    const char* cA = (const char*)cur.A; const char* cB = (const char*)cur.B;
    if (GATHER) {
#pragma unroll
        for (int i = 0; i < 2; ++i) { vA0[i] = (unsigned)(cur.tok[rowA[i]] * lda + colA[i]) * 2u; vA1[i] = (unsigned)(cur.tok[128 + rowA[i]] * lda + colA[i]) * 2u; nA0[i] = vA0[i]; nA1[i] = vA1[i]; }
    }
    PG8_STAGE(PG8_SB(0, 0), cB, voffB); PG8_STAGE(PG8_SA(0, 0), cA, vA0); PG8_STAGE(PG8_SB(0, 1), cB + hstepB, voffB); PG8_STAGE(PG8_SA(0, 1), cA, vA1);
    if (wr == 1) PG8_BAR;
    PG8_WAIT_V(4); PG8_BAR;
    PG8_STAGE(PG8_SB(1, 0), cB + kstep, voffB); PG8_STAGE(PG8_SA(1, 0), cA + kstep, vA0); PG8_STAGE(PG8_SB(1, 1), cB + hstepB + kstep, voffB);
    PG8_WAIT_V(6); PG8_BAR;
    for (;;) {
        const bool has_next = S.next(ui + 1, nxt);
        const char* nA = has_next ? (const char*)nxt.A : cA; const char* nB = has_next ? (const char*)nxt.B : cB;
        if (GATHER) {
            const int* tk = has_next ? nxt.tok : cur.tok;
#pragma unroll
            for (int i = 0; i < 2; ++i) { nA0[i] = (unsigned)(tk[rowA[i]] * lda + colA[i]) * 2u; nA1[i] = (unsigned)(tk[128 + rowA[i]] * lda + colA[i]) * 2u; }
        }
#pragma nounroll
        for (int sg = 0; sg < nseg; ++sg) {
#pragma nounroll
        for (int tt = 0; tt < tseg; tt += 2) {
            const int t = sg * tseg + tt;
            const bool last = (t == nt - 2);
            const char* a1 = cA + (size_t)(t + 1) * kstep;
            const char* a2 = last ? nA : cA + (size_t)(t + 2) * kstep; const char* b2 = last ? nB : cB + (size_t)(t + 2) * kstep;
            const char* a3 = a2 + kstep; const char* b3 = b2 + kstep;
            unsigned w0[2], w1[2];
#pragma unroll
            for (int i = 0; i < 2; ++i) { w0[i] = last ? nA0[i] : vA0[i]; w1[i] = last ? nA1[i] : vA1[i]; }
            PG8_LDB(B0, 0, 0); PG8_SCHED; PG8_LDA(At, 0, 0); PG8_STAGE(PG8_SA(1, 1), a1, vA1);
            PG8_WAIT_L(8); PG8_BAR; PG8_WAIT_L(0); PG8_MMA(0, 0, At, B0); PG8_BAR; PG8_SCHED;
            PG8_LDB(B1, 0, 1); PG8_STAGE(PG8_SB(0, 0), b2, voffB);
            PG8_BAR; PG8_WAIT_L(0); PG8_MMA(0, 1, At, B1); PG8_BAR;
            PG8_LDA(At, 0, 1); PG8_STAGE(PG8_SA(0, 0), a2, w0);
            PG8_BAR; PG8_WAIT_L(0); PG8_MMA(1, 0, At, B0); PG8_BAR; PG8_SCHED;
            PG8_STAGE(PG8_SB(0, 1), b2 + hstepB, voffB);
            PG8_WAIT_V(6); PG8_BAR; PG8_MMA(1, 1, At, B1); PG8_BAR;
            PG8_LDB(B0, 1, 0); PG8_SCHED; PG8_LDA(At, 1, 0); PG8_STAGE(PG8_SA(0, 1), a2, w1);
            PG8_WAIT_L(8); PG8_BAR; PG8_WAIT_L(0); PG8_MMA(0, 0, At, B0); PG8_BAR; PG8_SCHED;
            PG8_LDB(B1, 1, 1); PG8_STAGE(PG8_SB(1, 0), b3, voffB);
            PG8_BAR; PG8_WAIT_L(0); PG8_MMA(0, 1, At, B1); PG8_BAR;
            PG8_LDA(At, 1, 1); PG8_STAGE(PG8_SA(1, 0), a3, w0);
            PG8_BAR; PG8_WAIT_L(0); PG8_MMA(1, 0, At, B0); PG8_BAR; PG8_SCHED;
            PG8_STAGE(PG8_SB(1, 1), b3 + hstepB, voffB);
            PG8_WAIT_V(6); PG8_BAR; PG8_MMA(1, 1, At, B1); PG8_BAR;
        }
        PG8_EPI(sg);
        }
        if (!has_next) break;
#pragma unroll
        for (int a = 0; a < 2; ++a)
#pragma unroll
            for (int b = 0; b < 2; ++b)
#pragma unroll
                for (int m = 0; m < 4; ++m)
#pragma unroll
                    for (int n = 0; n < 2; ++n) acc[a][b][m][n] = (f32x4){0.f, 0.f, 0.f, 0.f};
        cur = nxt; cA = nA; cB = nB; ++ui;
#pragma unroll
        for (int i = 0; i < 2; ++i) { vA0[i] = nA0[i]; vA1[i] = nA1[i]; }
    }
    PG8_WAIT_V(0);
    if (wr == 0) PG8_BAR;
    PG8_BAR;
#undef PG8_SA
#undef PG8_SB
#undef PG8_STAGE
#undef PG8_LDA
#undef PG8_LDB
#undef PG8_MMA
#undef PG8_WAIT_V
#undef PG8_WAIT_L
#undef PG8_BAR
#undef PG8_SCHED
#undef PG8_EPI
}

template <bool GATHER = false, class Sched, class Epi>
__device__ __forceinline__ void gemm_run(unsigned char* lds, const Sched& S, const Epi& E, int K, int lda, int ldb, int nseg) {
    __syncthreads();
    gemm_mfma<GATHER>((LAS unsigned char*)lds, S, E, K, lda, ldb, nseg);
    __syncthreads();
}

struct TrDesc { const float* src; const float* cscale; bf16_t* dst; int ld_src, ld_dst, valid; };
__device__ __forceinline__ void tr_load(const TrDesc& d, f32x4 (&v)[16]) {
    if (d.src) {
#pragma unroll
        for (int i = 0; i < 16; ++i) v[i] = *(const f32x4*)(d.src + (size_t)(4 * i) * d.ld_src);
    } else {
#pragma unroll
        for (int i = 0; i < 16; ++i) v[i] = (f32x4){0.f, 0.f, 0.f, 0.f};
    }
}
__device__ __forceinline__ void tr_store(const TrDesc& d, f32x4 (&v)[16], float* scr, int lane) {
    const int c4 = (lane & 15) * 4, kr = lane >> 4;
    if (d.cscale) { const f32x4 s = *(const f32x4*)d.cscale;
#pragma unroll
        for (int i = 0; i < 16; ++i) v[i] = v[i] * s; }
#pragma unroll
    for (int i = 0; i < 16; ++i) { float* q = scr + (kr + 4 * i) * 65 + c4; q[0] = v[i][0]; q[1] = v[i][1]; q[2] = v[i][2]; q[3] = v[i][3]; }
    asm volatile("s_waitcnt lgkmcnt(0)" ::: "memory");
    const int c = lane & 7;
#pragma unroll
    for (int j = 0; j < 8; ++j) { const int n = (lane >> 3) + 8 * j; const float* s = scr + (8 * c) * 65 + n;
        u32x4 o; o.x = pk2(s[0 * 65], s[1 * 65]); o.y = pk2(s[2 * 65], s[3 * 65]); o.z = pk2(s[4 * 65], s[5 * 65]); o.w = pk2(s[6 * 65], s[7 * 65]);
        *(u32x4*)(d.dst + (size_t)n * d.ld_dst + 8 * c) = o; }
    asm volatile("s_waitcnt lgkmcnt(0)" ::: "memory");
}
__device__ __forceinline__ TrDesc tr_desc(const float* W, int ld_src, int srcq, bf16_t* WT, int ld_dst, int n_dst, int kdst0, int k0, int lane, const float* cscale = nullptr) {
    TrDesc d; d.ld_src = ld_src; d.ld_dst = ld_dst; d.valid = 1;
    d.src = srcq >= 0 ? W + (size_t)(k0 + (lane >> 4)) * ld_src + srcq : nullptr;
    d.cscale = (cscale && srcq >= 0) ? cscale + srcq : nullptr;
    d.dst = WT + (size_t)n_dst * ld_dst + kdst0 + k0; return d;
}
constexpr int CV_MIX_ITEMS = 2880 + 64 + 768 + 256;
constexpr int CV_EXP_ITEMS = 32 * 384;
__device__ __forceinline__ TrDesc convert_desc(const Params& p, int le, int lm, int it, int lane) {
    unsigned char* ws = p.ws;
    const int c4 = (lane & 15) * 4;
    if (le >= 0) {
        if (it < CV_EXP_ITEMS) {
            const int e = it / 384, r = it % 384;
            if (r < 256) { const int up = r >> 7, q = r & 127, kb = ((q >> 5) << 2) | ((q >> 1) & 3), nb = (((q >> 3) & 3) << 1) | (q & 1); const int c = nb * 64;
                const float* src = (up ? p.w_eu : p.w_eg) + (size_t)(le * 32 + e) * 1024 * 512;
                return tr_desc(src, 512, c + c4, (bf16_t*)(ws + WS_EW1) + (size_t)e * 1048576, 1024, (c >> 7) * 256 + up * 128 + (c & 127), 0, kb * 64, lane); }
            const int q = r - 256, kb = ((q >> 6) << 2) | ((q >> 1) & 3), nb = (((q >> 3) & 7) << 1) | (q & 1);
            return tr_desc(p.w_ed + (size_t)(le * 32 + e) * 512 * 1024, 1024, nb * 64 + c4, (bf16_t*)(ws + WS_EW2) + (size_t)e * 524288, 512, nb * 64, 0, kb * 64, lane);
        }
        it -= CV_EXP_ITEMS;
    }
    const int l = lm;
    if (it < 2880) { const int R = it >> 4, kb = it & 15, dstn = R * 64; int srcq;
        if (R < 80) srcq = dstn + c4; else if (R < 128) srcq = dstn + 16 + c4; else if (R < 176) srcq = dstn + 48 + c4;
        else if (R == 176) srcq = c4 < 32 ? 8208 + c4 : (c4 < 48 ? 5120 + (c4 - 32) : -1); else srcq = -1;
        return tr_desc(p.w_in + (size_t)l * 1024 * DIN, DIN, srcq, (bf16_t*)(ws + WS_WIN), 1024, dstn, 0, kb * 64, lane); }
    it -= 2880;
    if (it < 64) { const int g = it >> 4, r = it & 15, kb = r >> 2, nb = r & 3;
        return tr_desc(p.pool_w + (size_t)(l * 4 + g) * 65536, 256, nb * 64 + c4, (bf16_t*)(ws + WS_WPOOL) + (size_t)g * 65536, 256, nb * 64, 0, kb * 64, lane, p.pool_scale + l * 1024 + g * 256); }
    it -= 64;
    if (it < 768) { const int br = it >> 8, r = it & 255, kb = r >> 4, nb = r & 15;
        return tr_desc(p.w_branch + (size_t)(l * 3 + br) * 1048576, 1024, nb * 64 + c4, (bf16_t*)(ws + WS_WBR), 3072, nb * 64, br * 1024, kb * 64, lane); }
    it -= 768;
    { const int kb = it >> 4, nb = it & 15;
      return tr_desc(p.w_out + (size_t)l * 1048576, 1024, nb * 64 + c4, (bf16_t*)(ws + WS_WOUT), 1024, nb * 64, 0, kb * 64, lane); }
}
__device__ __forceinline__ void convert_run(const Params& p, int le, int lm, int first, int step, float* scr, int lane) {
    const int nitems = (le >= 0 ? CV_EXP_ITEMS : 0) + (lm >= 0 ? CV_MIX_ITEMS : 0);
    if (first >= nitems) return;
    f32x4 va[16], vb[16];
    TrDesc da = convert_desc(p, le, lm, first, lane), db;
    tr_load(da, va);
    for (int it = first; it < nitems; it += 2 * step) {
        const int i1 = it + step, i2 = it + 2 * step;
        if (i1 < nitems) { db = convert_desc(p, le, lm, i1, lane); tr_load(db, vb); }
        tr_store(da, va, scr, lane);
        if (i1 >= nitems) break;
        if (i2 < nitems) { da = convert_desc(p, le, lm, i2, lane); tr_load(da, va); }
        tr_store(db, vb, scr, lane);
    }
}

__device__ __forceinline__ void cvmicro_load(const Params& p, int le, int m, int lane, f32x4 (&v)[8], TrDesc& d) {
    d = convert_desc(p, le, -1, m >> 1, lane);
    const float* s = d.src + (size_t)(32 * (m & 1)) * d.ld_src;
#pragma unroll
    for (int i = 0; i < 8; ++i) v[i] = *(const f32x4*)(s + (size_t)(4 * i) * d.ld_src);
}
__device__ __forceinline__ void cvmicro_store(const TrDesc& d, int m, const f32x4 (&v)[8], LAS float* scr, int lane) {
    const int c4 = (lane & 15) * 4, kr = lane >> 4;
#pragma unroll
    for (int i = 0; i < 8; ++i) { LAS float* q = scr + (kr + 4 * i) * 65 + c4; q[0] = v[i][0]; q[1] = v[i][1]; q[2] = v[i][2]; q[3] = v[i][3]; }
    asm volatile("s_waitcnt lgkmcnt(0)" ::: "memory");
    bf16_t* drow = d.dst + (size_t)lane * d.ld_dst + 32 * (m & 1);
#pragma unroll
    for (int g = 0; g < 4; ++g) { const LAS float* s = scr + (8 * g) * 65 + lane;
        u32x4 o; o.x = pk2(s[0 * 65], s[1 * 65]); o.y = pk2(s[2 * 65], s[3 * 65]); o.z = pk2(s[4 * 65], s[5 * 65]); o.w = pk2(s[6 * 65], s[7 * 65]);
        *(u32x4*)(drow + 8 * g) = o; }
    asm volatile("s_waitcnt lgkmcnt(0)" ::: "memory");
}

__device__ __forceinline__ void phase_pre(const Params& p, unsigned char* ldsb, int bid, int nb) {
    float* lds = reinterpret_cast<float*>(ldsb);
    const int tid = tid_fresh(), lane = tid & 63, wave = tid >> 6;
    for (int i = tid; i < 5 * 1024; i += NTHR) { const float v = i < 4096 ? p.c[i] : p.c_ctx[i - 4096]; lds[i] = silu_f(v); }
    __syncthreads();
    float* red = lds + 5120;
    for (int it = bid; it < 2 * 96; it += nb) {
        const int l = it / 96, j = (it % 96) * 64 + lane;
        const float* w = p.w_ada + (size_t)l * 1024 * 6144 + j;
        float a0 = 0, a1 = 0, a2 = 0, a3 = 0, a4 = 0;
#pragma unroll 16
        for (int k = wave * 128; k < wave * 128 + 128; ++k) { const float wv = w[(size_t)k * 6144];
            a0 += lds[k] * wv; a1 += lds[1024 + k] * wv; a2 += lds[2048 + k] * wv; a3 += lds[3072 + k] * wv; a4 += lds[4096 + k] * wv; }
        red[(wave * 5 + 0) * 64 + lane] = a0; red[(wave * 5 + 1) * 64 + lane] = a1; red[(wave * 5 + 2) * 64 + lane] = a2;
        red[(wave * 5 + 3) * 64 + lane] = a3; red[(wave * 5 + 4) * 64 + lane] = a4;
        __syncthreads();
        if (tid < 320) { const int r = tid >> 6, jj = tid & 63; float s = 0;
            for (int w8 = 0; w8 < 8; ++w8) s += red[(w8 * 5 + r) * 64 + jj];
            const int col = (it % 96) * 64 + jj;
            ((float*)(p.ws + WS_MOD))[(size_t)(l * 5 + r) * 6144 + col] = s + p.b_ada[l * 6144 + col]; }
        __syncthreads();
    }
    __syncthreads();
    float* scr = lds + wave * (64 * 65);
    convert_run(p, -1, 0, bid * 8 + wave, nb * 8, scr, lane);
}

__device__ __forceinline__ void norm_mod_row(f32x4 (&v)[4], const float* g, const float* shift, const float* scale, int lane) {
    float s = 0.f;
#pragma unroll
    for (int j = 0; j < 4; ++j) s += (v[j][0] * v[j][0] + v[j][1] * v[j][1]) + (v[j][2] * v[j][2] + v[j][3] * v[j][3]);
    const float rs = __builtin_amdgcn_rsqf(wave_sum(s) * (1.f / 1024.f) + EPS);
#pragma unroll
    for (int j = 0; j < 4; ++j) { const int c = 4 * lane + 256 * j; const f32x4 gg = *(const f32x4*)(g + c);
        f32x4 y = v[j] * rs * gg;
        if (shift) { const f32x4 sh = *(const f32x4*)(shift + c), sc = *(const f32x4*)(scale + c); y = y * (1.f + sc) + sh; }
        v[j] = y; }
}
__device__ __forceinline__ void store_row_bf16(bf16_t* dst, const f32x4 (&v)[4], int lane) {
#pragma unroll
    for (int j = 0; j < 4; ++j) { u32x2 w; w.x = pk2(v[j][0], v[j][1]); w.y = pk2(v[j][2], v[j][3]); *(u32x2*)(dst + 4 * lane + 256 * j) = w; }
}

__device__ __forceinline__ void phase_norm1(const Params& p, int bid, int nb) {
    const int lane = tid_fresh() & 63, wave = tid_fresh() >> 6;
    const float* mod = (const float*)(p.ws + WS_MOD);
    const int stride = nb * 8;
    int m = bid * 8 + wave;
    f32x4 v[4], w[4];
    if (m < MT) { const float* src = m < MC ? p.ctx + (size_t)m * 1024 : p.x + (size_t)(m - MC) * 1024;
#pragma unroll
        for (int j = 0; j < 4; ++j) v[j] = *(const f32x4*)(src + 4 * lane + 256 * j); }
    for (; m < MT; m += stride) {
        const int mn = m + stride;
        if (mn < MT) { const float* src = mn < MC ? p.ctx + (size_t)mn * 1024 : p.x + (size_t)(mn - MC) * 1024;
#pragma unroll
            for (int j = 0; j < 4; ++j) w[j] = *(const f32x4*)(src + 4 * lane + 256 * j); }
        const float* mr = mod + modrow(m) * 6144;
        norm_mod_row(v, p.g_mix, mr, mr + 1024, lane);
        store_row_bf16((bf16_t*)(p.ws + WS_H) + (size_t)m * 1024, v, lane);
#pragma unroll
        for (int j = 0; j < 4; ++j) v[j] = w[j];
    }
}

__device__ __forceinline__ float wave_incl_sum(float v, int lane) {
#pragma unroll
    for (int o = 1; o < 64; o <<= 1) { const float u = __shfl_up(v, o); if (lane >= o) v += u; }
    return v;
}
__device__ __forceinline__ float wave_incl_max(float v, int lane) {
#pragma unroll
    for (int o = 1; o < 64; o <<= 1) { const float u = __shfl_up(v, o); if (lane >= o) v = fmaxf(v, u); }
    return v;
}
__device__ __forceinline__ u32x2 pack4(f32x4 a) { u32x2 w; w.x = pk2(a[0], a[1]); w.y = pk2(a[2], a[3]); return w; }

__device__ __forceinline__ void chunk_geom(int gc, int& rbase, int& n0, int& len) {
    const int b = gc / 68, cin = gc % 68;
    if (cin < 4) { rbase = b * 256; n0 = cin * 64; len = 256; } else { rbase = MC + b * 4096; n0 = (cin - 4) * 64; len = 4096; }
}
__device__ __forceinline__ void conv8x4(const u32x4 (&raw)[7], const float* cw, const float* cb, int ch0, float scale, u32x4 (&out)[4]) {
    float w[4][8], bs[8];
#pragma unroll
    for (int j = 0; j < 4; ++j) { const f32x4 a = *(const f32x4*)(cw + j * 2048 + ch0), b2 = *(const f32x4*)(cw + j * 2048 + ch0 + 4);
#pragma unroll
        for (int i = 0; i < 4; ++i) { w[j][i] = a[i]; w[j][4 + i] = b2[i]; } }
    { const f32x4 a = *(const f32x4*)(cb + ch0), b2 = *(const f32x4*)(cb + ch0 + 4);
#pragma unroll
      for (int i = 0; i < 4; ++i) { bs[i] = a[i]; bs[4 + i] = b2[i]; } }
    float f[7][8];
#pragma unroll
    for (int k = 0; k < 7; ++k) unpack8(raw[k], f[k]);
#pragma unroll
    for (int pp = 0; pp < 4; ++pp) { f32x4 o0, o1;
#pragma unroll
        for (int i = 0; i < 8; ++i) { float a = bs[i];
#pragma unroll
            for (int j = 0; j < 4; ++j) a += w[j][i] * f[pp + j][i];
            a = silu_f(a) * scale; if (i < 4) o0[i] = a; else o1[i - 4] = a; }
        out[pp] = pack8(o0, o1); }
}
__device__ __forceinline__ void load_raw7(const bf16_t* src, size_t ld, int rbase, int tbase, int len, u32x4 (&raw)[7]) {
#pragma unroll
    for (int k = 0; k < 7; ++k) { const int t = tbase + k; const bool ok = (t >= 0) && (t < len); const int tc = t < 0 ? 0 : (t >= len ? len - 1 : t);
        u32x4 a = *(const u32x4*)(src + (size_t)(rbase + tc) * ld);
        if (!ok) a = (u32x4){0u, 0u, 0u, 0u};
        raw[k] = a; }
}
template <class F>
__device__ __forceinline__ void tile_transpose_out(const LAS bf16_t* tile, int ldsw, int ncol, int tid, F rowptr) {
    for (int q = tid; q < ncol * 8; q += NTHR) { const int c = q % ncol, sc = q / ncol;
        unsigned v[8];
#pragma unroll
        for (int i = 0; i < 8; ++i) v[i] = tile[(sc * 8 + i) * ldsw + c];
        u32x4 w; w.x = v[0] | (v[1] << 16); w.y = v[2] | (v[3] << 16); w.z = v[4] | (v[5] << 16); w.w = v[6] | (v[7] << 16);
        *(u32x4*)(rowptr(c) + sc * 8) = w; }
}

__device__ __forceinline__ void conv_m_item(const Params& p, int l, int item, LAS unsigned char* lds) {
    const int tid = tid_fresh(), gc = item >> 2, hd = item & 3;
    int rbase, n0, len; chunk_geom(gc, rbase, n0, len);
    const int cs = tid & 31, tg = tid >> 5, d0 = cs * 8, i0 = tg * 4;
    const float* cw = p.mconv_w + (size_t)l * 4 * 2048; const float* cb = p.mconv_b + (size_t)l * 2048;
    LAS bf16_t* Kl = (LAS bf16_t*)lds; LAS bf16_t* Vl = (LAS bf16_t*)(lds + 64 * 528);
    __syncthreads();
    { u32x4 raw[7], o[4];
      load_raw7((const bf16_t*)(p.ws + WS_Q) + hd * 256 + d0, 1024, rbase, n0 + i0 - 2, len, raw);
      conv8x4(raw, cw, cb, hd * 256 + d0, 1.0f, o);
#pragma unroll
      for (int pp = 0; pp < 4; ++pp) *(u32x4*)((bf16_t*)(p.ws + WS_QC) + (size_t)(rbase + n0 + i0 + pp) * 1024 + hd * 256 + d0) = o[pp];
      load_raw7((const bf16_t*)(p.ws + WS_K) + hd * 256 + d0, 1024, rbase, n0 + i0 - 2, len, raw);
      conv8x4(raw, cw, cb, 1024 + hd * 256 + d0, 0.0625f, o);
#pragma unroll
      for (int pp = 0; pp < 4; ++pp) { *(u32x4*)((bf16_t*)(p.ws + WS_KC) + (size_t)(rbase + n0 + i0 + pp) * 1024 + hd * 256 + d0) = o[pp];
          *(LAS u32x4*)((LAS unsigned char*)Kl + (i0 + pp) * 528 + d0 * 2) = o[pp]; } }
#pragma unroll
    for (int j = 0; j < 4; ++j) { const int q = tid + NTHR * j, row = q >> 5, ch = q & 31;
        *(LAS u32x4*)((LAS unsigned char*)Vl + row * 528 + ch * 16) = *(const u32x4*)((const bf16_t*)(p.ws + WS_V) + (size_t)(rbase + n0 + row) * 1024 + hd * 256 + ch * 8); }
    __syncthreads();
    if ((tid >> 6) < 2) {
        const int dir = tid >> 6, lane = tid & 63, j = dir ? 63 - lane : lane;
        const float* g = (const float*)(p.ws + WS_GA) + (size_t)(rbase + n0 + j) * 16;
        const float ig = g[dir * 4 + hd] + p.mgate_b[l * 16 + dir * 4 + hd], lf = logsigmoid_f(g[(2 + dir) * 4 + hd] + p.mgate_b[l * 16 + (2 + dir) * 4 + hd]);
        const float cum = wave_incl_sum(lf, lane), a = ig - cum, pm = wave_incl_max(a, lane);
        const size_t o = (size_t)(gc * 8 + dir * 4 + hd) * 64 + j;
        ((float*)(p.ws + WS_MGA))[o] = a; ((float*)(p.ws + WS_MGC))[o] = cum; ((float*)(p.ws + WS_MGP))[o] = pm;
    }
    bf16_t* kct = (bf16_t*)(p.ws + WS_KCT) + (size_t)(gc * 4 + hd) * 16384; bf16_t* vt = (bf16_t*)(p.ws + WS_VT) + (size_t)(gc * 4 + hd) * 16384;
    tile_transpose_out(Kl, 264, 256, tid, [&](int c) { return kct + c * 64; });
    tile_transpose_out(Vl, 264, 256, tid, [&](int c) { return vt + c * 64; });
}

__device__ __forceinline__ void conv_s_item(const Params& p, int l, int item, LAS unsigned char* lds) {
    const int tid = tid_fresh(), gc = item >> 2, grp = item & 3;
    int rbase, n0, len; chunk_geom(gc, rbase, n0, len);
    const int cs = tid & 31, tg = tid >> 5, i0 = tg * 4;
    const float* cw = p.sconv_w + (size_t)l * 4 * 2048; const float* cb = p.sconv_b + (size_t)l * 2048;
    LAS bf16_t* Bl = (LAS bf16_t*)lds; LAS bf16_t* Xl = (LAS bf16_t*)(lds + 64 * 272);
    __syncthreads();
    { u32x4 raw[7], o[4];
      const int isC = cs >> 4, nn = (cs & 15) * 8;
      load_raw7((const bf16_t*)(p.ws + (isC ? WS_SC : WS_SB)) + grp * 128 + nn, 512, rbase, n0 + i0 - 2, len, raw);
      conv8x4(raw, cw, cb, 1024 + isC * 512 + grp * 128 + nn, 1.0f, o);
      bf16_t* dst = (bf16_t*)(p.ws + (isC ? WS_CC : WS_BC)) + grp * 128 + nn;
#pragma unroll
      for (int pp = 0; pp < 4; ++pp) { *(u32x4*)(dst + (size_t)(rbase + n0 + i0 + pp) * 512) = o[pp];
          if (!isC) *(LAS u32x4*)((LAS unsigned char*)Bl + (i0 + pp) * 272 + nn * 2) = o[pp]; }
      load_raw7((const bf16_t*)(p.ws + WS_SX) + grp * 256 + cs * 8, 1024, rbase, n0 + i0 - 2, len, raw);
      conv8x4(raw, cw, cb, grp * 256 + cs * 8, 1.0f, o);
#pragma unroll
      for (int pp = 0; pp < 4; ++pp) *(LAS u32x4*)((LAS unsigned char*)Xl + (i0 + pp) * 528 + cs * 16) = o[pp]; }
    __syncthreads();
    { const int wv = tid >> 6, lane = tid & 63, dir = wv >> 2, hd = grp * 4 + (wv & 3), j = dir ? 63 - lane : lane;
      const float dtv = softplus_f(((const float*)(p.ws + WS_DT))[(size_t)(rbase + n0 + j) * 32 + dir * 16 + hd] + p.sdt_bias[l * 32 + dir * 16 + hd]);
      const float acs = wave_incl_sum(dtv * -__expf(p.sa_log[l * 32 + dir * 16 + hd]), lane);
      const size_t o = (size_t)(gc * 32 + dir * 16 + hd) * 64 + j;
      ((float*)(p.ws + WS_SACS))[o] = acs; ((float*)(p.ws + WS_SDT))[o] = dtv; }
    bf16_t* bct = (bf16_t*)(p.ws + WS_BCT) + (size_t)(gc * 4 + grp) * 8192; bf16_t* xct = (bf16_t*)(p.ws + WS_XCT) + (size_t)(gc * 16 + grp * 4) * 4096;
    tile_transpose_out(Bl, 136, 128, tid, [&](int c) { return bct + c * 64; });
    tile_transpose_out(Xl, 264, 256, tid, [&](int c) { return xct + c * 64; });
}

__device__ __forceinline__ void pool_window_item(const Params& p, int it, LAS unsigned char* lds) {
    const int tid = tid_fresh();
    bf16_t* BR = (bf16_t*)(p.ws + WS_BR);
    __syncthreads();
    if (it < 256) {
        const int row0 = MC + it * 64;
        for (int q = tid; q < 64 * 128; q += NTHR) { const int r = q >> 7, ch = q & 127;
            *(LAS u32x4*)(lds + q * 16) = *(const u32x4*)(BR + (size_t)(row0 + r) * 3072 + ch * 8); }
        __syncthreads();
        for (int q = tid; q < 64 * 128; q += NTHR) { const int r = q >> 7, ch = q & 127, w = 2 << (ch >> 5);
            int lo = r - (w >> 1), hi = lo + w - 1; lo = lo < 0 ? 0 : lo; hi = hi > 63 ? 63 : hi;
            float s[8] = {0, 0, 0, 0, 0, 0, 0, 0}, self[8];
            for (int rr = lo; rr <= hi; ++rr) { float f[8]; unpack8(*(const LAS u32x4*)(lds + (rr * 128 + ch) * 16), f);
#pragma unroll
                for (int j = 0; j < 8; ++j) s[j] += f[j]; }
            unpack8(*(const LAS u32x4*)(lds + q * 16), self);
            const float inv = __builtin_amdgcn_rcpf((float)(hi - lo + 1)); f32x4 a, b;
#pragma unroll
            for (int j = 0; j < 4; ++j) { a[j] = s[j] * inv - self[j]; b[j] = s[4 + j] * inv - self[4 + j]; }
            *(u32x4*)(BR + (size_t)(row0 + r) * 3072 + ch * 8) = pack8(a, b); }
    } else {
        const int bb = (it - 256) >> 2, g = (it - 256) & 3, row0 = bb * 256, w = 2 << g;
        for (int q = tid; q < 256 * 32; q += NTHR) { const int r = q >> 5, ch = q & 31;
            *(LAS u32x4*)(lds + q * 16) = *(const u32x4*)(BR + (size_t)(row0 + r) * 3072 + g * 256 + ch * 8); }
        __syncthreads();
        for (int q = tid; q < 256 * 32; q += NTHR) { const int r = q >> 5, ch = q & 31;
            int lo = r - (w >> 1), hi = lo + w - 1; lo = lo < 0 ? 0 : lo; hi = hi > 255 ? 255 : hi;
            float s[8] = {0, 0, 0, 0, 0, 0, 0, 0}, self[8];
            for (int rr = lo; rr <= hi; ++rr) { float f[8]; unpack8(*(const LAS u32x4*)(lds + (rr * 32 + ch) * 16), f);
#pragma unroll
                for (int j = 0; j < 8; ++j) s[j] += f[j]; }
            unpack8(*(const LAS u32x4*)(lds + q * 16), self);
            const float inv = __builtin_amdgcn_rcpf((float)(hi - lo + 1)); f32x4 a, b;
#pragma unroll
            for (int j = 0; j < 4; ++j) { a[j] = s[j] * inv - self[j]; b[j] = s[4 + j] * inv - self[4 + j]; }
            *(u32x4*)(BR + (size_t)(row0 + r) * 3072 + g * 256 + ch * 8) = pack8(a, b); }
    }
    __syncthreads();
}

constexpr int ML_VT = 0, ML_VWT = 5280, ML_CT = 10560, ML_Q = 28512, ML_K = 63328, ML_KT = 98144, ML_A = 139104, ML_MISC = 149344;
__device__ __forceinline__ void mlstm_chunk_item(const Params& p, int l, int item, LAS unsigned char* lds) {
    const int tid = tid_fresh(), lane = tid & 63, wid = __builtin_amdgcn_readfirstlane(tid >> 6), fr = lane & 15, fq = lane >> 4;
    const int b = item >> 6, hd = (item >> 4) & 3, dir = (item >> 3) & 1, eg = item & 7;
    const bf16_t* QC = (const bf16_t*)(p.ws + WS_QC); const bf16_t* KC = (const bf16_t*)(p.ws + WS_KC);
    const bf16_t* KCT = (const bf16_t*)(p.ws + WS_KCT); const bf16_t* VT = (const bf16_t*)(p.ws + WS_VT);
    const float* GAa = (const float*)(p.ws + WS_MGA); const float* GCc = (const float*)(p.ws + WS_MGC); const float* GPp = (const float*)(p.ws + WS_MGP);
    bf16_t* OUT = (bf16_t*)(p.ws + (dir ? WS_HB2 : WS_HF2));
    const int ti = wid >> 1, wh = wid & 1;
    __syncthreads();
    for (int i = tid; i < 17952 / 4; i += NTHR) ((LAS unsigned*)(lds + ML_CT))[i] = 0u;
    if (tid < 64) ((LAS bf16_t*)(lds + ML_VT + 32 * 160))[tid] = (bf16_t)0x3F80;
    f32x4 Cacc[2][3];
#pragma unroll
    for (int j = 0; j < 2; ++j)
#pragma unroll
        for (int e = 0; e < 3; ++e) Cacc[j][e] = (f32x4){0.f, 0.f, 0.f, 0.f};
    float m_st = 0.f;
    f32x4 ca0 = (f32x4){0.f, 0.f, 0.f, 0.f}, ca1 = ca0, caw = ca0, cP4 = ca0, cC4 = ca0; float cPt = 0.f, cPl = 0.f, cCl = 0.f;
    const int gs0 = 16 * (2 * wh) + 4 * fq, gs4 = (tid & 15) * 4, gt = 16 * ti + fr, gt0 = 16 * ti + 4 * fq, jl = dir ? 0 : 63;
    __syncthreads();
    for (int c = -1; c < 68; ++c) {
        const int cn = c + 1;
        u32x4 rq[4], rk[4], rt[4], rv = (u32x4){0u, 0u, 0u, 0u};
        f32x4 na0 = (f32x4){0.f, 0.f, 0.f, 0.f}, na1 = na0, naw = na0, nP4 = na0, nC4 = na0; float nPt = 0.f, nPl = 0.f, nCl = 0.f;
#pragma unroll
        for (int j = 0; j < 4; ++j) { rq[j] = (u32x4){0u, 0u, 0u, 0u}; rk[j] = rq[j]; rt[j] = rq[j]; }
        if (cn < 68) {
            const int cin = cn < 4 ? (dir ? 3 - cn : cn) : 4 + (dir ? 67 - cn : cn - 4), gc = b * 68 + cin;
            int rbase, n0, len; chunk_geom(gc, rbase, n0, len);
#pragma unroll
            for (int j = 0; j < 4; ++j) { const int q = tid + NTHR * j;
                const size_t ro = (size_t)(rbase + n0 + (q >> 5)) * 1024 + hd * 256 + (q & 31) * 8;
                rq[j] = *(const u32x4*)(QC + ro); rk[j] = *(const u32x4*)(KC + ro);
                rt[j] = *(const u32x4*)(KCT + (size_t)(gc * 4 + hd) * 16384 + (size_t)q * 8); }
            if (tid < 256) rv = *(const u32x4*)(VT + ((size_t)(gc * 4 + hd) * 256 + eg * 32) * 64 + (size_t)tid * 8);
            { const size_t gb = (size_t)(gc * 8 + dir * 4 + hd) * 64;
              na0 = *(const f32x4*)(GAa + gb + gs0); na1 = *(const f32x4*)(GAa + gb + gs0 + 16); naw = *(const f32x4*)(GAa + gb + gs4);
              nP4 = *(const f32x4*)(GPp + gb + gt0); nC4 = *(const f32x4*)(GCc + gb + gt0); nPt = GPp[gb + gt]; nPl = GPp[gb + jl]; nCl = GCc[gb + jl]; }
        }
        if (c >= 0) {
            const int cin = c < 4 ? (dir ? 3 - c : c) : 4 + (dir ? 67 - c : c - 4), gc = b * 68 + cin;
            int rbase, n0, len; chunk_geom(gc, rbase, n0, len);
            {
                f32x4 st[2] = {(f32x4){0.f, 0.f, 0.f, 0.f}, (f32x4){0.f, 0.f, 0.f, 0.f}};
                const LAS unsigned char* qb = lds + ML_Q + (16 * ti + fr) * 544 + fq * 16;
                const LAS unsigned char* kb0 = lds + ML_K + (16 * (2 * wh) + fr) * 544 + fq * 16;
                bf16x8 qf[4], k0f[4], k1f[4];
#pragma unroll
                for (int hb = 0; hb < 2; ++hb) {
#pragma unroll
                    for (int kd = 0; kd < 4; ++kd) { qf[kd] = *(const LAS bf16x8*)(qb + (4 * hb + kd) * 64); k0f[kd] = *(const LAS bf16x8*)(kb0 + (4 * hb + kd) * 64); k1f[kd] = *(const LAS bf16x8*)(kb0 + 16 * 544 + (4 * hb + kd) * 64); }
                    __builtin_amdgcn_sched_barrier(0);
#pragma unroll
                    for (int kd = 0; kd < 4; ++kd) {
                        st[0] = __builtin_amdgcn_mfma_f32_16x16x32_bf16(k0f[kd], qf[kd], st[0], 0, 0, 0);
                        st[1] = __builtin_amdgcn_mfma_f32_16x16x32_bf16(k1f[kd], qf[kd], st[1], 0, 0, 0);
                    }
                    __builtin_amdgcn_sched_barrier(0);
                }
                const int t = 16 * ti + fr; const float Mt = fmaxf(m_st, cPt), M63 = fmaxf(m_st, cPl);
#pragma unroll
                for (int j = 0; j < 2; ++j) { const int s0 = 16 * (2 * wh + j) + 4 * fq; const f32x4 av = j ? ca1 : ca0;
                    f32x4 o;
#pragma unroll
                    for (int r = 0; r < 4; ++r) { const bool keep = dir ? (s0 + r >= t) : (s0 + r <= t); o[r] = keep ? st[j][r] * __expf(av[r] - Mt) : 0.f; }
                    *(LAS u32x2*)(lds + ML_A + t * 160 + s0 * 2) = pack4(o); }
                { const int e = tid >> 4, s4 = (tid & 15) * 4; const u32x2 v = *(const LAS u32x2*)(lds + ML_VT + e * 160 + s4 * 2);
                  f32x4 w; w[0] = __expf(caw[0] - M63); w[1] = __expf(caw[1] - M63); w[2] = __expf(caw[2] - M63); w[3] = __expf(caw[3] - M63);
                  f32x4 o; o[0] = lo16(v.x) * w[0]; o[1] = hi16(v.x) * w[1]; o[2] = lo16(v.y) * w[2]; o[3] = hi16(v.y) * w[3];
                  *(LAS u32x2*)(lds + ML_VWT + e * 160 + s4 * 2) = pack4(o);
                  if (tid < 16) *(LAS u32x2*)(lds + ML_VWT + 32 * 160 + s4 * 2) = pack4(w); }
            }
            __syncthreads();
            {
                f32x4 n1o = (f32x4){0.f, 0.f, 0.f, 0.f}, n1a = n1o, n2o = n1o, n2a = n1o;
                const LAS unsigned char* ab = lds + ML_A + (16 * ti + fr) * 160 + fq * 16;
                const LAS unsigned char* vo = lds + ML_VT + (16 * wh + fr) * 160 + fq * 16;
                const LAS unsigned char* va = lds + ML_VT + (32 + fr) * 160 + fq * 16;
                const LAS unsigned char* qb = lds + ML_Q + (16 * ti + fr) * 544 + fq * 16;
                const LAS unsigned char* co = lds + ML_CT + (16 * wh + fr) * 544 + fq * 16;
                const LAS unsigned char* ca = lds + ML_CT + (32 + fr) * 544 + fq * 16;
                bf16x8 af[2], vof[2], vaf[2], qf[4], cof[4], caf[4];
#pragma unroll
                for (int ks = 0; ks < 2; ++ks) { af[ks] = *(const LAS bf16x8*)(ab + ks * 64); vof[ks] = *(const LAS bf16x8*)(vo + ks * 64); vaf[ks] = *(const LAS bf16x8*)(va + ks * 64); }
#pragma unroll
                for (int kd = 0; kd < 4; ++kd) { qf[kd] = *(const LAS bf16x8*)(qb + kd * 64); cof[kd] = *(const LAS bf16x8*)(co + kd * 64); caf[kd] = *(const LAS bf16x8*)(ca + kd * 64); }
                __builtin_amdgcn_sched_barrier(0);
#pragma unroll
                for (int ks = 0; ks < 2; ++ks) {
                    n1o = __builtin_amdgcn_mfma_f32_16x16x32_bf16(af[ks], vof[ks], n1o, 0, 0, 0);
                    n1a = __builtin_amdgcn_mfma_f32_16x16x32_bf16(af[ks], vaf[ks], n1a, 0, 0, 0); }
#pragma unroll
                for (int kd = 0; kd < 4; ++kd) {
                    n2o = __builtin_amdgcn_mfma_f32_16x16x32_bf16(qf[kd], cof[kd], n2o, 0, 0, 0);
                    n2a = __builtin_amdgcn_mfma_f32_16x16x32_bf16(qf[kd], caf[kd], n2a, 0, 0, 0); }
                __builtin_amdgcn_sched_barrier(0);
#pragma unroll
                for (int kd = 0; kd < 4; ++kd) { qf[kd] = *(const LAS bf16x8*)(qb + (4 + kd) * 64); cof[kd] = *(const LAS bf16x8*)(co + (4 + kd) * 64); caf[kd] = *(const LAS bf16x8*)(ca + (4 + kd) * 64); }
                __builtin_amdgcn_sched_barrier(0);
#pragma unroll
                for (int kd = 0; kd < 4; ++kd) {
                    n2o = __builtin_amdgcn_mfma_f32_16x16x32_bf16(qf[kd], cof[kd], n2o, 0, 0, 0);
                    n2a = __builtin_amdgcn_mfma_f32_16x16x32_bf16(qf[kd], caf[kd], n2a, 0, 0, 0); }
                const int t0 = 16 * ti + 4 * fq;
                f32x4 sgv, emv;
#pragma unroll
                for (int r = 0; r < 4; ++r) { const float Mr = fmaxf(m_st, cP4[r]); sgv[r] = __expf(m_st - Mr); emv[r] = __expf(-(cC4[r] + Mr)); }
                const bool wr_out = !(l == 1 && cin < 4);
#pragma unroll
                for (int r = 0; r < 4; ++r) {
                    const float den = __shfl(n1a[r] + sgv[r] * n2a[r], lane & 48);
                    const float hv = (n1o[r] + sgv[r] * n2o[r]) * __builtin_amdgcn_rcpf(fmaxf(fabsf(den), emv[r]));
                    if (wr_out) OUT[(size_t)(rbase + n0 + t0 + r) * 1024 + hd * 256 + eg * 32 + 16 * wh + fr] = (bf16_t)f2bf(hv);
                }
                const float decay = __expf(m_st - fmaxf(m_st, cPl));
#pragma unroll
                for (int j = 0; j < 2; ++j)
#pragma unroll
                    for (int e = 0; e < 3; ++e) Cacc[j][e] = Cacc[j][e] * decay;
                const LAS unsigned char* kt = lds + ML_KT + (16 * (2 * wid) + fr) * 160 + fq * 16;
                const LAS unsigned char* vw = lds + ML_VWT + fr * 160 + fq * 16;
                bf16x8 k0f[2], k1f[2], v0f[2], v1f[2], v2f[2];
#pragma unroll
                for (int ks = 0; ks < 2; ++ks) { k0f[ks] = *(const LAS bf16x8*)(kt + ks * 64); k1f[ks] = *(const LAS bf16x8*)(kt + 16 * 160 + ks * 64);
                    v0f[ks] = *(const LAS bf16x8*)(vw + ks * 64); v1f[ks] = *(const LAS bf16x8*)(vw + 16 * 160 + ks * 64); v2f[ks] = *(const LAS bf16x8*)(vw + 32 * 160 + ks * 64); }
                __builtin_amdgcn_sched_barrier(0);
#pragma unroll
                for (int ks = 0; ks < 2; ++ks) {
                    Cacc[0][0] = __builtin_amdgcn_mfma_f32_16x16x32_bf16(k0f[ks], v0f[ks], Cacc[0][0], 0, 0, 0);
                    Cacc[0][1] = __builtin_amdgcn_mfma_f32_16x16x32_bf16(k0f[ks], v1f[ks], Cacc[0][1], 0, 0, 0);
                    Cacc[0][2] = __builtin_amdgcn_mfma_f32_16x16x32_bf16(k0f[ks], v2f[ks], Cacc[0][2], 0, 0, 0);
                    Cacc[1][0] = __builtin_amdgcn_mfma_f32_16x16x32_bf16(k1f[ks], v0f[ks], Cacc[1][0], 0, 0, 0);
                    Cacc[1][1] = __builtin_amdgcn_mfma_f32_16x16x32_bf16(k1f[ks], v1f[ks], Cacc[1][1], 0, 0, 0);
                    Cacc[1][2] = __builtin_amdgcn_mfma_f32_16x16x32_bf16(k1f[ks], v2f[ks], Cacc[1][2], 0, 0, 0);
                }
            }
            __syncthreads();
#pragma unroll
            for (int j = 0; j < 2; ++j) { const int dcol = (16 * (2 * wid + j) + 4 * fq) * 2;
                *(LAS u32x2*)(lds + ML_CT + fr * 544 + dcol) = pack4(Cacc[j][0]);
                *(LAS u32x2*)(lds + ML_CT + (16 + fr) * 544 + dcol) = pack4(Cacc[j][1]);
                if (fr == 0) *(LAS u32x2*)(lds + ML_CT + 32 * 544 + dcol) = pack4(Cacc[j][2]); }
        }
        if (c >= 0) m_st = cCl + fmaxf(m_st, cPl);
        ca0 = na0; ca1 = na1; caw = naw; cP4 = nP4; cC4 = nC4; cPt = nPt; cPl = nPl; cCl = nCl;
        if (cn < 68) {
#pragma unroll
            for (int j = 0; j < 4; ++j) { const int q = tid + NTHR * j;
                *(LAS u32x4*)(lds + ML_Q + (q >> 5) * 544 + (q & 31) * 16) = rq[j];
                *(LAS u32x4*)(lds + ML_K + (q >> 5) * 544 + (q & 31) * 16) = rk[j];
                *(LAS u32x4*)(lds + ML_KT + (q >> 3) * 160 + (q & 7) * 16) = rt[j]; }
            if (tid < 256) *(LAS u32x4*)(lds + ML_VT + (tid >> 3) * 160 + (tid & 7) * 16) = rv;
        }
        __syncthreads();
    }
}

constexpr int SS_C = 0, SS_B = 18432, SS_BT = 36864, SS_XT = 57344, SS_XWT = 62464, SS_G = 67584, SS_S = 77824, SS_XRT = 87040, SS_MISC = 92160;
__device__ __forceinline__ void ssd_chunk_item(const Params& p, int l, int item, LAS unsigned char* lds) {
    const int tid = tid_fresh(), lane = tid & 63, wid = __builtin_amdgcn_readfirstlane(tid >> 6), fr = lane & 15, fq = lane >> 4;
    const int b = item >> 6, hd = (item >> 2) & 15, dir = (item >> 1) & 1, ps = item & 1, grp = hd >> 2;
    const bf16_t* BC = (const bf16_t*)(p.ws + WS_BC); const bf16_t* CC = (const bf16_t*)(p.ws + WS_CC);
    const bf16_t* BCT = (const bf16_t*)(p.ws + WS_BCT); const bf16_t* XCT = (const bf16_t*)(p.ws + WS_XCT);
    const float* ACS = (const float*)(p.ws + WS_SACS); const float* SDT = (const float*)(p.ws + WS_SDT);
    bf16_t* OUT = (bf16_t*)(p.ws + (dir ? WS_YB : WS_YF));
    const float dskip = p.sd[l * 16 + hd];
    const int ti = wid >> 1, wh = wid & 1;
    LAS float* cvscr = (LAS float*)(lds + SS_MISC) + wid * (32 * 65);
    const int cv_gw = blockIdx.x * 8 + wid, cv_ph = 0;
    __syncthreads();
    for (int i = tid; i < 9216 / 4; i += NTHR) ((LAS unsigned*)(lds + SS_S))[i] = 0u;
    f32x4 Sacc[2] = {(f32x4){0.f, 0.f, 0.f, 0.f}, (f32x4){0.f, 0.f, 0.f, 0.f}};
    f32x4 cs0 = (f32x4){0.f, 0.f, 0.f, 0.f}, cs1 = cs0, csw = cs0, cdw = cs0, ct4 = cs0; float cat = 0.f, cal = 0.f;
    const int gs0 = 16 * (2 * wh) + 4 * fq, gs4 = (tid & 15) * 4, gt = 16 * ti + fr, gt0 = 16 * ti + 4 * fq, jl = dir ? 0 : 63;
    __syncthreads();
    for (int c = -1; c < 68; ++c) {
        const int cn = c + 1;
        u32x4 rc[2], rb[2], rt[2], rx = (u32x4){0u, 0u, 0u, 0u};
        f32x4 ns0 = (f32x4){0.f, 0.f, 0.f, 0.f}, ns1 = ns0, nsw = ns0, ndw = ns0, nt4 = ns0; float nat = 0.f, nal = 0.f;
        f32x4 cvv[8]; TrDesc cvd; cvd.valid = 0;
        { const int itc = c + 1, jj = itc / 5, m = cv_gw + 2048 * jj;
          if (CV_IN_SCAN && (itc % 5) == cv_ph && jj < 12 && m < 2 * CV_EXP_ITEMS && gridDim.x == 256) { cvmicro_load(p, l, m, lane, cvv, cvd); cvd.valid = 1 + m; } }
#pragma unroll
        for (int j = 0; j < 2; ++j) { rc[j] = (u32x4){0u, 0u, 0u, 0u}; rb[j] = rc[j]; rt[j] = rc[j]; }
        if (cn < 68) {
            const int cin = cn < 4 ? (dir ? 3 - cn : cn) : 4 + (dir ? 67 - cn : cn - 4), gc = b * 68 + cin;
            int rbase, n0, len; chunk_geom(gc, rbase, n0, len);
#pragma unroll
            for (int j = 0; j < 2; ++j) { const int q = tid + NTHR * j;
                const size_t ro = (size_t)(rbase + n0 + (q >> 4)) * 512 + grp * 128 + (q & 15) * 8;
                rc[j] = *(const u32x4*)(CC + ro); rb[j] = *(const u32x4*)(BC + ro);
                rt[j] = *(const u32x4*)(BCT + (size_t)(gc * 4 + grp) * 8192 + (size_t)q * 8); }
            if (tid < 256) rx = *(const u32x4*)(XCT + ((size_t)(gc * 16 + hd) * 64 + ps * 32) * 64 + (size_t)tid * 8);
            { const size_t gb = (size_t)(gc * 32 + dir * 16 + hd) * 64;
              ns0 = *(const f32x4*)(ACS + gb + gs0); ns1 = *(const f32x4*)(ACS + gb + gs0 + 16); nsw = *(const f32x4*)(ACS + gb + gs4); ndw = *(const f32x4*)(SDT + gb + gs4);
              nt4 = *(const f32x4*)(ACS + gb + gt0); nat = ACS[gb + gt]; nal = ACS[gb + jl]; }
        }
        if (c >= 0) {
            const int cin = c < 4 ? (dir ? 3 - c : c) : 4 + (dir ? 67 - c : c - 4), gc = b * 68 + cin;
            int rbase, n0, len; chunk_geom(gc, rbase, n0, len);
            {
                f32x4 st[2] = {(f32x4){0.f, 0.f, 0.f, 0.f}, (f32x4){0.f, 0.f, 0.f, 0.f}};
                const LAS unsigned char* cbp = lds + SS_C + (16 * ti + fr) * 288 + fq * 16;
                const LAS unsigned char* bb0 = lds + SS_B + (16 * (2 * wh) + fr) * 288 + fq * 16;
#pragma unroll
                for (int kn = 0; kn < 4; ++kn) {
                    const bf16x8 cf = *(const LAS bf16x8*)(cbp + kn * 64);
                    const bf16x8 b0 = *(const LAS bf16x8*)(bb0 + kn * 64), b1 = *(const LAS bf16x8*)(bb0 + 16 * 288 + kn * 64);
                    st[0] = __builtin_amdgcn_mfma_f32_16x16x32_bf16(b0, cf, st[0], 0, 0, 0);
                    st[1] = __builtin_amdgcn_mfma_f32_16x16x32_bf16(b1, cf, st[1], 0, 0, 0);
                }
                const int t = 16 * ti + fr; const float at = cat;
#pragma unroll
                for (int j = 0; j < 2; ++j) { const int s0 = 16 * (2 * wh + j) + 4 * fq; const f32x4 av = j ? cs1 : cs0;
                    f32x4 o;
#pragma unroll
                    for (int r = 0; r < 4; ++r) { const bool keep = dir ? (s0 + r >= t) : (s0 + r <= t); o[r] = keep ? st[j][r] * __expf(at - av[r]) : 0.f; }
                    *(LAS u32x2*)(lds + SS_G + t * 160 + s0 * 2) = pack4(o); }
                { const int e = tid >> 4, s4 = (tid & 15) * 4; const u32x2 v = *(const LAS u32x2*)(lds + SS_XRT + e * 160 + s4 * 2);
                  const f32x4 dv = cdw; f32x4 w; w[0] = __expf(cal - csw[0]); w[1] = __expf(cal - csw[1]); w[2] = __expf(cal - csw[2]); w[3] = __expf(cal - csw[3]);
                  f32x4 o; o[0] = lo16(v.x) * dv[0]; o[1] = hi16(v.x) * dv[1]; o[2] = lo16(v.y) * dv[2]; o[3] = hi16(v.y) * dv[3];
                  *(LAS u32x2*)(lds + SS_XT + e * 160 + s4 * 2) = pack4(o);
                  *(LAS u32x2*)(lds + SS_XWT + e * 160 + s4 * 2) = pack4(o * w); }
            }
            __syncthreads();
            {
                f32x4 y1 = (f32x4){0.f, 0.f, 0.f, 0.f}, y2 = y1;
                const LAS unsigned char* gb = lds + SS_G + (16 * ti + fr) * 160 + fq * 16;
                const LAS unsigned char* xb = lds + SS_XT + (16 * wh + fr) * 160 + fq * 16;
#pragma unroll
                for (int ks = 0; ks < 2; ++ks) y1 = __builtin_amdgcn_mfma_f32_16x16x32_bf16(*(const LAS bf16x8*)(gb + ks * 64), *(const LAS bf16x8*)(xb + ks * 64), y1, 0, 0, 0);
                const LAS unsigned char* cbp = lds + SS_C + (16 * ti + fr) * 288 + fq * 16;
                const LAS unsigned char* sb = lds + SS_S + (16 * wh + fr) * 288 + fq * 16;
#pragma unroll
                for (int kn = 0; kn < 4; ++kn) y2 = __builtin_amdgcn_mfma_f32_16x16x32_bf16(*(const LAS bf16x8*)(cbp + kn * 64), *(const LAS bf16x8*)(sb + kn * 64), y2, 0, 0, 0);
                const int t0 = 16 * ti + 4 * fq;
                f32x4 eav; eav[0] = __expf(ct4[0]); eav[1] = __expf(ct4[1]); eav[2] = __expf(ct4[2]); eav[3] = __expf(ct4[3]);
                const u32x2 xs = *(const LAS u32x2*)(lds + SS_XRT + (16 * wh + fr) * 160 + t0 * 2);
                const float xv[4] = {lo16(xs.x), hi16(xs.x), lo16(xs.y), hi16(xs.y)};
                const bool wr_out = !(l == 1 && cin < 4);
#pragma unroll
                for (int r = 0; r < 4; ++r) {
                    float yv = y1[r] + eav[r] * y2[r];
                    if (dir == 0) yv += dskip * xv[r];
                    if (wr_out) OUT[(size_t)(rbase + n0 + t0 + r) * 1024 + hd * 64 + ps * 32 + 16 * wh + fr] = (bf16_t)f2bf(yv);
                }
                const float dec = __expf(cal);
                Sacc[0] = Sacc[0] * dec; Sacc[1] = Sacc[1] * dec;
                const LAS unsigned char* bt = lds + SS_BT + (16 * wid + fr) * 160 + fq * 16;
                const LAS unsigned char* xw = lds + SS_XWT + fr * 160 + fq * 16;
#pragma unroll
                for (int ks = 0; ks < 2; ++ks) { const bf16x8 bf = *(const LAS bf16x8*)(bt + ks * 64);
                    Sacc[0] = __builtin_amdgcn_mfma_f32_16x16x32_bf16(bf, *(const LAS bf16x8*)(xw + ks * 64), Sacc[0], 0, 0, 0);
                    Sacc[1] = __builtin_amdgcn_mfma_f32_16x16x32_bf16(bf, *(const LAS bf16x8*)(xw + 16 * 160 + ks * 64), Sacc[1], 0, 0, 0); }
            }
            __syncthreads();
            { const int ncol = (16 * wid + 4 * fq) * 2;
              *(LAS u32x2*)(lds + SS_S + fr * 288 + ncol) = pack4(Sacc[0]);
              *(LAS u32x2*)(lds + SS_S + (16 + fr) * 288 + ncol) = pack4(Sacc[1]); }
        }
        cs0 = ns0; cs1 = ns1; csw = nsw; cdw = ndw; ct4 = nt4; cat = nat; cal = nal;
        if (cvd.valid) cvmicro_store(cvd, cvd.valid - 1, cvv, cvscr, lane);
        if (cn < 68) {
#pragma unroll
            for (int j = 0; j < 2; ++j) { const int q = tid + NTHR * j;
                *(LAS u32x4*)(lds + SS_C + (q >> 4) * 288 + (q & 15) * 16) = rc[j];
                *(LAS u32x4*)(lds + SS_B + (q >> 4) * 288 + (q & 15) * 16) = rb[j];
                *(LAS u32x4*)(lds + SS_BT + (q >> 3) * 160 + (q & 7) * 16) = rt[j]; }
            if (tid < 256) *(LAS u32x4*)(lds + SS_XRT + (tid >> 3) * 160 + (tid & 7) * 16) = rx;
        }
        __syncthreads();
    }
}

__device__ __forceinline__ void mlstm_finish_rows(const Params& p, int l, int row_lo, int gw, int ngw) {
    if (p.dup) return;
    const int lane = tid_fresh() & 63;
    const bf16_t* HF = (const bf16_t*)(p.ws + WS_HF2); const bf16_t* HB = (const bf16_t*)(p.ws + WS_HB2);
    bf16_t* BR = (bf16_t*)(p.ws + WS_BR);
    const float* ng = p.mnorm_g + l * 1024;
    int row = row_lo + gw;
    u32x2 ca[4], cb[4], co[4], na[4], nbv[4], no[4];
    if (row < MT) { const size_t so = (size_t)scanrow(row) * 1024;
#pragma unroll
        for (int hd = 0; hd < 4; ++hd) { const int c = hd * 256 + 4 * lane; ca[hd] = *(const u32x2*)(HF + so + c); cb[hd] = *(const u32x2*)(HB + so + c); co[hd] = *(const u32x2*)(BR + (size_t)row * 3072 + 1024 + c); } }
    for (; row < MT; row += ngw) {
        const int rn = row + ngw;
        if (rn < MT) { const size_t so = (size_t)scanrow(rn) * 1024;
#pragma unroll
            for (int hd = 0; hd < 4; ++hd) { const int c = hd * 256 + 4 * lane; na[hd] = *(const u32x2*)(HF + so + c); nbv[hd] = *(const u32x2*)(HB + so + c); no[hd] = *(const u32x2*)(BR + (size_t)rn * 3072 + 1024 + c); } }
#pragma unroll
        for (int hd = 0; hd < 4; ++hd) { const int c = hd * 256 + 4 * lane;
            const u32x2 a = ca[hd], b2 = cb[hd], o = co[hd];
            f32x4 h; h[0] = lo16(a.x) + lo16(b2.x); h[1] = hi16(a.x) + hi16(b2.x); h[2] = lo16(a.y) + lo16(b2.y); h[3] = hi16(a.y) + hi16(b2.y);
            const float ss = wave_sum((h[0] * h[0] + h[1] * h[1]) + (h[2] * h[2] + h[3] * h[3]));
            const float rs = __builtin_amdgcn_rsqf(ss * (1.f / 256.f) + EPS);
            const f32x4 g = *(const f32x4*)(ng + c);
            f32x4 r; r[0] = sigmoid_f(lo16(o.x)) * (h[0] * rs * g[0]); r[1] = sigmoid_f(hi16(o.x)) * (h[1] * rs * g[1]);
            r[2] = sigmoid_f(lo16(o.y)) * (h[2] * rs * g[2]); r[3] = sigmoid_f(hi16(o.y)) * (h[3] * rs * g[3]);
            u32x2 w; w.x = pk2(r[0], r[1]); w.y = pk2(r[2], r[3]);
            *(u32x2*)(BR + (size_t)row * 3072 + 1024 + c) = w; }
#pragma unroll
        for (int hd = 0; hd < 4; ++hd) { ca[hd] = na[hd]; cb[hd] = nbv[hd]; co[hd] = no[hd]; }
    }
}
__device__ __forceinline__ void ssd_finish_rows(const Params& p, int l, int row_lo, int gw, int ngw) {
    if (p.dup) return;
    const int lane = tid_fresh() & 63;
    const bf16_t* YF = (const bf16_t*)(p.ws + WS_YF); const bf16_t* YB = (const bf16_t*)(p.ws + WS_YB);
    bf16_t* BR = (bf16_t*)(p.ws + WS_BR);
    const float* ng = p.snorm_g + l * 1024;
    int row = row_lo + gw;
    u32x2 ca[4], cb[4], cz[4], na[4], nbv[4], nz[4];
    if (row < MT) {
#pragma unroll
        for (int j = 0; j < 4; ++j) { const int c = 4 * lane + 256 * j; ca[j] = *(const u32x2*)(YF + (size_t)row * 1024 + c); cb[j] = *(const u32x2*)(YB + (size_t)row * 1024 + c); cz[j] = *(const u32x2*)(BR + (size_t)row * 3072 + 2048 + c); } }
    for (; row < MT; row += ngw) {
        const int rn = row + ngw;
        if (rn < MT) {
#pragma unroll
            for (int j = 0; j < 4; ++j) { const int c = 4 * lane + 256 * j; na[j] = *(const u32x2*)(YF + (size_t)rn * 1024 + c); nbv[j] = *(const u32x2*)(YB + (size_t)rn * 1024 + c); nz[j] = *(const u32x2*)(BR + (size_t)rn * 3072 + 2048 + c); } }
        f32x4 v[4]; float ss = 0.f;
#pragma unroll
        for (int j = 0; j < 4; ++j) { const u32x2 a = ca[j], b2 = cb[j], z = cz[j];
            v[j][0] = (lo16(a.x) + lo16(b2.x)) * silu_f(lo16(z.x)); v[j][1] = (hi16(a.x) + hi16(b2.x)) * silu_f(hi16(z.x));
            v[j][2] = (lo16(a.y) + lo16(b2.y)) * silu_f(lo16(z.y)); v[j][3] = (hi16(a.y) + hi16(b2.y)) * silu_f(hi16(z.y));
            ss += (v[j][0] * v[j][0] + v[j][1] * v[j][1]) + (v[j][2] * v[j][2] + v[j][3] * v[j][3]); }
        const float rs = __builtin_amdgcn_rsqf(wave_sum(ss) * (1.f / 1024.f) + EPS);
#pragma unroll
        for (int j = 0; j < 4; ++j) { const int c = 4 * lane + 256 * j; const f32x4 g = *(const f32x4*)(ng + c);
            u32x2 w; w.x = pk2(v[j][0] * rs * g[0], v[j][1] * rs * g[1]); w.y = pk2(v[j][2] * rs * g[2], v[j][3] * rs * g[3]);
            *(u32x2*)(BR + (size_t)row * 3072 + 2048 + c) = w; }
#pragma unroll
        for (int j = 0; j < 4; ++j) { ca[j] = na[j]; cb[j] = nbv[j]; cz[j] = nz[j]; }
    }
}

__device__ __forceinline__ void phase_route(const Params& p, int l, unsigned char* ldsb, int bid, int nb) {
    float* lds = reinterpret_cast<float*>(ldsb);
    float* Wt = lds;
    int* hist = reinterpret_cast<int*>(lds + 36 * 1024);
    const int tid = tid_fresh(), lane = tid & 63, wave = tid >> 6;
    const int row_lo = l == 0 ? 0 : MC, rpb = l == 0 ? 68 : 64;
    const float* wrg = p.w_rg + (size_t)l * 1024 * 4; const float* wre = p.w_re + (size_t)l * 1024 * 32;
    for (int i = tid; i < 1024 * 4; i += NTHR) { const int k = i >> 2, g = i & 3; Wt[g * 1024 + (k ^ ((g & 7) << 2))] = wrg[i]; }
    for (int i = tid; i < 1024 * 32; i += NTHR) { const int k = i >> 5, e = i & 31; Wt[(4 + e) * 1024 + (k ^ (((4 + e) & 7) << 2))] = wre[i]; }
    const float* mod = (const float*)(p.ws + WS_MOD) + l * 5 * 6144;
    const float* XL = (const float*)(p.ws + WS_XL);
    int* EID = (int*)(p.ws + WS_EID); float* EWT = (float*)(p.ws + WS_EWT);
    for (int vb = bid; vb < 256; vb += nb) {
        if (tid < 32) hist[tid] = 0;
        __syncthreads();
        for (int rr = wave; rr < rpb; rr += 8) {
            const int row = row_lo + vb * rpb + rr;
            f32x4 v[4];
#pragma unroll
            for (int j = 0; j < 4; ++j) v[j] = *(const f32x4*)(XL + (size_t)row * 1024 + 4 * lane + 256 * j);
            const float* mr = mod + modrow(row) * 6144;
            norm_mod_row(v, p.g_ffn + l * 1024, mr + 3 * 1024, mr + 4 * 1024, lane);
            store_row_bf16((bf16_t*)(p.ws + WS_H) + (size_t)row * 1024, v, lane);
            float lg[36];
#pragma unroll
            for (int e = 0; e < 36; ++e) { float s = 0.f;
#pragma unroll
                for (int j = 0; j < 4; ++j) { const f32x4 w = *(const f32x4*)(Wt + e * 1024 + ((4 * lane + 256 * j) ^ ((e & 7) << 2))); s += (v[j][0] * w[0] + v[j][1] * w[1]) + (v[j][2] * w[2] + v[j][3] * w[3]); }
                lg[e] = wave_sum(s); }
            float gl[4]; int gi = 0; float gmax;
#pragma unroll
            for (int g = 0; g < 4; ++g) gl[g] = lg[g] + p.b_rg[l * 4 + g];
            gmax = gl[0];
#pragma unroll
            for (int g = 1; g < 4; ++g) if (gl[g] > gmax) { gmax = gl[g]; gi = g; }
            float den = 0.f;
#pragma unroll
            for (int g = 0; g < 4; ++g) den += __expf(gl[g] - gmax);
            const float pg = 1.f / den;
            float v1 = -3.0e38f, v2 = -3.0e38f; int i1 = 0, i2 = 0;
#pragma unroll
            for (int g = 0; g < 4; ++g) if (g == gi) {
#pragma unroll
                for (int j = 0; j < 8; ++j) { const float x = lg[4 + g * 8 + j] + p.b_re[l * 32 + g * 8 + j];
                    if (x > v1) { v2 = v1; i2 = i1; v1 = x; i1 = j; } else if (x > v2) { v2 = x; i2 = j; } } }
            const float e2 = __expf(v2 - v1), w1 = pg / (1.f + e2), w2 = pg * e2 / (1.f + e2);
            if (lane == 0) { EID[row * 2] = gi * 8 + i1; EID[row * 2 + 1] = gi * 8 + i2; EWT[row * 2] = w1; EWT[row * 2 + 1] = w2;
                atomicAdd(&hist[gi * 8 + i1], 1); atomicAdd(&hist[gi * 8 + i2], 1); }
        }
        __syncthreads();
        if (tid < 32) ((int*)(p.ws + WS_HIST))[vb * 32 + tid] = hist[tid];
        __syncthreads();
    }
    __syncthreads();
    float* scr = lds + wave * (64 * 65);
    convert_run(p, (CV_IN_SCAN && nb == 256) ? -1 : l, l + 1 < 2 ? l + 1 : -1, bid * 8 + wave, nb * 8, scr, lane);
}

__device__ __forceinline__ void phase_scatter(const Params& p, int l, unsigned char* ldsb, int bid, int nb) {
    int* li = reinterpret_cast<int*>(ldsb);
    int* tot = li; int* pre = li + 32; int* pst = li + 64; int* ea = li + 128; int* pos = li + 384;
    const int tid = tid_fresh(), lane = tid & 63, wave = tid >> 6;
    const int row_lo = l == 0 ? 0 : MC, rpb = l == 0 ? 68 : 64;
    const int* HIST = (const int*)(p.ws + WS_HIST); const int* EID = (const int*)(p.ws + WS_EID);
    int* SLOT = (int*)(p.ws + WS_SLOT);
    for (int vb = bid; vb < 256; vb += nb) {
        __syncthreads();
        if (tid < 32) { int t = 0, pr = 0; for (int j = 0; j < 256; ++j) { const int hv = HIST[j * 32 + tid]; t += hv; if (j < vb) pr += hv; } tot[tid] = t; pre[tid] = pr; }
        __syncthreads();
        if (tid == 0) { int s = 0; for (int e = 0; e < 32; ++e) { pst[e] = s; s += ((tot[e] + 255) >> 8) << 8; }
            if (vb == 0) { int* BE = (int*)(p.ws + WS_BLKEXP); int nblk = 0;
                for (int e = 0; e < 32; ++e) { const int nbk = (tot[e] + 255) >> 8; for (int j = 0; j < nbk; ++j) BE[nblk++] = e; }
                BE[200] = nblk; } }
        if (tid < rpb * 2) ea[tid] = EID[(row_lo + vb * rpb) * 2 + tid];
        __syncthreads();
        if (tid < rpb * 2) { const int e = ea[tid]; int rk = 0; for (int j = 0; j < tid; ++j) rk += (ea[j] == e) ? 1 : 0;
            const int ps = pst[e] + pre[e] + rk; SLOT[(row_lo + vb * rpb) * 2 + tid] = ps; ((int*)(p.ws + WS_TOK))[ps] = row_lo + vb * rpb + (tid >> 1); }
        if (vb == 0 && tid < 32) { int* TOK = (int*)(p.ws + WS_TOK); const int e0 = pst[tid] + tot[tid], e1 = pst[tid] + (((tot[tid] + 255) >> 8) << 8);
            for (int q = e0; q < e1; ++q) TOK[q] = row_lo; }
    }
    __syncthreads();
}

__device__ __forceinline__ void phase_combine(const Params& p, int l, int bid, int nb) {
    if (p.dup && l == 0) return;
    const int lane = tid_fresh() & 63, wave = tid_fresh() >> 6;
    const float* mod = (const float*)(p.ws + WS_MOD);
    const int* SLOT = (const int*)(p.ws + WS_SLOT); const float* EWT = (const float*)(p.ws + WS_EWT);
    const bf16_t* Y = (const bf16_t*)(p.ws + WS_Y);
    float* XL = (float*)(p.ws + WS_XL);
    const int row_lo = l == 0 ? 0 : MC, stride = nb * 8;
    for (int rowA = row_lo + bid * 8 + wave; rowA < MT; rowA += 2 * stride) {
        const int rowB = rowA + stride; const bool hasB = rowB < MT; const int rb = hasB ? rowB : rowA;
        const int sA0 = SLOT[rowA * 2], sA1 = SLOT[rowA * 2 + 1], sB0 = SLOT[rb * 2], sB1 = SLOT[rb * 2 + 1];
        const float wA0 = EWT[rowA * 2], wA1 = EWT[rowA * 2 + 1], wB0 = EWT[rb * 2], wB1 = EWT[rb * 2 + 1];
        u32x2 yA0[4], yA1[4], yB0[4], yB1[4]; f32x4 xA[4], xB[4];
#pragma unroll
        for (int j = 0; j < 4; ++j) { const int c = 4 * lane + 256 * j;
            yA0[j] = *(const u32x2*)(Y + (size_t)sA0 * 1024 + c); yA1[j] = *(const u32x2*)(Y + (size_t)sA1 * 1024 + c); xA[j] = *(const f32x4*)(XL + (size_t)rowA * 1024 + c);
            yB0[j] = *(const u32x2*)(Y + (size_t)sB0 * 1024 + c); yB1[j] = *(const u32x2*)(Y + (size_t)sB1 * 1024 + c); xB[j] = *(const f32x4*)(XL + (size_t)rb * 1024 + c); }
#pragma unroll
        for (int half = 0; half < 2; ++half) {
            if (half == 1 && !hasB) break;
            const int row = half ? rowB : rowA; const float w0 = half ? wB0 : wA0, w1 = half ? wB1 : wA1;
            const float* g5 = mod + (l * 5 + modrow(row)) * 6144 + 5 * 1024;
            f32x4 v[4];
#pragma unroll
            for (int j = 0; j < 4; ++j) { const int c = 4 * lane + 256 * j;
                const u32x2 a = half ? yB0[j] : yA0[j], b2 = half ? yB1[j] : yA1[j];
                f32x4 y; y[0] = w0 * lo16(a.x) + w1 * lo16(b2.x); y[1] = w0 * hi16(a.x) + w1 * hi16(b2.x); y[2] = w0 * lo16(a.y) + w1 * lo16(b2.y); y[3] = w0 * hi16(a.y) + w1 * hi16(b2.y);
                v[j] = (half ? xB[j] : xA[j]) + *(const f32x4*)(g5 + c) * y; }
            if (l == 0) {
#pragma unroll
                for (int j = 0; j < 4; ++j) *(f32x4*)(XL + (size_t)row * 1024 + 4 * lane + 256 * j) = v[j];
                const float* mr = mod + (5 + modrow(row)) * 6144;
                norm_mod_row(v, p.g_mix + 1024, mr, mr + 1024, lane);
                store_row_bf16((bf16_t*)(p.ws + WS_H) + (size_t)row * 1024, v, lane);
            } else {
                norm_mod_row(v, p.g_final, nullptr, nullptr, lane);
                float* o = p.out + (size_t)(row - MC) * 1024;
#pragma unroll
                for (int j = 0; j < 4; ++j) *(f32x4*)(o + 4 * lane + 256 * j) = v[j];
            }
        }
    }
}

constexpr int NPH_L = 14, NPHASES = 1 + 2 * NPH_L;
__device__ __forceinline__ void run_phase(const Params& p, int ph, unsigned char* lds) {
    const int bid = blockIdx.x, nb = gridDim.x;
    const int wave = tid_fresh() >> 6;
#ifndef ONLY_S
    if (ph == 0) { phase_pre(p, lds, bid, nb); return; }
#else
    if (ph == 0) { if (ONLY_S == 99) phase_pre(p, lds, bid, nb); return; }
#endif
    const int l = (ph - 1) / NPH_L, s = (ph - 1) % NPH_L;
    unsigned char* ws = p.ws;
    const int pm0 = l == 0 ? 0 : 4, nMrows = l == 0 ? 68 : 64, row_lo = l == 0 ? 0 : MC;
#ifdef ONLY_S
    if (s != ONLY_S) return;
#endif
    switch (s) {
    case 0: if (l == 0) phase_norm1(p, bid, nb); break;
    case 1: { EpiInproj E{ws};
              if (l == 0) { SchedGrid S{(const bf16_t*)(ws + WS_H), (const bf16_t*)(ws + WS_WIN), 1024, 1024, 0, 68, 45, nb, bid}; gemm_run(lds, S, E, 1024, 1024, 1024, 1); }
              else { SchedInproj1 S{(const bf16_t*)(ws + WS_H), (const bf16_t*)(ws + WS_WIN), nb, bid}; gemm_run(lds, S, E, 1024, 1024, 1024, 1); } } break;
    case 2: { for (int it = bid; it < 1088; it += nb) conv_m_item(p, l, it, (LAS unsigned char*)lds);
              if (!p.dup) for (int it = bid; it < (l == 0 ? 272 : 256); it += nb) pool_window_item(p, it, (LAS unsigned char*)lds); } break;
    case 3: {
              for (int it = bid; it < 256; it += nb) { const int x = it & 7, y = it >> 3; mlstm_chunk_item(p, l, nb == 256 ? ((((y >> 4) * 8 + x) << 4) | (y & 15)) : it, (LAS unsigned char*)lds); }
              SchedPool S{(const bf16_t*)(ws + WS_BR), (const bf16_t*)(ws + WS_WPOOL), pm0, nMrows, nb, bid}; EpiPool E{(bf16_t*)(ws + WS_BR)};
              if (!p.dup) gemm_run(lds, S, E, 256, 3072, 256, 1); } break;
    case 4: { for (int it = bid; it < 1088; it += nb) conv_s_item(p, l, it, (LAS unsigned char*)lds);
              mlstm_finish_rows(p, l, row_lo, bid * 8 + wave, nb * 8); } break;
    case 5: for (int it = bid; it < 256; it += nb) { const int x = it & 7, y = it >> 3;
                ssd_chunk_item(p, l, nb == 256 ? ((((y >> 4) * 8 + x) << 4) | (y & 15)) : it, (LAS unsigned char*)lds); }
            break;
    case 6: ssd_finish_rows(p, l, row_lo, bid * 8 + wave, nb * 8); break;
    case 7: { SchedGrid S{(const bf16_t*)(ws + WS_BR), (const bf16_t*)(ws + WS_WBR), 3072, 3072, pm0, nMrows, 4, nb, bid}; EpiBranch E{(const bf16_t*)(ws + WS_MG), (bf16_t*)(ws + WS_MERGED)};
              gemm_run(lds, S, E, 3072, 3072, 3072, 3); } break;
    case 8: { SchedGrid S{(const bf16_t*)(ws + WS_MERGED), (const bf16_t*)(ws + WS_WOUT), 1024, 1024, pm0, nMrows, 4, nb, bid}; EpiOut E{(float*)(ws + WS_XL), (const float*)(ws + WS_MOD) + l * 5 * 6144, l == 0 ? p.x : nullptr, l == 0 ? p.ctx : nullptr, p.dup};
              gemm_run(lds, S, E, 1024, 1024, 1024, 1); } break;
    case 9: phase_route(p, l, lds, bid, nb); break;
    case 10: phase_scatter(p, l, lds, bid, nb); break;
    case 11: { const int* BE = (const int*)(ws + WS_BLKEXP);
              SchedMoe S{(const bf16_t*)(ws + WS_H), (const bf16_t*)(ws + WS_EW1), BE, (const int*)(ws + WS_TOK), 1024, BE[200], nb, bid, (size_t)1048576, (size_t)1024}; EpiMoe1 E{(bf16_t*)(ws + WS_ACT)};
              gemm_run<true>(lds, S, E, 1024, 1024, 1024, 1); } break;
    case 12: { const int* BE = (const int*)(ws + WS_BLKEXP);
              SchedMoe S{(const bf16_t*)(ws + WS_ACT), (const bf16_t*)(ws + WS_EW2), BE, nullptr, 512, BE[200], nb, bid, (size_t)524288, (size_t)512}; EpiMoe2 E{(bf16_t*)(ws + WS_Y)};
              gemm_run(lds, S, E, 512, 512, 512, 1); } break;
    case 13: phase_combine(p, l, bid, nb); break;
    }
}

#define XB_TMO      128
#define XB_XCNT(j)  (256  + 64 * (j))
#define XB_XSUB(j)  (1280 + 64 * (j))
#define XB_XGEN(j)  (2304 + 64 * (j))
#define XB_TOP      3328
#define XB_TOPGEN   3392
#define XCD_BAR_WORDS 3456
#define XB_SPIN_CAP (1u << 18)
__device__ __forceinline__ unsigned xb_ld(unsigned* p)              { return __hip_atomic_load(p, __ATOMIC_RELAXED, __HIP_MEMORY_SCOPE_AGENT); }
__device__ __forceinline__ unsigned xb_add(unsigned* p, unsigned v) { return __hip_atomic_fetch_add(p, v, __ATOMIC_RELAXED, __HIP_MEMORY_SCOPE_AGENT); }
__device__ __forceinline__ unsigned xb_xcc_id() { return (unsigned)__builtin_amdgcn_s_getreg((3 << 11) | 20) & 0xFu; }
#define XB_SPIN(cond, bar) do { unsigned _sp = 0; while (cond) { __builtin_amdgcn_s_sleep(1); \
    if ((++_sp & 255u) == 0u) { if (xb_ld(&(bar)[XB_TMO])) break; if (_sp > XB_SPIN_CAP) { atomicAdd(&(bar)[XB_TMO], 1u); break; } } } } while (0)
__device__ __forceinline__ void xcd_barrier_complete(unsigned* bar, unsigned x, unsigned& nloc, unsigned& nx) {
    const unsigned G = gridDim.x * gridDim.y * gridDim.z;
    unsigned sum, cnt, mine, sp = 0u;
    for (;;) {
        sum = 0u; cnt = 0u; mine = 0u;
#pragma unroll
        for (unsigned j = 0; j < 16; ++j) { const unsigned c = xb_ld(&bar[XB_XCNT(j)]); sum += c; cnt += (c > 0u) ? 1u : 0u; mine = (j == x) ? c : mine; }
        if (sum == G) break;
        __builtin_amdgcn_s_sleep(1);
        if ((++sp & 255u) == 0u) { if (xb_ld(&bar[XB_TMO])) break; if (sp > XB_SPIN_CAP) { atomicAdd(&bar[XB_TMO], 1u); break; } }
    }
    nloc = mine > 0u ? mine : 1u; nx = cnt > 0u ? cnt : 1u;
}
__device__ __forceinline__ void xcd_barrier(unsigned* bar, volatile LAS unsigned* st) {
    asm volatile("s_waitcnt vmcnt(0)" ::: "memory");
    __syncthreads();
    if (threadIdx.x == 0) {
        __builtin_amdgcn_s_waitcnt(0);
        const unsigned x = xb_xcc_id();
        unsigned nloc = st[0], nx = st[1];
        if (nloc == 0u) { xcd_barrier_complete(bar, x, nloc, nx); st[0] = nloc; st[1] = nx; }
        const unsigned old = xb_add(&bar[XB_XSUB(x)], 1u);
        const unsigned gen = old / nloc;
        if (old + 1u == (gen + 1u) * nloc) {
            __builtin_amdgcn_fence(__ATOMIC_RELEASE, "agent");
            asm volatile("s_waitcnt vmcnt(0)" ::: "memory");
            const unsigned og = xb_add(&bar[XB_TOP], 1u);
            const unsigned tg = og / nx;
            if (og + 1u == (tg + 1u) * nx) xb_add(&bar[XB_TOPGEN], 1u);
            else XB_SPIN(xb_ld(&bar[XB_TOPGEN]) == tg, bar);
            __builtin_amdgcn_fence(__ATOMIC_ACQUIRE, "agent");
            xb_add(&bar[XB_XGEN(x)], 1u);
            asm volatile("s_waitcnt vmcnt(0)" ::: "memory");
        } else {
            XB_SPIN(xb_ld(&bar[XB_XGEN(x)]) == gen, bar);
            __builtin_amdgcn_fence(__ATOMIC_ACQUIRE, "agent");
            asm volatile("s_waitcnt vmcnt(0)" ::: "memory");
        }
    }
    __syncthreads();
}

constexpr int BAR_LDS_OFF = LDS_BYTES - 16;
__global__ void __launch_bounds__(NTHR, 2) fwd_kernel(Params pk) {
    extern __shared__ __attribute__((aligned(16))) unsigned char lds[];
    const Params& p = pk;
    const int lo = pk.ph_lo, hi = pk.ph_hi;
    unsigned* bar = (unsigned*)(pk.ws + WS_BAR);
    volatile LAS unsigned* bst = (volatile LAS unsigned*)((LAS unsigned char*)lds + BAR_LDS_OFF);
    if (hi - lo > 1) {
        if (threadIdx.x == 0) { bst[0] = 0u; bst[1] = 0u; (void)xb_add(&bar[XB_XCNT(xb_xcc_id())], 1u); }
        __syncthreads();
    }
#define STEP(k) if (lo <= (k) && (k) < hi) { run_phase(p, (k), lds); if ((k) + 1 < hi) { if (pk.dup < 0) cg::this_grid().sync(); else xcd_barrier(bar, bst); } }
    STEP(0) STEP(1) STEP(2) STEP(3) STEP(4) STEP(5) STEP(6) STEP(7) STEP(8) STEP(9) STEP(10) STEP(11) STEP(12) STEP(13) STEP(14)
    STEP(16) STEP(17) STEP(18) STEP(19) STEP(20) STEP(21) STEP(22) STEP(23) STEP(24) STEP(25) STEP(26) STEP(27) STEP(28)
#undef STEP
}

extern "C" void kernel_launch(void* const* d_in, const int* in_sizes, int n_in, void* d_out, int out_size, void* d_ws, size_t ws_size, hipStream_t stream) {
    static int grid_blocks = 0;
    if (!grid_blocks) {
        if (n_in != 31 || ws_size < WS_END) { fprintf(stderr, "kernel_launch: unexpected n_in %d / ws_size %zu (need %zu)\n", n_in, ws_size, (size_t)WS_END); grid_blocks = -1; return; }
        int dev = 0, cus = 0, per_cu = 0;
        hipGetDevice(&dev);
        hipDeviceGetAttribute(&cus, hipDeviceAttributeMultiprocessorCount, dev);
        if (hipFuncSetAttribute((const void*)fwd_kernel, hipFuncAttributeMaxDynamicSharedMemorySize, LDS_BYTES) != hipSuccess) fprintf(stderr, "kernel_launch: hipFuncSetAttribute failed\n");
        hipOccupancyMaxActiveBlocksPerMultiprocessor(&per_cu, (const void*)fwd_kernel, NTHR, LDS_BYTES);
        if (per_cu < 1) { fprintf(stderr, "kernel_launch: occupancy query says %d blocks per CU\n", per_cu); per_cu = 1; }
        grid_blocks = cus * per_cu;
        (void)hipGetLastError();
    }
    if (grid_blocks < 0) return;
    Params p{};
    const float** dst = (const float**)&p;
    for (int i = 0; i < 31; ++i) dst[i] = (const float*)d_in[i];
    p.out = (float*)d_out; p.ws = (unsigned char*)d_ws;
#if SINGLE_LAUNCH
    if (hipMemsetAsync((char*)d_ws + WS_BAR, 0, 16384, stream) != hipSuccess) fprintf(stderr, "kernel_launch: hipMemsetAsync failed\n");
    p.ph_lo = 0; p.ph_hi = NPHASES;
    void* args[] = {&p};
    hipError_t e = hipLaunchCooperativeKernel((const void*)fwd_kernel, dim3(grid_blocks), dim3(NTHR), args, LDS_BYTES, stream);
    if (e != hipSuccess) fprintf(stderr, "cooperative launch failed: %s (grid %d)\n", hipGetErrorString(e), grid_blocks);
#else
    for (int ph = 0; ph < NPHASES; ++ph) {
        if (ph == 1 + NPH_L) continue;
        p.ph_lo = ph; p.ph_hi = ph + 1;
        hipLaunchKernelGGL(fwd_kernel, dim3(grid_blocks), dim3(NTHR), LDS_BYTES, stream, p);
        const int sidx = ph == 0 ? 14 : (ph - 1) % NPH_L;
        if ((PROBE_DUP_MASK >> sidx) & 1) { p.dup = 1; for (int r = 0; r < PROBE_DUP_N; ++r) hipLaunchKernelGGL(fwd_kernel, dim3(grid_blocks), dim3(NTHR), LDS_BYTES, stream, p); p.dup = 0; }
    }
#endif
}
```

```cpp
#include <hip/hip_runtime.h>
#include <hip/hip_cooperative_groups.h>
#include <cstdio>
namespace cg = cooperative_groups;

#ifndef SINGLE_LAUNCH
#define SINGLE_LAUNCH 1
#endif
#ifndef PROBE_DUP_MASK
#define PROBE_DUP_MASK 0
#endif
#ifndef PROBE_DUP_N
#define PROBE_DUP_N 1
#endif
#ifndef USE_MLSTM_CHUNK
#define USE_MLSTM_CHUNK 1
#endif
#ifndef USE_SSD_CHUNK
#define USE_SSD_CHUNK 1
#endif
#ifndef CV_IN_SCAN
#define CV_IN_SCAN 0
#endif
#ifndef USE_MFMA_GEMM
#define USE_MFMA_GEMM 1
#endif

typedef unsigned short bf16_t;
typedef float f32x4 __attribute__((ext_vector_type(4)));
typedef unsigned u32x4 __attribute__((ext_vector_type(4)));
typedef unsigned u32x2 __attribute__((ext_vector_type(2)));

constexpr int NTHR = 512;
constexpr int D = 1024, NB = 4, SEQ = 4096, CTXL = 256;
constexpr int MC = NB * CTXL;
constexpr int ML = NB * SEQ;
constexpr int MT = MC + ML;
constexpr int DIN = 11312, NPAD = 11520;
constexpr int NE = 32, DE = 512;
constexpr int CAP = 43008;
constexpr float EPS = 1e-6f;
constexpr int LDS_BYTES = 163840;

constexpr size_t MiB = 1u << 20;
constexpr size_t WS_HIST = 0;
constexpr size_t WS_BLKEXP = 64 * 1024;
constexpr size_t WS_BAR = 128 * 1024;
constexpr size_t WS_TOK = 256 * 1024;
constexpr size_t WS_MOD = 1 * MiB;
constexpr size_t WS_GA = 2 * MiB;
constexpr size_t WS_DT = 4 * MiB;
constexpr size_t WS_EID = 7 * MiB;
constexpr size_t WS_EWT = 7 * MiB + 256 * 1024;
constexpr size_t WS_SLOT = 7 * MiB + 512 * 1024;
constexpr size_t WS_WIN = 8 * MiB;
constexpr size_t WS_WPOOL = 31 * MiB;
constexpr size_t WS_WBR = 32 * MiB;
constexpr size_t WS_WOUT = 38 * MiB;
constexpr size_t WS_XL = 40 * MiB;
constexpr size_t WS_H = 108 * MiB;
constexpr size_t WS_BR = 142 * MiB;
constexpr size_t WS_Q = 244 * MiB, WS_K = 278 * MiB, WS_V = 312 * MiB;
constexpr size_t WS_SX = 346 * MiB, WS_SB = 380 * MiB, WS_SC = 397 * MiB;
constexpr size_t WS_MG = 414 * MiB;
constexpr size_t WS_HF = 516 * MiB, WS_HB = 550 * MiB;
constexpr size_t WS_VT = 584 * MiB;
constexpr size_t WS_END = 618 * MiB;
constexpr size_t WS_MGA = WS_WIN, WS_MGC = WS_WIN + 576 * 1024, WS_MGP = WS_WIN + 1152 * 1024;
constexpr size_t WS_SACS = WS_WIN + 2 * MiB, WS_SDT = WS_WIN + 5 * MiB;
constexpr size_t WS_QC = WS_H, WS_KC = WS_HF, WS_KCT = WS_HB;
constexpr size_t WS_HF2 = WS_Q, WS_HB2 = WS_K;
constexpr size_t WS_XCT = WS_HF;
constexpr size_t WS_BC = WS_H, WS_CC = WS_H + 17 * MiB, WS_BCT = WS_HB;
constexpr size_t WS_YF = WS_SX, WS_YB = WS_SB;
constexpr size_t WS_MERGED = WS_H;
constexpr size_t WS_EW1 = 244 * MiB;
constexpr size_t WS_EW2 = 308 * MiB;
constexpr size_t WS_XB = WS_BR;
constexpr size_t WS_ACT = WS_SX;
constexpr size_t WS_Y = WS_MG;

struct Params {
    const float *x, *c, *ctx, *c_ctx, *w_ada, *b_ada, *g_mix, *g_ffn, *w_in, *pool_w, *pool_scale,
        *mconv_w, *mconv_b, *mgate_b, *mnorm_g, *sconv_w, *sconv_b, *sdt_bias, *sa_log, *sd, *snorm_g,
        *w_branch, *w_out, *w_rg, *b_rg, *w_re, *b_re, *w_eg, *w_eu, *w_ed, *g_final;
    float* out; unsigned char* ws; int ph_lo, ph_hi, dup, pad;
};

__device__ __forceinline__ int tid_fresh() { int t = threadIdx.x; asm volatile("" : "+v"(t)); return t; }
__device__ __forceinline__ float bf2f(unsigned b) { return __uint_as_float(b << 16); }
__device__ __forceinline__ unsigned f2bf(float f) { unsigned u = __float_as_uint(f); return (u + 0x7fffu + ((u >> 16) & 1u)) >> 16; }
typedef __bf16 bf16x2_t __attribute__((ext_vector_type(2)));
typedef float f32x2_t __attribute__((ext_vector_type(2)));
__device__ __forceinline__ unsigned pk2(float lo, float hi) { const f32x2_t v = {lo, hi}; return __builtin_bit_cast(unsigned, __builtin_convertvector(v, bf16x2_t)); }
__device__ __forceinline__ float lo16(unsigned w) { return __uint_as_float(w << 16); }
__device__ __forceinline__ float hi16(unsigned w) { return __uint_as_float(w & 0xffff0000u); }
__device__ __forceinline__ float wave_sum(float v) {
#pragma unroll
    for (int o = 1; o < 64; o <<= 1) v += __shfl_xor(v, o);
    return v;
}
__device__ __forceinline__ float sigmoid_f(float x) { return __builtin_amdgcn_rcpf(1.f + __expf(-x)); }
__device__ __forceinline__ float silu_f(float x) { return x * __builtin_amdgcn_rcpf(1.f + __expf(-x)); }
__device__ __forceinline__ float softplus_f(float x) { return fmaxf(x, 0.f) + log1pf(__expf(-fabsf(x))); }
__device__ __forceinline__ float logsigmoid_f(float x) { return fminf(x, 0.f) - log1pf(__expf(-fabsf(x))); }
__device__ __forceinline__ void unpack8(u32x4 w, float* f) {
    f[0] = lo16(w.x); f[1] = hi16(w.x); f[2] = lo16(w.y); f[3] = hi16(w.y);
    f[4] = lo16(w.z); f[5] = hi16(w.z); f[6] = lo16(w.w); f[7] = hi16(w.w);
}
__device__ __forceinline__ u32x4 pack8(f32x4 a, f32x4 b) {
    u32x4 w; w.x = pk2(a[0], a[1]); w.y = pk2(a[2], a[3]); w.z = pk2(b[0], b[1]); w.w = pk2(b[2], b[3]); return w;
}
__device__ __forceinline__ int scanrow(int row) {
    if (row < MC) return row;
    const int r = row - MC, b = r >> 12, t = r & 4095;
    return MC + (b << 12) + ((t & 63) << 6) + (t >> 6);
}
__device__ __forceinline__ int modrow(int row) { return row < MC ? 4 : ((row - MC) >> 12); }

struct Unit { const bf16_t* A; const bf16_t* B; const int* tok; int pm, pn; };

__device__ __forceinline__ void tile_order(int L, int nM, int nN, int& pm, int& pn) {
    const int nwg = nM * nN; int wgid = L;
    { const int q = nwg / 8, r = nwg % 8, xcd = wgid % 8, off = wgid / 8; wgid = (xcd < r ? xcd * (q + 1) : r * (q + 1) + (xcd - r) * q) + off; }
    const int nig = 8 * nN, gid = wgid / nig, fm = gid * 8, gsz = (nM - fm) < 8 ? (nM - fm) : 8;
    pm = fm + ((wgid % nig) % gsz); pn = (wgid % nig) / gsz;
}
struct SchedGrid {
    const bf16_t* A; const bf16_t* B; int lda, ldb, pm0, nM, nN, G, c;
    __device__ __forceinline__ bool next(int i, Unit& u) const {
        const long L = (long)i * G + c; if (L >= (long)nM * nN) return false;
        int pm, pn; tile_order((int)L, nM, nN, pm, pn); pm += pm0;
        u.pm = pm; u.pn = pn; u.tok = nullptr; u.A = A + (size_t)pm * 256 * lda; u.B = B + (size_t)pn * 256 * ldb; return true;
    }
};
struct SchedInproj1 {
    const bf16_t* A; const bf16_t* B; int G, c;
    __device__ __forceinline__ bool next(int i, Unit& u) const {
        const long L = (long)i * G + c; if (L >= 2880 + 84) return false;
        int pm, pn;
        if (L < 2880) { tile_order((int)L, 64, 45, pm, pn); pm += 4; }
        else { const int idx = (int)L - 2880, k = idx % 21; pm = idx / 21; pn = k < 12 ? 4 + k : (k < 16 ? 20 + (k - 12) : (k < 20 ? 28 + (k - 16) : 44)); }
        u.pm = pm; u.pn = pn; u.tok = nullptr; u.A = A + (size_t)pm * 256 * 1024; u.B = B + (size_t)pn * 256 * 1024; return true;
    }
};
struct SchedPool {
    const bf16_t* A; const bf16_t* B; int pm0, nM, G, c;
    __device__ __forceinline__ bool next(int i, Unit& u) const {
        const long L = (long)i * G + c; if (L >= (long)nM * 4) return false;
        const int pm = pm0 + (int)(L >> 2), g = (int)(L & 3);
        u.pm = pm; u.pn = g; u.tok = nullptr; u.A = A + (size_t)pm * 256 * 3072 + g * 256; u.B = B + (size_t)g * 65536; return true;
    }
};
struct SchedMoe {
    const bf16_t* A; const bf16_t* B; const int* blkexp; const int* tok; int lda, nblk, G, c; size_t bexp_stride, ldb;
    __device__ __forceinline__ bool next(int i, Unit& u) const {
        const long L = (long)i * G + c; if (L >= (long)nblk * 4) return false;
        const int blk = (int)(L >> 2), nt = (int)(L & 3); const int e = blkexp[blk];
        u.pm = blk; u.pn = nt; u.tok = tok ? tok + blk * 256 : nullptr; u.A = tok ? A : A + (size_t)blk * 256 * lda;
        u.B = B + (size_t)e * bexp_stride + (size_t)nt * 256 * ldb; return true;
    }
};

struct EpiInproj {
    unsigned char* ws;
    __device__ __forceinline__ void seg(const Unit& u, int, int r, int c0, f32x4& lo0, f32x4& lo1, f32x4& hi0, f32x4& hi1) const {
        const int row = u.pm * 256 + r, t = u.pn;
        bf16_t* dst; size_t ld; int cb;
        if (t < 4) { dst = (bf16_t*)(ws + WS_BR) + (size_t)row * 3072; cb = t * 256; }
        else if (t < 16) { const int w = (t - 4) >> 2; dst = (bf16_t*)(ws + WS_Q + (size_t)w * 34 * MiB) + (size_t)scanrow(row) * 1024; cb = ((t - 4) & 3) * 256; }
        else if (t < 20) { dst = (bf16_t*)(ws + WS_BR) + (size_t)row * 3072 + 1024; cb = (t - 16) * 256; }
        else if (t < 24) { dst = (bf16_t*)(ws + WS_SX) + (size_t)row * 1024; cb = (t - 20) * 256; }
        else if (t < 28) { dst = (bf16_t*)(ws + WS_BR) + (size_t)row * 3072 + 2048; cb = (t - 24) * 256; }
        else if (t < 30) { dst = (bf16_t*)(ws + WS_SB) + (size_t)row * 512; cb = (t - 28) * 256; }
        else if (t < 32) { dst = (bf16_t*)(ws + WS_SC) + (size_t)row * 512; cb = (t - 30) * 256; }
        else if (t < 44) {
            dst = (bf16_t*)(ws + WS_MG) + (size_t)row * 3072; cb = (t - 32) * 256;
#pragma unroll
            for (int j = 0; j < 4; ++j) { lo0[j] = sigmoid_f(lo0[j]); lo1[j] = sigmoid_f(lo1[j]); hi0[j] = sigmoid_f(hi0[j]); hi1[j] = sigmoid_f(hi1[j]); }
        } else {
            if (c0 < 32) { float* d = (float*)(ws + WS_DT) + (size_t)row * 32 + c0; *(f32x4*)d = lo0; *(f32x4*)(d + 4) = lo1; }
            else if (c0 < 48) { float* d = (float*)(ws + WS_GA) + (size_t)scanrow(row) * 16 + (c0 - 32); *(f32x4*)d = lo0; *(f32x4*)(d + 4) = lo1; }
            return;
        }
        *(u32x4*)(dst + cb + c0) = pack8(lo0, lo1);
        *(u32x4*)(dst + cb + 128 + c0) = pack8(hi0, hi1);
    }
};
struct EpiPool {
    bf16_t* BR;
    __device__ __forceinline__ void seg(const Unit& u, int, int r, int c0, f32x4& lo0, f32x4& lo1, f32x4& hi0, f32x4& hi1) const {
        bf16_t* d = BR + (size_t)(u.pm * 256 + r) * 3072 + u.pn * 256 + c0;
        *(u32x4*)d = pack8(lo0, lo1);
        *(u32x4*)(d + 128) = pack8(hi0, hi1);
    }
};
struct EpiBranch {
    const bf16_t* MG; bf16_t* OUT;
    __device__ __forceinline__ void seg(const Unit& u, int sg, int r, int c0, f32x4& lo0, f32x4& lo1, f32x4& hi0, f32x4& hi1) const {
        const int row = u.pm * 256 + r, col = u.pn * 256 + c0;
        const bf16_t* g = MG + (size_t)row * 3072 + sg * 1024 + col;
        const int nx = sg < 2 ? 1024 : 0;
        const u32x4 ga = *(const u32x4*)g, gb = *(const u32x4*)(g + 128), gc = *(const u32x4*)(g + nx), gd = *(const u32x4*)(g + nx + 128);
        float a[8], b[8], a2[8], b2[8]; unpack8(ga, a); unpack8(gb, b); unpack8(gc, a2); unpack8(gd, b2);
        if (sg < 2) {
#pragma unroll
            for (int j = 0; j < 8; ++j) { a[j] = a[j] * __builtin_amdgcn_rcpf(a2[j]); b[j] = b[j] * __builtin_amdgcn_rcpf(b2[j]); } }
#pragma unroll
        for (int j = 0; j < 4; ++j) { lo0[j] *= a[j]; lo1[j] *= a[4 + j]; hi0[j] *= b[j]; hi1[j] *= b[4 + j]; }
        if (sg == 2) { bf16_t* d = OUT + (size_t)row * 1024 + col; *(u32x4*)d = pack8(lo0, lo1); *(u32x4*)(d + 128) = pack8(hi0, hi1); }
    }
};
struct EpiOut {
    float* XL; const float* mod; const float* x_in; const float* ctx_in; int dup;
    __device__ __forceinline__ void seg(const Unit& u, int, int r, int c0, f32x4& lo0, f32x4& lo1, f32x4& hi0, f32x4& hi1) const {
        const int row = u.pm * 256 + r, col = u.pn * 256 + c0;
        const float* g = mod + modrow(row) * 6144 + 2 * 1024 + col;
        float* x = XL + (size_t)row * 1024 + col;
        const float* rs = x_in ? (row < MC ? ctx_in + (size_t)row * 1024 + col : x_in + (size_t)(row - MC) * 1024 + col) : x;
        const f32x4 x0 = *(const f32x4*)rs, x1 = *(const f32x4*)(rs + 4), x2 = *(const f32x4*)(rs + 128), x3 = *(const f32x4*)(rs + 132);
        const f32x4 g0 = *(const f32x4*)g, g1 = *(const f32x4*)(g + 4), g2 = *(const f32x4*)(g + 128), g3 = *(const f32x4*)(g + 132);
        if (dup) return;
        *(f32x4*)x = x0 + g0 * lo0; *(f32x4*)(x + 4) = x1 + g1 * lo1; *(f32x4*)(x + 128) = x2 + g2 * hi0; *(f32x4*)(x + 132) = x3 + g3 * hi1;
    }
};
struct EpiMoe1 {
    bf16_t* ACT;
    __device__ __forceinline__ void seg(const Unit& u, int, int r, int c0, f32x4& lo0, f32x4& lo1, f32x4& hi0, f32x4& hi1) const {
        const int row = u.pm * 256 + r;
        f32x4 a, b;
#pragma unroll
        for (int j = 0; j < 4; ++j) { a[j] = silu_f(lo0[j]) * hi0[j]; b[j] = silu_f(lo1[j]) * hi1[j]; }
        *(u32x4*)(ACT + (size_t)row * 512 + u.pn * 128 + c0) = pack8(a, b);
    }
};
struct EpiMoe2 {
    bf16_t* Y;
    __device__ __forceinline__ void seg(const Unit& u, int, int r, int c0, f32x4& lo0, f32x4& lo1, f32x4& hi0, f32x4& hi1) const {
        bf16_t* d = Y + (size_t)(u.pm * 256 + r) * 1024 + u.pn * 256 + c0;
        *(u32x4*)d = pack8(lo0, lo1); *(u32x4*)(d + 128) = pack8(hi0, hi1);
    }
};

#define LAS __attribute__((address_space(3)))
typedef short bf16x8 __attribute__((ext_vector_type(8)));
constexpr int HTB = 128 * 64 * 2;
__device__ __forceinline__ int lds_byte(int r, int c) { const int st = (r >> 4) * 2 + (c >> 5), rr = r & 15, cc = c & 31, ob = rr * 64 + cc * 2; return st * 1024 + (ob ^ (((ob >> 9) & 1) << 5)); }
__device__ __forceinline__ void stage_rc(int b, int& R, int& C) { const int st = b / 1024, sb = b % 1024, swz = sb ^ (((sb >> 9) & 1) << 5); R = (st >> 1) * 16 + swz / 64; C = (st & 1) * 32 + (swz % 64) / 2; }
__device__ __forceinline__ int perm32(int rho) { const int n = rho >> 4, i = rho & 15; return 8 * (i >> 2) + 4 * n + (i & 3); }

template <bool GATHER, class Sched, class Epi>
__device__ __forceinline__ void gemm_mfma(LAS unsigned char* lds, const Sched& S, const Epi& E, const int K, const int lda, const int ldb, const int nseg) {
    const int tid = tid_fresh(), wid = __builtin_amdgcn_readfirstlane(tid >> 6), lane = tid & 63, wr = wid >> 2, wc = wid & 3, fr = lane & 15, fq = lane >> 4;
    const int nt = K / 64, tseg = nt / nseg;
    unsigned vA0[2], vA1[2], nA0[2], nA1[2], voffB[2]; int rowA[2], colA[2];
#pragma unroll
    for (int i = 0; i < 2; ++i) { int R, C; stage_rc(tid * 16 + i * 8192, R, C); const int Rb = (R & ~31) + perm32(R & 31);
        rowA[i] = R; colA[i] = C;
        vA0[i] = (unsigned)(R * lda + C) * 2u; vA1[i] = vA0[i] + (unsigned)(128 * lda * 2); nA0[i] = vA0[i]; nA1[i] = vA1[i];
        voffB[i] = (unsigned)(Rb * ldb + C) * 2u; }
    const size_t kstep = 128;
    const size_t hstepB = (size_t)128 * ldb * 2;
    const unsigned ldsw = (unsigned)wid * 1024u;
    const int aoff = lds_byte(wr * 64 + fr, fq * 8), boff = lds_byte(wc * 32 + fr, fq * 8);
#define PG8_SA(b, h) (((b) * 2 + (h)) * HTB)
#define PG8_SB(b, h) ((4 + (b) * 2 + (h)) * HTB)
#define PG8_STAGE(bufoff, gbase, voff) do { _Pragma("unroll") for (int _i = 0; _i < 2; ++_i) \
        __builtin_amdgcn_global_load_lds((const unsigned*)((const char*)(gbase) + (voff)[_i]), (LAS unsigned*)(lds + (bufoff) + ldsw + _i * 8192), 16, 0, 0); } while (0)
#define PG8_LDA(dst, b, h) do { _Pragma("unroll") for (int m = 0; m < 4; ++m) _Pragma("unroll") for (int k = 0; k < 2; ++k) dst[m][k] = *(const LAS bf16x8*)(lds + PG8_SA(b, h) + aoff + m * 2048 + k * 1024); } while (0)
#define PG8_LDB(dst, b, h) do { _Pragma("unroll") for (int n = 0; n < 2; ++n) _Pragma("unroll") for (int k = 0; k < 2; ++k) dst[n][k] = *(const LAS bf16x8*)(lds + PG8_SB(b, h) + boff + n * 2048 + k * 1024); } while (0)
#define PG8_MMA(ai, bj, At, Bt) do { __builtin_amdgcn_s_setprio(1); _Pragma("unroll") for (int m = 0; m < 4; ++m) _Pragma("unroll") for (int n = 0; n < 2; ++n) _Pragma("unroll") for (int k = 0; k < 2; ++k) \
        acc[ai][bj][m][n] = __builtin_amdgcn_mfma_f32_16x16x32_bf16(Bt[n][k], At[m][k], acc[ai][bj][m][n], 0, 0, 0); __builtin_amdgcn_s_setprio(0); } while (0)
#define PG8_WAIT_V(n) asm volatile("s_waitcnt vmcnt(" #n ")" ::: "memory")
#define PG8_WAIT_L(n) asm volatile("s_waitcnt lgkmcnt(" #n ")" ::: "memory")
#define PG8_BAR __builtin_amdgcn_s_barrier()
#define PG8_SCHED __builtin_amdgcn_sched_barrier(0)
#define PG8_EPI(sg) do { _Pragma("unroll") for (int ai = 0; ai < 2; ++ai) _Pragma("unroll") for (int m = 0; m < 4; ++m) { \
        int r_ = ai * 128 + wr * 64 + m * 16 + fr; asm volatile("" : "+v"(r_));     \
        E.seg(cur, (sg), r_, wc * 32 + fq * 8, acc[ai][0][m][0], acc[ai][0][m][1], acc[ai][1][m][0], acc[ai][1][m][1]); } } while (0)
    Unit cur, nxt; int ui = 0;
    if (!S.next(0, cur)) return;
    f32x4 acc[2][2][4][2];
#pragma unroll
    for (int a = 0; a < 2; ++a)
#pragma unroll
        for (int b = 0; b < 2; ++b)
#pragma unroll
            for (int m = 0; m < 4; ++m)
#pragma unroll
                for (int n = 0; n < 2; ++n) acc[a][b][m][n] = (f32x4){0.f, 0.f, 0.f, 0.f};
    bf16x8 At[4][2], B0[2][2], B1[2][2];
    const char* cA = (const char*)cur.A; const char* cB = (const char*)cur.B;
    if (GATHER) {
#pragma unroll
        for (int i = 0; i < 2; ++i) { vA0[i] = (unsigned)(cur.tok[rowA[i]] * lda + colA[i]) * 2u; vA1[i] = (unsigned)(cur.tok[128 + rowA[i]] * lda + colA[i]) * 2u; nA0[i] = vA0[i]; nA1[i] = vA1[i]; }
    }
    PG8_STAGE(PG8_SB(0, 0), cB, voffB); PG8_STAGE(PG8_SA(0, 0), cA, vA0); PG8_STAGE(PG8_SB(0, 1), cB + hstepB, voffB); PG8_STAGE(PG8_SA(0, 1), cA, vA1);
    if (wr == 1) PG8_BAR;
    PG8_WAIT_V(4); PG8_BAR;
    PG8_STAGE(PG8_SB(1, 0), cB + kstep, voffB); PG8_STAGE(PG8_SA(1, 0), cA + kstep, vA0); PG8_STAGE(PG8_SB(1, 1), cB + hstepB + kstep, voffB);
    PG8_WAIT_V(6); PG8_BAR;
    for (;;) {
        const bool has_next = S.next(ui + 1, nxt);
        const char* nA = has_next ? (const char*)nxt.A : cA; const char* nB = has_next ? (const char*)nxt.B : cB;
        if (GATHER) {
            const int* tk = has_next ? nxt.tok : cur.tok;
#pragma unroll
            for (int i = 0; i < 2; ++i) { nA0[i] = (unsigned)(tk[rowA[i]] * lda + colA[i]) * 2u; nA1[i] = (unsigned)(tk[128 + rowA[i]] * lda + colA[i]) * 2u; }
        }
#pragma nounroll
        for (int sg = 0; sg < nseg; ++sg) {
#pragma nounroll
        for (int tt = 0; tt < tseg; tt += 2) {
            const int t = sg * tseg + tt;
            const bool last = (t == nt - 2);
            const char* a1 = cA + (size_t)(t + 1) * kstep;
            const char* a2 = last ? nA : cA + (size_t)(t + 2) * kstep; const char* b2 = last ? nB : cB + (size_t)(t + 2) * kstep;
            const char* a3 = a2 + kstep; const char* b3 = b2 + kstep;
            unsigned w0[2], w1[2];
#pragma unroll
            for (int i = 0; i < 2; ++i) { w0[i] = last ? nA0[i] : vA0[i]; w1[i] = last ? nA1[i] : vA1[i]; }
            PG8_LDB(B0, 0, 0); PG8_SCHED; PG8_LDA(At, 0, 0); PG8_STAGE(PG8_SA(1, 1), a1, vA1);
            PG8_WAIT_L(8); PG8_BAR; PG8_WAIT_L(0); PG8_MMA(0, 0, At, B0); PG8_BAR; PG8_SCHED;
            PG8_LDB(B1, 0, 1); PG8_STAGE(PG8_SB(0, 0), b2, voffB);
            PG8_BAR; PG8_WAIT_L(0); PG8_MMA(0, 1, At, B1); PG8_BAR;
            PG8_LDA(At, 0, 1); PG8_STAGE(PG8_SA(0, 0), a2, w0);
            PG8_BAR; PG8_WAIT_L(0); PG8_MMA(1, 0, At, B0); PG8_BAR; PG8_SCHED;
            PG8_STAGE(PG8_SB(0, 1), b2 + hstepB, voffB);
            PG8_WAIT_V(6); PG8_BAR; PG8_MMA(1, 1, At, B1); PG8_BAR;
            PG8_LDB(B0, 1, 0); PG8_SCHED; PG8_LDA(At, 1, 0); PG8_STAGE(PG8_SA(0, 1), a2, w1);
            PG8_WAIT_L(8); PG8_BAR; PG8_WAIT_L(0); PG8_MMA(0, 0, At, B0); PG8_BAR; PG8_SCHED;
            PG8_LDB(B1, 1, 1); PG8_STAGE(PG8_SB(1, 0), b3, voffB);
            PG8_BAR; PG8_WAIT_L(0); PG8_MMA(0, 1, At, B1); PG8_BAR;
            PG8_LDA(At, 1, 1); PG8_STAGE(PG8_SA(1, 0), a3, w0);
            PG8_BAR; PG8_WAIT_L(0); PG8_MMA(1, 0, At, B0); PG8_BAR; PG8_SCHED;
            PG8_STAGE(PG8_SB(1, 1), b3 + hstepB, voffB);
            PG8_WAIT_V(6); PG8_BAR; PG8_MMA(1, 1, At, B1); PG8_BAR;
        }
        PG8_EPI(sg);
        }
        if (!has_next) break;
#pragma unroll
        for (int a = 0; a < 2; ++a)
#pragma unroll
            for (int b = 0; b < 2; ++b)
#pragma unroll
                for (int m = 0; m < 4; ++m)
#pragma unroll
                    for (int n = 0; n < 2; ++n) acc[a][b][m][n] = (f32x4){0.f, 0.f, 0.f, 0.f};
        cur = nxt; cA = nA; cB = nB; ++ui;
#pragma unroll
        for (int i = 0; i < 2; ++i) { vA0[i] = nA0[i]; vA1[i] = nA1[i]; }
    }
    PG8_WAIT_V(0);
    if (wr == 0) PG8_BAR;
    PG8_BAR;
#undef PG8_SA
#undef PG8_SB
#undef PG8_STAGE
#undef PG8_LDA
#undef PG8_LDB
#undef PG8_MMA
#undef PG8_WAIT_V
#undef PG8_WAIT_L
#undef PG8_BAR
#undef PG8_SCHED
#undef PG8_EPI
}

template <bool GATHER = false, class Sched, class Epi>
__device__ __forceinline__ void gemm_run(unsigned char* lds, const Sched& S, const Epi& E, int K, int lda, int ldb, int nseg) {
    __syncthreads();
    gemm_mfma<GATHER>((LAS unsigned char*)lds, S, E, K, lda, ldb, nseg);
    __syncthreads();
}

struct TrDesc { const float* src; const float* cscale; bf16_t* dst; int ld_src, ld_dst, valid; };
__device__ __forceinline__ void tr_load(const TrDesc& d, f32x4 (&v)[16]) {
    if (d.src) {
#pragma unroll
        for (int i = 0; i < 16; ++i) v[i] = *(const f32x4*)(d.src + (size_t)(4 * i) * d.ld_src);
    } else {
#pragma unroll
        for (int i = 0; i < 16; ++i) v[i] = (f32x4){0.f, 0.f, 0.f, 0.f};
    }
}
__device__ __forceinline__ void tr_store(const TrDesc& d, f32x4 (&v)[16], float* scr, int lane) {
    const int c4 = (lane & 15) * 4, kr = lane >> 4;
    if (d.cscale) { const f32x4 s = *(const f32x4*)d.cscale;
#pragma unroll
        for (int i = 0; i < 16; ++i) v[i] = v[i] * s; }
#pragma unroll
    for (int i = 0; i < 16; ++i) { float* q = scr + (kr + 4 * i) * 65 + c4; q[0] = v[i][0]; q[1] = v[i][1]; q[2] = v[i][2]; q[3] = v[i][3]; }
    asm volatile("s_waitcnt lgkmcnt(0)" ::: "memory");
    const int c = lane & 7;
#pragma unroll
    for (int j = 0; j < 8; ++j) { const int n = (lane >> 3) + 8 * j; const float* s = scr + (8 * c) * 65 + n;
        u32x4 o; o.x = pk2(s[0 * 65], s[1 * 65]); o.y = pk2(s[2 * 65], s[3 * 65]); o.z = pk2(s[4 * 65], s[5 * 65]); o.w = pk2(s[6 * 65], s[7 * 65]);
        *(u32x4*)(d.dst + (size_t)n * d.ld_dst + 8 * c) = o; }
    asm volatile("s_waitcnt lgkmcnt(0)" ::: "memory");
}
__device__ __forceinline__ TrDesc tr_desc(const float* W, int ld_src, int srcq, bf16_t* WT, int ld_dst, int n_dst, int kdst0, int k0, int lane, const float* cscale = nullptr) {
    TrDesc d; d.ld_src = ld_src; d.ld_dst = ld_dst; d.valid = 1;
    d.src = srcq >= 0 ? W + (size_t)(k0 + (lane >> 4)) * ld_src + srcq : nullptr;
    d.cscale = (cscale && srcq >= 0) ? cscale + srcq : nullptr;
    d.dst = WT + (size_t)n_dst * ld_dst + kdst0 + k0; return d;
}
constexpr int CV_MIX_ITEMS = 2880 + 64 + 768 + 256;
constexpr int CV_EXP_ITEMS = 32 * 384;
__device__ __forceinline__ TrDesc convert_desc(const Params& p, int le, int lm, int it, int lane) {
    unsigned char* ws = p.ws;
    const int c4 = (lane & 15) * 4;
    if (le >= 0) {
        if (it < CV_EXP_ITEMS) {
            const int e = it / 384, r = it % 384;
            if (r < 256) { const int up = r >> 7, q = r & 127, kb = ((q >> 5) << 2) | ((q >> 1) & 3), nb = (((q >> 3) & 3) << 1) | (q & 1); const int c = nb * 64;
                const float* src = (up ? p.w_eu : p.w_eg) + (size_t)(le * 32 + e) * 1024 * 512;
                return tr_desc(src, 512, c + c4, (bf16_t*)(ws + WS_EW1) + (size_t)e * 1048576, 1024, (c >> 7) * 256 + up * 128 + (c & 127), 0, kb * 64, lane); }
            const int q = r - 256, kb = ((q >> 6) << 2) | ((q >> 1) & 3), nb = (((q >> 3) & 7) << 1) | (q & 1);
            return tr_desc(p.w_ed + (size_t)(le * 32 + e) * 512 * 1024, 1024, nb * 64 + c4, (bf16_t*)(ws + WS_EW2) + (size_t)e * 524288, 512, nb * 64, 0, kb * 64, lane);
        }
        it -= CV_EXP_ITEMS;
    }
    const int l = lm;
    if (it < 2880) { const int R = it >> 4, kb = it & 15, dstn = R * 64; int srcq;
        if (R < 80) srcq = dstn + c4; else if (R < 128) srcq = dstn + 16 + c4; else if (R < 176) srcq = dstn + 48 + c4;
        else if (R == 176) srcq = c4 < 32 ? 8208 + c4 : (c4 < 48 ? 5120 + (c4 - 32) : -1); else srcq = -1;
        return tr_desc(p.w_in + (size_t)l * 1024 * DIN, DIN, srcq, (bf16_t*)(ws + WS_WIN), 1024, dstn, 0, kb * 64, lane); }
    it -= 2880;
    if (it < 64) { const int g = it >> 4, r = it & 15, kb = r >> 2, nb = r & 3;
        return tr_desc(p.pool_w + (size_t)(l * 4 + g) * 65536, 256, nb * 64 + c4, (bf16_t*)(ws + WS_WPOOL) + (size_t)g * 65536, 256, nb * 64, 0, kb * 64, lane, p.pool_scale + l * 1024 + g * 256); }
    it -= 64;
    if (it < 768) { const int br = it >> 8, r = it & 255, kb = r >> 4, nb = r & 15;
        return tr_desc(p.w_branch + (size_t)(l * 3 + br) * 1048576, 1024, nb * 64 + c4, (bf16_t*)(ws + WS_WBR), 3072, nb * 64, br * 1024, kb * 64, lane); }
    it -= 768;
    { const int kb = it >> 4, nb = it & 15;
      return tr_desc(p.w_out + (size_t)l * 1048576, 1024, nb * 64 + c4, (bf16_t*)(ws + WS_WOUT), 1024, nb * 64, 0, kb * 64, lane); }
}
__device__ __forceinline__ void convert_run(const Params& p, int le, int lm, int first, int step, float* scr, int lane) {
    const int nitems = (le >= 0 ? CV_EXP_ITEMS : 0) + (lm >= 0 ? CV_MIX_ITEMS : 0);
    if (first >= nitems) return;
    f32x4 va[16], vb[16];
    TrDesc da = convert_desc(p, le, lm, first, lane), db;
    tr_load(da, va);
    for (int it = first; it < nitems; it += 2 * step) {
        const int i1 = it + step, i2 = it + 2 * step;
        if (i1 < nitems) { db = convert_desc(p, le, lm, i1, lane); tr_load(db, vb); }
        tr_store(da, va, scr, lane);
        if (i1 >= nitems) break;
        if (i2 < nitems) { da = convert_desc(p, le, lm, i2, lane); tr_load(da, va); }
        tr_store(db, vb, scr, lane);
    }
}

__device__ __forceinline__ void cvmicro_load(const Params& p, int le, int m, int lane, f32x4 (&v)[8], TrDesc& d) {
    d = convert_desc(p, le, -1, m >> 1, lane);
    const float* s = d.src + (size_t)(32 * (m & 1)) * d.ld_src;
#pragma unroll
    for (int i = 0; i < 8; ++i) v[i] = *(const f32x4*)(s + (size_t)(4 * i) * d.ld_src);
}
__device__ __forceinline__ void cvmicro_store(const TrDesc& d, int m, const f32x4 (&v)[8], LAS float* scr, int lane) {
    const int c4 = (lane & 15) * 4, kr = lane >> 4;
#pragma unroll
    for (int i = 0; i < 8; ++i) { LAS float* q = scr + (kr + 4 * i) * 65 + c4; q[0] = v[i][0]; q[1] = v[i][1]; q[2] = v[i][2]; q[3] = v[i][3]; }
    asm volatile("s_waitcnt lgkmcnt(0)" ::: "memory");
    bf16_t* drow = d.dst + (size_t)lane * d.ld_dst + 32 * (m & 1);
#pragma unroll
    for (int g = 0; g < 4; ++g) { const LAS float* s = scr + (8 * g) * 65 + lane;
        u32x4 o; o.x = pk2(s[0 * 65], s[1 * 65]); o.y = pk2(s[2 * 65], s[3 * 65]); o.z = pk2(s[4 * 65], s[5 * 65]); o.w = pk2(s[6 * 65], s[7 * 65]);
        *(u32x4*)(drow + 8 * g) = o; }
    asm volatile("s_waitcnt lgkmcnt(0)" ::: "memory");
}

__device__ __forceinline__ void phase_pre(const Params& p, unsigned char* ldsb, int bid, int nb) {
    float* lds = reinterpret_cast<float*>(ldsb);
    const int tid = tid_fresh(), lane = tid & 63, wave = tid >> 6;
    for (int i = tid; i < 5 * 1024; i += NTHR) { const float v = i < 4096 ? p.c[i] : p.c_ctx[i - 4096]; lds[i] = silu_f(v); }
    __syncthreads();
    float* red = lds + 5120;
    for (int it = bid; it < 2 * 96; it += nb) {
        const int l = it / 96, j = (it % 96) * 64 + lane;
        const float* w = p.w_ada + (size_t)l * 1024 * 6144 + j;
        float a0 = 0, a1 = 0, a2 = 0, a3 = 0, a4 = 0;
#pragma unroll 16
        for (int k = wave * 128; k < wave * 128 + 128; ++k) { const float wv = w[(size_t)k * 6144];
            a0 += lds[k] * wv; a1 += lds[1024 + k] * wv; a2 += lds[2048 + k] * wv; a3 += lds[3072 + k] * wv; a4 += lds[4096 + k] * wv; }
        red[(wave * 5 + 0) * 64 + lane] = a0; red[(wave * 5 + 1) * 64 + lane] = a1; red[(wave * 5 + 2) * 64 + lane] = a2;
        red[(wave * 5 + 3) * 64 + lane] = a3; red[(wave * 5 + 4) * 64 + lane] = a4;
        __syncthreads();
        if (tid < 320) { const int r = tid >> 6, jj = tid & 63; float s = 0;
            for (int w8 = 0; w8 < 8; ++w8) s += red[(w8 * 5 + r) * 64 + jj];
            const int col = (it % 96) * 64 + jj;
            ((float*)(p.ws + WS_MOD))[(size_t)(l * 5 + r) * 6144 + col] = s + p.b_ada[l * 6144 + col]; }
        __syncthreads();
    }
    __syncthreads();
    float* scr = lds + wave * (64 * 65);
    convert_run(p, -1, 0, bid * 8 + wave, nb * 8, scr, lane);
}

__device__ __forceinline__ void norm_mod_row(f32x4 (&v)[4], const float* g, const float* shift, const float* scale, int lane) {
    float s = 0.f;
#pragma unroll
    for (int j = 0; j < 4; ++j) s += (v[j][0] * v[j][0] + v[j][1] * v[j][1]) + (v[j][2] * v[j][2] + v[j][3] * v[j][3]);
    const float rs = __builtin_amdgcn_rsqf(wave_sum(s) * (1.f / 1024.f) + EPS);
#pragma unroll
    for (int j = 0; j < 4; ++j) { const int c = 4 * lane + 256 * j; const f32x4 gg = *(const f32x4*)(g + c);
        f32x4 y = v[j] * rs * gg;
        if (shift) { const f32x4 sh = *(const f32x4*)(shift + c), sc = *(const f32x4*)(scale + c); y = y * (1.f + sc) + sh; }
        v[j] = y; }
}
__device__ __forceinline__ void store_row_bf16(bf16_t* dst, const f32x4 (&v)[4], int lane) {
#pragma unroll
    for (int j = 0; j < 4; ++j) { u32x2 w; w.x = pk2(v[j][0], v[j][1]); w.y = pk2(v[j][2], v[j][3]); *(u32x2*)(dst + 4 * lane + 256 * j) = w; }
}

__device__ __forceinline__ void phase_norm1(const Params& p, int bid, int nb) {
    const int lane = tid_fresh() & 63, wave = tid_fresh() >> 6;
    const float* mod = (const float*)(p.ws + WS_MOD);
    const int stride = nb * 8;
    int m = bid * 8 + wave;
    f32x4 v[4], w[4];
    if (m < MT) { const float* src = m < MC ? p.ctx + (size_t)m * 1024 : p.x + (size_t)(m - MC) * 1024;
#pragma unroll
        for (int j = 0; j < 4; ++j) v[j] = *(const f32x4*)(src + 4 * lane + 256 * j); }
    for (; m < MT; m += stride) {
        const int mn = m + stride;
        if (mn < MT) { const float* src = mn < MC ? p.ctx + (size_t)mn * 1024 : p.x + (size_t)(mn - MC) * 1024;
#pragma unroll
            for (int j = 0; j < 4; ++j) w[j] = *(const f32x4*)(src + 4 * lane + 256 * j); }
        const float* mr = mod + modrow(m) * 6144;
        norm_mod_row(v, p.g_mix, mr, mr + 1024, lane);
        store_row_bf16((bf16_t*)(p.ws + WS_H) + (size_t)m * 1024, v, lane);
#pragma unroll
        for (int j = 0; j < 4; ++j) v[j] = w[j];
    }
}

__device__ __forceinline__ float wave_incl_sum(float v, int lane) {
#pragma unroll
    for (int o = 1; o < 64; o <<= 1) { const float u = __shfl_up(v, o); if (lane >= o) v += u; }
    return v;
}
__device__ __forceinline__ float wave_incl_max(float v, int lane) {
#pragma unroll
    for (int o = 1; o < 64; o <<= 1) { const float u = __shfl_up(v, o); if (lane >= o) v = fmaxf(v, u); }
    return v;
}
__device__ __forceinline__ u32x2 pack4(f32x4 a) { u32x2 w; w.x = pk2(a[0], a[1]); w.y = pk2(a[2], a[3]); return w; }

__device__ __forceinline__ void chunk_geom(int gc, int& rbase, int& n0, int& len) {
    const int b = gc / 68, cin = gc % 68;
    if (cin < 4) { rbase = b * 256; n0 = cin * 64; len = 256; } else { rbase = MC + b * 4096; n0 = (cin - 4) * 64; len = 4096; }
}
__device__ __forceinline__ void conv8x4(const u32x4 (&raw)[7], const float* cw, const float* cb, int ch0, float scale, u32x4 (&out)[4]) {
    float w[4][8], bs[8];
#pragma unroll
    for (int j = 0; j < 4; ++j) { const f32x4 a = *(const f32x4*)(cw + j * 2048 + ch0), b2 = *(const f32x4*)(cw + j * 2048 + ch0 + 4);
#pragma unroll
        for (int i = 0; i < 4; ++i) { w[j][i] = a[i]; w[j][4 + i] = b2[i]; } }
    { const f32x4 a = *(const f32x4*)(cb + ch0), b2 = *(const f32x4*)(cb + ch0 + 4);
#pragma unroll
      for (int i = 0; i < 4; ++i) { bs[i] = a[i]; bs[4 + i] = b2[i]; } }
    float f[7][8];
#pragma unroll
    for (int k = 0; k < 7; ++k) unpack8(raw[k], f[k]);
#pragma unroll
    for (int pp = 0; pp < 4; ++pp) { f32x4 o0, o1;
#pragma unroll
        for (int i = 0; i < 8; ++i) { float a = bs[i];
#pragma unroll
            for (int j = 0; j < 4; ++j) a += w[j][i] * f[pp + j][i];
            a = silu_f(a) * scale; if (i < 4) o0[i] = a; else o1[i - 4] = a; }
        out[pp] = pack8(o0, o1); }
}
__device__ __forceinline__ void load_raw7(const bf16_t* src, size_t ld, int rbase, int tbase, int len, u32x4 (&raw)[7]) {
#pragma unroll
    for (int k = 0; k < 7; ++k) { const int t = tbase + k; const bool ok = (t >= 0) && (t < len); const int tc = t < 0 ? 0 : (t >= len ? len - 1 : t);
        u32x4 a = *(const u32x4*)(src + (size_t)(rbase + tc) * ld);
        if (!ok) a = (u32x4){0u, 0u, 0u, 0u};
        raw[k] = a; }
}
template <class F>
__device__ __forceinline__ void tile_transpose_out(const LAS bf16_t* tile, int ldsw, int ncol, int tid, F rowptr) {
    for (int q = tid; q < ncol * 8; q += NTHR) { const int c = q % ncol, sc = q / ncol;
        unsigned v[8];
#pragma unroll
        for (int i = 0; i < 8; ++i) v[i] = tile[(sc * 8 + i) * ldsw + c];
        u32x4 w; w.x = v[0] | (v[1] << 16); w.y = v[2] | (v[3] << 16); w.z = v[4] | (v[5] << 16); w.w = v[6] | (v[7] << 16);
        *(u32x4*)(rowptr(c) + sc * 8) = w; }
}

__device__ __forceinline__ void conv_m_item(const Params& p, int l, int item, LAS unsigned char* lds) {
    const int tid = tid_fresh(), gc = item >> 2, hd = item & 3;
    int rbase, n0, len; chunk_geom(gc, rbase, n0, len);
    const int cs = tid & 31, tg = tid >> 5, d0 = cs * 8, i0 = tg * 4;
    const float* cw = p.mconv_w + (size_t)l * 4 * 2048; const float* cb = p.mconv_b + (size_t)l * 2048;
    LAS bf16_t* Kl = (LAS bf16_t*)lds; LAS bf16_t* Vl = (LAS bf16_t*)(lds + 64 * 528);
    __syncthreads();
    { u32x4 raw[7], o[4];
      load_raw7((const bf16_t*)(p.ws + WS_Q) + hd * 256 + d0, 1024, rbase, n0 + i0 - 2, len, raw);
      conv8x4(raw, cw, cb, hd * 256 + d0, 1.0f, o);
#pragma unroll
      for (int pp = 0; pp < 4; ++pp) *(u32x4*)((bf16_t*)(p.ws + WS_QC) + (size_t)(rbase + n0 + i0 + pp) * 1024 + hd * 256 + d0) = o[pp];
      load_raw7((const bf16_t*)(p.ws + WS_K) + hd * 256 + d0, 1024, rbase, n0 + i0 - 2, len, raw);
      conv8x4(raw, cw, cb, 1024 + hd * 256 + d0, 0.0625f, o);
#pragma unroll
      for (int pp = 0; pp < 4; ++pp) { *(u32x4*)((bf16_t*)(p.ws + WS_KC) + (size_t)(rbase + n0 + i0 + pp) * 1024 + hd * 256 + d0) = o[pp];
          *(LAS u32x4*)((LAS unsigned char*)Kl + (i0 + pp) * 528 + d0 * 2) = o[pp]; } }
#pragma unroll
    for (int j = 0; j < 4; ++j) { const int q = tid + NTHR * j, row = q >> 5, ch = q & 31;
        *(LAS u32x4*)((LAS unsigned char*)Vl + row * 528 + ch * 16) = *(const u32x4*)((const bf16_t*)(p.ws + WS_V) + (size_t)(rbase + n0 + row) * 1024 + hd * 256 + ch * 8); }
    __syncthreads();
    if ((tid >> 6) < 2) {
        const int dir = tid >> 6, lane = tid & 63, j = dir ? 63 - lane : lane;
        const float* g = (const float*)(p.ws + WS_GA) + (size_t)(rbase + n0 + j) * 16;
        const float ig = g[dir * 4 + hd] + p.mgate_b[l * 16 + dir * 4 + hd], lf = logsigmoid_f(g[(2 + dir) * 4 + hd] + p.mgate_b[l * 16 + (2 + dir) * 4 + hd]);
        const float cum = wave_incl_sum(lf, lane), a = ig - cum, pm = wave_incl_max(a, lane);
        const size_t o = (size_t)(gc * 8 + dir * 4 + hd) * 64 + j;
        ((float*)(p.ws + WS_MGA))[o] = a; ((float*)(p.ws + WS_MGC))[o] = cum; ((float*)(p.ws + WS_MGP))[o] = pm;
    }
    bf16_t* kct = (bf16_t*)(p.ws + WS_KCT) + (size_t)(gc * 4 + hd) * 16384; bf16_t* vt = (bf16_t*)(p.ws + WS_VT) + (size_t)(gc * 4 + hd) * 16384;
    tile_transpose_out(Kl, 264, 256, tid, [&](int c) { return kct + c * 64; });
    tile_transpose_out(Vl, 264, 256, tid, [&](int c) { return vt + c * 64; });
}

__device__ __forceinline__ void conv_s_item(const Params& p, int l, int item, LAS unsigned char* lds) {
    const int tid = tid_fresh(), gc = item >> 2, grp = item & 3;
    int rbase, n0, len; chunk_geom(gc, rbase, n0, len);
    const int cs = tid & 31, tg = tid >> 5, i0 = tg * 4;
    const float* cw = p.sconv_w + (size_t)l * 4 * 2048; const float* cb = p.sconv_b + (size_t)l * 2048;
    LAS bf16_t* Bl = (LAS bf16_t*)lds; LAS bf16_t* Xl = (LAS bf16_t*)(lds + 64 * 272);
    __syncthreads();
    { u32x4 raw[7], o[4];
      const int isC = cs >> 4, nn = (cs & 15) * 8;
      load_raw7((const bf16_t*)(p.ws + (isC ? WS_SC : WS_SB)) + grp * 128 + nn, 512, rbase, n0 + i0 - 2, len, raw);
      conv8x4(raw, cw, cb, 1024 + isC * 512 + grp * 128 + nn, 1.0f, o);
      bf16_t* dst = (bf16_t*)(p.ws + (isC ? WS_CC : WS_BC)) + grp * 128 + nn;
#pragma unroll
      for (int pp = 0; pp < 4; ++pp) { *(u32x4*)(dst + (size_t)(rbase + n0 + i0 + pp) * 512) = o[pp];
          if (!isC) *(LAS u32x4*)((LAS unsigned char*)Bl + (i0 + pp) * 272 + nn * 2) = o[pp]; }
      load_raw7((const bf16_t*)(p.ws + WS_SX) + grp * 256 + cs * 8, 1024, rbase, n0 + i0 - 2, len, raw);
      conv8x4(raw, cw, cb, grp * 256 + cs * 8, 1.0f, o);
#pragma unroll
      for (int pp = 0; pp < 4; ++pp) *(LAS u32x4*)((LAS unsigned char*)Xl + (i0 + pp) * 528 + cs * 16) = o[pp]; }
    __syncthreads();
    { const int wv = tid >> 6, lane = tid & 63, dir = wv >> 2, hd = grp * 4 + (wv & 3), j = dir ? 63 - lane : lane;
      const float dtv = softplus_f(((const float*)(p.ws + WS_DT))[(size_t)(rbase + n0 + j) * 32 + dir * 16 + hd] + p.sdt_bias[l * 32 + dir * 16 + hd]);
      const float acs = wave_incl_sum(dtv * -__expf(p.sa_log[l * 32 + dir * 16 + hd]), lane);
      const size_t o = (size_t)(gc * 32 + dir * 16 + hd) * 64 + j;
      ((float*)(p.ws + WS_SACS))[o] = acs; ((float*)(p.ws + WS_SDT))[o] = dtv; }
    bf16_t* bct = (bf16_t*)(p.ws + WS_BCT) + (size_t)(gc * 4 + grp) * 8192; bf16_t* xct = (bf16_t*)(p.ws + WS_XCT) + (size_t)(gc * 16 + grp * 4) * 4096;
    tile_transpose_out(Bl, 136, 128, tid, [&](int c) { return bct + c * 64; });
    tile_transpose_out(Xl, 264, 256, tid, [&](int c) { return xct + c * 64; });
}

__device__ __forceinline__ void pool_window_item(const Params& p, int it, LAS unsigned char* lds) {
    const int tid = tid_fresh();
    bf16_t* BR = (bf16_t*)(p.ws + WS_BR);
    __syncthreads();
    if (it < 256) {
        const int row0 = MC + it * 64;
        for (int q = tid; q < 64 * 128; q += NTHR) { const int r = q >> 7, ch = q & 127;
            *(LAS u32x4*)(lds + q * 16) = *(const u32x4*)(BR + (size_t)(row0 + r) * 3072 + ch * 8); }
        __syncthreads();
        for (int q = tid; q < 64 * 128; q += NTHR) { const int r = q >> 7, ch = q & 127, w = 2 << (ch >> 5);
            int lo = r - (w >> 1), hi = lo + w - 1; lo = lo < 0 ? 0 : lo; hi = hi > 63 ? 63 : hi;
            float s[8] = {0, 0, 0, 0, 0, 0, 0, 0}, self[8];
            for (int rr = lo; rr <= hi; ++rr) { float f[8]; unpack8(*(const LAS u32x4*)(lds + (rr * 128 + ch) * 16), f);
#pragma unroll
                for (int j = 0; j < 8; ++j) s[j] += f[j]; }
            unpack8(*(const LAS u32x4*)(lds + q * 16), self);
            const float inv = __builtin_amdgcn_rcpf((float)(hi - lo + 1)); f32x4 a, b;
#pragma unroll
            for (int j = 0; j < 4; ++j) { a[j] = s[j] * inv - self[j]; b[j] = s[4 + j] * inv - self[4 + j]; }
            *(u32x4*)(BR + (size_t)(row0 + r) * 3072 + ch * 8) = pack8(a, b); }
    } else {
        const int bb = (it - 256) >> 2, g = (it - 256) & 3, row0 = bb * 256, w = 2 << g;
        for (int q = tid; q < 256 * 32; q += NTHR) { const int r = q >> 5, ch = q & 31;
            *(LAS u32x4*)(lds + q * 16) = *(const u32x4*)(BR + (size_t)(row0 + r) * 3072 + g * 256 + ch * 8); }
        __syncthreads();
        for (int q = tid; q < 256 * 32; q += NTHR) { const int r = q >> 5, ch = q & 31;
            int lo = r - (w >> 1), hi = lo + w - 1; lo = lo < 0 ? 0 : lo; hi = hi > 255 ? 255 : hi;
            float s[8] = {0, 0, 0, 0, 0, 0, 0, 0}, self[8];
            for (int rr = lo; rr <= hi; ++rr) { float f[8]; unpack8(*(const LAS u32x4*)(lds + (rr * 32 + ch) * 16), f);
#pragma unroll
                for (int j = 0; j < 8; ++j) s[j] += f[j]; }
            unpack8(*(const LAS u32x4*)(lds + q * 16), self);
            const float inv = __builtin_amdgcn_rcpf((float)(hi - lo + 1)); f32x4 a, b;
#pragma unroll
            for (int j = 0; j < 4; ++j) { a[j] = s[j] * inv - self[j]; b[j] = s[4 + j] * inv - self[4 + j]; }
            *(u32x4*)(BR + (size_t)(row0 + r) * 3072 + g * 256 + ch * 8) = pack8(a, b); }
    }
    __syncthreads();
}

constexpr int ML_VT = 0, ML_VWT = 5280, ML_CT = 10560, ML_Q = 28512, ML_K = 63328, ML_KT = 98144, ML_A = 139104, ML_MISC = 149344;
__device__ __forceinline__ void mlstm_chunk_item(const Params& p, int l, int item, LAS unsigned char* lds) {
    const int tid = tid_fresh(), lane = tid & 63, wid = __builtin_amdgcn_readfirstlane(tid >> 6), fr = lane & 15, fq = lane >> 4;
    const int b = item >> 6, hd = (item >> 4) & 3, dir = (item >> 3) & 1, eg = item & 7;
    const bf16_t* QC = (const bf16_t*)(p.ws + WS_QC); const bf16_t* KC = (const bf16_t*)(p.ws + WS_KC);
    const bf16_t* KCT = (const bf16_t*)(p.ws + WS_KCT); const bf16_t* VT = (const bf16_t*)(p.ws + WS_VT);
    const float* GAa = (const float*)(p.ws + WS_MGA); const float* GCc = (const float*)(p.ws + WS_MGC); const float* GPp = (const float*)(p.ws + WS_MGP);
    bf16_t* OUT = (bf16_t*)(p.ws + (dir ? WS_HB2 : WS_HF2));
    const int ti = wid >> 1, wh = wid & 1;
    __syncthreads();
    for (int i = tid; i < 17952 / 4; i += NTHR) ((LAS unsigned*)(lds + ML_CT))[i] = 0u;
    if (tid < 64) ((LAS bf16_t*)(lds + ML_VT + 32 * 160))[tid] = (bf16_t)0x3F80;
    f32x4 Cacc[2][3];
#pragma unroll
    for (int j = 0; j < 2; ++j)
#pragma unroll
        for (int e = 0; e < 3; ++e) Cacc[j][e] = (f32x4){0.f, 0.f, 0.f, 0.f};
    float m_st = 0.f;
    f32x4 ca0 = (f32x4){0.f, 0.f, 0.f, 0.f}, ca1 = ca0, caw = ca0, cP4 = ca0, cC4 = ca0; float cPt = 0.f, cPl = 0.f, cCl = 0.f;
    const int gs0 = 16 * (2 * wh) + 4 * fq, gs4 = (tid & 15) * 4, gt = 16 * ti + fr, gt0 = 16 * ti + 4 * fq, jl = dir ? 0 : 63;
    __syncthreads();
    for (int c = -1; c < 68; ++c) {
        const int cn = c + 1;
        u32x4 rq[4], rk[4], rt[4], rv = (u32x4){0u, 0u, 0u, 0u};
        f32x4 na0 = (f32x4){0.f, 0.f, 0.f, 0.f}, na1 = na0, naw = na0, nP4 = na0, nC4 = na0; float nPt = 0.f, nPl = 0.f, nCl = 0.f;
#pragma unroll
        for (int j = 0; j < 4; ++j) { rq[j] = (u32x4){0u, 0u, 0u, 0u}; rk[j] = rq[j]; rt[j] = rq[j]; }
        if (cn < 68) {
            const int cin = cn < 4 ? (dir ? 3 - cn : cn) : 4 + (dir ? 67 - cn : cn - 4), gc = b * 68 + cin;
            int rbase, n0, len; chunk_geom(gc, rbase, n0, len);
#pragma unroll
            for (int j = 0; j < 4; ++j) { const int q = tid + NTHR * j;
                const size_t ro = (size_t)(rbase + n0 + (q >> 5)) * 1024 + hd * 256 + (q & 31) * 8;
                rq[j] = *(const u32x4*)(QC + ro); rk[j] = *(const u32x4*)(KC + ro);
                rt[j] = *(const u32x4*)(KCT + (size_t)(gc * 4 + hd) * 16384 + (size_t)q * 8); }
            if (tid < 256) rv = *(const u32x4*)(VT + ((size_t)(gc * 4 + hd) * 256 + eg * 32) * 64 + (size_t)tid * 8);
            { const size_t gb = (size_t)(gc * 8 + dir * 4 + hd) * 64;
              na0 = *(const f32x4*)(GAa + gb + gs0); na1 = *(const f32x4*)(GAa + gb + gs0 + 16); naw = *(const f32x4*)(GAa + gb + gs4);
              nP4 = *(const f32x4*)(GPp + gb + gt0); nC4 = *(const f32x4*)(GCc + gb + gt0); nPt = GPp[gb + gt]; nPl = GPp[gb + jl]; nCl = GCc[gb + jl]; }
        }
        if (c >= 0) {
            const int cin = c < 4 ? (dir ? 3 - c : c) : 4 + (dir ? 67 - c : c - 4), gc = b * 68 + cin;
            int rbase, n0, len; chunk_geom(gc, rbase, n0, len);
            {
                f32x4 st[2] = {(f32x4){0.f, 0.f, 0.f, 0.f}, (f32x4){0.f, 0.f, 0.f, 0.f}};
                const LAS unsigned char* qb = lds + ML_Q + (16 * ti + fr) * 544 + fq * 16;
                const LAS unsigned char* kb0 = lds + ML_K + (16 * (2 * wh) + fr) * 544 + fq * 16;
                bf16x8 qf[4], k0f[4], k1f[4];
#pragma unroll
                for (int hb = 0; hb < 2; ++hb) {
#pragma unroll
                    for (int kd = 0; kd < 4; ++kd) { qf[kd] = *(const LAS bf16x8*)(qb + (4 * hb + kd) * 64); k0f[kd] = *(const LAS bf16x8*)(kb0 + (4 * hb + kd) * 64); k1f[kd] = *(const LAS bf16x8*)(kb0 + 16 * 544 + (4 * hb + kd) * 64); }
                    __builtin_amdgcn_sched_barrier(0);
#pragma unroll
                    for (int kd = 0; kd < 4; ++kd) {
                        st[0] = __builtin_amdgcn_mfma_f32_16x16x32_bf16(k0f[kd], qf[kd], st[0], 0, 0, 0);
                        st[1] = __builtin_amdgcn_mfma_f32_16x16x32_bf16(k1f[kd], qf[kd], st[1], 0, 0, 0);
                    }
                    __builtin_amdgcn_sched_barrier(0);
                }
                const int t = 16 * ti + fr; const float Mt = fmaxf(m_st, cPt), M63 = fmaxf(m_st, cPl);
#pragma unroll
                for (int j = 0; j < 2; ++j) { const int s0 = 16 * (2 * wh + j) + 4 * fq; const f32x4 av = j ? ca1 : ca0;
                    f32x4 o;
#pragma unroll
                    for (int r = 0; r < 4; ++r) { const bool keep = dir ? (s0 + r >= t) : (s0 + r <= t); o[r] = keep ? st[j][r] * __expf(av[r] - Mt) : 0.f; }
                    *(LAS u32x2*)(lds + ML_A + t * 160 + s0 * 2) = pack4(o); }
                { const int e = tid >> 4, s4 = (tid & 15) * 4; const u32x2 v = *(const LAS u32x2*)(lds + ML_VT + e * 160 + s4 * 2);
                  f32x4 w; w[0] = __expf(caw[0] - M63); w[1] = __expf(caw[1] - M63); w[2] = __expf(caw[2] - M63); w[3] = __expf(caw[3] - M63);
                  f32x4 o; o[0] = lo16(v.x) * w[0]; o[1] = hi16(v.x) * w[1]; o[2] = lo16(v.y) * w[2]; o[3] = hi16(v.y) * w[3];
                  *(LAS u32x2*)(lds + ML_VWT + e * 160 + s4 * 2) = pack4(o);
                  if (tid < 16) *(LAS u32x2*)(lds + ML_VWT + 32 * 160 + s4 * 2) = pack4(w); }
            }
            __syncthreads();
            {
                f32x4 n1o = (f32x4){0.f, 0.f, 0.f, 0.f}, n1a = n1o, n2o = n1o, n2a = n1o;
                const LAS unsigned char* ab = lds + ML_A + (16 * ti + fr) * 160 + fq * 16;
                const LAS unsigned char* vo = lds + ML_VT + (16 * wh + fr) * 160 + fq * 16;
                const LAS unsigned char* va = lds + ML_VT + (32 + fr) * 160 + fq * 16;
                const LAS unsigned char* qb = lds + ML_Q + (16 * ti + fr) * 544 + fq * 16;
                const LAS unsigned char* co = lds + ML_CT + (16 * wh + fr) * 544 + fq * 16;
                const LAS unsigned char* ca = lds + ML_CT + (32 + fr) * 544 + fq * 16;
                bf16x8 af[2], vof[2], vaf[2], qf[4], cof[4], caf[4];
#pragma unroll
                for (int ks = 0; ks < 2; ++ks) { af[ks] = *(const LAS bf16x8*)(ab + ks * 64); vof[ks] = *(const LAS bf16x8*)(vo + ks * 64); vaf[ks] = *(const LAS bf16x8*)(va + ks * 64); }
#pragma unroll
                for (int kd = 0; kd < 4; ++kd) { qf[kd] = *(const LAS bf16x8*)(qb + kd * 64); cof[kd] = *(const LAS bf16x8*)(co + kd * 64); caf[kd] = *(const LAS bf16x8*)(ca + kd * 64); }
                __builtin_amdgcn_sched_barrier(0);
#pragma unroll
                for (int ks = 0; ks < 2; ++ks) {
                    n1o = __builtin_amdgcn_mfma_f32_16x16x32_bf16(af[ks], vof[ks], n1o, 0, 0, 0);
                    n1a = __builtin_amdgcn_mfma_f32_16x16x32_bf16(af[ks], vaf[ks], n1a, 0, 0, 0); }
#pragma unroll
                for (int kd = 0; kd < 4; ++kd) {
                    n2o = __builtin_amdgcn_mfma_f32_16x16x32_bf16(qf[kd], cof[kd], n2o, 0, 0, 0);
                    n2a = __builtin_amdgcn_mfma_f32_16x16x32_bf16(qf[kd], caf[kd], n2a, 0, 0, 0); }
                __builtin_amdgcn_sched_barrier(0);
#pragma unroll
                for (int kd = 0; kd < 4; ++kd) { qf[kd] = *(const LAS bf16x8*)(qb + (4 + kd) * 64); cof[kd] = *(const LAS bf16x8*)(co + (4 + kd) * 64); caf[kd] = *(const LAS bf16x8*)(ca + (4 + kd) * 64); }
                __builtin_amdgcn_sched_barrier(0);
#pragma unroll
                for (int kd = 0; kd < 4; ++kd) {
                    n2o = __builtin_amdgcn_mfma_f32_16x16x32_bf16(qf[kd], cof[kd], n2o, 0, 0, 0);
                    n2a = __builtin_amdgcn_mfma_f32_16x16x32_bf16(qf[kd], caf[kd], n2a, 0, 0, 0); }
                const int t0 = 16 * ti + 4 * fq;
                f32x4 sgv, emv;
#pragma unroll
                for (int r = 0; r < 4; ++r) { const float Mr = fmaxf(m_st, cP4[r]); sgv[r] = __expf(m_st - Mr); emv[r] = __expf(-(cC4[r] + Mr)); }
                const bool wr_out = !(l == 1 && cin < 4);
#pragma unroll
                for (int r = 0; r < 4; ++r) {
                    const float den = __shfl(n1a[r] + sgv[r] * n2a[r], lane & 48);
                    const float hv = (n1o[r] + sgv[r] * n2o[r]) * __builtin_amdgcn_rcpf(fmaxf(fabsf(den), emv[r]));
                    if (wr_out) OUT[(size_t)(rbase + n0 + t0 + r) * 1024 + hd * 256 + eg * 32 + 16 * wh + fr] = (bf16_t)f2bf(hv);
                }
                const float decay = __expf(m_st - fmaxf(m_st, cPl));
#pragma unroll
                for (int j = 0; j < 2; ++j)
#pragma unroll
                    for (int e = 0; e < 3; ++e) Cacc[j][e] = Cacc[j][e] * decay;
                const LAS unsigned char* kt = lds + ML_KT + (16 * (2 * wid) + fr) * 160 + fq * 16;
                const LAS unsigned char* vw = lds + ML_VWT + fr * 160 + fq * 16;
                bf16x8 k0f[2], k1f[2], v0f[2], v1f[2], v2f[2];
#pragma unroll
                for (int ks = 0; ks < 2; ++ks) { k0f[ks] = *(const LAS bf16x8*)(kt + ks * 64); k1f[ks] = *(const LAS bf16x8*)(kt + 16 * 160 + ks * 64);
                    v0f[ks] = *(const LAS bf16x8*)(vw + ks * 64); v1f[ks] = *(const LAS bf16x8*)(vw + 16 * 160 + ks * 64); v2f[ks] = *(const LAS bf16x8*)(vw + 32 * 160 + ks * 64); }
                __builtin_amdgcn_sched_barrier(0);
#pragma unroll
                for (int ks = 0; ks < 2; ++ks) {
                    Cacc[0][0] = __builtin_amdgcn_mfma_f32_16x16x32_bf16(k0f[ks], v0f[ks], Cacc[0][0], 0, 0, 0);
                    Cacc[0][1] = __builtin_amdgcn_mfma_f32_16x16x32_bf16(k0f[ks], v1f[ks], Cacc[0][1], 0, 0, 0);
                    Cacc[0][2] = __builtin_amdgcn_mfma_f32_16x16x32_bf16(k0f[ks], v2f[ks], Cacc[0][2], 0, 0, 0);
                    Cacc[1][0] = __builtin_amdgcn_mfma_f32_16x16x32_bf16(k1f[ks], v0f[ks], Cacc[1][0], 0, 0, 0);
                    Cacc[1][1] = __builtin_amdgcn_mfma_f32_16x16x32_bf16(k1f[ks], v1f[ks], Cacc[1][1], 0, 0, 0);
                    Cacc[1][2] = __builtin_amdgcn_mfma_f32_16x16x32_bf16(k1f[ks], v2f[ks], Cacc[1][2], 0, 0, 0);
                }
            }
            __syncthreads();
#pragma unroll
            for (int j = 0; j < 2; ++j) { const int dcol = (16 * (2 * wid + j) + 4 * fq) * 2;
                *(LAS u32x2*)(lds + ML_CT + fr * 544 + dcol) = pack4(Cacc[j][0]);
                *(LAS u32x2*)(lds + ML_CT + (16 + fr) * 544 + dcol) = pack4(Cacc[j][1]);
                if (fr == 0) *(LAS u32x2*)(lds + ML_CT + 32 * 544 + dcol) = pack4(Cacc[j][2]); }
        }
        if (c >= 0) m_st = cCl + fmaxf(m_st, cPl);
        ca0 = na0; ca1 = na1; caw = naw; cP4 = nP4; cC4 = nC4; cPt = nPt; cPl = nPl; cCl = nCl;
        if (cn < 68) {
#pragma unroll
            for (int j = 0; j < 4; ++j) { const int q = tid + NTHR * j;
                *(LAS u32x4*)(lds + ML_Q + (q >> 5) * 544 + (q & 31) * 16) = rq[j];
                *(LAS u32x4*)(lds + ML_K + (q >> 5) * 544 + (q & 31) * 16) = rk[j];
                *(LAS u32x4*)(lds + ML_KT + (q >> 3) * 160 + (q & 7) * 16) = rt[j]; }
            if (tid < 256) *(LAS u32x4*)(lds + ML_VT + (tid >> 3) * 160 + (tid & 7) * 16) = rv;
        }
        __syncthreads();
    }
}

constexpr int SS_C = 0, SS_B = 18432, SS_BT = 36864, SS_XT = 57344, SS_XWT = 62464, SS_G = 67584, SS_S = 77824, SS_XRT = 87040, SS_MISC = 92160;
__device__ __forceinline__ void ssd_chunk_item(const Params& p, int l, int item, LAS unsigned char* lds) {
    const int tid = tid_fresh(), lane = tid & 63, wid = __builtin_amdgcn_readfirstlane(tid >> 6), fr = lane & 15, fq = lane >> 4;
    const int b = item >> 6, hd = (item >> 2) & 15, dir = (item >> 1) & 1, ps = item & 1, grp = hd >> 2;
    const bf16_t* BC = (const bf16_t*)(p.ws + WS_BC); const bf16_t* CC = (const bf16_t*)(p.ws + WS_CC);
    const bf16_t* BCT = (const bf16_t*)(p.ws + WS_BCT); const bf16_t* XCT = (const bf16_t*)(p.ws + WS_XCT);
    const float* ACS = (const float*)(p.ws + WS_SACS); const float* SDT = (const float*)(p.ws + WS_SDT);
    bf16_t* OUT = (bf16_t*)(p.ws + (dir ? WS_YB : WS_YF));
    const float dskip = p.sd[l * 16 + hd];
    const int ti = wid >> 1, wh = wid & 1;
    LAS float* cvscr = (LAS float*)(lds + SS_MISC) + wid * (32 * 65);
    const int cv_gw = blockIdx.x * 8 + wid, cv_ph = 0;
    __syncthreads();
    for (int i = tid; i < 9216 / 4; i += NTHR) ((LAS unsigned*)(lds + SS_S))[i] = 0u;
    f32x4 Sacc[2] = {(f32x4){0.f, 0.f, 0.f, 0.f}, (f32x4){0.f, 0.f, 0.f, 0.f}};
    f32x4 cs0 = (f32x4){0.f, 0.f, 0.f, 0.f}, cs1 = cs0, csw = cs0, cdw = cs0, ct4 = cs0; float cat = 0.f, cal = 0.f;
    const int gs0 = 16 * (2 * wh) + 4 * fq, gs4 = (tid & 15) * 4, gt = 16 * ti + fr, gt0 = 16 * ti + 4 * fq, jl = dir ? 0 : 63;
    __syncthreads();
    for (int c = -1; c < 68; ++c) {
        const int cn = c + 1;
        u32x4 rc[2], rb[2], rt[2], rx = (u32x4){0u, 0u, 0u, 0u};
        f32x4 ns0 = (f32x4){0.f, 0.f, 0.f, 0.f}, ns1 = ns0, nsw = ns0, ndw = ns0, nt4 = ns0; float nat = 0.f, nal = 0.f;
        f32x4 cvv[8]; TrDesc cvd; cvd.valid = 0;
        { const int itc = c + 1, jj = itc / 5, m = cv_gw + 2048 * jj;
          if (CV_IN_SCAN && (itc % 5) == cv_ph && jj < 12 && m < 2 * CV_EXP_ITEMS && gridDim.x == 256) { cvmicro_load(p, l, m, lane, cvv, cvd); cvd.valid = 1 + m; } }
#pragma unroll
        for (int j = 0; j < 2; ++j) { rc[j] = (u32x4){0u, 0u, 0u, 0u}; rb[j] = rc[j]; rt[j] = rc[j]; }
        if (cn < 68) {
            const int cin = cn < 4 ? (dir ? 3 - cn : cn) : 4 + (dir ? 67 - cn : cn - 4), gc = b * 68 + cin;
            int rbase, n0, len; chunk_geom(gc, rbase, n0, len);
#pragma unroll
            for (int j = 0; j < 2; ++j) { const int q = tid + NTHR * j;
                const size_t ro = (size_t)(rbase + n0 + (q >> 4)) * 512 + grp * 128 + (q & 15) * 8;
                rc[j] = *(const u32x4*)(CC + ro); rb[j] = *(const u32x4*)(BC + ro);
                rt[j] = *(const u32x4*)(BCT + (size_t)(gc * 4 + grp) * 8192 + (size_t)q * 8); }
            if (tid < 256) rx = *(const u32x4*)(XCT + ((size_t)(gc * 16 + hd) * 64 + ps * 32) * 64 + (size_t)tid * 8);
            { const size_t gb = (size_t)(gc * 32 + dir * 16 + hd) * 64;
              ns0 = *(const f32x4*)(ACS + gb + gs0); ns1 = *(const f32x4*)(ACS + gb + gs0 + 16); nsw = *(const f32x4*)(ACS + gb + gs4); ndw = *(const f32x4*)(SDT + gb + gs4);
              nt4 = *(const f32x4*)(ACS + gb + gt0); nat = ACS[gb + gt]; nal = ACS[gb + jl]; }
        }
        if (c >= 0) {
            const int cin = c < 4 ? (dir ? 3 - c : c) : 4 + (dir ? 67 - c : c - 4), gc = b * 68 + cin;
            int rbase, n0, len; chunk_geom(gc, rbase, n0, len);
            {
                f32x4 st[2] = {(f32x4){0.f, 0.f, 0.f, 0.f}, (f32x4){0.f, 0.f, 0.f, 0.f}};
                const LAS unsigned char* cbp = lds + SS_C + (16 * ti + fr) * 288 + fq * 16;
                const LAS unsigned char* bb0 = lds + SS_B + (16 * (2 * wh) + fr) * 288 + fq * 16;
                bf16x8 cf[4], b0f[4], b1f[4];
#pragma unroll
                for (int kn = 0; kn < 4; ++kn) { cf[kn] = *(const LAS bf16x8*)(cbp + kn * 64); b0f[kn] = *(const LAS bf16x8*)(bb0 + kn * 64); b1f[kn] = *(const LAS bf16x8*)(bb0 + 16 * 288 + kn * 64); }
                __builtin_amdgcn_sched_barrier(0);
#pragma unroll
                for (int kn = 0; kn < 4; ++kn) {
                    st[0] = __builtin_amdgcn_mfma_f32_16x16x32_bf16(b0f[kn], cf[kn], st[0], 0, 0, 0);
                    st[1] = __builtin_amdgcn_mfma_f32_16x16x32_bf16(b1f[kn], cf[kn], st[1], 0, 0, 0);
                }
                __builtin_amdgcn_sched_barrier(0);
                const int t = 16 * ti + fr; const float at = cat;
#pragma unroll
                for (int j = 0; j < 2; ++j) { const int s0 = 16 * (2 * wh + j) + 4 * fq; const f32x4 av = j ? cs1 : cs0;
                    f32x4 o;
#pragma unroll
                    for (int r = 0; r < 4; ++r) { const bool keep = dir ? (s0 + r >= t) : (s0 + r <= t); o[r] = keep ? st[j][r] * __expf(at - av[r]) : 0.f; }
                    *(LAS u32x2*)(lds + SS_G + t * 160 + s0 * 2) = pack4(o); }
                { const int e = tid >> 4, s4 = (tid & 15) * 4; const u32x2 v = *(const LAS u32x2*)(lds + SS_XRT + e * 160 + s4 * 2);
                  const f32x4 dv = cdw; f32x4 w; w[0] = __expf(cal - csw[0]); w[1] = __expf(cal - csw[1]); w[2] = __expf(cal - csw[2]); w[3] = __expf(cal - csw[3]);
                  f32x4 o; o[0] = lo16(v.x) * dv[0]; o[1] = hi16(v.x) * dv[1]; o[2] = lo16(v.y) * dv[2]; o[3] = hi16(v.y) * dv[3];
                  *(LAS u32x2*)(lds + SS_XT + e * 160 + s4 * 2) = pack4(o);
                  *(LAS u32x2*)(lds + SS_XWT + e * 160 + s4 * 2) = pack4(o * w); }
            }
            __syncthreads();
            {
                f32x4 y1 = (f32x4){0.f, 0.f, 0.f, 0.f}, y2 = y1;
                const LAS unsigned char* gb = lds + SS_G + (16 * ti + fr) * 160 + fq * 16;
                const LAS unsigned char* xb = lds + SS_XT + (16 * wh + fr) * 160 + fq * 16;
                const LAS unsigned char* cbp = lds + SS_C + (16 * ti + fr) * 288 + fq * 16;
                const LAS unsigned char* sb = lds + SS_S + (16 * wh + fr) * 288 + fq * 16;
                const LAS unsigned char* bt = lds + SS_BT + (16 * wid + fr) * 160 + fq * 16;
                const LAS unsigned char* xw = lds + SS_XWT + fr * 160 + fq * 16;
                bf16x8 gf[2], xf[2], cf[4], sf[4], btf[2], xw0f[2], xw1f[2];
#pragma unroll
                for (int ks = 0; ks < 2; ++ks) { gf[ks] = *(const LAS bf16x8*)(gb + ks * 64); xf[ks] = *(const LAS bf16x8*)(xb + ks * 64); }
#pragma unroll
                for (int kn = 0; kn < 4; ++kn) { cf[kn] = *(const LAS bf16x8*)(cbp + kn * 64); sf[kn] = *(const LAS bf16x8*)(sb + kn * 64); }
#pragma unroll
                for (int ks = 0; ks < 2; ++ks) { btf[ks] = *(const LAS bf16x8*)(bt + ks * 64); xw0f[ks] = *(const LAS bf16x8*)(xw + ks * 64); xw1f[ks] = *(const LAS bf16x8*)(xw + 16 * 160 + ks * 64); }
                __builtin_amdgcn_sched_barrier(0);
#pragma unroll
                for (int ks = 0; ks < 2; ++ks) y1 = __builtin_amdgcn_mfma_f32_16x16x32_bf16(gf[ks], xf[ks], y1, 0, 0, 0);
#pragma unroll
                for (int kn = 0; kn < 4; ++kn) y2 = __builtin_amdgcn_mfma_f32_16x16x32_bf16(cf[kn], sf[kn], y2, 0, 0, 0);
                const int t0 = 16 * ti + 4 * fq;
                f32x4 eav; eav[0] = __expf(ct4[0]); eav[1] = __expf(ct4[1]); eav[2] = __expf(ct4[2]); eav[3] = __expf(ct4[3]);
                const u32x2 xs = *(const LAS u32x2*)(lds + SS_XRT + (16 * wh + fr) * 160 + t0 * 2);
                const float xv[4] = {lo16(xs.x), hi16(xs.x), lo16(xs.y), hi16(xs.y)};
                const bool wr_out = !(l == 1 && cin < 4);
#pragma unroll
                for (int r = 0; r < 4; ++r) {
                    float yv = y1[r] + eav[r] * y2[r];
                    if (dir == 0) yv += dskip * xv[r];
                    if (wr_out) OUT[(size_t)(rbase + n0 + t0 + r) * 1024 + hd * 64 + ps * 32 + 16 * wh + fr] = (bf16_t)f2bf(yv);
                }
                const float dec = __expf(cal);
                Sacc[0] = Sacc[0] * dec; Sacc[1] = Sacc[1] * dec;
#pragma unroll
                for (int ks = 0; ks < 2; ++ks) {
                    Sacc[0] = __builtin_amdgcn_mfma_f32_16x16x32_bf16(btf[ks], xw0f[ks], Sacc[0], 0, 0, 0);
                    Sacc[1] = __builtin_amdgcn_mfma_f32_16x16x32_bf16(btf[ks], xw1f[ks], Sacc[1], 0, 0, 0); }
            }
            __syncthreads();
            { const int ncol = (16 * wid + 4 * fq) * 2;
              *(LAS u32x2*)(lds + SS_S + fr * 288 + ncol) = pack4(Sacc[0]);
              *(LAS u32x2*)(lds + SS_S + (16 + fr) * 288 + ncol) = pack4(Sacc[1]); }
        }
        cs0 = ns0; cs1 = ns1; csw = nsw; cdw = ndw; ct4 = nt4; cat = nat; cal = nal;
        if (cvd.valid) cvmicro_store(cvd, cvd.valid - 1, cvv, cvscr, lane);
        if (cn < 68) {
#pragma unroll
            for (int j = 0; j < 2; ++j) { const int q = tid + NTHR * j;
                *(LAS u32x4*)(lds + SS_C + (q >> 4) * 288 + (q & 15) * 16) = rc[j];
                *(LAS u32x4*)(lds + SS_B + (q >> 4) * 288 + (q & 15) * 16) = rb[j];
                *(LAS u32x4*)(lds + SS_BT + (q >> 3) * 160 + (q & 7) * 16) = rt[j]; }
            if (tid < 256) *(LAS u32x4*)(lds + SS_XRT + (tid >> 3) * 160 + (tid & 7) * 16) = rx;
        }
        __syncthreads();
    }
}

__device__ __forceinline__ void mlstm_finish_rows(const Params& p, int l, int row_lo, int gw, int ngw) {
    if (p.dup) return;
    const int lane = tid_fresh() & 63;
    const bf16_t* HF = (const bf16_t*)(p.ws + WS_HF2); const bf16_t* HB = (const bf16_t*)(p.ws + WS_HB2);
    bf16_t* BR = (bf16_t*)(p.ws + WS_BR);
    const float* ng = p.mnorm_g + l * 1024;
    int row = row_lo + gw;
    u32x2 ca[4], cb[4], co[4], na[4], nbv[4], no[4];
    if (row < MT) { const size_t so = (size_t)scanrow(row) * 1024;
#pragma unroll
        for (int hd = 0; hd < 4; ++hd) { const int c = hd * 256 + 4 * lane; ca[hd] = *(const u32x2*)(HF + so + c); cb[hd] = *(const u32x2*)(HB + so + c); co[hd] = *(const u32x2*)(BR + (size_t)row * 3072 + 1024 + c); } }
    for (; row < MT; row += ngw) {
        const int rn = row + ngw;
        if (rn < MT) { const size_t so = (size_t)scanrow(rn) * 1024;
#pragma unroll
            for (int hd = 0; hd < 4; ++hd) { const int c = hd * 256 + 4 * lane; na[hd] = *(const u32x2*)(HF + so + c); nbv[hd] = *(const u32x2*)(HB + so + c); no[hd] = *(const u32x2*)(BR + (size_t)rn * 3072 + 1024 + c); } }
#pragma unroll
        for (int hd = 0; hd < 4; ++hd) { const int c = hd * 256 + 4 * lane;
            const u32x2 a = ca[hd], b2 = cb[hd], o = co[hd];
            f32x4 h; h[0] = lo16(a.x) + lo16(b2.x); h[1] = hi16(a.x) + hi16(b2.x); h[2] = lo16(a.y) + lo16(b2.y); h[3] = hi16(a.y) + hi16(b2.y);
            const float ss = wave_sum((h[0] * h[0] + h[1] * h[1]) + (h[2] * h[2] + h[3] * h[3]));
            const float rs = __builtin_amdgcn_rsqf(ss * (1.f / 256.f) + EPS);
            const f32x4 g = *(const f32x4*)(ng + c);
            f32x4 r; r[0] = sigmoid_f(lo16(o.x)) * (h[0] * rs * g[0]); r[1] = sigmoid_f(hi16(o.x)) * (h[1] * rs * g[1]);
            r[2] = sigmoid_f(lo16(o.y)) * (h[2] * rs * g[2]); r[3] = sigmoid_f(hi16(o.y)) * (h[3] * rs * g[3]);
            u32x2 w; w.x = pk2(r[0], r[1]); w.y = pk2(r[2], r[3]);
            *(u32x2*)(BR + (size_t)row * 3072 + 1024 + c) = w; }
#pragma unroll
        for (int hd = 0; hd < 4; ++hd) { ca[hd] = na[hd]; cb[hd] = nbv[hd]; co[hd] = no[hd]; }
    }
}
__device__ __forceinline__ void ssd_finish_rows(const Params& p, int l, int row_lo, int gw, int ngw) {
    if (p.dup) return;
    const int lane = tid_fresh() & 63;
    const bf16_t* YF = (const bf16_t*)(p.ws + WS_YF); const bf16_t* YB = (const bf16_t*)(p.ws + WS_YB);
    bf16_t* BR = (bf16_t*)(p.ws + WS_BR);
    const float* ng = p.snorm_g + l * 1024;
    int row = row_lo + gw;
    u32x2 ca[4], cb[4], cz[4], na[4], nbv[4], nz[4];
    if (row < MT) {
#pragma unroll
        for (int j = 0; j < 4; ++j) { const int c = 4 * lane + 256 * j; ca[j] = *(const u32x2*)(YF + (size_t)row * 1024 + c); cb[j] = *(const u32x2*)(YB + (size_t)row * 1024 + c); cz[j] = *(const u32x2*)(BR + (size_t)row * 3072 + 2048 + c); } }
    for (; row < MT; row += ngw) {
        const int rn = row + ngw;
        if (rn < MT) {
#pragma unroll
            for (int j = 0; j < 4; ++j) { const int c = 4 * lane + 256 * j; na[j] = *(const u32x2*)(YF + (size_t)rn * 1024 + c); nbv[j] = *(const u32x2*)(YB + (size_t)rn * 1024 + c); nz[j] = *(const u32x2*)(BR + (size_t)rn * 3072 + 2048 + c); } }
        f32x4 v[4]; float ss = 0.f;
#pragma unroll
        for (int j = 0; j < 4; ++j) { const u32x2 a = ca[j], b2 = cb[j], z = cz[j];
            v[j][0] = (lo16(a.x) + lo16(b2.x)) * silu_f(lo16(z.x)); v[j][1] = (hi16(a.x) + hi16(b2.x)) * silu_f(hi16(z.x));
            v[j][2] = (lo16(a.y) + lo16(b2.y)) * silu_f(lo16(z.y)); v[j][3] = (hi16(a.y) + hi16(b2.y)) * silu_f(hi16(z.y));
            ss += (v[j][0] * v[j][0] + v[j][1] * v[j][1]) + (v[j][2] * v[j][2] + v[j][3] * v[j][3]); }
        const float rs = __builtin_amdgcn_rsqf(wave_sum(ss) * (1.f / 1024.f) + EPS);
#pragma unroll
        for (int j = 0; j < 4; ++j) { const int c = 4 * lane + 256 * j; const f32x4 g = *(const f32x4*)(ng + c);
            u32x2 w; w.x = pk2(v[j][0] * rs * g[0], v[j][1] * rs * g[1]); w.y = pk2(v[j][2] * rs * g[2], v[j][3] * rs * g[3]);
            *(u32x2*)(BR + (size_t)row * 3072 + 2048 + c) = w; }
#pragma unroll
        for (int j = 0; j < 4; ++j) { ca[j] = na[j]; cb[j] = nbv[j]; cz[j] = nz[j]; }
    }
}

__device__ __forceinline__ void phase_route(const Params& p, int l, unsigned char* ldsb, int bid, int nb) {
    float* lds = reinterpret_cast<float*>(ldsb);
    float* Wt = lds;
    int* hist = reinterpret_cast<int*>(lds + 36 * 1024);
    const int tid = tid_fresh(), lane = tid & 63, wave = tid >> 6;
    const int row_lo = l == 0 ? 0 : MC, rpb = l == 0 ? 68 : 64;
    const float* wrg = p.w_rg + (size_t)l * 1024 * 4; const float* wre = p.w_re + (size_t)l * 1024 * 32;
    for (int i = tid; i < 1024 * 4; i += NTHR) { const int k = i >> 2, g = i & 3; Wt[g * 1024 + (k ^ ((g & 7) << 2))] = wrg[i]; }
    for (int i = tid; i < 1024 * 32; i += NTHR) { const int k = i >> 5, e = i & 31; Wt[(4 + e) * 1024 + (k ^ (((4 + e) & 7) << 2))] = wre[i]; }
    const float* mod = (const float*)(p.ws + WS_MOD) + l * 5 * 6144;
    const float* XL = (const float*)(p.ws + WS_XL);
    int* EID = (int*)(p.ws + WS_EID); float* EWT = (float*)(p.ws + WS_EWT);
    for (int vb = bid; vb < 256; vb += nb) {
        if (tid < 32) hist[tid] = 0;
        __syncthreads();
        for (int rr = wave; rr < rpb; rr += 8) {
            const int row = row_lo + vb * rpb + rr;
            f32x4 v[4];
#pragma unroll
            for (int j = 0; j < 4; ++j) v[j] = *(const f32x4*)(XL + (size_t)row * 1024 + 4 * lane + 256 * j);
            const float* mr = mod + modrow(row) * 6144;
            norm_mod_row(v, p.g_ffn + l * 1024, mr + 3 * 1024, mr + 4 * 1024, lane);
            store_row_bf16((bf16_t*)(p.ws + WS_H) + (size_t)row * 1024, v, lane);
            float lg[36];
#pragma unroll
            for (int e = 0; e < 36; ++e) { float s = 0.f;
#pragma unroll
                for (int j = 0; j < 4; ++j) { const f32x4 w = *(const f32x4*)(Wt + e * 1024 + ((4 * lane + 256 * j) ^ ((e & 7) << 2))); s += (v[j][0] * w[0] + v[j][1] * w[1]) + (v[j][2] * w[2] + v[j][3] * w[3]); }
                lg[e] = wave_sum(s); }
            float gl[4]; int gi = 0; float gmax;
#pragma unroll
            for (int g = 0; g < 4; ++g) gl[g] = lg[g] + p.b_rg[l * 4 + g];
            gmax = gl[0];
#pragma unroll
            for (int g = 1; g < 4; ++g) if (gl[g] > gmax) { gmax = gl[g]; gi = g; }
            float den = 0.f;
#pragma unroll
            for (int g = 0; g < 4; ++g) den += __expf(gl[g] - gmax);
            const float pg = 1.f / den;
            float v1 = -3.0e38f, v2 = -3.0e38f; int i1 = 0, i2 = 0;
#pragma unroll
            for (int g = 0; g < 4; ++g) if (g == gi) {
#pragma unroll
                for (int j = 0; j < 8; ++j) { const float x = lg[4 + g * 8 + j] + p.b_re[l * 32 + g * 8 + j];
                    if (x > v1) { v2 = v1; i2 = i1; v1 = x; i1 = j; } else if (x > v2) { v2 = x; i2 = j; } } }
            const float e2 = __expf(v2 - v1), w1 = pg / (1.f + e2), w2 = pg * e2 / (1.f + e2);
            if (lane == 0) { EID[row * 2] = gi * 8 + i1; EID[row * 2 + 1] = gi * 8 + i2; EWT[row * 2] = w1; EWT[row * 2 + 1] = w2;
                atomicAdd(&hist[gi * 8 + i1], 1); atomicAdd(&hist[gi * 8 + i2], 1); }
        }
        __syncthreads();
        if (tid < 32) ((int*)(p.ws + WS_HIST))[vb * 32 + tid] = hist[tid];
        __syncthreads();
    }
    __syncthreads();
    float* scr = lds + wave * (64 * 65);
    convert_run(p, (CV_IN_SCAN && nb == 256) ? -1 : l, l + 1 < 2 ? l + 1 : -1, bid * 8 + wave, nb * 8, scr, lane);
}

__device__ __forceinline__ void phase_scatter(const Params& p, int l, unsigned char* ldsb, int bid, int nb) {
    int* li = reinterpret_cast<int*>(ldsb);
    int* tot = li; int* pre = li + 32; int* pst = li + 64; int* ea = li + 128; int* pos = li + 384;
    const int tid = tid_fresh(), lane = tid & 63, wave = tid >> 6;
    const int row_lo = l == 0 ? 0 : MC, rpb = l == 0 ? 68 : 64;
    const int* HIST = (const int*)(p.ws + WS_HIST); const int* EID = (const int*)(p.ws + WS_EID);
    int* SLOT = (int*)(p.ws + WS_SLOT);
    for (int vb = bid; vb < 256; vb += nb) {
        __syncthreads();
        if (tid < 32) { int t = 0, pr = 0; for (int j = 0; j < 256; ++j) { const int hv = HIST[j * 32 + tid]; t += hv; if (j < vb) pr += hv; } tot[tid] = t; pre[tid] = pr; }
        __syncthreads();
        if (tid == 0) { int s = 0; for (int e = 0; e < 32; ++e) { pst[e] = s; s += ((tot[e] + 255) >> 8) << 8; }
            if (vb == 0) { int* BE = (int*)(p.ws + WS_BLKEXP); int nblk = 0;
                for (int e = 0; e < 32; ++e) { const int nbk = (tot[e] + 255) >> 8; for (int j = 0; j < nbk; ++j) BE[nblk++] = e; }
                BE[200] = nblk; } }
        if (tid < rpb * 2) ea[tid] = EID[(row_lo + vb * rpb) * 2 + tid];
        __syncthreads();
        if (tid < rpb * 2) { const int e = ea[tid]; int rk = 0; for (int j = 0; j < tid; ++j) rk += (ea[j] == e) ? 1 : 0;
            const int ps = pst[e] + pre[e] + rk; SLOT[(row_lo + vb * rpb) * 2 + tid] = ps; ((int*)(p.ws + WS_TOK))[ps] = row_lo + vb * rpb + (tid >> 1); }
        if (vb == 0 && tid < 32) { int* TOK = (int*)(p.ws + WS_TOK); const int e0 = pst[tid] + tot[tid], e1 = pst[tid] + (((tot[tid] + 255) >> 8) << 8);
            for (int q = e0; q < e1; ++q) TOK[q] = row_lo; }
    }
    __syncthreads();
}

__device__ __forceinline__ void phase_combine(const Params& p, int l, int bid, int nb) {
    if (p.dup && l == 0) return;
    const int lane = tid_fresh() & 63, wave = tid_fresh() >> 6;
    const float* mod = (const float*)(p.ws + WS_MOD);
    const int* SLOT = (const int*)(p.ws + WS_SLOT); const float* EWT = (const float*)(p.ws + WS_EWT);
    const bf16_t* Y = (const bf16_t*)(p.ws + WS_Y);
    float* XL = (float*)(p.ws + WS_XL);
    const int row_lo = l == 0 ? 0 : MC, stride = nb * 8;
    for (int rowA = row_lo + bid * 8 + wave; rowA < MT; rowA += 2 * stride) {
        const int rowB = rowA + stride; const bool hasB = rowB < MT; const int rb = hasB ? rowB : rowA;
        const int sA0 = SLOT[rowA * 2], sA1 = SLOT[rowA * 2 + 1], sB0 = SLOT[rb * 2], sB1 = SLOT[rb * 2 + 1];
        const float wA0 = EWT[rowA * 2], wA1 = EWT[rowA * 2 + 1], wB0 = EWT[rb * 2], wB1 = EWT[rb * 2 + 1];
        u32x2 yA0[4], yA1[4], yB0[4], yB1[4]; f32x4 xA[4], xB[4];
#pragma unroll
        for (int j = 0; j < 4; ++j) { const int c = 4 * lane + 256 * j;
            yA0[j] = *(const u32x2*)(Y + (size_t)sA0 * 1024 + c); yA1[j] = *(const u32x2*)(Y + (size_t)sA1 * 1024 + c); xA[j] = *(const f32x4*)(XL + (size_t)rowA * 1024 + c);
            yB0[j] = *(const u32x2*)(Y + (size_t)sB0 * 1024 + c); yB1[j] = *(const u32x2*)(Y + (size_t)sB1 * 1024 + c); xB[j] = *(const f32x4*)(XL + (size_t)rb * 1024 + c); }
#pragma unroll
        for (int half = 0; half < 2; ++half) {
            if (half == 1 && !hasB) break;
            const int row = half ? rowB : rowA; const float w0 = half ? wB0 : wA0, w1 = half ? wB1 : wA1;
            const float* g5 = mod + (l * 5 + modrow(row)) * 6144 + 5 * 1024;
            f32x4 v[4];
#pragma unroll
            for (int j = 0; j < 4; ++j) { const int c = 4 * lane + 256 * j;
                const u32x2 a = half ? yB0[j] : yA0[j], b2 = half ? yB1[j] : yA1[j];
                f32x4 y; y[0] = w0 * lo16(a.x) + w1 * lo16(b2.x); y[1] = w0 * hi16(a.x) + w1 * hi16(b2.x); y[2] = w0 * lo16(a.y) + w1 * lo16(b2.y); y[3] = w0 * hi16(a.y) + w1 * hi16(b2.y);
                v[j] = (half ? xB[j] : xA[j]) + *(const f32x4*)(g5 + c) * y; }
            if (l == 0) {
#pragma unroll
                for (int j = 0; j < 4; ++j) *(f32x4*)(XL + (size_t)row * 1024 + 4 * lane + 256 * j) = v[j];
                const float* mr = mod + (5 + modrow(row)) * 6144;
                norm_mod_row(v, p.g_mix + 1024, mr, mr + 1024, lane);
                store_row_bf16((bf16_t*)(p.ws + WS_H) + (size_t)row * 1024, v, lane);
            } else {
                norm_mod_row(v, p.g_final, nullptr, nullptr, lane);
                float* o = p.out + (size_t)(row - MC) * 1024;
#pragma unroll
                for (int j = 0; j < 4; ++j) *(f32x4*)(o + 4 * lane + 256 * j) = v[j];
            }
        }
    }
}

constexpr int NPH_L = 14, NPHASES = 1 + 2 * NPH_L;
__device__ __forceinline__ void run_phase(const Params& p, int ph, unsigned char* lds) {
    const int bid = blockIdx.x, nb = gridDim.x;
    const int wave = tid_fresh() >> 6;
#ifndef ONLY_S
    if (ph == 0) { phase_pre(p, lds, bid, nb); return; }
#else
    if (ph == 0) { if (ONLY_S == 99) phase_pre(p, lds, bid, nb); return; }
#endif
    const int l = (ph - 1) / NPH_L, s = (ph - 1) % NPH_L;
    unsigned char* ws = p.ws;
    const int pm0 = l == 0 ? 0 : 4, nMrows = l == 0 ? 68 : 64, row_lo = l == 0 ? 0 : MC;
#ifdef ONLY_S
    if (s != ONLY_S) return;
#endif
    switch (s) {
    case 0: if (l == 0) phase_norm1(p, bid, nb); break;
    case 1: { EpiInproj E{ws};
              if (l == 0) { SchedGrid S{(const bf16_t*)(ws + WS_H), (const bf16_t*)(ws + WS_WIN), 1024, 1024, 0, 68, 45, nb, bid}; gemm_run(lds, S, E, 1024, 1024, 1024, 1); }
              else { SchedInproj1 S{(const bf16_t*)(ws + WS_H), (const bf16_t*)(ws + WS_WIN), nb, bid}; gemm_run(lds, S, E, 1024, 1024, 1024, 1); } } break;
    case 2: { for (int it = bid; it < 1088; it += nb) conv_m_item(p, l, it, (LAS unsigned char*)lds);
              if (!p.dup) for (int it = bid; it < (l == 0 ? 272 : 256); it += nb) pool_window_item(p, it, (LAS unsigned char*)lds); } break;
    case 3: {
              for (int it = bid; it < 256; it += nb) { const int x = it & 7, y = it >> 3; mlstm_chunk_item(p, l, nb == 256 ? ((((y >> 4) * 8 + x) << 4) | (y & 15)) : it, (LAS unsigned char*)lds); }
              SchedPool S{(const bf16_t*)(ws + WS_BR), (const bf16_t*)(ws + WS_WPOOL), pm0, nMrows, nb, bid}; EpiPool E{(bf16_t*)(ws + WS_BR)};
              if (!p.dup) gemm_run(lds, S, E, 256, 3072, 256, 1); } break;
    case 4: { for (int it = bid; it < 1088; it += nb) conv_s_item(p, l, it, (LAS unsigned char*)lds);
              mlstm_finish_rows(p, l, row_lo, bid * 8 + wave, nb * 8); } break;
    case 5: for (int it = bid; it < 256; it += nb) { const int x = it & 7, y = it >> 3;
                ssd_chunk_item(p, l, nb == 256 ? ((((y >> 4) * 8 + x) << 4) | (y & 15)) : it, (LAS unsigned char*)lds); }
            break;
    case 6: ssd_finish_rows(p, l, row_lo, bid * 8 + wave, nb * 8); break;
    case 7: { SchedGrid S{(const bf16_t*)(ws + WS_BR), (const bf16_t*)(ws + WS_WBR), 3072, 3072, pm0, nMrows, 4, nb, bid}; EpiBranch E{(const bf16_t*)(ws + WS_MG), (bf16_t*)(ws + WS_MERGED)};
              gemm_run(lds, S, E, 3072, 3072, 3072, 3); } break;
    case 8: { SchedGrid S{(const bf16_t*)(ws + WS_MERGED), (const bf16_t*)(ws + WS_WOUT), 1024, 1024, pm0, nMrows, 4, nb, bid}; EpiOut E{(float*)(ws + WS_XL), (const float*)(ws + WS_MOD) + l * 5 * 6144, l == 0 ? p.x : nullptr, l == 0 ? p.ctx : nullptr, p.dup};
              gemm_run(lds, S, E, 1024, 1024, 1024, 1); } break;
    case 9: phase_route(p, l, lds, bid, nb); break;
    case 10: phase_scatter(p, l, lds, bid, nb); break;
    case 11: { const int* BE = (const int*)(ws + WS_BLKEXP);
              SchedMoe S{(const bf16_t*)(ws + WS_H), (const bf16_t*)(ws + WS_EW1), BE, (const int*)(ws + WS_TOK), 1024, BE[200], nb, bid, (size_t)1048576, (size_t)1024}; EpiMoe1 E{(bf16_t*)(ws + WS_ACT)};
              gemm_run<true>(lds, S, E, 1024, 1024, 1024, 1); } break;
    case 12: { const int* BE = (const int*)(ws + WS_BLKEXP);
              SchedMoe S{(const bf16_t*)(ws + WS_ACT), (const bf16_t*)(ws + WS_EW2), BE, nullptr, 512, BE[200], nb, bid, (size_t)524288, (size_t)512}; EpiMoe2 E{(bf16_t*)(ws + WS_Y)};
              gemm_run(lds, S, E, 512, 512, 512, 1); } break;
    case 13: phase_combine(p, l, bid, nb); break;
    }
}

#define XB_TMO      128
#define XB_XCNT(j)  (256  + 64 * (j))
#define XB_XSUB(j)  (1280 + 64 * (j))
#define XB_XGEN(j)  (2304 + 64 * (j))
#define XB_TOP      3328
#define XB_TOPGEN   3392
#define XCD_BAR_WORDS 3456
#define XB_SPIN_CAP (1u << 18)
__device__ __forceinline__ unsigned xb_ld(unsigned* p)              { return __hip_atomic_load(p, __ATOMIC_RELAXED, __HIP_MEMORY_SCOPE_AGENT); }
__device__ __forceinline__ unsigned xb_add(unsigned* p, unsigned v) { return __hip_atomic_fetch_add(p, v, __ATOMIC_RELAXED, __HIP_MEMORY_SCOPE_AGENT); }
__device__ __forceinline__ unsigned xb_xcc_id() { return (unsigned)__builtin_amdgcn_s_getreg((3 << 11) | 20) & 0xFu; }
#define XB_SPIN(cond, bar) do { unsigned _sp = 0; while (cond) { __builtin_amdgcn_s_sleep(1); \
    if ((++_sp & 255u) == 0u) { if (xb_ld(&(bar)[XB_TMO])) break; if (_sp > XB_SPIN_CAP) { atomicAdd(&(bar)[XB_TMO], 1u); break; } } } } while (0)
__device__ __forceinline__ void xcd_barrier_complete(unsigned* bar, unsigned x, unsigned& nloc, unsigned& nx) {
    const unsigned G = gridDim.x * gridDim.y * gridDim.z;
    unsigned sum, cnt, mine, sp = 0u;
    for (;;) {
        sum = 0u; cnt = 0u; mine = 0u;
#pragma unroll
        for (unsigned j = 0; j < 16; ++j) { const unsigned c = xb_ld(&bar[XB_XCNT(j)]); sum += c; cnt += (c > 0u) ? 1u : 0u; mine = (j == x) ? c : mine; }
        if (sum == G) break;
        __builtin_amdgcn_s_sleep(1);
        if ((++sp & 255u) == 0u) { if (xb_ld(&bar[XB_TMO])) break; if (sp > XB_SPIN_CAP) { atomicAdd(&bar[XB_TMO], 1u); break; } }
    }
    nloc = mine > 0u ? mine : 1u; nx = cnt > 0u ? cnt : 1u;
}
__device__ __forceinline__ void xcd_barrier(unsigned* bar, volatile LAS unsigned* st) {
    asm volatile("s_waitcnt vmcnt(0)" ::: "memory");
    __syncthreads();
    if (threadIdx.x == 0) {
        __builtin_amdgcn_s_waitcnt(0);
        const unsigned x = xb_xcc_id();
        unsigned nloc = st[0], nx = st[1];
        if (nloc == 0u) { xcd_barrier_complete(bar, x, nloc, nx); st[0] = nloc; st[1] = nx; }
        const unsigned old = xb_add(&bar[XB_XSUB(x)], 1u);
        const unsigned gen = old / nloc;
        if (old + 1u == (gen + 1u) * nloc) {
            __builtin_amdgcn_fence(__ATOMIC_RELEASE, "agent");
            asm volatile("s_waitcnt vmcnt(0)" ::: "memory");
            const unsigned og = xb_add(&bar[XB_TOP], 1u);
            const unsigned tg = og / nx;
            if (og + 1u == (tg + 1u) * nx) xb_add(&bar[XB_TOPGEN], 1u);
            else XB_SPIN(xb_ld(&bar[XB_TOPGEN]) == tg, bar);
            __builtin_amdgcn_fence(__ATOMIC_ACQUIRE, "agent");
            xb_add(&bar[XB_XGEN(x)], 1u);
            asm volatile("s_waitcnt vmcnt(0)" ::: "memory");
        } else {
            XB_SPIN(xb_ld(&bar[XB_XGEN(x)]) == gen, bar);
            __builtin_amdgcn_fence(__ATOMIC_ACQUIRE, "agent");
            asm volatile("s_waitcnt vmcnt(0)" ::: "memory");
        }
    }
    __syncthreads();
}

constexpr int BAR_LDS_OFF = LDS_BYTES - 16;
__global__ void __launch_bounds__(NTHR, 2) fwd_kernel(Params pk) {
    extern __shared__ __attribute__((aligned(16))) unsigned char lds[];
    const Params& p = pk;
    const int lo = pk.ph_lo, hi = pk.ph_hi;
    unsigned* bar = (unsigned*)(pk.ws + WS_BAR);
    volatile LAS unsigned* bst = (volatile LAS unsigned*)((LAS unsigned char*)lds + BAR_LDS_OFF);
    if (hi - lo > 1) {
        if (threadIdx.x == 0) { bst[0] = 0u; bst[1] = 0u; (void)xb_add(&bar[XB_XCNT(xb_xcc_id())], 1u); }
        __syncthreads();
    }
#define STEP(k) if (lo <= (k) && (k) < hi) { run_phase(p, (k), lds); if ((k) + 1 < hi) { if (pk.dup < 0) cg::this_grid().sync(); else xcd_barrier(bar, bst); } }
    STEP(0) STEP(1) STEP(2) STEP(3) STEP(4) STEP(5) STEP(6) STEP(7) STEP(8) STEP(9) STEP(10) STEP(11) STEP(12) STEP(13) STEP(14)
    STEP(16) STEP(17) STEP(18) STEP(19) STEP(20) STEP(21) STEP(22) STEP(23) STEP(24) STEP(25) STEP(26) STEP(27) STEP(28)
#undef STEP
}

extern "C" void kernel_launch(void* const* d_in, const int* in_sizes, int n_in, void* d_out, int out_size, void* d_ws, size_t ws_size, hipStream_t stream) {
    static int grid_blocks = 0;
    if (!grid_blocks) {
        if (n_in != 31 || ws_size < WS_END) { fprintf(stderr, "kernel_launch: unexpected n_in %d / ws_size %zu (need %zu)\n", n_in, ws_size, (size_t)WS_END); grid_blocks = -1; return; }
        int dev = 0, cus = 0, per_cu = 0;
        hipGetDevice(&dev);
        hipDeviceGetAttribute(&cus, hipDeviceAttributeMultiprocessorCount, dev);
        if (hipFuncSetAttribute((const void*)fwd_kernel, hipFuncAttributeMaxDynamicSharedMemorySize, LDS_BYTES) != hipSuccess) fprintf(stderr, "kernel_launch: hipFuncSetAttribute failed\n");
        hipOccupancyMaxActiveBlocksPerMultiprocessor(&per_cu, (const void*)fwd_kernel, NTHR, LDS_BYTES);
        if (per_cu < 1) { fprintf(stderr, "kernel_launch: occupancy query says %d blocks per CU\n", per_cu); per_cu = 1; }
        grid_blocks = cus * per_cu;
        (void)hipGetLastError();
    }
    if (grid_blocks < 0) return;
    Params p{};
    const float** dst = (const float**)&p;
    for (int i = 0; i < 31; ++i) dst[i] = (const float*)d_in[i];
    p.out = (float*)d_out; p.ws = (unsigned char*)d_ws;
#if SINGLE_LAUNCH
    if (hipMemsetAsync((char*)d_ws + WS_BAR, 0, 16384, stream) != hipSuccess) fprintf(stderr, "kernel_launch: hipMemsetAsync failed\n");
    p.ph_lo = 0; p.ph_hi = NPHASES;
    void* args[] = {&p};
    hipError_t e = hipLaunchCooperativeKernel((const void*)fwd_kernel, dim3(grid_blocks), dim3(NTHR), args, LDS_BYTES, stream);
    if (e != hipSuccess) fprintf(stderr, "cooperative launch failed: %s (grid %d)\n", hipGetErrorString(e), grid_blocks);
#else
    for (int ph = 0; ph < NPHASES; ++ph) {
        if (ph == 1 + NPH_L) continue;
        p.ph_lo = ph; p.ph_hi = ph + 1;
        hipLaunchKernelGGL(fwd_kernel, dim3(grid_blocks), dim3(NTHR), LDS_BYTES, stream, p);
        const int sidx = ph == 0 ? 14 : (ph - 1) % NPH_L;
        if ((PROBE_DUP_MASK >> sidx) & 1) { p.dup = 1; for (int r = 0; r < PROBE_DUP_N; ++r) hipLaunchKernelGGL(fwd_kernel, dim3(grid_blocks), dim3(NTHR), LDS_BYTES, stream, p); p.dup = 0; }
    }
#endif
}
```

```cpp
#include <hip/hip_runtime.h>
#include <hip/hip_cooperative_groups.h>
#include <cstdio>
namespace cg = cooperative_groups;

#ifndef SINGLE_LAUNCH
#define SINGLE_LAUNCH 1
#endif
#ifndef PROBE_DUP_MASK
#define PROBE_DUP_MASK 0
#endif
#ifndef PROBE_DUP_N
#define PROBE_DUP_N 1
#endif
#ifndef USE_MLSTM_CHUNK
#define USE_MLSTM_CHUNK 1
#endif
#ifndef USE_SSD_CHUNK
#define USE_SSD_CHUNK 1
#endif
#ifndef CV_IN_SCAN
#define CV_IN_SCAN 0
#endif
#ifndef PROF_S
#define PROF_S (-1)
#endif
#ifndef CONVDUP
#define CONVDUP 0
#endif
#ifndef INPROJ_WGM
#define INPROJ_WGM 4
#endif
#ifndef USE_MFMA_GEMM
#define USE_MFMA_GEMM 1
#endif

typedef unsigned short bf16_t;
typedef float f32x4 __attribute__((ext_vector_type(4)));
typedef unsigned u32x4 __attribute__((ext_vector_type(4)));
typedef unsigned u32x2 __attribute__((ext_vector_type(2)));

constexpr int NTHR = 512;
constexpr int D = 1024, NB = 4, SEQ = 4096, CTXL = 256;
constexpr int MC = NB * CTXL;
constexpr int ML = NB * SEQ;
constexpr int MT = MC + ML;
constexpr int DIN = 11312, NPAD = 11520;
constexpr int NE = 32, DE = 512;
constexpr int CAP = 43008;
constexpr float EPS = 1e-6f;
constexpr int LDS_BYTES = 163840;

constexpr size_t MiB = 1u << 20;
constexpr size_t WS_HIST = 0;
constexpr size_t WS_BLKEXP = 64 * 1024;
constexpr size_t WS_BAR = 128 * 1024;
constexpr size_t WS_TOK = 256 * 1024;
constexpr size_t WS_MOD = 1 * MiB;
constexpr size_t WS_GA = 2 * MiB;
constexpr size_t WS_DT = 4 * MiB;
constexpr size_t WS_EID = 7 * MiB;
constexpr size_t WS_EWT = 7 * MiB + 256 * 1024;
constexpr size_t WS_SLOT = 7 * MiB + 512 * 1024;
constexpr size_t WS_WIN = 8 * MiB;
constexpr size_t WS_WPOOL = 31 * MiB;
constexpr size_t WS_WBR = 32 * MiB;
constexpr size_t WS_WOUT = 38 * MiB;
constexpr size_t WS_XL = 40 * MiB;
constexpr size_t WS_H = 108 * MiB;
constexpr size_t WS_BR = 142 * MiB;
constexpr size_t WS_Q = 244 * MiB, WS_K = 278 * MiB, WS_V = 312 * MiB;
constexpr size_t WS_SX = 346 * MiB, WS_SB = 380 * MiB, WS_SC = 397 * MiB;
constexpr size_t WS_MG = 414 * MiB;
constexpr size_t WS_HF = 516 * MiB, WS_HB = 550 * MiB;
constexpr size_t WS_VT = 584 * MiB;
constexpr size_t WS_END = 618 * MiB;
constexpr size_t WS_MGA = WS_WIN, WS_MGC = WS_WIN + 576 * 1024, WS_MGP = WS_WIN + 1152 * 1024;
constexpr size_t WS_SACS = WS_WIN + 2 * MiB, WS_SDT = WS_WIN + 5 * MiB;
constexpr size_t WS_QC = WS_H, WS_KC = WS_HF, WS_KCT = WS_HB;
constexpr size_t WS_HF2 = WS_Q, WS_HB2 = WS_K;
constexpr size_t WS_XCT = WS_HB;
constexpr size_t WS_BC = WS_VT, WS_CC = WS_VT + 17 * MiB;
constexpr size_t WS_OL = WS_HF;
constexpr size_t WS_YF = WS_SX, WS_YB = WS_SB;
constexpr size_t WS_MERGED = WS_H;
constexpr size_t WS_EW1 = 244 * MiB;
constexpr size_t WS_EW2 = 308 * MiB;
constexpr size_t WS_XB = WS_BR;
constexpr size_t WS_ACT = WS_SX;
constexpr size_t WS_Y = WS_MG;

struct Params {
    const float *x, *c, *ctx, *c_ctx, *w_ada, *b_ada, *g_mix, *g_ffn, *w_in, *pool_w, *pool_scale,
        *mconv_w, *mconv_b, *mgate_b, *mnorm_g, *sconv_w, *sconv_b, *sdt_bias, *sa_log, *sd, *snorm_g,
        *w_branch, *w_out, *w_rg, *b_rg, *w_re, *b_re, *w_eg, *w_eu, *w_ed, *g_final;
    float* out; unsigned char* ws; int ph_lo, ph_hi, dup, pad;
};

__device__ __forceinline__ int tid_fresh() { int t = threadIdx.x; asm volatile("" : "+v"(t)); return t; }
__device__ __forceinline__ float bf2f(unsigned b) { return __uint_as_float(b << 16); }
__device__ __forceinline__ unsigned f2bf(float f) { unsigned u = __float_as_uint(f); return (u + 0x7fffu + ((u >> 16) & 1u)) >> 16; }
typedef __bf16 bf16x2_t __attribute__((ext_vector_type(2)));
typedef float f32x2_t __attribute__((ext_vector_type(2)));
__device__ __forceinline__ unsigned pk2(float lo, float hi) { const f32x2_t v = {lo, hi}; return __builtin_bit_cast(unsigned, __builtin_convertvector(v, bf16x2_t)); }
__device__ __forceinline__ float lo16(unsigned w) { return __uint_as_float(w << 16); }
__device__ __forceinline__ float hi16(unsigned w) { return __uint_as_float(w & 0xffff0000u); }
__device__ __forceinline__ float wave_sum(float v) {
#pragma unroll
    for (int o = 1; o < 64; o <<= 1) v += __shfl_xor(v, o);
    return v;
}
__device__ __forceinline__ float sigmoid_f(float x) { return __builtin_amdgcn_rcpf(1.f + __expf(-x)); }
__device__ __forceinline__ float silu_f(float x) { return x * __builtin_amdgcn_rcpf(1.f + __expf(-x)); }
__device__ __forceinline__ float softplus_f(float x) { return fmaxf(x, 0.f) + log1pf(__expf(-fabsf(x))); }
__device__ __forceinline__ float logsigmoid_f(float x) { return fminf(x, 0.f) - log1pf(__expf(-fabsf(x))); }
__device__ __forceinline__ void unpack8(u32x4 w, float* f) {
    f[0] = lo16(w.x); f[1] = hi16(w.x); f[2] = lo16(w.y); f[3] = hi16(w.y);
    f[4] = lo16(w.z); f[5] = hi16(w.z); f[6] = lo16(w.w); f[7] = hi16(w.w);
}
__device__ __forceinline__ u32x4 pack8(f32x4 a, f32x4 b) {
    u32x4 w; w.x = pk2(a[0], a[1]); w.y = pk2(a[2], a[3]); w.z = pk2(b[0], b[1]); w.w = pk2(b[2], b[3]); return w;
}
__device__ __forceinline__ int scanrow(int row) {
    if (row < MC) return row;
    const int r = row - MC, b = r >> 12, t = r & 4095;
    return MC + (b << 12) + ((t & 63) << 6) + (t >> 6);
}
__device__ __forceinline__ int modrow(int row) { return row < MC ? 4 : ((row - MC) >> 12); }

struct Unit { const bf16_t* A; const bf16_t* B; const int* tok; int pm, pn; };

template <int WGM = 8>
__device__ __forceinline__ void tile_order(int L, int nM, int nN, int& pm, int& pn) {
    const int nwg = nM * nN; int wgid = L;
    { const int q = nwg / 8, r = nwg % 8, xcd = wgid % 8, off = wgid / 8; wgid = (xcd < r ? xcd * (q + 1) : r * (q + 1) + (xcd - r) * q) + off; }
    const int nig = WGM * nN, gid = wgid / nig, fm = gid * WGM, gsz = (nM - fm) < WGM ? (nM - fm) : WGM;
    pm = fm + ((wgid % nig) % gsz); pn = (wgid % nig) / gsz;
}
struct SchedGrid {
    const bf16_t* A; const bf16_t* B; int lda, ldb, pm0, nM, nN, G, c;
    __device__ __forceinline__ bool next(int i, Unit& u) const {
        const long L = (long)i * G + c; if (L >= (long)nM * nN) return false;
        int pm, pn; if (nN == 45) tile_order<INPROJ_WGM>((int)L, nM, nN, pm, pn); else tile_order<8>((int)L, nM, nN, pm, pn); pm += pm0;
        u.pm = pm; u.pn = pn; u.tok = nullptr; u.A = A + (size_t)pm * 256 * lda; u.B = B + (size_t)pn * 256 * ldb; return true;
    }
};
struct SchedInproj1 {
    const bf16_t* A; const bf16_t* B; int G, c;
    __device__ __forceinline__ bool next(int i, Unit& u) const {
        const long L = (long)i * G + c; if (L >= 2880 + 84) return false;
        int pm, pn;
        if (L < 2880) { tile_order<INPROJ_WGM>((int)L, 64, 45, pm, pn); pm += 4; }
        else { const int idx = (int)L - 2880, k = idx % 21; pm = idx / 21; pn = k < 12 ? 4 + k : (k < 16 ? 20 + (k - 12) : (k < 20 ? 28 + (k - 16) : 44)); }
        u.pm = pm; u.pn = pn; u.tok = nullptr; u.A = A + (size_t)pm * 256 * 1024; u.B = B + (size_t)pn * 256 * 1024; return true;
    }
};
struct SchedPool {
    const bf16_t* A; const bf16_t* B; int pm0, nM, G, c;
    __device__ __forceinline__ bool next(int i, Unit& u) const {
        const long L = (long)i * G + c; if (L >= (long)nM * 4) return false;
        const int pm = pm0 + (int)(L >> 2), g = (int)(L & 3);
        u.pm = pm; u.pn = g; u.tok = nullptr; u.A = A + (size_t)pm * 256 * 3072 + g * 256; u.B = B + (size_t)g * 65536; return true;
    }
};
struct SchedMoe {
    const bf16_t* A; const bf16_t* B; const int* blkexp; const int* tok; int lda, nblk, G, c; size_t bexp_stride, ldb;
    __device__ __forceinline__ bool next(int i, Unit& u) const {
        const long L = (long)i * G + c; if (L >= (long)nblk * 4) return false;
        const int blk = (int)(L >> 2), nt = (int)(L & 3); const int e = blkexp[blk];
        u.pm = blk; u.pn = nt; u.tok = tok ? tok + blk * 256 : nullptr; u.A = tok ? A : A + (size_t)blk * 256 * lda;
        u.B = B + (size_t)e * bexp_stride + (size_t)nt * 256 * ldb; return true;
    }
};

struct EpiInproj {
    unsigned char* ws;
    __device__ __forceinline__ void seg(const Unit& u, int, int r, int c0, f32x4& lo0, f32x4& lo1, f32x4& hi0, f32x4& hi1) const {
        const int row = u.pm * 256 + r, t = u.pn;
        bf16_t* dst; size_t ld; int cb;
        if (t < 4) { dst = (bf16_t*)(ws + WS_BR) + (size_t)row * 3072; cb = t * 256; }
        else if (t < 16) { const int w = (t - 4) >> 2; dst = (bf16_t*)(ws + WS_Q + (size_t)w * 34 * MiB) + (size_t)scanrow(row) * 1024; cb = ((t - 4) & 3) * 256; }
        else if (t < 20) { dst = (bf16_t*)(ws + WS_BR) + (size_t)row * 3072 + 1024; cb = (t - 16) * 256; }
        else if (t < 24) { dst = (bf16_t*)(ws + WS_SX) + (size_t)row * 1024; cb = (t - 20) * 256; }
        else if (t < 28) { dst = (bf16_t*)(ws + WS_BR) + (size_t)row * 3072 + 2048; cb = (t - 24) * 256; }
        else if (t < 30) { dst = (bf16_t*)(ws + WS_SB) + (size_t)row * 512; cb = (t - 28) * 256; }
        else if (t < 32) { dst = (bf16_t*)(ws + WS_SC) + (size_t)row * 512; cb = (t - 30) * 256; }
        else if (t < 44) {
            dst = (bf16_t*)(ws + WS_MG) + (size_t)row * 3072; cb = (t - 32) * 256;
#pragma unroll
            for (int j = 0; j < 4; ++j) { lo0[j] = sigmoid_f(lo0[j]); lo1[j] = sigmoid_f(lo1[j]); hi0[j] = sigmoid_f(hi0[j]); hi1[j] = sigmoid_f(hi1[j]); }
        } else {
            if (c0 < 32) { float* d = (float*)(ws + WS_DT) + (size_t)row * 32 + c0; *(f32x4*)d = lo0; *(f32x4*)(d + 4) = lo1; }
            else if (c0 < 48) { float* d = (float*)(ws + WS_GA) + (size_t)scanrow(row) * 16 + (c0 - 32); *(f32x4*)d = lo0; *(f32x4*)(d + 4) = lo1; }
            return;
        }
        *(u32x4*)(dst + cb + c0) = pack8(lo0, lo1);
        *(u32x4*)(dst + cb + 128 + c0) = pack8(hi0, hi1);
    }
};
struct EpiPool {
    bf16_t* BR;
    __device__ __forceinline__ void seg(const Unit& u, int, int r, int c0, f32x4& lo0, f32x4& lo1, f32x4& hi0, f32x4& hi1) const {
        bf16_t* d = BR + (size_t)(u.pm * 256 + r) * 3072 + u.pn * 256 + c0;
        *(u32x4*)d = pack8(lo0, lo1);
        *(u32x4*)(d + 128) = pack8(hi0, hi1);
    }
};
struct EpiBranch {
    const bf16_t* MG; bf16_t* OUT;
    static constexpr bool PRELOAD = true;
    __device__ __forceinline__ void load(const Unit& u, int sg, int r, int c0, u32x4 (&b)[4]) const {
        const bf16_t* g = MG + (size_t)(u.pm * 256 + r) * 3072 + sg * 1024 + u.pn * 256 + c0;
        const int nx = sg < 2 ? 1024 : 0;
        b[0] = *(const u32x4*)g; b[1] = *(const u32x4*)(g + 128); b[2] = *(const u32x4*)(g + nx); b[3] = *(const u32x4*)(g + nx + 128);
    }
    __device__ __forceinline__ void apply(const Unit& u, int sg, int r, int c0, const u32x4 (&bb)[4], f32x4& lo0, f32x4& lo1, f32x4& hi0, f32x4& hi1) const {
        float a[8], b[8], a2[8], b2[8]; unpack8(bb[0], a); unpack8(bb[1], b); unpack8(bb[2], a2); unpack8(bb[3], b2);
        if (sg < 2) {
#pragma unroll
            for (int j = 0; j < 8; ++j) { a[j] = a[j] * __builtin_amdgcn_rcpf(a2[j]); b[j] = b[j] * __builtin_amdgcn_rcpf(b2[j]); } }
#pragma unroll
        for (int j = 0; j < 4; ++j) { lo0[j] *= a[j]; lo1[j] *= a[4 + j]; hi0[j] *= b[j]; hi1[j] *= b[4 + j]; }
        if (sg == 2) { bf16_t* d = OUT + (size_t)(u.pm * 256 + r) * 1024 + u.pn * 256 + c0; *(u32x4*)d = pack8(lo0, lo1); *(u32x4*)(d + 128) = pack8(hi0, hi1); }
    }
    __device__ __forceinline__ void seg(const Unit&, int, int, int, f32x4&, f32x4&, f32x4&, f32x4&) const {}
};
struct EpiOut {
    bf16_t* OL;
    __device__ __forceinline__ void seg(const Unit& u, int, int r, int c0, f32x4& lo0, f32x4& lo1, f32x4& hi0, f32x4& hi1) const {
        bf16_t* d = OL + (size_t)(u.pm * 256 + r) * 1024 + u.pn * 256 + c0;
        *(u32x4*)d = pack8(lo0, lo1); *(u32x4*)(d + 128) = pack8(hi0, hi1);
    }
};
struct EpiMoe1 {
    bf16_t* ACT;
    __device__ __forceinline__ void seg(const Unit& u, int, int r, int c0, f32x4& lo0, f32x4& lo1, f32x4& hi0, f32x4& hi1) const {
        const int row = u.pm * 256 + r;
        f32x4 a, b;
#pragma unroll
        for (int j = 0; j < 4; ++j) { a[j] = silu_f(lo0[j]) * hi0[j]; b[j] = silu_f(lo1[j]) * hi1[j]; }
        *(u32x4*)(ACT + (size_t)row * 512 + u.pn * 128 + c0) = pack8(a, b);
    }
};
struct EpiMoe2 {
    bf16_t* Y;
    __device__ __forceinline__ void seg(const Unit& u, int, int r, int c0, f32x4& lo0, f32x4& lo1, f32x4& hi0, f32x4& hi1) const {
        bf16_t* d = Y + (size_t)(u.pm * 256 + r) * 1024 + u.pn * 256 + c0;
        *(u32x4*)d = pack8(lo0, lo1); *(u32x4*)(d + 128) = pack8(hi0, hi1);
    }
};

template <class E, class = void> struct epi_preload { static constexpr bool value = false; };
template <class E> struct epi_preload<E, decltype((void)E::PRELOAD)> { static constexpr bool value = E::PRELOAD; };

#define LAS __attribute__((address_space(3)))
typedef short bf16x8 __attribute__((ext_vector_type(8)));
constexpr int HTB = 128 * 64 * 2;
__device__ __forceinline__ int lds_byte(int r, int c) { const int st = (r >> 4) * 2 + (c >> 5), rr = r & 15, cc = c & 31, ob = rr * 64 + cc * 2; return st * 1024 + (ob ^ (((ob >> 9) & 1) << 5)); }
__device__ __forceinline__ void stage_rc(int b, int& R, int& C) { const int st = b / 1024, sb = b % 1024, swz = sb ^ (((sb >> 9) & 1) << 5); R = (st >> 1) * 16 + swz / 64; C = (st & 1) * 32 + (swz % 64) / 2; }
__device__ __forceinline__ int perm32(int rho) { const int n = rho >> 4, i = rho & 15; return 8 * (i >> 2) + 4 * n + (i & 3); }

template <bool GATHER, class Sched, class Epi>
__device__ __forceinline__ void gemm_mfma(LAS unsigned char* lds, const Sched& S, const Epi& E, const int K, const int lda, const int ldb, const int nseg) {
    const int tid = tid_fresh(), wid = __builtin_amdgcn_readfirstlane(tid >> 6), lane = tid & 63, wr = wid >> 2, wc = wid & 3, fr = lane & 15, fq = lane >> 4;
    const int nt = K / 64, tseg = nt / nseg;
    unsigned vA0[2], vA1[2], nA0[2], nA1[2], voffB[2]; int rowA[2], colA[2];
#pragma unroll
    for (int i = 0; i < 2; ++i) { int R, C; stage_rc(tid * 16 + i * 8192, R, C); const int Rb = (R & ~31) + perm32(R & 31);
        rowA[i] = R; colA[i] = C;
        vA0[i] = (unsigned)(R * lda + C) * 2u; vA1[i] = vA0[i] + (unsigned)(128 * lda * 2); nA0[i] = vA0[i]; nA1[i] = vA1[i];
        voffB[i] = (unsigned)(Rb * ldb + C) * 2u; }
    const size_t kstep = 128;
    const size_t hstepB = (size_t)128 * ldb * 2;
    const unsigned ldsw = (unsigned)wid * 1024u;
    const int aoff = lds_byte(wr * 64 + fr, fq * 8), boff = lds_byte(wc * 32 + fr, fq * 8);
#define PG8_SA(b, h) (((b) * 2 + (h)) * HTB)
#define PG8_SB(b, h) ((4 + (b) * 2 + (h)) * HTB)
#define PG8_STAGE(bufoff, gbase, voff) do { _Pragma("unroll") for (int _i = 0; _i < 2; ++_i) \
        __builtin_amdgcn_global_load_lds((const unsigned*)((const char*)(gbase) + (voff)[_i]), (LAS unsigned*)(lds + (bufoff) + ldsw + _i * 8192), 16, 0, 0); } while (0)
#define PG8_LDA(dst, b, h) do { _Pragma("unroll") for (int m = 0; m < 4; ++m) _Pragma("unroll") for (int k = 0; k < 2; ++k) dst[m][k] = *(const LAS bf16x8*)(lds + PG8_SA(b, h) + aoff + m * 2048 + k * 1024); } while (0)
#define PG8_LDB(dst, b, h) do { _Pragma("unroll") for (int n = 0; n < 2; ++n) _Pragma("unroll") for (int k = 0; k < 2; ++k) dst[n][k] = *(const LAS bf16x8*)(lds + PG8_SB(b, h) + boff + n * 2048 + k * 1024); } while (0)
#define PG8_MMA(ai, bj, At, Bt) do { __builtin_amdgcn_s_setprio(1); _Pragma("unroll") for (int m = 0; m < 4; ++m) _Pragma("unroll") for (int n = 0; n < 2; ++n) _Pragma("unroll") for (int k = 0; k < 2; ++k) \
        acc[ai][bj][m][n] = __builtin_amdgcn_mfma_f32_16x16x32_bf16(Bt[n][k], At[m][k], acc[ai][bj][m][n], 0, 0, 0); __builtin_amdgcn_s_setprio(0); } while (0)
#define PG8_WAIT_V(n) asm volatile("s_waitcnt vmcnt(" #n ")" ::: "memory")
#define PG8_WAIT_L(n) asm volatile("s_waitcnt lgkmcnt(" #n ")" ::: "memory")
#define PG8_BAR __builtin_amdgcn_s_barrier()
#define PG8_SCHED __builtin_amdgcn_sched_barrier(0)
#define PG8_EPI(sg) do { \
    if constexpr (epi_preload<Epi>::value) { \
        _Pragma("unroll") for (int ai = 0; ai < 2; ++ai) _Pragma("unroll") for (int mh = 0; mh < 2; ++mh) { u32x4 gbuf[2][4]; int rr_[2]; \
            _Pragma("unroll") for (int m = 0; m < 2; ++m) { int r_ = ai * 128 + wr * 64 + (2 * mh + m) * 16 + fr; asm volatile("" : "+v"(r_)); rr_[m] = r_; E.load(cur, (sg), r_, wc * 32 + fq * 8, gbuf[m]); } \
            __builtin_amdgcn_sched_barrier(0); \
            _Pragma("unroll") for (int m = 0; m < 2; ++m) E.apply(cur, (sg), rr_[m], wc * 32 + fq * 8, gbuf[m], acc[ai][0][2 * mh + m][0], acc[ai][0][2 * mh + m][1], acc[ai][1][2 * mh + m][0], acc[ai][1][2 * mh + m][1]); \
            __builtin_amdgcn_sched_barrier(0); } \
    } else { \
        _Pragma("unroll") for (int ai = 0; ai < 2; ++ai) _Pragma("unroll") for (int m = 0; m < 4; ++m) { \
            int r_ = ai * 128 + wr * 64 + m * 16 + fr; asm volatile("" : "+v"(r_));     \
            E.seg(cur, (sg), r_, wc * 32 + fq * 8, acc[ai][0][m][0], acc[ai][0][m][1], acc[ai][1][m][0], acc[ai][1][m][1]); } } } while (0)
    Unit cur, nxt; int ui = 0;
    if (!S.next(0, cur)) return;
    f32x4 acc[2][2][4][2];
#pragma unroll
    for (int a = 0; a < 2; ++a)
#pragma unroll
        for (int b = 0; b < 2; ++b)
#pragma unroll
            for (int m = 0; m < 4; ++m)
#pragma unroll
                for (int n = 0; n < 2; ++n) acc[a][b][m][n] = (f32x4){0.f, 0.f, 0.f, 0.f};
    bf16x8 At[4][2], B0[2][2], B1[2][2];
    const char* cA = (const char*)cur.A; const char* cB = (const char*)cur.B;
    if (GATHER) {
#pragma unroll
        for (int i = 0; i < 2; ++i) { vA0[i] = (unsigned)(cur.tok[rowA[i]] * lda + colA[i]) * 2u; vA1[i] = (unsigned)(cur.tok[128 + rowA[i]] * lda + colA[i]) * 2u; nA0[i] = vA0[i]; nA1[i] = vA1[i]; }
    }
    PG8_STAGE(PG8_SB(0, 0), cB, voffB); PG8_STAGE(PG8_SA(0, 0), cA, vA0); PG8_STAGE(PG8_SB(0, 1), cB + hstepB, voffB); PG8_STAGE(PG8_SA(0, 1), cA, vA1);
    if (wr == 1) PG8_BAR;
    PG8_WAIT_V(4); PG8_BAR;
    PG8_STAGE(PG8_SB(1, 0), cB + kstep, voffB); PG8_STAGE(PG8_SA(1, 0), cA + kstep, vA0); PG8_STAGE(PG8_SB(1, 1), cB + hstepB + kstep, voffB);
    PG8_WAIT_V(6); PG8_BAR;
    for (;;) {
        const bool has_next = S.next(ui + 1, nxt);
        const char* nA = has_next ? (const char*)nxt.A : cA; const char* nB = has_next ? (const char*)nxt.B : cB;
        if (GATHER) {
            const int* tk = has_next ? nxt.tok : cur.tok;
#pragma unroll
            for (int i = 0; i < 2; ++i) { nA0[i] = (unsigned)(tk[rowA[i]] * lda + colA[i]) * 2u; nA1[i] = (unsigned)(tk[128 + rowA[i]] * lda + colA[i]) * 2u; }
        }
#pragma nounroll
        for (int sg = 0; sg < nseg; ++sg) {
#pragma nounroll
        for (int tt = 0; tt < tseg; tt += 2) {
            const int t = sg * tseg + tt;
            const bool last = (t == nt - 2);
            const char* a1 = cA + (size_t)(t + 1) * kstep;
            const char* a2 = last ? nA : cA + (size_t)(t + 2) * kstep; const char* b2 = last ? nB : cB + (size_t)(t + 2) * kstep;
            const char* a3 = a2 + kstep; const char* b3 = b2 + kstep;
            unsigned w0[2], w1[2];
#pragma unroll
            for (int i = 0; i < 2; ++i) { w0[i] = last ? nA0[i] : vA0[i]; w1[i] = last ? nA1[i] : vA1[i]; }
            PG8_LDB(B0, 0, 0); PG8_SCHED; PG8_LDA(At, 0, 0); PG8_STAGE(PG8_SA(1, 1), a1, vA1);
            PG8_WAIT_L(8); PG8_BAR; PG8_WAIT_L(0); PG8_MMA(0, 0, At, B0); PG8_BAR; PG8_SCHED;
            PG8_LDB(B1, 0, 1); PG8_STAGE(PG8_SB(0, 0), b2, voffB);
            PG8_BAR; PG8_WAIT_L(0); PG8_MMA(0, 1, At, B1); PG8_BAR;
            PG8_LDA(At, 0, 1); PG8_STAGE(PG8_SA(0, 0), a2, w0);
            PG8_BAR; PG8_WAIT_L(0); PG8_MMA(1, 0, At, B0); PG8_BAR; PG8_SCHED;
            PG8_STAGE(PG8_SB(0, 1), b2 + hstepB, voffB);
            PG8_WAIT_V(6); PG8_BAR; PG8_MMA(1, 1, At, B1); PG8_BAR;
            PG8_LDB(B0, 1, 0); PG8_SCHED; PG8_LDA(At, 1, 0); PG8_STAGE(PG8_SA(0, 1), a2, w1);
            PG8_WAIT_L(8); PG8_BAR; PG8_WAIT_L(0); PG8_MMA(0, 0, At, B0); PG8_BAR; PG8_SCHED;
            PG8_LDB(B1, 1, 1); PG8_STAGE(PG8_SB(1, 0), b3, voffB);
            PG8_BAR; PG8_WAIT_L(0); PG8_MMA(0, 1, At, B1); PG8_BAR;
            PG8_LDA(At, 1, 1); PG8_STAGE(PG8_SA(1, 0), a3, w0);
            PG8_BAR; PG8_WAIT_L(0); PG8_MMA(1, 0, At, B0); PG8_BAR; PG8_SCHED;
            PG8_STAGE(PG8_SB(1, 1), b3 + hstepB, voffB);
            PG8_WAIT_V(6); PG8_BAR; PG8_MMA(1, 1, At, B1); PG8_BAR;
        }
        PG8_EPI(sg);
        }
        if (!has_next) break;
#pragma unroll
        for (int a = 0; a < 2; ++a)
#pragma unroll
            for (int b = 0; b < 2; ++b)
#pragma unroll
                for (int m = 0; m < 4; ++m)
#pragma unroll
                    for (int n = 0; n < 2; ++n) acc[a][b][m][n] = (f32x4){0.f, 0.f, 0.f, 0.f};
        cur = nxt; cA = nA; cB = nB; ++ui;
#pragma unroll
        for (int i = 0; i < 2; ++i) { vA0[i] = nA0[i]; vA1[i] = nA1[i]; }
    }
    PG8_WAIT_V(0);
    if (wr == 0) PG8_BAR;
    PG8_BAR;
#undef PG8_SA
#undef PG8_SB
#undef PG8_STAGE
#undef PG8_LDA
#undef PG8_LDB
#undef PG8_MMA
#undef PG8_WAIT_V
#undef PG8_WAIT_L
#undef PG8_BAR
#undef PG8_SCHED
#undef PG8_EPI
}

template <bool GATHER = false, class Sched, class Epi>
__device__ __forceinline__ void gemm_run(unsigned char* lds, const Sched& S, const Epi& E, int K, int lda, int ldb, int nseg) {
    __syncthreads();
    gemm_mfma<GATHER>((LAS unsigned char*)lds, S, E, K, lda, ldb, nseg);
    __syncthreads();
}

struct TrDesc { const float* src; const float* cscale; bf16_t* dst; int ld_src, ld_dst, valid; };
__device__ __forceinline__ void tr_load(const TrDesc& d, f32x4 (&v)[16]) {
    if (d.src) {
#pragma unroll
        for (int i = 0; i < 16; ++i) v[i] = *(const f32x4*)(d.src + (size_t)(4 * i) * d.ld_src);
    } else {
#pragma unroll
        for (int i = 0; i < 16; ++i) v[i] = (f32x4){0.f, 0.f, 0.f, 0.f};
    }
}
__device__ __forceinline__ void tr_store(const TrDesc& d, f32x4 (&v)[16], float* scr, int lane) {
    const int c4 = (lane & 15) * 4, kr = lane >> 4;
    if (d.cscale) { const f32x4 s = *(const f32x4*)d.cscale;
#pragma unroll
        for (int i = 0; i < 16; ++i) v[i] = v[i] * s; }
#pragma unroll
    for (int i = 0; i < 16; ++i) { float* q = scr + (kr + 4 * i) * 65 + c4; q[0] = v[i][0]; q[1] = v[i][1]; q[2] = v[i][2]; q[3] = v[i][3]; }
    asm volatile("s_waitcnt lgkmcnt(0)" ::: "memory");
    const int c = lane & 7;
#pragma unroll
    for (int j = 0; j < 8; ++j) { const int n = (lane >> 3) + 8 * j; const float* s = scr + (8 * c) * 65 + n;
        u32x4 o; o.x = pk2(s[0 * 65], s[1 * 65]); o.y = pk2(s[2 * 65], s[3 * 65]); o.z = pk2(s[4 * 65], s[5 * 65]); o.w = pk2(s[6 * 65], s[7 * 65]);
        *(u32x4*)(d.dst + (size_t)n * d.ld_dst + 8 * c) = o; }
    asm volatile("s_waitcnt lgkmcnt(0)" ::: "memory");
}
__device__ __forceinline__ TrDesc tr_desc(const float* W, int ld_src, int srcq, bf16_t* WT, int ld_dst, int n_dst, int kdst0, int k0, int lane, const float* cscale = nullptr) {
    TrDesc d; d.ld_src = ld_src; d.ld_dst = ld_dst; d.valid = 1;
    d.src = srcq >= 0 ? W + (size_t)(k0 + (lane >> 4)) * ld_src + srcq : nullptr;
    d.cscale = (cscale && srcq >= 0) ? cscale + srcq : nullptr;
    d.dst = WT + (size_t)n_dst * ld_dst + kdst0 + k0; return d;
}
constexpr int CV_MIX_ITEMS = 2880 + 64 + 768 + 256;
constexpr int CV_EXP_ITEMS = 32 * 384;
__device__ __forceinline__ TrDesc convert_desc(const Params& p, int le, int lm, int it, int lane) {
    unsigned char* ws = p.ws;
    const int c4 = (lane & 15) * 4;
    if (le >= 0) {
        if (it < CV_EXP_ITEMS) {
            const int e = it / 384, r = it % 384;
            if (r < 256) { const int up = r >> 7, q = r & 127, kb = ((q >> 5) << 2) | ((q >> 1) & 3), nb = (((q >> 3) & 3) << 1) | (q & 1); const int c = nb * 64;
                const float* src = (up ? p.w_eu : p.w_eg) + (size_t)(le * 32 + e) * 1024 * 512;
                return tr_desc(src, 512, c + c4, (bf16_t*)(ws + WS_EW1) + (size_t)e * 1048576, 1024, (c >> 7) * 256 + up * 128 + (c & 127), 0, kb * 64, lane); }
            const int q = r - 256, kb = ((q >> 6) << 2) | ((q >> 1) & 3), nb = (((q >> 3) & 7) << 1) | (q & 1);
            return tr_desc(p.w_ed + (size_t)(le * 32 + e) * 512 * 1024, 1024, nb * 64 + c4, (bf16_t*)(ws + WS_EW2) + (size_t)e * 524288, 512, nb * 64, 0, kb * 64, lane);
        }
        it -= CV_EXP_ITEMS;
    }
    const int l = lm;
    if (it < 2880) { const int R = it >> 4, kb = it & 15, dstn = R * 64; int srcq;
        if (R < 80) srcq = dstn + c4; else if (R < 128) srcq = dstn + 16 + c4; else if (R < 176) srcq = dstn + 48 + c4;
        else if (R == 176) srcq = c4 < 32 ? 8208 + c4 : (c4 < 48 ? 5120 + (c4 - 32) : -1); else srcq = -1;
        return tr_desc(p.w_in + (size_t)l * 1024 * DIN, DIN, srcq, (bf16_t*)(ws + WS_WIN), 1024, dstn, 0, kb * 64, lane); }
    it -= 2880;
    if (it < 64) { const int g = it >> 4, r = it & 15, kb = r >> 2, nb = r & 3;
        return tr_desc(p.pool_w + (size_t)(l * 4 + g) * 65536, 256, nb * 64 + c4, (bf16_t*)(ws + WS_WPOOL) + (size_t)g * 65536, 256, nb * 64, 0, kb * 64, lane, p.pool_scale + l * 1024 + g * 256); }
    it -= 64;
    if (it < 768) { const int br = it >> 8, r = it & 255, kb = r >> 4, nb = r & 15;
        return tr_desc(p.w_branch + (size_t)(l * 3 + br) * 1048576, 1024, nb * 64 + c4, (bf16_t*)(ws + WS_WBR), 3072, nb * 64, br * 1024, kb * 64, lane); }
    it -= 768;
    { const int kb = it >> 4, nb = it & 15;
      return tr_desc(p.w_out + (size_t)l * 1048576, 1024, nb * 64 + c4, (bf16_t*)(ws + WS_WOUT), 1024, nb * 64, 0, kb * 64, lane); }
}
__device__ __forceinline__ void convert_run(const Params& p, int le, int lm, int first, int step, float* scr, int lane) {
    const int nitems = (le >= 0 ? CV_EXP_ITEMS : 0) + (lm >= 0 ? CV_MIX_ITEMS : 0);
    if (first >= nitems) return;
    f32x4 va[16], vb[16];
    TrDesc da = convert_desc(p, le, lm, first, lane), db;
    tr_load(da, va);
    for (int it = first; it < nitems; it += 2 * step) {
        const int i1 = it + step, i2 = it + 2 * step;
        if (i1 < nitems) { db = convert_desc(p, le, lm, i1, lane); tr_load(db, vb); }
        tr_store(da, va, scr, lane);
        if (i1 >= nitems) break;
        if (i2 < nitems) { da = convert_desc(p, le, lm, i2, lane); tr_load(da, va); }
        tr_store(db, vb, scr, lane);
    }
}

__device__ __forceinline__ void cvmicro_load(const Params& p, int le, int m, int lane, f32x4 (&v)[8], TrDesc& d) {
    d = convert_desc(p, le, -1, m >> 1, lane);
    const float* s = d.src + (size_t)(32 * (m & 1)) * d.ld_src;
#pragma unroll
    for (int i = 0; i < 8; ++i) v[i] = *(const f32x4*)(s + (size_t)(4 * i) * d.ld_src);
}
__device__ __forceinline__ void cvmicro_store(const TrDesc& d, int m, const f32x4 (&v)[8], LAS float* scr, int lane) {
    const int c4 = (lane & 15) * 4, kr = lane >> 4;
#pragma unroll
    for (int i = 0; i < 8; ++i) { LAS float* q = scr + (kr + 4 * i) * 65 + c4; q[0] = v[i][0]; q[1] = v[i][1]; q[2] = v[i][2]; q[3] = v[i][3]; }
    asm volatile("s_waitcnt lgkmcnt(0)" ::: "memory");
    bf16_t* drow = d.dst + (size_t)lane * d.ld_dst + 32 * (m & 1);
#pragma unroll
    for (int g = 0; g < 4; ++g) { const LAS float* s = scr + (8 * g) * 65 + lane;
        u32x4 o; o.x = pk2(s[0 * 65], s[1 * 65]); o.y = pk2(s[2 * 65], s[3 * 65]); o.z = pk2(s[4 * 65], s[5 * 65]); o.w = pk2(s[6 * 65], s[7 * 65]);
        *(u32x4*)(drow + 8 * g) = o; }
    asm volatile("s_waitcnt lgkmcnt(0)" ::: "memory");
}

__device__ __forceinline__ void phase_pre(const Params& p, unsigned char* ldsb, int bid, int nb) {
    float* lds = reinterpret_cast<float*>(ldsb);
    const int tid = tid_fresh(), lane = tid & 63, wave = tid >> 6;
    for (int i = tid; i < 5 * 1024; i += NTHR) { const float v = i < 4096 ? p.c[i] : p.c_ctx[i - 4096]; lds[i] = silu_f(v); }
    __syncthreads();
    float* red = lds + 5120;
    for (int it = bid; it < 2 * 96; it += nb) {
        const int l = it / 96, j = (it % 96) * 64 + lane;
        const float* w = p.w_ada + (size_t)l * 1024 * 6144 + j;
        float a0 = 0, a1 = 0, a2 = 0, a3 = 0, a4 = 0;
#pragma unroll 16
        for (int k = wave * 128; k < wave * 128 + 128; ++k) { const float wv = w[(size_t)k * 6144];
            a0 += lds[k] * wv; a1 += lds[1024 + k] * wv; a2 += lds[2048 + k] * wv; a3 += lds[3072 + k] * wv; a4 += lds[4096 + k] * wv; }
        red[(wave * 5 + 0) * 64 + lane] = a0; red[(wave * 5 + 1) * 64 + lane] = a1; red[(wave * 5 + 2) * 64 + lane] = a2;
        red[(wave * 5 + 3) * 64 + lane] = a3; red[(wave * 5 + 4) * 64 + lane] = a4;
        __syncthreads();
        if (tid < 320) { const int r = tid >> 6, jj = tid & 63; float s = 0;
            for (int w8 = 0; w8 < 8; ++w8) s += red[(w8 * 5 + r) * 64 + jj];
            const int col = (it % 96) * 64 + jj;
            ((float*)(p.ws + WS_MOD))[(size_t)(l * 5 + r) * 6144 + col] = s + p.b_ada[l * 6144 + col]; }
        __syncthreads();
    }
    __syncthreads();
    float* scr = lds + wave * (64 * 65);
    convert_run(p, -1, 0, bid * 8 + wave, nb * 8, scr, lane);
}

__device__ __forceinline__ void norm_mod_row(f32x4 (&v)[4], const float* g, const float* shift, const float* scale, int lane) {
    float s = 0.f;
#pragma unroll
    for (int j = 0; j < 4; ++j) s += (v[j][0] * v[j][0] + v[j][1] * v[j][1]) + (v[j][2] * v[j][2] + v[j][3] * v[j][3]);
    const float rs = __builtin_amdgcn_rsqf(wave_sum(s) * (1.f / 1024.f) + EPS);
#pragma unroll
    for (int j = 0; j < 4; ++j) { const int c = 4 * lane + 256 * j; const f32x4 gg = *(const f32x4*)(g + c);
        f32x4 y = v[j] * rs * gg;
        if (shift) { const f32x4 sh = *(const f32x4*)(shift + c), sc = *(const f32x4*)(scale + c); y = y * (1.f + sc) + sh; }
        v[j] = y; }
}
__device__ __forceinline__ void store_row_bf16(bf16_t* dst, const f32x4 (&v)[4], int lane) {
#pragma unroll
    for (int j = 0; j < 4; ++j) { u32x2 w; w.x = pk2(v[j][0], v[j][1]); w.y = pk2(v[j][2], v[j][3]); *(u32x2*)(dst + 4 * lane + 256 * j) = w; }
}

__device__ __forceinline__ void phase_norm1(const Params& p, int bid, int nb) {
    const int lane = tid_fresh() & 63, wave = tid_fresh() >> 6;
    const float* mod = (const float*)(p.ws + WS_MOD);
    const int stride = nb * 8;
    int m = bid * 8 + wave;
    f32x4 v[4], w[4];
    if (m < MT) { const float* src = m < MC ? p.ctx + (size_t)m * 1024 : p.x + (size_t)(m - MC) * 1024;
#pragma unroll
        for (int j = 0; j < 4; ++j) v[j] = *(const f32x4*)(src + 4 * lane + 256 * j); }
    for (; m < MT; m += stride) {
        const int mn = m + stride;
        if (mn < MT) { const float* src = mn < MC ? p.ctx + (size_t)mn * 1024 : p.x + (size_t)(mn - MC) * 1024;
#pragma unroll
            for (int j = 0; j < 4; ++j) w[j] = *(const f32x4*)(src + 4 * lane + 256 * j); }
        const float* mr = mod + modrow(m) * 6144;
        norm_mod_row(v, p.g_mix, mr, mr + 1024, lane);
        store_row_bf16((bf16_t*)(p.ws + WS_H) + (size_t)m * 1024, v, lane);
#pragma unroll
        for (int j = 0; j < 4; ++j) v[j] = w[j];
    }
}

__device__ __forceinline__ float wave_incl_sum(float v, int lane) {
#pragma unroll
    for (int o = 1; o < 64; o <<= 1) { const float u = __shfl_up(v, o); if (lane >= o) v += u; }
    return v;
}
__device__ __forceinline__ float wave_incl_max(float v, int lane) {
#pragma unroll
    for (int o = 1; o < 64; o <<= 1) { const float u = __shfl_up(v, o); if (lane >= o) v = fmaxf(v, u); }
    return v;
}
__device__ __forceinline__ u32x2 pack4(f32x4 a) { u32x2 w; w.x = pk2(a[0], a[1]); w.y = pk2(a[2], a[3]); return w; }

__device__ __forceinline__ void chunk_geom(int gc, int& rbase, int& n0, int& len) {
    const int b = gc / 68, cin = gc % 68;
    if (cin < 4) { rbase = b * 256; n0 = cin * 64; len = 256; } else { rbase = MC + b * 4096; n0 = (cin - 4) * 64; len = 4096; }
}
struct ConvW { float w[4][8], b[8]; };
__device__ __forceinline__ void conv_load_w(const float* cw, const float* cb, int ch0, ConvW& W) {
#pragma unroll
    for (int j = 0; j < 4; ++j) { const f32x4 a = *(const f32x4*)(cw + j * 2048 + ch0), b2 = *(const f32x4*)(cw + j * 2048 + ch0 + 4);
#pragma unroll
        for (int i = 0; i < 4; ++i) { W.w[j][i] = a[i]; W.w[j][4 + i] = b2[i]; } }
    { const f32x4 a = *(const f32x4*)(cb + ch0), b2 = *(const f32x4*)(cb + ch0 + 4);
#pragma unroll
      for (int i = 0; i < 4; ++i) { W.b[i] = a[i]; W.b[4 + i] = b2[i]; } }
}
__device__ __forceinline__ void conv8x4(const u32x4 (&raw)[7], const ConvW& W, float scale, u32x4 (&out)[4]) {
    float f[7][8];
#pragma unroll
    for (int k = 0; k < 7; ++k) unpack8(raw[k], f[k]);
#pragma unroll
    for (int pp = 0; pp < 4; ++pp) { f32x4 o0, o1;
#pragma unroll
        for (int i = 0; i < 8; ++i) { float a = W.b[i];
#pragma unroll
            for (int j = 0; j < 4; ++j) a += W.w[j][i] * f[pp + j][i];
            a = silu_f(a) * scale; if (i < 4) o0[i] = a; else o1[i - 4] = a; }
        out[pp] = pack8(o0, o1); }
}
__device__ __forceinline__ void load_raw7(const bf16_t* src, size_t ld, int rbase, int tbase, int len, u32x4 (&raw)[7]) {
#pragma unroll
    for (int k = 0; k < 7; ++k) { const int t = tbase + k; const bool ok = (t >= 0) && (t < len); const int tc = t < 0 ? 0 : (t >= len ? len - 1 : t);
        u32x4 a = *(const u32x4*)(src + (size_t)(rbase + tc) * ld);
        if (!ok) a = (u32x4){0u, 0u, 0u, 0u};
        raw[k] = a; }
}
template <class F>
__device__ __forceinline__ void tile_transpose_out(const LAS bf16_t* tile, int ldsw, int ncol, int tid, F rowptr) {
    for (int q = tid; q < ncol * 8; q += NTHR) { const int c = q % ncol, sc = q / ncol;
        unsigned v[8];
#pragma unroll
        for (int i = 0; i < 8; ++i) v[i] = tile[(sc * 8 + i) * ldsw + c];
        u32x4 w; w.x = v[0] | (v[1] << 16); w.y = v[2] | (v[3] << 16); w.z = v[4] | (v[5] << 16); w.w = v[6] | (v[7] << 16);
        *(u32x4*)(rowptr(c) + sc * 8) = w; }
}

__device__ __forceinline__ void conv_m_item(const Params& p, int l, int item, LAS unsigned char* lds, const ConvW& Wq, const ConvW& Wk) {
    const int tid = tid_fresh(), gc = item >> 2, hd = item & 3;
    int rbase, n0, len; chunk_geom(gc, rbase, n0, len);
    const int cs = tid & 31, tg = tid >> 5, d0 = cs * 8, i0 = tg * 4;
    u32x4 rq[7], rk[7]; float g0 = 0.f, g1 = 0.f;
    load_raw7((const bf16_t*)(p.ws + WS_Q) + hd * 256 + d0, 1024, rbase, n0 + i0 - 2, len, rq);
    load_raw7((const bf16_t*)(p.ws + WS_K) + hd * 256 + d0, 1024, rbase, n0 + i0 - 2, len, rk);
    const int gdir = tid >> 6, glane = tid & 63, gj = gdir ? 63 - glane : glane;
    if (gdir < 2) { const float* g = (const float*)(p.ws + WS_GA) + (size_t)(rbase + n0 + gj) * 16; g0 = g[gdir * 4 + hd]; g1 = g[(2 + gdir) * 4 + hd]; }
    { u32x4 o[4];
      conv8x4(rq, Wq, 1.0f, o);
#pragma unroll
      for (int pp = 0; pp < 4; ++pp) *(u32x4*)((bf16_t*)(p.ws + WS_QC) + (size_t)(rbase + n0 + i0 + pp) * 1024 + hd * 256 + d0) = o[pp];
      conv8x4(rk, Wk, 0.0625f, o);
#pragma unroll
      for (int pp = 0; pp < 4; ++pp) *(u32x4*)((bf16_t*)(p.ws + WS_KC) + (size_t)(rbase + n0 + i0 + pp) * 1024 + hd * 256 + d0) = o[pp]; }
    for (int rep_ = 0; rep_ < ((CONVDUP & 4) ? 2 : 1); ++rep_)
    if (gdir < 2) {
        const float ig = g0 + p.mgate_b[l * 16 + gdir * 4 + hd], lf = logsigmoid_f(g1 + p.mgate_b[l * 16 + (2 + gdir) * 4 + hd]);
        const float cum = wave_incl_sum(lf, glane), a = ig - cum, pm = wave_incl_max(a, glane);
        const size_t o = (size_t)(gc * 8 + gdir * 4 + hd) * 64 + gj;
        ((float*)(p.ws + WS_MGA))[o] = a; ((float*)(p.ws + WS_MGC))[o] = cum; ((float*)(p.ws + WS_MGP))[o] = pm;
    }
}

__device__ __forceinline__ void conv_s_item(const Params& p, int l, int item, LAS unsigned char* lds, const ConvW& Wbc, const ConvW& Wx) {
    const int tid = tid_fresh(), gc = item >> 2, grp = item & 3;
    int rbase, n0, len; chunk_geom(gc, rbase, n0, len);
    const int cs = tid & 31, tg = tid >> 5, i0 = tg * 4;
    const int isC = cs >> 4, nn = (cs & 15) * 8;
    u32x4 rbc[7], rx[7];
    load_raw7((const bf16_t*)(p.ws + (isC ? WS_SC : WS_SB)) + grp * 128 + nn, 512, rbase, n0 + i0 - 2, len, rbc);
    load_raw7((const bf16_t*)(p.ws + WS_SX) + grp * 256 + cs * 8, 1024, rbase, n0 + i0 - 2, len, rx);
    const int wv = tid >> 6, lane = tid & 63, dir = wv >> 2, hd = grp * 4 + (wv & 3), jn = dir ? 63 - lane : lane;
    const float dtraw = ((const float*)(p.ws + WS_DT))[(size_t)(rbase + n0 + jn) * 32 + dir * 16 + hd];
    { u32x4 o[4];
      conv8x4(rbc, Wbc, 1.0f, o);
      bf16_t* dst = (bf16_t*)(p.ws + (isC ? WS_CC : WS_BC)) + grp * 128 + nn;
#pragma unroll
      for (int pp = 0; pp < 4; ++pp) *(u32x4*)(dst + (size_t)(rbase + n0 + i0 + pp) * 512) = o[pp];
      conv8x4(rx, Wx, 1.0f, o);
      bf16_t* dx = (bf16_t*)(p.ws + WS_XCT) + grp * 256 + cs * 8;
#pragma unroll
      for (int pp = 0; pp < 4; ++pp) *(u32x4*)(dx + (size_t)(rbase + n0 + i0 + pp) * 1024) = o[pp]; }
    { const float dtv = softplus_f(dtraw + p.sdt_bias[l * 32 + dir * 16 + hd]);
      const float acs = wave_incl_sum(dtv * -__expf(p.sa_log[l * 32 + dir * 16 + hd]), lane);
      const size_t o = (size_t)(gc * 32 + dir * 16 + hd) * 64 + jn;
      ((float*)(p.ws + WS_SACS))[o] = acs; ((float*)(p.ws + WS_SDT))[o] = dtv; }
}

__device__ __forceinline__ void pool_window_item(const Params& p, int it, LAS unsigned char* lds) {
    const int tid = tid_fresh();
    bf16_t* BR = (bf16_t*)(p.ws + WS_BR);
    __syncthreads();
    if (it < 256) {
        const int row0 = MC + it * 64;
        { u32x4 t[16];
#pragma unroll
          for (int i = 0; i < 16; ++i) { const int q = tid + NTHR * i, r = q >> 7, ch = q & 127; t[i] = *(const u32x4*)(BR + (size_t)(row0 + r) * 3072 + ch * 8); }
#pragma unroll
          for (int i = 0; i < 16; ++i) *(LAS u32x4*)(lds + (tid + NTHR * i) * 16) = t[i]; }
        __syncthreads();
        for (int q = tid; q < 64 * 128; q += NTHR) { const int r = q >> 7, ch = q & 127, w = 2 << (ch >> 5);
            int lo = r - (w >> 1), hi = lo + w - 1; lo = lo < 0 ? 0 : lo; hi = hi > 63 ? 63 : hi;
            float s[8] = {0, 0, 0, 0, 0, 0, 0, 0}, self[8];
            for (int rr = lo; rr <= hi; ++rr) { float f[8]; unpack8(*(const LAS u32x4*)(lds + (rr * 128 + ch) * 16), f);
#pragma unroll
                for (int j = 0; j < 8; ++j) s[j] += f[j]; }
            unpack8(*(const LAS u32x4*)(lds + q * 16), self);
            const float inv = __builtin_amdgcn_rcpf((float)(hi - lo + 1)); f32x4 a, b;
#pragma unroll
            for (int j = 0; j < 4; ++j) { a[j] = s[j] * inv - self[j]; b[j] = s[4 + j] * inv - self[4 + j]; }
            *(u32x4*)(BR + (size_t)(row0 + r) * 3072 + ch * 8) = pack8(a, b); }
    } else {
        const int bb = (it - 256) >> 2, g = (it - 256) & 3, row0 = bb * 256, w = 2 << g;
        { u32x4 t[16];
#pragma unroll
          for (int i = 0; i < 16; ++i) { const int q = tid + NTHR * i, r = q >> 5, ch = q & 31; t[i] = *(const u32x4*)(BR + (size_t)(row0 + r) * 3072 + g * 256 + ch * 8); }
#pragma unroll
          for (int i = 0; i < 16; ++i) *(LAS u32x4*)(lds + (tid + NTHR * i) * 16) = t[i]; }
        __syncthreads();
        for (int q = tid; q < 256 * 32; q += NTHR) { const int r = q >> 5, ch = q & 31;
            int lo = r - (w >> 1), hi = lo + w - 1; lo = lo < 0 ? 0 : lo; hi = hi > 255 ? 255 : hi;
            float s[8] = {0, 0, 0, 0, 0, 0, 0, 0}, self[8];
            for (int rr = lo; rr <= hi; ++rr) { float f[8]; unpack8(*(const LAS u32x4*)(lds + (rr * 32 + ch) * 16), f);
#pragma unroll
                for (int j = 0; j < 8; ++j) s[j] += f[j]; }
            unpack8(*(const LAS u32x4*)(lds + q * 16), self);
            const float inv = __builtin_amdgcn_rcpf((float)(hi - lo + 1)); f32x4 a, b;
#pragma unroll
            for (int j = 0; j < 4; ++j) { a[j] = s[j] * inv - self[j]; b[j] = s[4 + j] * inv - self[4 + j]; }
            *(u32x4*)(BR + (size_t)(row0 + r) * 3072 + g * 256 + ch * 8) = pack8(a, b); }
    }
    __syncthreads();
}

typedef short bf16x4 __attribute__((ext_vector_type(4)));
__device__ __forceinline__ bf16x8 tr_join(bf16x4 r0, bf16x4 r1) { bf16x8 o; o[0] = r0[0]; o[1] = r0[1]; o[2] = r0[2]; o[3] = r0[3]; o[4] = r1[0]; o[5] = r1[1]; o[6] = r1[2]; o[7] = r1[3]; return o; }
__device__ __forceinline__ bf16x8 tr_frag(unsigned a0, unsigned a1) {
    bf16x4 r0, r1;
    asm volatile("ds_read_b64_tr_b16 %0, %2\n\tds_read_b64_tr_b16 %1, %3\n\ts_waitcnt lgkmcnt(0)" : "=&v"(r0), "=&v"(r1) : "v"(a0), "v"(a1) : "memory");
    return tr_join(r0, r1);
}
__device__ __forceinline__ void tr_frag4(const unsigned (&a)[4], unsigned d, bf16x8 (&f)[4]) {
    bf16x4 r[8];
    asm volatile("ds_read_b64_tr_b16 %0, %8\n\tds_read_b64_tr_b16 %1, %9\n\tds_read_b64_tr_b16 %2, %10\n\tds_read_b64_tr_b16 %3, %11\n\t"
                 "ds_read_b64_tr_b16 %4, %12\n\tds_read_b64_tr_b16 %5, %13\n\tds_read_b64_tr_b16 %6, %14\n\tds_read_b64_tr_b16 %7, %15\n\ts_waitcnt lgkmcnt(0)"
                 : "=&v"(r[0]), "=&v"(r[1]), "=&v"(r[2]), "=&v"(r[3]), "=&v"(r[4]), "=&v"(r[5]), "=&v"(r[6]), "=&v"(r[7])
                 : "v"(a[0]), "v"(a[0] + d), "v"(a[1]), "v"(a[1] + d), "v"(a[2]), "v"(a[2] + d), "v"(a[3]), "v"(a[3] + d) : "memory");
#pragma unroll
    for (int i = 0; i < 4; ++i) f[i] = tr_join(r[2 * i], r[2 * i + 1]);
}
__device__ __forceinline__ void tr_frag6(const unsigned (&a)[6], unsigned d, bf16x8 (&f)[6]) {
    bf16x4 r[12];
    asm volatile("ds_read_b64_tr_b16 %0, %12\n\tds_read_b64_tr_b16 %1, %13\n\tds_read_b64_tr_b16 %2, %14\n\tds_read_b64_tr_b16 %3, %15\n\t"
                 "ds_read_b64_tr_b16 %4, %16\n\tds_read_b64_tr_b16 %5, %17\n\tds_read_b64_tr_b16 %6, %18\n\tds_read_b64_tr_b16 %7, %19\n\t"
                 "ds_read_b64_tr_b16 %8, %20\n\tds_read_b64_tr_b16 %9, %21\n\tds_read_b64_tr_b16 %10, %22\n\tds_read_b64_tr_b16 %11, %23\n\ts_waitcnt lgkmcnt(0)"
                 : "=&v"(r[0]), "=&v"(r[1]), "=&v"(r[2]), "=&v"(r[3]), "=&v"(r[4]), "=&v"(r[5]), "=&v"(r[6]), "=&v"(r[7]), "=&v"(r[8]), "=&v"(r[9]), "=&v"(r[10]), "=&v"(r[11])
                 : "v"(a[0]), "v"(a[0] + d), "v"(a[1]), "v"(a[1] + d), "v"(a[2]), "v"(a[2] + d), "v"(a[3]), "v"(a[3] + d), "v"(a[4]), "v"(a[4] + d), "v"(a[5]), "v"(a[5] + d) : "memory");
#pragma unroll
    for (int i = 0; i < 6; ++i) f[i] = tr_join(r[2 * i], r[2 * i + 1]);
}
constexpr int ML_CT = 0, ML_Q = 36864, ML_K = 71680, ML_V = 106496, ML_A = 135168;
__device__ __forceinline__ void mlstm_chunk_item(const Params& p, int l, int item, LAS unsigned char* lds) {
    const int tid0 = tid_fresh(), wid = __builtin_amdgcn_readfirstlane(tid0 >> 6);
    const int b = item >> 5, hd = (item >> 3) & 3, dir = (item >> 2) & 1, eg2 = item & 3;
    const bf16_t* QC = (const bf16_t*)(p.ws + WS_QC); const bf16_t* KC = (const bf16_t*)(p.ws + WS_KC);
    const bf16_t* Vg = (const bf16_t*)(p.ws + WS_V);
    const float* GAa = (const float*)(p.ws + WS_MGA); const float* GCc = (const float*)(p.ws + WS_MGC); const float* GPp = (const float*)(p.ws + WS_MGP);
    bf16_t* OUT = (bf16_t*)(p.ws + (dir ? WS_HB2 : WS_HF2));
    const int ti = wid >> 1, wh = wid & 1;
    __syncthreads();
    for (int i = tid0; i < 36864 / 4; i += NTHR) ((LAS unsigned*)(lds + ML_CT))[i] = 0u;
    if (tid0 < 128) { const int es = tid0 >> 6, r = tid0 & 63; *(LAS u32x4*)(lds + ML_V + es * 14336 + r * 112 + 64) = (u32x4){0x3F80u, 0u, 0u, 0u}; *(LAS u32x4*)(lds + ML_V + es * 14336 + r * 112 + 80) = (u32x4){0u, 0u, 0u, 0u}; }
    f32x4 Cacc[2][2][3];
#pragma unroll
    for (int es = 0; es < 2; ++es)
#pragma unroll
        for (int j = 0; j < 2; ++j)
#pragma unroll
            for (int e = 0; e < 3; ++e) Cacc[es][j][e] = (f32x4){0.f, 0.f, 0.f, 0.f};
    float m_st = 0.f;
    f32x4 ca0 = (f32x4){0.f, 0.f, 0.f, 0.f}, ca1 = ca0, cP4 = ca0, cC4 = ca0; float cPt = 0.f, cPl = 0.f, cCl = 0.f, caw = 0.f;
    const int jl = dir ? 0 : 63;
    __syncthreads();
    for (int c = -1; c < 68; ++c) {
        const int cn = c + 1;
        const int tid = tid_fresh(), lane = tid & 63, fr = lane & 15, fq = lane >> 4;
        const int vrow = tid < 384 ? tid / 6 : 63, vch = tid < 384 ? tid % 6 : 0;
        const int gs0 = 16 * (2 * wh) + 4 * fq, gt = 16 * ti + fr, gt0 = 16 * ti + 4 * fq;
        u32x4 rq[4], rk[4], rv[1];
#pragma unroll
        for (int j = 0; j < 4; ++j) { rq[j] = (u32x4){0u, 0u, 0u, 0u}; rk[j] = rq[j]; }
        rv[0] = (u32x4){0u, 0u, 0u, 0u};
        if (cn < 68) {
            const int cin = cn < 4 ? (dir ? 3 - cn : cn) : 4 + (dir ? 67 - cn : cn - 4), gc = b * 68 + cin;
            int rbase, n0, len; chunk_geom(gc, rbase, n0, len);
#pragma unroll
            for (int j = 0; j < 4; ++j) { const int q = tid + NTHR * j;
                const size_t ro = (size_t)(rbase + n0 + (q >> 5)) * 1024 + hd * 256 + (q & 31) * 8;
                rq[j] = *(const u32x4*)(QC + ro); rk[j] = *(const u32x4*)(KC + ro); }
            { const int es = tid >> 8, r = (tid & 255) >> 2, ch = tid & 3;
              rv[0] = *(const u32x4*)(Vg + (size_t)(rbase + n0 + r) * 1024 + hd * 256 + (2 * eg2 + es) * 32 + ch * 8); }
        }
        if (c >= 0) {
            const int cin = c < 4 ? (dir ? 3 - c : c) : 4 + (dir ? 67 - c : c - 4), gc = b * 68 + cin;
            int rbase, n0, len; chunk_geom(gc, rbase, n0, len);
            {
                f32x4 st[2] = {(f32x4){0.f, 0.f, 0.f, 0.f}, (f32x4){0.f, 0.f, 0.f, 0.f}};
                const LAS unsigned char* qb = lds + ML_Q + (16 * ti + fr) * 544 + fq * 16;
                const LAS unsigned char* kb0 = lds + ML_K + (16 * (2 * wh) + fr) * 544 + fq * 16;
                bf16x8 qfa[4], k0f[4], k1f[4];
#pragma unroll
                for (int hb = 0; hb < 2; ++hb) {
#pragma unroll
                    for (int kd = 0; kd < 4; ++kd) { qfa[kd] = *(const LAS bf16x8*)(qb + (4 * (1 - hb) + kd) * 64); k0f[kd] = *(const LAS bf16x8*)(kb0 + (4 * (1 - hb) + kd) * 64); k1f[kd] = *(const LAS bf16x8*)(kb0 + 16 * 544 + (4 * (1 - hb) + kd) * 64); }
                    __builtin_amdgcn_sched_barrier(0);
#pragma unroll
                    for (int kd = 0; kd < 4; ++kd) {
                        st[0] = __builtin_amdgcn_mfma_f32_16x16x32_bf16(k0f[kd], qfa[kd], st[0], 0, 0, 0);
                        st[1] = __builtin_amdgcn_mfma_f32_16x16x32_bf16(k1f[kd], qfa[kd], st[1], 0, 0, 0);
                    }
                    __builtin_amdgcn_sched_barrier(0);
                }
                const int t = 16 * ti + fr; const float Mt = fmaxf(m_st, cPt), M63 = fmaxf(m_st, cPl);
#pragma unroll
                for (int j = 0; j < 2; ++j) { const int s0 = 16 * (2 * wh + j) + 4 * fq; const f32x4 av = j ? ca1 : ca0;
                    f32x4 o;
#pragma unroll
                    for (int r = 0; r < 4; ++r) { const bool keep = dir ? (s0 + r >= t) : (s0 + r <= t); o[r] = keep ? st[j][r] * __expf(av[r] - Mt) : 0.f; }
                    *(LAS u32x2*)(lds + ML_A + t * 160 + s0 * 2) = pack4(o); }
                if (tid < 384) { const float w = __expf(caw - M63);
#pragma unroll
                    for (int es = 0; es < 2; ++es) { float f[8]; unpack8(*(const LAS u32x4*)(lds + ML_V + es * 14336 + vrow * 112 + vch * 16), f);
                        f32x4 o0, o1;
#pragma unroll
                        for (int i = 0; i < 4; ++i) { o0[i] = f[i] * w; o1[i] = f[4 + i] * w; }
                        *(LAS u32x4*)(lds + ML_V + es * 14336 + 7168 + vrow * 112 + vch * 16) = pack8(o0, o1); } }
            }
            __syncthreads();
            {
                const LAS unsigned char* ab = lds + ML_A + (16 * ti + fr) * 160 + fq * 16;
                const LAS unsigned char* qb = lds + ML_Q + (16 * ti + fr) * 544 + fq * 16;
                bf16x8 af[2], k0f[2], k1f[2], qf[8];
#pragma unroll
                for (int ks = 0; ks < 2; ++ks) af[ks] = *(const LAS bf16x8*)(ab + ks * 64);
#pragma unroll
                for (int kd = 0; kd < 8; ++kd) qf[kd] = *(const LAS bf16x8*)(qb + kd * 64);
                { const unsigned kb_ = (unsigned)(size_t)(lds + ML_K) + (unsigned)((8 * fq + (fr >> 2)) * 544 + (fr & 3) * 8 + wid * 64);
                  const unsigned ka[4] = {kb_, kb_ + 32, kb_ + 32 * 544, kb_ + 32 * 544 + 32}; bf16x8 kf[4]; tr_frag4(ka, 4 * 544, kf);
                  k0f[0] = kf[0]; k1f[0] = kf[1]; k0f[1] = kf[2]; k1f[1] = kf[3]; }
                const int t0 = 16 * ti + 4 * fq;
                f32x4 sgv, emv;
#pragma unroll
                for (int r = 0; r < 4; ++r) { const float Mr = fmaxf(m_st, cP4[r]); sgv[r] = __expf(m_st - Mr); emv[r] = __expf(-(cC4[r] + Mr)); }
                const float decay = __expf(m_st - fmaxf(m_st, cPl));
                const bool wr_out = !(l == 1 && cin < 4);
#pragma unroll
                for (int es = 0; es < 2; ++es) {
                    f32x4 n1o = (f32x4){0.f, 0.f, 0.f, 0.f}, n1a = n1o, n2o = n1o, n2a = n1o;
                    const LAS unsigned char* co = lds + ML_CT + es * 18432 + (16 * wh + fr) * 544 + fq * 16;
                    const LAS unsigned char* ca = lds + ML_CT + es * 18432 + (32 + fr) * 544 + fq * 16;
                    const unsigned vtr = (unsigned)(size_t)(lds + ML_V + es * 14336) + (unsigned)((8 * fq + (fr >> 2)) * 112 + (fr & 3) * 8);
                    { bf16x8 vof[2], vaf[2];
                      { const unsigned va_[4] = {vtr + wh * 32, vtr + 64, vtr + 3584 + wh * 32, vtr + 3584 + 64}; bf16x8 vf[4]; tr_frag4(va_, 448, vf); vof[0] = vf[0]; vaf[0] = vf[1]; vof[1] = vf[2]; vaf[1] = vf[3]; }
                      __builtin_amdgcn_sched_barrier(0);
#pragma unroll
                      for (int ks = 0; ks < 2; ++ks) {
                          n1o = __builtin_amdgcn_mfma_f32_16x16x32_bf16(af[ks], vof[ks], n1o, 0, 0, 0);
                          n1a = __builtin_amdgcn_mfma_f32_16x16x32_bf16(af[ks], vaf[ks], n1a, 0, 0, 0); }
                      __builtin_amdgcn_sched_barrier(0); }
#pragma unroll
                    for (int kb = 0; kb < 2; ++kb) {
                        bf16x8 cof[4], caf[4];
#pragma unroll
                        for (int kd = 0; kd < 4; ++kd) { cof[kd] = *(const LAS bf16x8*)(co + (4 * kb + kd) * 64); caf[kd] = *(const LAS bf16x8*)(ca + (4 * kb + kd) * 64); }
                        __builtin_amdgcn_sched_barrier(0);
#pragma unroll
                        for (int kd = 0; kd < 4; ++kd) {
                            n2o = __builtin_amdgcn_mfma_f32_16x16x32_bf16(qf[4 * kb + kd], cof[kd], n2o, 0, 0, 0);
                            n2a = __builtin_amdgcn_mfma_f32_16x16x32_bf16(qf[4 * kb + kd], caf[kd], n2a, 0, 0, 0); }
                        __builtin_amdgcn_sched_barrier(0);
                    }
#pragma unroll
                    for (int r = 0; r < 4; ++r) {
                        const float den = __shfl(n1a[r] + sgv[r] * n2a[r], lane & 48);
                        const float hv = (n1o[r] + sgv[r] * n2o[r]) * __builtin_amdgcn_rcpf(fmaxf(fabsf(den), emv[r]));
                        if (wr_out) OUT[(size_t)(rbase + n0 + t0 + r) * 1024 + hd * 256 + (2 * eg2 + es) * 32 + 16 * wh + fr] = (bf16_t)f2bf(hv);
                    }
#pragma unroll
                    for (int j = 0; j < 2; ++j)
#pragma unroll
                        for (int e = 0; e < 3; ++e) Cacc[es][j][e] = Cacc[es][j][e] * decay;
                    const unsigned vwr = vtr + 7168;
                    bf16x8 v0f[2], v1f[2], v2f[2];
                    { const unsigned wa_[6] = {vwr, vwr + 32, vwr + 64, vwr + 3584, vwr + 3584 + 32, vwr + 3584 + 64}; bf16x8 wf[6]; tr_frag6(wa_, 448, wf);
                      v0f[0] = wf[0]; v1f[0] = wf[1]; v2f[0] = wf[2]; v0f[1] = wf[3]; v1f[1] = wf[4]; v2f[1] = wf[5]; }
                    __builtin_amdgcn_sched_barrier(0);
#pragma unroll
                    for (int ks = 0; ks < 2; ++ks) {
                        Cacc[es][0][0] = __builtin_amdgcn_mfma_f32_16x16x32_bf16(k0f[ks], v0f[ks], Cacc[es][0][0], 0, 0, 0);
                        Cacc[es][0][1] = __builtin_amdgcn_mfma_f32_16x16x32_bf16(k0f[ks], v1f[ks], Cacc[es][0][1], 0, 0, 0);
                        Cacc[es][0][2] = __builtin_amdgcn_mfma_f32_16x16x32_bf16(k0f[ks], v2f[ks], Cacc[es][0][2], 0, 0, 0);
                        Cacc[es][1][0] = __builtin_amdgcn_mfma_f32_16x16x32_bf16(k1f[ks], v0f[ks], Cacc[es][1][0], 0, 0, 0);
                        Cacc[es][1][1] = __builtin_amdgcn_mfma_f32_16x16x32_bf16(k1f[ks], v1f[ks], Cacc[es][1][1], 0, 0, 0);
                        Cacc[es][1][2] = __builtin_amdgcn_mfma_f32_16x16x32_bf16(k1f[ks], v2f[ks], Cacc[es][1][2], 0, 0, 0);
                    }
                    __builtin_amdgcn_sched_barrier(0);
                }
            }
            __syncthreads();
#pragma unroll
            for (int es = 0; es < 2; ++es)
#pragma unroll
                for (int j = 0; j < 2; ++j) { const int dcol = (16 * (2 * wid + j) + 4 * fq) * 2;
                    *(LAS u32x2*)(lds + ML_CT + es * 18432 + fr * 544 + dcol) = pack4(Cacc[es][j][0]);
                    *(LAS u32x2*)(lds + ML_CT + es * 18432 + (16 + fr) * 544 + dcol) = pack4(Cacc[es][j][1]);
                    if (fr == 0) *(LAS u32x2*)(lds + ML_CT + es * 18432 + 32 * 544 + dcol) = pack4(Cacc[es][j][2]); }
        }
        if (c >= 0) m_st = cCl + fmaxf(m_st, cPl);
        if (cn < 68) {
            const int cin = cn < 4 ? (dir ? 3 - cn : cn) : 4 + (dir ? 67 - cn : cn - 4); const size_t gb = (size_t)((b * 68 + cin) * 8 + dir * 4 + hd) * 64;
            ca0 = *(const f32x4*)(GAa + gb + gs0); ca1 = *(const f32x4*)(GAa + gb + gs0 + 16); caw = GAa[gb + vrow];
            cP4 = *(const f32x4*)(GPp + gb + gt0); cC4 = *(const f32x4*)(GCc + gb + gt0); cPt = GPp[gb + gt]; cPl = GPp[gb + jl]; cCl = GCc[gb + jl]; }
        if (cn < 68) {
#pragma unroll
            for (int j = 0; j < 4; ++j) { const int q = tid + NTHR * j;
                *(LAS u32x4*)(lds + ML_Q + (q >> 5) * 544 + (q & 31) * 16) = rq[j];
                *(LAS u32x4*)(lds + ML_K + (q >> 5) * 544 + (q & 31) * 16) = rk[j]; }
            *(LAS u32x4*)(lds + ML_V + (tid >> 8) * 14336 + ((tid & 255) >> 2) * 112 + (tid & 3) * 16) = rv[0];
        }
        __syncthreads();
    }
}

constexpr int SS_C = 0, SS_B = 18432, SS_X = 36864, SS_G = 67584, SS_S = 77824;
__device__ __forceinline__ void ssd_chunk_item(const Params& p, int l, int item, LAS unsigned char* lds) {
    const int tid0 = tid_fresh(), wid = __builtin_amdgcn_readfirstlane(tid0 >> 6);
    const int b = item >> 5, hd = (item >> 1) & 15, dir = item & 1, grp = hd >> 2;
    const bf16_t* BC = (const bf16_t*)(p.ws + WS_BC); const bf16_t* CC = (const bf16_t*)(p.ws + WS_CC); const bf16_t* XC = (const bf16_t*)(p.ws + WS_XCT);
    const float* ACS = (const float*)(p.ws + WS_SACS); const float* SDT = (const float*)(p.ws + WS_SDT);
    bf16_t* OUT = (bf16_t*)(p.ws + (dir ? WS_YB : WS_YF));
    const float dskip = p.sd[l * 16 + hd];
    const int ti = wid >> 1, wh = wid & 1, jl = dir ? 0 : 63;
    __syncthreads();
    for (int i = tid0; i < 18432 / 4; i += NTHR) ((LAS unsigned*)(lds + SS_S))[i] = 0u;
    f32x4 Sacc[2][2];
#pragma unroll
    for (int ph = 0; ph < 2; ++ph) { Sacc[ph][0] = (f32x4){0.f, 0.f, 0.f, 0.f}; Sacc[ph][1] = Sacc[ph][0]; }
    f32x4 cs0 = (f32x4){0.f, 0.f, 0.f, 0.f}, cs1 = cs0, ct4 = cs0; float cat = 0.f, cal = 0.f, csw = 0.f, cdw = 0.f;
    __syncthreads();
    for (int c = -1; c < 68; ++c) {
        const int cn = c + 1;
        const int tid = tid_fresh(), lane = tid & 63, fr = lane & 15, fq = lane >> 4;
        const int xph = tid >> 8, xrow = (tid & 255) >> 2, xch = tid & 3;
        const int gs0 = 16 * (2 * wh) + 4 * fq, gt = 16 * ti + fr, gt0 = 16 * ti + 4 * fq;
        u32x4 rc[2], rb[2], rx = (u32x4){0u, 0u, 0u, 0u};
#pragma unroll
        for (int j = 0; j < 2; ++j) { rc[j] = (u32x4){0u, 0u, 0u, 0u}; rb[j] = rc[j]; }
        if (cn < 68) {
            const int cin = cn < 4 ? (dir ? 3 - cn : cn) : 4 + (dir ? 67 - cn : cn - 4), gc = b * 68 + cin;
            int rbase, n0, len; chunk_geom(gc, rbase, n0, len);
#pragma unroll
            for (int j = 0; j < 2; ++j) { const int q = tid + NTHR * j;
                const size_t ro = (size_t)(rbase + n0 + (q >> 4)) * 512 + grp * 128 + (q & 15) * 8;
                rc[j] = *(const u32x4*)(CC + ro); rb[j] = *(const u32x4*)(BC + ro); }
            rx = *(const u32x4*)(XC + (size_t)(rbase + n0 + xrow) * 1024 + hd * 64 + xph * 32 + xch * 8);
        }
        if (c >= 0) {
            const int cin = c < 4 ? (dir ? 3 - c : c) : 4 + (dir ? 67 - c : c - 4), gc = b * 68 + cin;
            int rbase, n0, len; chunk_geom(gc, rbase, n0, len);
            {
                f32x4 st[2] = {(f32x4){0.f, 0.f, 0.f, 0.f}, (f32x4){0.f, 0.f, 0.f, 0.f}};
                const LAS unsigned char* cbp = lds + SS_C + (16 * ti + fr) * 288 + fq * 16;
                const LAS unsigned char* bb0 = lds + SS_B + (16 * (2 * wh) + fr) * 288 + fq * 16;
                bf16x8 cf[4], b0f[4], b1f[4];
#pragma unroll
                for (int kn = 0; kn < 4; ++kn) { cf[kn] = *(const LAS bf16x8*)(cbp + kn * 64); b0f[kn] = *(const LAS bf16x8*)(bb0 + kn * 64); b1f[kn] = *(const LAS bf16x8*)(bb0 + 16 * 288 + kn * 64); }
                __builtin_amdgcn_sched_barrier(0);
#pragma unroll
                for (int kn = 0; kn < 4; ++kn) {
                    st[0] = __builtin_amdgcn_mfma_f32_16x16x32_bf16(b0f[kn], cf[kn], st[0], 0, 0, 0);
                    st[1] = __builtin_amdgcn_mfma_f32_16x16x32_bf16(b1f[kn], cf[kn], st[1], 0, 0, 0);
                }
                __builtin_amdgcn_sched_barrier(0);
                const int t = 16 * ti + fr; const float at = cat;
#pragma unroll
                for (int j = 0; j < 2; ++j) { const int s0 = 16 * (2 * wh + j) + 4 * fq; const f32x4 av = j ? cs1 : cs0;
                    f32x4 o;
#pragma unroll
                    for (int r = 0; r < 4; ++r) { const bool keep = dir ? (s0 + r >= t) : (s0 + r <= t); o[r] = keep ? st[j][r] * __expf(at - av[r]) : 0.f; }
                    *(LAS u32x2*)(lds + SS_G + t * 160 + s0 * 2) = pack4(o); }
                { float f[8]; unpack8(*(const LAS u32x4*)(lds + SS_X + xph * 15360 + xrow * 80 + xch * 16), f);
                  const float w = __expf(cal - csw); f32x4 o0, o1, w0, w1;
#pragma unroll
                  for (int i = 0; i < 4; ++i) { o0[i] = f[i] * cdw; o1[i] = f[4 + i] * cdw; w0[i] = o0[i] * w; w1[i] = o1[i] * w; }
                  *(LAS u32x4*)(lds + SS_X + xph * 15360 + 5120 + xrow * 80 + xch * 16) = pack8(o0, o1);
                  *(LAS u32x4*)(lds + SS_X + xph * 15360 + 10240 + xrow * 80 + xch * 16) = pack8(w0, w1); }
            }
            __syncthreads();
            {
                const LAS unsigned char* gb = lds + SS_G + (16 * ti + fr) * 160 + fq * 16;
                const LAS unsigned char* cbp = lds + SS_C + (16 * ti + fr) * 288 + fq * 16;
                const unsigned btr = (unsigned)(size_t)(lds + SS_B) + (unsigned)((8 * fq + (fr >> 2)) * 288 + (fr & 3) * 8 + wid * 32);
                bf16x8 gf[2], cf[4], btf[2];
#pragma unroll
                for (int ks = 0; ks < 2; ++ks) gf[ks] = *(const LAS bf16x8*)(gb + ks * 64);
#pragma unroll
                for (int kn = 0; kn < 4; ++kn) cf[kn] = *(const LAS bf16x8*)(cbp + kn * 64);
#pragma unroll
                for (int ks = 0; ks < 2; ++ks) btf[ks] = tr_frag(btr + ks * 9216, btr + ks * 9216 + 1152);
                const int t0 = 16 * ti + 4 * fq;
                f32x4 eav; eav[0] = __expf(ct4[0]); eav[1] = __expf(ct4[1]); eav[2] = __expf(ct4[2]); eav[3] = __expf(ct4[3]);
                const float dec = __expf(cal);
                const bool wr_out = !(l == 1 && cin < 4);
#pragma unroll
                for (int ph = 0; ph < 2; ++ph) {
                    f32x4 y1 = (f32x4){0.f, 0.f, 0.f, 0.f}, y2 = y1;
                    const LAS unsigned char* sb = lds + SS_S + ph * 9216 + (16 * wh + fr) * 288 + fq * 16;
                    const unsigned xtr = (unsigned)(size_t)(lds + SS_X + ph * 15360 + 5120) + (unsigned)((8 * fq + (fr >> 2)) * 80 + (fr & 3) * 8);
                    bf16x8 xf[2], sf[4], xw0f[2], xw1f[2];
#pragma unroll
                    for (int kn = 0; kn < 4; ++kn) sf[kn] = *(const LAS bf16x8*)(sb + kn * 64);
                    { const unsigned xa_[6] = {xtr + wh * 32, xtr + 2560 + wh * 32, xtr + 5120, xtr + 5120 + 32, xtr + 5120 + 2560, xtr + 5120 + 2560 + 32}; bf16x8 xq[6]; tr_frag6(xa_, 320, xq);
                      xf[0] = xq[0]; xf[1] = xq[1]; xw0f[0] = xq[2]; xw1f[0] = xq[3]; xw0f[1] = xq[4]; xw1f[1] = xq[5]; }
                    __builtin_amdgcn_sched_barrier(0);
#pragma unroll
                    for (int ks = 0; ks < 2; ++ks) y1 = __builtin_amdgcn_mfma_f32_16x16x32_bf16(gf[ks], xf[ks], y1, 0, 0, 0);
#pragma unroll
                    for (int kn = 0; kn < 4; ++kn) y2 = __builtin_amdgcn_mfma_f32_16x16x32_bf16(cf[kn], sf[kn], y2, 0, 0, 0);
#pragma unroll
                    for (int r = 0; r < 4; ++r) {
                        float yv = y1[r] + eav[r] * y2[r];
                        if (dir == 0) yv += dskip * bf2f(*(const LAS bf16_t*)(lds + SS_X + ph * 15360 + (t0 + r) * 80 + (16 * wh + fr) * 2));
                        if (wr_out) OUT[(size_t)(rbase + n0 + t0 + r) * 1024 + hd * 64 + ph * 32 + 16 * wh + fr] = (bf16_t)f2bf(yv);
                    }
                    Sacc[ph][0] = Sacc[ph][0] * dec; Sacc[ph][1] = Sacc[ph][1] * dec;
#pragma unroll
                    for (int ks = 0; ks < 2; ++ks) {
                        Sacc[ph][0] = __builtin_amdgcn_mfma_f32_16x16x32_bf16(btf[ks], xw0f[ks], Sacc[ph][0], 0, 0, 0);
                        Sacc[ph][1] = __builtin_amdgcn_mfma_f32_16x16x32_bf16(btf[ks], xw1f[ks], Sacc[ph][1], 0, 0, 0); }
                    __builtin_amdgcn_sched_barrier(0);
                }
            }
            __syncthreads();
#pragma unroll
            for (int ph = 0; ph < 2; ++ph) { const int ncol = (16 * wid + 4 * fq) * 2;
              *(LAS u32x2*)(lds + SS_S + ph * 9216 + fr * 288 + ncol) = pack4(Sacc[ph][0]);
              *(LAS u32x2*)(lds + SS_S + ph * 9216 + (16 + fr) * 288 + ncol) = pack4(Sacc[ph][1]); }
        }
        if (cn < 68) {
            const int cin = cn < 4 ? (dir ? 3 - cn : cn) : 4 + (dir ? 67 - cn : cn - 4); const size_t gb = (size_t)((b * 68 + cin) * 32 + dir * 16 + hd) * 64;
            cs0 = *(const f32x4*)(ACS + gb + gs0); cs1 = *(const f32x4*)(ACS + gb + gs0 + 16); csw = ACS[gb + xrow]; cdw = SDT[gb + xrow];
            ct4 = *(const f32x4*)(ACS + gb + gt0); cat = ACS[gb + gt]; cal = ACS[gb + jl];
#pragma unroll
            for (int j = 0; j < 2; ++j) { const int q = tid + NTHR * j;
                *(LAS u32x4*)(lds + SS_C + (q >> 4) * 288 + (q & 15) * 16) = rc[j];
                *(LAS u32x4*)(lds + SS_B + (q >> 4) * 288 + (q & 15) * 16) = rb[j]; }
            *(LAS u32x4*)(lds + SS_X + xph * 15360 + xrow * 80 + xch * 16) = rx;
        }
        __syncthreads();
    }
}

__device__ __forceinline__ void mlstm_finish_rows(const Params& p, int l, int row_lo, int gw, int ngw) {
    if (p.dup) return;
    const int lane = tid_fresh() & 63;
    const bf16_t* HF = (const bf16_t*)(p.ws + WS_HF2); const bf16_t* HB = (const bf16_t*)(p.ws + WS_HB2);
    bf16_t* BR = (bf16_t*)(p.ws + WS_BR);
    const float* ng = p.mnorm_g + l * 1024;
    int row = row_lo + gw;
    u32x2 ca[4], cb[4], co[4], na[4], nbv[4], no[4];
    if (row < MT) { const size_t so = (size_t)scanrow(row) * 1024;
#pragma unroll
        for (int hd = 0; hd < 4; ++hd) { const int c = hd * 256 + 4 * lane; ca[hd] = *(const u32x2*)(HF + so + c); cb[hd] = *(const u32x2*)(HB + so + c); co[hd] = *(const u32x2*)(BR + (size_t)row * 3072 + 1024 + c); } }
    for (; row < MT; row += ngw) {
        const int rn = row + ngw;
        if (rn < MT) { const size_t so = (size_t)scanrow(rn) * 1024;
#pragma unroll
            for (int hd = 0; hd < 4; ++hd) { const int c = hd * 256 + 4 * lane; na[hd] = *(const u32x2*)(HF + so + c); nbv[hd] = *(const u32x2*)(HB + so + c); no[hd] = *(const u32x2*)(BR + (size_t)rn * 3072 + 1024 + c); } }
#pragma unroll
        for (int hd = 0; hd < 4; ++hd) { const int c = hd * 256 + 4 * lane;
            const u32x2 a = ca[hd], b2 = cb[hd], o = co[hd];
            f32x4 h; h[0] = lo16(a.x) + lo16(b2.x); h[1] = hi16(a.x) + hi16(b2.x); h[2] = lo16(a.y) + lo16(b2.y); h[3] = hi16(a.y) + hi16(b2.y);
            const float ss = wave_sum((h[0] * h[0] + h[1] * h[1]) + (h[2] * h[2] + h[3] * h[3]));
            const float rs = __builtin_amdgcn_rsqf(ss * (1.f / 256.f) + EPS);
            const f32x4 g = *(const f32x4*)(ng + c);
            f32x4 r; r[0] = sigmoid_f(lo16(o.x)) * (h[0] * rs * g[0]); r[1] = sigmoid_f(hi16(o.x)) * (h[1] * rs * g[1]);
            r[2] = sigmoid_f(lo16(o.y)) * (h[2] * rs * g[2]); r[3] = sigmoid_f(hi16(o.y)) * (h[3] * rs * g[3]);
            u32x2 w; w.x = pk2(r[0], r[1]); w.y = pk2(r[2], r[3]);
            *(u32x2*)(BR + (size_t)row * 3072 + 1024 + c) = w; }
#pragma unroll
        for (int hd = 0; hd < 4; ++hd) { ca[hd] = na[hd]; cb[hd] = nbv[hd]; co[hd] = no[hd]; }
    }
}
__device__ __forceinline__ void ssd_finish_rows(const Params& p, int l, int row_lo, int gw, int ngw) {
    if (p.dup) return;
    const int lane = tid_fresh() & 63;
    const bf16_t* YF = (const bf16_t*)(p.ws + WS_YF); const bf16_t* YB = (const bf16_t*)(p.ws + WS_YB);
    bf16_t* BR = (bf16_t*)(p.ws + WS_BR);
    const float* ng = p.snorm_g + l * 1024;
    int row = row_lo + gw;
    u32x2 ca[4], cb[4], cz[4], na[4], nbv[4], nz[4];
    if (row < MT) {
#pragma unroll
        for (int j = 0; j < 4; ++j) { const int c = 4 * lane + 256 * j; ca[j] = *(const u32x2*)(YF + (size_t)row * 1024 + c); cb[j] = *(const u32x2*)(YB + (size_t)row * 1024 + c); cz[j] = *(const u32x2*)(BR + (size_t)row * 3072 + 2048 + c); } }
    for (; row < MT; row += ngw) {
        const int rn = row + ngw;
        if (rn < MT) {
#pragma unroll
            for (int j = 0; j < 4; ++j) { const int c = 4 * lane + 256 * j; na[j] = *(const u32x2*)(YF + (size_t)rn * 1024 + c); nbv[j] = *(const u32x2*)(YB + (size_t)rn * 1024 + c); nz[j] = *(const u32x2*)(BR + (size_t)rn * 3072 + 2048 + c); } }
        f32x4 v[4]; float ss = 0.f;
#pragma unroll
        for (int j = 0; j < 4; ++j) { const u32x2 a = ca[j], b2 = cb[j], z = cz[j];
            v[j][0] = (lo16(a.x) + lo16(b2.x)) * silu_f(lo16(z.x)); v[j][1] = (hi16(a.x) + hi16(b2.x)) * silu_f(hi16(z.x));
            v[j][2] = (lo16(a.y) + lo16(b2.y)) * silu_f(lo16(z.y)); v[j][3] = (hi16(a.y) + hi16(b2.y)) * silu_f(hi16(z.y));
            ss += (v[j][0] * v[j][0] + v[j][1] * v[j][1]) + (v[j][2] * v[j][2] + v[j][3] * v[j][3]); }
        const float rs = __builtin_amdgcn_rsqf(wave_sum(ss) * (1.f / 1024.f) + EPS);
#pragma unroll
        for (int j = 0; j < 4; ++j) { const int c = 4 * lane + 256 * j; const f32x4 g = *(const f32x4*)(ng + c);
            u32x2 w; w.x = pk2(v[j][0] * rs * g[0], v[j][1] * rs * g[1]); w.y = pk2(v[j][2] * rs * g[2], v[j][3] * rs * g[3]);
            *(u32x2*)(BR + (size_t)row * 3072 + 2048 + c) = w; }
#pragma unroll
        for (int j = 0; j < 4; ++j) { ca[j] = na[j]; cb[j] = nbv[j]; cz[j] = nz[j]; }
    }
}

__device__ __forceinline__ void phase_route(const Params& p, int l, unsigned char* ldsb, int bid, int nb) {
    float* lds = reinterpret_cast<float*>(ldsb);
    float* Wt = lds;
    int* hist = reinterpret_cast<int*>(lds + 36 * 1024);
    const int tid = tid_fresh(), lane = tid & 63, wave = tid >> 6;
    const int row_lo = l == 0 ? 0 : MC, rpb = l == 0 ? 68 : 64;
    const float* wrg = p.w_rg + (size_t)l * 1024 * 4; const float* wre = p.w_re + (size_t)l * 1024 * 32;
    for (int i = tid; i < 1024 * 4; i += NTHR) { const int k = i >> 2, g = i & 3; Wt[g * 1024 + (k ^ ((g & 7) << 2))] = wrg[i]; }
    for (int i = tid; i < 1024 * 32; i += NTHR) { const int k = i >> 5, e = i & 31; Wt[(4 + e) * 1024 + (k ^ (((4 + e) & 7) << 2))] = wre[i]; }
    const float* mod = (const float*)(p.ws + WS_MOD) + l * 5 * 6144;
    const float* XL = (const float*)(p.ws + WS_XL);
    int* EID = (int*)(p.ws + WS_EID); float* EWT = (float*)(p.ws + WS_EWT);
    for (int vb = bid; vb < 256; vb += nb) {
        if (tid < 32) hist[tid] = 0;
        __syncthreads();
        for (int rr = wave; rr < rpb; rr += 8) {
            const int row = row_lo + vb * rpb + rr;
            f32x4 v[4];
            const float* mr = mod + modrow(row) * 6144;
            {
              const float* res = l == 0 ? (row < MC ? p.ctx + (size_t)row * 1024 : p.x + (size_t)(row - MC) * 1024) : XL + (size_t)row * 1024;
              if (p.dup) res = XL + (size_t)row * 1024;
              u32x2 o2[4];
#pragma unroll
              for (int j = 0; j < 4; ++j) { v[j] = *(const f32x4*)(res + 4 * lane + 256 * j); o2[j] = *(const u32x2*)((const bf16_t*)(p.ws + WS_OL) + (size_t)row * 1024 + 4 * lane + 256 * j); }
              if (!p.dup) {
#pragma unroll
                  for (int j = 0; j < 4; ++j) { const f32x4 g2 = *(const f32x4*)(mr + 2 * 1024 + 4 * lane + 256 * j);
                      v[j][0] += g2[0] * lo16(o2[j].x); v[j][1] += g2[1] * hi16(o2[j].x); v[j][2] += g2[2] * lo16(o2[j].y); v[j][3] += g2[3] * hi16(o2[j].y);
                      *(f32x4*)((float*)(p.ws + WS_XL) + (size_t)row * 1024 + 4 * lane + 256 * j) = v[j]; } } }
            norm_mod_row(v, p.g_ffn + l * 1024, mr + 3 * 1024, mr + 4 * 1024, lane);
            store_row_bf16((bf16_t*)(p.ws + WS_H) + (size_t)row * 1024, v, lane);
            float lg[36];
#pragma unroll
            for (int e = 0; e < 36; ++e) { float s = 0.f;
#pragma unroll
                for (int j = 0; j < 4; ++j) { const f32x4 w = *(const f32x4*)(Wt + e * 1024 + ((4 * lane + 256 * j) ^ ((e & 7) << 2))); s += (v[j][0] * w[0] + v[j][1] * w[1]) + (v[j][2] * w[2] + v[j][3] * w[3]); }
                lg[e] = wave_sum(s); }
            float gl[4]; int gi = 0; float gmax;
#pragma unroll
            for (int g = 0; g < 4; ++g) gl[g] = lg[g] + p.b_rg[l * 4 + g];
            gmax = gl[0];
#pragma unroll
            for (int g = 1; g < 4; ++g) if (gl[g] > gmax) { gmax = gl[g]; gi = g; }
            float den = 0.f;
#pragma unroll
            for (int g = 0; g < 4; ++g) den += __expf(gl[g] - gmax);
            const float pg = 1.f / den;
            float v1 = -3.0e38f, v2 = -3.0e38f; int i1 = 0, i2 = 0;
#pragma unroll
            for (int g = 0; g < 4; ++g) if (g == gi) {
#pragma unroll
                for (int j = 0; j < 8; ++j) { const float x = lg[4 + g * 8 + j] + p.b_re[l * 32 + g * 8 + j];
                    if (x > v1) { v2 = v1; i2 = i1; v1 = x; i1 = j; } else if (x > v2) { v2 = x; i2 = j; } } }
            const float e2 = __expf(v2 - v1), w1 = pg / (1.f + e2), w2 = pg * e2 / (1.f + e2);
            if (lane == 0) { EID[row * 2] = gi * 8 + i1; EID[row * 2 + 1] = gi * 8 + i2; EWT[row * 2] = w1; EWT[row * 2 + 1] = w2;
                atomicAdd(&hist[gi * 8 + i1], 1); atomicAdd(&hist[gi * 8 + i2], 1); }
        }
        __syncthreads();
        if (tid < 32) ((int*)(p.ws + WS_HIST))[vb * 32 + tid] = hist[tid];
        __syncthreads();
    }
    __syncthreads();
    float* scr = lds + wave * (64 * 65);
    convert_run(p, (CV_IN_SCAN && nb == 256) ? -1 : l, l + 1 < 2 ? l + 1 : -1, bid * 8 + wave, nb * 8, scr, lane);
}

__device__ __forceinline__ void phase_scatter(const Params& p, int l, unsigned char* ldsb, int bid, int nb) {
    int* li = reinterpret_cast<int*>(ldsb);
    int* tot = li; int* pre = li + 32; int* pst = li + 64; int* ea = li + 128; int* pos = li + 384;
    const int tid = tid_fresh(), lane = tid & 63, wave = tid >> 6;
    const int row_lo = l == 0 ? 0 : MC, rpb = l == 0 ? 68 : 64;
    const int* HIST = (const int*)(p.ws + WS_HIST); const int* EID = (const int*)(p.ws + WS_EID);
    int* SLOT = (int*)(p.ws + WS_SLOT);
    for (int vb = bid; vb < 256; vb += nb) {
        __syncthreads();
        { const int e = tid & 31, jg = tid >> 5; int hv[16];
#pragma unroll
          for (int i = 0; i < 16; ++i) hv[i] = HIST[(jg * 16 + i) * 32 + e];
          int t = 0, pr = 0;
#pragma unroll
          for (int i = 0; i < 16; ++i) { t += hv[i]; pr += (jg * 16 + i < vb) ? hv[i] : 0; }
          li[512 + jg * 32 + e] = t; li[1024 + jg * 32 + e] = pr; }
        __syncthreads();
        if (tid < 32) { int t = 0, pr = 0;
#pragma unroll
            for (int g = 0; g < 16; ++g) { t += li[512 + g * 32 + tid]; pr += li[1024 + g * 32 + tid]; }
            tot[tid] = t; pre[tid] = pr; }
        __syncthreads();
        if (tid == 0) { int s = 0; for (int e = 0; e < 32; ++e) { pst[e] = s; s += ((tot[e] + 255) >> 8) << 8; }
            if (vb == 0) { int* BE = (int*)(p.ws + WS_BLKEXP); int nblk = 0;
                for (int e = 0; e < 32; ++e) { const int nbk = (tot[e] + 255) >> 8; for (int j = 0; j < nbk; ++j) BE[nblk++] = e; }
                BE[200] = nblk; } }
        if (tid < rpb * 2) ea[tid] = EID[(row_lo + vb * rpb) * 2 + tid];
        __syncthreads();
        if (tid < rpb * 2) { const int e = ea[tid]; int rk = 0; for (int j = 0; j < tid; ++j) rk += (ea[j] == e) ? 1 : 0;
            const int ps = pst[e] + pre[e] + rk; SLOT[(row_lo + vb * rpb) * 2 + tid] = ps; ((int*)(p.ws + WS_TOK))[ps] = row_lo + vb * rpb + (tid >> 1); }
        if (vb == 0 && tid < 32) { int* TOK = (int*)(p.ws + WS_TOK); const int e0 = pst[tid] + tot[tid], e1 = pst[tid] + (((tot[tid] + 255) >> 8) << 8);
            for (int q = e0; q < e1; ++q) TOK[q] = row_lo; }
    }
    __syncthreads();
}

__device__ __forceinline__ void phase_combine(const Params& p, int l, int bid, int nb) {
    if (p.dup && l == 0) return;
    const int lane = tid_fresh() & 63, wave = tid_fresh() >> 6;
    const float* mod = (const float*)(p.ws + WS_MOD);
    const int* SLOT = (const int*)(p.ws + WS_SLOT); const float* EWT = (const float*)(p.ws + WS_EWT);
    const bf16_t* Y = (const bf16_t*)(p.ws + WS_Y);
    float* XL = (float*)(p.ws + WS_XL);
    const int row_lo = l == 0 ? 0 : MC, stride = nb * 8;
    for (int rowA = row_lo + bid * 8 + wave; rowA < MT; rowA += 2 * stride) {
        const int rowB = rowA + stride; const bool hasB = rowB < MT; const int rb = hasB ? rowB : rowA;
        const int sA0 = SLOT[rowA * 2], sA1 = SLOT[rowA * 2 + 1], sB0 = SLOT[rb * 2], sB1 = SLOT[rb * 2 + 1];
        const float wA0 = EWT[rowA * 2], wA1 = EWT[rowA * 2 + 1], wB0 = EWT[rb * 2], wB1 = EWT[rb * 2 + 1];
        u32x2 yA0[4], yA1[4], yB0[4], yB1[4]; f32x4 xA[4], xB[4];
#pragma unroll
        for (int j = 0; j < 4; ++j) { const int c = 4 * lane + 256 * j;
            yA0[j] = *(const u32x2*)(Y + (size_t)sA0 * 1024 + c); yA1[j] = *(const u32x2*)(Y + (size_t)sA1 * 1024 + c); xA[j] = *(const f32x4*)(XL + (size_t)rowA * 1024 + c);
            yB0[j] = *(const u32x2*)(Y + (size_t)sB0 * 1024 + c); yB1[j] = *(const u32x2*)(Y + (size_t)sB1 * 1024 + c); xB[j] = *(const f32x4*)(XL + (size_t)rb * 1024 + c); }
#pragma unroll
        for (int half = 0; half < 2; ++half) {
            if (half == 1 && !hasB) break;
            const int row = half ? rowB : rowA; const float w0 = half ? wB0 : wA0, w1 = half ? wB1 : wA1;
            const float* g5 = mod + (l * 5 + modrow(row)) * 6144 + 5 * 1024;
            f32x4 v[4];
#pragma unroll
            for (int j = 0; j < 4; ++j) { const int c = 4 * lane + 256 * j;
                const u32x2 a = half ? yB0[j] : yA0[j], b2 = half ? yB1[j] : yA1[j];
                f32x4 y; y[0] = w0 * lo16(a.x) + w1 * lo16(b2.x); y[1] = w0 * hi16(a.x) + w1 * hi16(b2.x); y[2] = w0 * lo16(a.y) + w1 * lo16(b2.y); y[3] = w0 * hi16(a.y) + w1 * hi16(b2.y);
                v[j] = (half ? xB[j] : xA[j]) + *(const f32x4*)(g5 + c) * y; }
            if (l == 0) {
#pragma unroll
                for (int j = 0; j < 4; ++j) *(f32x4*)(XL + (size_t)row * 1024 + 4 * lane + 256 * j) = v[j];
                const float* mr = mod + (5 + modrow(row)) * 6144;
                norm_mod_row(v, p.g_mix + 1024, mr, mr + 1024, lane);
                store_row_bf16((bf16_t*)(p.ws + WS_H) + (size_t)row * 1024, v, lane);
            } else {
                norm_mod_row(v, p.g_final, nullptr, nullptr, lane);
                float* o = p.out + (size_t)(row - MC) * 1024;
#pragma unroll
                for (int j = 0; j < 4; ++j) *(f32x4*)(o + 4 * lane + 256 * j) = v[j];
            }
        }
    }
}

constexpr int NPH_L = 12, NPHASES = 1 + 2 * NPH_L;
__device__ __forceinline__ void run_phase(const Params& p, int ph, unsigned char* lds) {
    const int bid = blockIdx.x, nb = gridDim.x;
    const int wave = tid_fresh() >> 6;
#ifndef ONLY_S
    if (ph == 0) { phase_pre(p, lds, bid, nb); return; }
#else
    if (ph == 0) { if (ONLY_S == 99) phase_pre(p, lds, bid, nb); return; }
#endif
    const int l = (ph - 1) / NPH_L, s = (ph - 1) % NPH_L;
    unsigned char* ws = p.ws;
    const int pm0 = l == 0 ? 0 : 4, nMrows = l == 0 ? 68 : 64, row_lo = l == 0 ? 0 : MC;
#ifdef ONLY_S
    if (s != ONLY_S) return;
#endif
    switch (s) {
    case 0: if (l == 0) phase_norm1(p, bid, nb); break;
    case 1: { EpiInproj E{ws};
              if (l == 0) { SchedGrid S{(const bf16_t*)(ws + WS_H), (const bf16_t*)(ws + WS_WIN), 1024, 1024, 0, 68, 45, nb, bid}; gemm_run(lds, S, E, 1024, 1024, 1024, 1); }
              else { SchedInproj1 S{(const bf16_t*)(ws + WS_H), (const bf16_t*)(ws + WS_WIN), nb, bid}; gemm_run(lds, S, E, 1024, 1024, 1024, 1); } } break;
    case 2: { { ConvW Wq, Wk; int whd = -1; const int d0 = (tid_fresh() & 31) * 8;
                for (int v = (bid * 1088) / nb; v < ((bid + 1) * 1088) / nb; ++v) { const int hd = v / 272, it = (v % 272) * 4 + hd;
                    if (hd != whd) { conv_load_w(p.mconv_w + (size_t)l * 4 * 2048, p.mconv_b + (size_t)l * 2048, hd * 256 + d0, Wq); conv_load_w(p.mconv_w + (size_t)l * 4 * 2048, p.mconv_b + (size_t)l * 2048, 1024 + hd * 256 + d0, Wk); whd = hd; }
                    conv_m_item(p, l, it, (LAS unsigned char*)lds, Wq, Wk); } }
              { ConvW Wbc, Wx; int wg = -1; const int cs = tid_fresh() & 31;
                for (int v = (bid * 1088) / nb; v < ((bid + 1) * 1088) / nb; ++v) { const int grp = v / 272, it = (v % 272) * 4 + grp;
                    if (grp != wg) { conv_load_w(p.sconv_w + (size_t)l * 4 * 2048, p.sconv_b + (size_t)l * 2048, 1024 + (cs >> 4) * 512 + grp * 128 + (cs & 15) * 8, Wbc); conv_load_w(p.sconv_w + (size_t)l * 4 * 2048, p.sconv_b + (size_t)l * 2048, grp * 256 + cs * 8, Wx); wg = grp; }
                    conv_s_item(p, l, it, (LAS unsigned char*)lds, Wbc, Wx); } }
              if (!p.dup) for (int it = bid; it < (l == 0 ? 272 : 256); it += nb) pool_window_item(p, it, (LAS unsigned char*)lds); } break;
    case 3: {
              int pool_c = bid, pool_g = nb;
              if (nb == 256) { const int x = bid & 7, y = bid >> 3;
                  if (y < 16) { mlstm_chunk_item(p, l, (((y >> 3) * 8 + x) << 3) | (y & 7), (LAS unsigned char*)lds); pool_c = -1; }
                  else { ssd_chunk_item(p, l, ((((y - 16) >> 3) * 8 + x) << 3) | ((y - 16) & 7), (LAS unsigned char*)lds); pool_c = (y - 16) * 8 + x; pool_g = 128; } }
              else { for (int it = bid; it < 256; it += nb) { if (it < 128) mlstm_chunk_item(p, l, it, (LAS unsigned char*)lds); else ssd_chunk_item(p, l, it - 128, (LAS unsigned char*)lds); } }
              if (pool_c >= 0 && !p.dup) { SchedPool S{(const bf16_t*)(ws + WS_BR), (const bf16_t*)(ws + WS_WPOOL), pm0, nMrows, pool_g, pool_c}; EpiPool E{(bf16_t*)(ws + WS_BR)};
                  gemm_run(lds, S, E, 256, 3072, 256, 1); } } break;
    case 4: { mlstm_finish_rows(p, l, row_lo, bid * 8 + wave, nb * 8); ssd_finish_rows(p, l, row_lo, bid * 8 + wave, nb * 8); } break;
    case 5: { SchedGrid S{(const bf16_t*)(ws + WS_BR), (const bf16_t*)(ws + WS_WBR), 3072, 3072, pm0, nMrows, 4, nb, bid}; EpiBranch E{(const bf16_t*)(ws + WS_MG), (bf16_t*)(ws + WS_MERGED)};
              gemm_run(lds, S, E, 3072, 3072, 3072, 3); } break;
    case 6: { SchedGrid S{(const bf16_t*)(ws + WS_MERGED), (const bf16_t*)(ws + WS_WOUT), 1024, 1024, pm0, nMrows, 4, nb, bid}; EpiOut E{(bf16_t*)(ws + WS_OL)};
              gemm_run(lds, S, E, 1024, 1024, 1024, 1); } break;
    case 7: phase_route(p, l, lds, bid, nb); break;
    case 8: phase_scatter(p, l, lds, bid, nb); break;
    case 9: { const int* BE = (const int*)(ws + WS_BLKEXP);
              SchedMoe S{(const bf16_t*)(ws + WS_H), (const bf16_t*)(ws + WS_EW1), BE, (const int*)(ws + WS_TOK), 1024, BE[200], nb, bid, (size_t)1048576, (size_t)1024}; EpiMoe1 E{(bf16_t*)(ws + WS_ACT)};
              gemm_run<true>(lds, S, E, 1024, 1024, 1024, 1); } break;
    case 10: { const int* BE = (const int*)(ws + WS_BLKEXP);
              SchedMoe S{(const bf16_t*)(ws + WS_ACT), (const bf16_t*)(ws + WS_EW2), BE, nullptr, 512, BE[200], nb, bid, (size_t)524288, (size_t)512}; EpiMoe2 E{(bf16_t*)(ws + WS_Y)};
              gemm_run(lds, S, E, 512, 512, 512, 1); } break;
    case 11: phase_combine(p, l, bid, nb); break;
    }
}

#define XB_TMO      128
#define XB_XCNT(j)  (256  + 64 * (j))
#define XB_XSUB(j)  (1280 + 64 * (j))
#define XB_XGEN(j)  (2304 + 64 * (j))
#define XB_TOP      3328
#define XB_TOPGEN   3392
#define XCD_BAR_WORDS 3456
#define XB_SPIN_CAP (1u << 18)
__device__ __forceinline__ unsigned xb_ld(unsigned* p)              { return __hip_atomic_load(p, __ATOMIC_RELAXED, __HIP_MEMORY_SCOPE_AGENT); }
__device__ __forceinline__ unsigned xb_add(unsigned* p, unsigned v) { return __hip_atomic_fetch_add(p, v, __ATOMIC_RELAXED, __HIP_MEMORY_SCOPE_AGENT); }
__device__ __forceinline__ unsigned xb_xcc_id() { return (unsigned)__builtin_amdgcn_s_getreg((3 << 11) | 20) & 0xFu; }
#define XB_SPIN(cond, bar) do { unsigned _sp = 0; while (cond) { __builtin_amdgcn_s_sleep(1); \
    if ((++_sp & 255u) == 0u) { if (xb_ld(&(bar)[XB_TMO])) break; if (_sp > XB_SPIN_CAP) { atomicAdd(&(bar)[XB_TMO], 1u); break; } } } } while (0)
__device__ __forceinline__ void xcd_barrier_complete(unsigned* bar, unsigned x, unsigned& nloc, unsigned& nx) {
    const unsigned G = gridDim.x * gridDim.y * gridDim.z;
    unsigned sum, cnt, mine, sp = 0u;
    for (;;) {
        sum = 0u; cnt = 0u; mine = 0u;
#pragma unroll
        for (unsigned j = 0; j < 16; ++j) { const unsigned c = xb_ld(&bar[XB_XCNT(j)]); sum += c; cnt += (c > 0u) ? 1u : 0u; mine = (j == x) ? c : mine; }
        if (sum == G) break;
        __builtin_amdgcn_s_sleep(1);
        if ((++sp & 255u) == 0u) { if (xb_ld(&bar[XB_TMO])) break; if (sp > XB_SPIN_CAP) { atomicAdd(&bar[XB_TMO], 1u); break; } }
    }
    nloc = mine > 0u ? mine : 1u; nx = cnt > 0u ? cnt : 1u;
}
__device__ __forceinline__ void xcd_barrier(unsigned* bar, volatile LAS unsigned* st) {
    asm volatile("s_waitcnt vmcnt(0)" ::: "memory");
    __syncthreads();
    if (threadIdx.x == 0) {
        __builtin_amdgcn_s_waitcnt(0);
        const unsigned x = xb_xcc_id();
        unsigned nloc = st[0], nx = st[1];
        if (nloc == 0u) { xcd_barrier_complete(bar, x, nloc, nx); st[0] = nloc; st[1] = nx; }
        const unsigned old = xb_add(&bar[XB_XSUB(x)], 1u);
        const unsigned gen = old / nloc;
        if (old + 1u == (gen + 1u) * nloc) {
            __builtin_amdgcn_fence(__ATOMIC_RELEASE, "agent");
            asm volatile("s_waitcnt vmcnt(0)" ::: "memory");
            const unsigned og = xb_add(&bar[XB_TOP], 1u);
            const unsigned tg = og / nx;
            if (og + 1u == (tg + 1u) * nx) xb_add(&bar[XB_TOPGEN], 1u);
            else XB_SPIN(xb_ld(&bar[XB_TOPGEN]) == tg, bar);
            __builtin_amdgcn_fence(__ATOMIC_ACQUIRE, "agent");
            xb_add(&bar[XB_XGEN(x)], 1u);
            asm volatile("s_waitcnt vmcnt(0)" ::: "memory");
        } else {
            XB_SPIN(xb_ld(&bar[XB_XGEN(x)]) == gen, bar);
            __builtin_amdgcn_fence(__ATOMIC_ACQUIRE, "agent");
            asm volatile("s_waitcnt vmcnt(0)" ::: "memory");
        }
    }
    __syncthreads();
}

constexpr int BAR_LDS_OFF = LDS_BYTES - 16;
__global__ void __launch_bounds__(NTHR, 2) fwd_kernel(Params pk) {
    extern __shared__ __attribute__((aligned(16))) unsigned char lds[];
    const Params& p = pk;
    const int lo = pk.ph_lo, hi = pk.ph_hi;
    unsigned* bar = (unsigned*)(pk.ws + WS_BAR);
    volatile LAS unsigned* bst = (volatile LAS unsigned*)((LAS unsigned char*)lds + BAR_LDS_OFF);
    if (hi - lo > 1) {
        if (threadIdx.x == 0) { bst[0] = 0u; bst[1] = 0u; (void)xb_add(&bar[XB_XCNT(xb_xcc_id())], 1u); }
        __syncthreads();
    }
#define STEP(k) if (lo <= (k) && (k) < hi) { \
    if (PROF_S >= 0 && blockIdx.x == 0 && threadIdx.x == 0) ((volatile LAS unsigned long long*)((LAS unsigned char*)lds + 163000))[k] = __builtin_amdgcn_s_memrealtime(); \
    run_phase(p, (k), lds); if ((k) + 1 < hi) { if (pk.dup < 0) cg::this_grid().sync(); else xcd_barrier(bar, bst); } }
    STEP(0) STEP(1) STEP(2) STEP(3) STEP(4) STEP(5) STEP(6) STEP(7) STEP(8) STEP(9) STEP(10) STEP(11) STEP(12)
    STEP(14) STEP(15) STEP(16) STEP(17) STEP(18) STEP(19) STEP(20) STEP(21) STEP(22) STEP(23) STEP(24)
#undef STEP
    if (PROF_S >= 0 && hi - lo > 1) {
        __syncthreads();
        if (blockIdx.x == 0 && threadIdx.x == 0) {
            volatile LAS unsigned long long* ts = (volatile LAS unsigned long long*)((LAS unsigned char*)lds + 163000);
            const unsigned long long tend = __builtin_amdgcn_s_memrealtime();
            float acc = 0.f;
            for (int k = 0; k < NPHASES; ++k) { if (k == 1 + NPH_L) continue; const int s = k == 0 ? 14 : (k - 1) % NPH_L; if (s != PROF_S) continue;
                int kn = k + 1; if (kn == 1 + NPH_L) kn++; const unsigned long long t1 = kn < NPHASES ? ts[kn] : tend; acc += (float)(t1 - ts[k]) * 0.001f; }
            __threadfence(); atomicAdd(pk.out, acc);
        }
    }
}

extern "C" void kernel_launch(void* const* d_in, const int* in_sizes, int n_in, void* d_out, int out_size, void* d_ws, size_t ws_size, hipStream_t stream) {
    static int grid_blocks = 0;
    if (!grid_blocks) {
        if (n_in != 31 || ws_size < WS_END) { fprintf(stderr, "kernel_launch: unexpected n_in %d / ws_size %zu (need %zu)\n", n_in, ws_size, (size_t)WS_END); grid_blocks = -1; return; }
        int dev = 0, cus = 0, per_cu = 0;
        hipGetDevice(&dev);
        hipDeviceGetAttribute(&cus, hipDeviceAttributeMultiprocessorCount, dev);
        if (hipFuncSetAttribute((const void*)fwd_kernel, hipFuncAttributeMaxDynamicSharedMemorySize, LDS_BYTES) != hipSuccess) fprintf(stderr, "kernel_launch: hipFuncSetAttribute failed\n");
        hipOccupancyMaxActiveBlocksPerMultiprocessor(&per_cu, (const void*)fwd_kernel, NTHR, LDS_BYTES);
        if (per_cu < 1) { fprintf(stderr, "kernel_launch: occupancy query says %d blocks per CU\n", per_cu); per_cu = 1; }
        grid_blocks = cus * per_cu;
        (void)hipGetLastError();
    }
    if (grid_blocks < 0) return;
    Params p{};
    const float** dst = (const float**)&p;
    for (int i = 0; i < 31; ++i) dst[i] = (const float*)d_in[i];
    p.out = (float*)d_out; p.ws = (unsigned char*)d_ws;
#if SINGLE_LAUNCH
    if (hipMemsetAsync((char*)d_ws + WS_BAR, 0, 16384, stream) != hipSuccess) fprintf(stderr, "kernel_launch: hipMemsetAsync failed\n");
    p.ph_lo = 0; p.ph_hi = NPHASES;
    void* args[] = {&p};
    hipError_t e = hipLaunchCooperativeKernel((const void*)fwd_kernel, dim3(grid_blocks), dim3(NTHR), args, LDS_BYTES, stream);
    if (e != hipSuccess) fprintf(stderr, "cooperative launch failed: %s (grid %d)\n", hipGetErrorString(e), grid_blocks);
#else
    for (int ph = 0; ph < NPHASES; ++ph) {
        if (ph == 1 + NPH_L) continue;
        p.ph_lo = ph; p.ph_hi = ph + 1;
        hipLaunchKernelGGL(fwd_kernel, dim3(grid_blocks), dim3(NTHR), LDS_BYTES, stream, p);
        const int sidx = ph == 0 ? 14 : (ph - 1) % NPH_L;
        if ((PROBE_DUP_MASK >> sidx) & 1) { p.dup = 1; for (int r = 0; r < PROBE_DUP_N; ++r) hipLaunchKernelGGL(fwd_kernel, dim3(grid_blocks), dim3(NTHR), LDS_BYTES, stream, p); p.dup = 0; }
    }
#endif
}
```

```cpp
#include <hip/hip_runtime.h>
#include <hip/hip_cooperative_groups.h>
#include <cstdio>
namespace cg = cooperative_groups;

#ifndef SINGLE_LAUNCH
#define SINGLE_LAUNCH 1
#endif
#ifndef PROBE_DUP_MASK
#define PROBE_DUP_MASK 0
#endif
#ifndef PROBE_DUP_N
#define PROBE_DUP_N 1
#endif
#ifndef USE_MLSTM_CHUNK
#define USE_MLSTM_CHUNK 1
#endif
#ifndef USE_SSD_CHUNK
#define USE_SSD_CHUNK 1
#endif
#ifndef CV_IN_SCAN
#define CV_IN_SCAN 0
#endif
#ifndef PROF_S
#define PROF_S (-1)
#endif
#ifndef CONVDUP
#define CONVDUP 0
#endif
#ifndef INPROJ_WGM
#define INPROJ_WGM 4
#endif
#ifndef USE_MFMA_GEMM
#define USE_MFMA_GEMM 1
#endif

typedef unsigned short bf16_t;
typedef float f32x4 __attribute__((ext_vector_type(4)));
typedef unsigned u32x4 __attribute__((ext_vector_type(4)));
typedef unsigned u32x2 __attribute__((ext_vector_type(2)));

constexpr int NTHR = 512;
constexpr int D = 1024, NB = 4, SEQ = 4096, CTXL = 256;
constexpr int MC = NB * CTXL;
constexpr int ML = NB * SEQ;
constexpr int MT = MC + ML;
constexpr int DIN = 11312, NPAD = 11520;
constexpr int NE = 32, DE = 512;
constexpr int CAP = 43008;
constexpr float EPS = 1e-6f;
constexpr int LDS_BYTES = 163840;

constexpr size_t MiB = 1u << 20;
constexpr size_t WS_HIST = 0;
constexpr size_t WS_BLKEXP = 64 * 1024;
constexpr size_t WS_BAR = 128 * 1024;
constexpr size_t WS_TOK = 256 * 1024;
constexpr size_t WS_MOD = 1 * MiB;
constexpr size_t WS_GA = 2 * MiB;
constexpr size_t WS_DT = 4 * MiB;
constexpr size_t WS_EID = 7 * MiB;
constexpr size_t WS_EWT = 7 * MiB + 256 * 1024;
constexpr size_t WS_SLOT = 7 * MiB + 512 * 1024;
constexpr size_t WS_WIN = 8 * MiB;
constexpr size_t WS_WPOOL = 31 * MiB;
constexpr size_t WS_WBR = 32 * MiB;
constexpr size_t WS_WOUT = 38 * MiB;
constexpr size_t WS_XL = 40 * MiB;
constexpr size_t WS_H = 108 * MiB;
constexpr size_t WS_BR = 142 * MiB;
constexpr size_t WS_Q = 244 * MiB, WS_K = 278 * MiB, WS_V = 312 * MiB;
constexpr size_t WS_SX = 346 * MiB, WS_SB = 380 * MiB, WS_SC = 397 * MiB;
constexpr size_t WS_MG = 414 * MiB;
constexpr size_t WS_HF = 516 * MiB, WS_HB = 550 * MiB;
constexpr size_t WS_VT = 584 * MiB;
constexpr size_t WS_END = 618 * MiB;
constexpr size_t WS_MGA = WS_WIN, WS_MGC = WS_WIN + 576 * 1024, WS_MGP = WS_WIN + 1152 * 1024;
constexpr size_t WS_SACS = WS_WIN + 2 * MiB, WS_SDT = WS_WIN + 5 * MiB;
constexpr size_t WS_QC = WS_H, WS_KC = WS_HF, WS_KCT = WS_HB;
constexpr size_t WS_HF2 = WS_Q, WS_HB2 = WS_K;
constexpr size_t WS_XCT = WS_HB;
constexpr size_t WS_BC = WS_VT, WS_CC = WS_VT + 17 * MiB;
constexpr size_t WS_OL = WS_HF;
constexpr size_t WS_YF = WS_SX, WS_YB = WS_SB;
constexpr size_t WS_MERGED = WS_H;
constexpr size_t WS_EW1 = 244 * MiB;
constexpr size_t WS_EW2 = 308 * MiB;
constexpr size_t WS_XB = WS_BR;
constexpr size_t WS_ACT = WS_SX;
constexpr size_t WS_Y = WS_MG;

struct Params {
    const float *x, *c, *ctx, *c_ctx, *w_ada, *b_ada, *g_mix, *g_ffn, *w_in, *pool_w, *pool_scale,
        *mconv_w, *mconv_b, *mgate_b, *mnorm_g, *sconv_w, *sconv_b, *sdt_bias, *sa_log, *sd, *snorm_g,
        *w_branch, *w_out, *w_rg, *b_rg, *w_re, *b_re, *w_eg, *w_eu, *w_ed, *g_final;
    float* out; unsigned char* ws; int ph_lo, ph_hi, dup, pad;
};

__device__ __forceinline__ int tid_fresh() { int t = threadIdx.x; asm volatile("" : "+v"(t)); return t; }
__device__ __forceinline__ float bf2f(unsigned b) { return __uint_as_float(b << 16); }
__device__ __forceinline__ unsigned f2bf(float f) { unsigned u = __float_as_uint(f); return (u + 0x7fffu + ((u >> 16) & 1u)) >> 16; }
typedef __bf16 bf16x2_t __attribute__((ext_vector_type(2)));
typedef float f32x2_t __attribute__((ext_vector_type(2)));
__device__ __forceinline__ unsigned pk2(float lo, float hi) { const f32x2_t v = {lo, hi}; return __builtin_bit_cast(unsigned, __builtin_convertvector(v, bf16x2_t)); }
__device__ __forceinline__ float lo16(unsigned w) { return __uint_as_float(w << 16); }
__device__ __forceinline__ float hi16(unsigned w) { return __uint_as_float(w & 0xffff0000u); }
__device__ __forceinline__ float wave_sum(float v) {
#pragma unroll
    for (int o = 1; o < 64; o <<= 1) v += __shfl_xor(v, o);
    return v;
}
__device__ __forceinline__ float sigmoid_f(float x) { return __builtin_amdgcn_rcpf(1.f + __expf(-x)); }
__device__ __forceinline__ float silu_f(float x) { return x * __builtin_amdgcn_rcpf(1.f + __expf(-x)); }
__device__ __forceinline__ float softplus_f(float x) { return fmaxf(x, 0.f) + log1pf(__expf(-fabsf(x))); }
__device__ __forceinline__ float logsigmoid_f(float x) { return fminf(x, 0.f) - log1pf(__expf(-fabsf(x))); }
__device__ __forceinline__ void unpack8(u32x4 w, float* f) {
    f[0] = lo16(w.x); f[1] = hi16(w.x); f[2] = lo16(w.y); f[3] = hi16(w.y);
    f[4] = lo16(w.z); f[5] = hi16(w.z); f[6] = lo16(w.w); f[7] = hi16(w.w);
}
__device__ __forceinline__ u32x4 pack8(f32x4 a, f32x4 b) {
    u32x4 w; w.x = pk2(a[0], a[1]); w.y = pk2(a[2], a[3]); w.z = pk2(b[0], b[1]); w.w = pk2(b[2], b[3]); return w;
}
__device__ __forceinline__ int scanrow(int row) {
    if (row < MC) return row;
    const int r = row - MC, b = r >> 12, t = r & 4095;
    return MC + (b << 12) + ((t & 63) << 6) + (t >> 6);
}
__device__ __forceinline__ int modrow(int row) { return row < MC ? 4 : ((row - MC) >> 12); }

struct Unit { const bf16_t* A; const bf16_t* B; const int* tok; int pm, pn; };

template <int WGM = 8>
__device__ __forceinline__ void tile_order(int L, int nM, int nN, int& pm, int& pn) {
    const int nwg = nM * nN; int wgid = L;
    { const int q = nwg / 8, r = nwg % 8, xcd = wgid % 8, off = wgid / 8; wgid = (xcd < r ? xcd * (q + 1) : r * (q + 1) + (xcd - r) * q) + off; }
    const int nig = WGM * nN, gid = wgid / nig, fm = gid * WGM, gsz = (nM - fm) < WGM ? (nM - fm) : WGM;
    pm = fm + ((wgid % nig) % gsz); pn = (wgid % nig) / gsz;
}
struct SchedGrid {
    const bf16_t* A; const bf16_t* B; int lda, ldb, pm0, nM, nN, G, c;
    __device__ __forceinline__ bool next(int i, Unit& u) const {
        const long L = (long)i * G + c; if (L >= (long)nM * nN) return false;
        int pm, pn; if (nN == 45) tile_order<INPROJ_WGM>((int)L, nM, nN, pm, pn); else tile_order<8>((int)L, nM, nN, pm, pn); pm += pm0;
        u.pm = pm; u.pn = pn; u.tok = nullptr; u.A = A + (size_t)pm * 256 * lda; u.B = B + (size_t)pn * 256 * ldb; return true;
    }
};
struct SchedInproj1 {
    const bf16_t* A; const bf16_t* B; int G, c;
    __device__ __forceinline__ bool next(int i, Unit& u) const {
        const long L = (long)i * G + c; if (L >= 2880 + 84) return false;
        int pm, pn;
        if (L < 2880) { tile_order<INPROJ_WGM>((int)L, 64, 45, pm, pn); pm += 4; }
        else { const int idx = (int)L - 2880, k = idx % 21; pm = idx / 21; pn = k < 12 ? 4 + k : (k < 16 ? 20 + (k - 12) : (k < 20 ? 28 + (k - 16) : 44)); }
        u.pm = pm; u.pn = pn; u.tok = nullptr; u.A = A + (size_t)pm * 256 * 1024; u.B = B + (size_t)pn * 256 * 1024; return true;
    }
};
struct SchedPool {
    const bf16_t* A; const bf16_t* B; int pm0, nM, G, c;
    __device__ __forceinline__ bool next(int i, Unit& u) const {
        const long L = (long)i * G + c; if (L >= (long)nM * 4) return false;
        const int pm = pm0 + (int)(L >> 2), g = (int)(L & 3);
        u.pm = pm; u.pn = g; u.tok = nullptr; u.A = A + (size_t)pm * 256 * 3072 + g * 256; u.B = B + (size_t)g * 65536; return true;
    }
};
struct SchedMoe {
    const bf16_t* A; const bf16_t* B; const int* blkexp; const int* tok; int lda, nblk, G, c; size_t bexp_stride, ldb;
    __device__ __forceinline__ bool next(int i, Unit& u) const {
        const long L = (long)i * G + c; if (L >= (long)nblk * 4) return false;
        const int blk = (int)(L >> 2), nt = (int)(L & 3); const int e = blkexp[blk];
        u.pm = blk; u.pn = nt; u.tok = tok ? tok + blk * 256 : nullptr; u.A = tok ? A : A + (size_t)blk * 256 * lda;
        u.B = B + (size_t)e * bexp_stride + (size_t)nt * 256 * ldb; return true;
    }
};

struct EpiInproj {
    unsigned char* ws;
    __device__ __forceinline__ void seg(const Unit& u, int, int r, int c0, f32x4& lo0, f32x4& lo1, f32x4& hi0, f32x4& hi1) const {
        const int row = u.pm * 256 + r, t = u.pn;
        bf16_t* dst; size_t ld; int cb;
        if (t < 4) { dst = (bf16_t*)(ws + WS_BR) + (size_t)row * 3072; cb = t * 256; }
        else if (t < 16) { const int w = (t - 4) >> 2; dst = (bf16_t*)(ws + WS_Q + (size_t)w * 34 * MiB) + (size_t)scanrow(row) * 1024; cb = ((t - 4) & 3) * 256; }
        else if (t < 20) { dst = (bf16_t*)(ws + WS_BR) + (size_t)row * 3072 + 1024; cb = (t - 16) * 256; }
        else if (t < 24) { dst = (bf16_t*)(ws + WS_SX) + (size_t)row * 1024; cb = (t - 20) * 256; }
        else if (t < 28) { dst = (bf16_t*)(ws + WS_BR) + (size_t)row * 3072 + 2048; cb = (t - 24) * 256; }
        else if (t < 30) { dst = (bf16_t*)(ws + WS_SB) + (size_t)row * 512; cb = (t - 28) * 256; }
        else if (t < 32) { dst = (bf16_t*)(ws + WS_SC) + (size_t)row * 512; cb = (t - 30) * 256; }
        else if (t < 44) {
            dst = (bf16_t*)(ws + WS_MG) + (size_t)row * 3072; cb = (t - 32) * 256;
#pragma unroll
            for (int j = 0; j < 4; ++j) { lo0[j] = sigmoid_f(lo0[j]); lo1[j] = sigmoid_f(lo1[j]); hi0[j] = sigmoid_f(hi0[j]); hi1[j] = sigmoid_f(hi1[j]); }
        } else {
            if (c0 < 32) { float* d = (float*)(ws + WS_DT) + (size_t)row * 32 + c0; *(f32x4*)d = lo0; *(f32x4*)(d + 4) = lo1; }
            else if (c0 < 48) { float* d = (float*)(ws + WS_GA) + (size_t)scanrow(row) * 16 + (c0 - 32); *(f32x4*)d = lo0; *(f32x4*)(d + 4) = lo1; }
            return;
        }
        *(u32x4*)(dst + cb + c0) = pack8(lo0, lo1);
        *(u32x4*)(dst + cb + 128 + c0) = pack8(hi0, hi1);
    }
};
struct EpiPool {
    bf16_t* BR;
    __device__ __forceinline__ void seg(const Unit& u, int, int r, int c0, f32x4& lo0, f32x4& lo1, f32x4& hi0, f32x4& hi1) const {
        bf16_t* d = BR + (size_t)(u.pm * 256 + r) * 3072 + u.pn * 256 + c0;
        *(u32x4*)d = pack8(lo0, lo1);
        *(u32x4*)(d + 128) = pack8(hi0, hi1);
    }
};
struct EpiBranch {
    const bf16_t* MG; bf16_t* OUT;
    static constexpr bool PRELOAD = true;
    __device__ __forceinline__ void load(const Unit& u, int sg, int r, int c0, u32x4 (&b)[4]) const {
        const bf16_t* g = MG + (size_t)(u.pm * 256 + r) * 3072 + sg * 1024 + u.pn * 256 + c0;
        const int nx = sg < 2 ? 1024 : 0;
        b[0] = *(const u32x4*)g; b[1] = *(const u32x4*)(g + 128); b[2] = *(const u32x4*)(g + nx); b[3] = *(const u32x4*)(g + nx + 128);
    }
    __device__ __forceinline__ void apply(const Unit& u, int sg, int r, int c0, const u32x4 (&bb)[4], f32x4& lo0, f32x4& lo1, f32x4& hi0, f32x4& hi1) const {
        float a[8], b[8], a2[8], b2[8]; unpack8(bb[0], a); unpack8(bb[1], b); unpack8(bb[2], a2); unpack8(bb[3], b2);
        if (sg < 2) {
#pragma unroll
            for (int j = 0; j < 8; ++j) { a[j] = a[j] * __builtin_amdgcn_rcpf(a2[j]); b[j] = b[j] * __builtin_amdgcn_rcpf(b2[j]); } }
#pragma unroll
        for (int j = 0; j < 4; ++j) { lo0[j] *= a[j]; lo1[j] *= a[4 + j]; hi0[j] *= b[j]; hi1[j] *= b[4 + j]; }
        if (sg == 2) { bf16_t* d = OUT + (size_t)(u.pm * 256 + r) * 1024 + u.pn * 256 + c0; *(u32x4*)d = pack8(lo0, lo1); *(u32x4*)(d + 128) = pack8(hi0, hi1); }
    }
    __device__ __forceinline__ void seg(const Unit&, int, int, int, f32x4&, f32x4&, f32x4&, f32x4&) const {}
};
struct EpiOut {
    bf16_t* OL;
    __device__ __forceinline__ void seg(const Unit& u, int, int r, int c0, f32x4& lo0, f32x4& lo1, f32x4& hi0, f32x4& hi1) const {
        bf16_t* d = OL + (size_t)(u.pm * 256 + r) * 1024 + u.pn * 256 + c0;
        *(u32x4*)d = pack8(lo0, lo1); *(u32x4*)(d + 128) = pack8(hi0, hi1);
    }
};
struct EpiMoe1 {
    bf16_t* ACT;
    __device__ __forceinline__ void seg(const Unit& u, int, int r, int c0, f32x4& lo0, f32x4& lo1, f32x4& hi0, f32x4& hi1) const {
        const int row = u.pm * 256 + r;
        f32x4 a, b;
#pragma unroll
        for (int j = 0; j < 4; ++j) { a[j] = silu_f(lo0[j]) * hi0[j]; b[j] = silu_f(lo1[j]) * hi1[j]; }
        *(u32x4*)(ACT + (size_t)row * 512 + u.pn * 128 + c0) = pack8(a, b);
    }
};
struct EpiMoe2 {
    bf16_t* Y;
    __device__ __forceinline__ void seg(const Unit& u, int, int r, int c0, f32x4& lo0, f32x4& lo1, f32x4& hi0, f32x4& hi1) const {
        bf16_t* d = Y + (size_t)(u.pm * 256 + r) * 1024 + u.pn * 256 + c0;
        *(u32x4*)d = pack8(lo0, lo1); *(u32x4*)(d + 128) = pack8(hi0, hi1);
    }
};

template <class E, class = void> struct epi_preload { static constexpr bool value = false; };
template <class E> struct epi_preload<E, decltype((void)E::PRELOAD)> { static constexpr bool value = E::PRELOAD; };

#define LAS __attribute__((address_space(3)))
typedef short bf16x8 __attribute__((ext_vector_type(8)));
constexpr int HTB = 128 * 64 * 2;
__device__ __forceinline__ int lds_byte(int r, int c) { const int st = (r >> 4) * 2 + (c >> 5), rr = r & 15, cc = c & 31, ob = rr * 64 + cc * 2; return st * 1024 + (ob ^ (((ob >> 9) & 1) << 5)); }
__device__ __forceinline__ void stage_rc(int b, int& R, int& C) { const int st = b / 1024, sb = b % 1024, swz = sb ^ (((sb >> 9) & 1) << 5); R = (st >> 1) * 16 + swz / 64; C = (st & 1) * 32 + (swz % 64) / 2; }
__device__ __forceinline__ int perm32(int rho) { const int n = rho >> 4, i = rho & 15; return 8 * (i >> 2) + 4 * n + (i & 3); }

template <bool GATHER, class Sched, class Epi>
__device__ __forceinline__ void gemm_mfma(LAS unsigned char* lds, const Sched& S, const Epi& E, const int K, const int lda, const int ldb, const int nseg) {
    const int tid = tid_fresh(), wid = __builtin_amdgcn_readfirstlane(tid >> 6), lane = tid & 63, wr = wid >> 2, wc = wid & 3, fr = lane & 15, fq = lane >> 4;
    const int nt = K / 64, tseg = nt / nseg;
    unsigned vA0[2], vA1[2], nA0[2], nA1[2], voffB[2]; int rowA[2], colA[2];
#pragma unroll
    for (int i = 0; i < 2; ++i) { int R, C; stage_rc(tid * 16 + i * 8192, R, C); const int Rb = (R & ~31) + perm32(R & 31);
        rowA[i] = R; colA[i] = C;
        vA0[i] = (unsigned)(R * lda + C) * 2u; vA1[i] = vA0[i] + (unsigned)(128 * lda * 2); nA0[i] = vA0[i]; nA1[i] = vA1[i];
        voffB[i] = (unsigned)(Rb * ldb + C) * 2u; }
    const size_t kstep = 128;
    const size_t hstepB = (size_t)128 * ldb * 2;
    const unsigned ldsw = (unsigned)wid * 1024u;
    const int aoff = lds_byte(wr * 64 + fr, fq * 8), boff = lds_byte(wc * 32 + fr, fq * 8);
#define PG8_SA(b, h) (((b) * 2 + (h)) * HTB)
#define PG8_SB(b, h) ((4 + (b) * 2 + (h)) * HTB)
#define PG8_STAGE(bufoff, gbase, voff) do { _Pragma("unroll") for (int _i = 0; _i < 2; ++_i) \
        __builtin_amdgcn_global_load_lds((const unsigned*)((const char*)(gbase) + (voff)[_i]), (LAS unsigned*)(lds + (bufoff) + ldsw + _i * 8192), 16, 0, 0); } while (0)
#define PG8_LDA(dst, b, h) do { _Pragma("unroll") for (int m = 0; m < 4; ++m) _Pragma("unroll") for (int k = 0; k < 2; ++k) dst[m][k] = *(const LAS bf16x8*)(lds + PG8_SA(b, h) + aoff + m * 2048 + k * 1024); } while (0)
#define PG8_LDB(dst, b, h) do { _Pragma("unroll") for (int n = 0; n < 2; ++n) _Pragma("unroll") for (int k = 0; k < 2; ++k) dst[n][k] = *(const LAS bf16x8*)(lds + PG8_SB(b, h) + boff + n * 2048 + k * 1024); } while (0)
#define PG8_MMA(ai, bj, At, Bt) do { __builtin_amdgcn_s_setprio(1); _Pragma("unroll") for (int m = 0; m < 4; ++m) _Pragma("unroll") for (int n = 0; n < 2; ++n) _Pragma("unroll") for (int k = 0; k < 2; ++k) \
        acc[ai][bj][m][n] = __builtin_amdgcn_mfma_f32_16x16x32_bf16(Bt[n][k], At[m][k], acc[ai][bj][m][n], 0, 0, 0); __builtin_amdgcn_s_setprio(0); } while (0)
#define PG8_WAIT_V(n) asm volatile("s_waitcnt vmcnt(" #n ")" ::: "memory")
#define PG8_WAIT_L(n) asm volatile("s_waitcnt lgkmcnt(" #n ")" ::: "memory")
#define PG8_BAR __builtin_amdgcn_s_barrier()
#define PG8_SCHED __builtin_amdgcn_sched_barrier(0)
#define PG8_EPI(sg) do { \
    if constexpr (epi_preload<Epi>::value) { \
        _Pragma("unroll") for (int ai = 0; ai < 2; ++ai) _Pragma("unroll") for (int mh = 0; mh < 2; ++mh) { u32x4 gbuf[2][4]; int rr_[2]; \
            _Pragma("unroll") for (int m = 0; m < 2; ++m) { int r_ = ai * 128 + wr * 64 + (2 * mh + m) * 16 + fr; asm volatile("" : "+v"(r_)); rr_[m] = r_; E.load(cur, (sg), r_, wc * 32 + fq * 8, gbuf[m]); } \
            __builtin_amdgcn_sched_barrier(0); \
            _Pragma("unroll") for (int m = 0; m < 2; ++m) E.apply(cur, (sg), rr_[m], wc * 32 + fq * 8, gbuf[m], acc[ai][0][2 * mh + m][0], acc[ai][0][2 * mh + m][1], acc[ai][1][2 * mh + m][0], acc[ai][1][2 * mh + m][1]); \
            __builtin_amdgcn_sched_barrier(0); } \
    } else { \
        _Pragma("unroll") for (int ai = 0; ai < 2; ++ai) _Pragma("unroll") for (int m = 0; m < 4; ++m) { \
            int r_ = ai * 128 + wr * 64 + m * 16 + fr; asm volatile("" : "+v"(r_));     \
            E.seg(cur, (sg), r_, wc * 32 + fq * 8, acc[ai][0][m][0], acc[ai][0][m][1], acc[ai][1][m][0], acc[ai][1][m][1]); } } } while (0)
    Unit cur, nxt; int ui = 0;
    if (!S.next(0, cur)) return;
    f32x4 acc[2][2][4][2];
#pragma unroll
    for (int a = 0; a < 2; ++a)
#pragma unroll
        for (int b = 0; b < 2; ++b)
#pragma unroll
            for (int m = 0; m < 4; ++m)
#pragma unroll
                for (int n = 0; n < 2; ++n) acc[a][b][m][n] = (f32x4){0.f, 0.f, 0.f, 0.f};
    bf16x8 At[4][2], B0[2][2], B1[2][2];
    const char* cA = (const char*)cur.A; const char* cB = (const char*)cur.B;
    if (GATHER) {
#pragma unroll
        for (int i = 0; i < 2; ++i) { vA0[i] = (unsigned)(cur.tok[rowA[i]] * lda + colA[i]) * 2u; vA1[i] = (unsigned)(cur.tok[128 + rowA[i]] * lda + colA[i]) * 2u; nA0[i] = vA0[i]; nA1[i] = vA1[i]; }
    }
    PG8_STAGE(PG8_SB(0, 0), cB, voffB); PG8_STAGE(PG8_SA(0, 0), cA, vA0); PG8_STAGE(PG8_SB(0, 1), cB + hstepB, voffB); PG8_STAGE(PG8_SA(0, 1), cA, vA1);
    if (wr == 1) PG8_BAR;
    PG8_WAIT_V(4); PG8_BAR;
    PG8_STAGE(PG8_SB(1, 0), cB + kstep, voffB); PG8_STAGE(PG8_SA(1, 0), cA + kstep, vA0); PG8_STAGE(PG8_SB(1, 1), cB + hstepB + kstep, voffB);
    PG8_WAIT_V(6); PG8_BAR;
    for (;;) {
        const bool has_next = S.next(ui + 1, nxt);
        const char* nA = has_next ? (const char*)nxt.A : cA; const char* nB = has_next ? (const char*)nxt.B : cB;
        if (GATHER) {
            const int* tk = has_next ? nxt.tok : cur.tok;
#pragma unroll
            for (int i = 0; i < 2; ++i) { nA0[i] = (unsigned)(tk[rowA[i]] * lda + colA[i]) * 2u; nA1[i] = (unsigned)(tk[128 + rowA[i]] * lda + colA[i]) * 2u; }
        }
#pragma nounroll
        for (int sg = 0; sg < nseg; ++sg) {
#pragma nounroll
        for (int tt = 0; tt < tseg; tt += 2) {
            const int t = sg * tseg + tt;
            const bool last = (t == nt - 2);
            const char* a1 = cA + (size_t)(t + 1) * kstep;
            const char* a2 = last ? nA : cA + (size_t)(t + 2) * kstep; const char* b2 = last ? nB : cB + (size_t)(t + 2) * kstep;
            const char* a3 = a2 + kstep; const char* b3 = b2 + kstep;
            unsigned w0[2], w1[2];
#pragma unroll
            for (int i = 0; i < 2; ++i) { w0[i] = last ? nA0[i] : vA0[i]; w1[i] = last ? nA1[i] : vA1[i]; }
            PG8_LDB(B0, 0, 0); PG8_SCHED; PG8_LDA(At, 0, 0); PG8_STAGE(PG8_SA(1, 1), a1, vA1);
            PG8_WAIT_L(8); PG8_BAR; PG8_WAIT_L(0); PG8_MMA(0, 0, At, B0); PG8_BAR; PG8_SCHED;
            PG8_LDB(B1, 0, 1); PG8_STAGE(PG8_SB(0, 0), b2, voffB);
            PG8_BAR; PG8_WAIT_L(0); PG8_MMA(0, 1, At, B1); PG8_BAR;
            PG8_LDA(At, 0, 1); PG8_STAGE(PG8_SA(0, 0), a2, w0);
            PG8_BAR; PG8_WAIT_L(0); PG8_MMA(1, 0, At, B0); PG8_BAR; PG8_SCHED;
            PG8_STAGE(PG8_SB(0, 1), b2 + hstepB, voffB);
            PG8_WAIT_V(6); PG8_BAR; PG8_MMA(1, 1, At, B1); PG8_BAR;
            PG8_LDB(B0, 1, 0); PG8_SCHED; PG8_LDA(At, 1, 0); PG8_STAGE(PG8_SA(0, 1), a2, w1);
            PG8_WAIT_L(8); PG8_BAR; PG8_WAIT_L(0); PG8_MMA(0, 0, At, B0); PG8_BAR; PG8_SCHED;
            PG8_LDB(B1, 1, 1); PG8_STAGE(PG8_SB(1, 0), b3, voffB);
            PG8_BAR; PG8_WAIT_L(0); PG8_MMA(0, 1, At, B1); PG8_BAR;
            PG8_LDA(At, 1, 1); PG8_STAGE(PG8_SA(1, 0), a3, w0);
            PG8_BAR; PG8_WAIT_L(0); PG8_MMA(1, 0, At, B0); PG8_BAR; PG8_SCHED;
            PG8_STAGE(PG8_SB(1, 1), b3 + hstepB, voffB);
            PG8_WAIT_V(6); PG8_BAR; PG8_MMA(1, 1, At, B1); PG8_BAR;
        }
        PG8_EPI(sg);
        }
        if (!has_next) break;
#pragma unroll
        for (int a = 0; a < 2; ++a)
#pragma unroll
            for (int b = 0; b < 2; ++b)
#pragma unroll
                for (int m = 0; m < 4; ++m)
#pragma unroll
                    for (int n = 0; n < 2; ++n) acc[a][b][m][n] = (f32x4){0.f, 0.f, 0.f, 0.f};
        cur = nxt; cA = nA; cB = nB; ++ui;
#pragma unroll
        for (int i = 0; i < 2; ++i) { vA0[i] = nA0[i]; vA1[i] = nA1[i]; }
    }
    PG8_WAIT_V(0);
    if (wr == 0) PG8_BAR;
    PG8_BAR;
#undef PG8_SA
#undef PG8_SB
#undef PG8_STAGE
#undef PG8_LDA
#undef PG8_LDB
#undef PG8_MMA
#undef PG8_WAIT_V
#undef PG8_WAIT_L
#undef PG8_BAR
#undef PG8_SCHED
#undef PG8_EPI
}

template <bool GATHER = false, class Sched, class Epi>
__device__ __forceinline__ void gemm_run(unsigned char* lds, const Sched& S, const Epi& E, int K, int lda, int ldb, int nseg) {
    __syncthreads();
    gemm_mfma<GATHER>((LAS unsigned char*)lds, S, E, K, lda, ldb, nseg);
    __syncthreads();
}

struct TrDesc { const float* src; const float* cscale; bf16_t* dst; int ld_src, ld_dst, valid; };
__device__ __forceinline__ void tr_load(const TrDesc& d, f32x4 (&v)[16]) {
    if (d.src) {
#pragma unroll
        for (int i = 0; i < 16; ++i) v[i] = *(const f32x4*)(d.src + (size_t)(4 * i) * d.ld_src);
    } else {
#pragma unroll
        for (int i = 0; i < 16; ++i) v[i] = (f32x4){0.f, 0.f, 0.f, 0.f};
    }
}
__device__ __forceinline__ void tr_store(const TrDesc& d, f32x4 (&v)[16], float* scr, int lane) {
    const int c4 = (lane & 15) * 4, kr = lane >> 4;
    if (d.cscale) { const f32x4 s = *(const f32x4*)d.cscale;
#pragma unroll
        for (int i = 0; i < 16; ++i) v[i] = v[i] * s; }
#pragma unroll
    for (int i = 0; i < 16; ++i) { float* q = scr + (kr + 4 * i) * 65 + c4; q[0] = v[i][0]; q[1] = v[i][1]; q[2] = v[i][2]; q[3] = v[i][3]; }
    asm volatile("s_waitcnt lgkmcnt(0)" ::: "memory");
    const int c = lane & 7;
#pragma unroll
    for (int j = 0; j < 8; ++j) { const int n = (lane >> 3) + 8 * j; const float* s = scr + (8 * c) * 65 + n;
        u32x4 o; o.x = pk2(s[0 * 65], s[1 * 65]); o.y = pk2(s[2 * 65], s[3 * 65]); o.z = pk2(s[4 * 65], s[5 * 65]); o.w = pk2(s[6 * 65], s[7 * 65]);
        *(u32x4*)(d.dst + (size_t)n * d.ld_dst + 8 * c) = o; }
    asm volatile("s_waitcnt lgkmcnt(0)" ::: "memory");
}
__device__ __forceinline__ TrDesc tr_desc(const float* W, int ld_src, int srcq, bf16_t* WT, int ld_dst, int n_dst, int kdst0, int k0, int lane, const float* cscale = nullptr) {
    TrDesc d; d.ld_src = ld_src; d.ld_dst = ld_dst; d.valid = 1;
    d.src = srcq >= 0 ? W + (size_t)(k0 + (lane >> 4)) * ld_src + srcq : nullptr;
    d.cscale = (cscale && srcq >= 0) ? cscale + srcq : nullptr;
    d.dst = WT + (size_t)n_dst * ld_dst + kdst0 + k0; return d;
}
constexpr int CV_MIX_ITEMS = 2880 + 64 + 768 + 256;
constexpr int CV_EXP_ITEMS = 32 * 384;
__device__ __forceinline__ TrDesc convert_desc(const Params& p, int le, int lm, int it, int lane) {
    unsigned char* ws = p.ws;
    const int c4 = (lane & 15) * 4;
    if (le >= 0) {
        if (it < CV_EXP_ITEMS) {
            const int e = it / 384, r = it % 384;
            if (r < 256) { const int up = r >> 7, q = r & 127, kb = ((q >> 5) << 2) | ((q >> 1) & 3), nb = (((q >> 3) & 3) << 1) | (q & 1); const int c = nb * 64;
                const float* src = (up ? p.w_eu : p.w_eg) + (size_t)(le * 32 + e) * 1024 * 512;
                return tr_desc(src, 512, c + c4, (bf16_t*)(ws + WS_EW1) + (size_t)e * 1048576, 1024, (c >> 7) * 256 + up * 128 + (c & 127), 0, kb * 64, lane); }
            const int q = r - 256, kb = ((q >> 6) << 2) | ((q >> 1) & 3), nb = (((q >> 3) & 7) << 1) | (q & 1);
            return tr_desc(p.w_ed + (size_t)(le * 32 + e) * 512 * 1024, 1024, nb * 64 + c4, (bf16_t*)(ws + WS_EW2) + (size_t)e * 524288, 512, nb * 64, 0, kb * 64, lane);
        }
        it -= CV_EXP_ITEMS;
    }
    const int l = lm;
    if (it < 2880) { const int R = it >> 4, kb = it & 15, dstn = R * 64; int srcq;
        if (R < 80) srcq = dstn + c4; else if (R < 128) srcq = dstn + 16 + c4; else if (R < 176) srcq = dstn + 48 + c4;
        else if (R == 176) srcq = c4 < 32 ? 8208 + c4 : (c4 < 48 ? 5120 + (c4 - 32) : -1); else srcq = -1;
        return tr_desc(p.w_in + (size_t)l * 1024 * DIN, DIN, srcq, (bf16_t*)(ws + WS_WIN), 1024, dstn, 0, kb * 64, lane); }
    it -= 2880;
    if (it < 64) { const int g = it >> 4, r = it & 15, kb = r >> 2, nb = r & 3;
        return tr_desc(p.pool_w + (size_t)(l * 4 + g) * 65536, 256, nb * 64 + c4, (bf16_t*)(ws + WS_WPOOL) + (size_t)g * 65536, 256, nb * 64, 0, kb * 64, lane, p.pool_scale + l * 1024 + g * 256); }
    it -= 64;
    if (it < 768) { const int br = it >> 8, r = it & 255, kb = r >> 4, nb = r & 15;
        return tr_desc(p.w_branch + (size_t)(l * 3 + br) * 1048576, 1024, nb * 64 + c4, (bf16_t*)(ws + WS_WBR), 3072, nb * 64, br * 1024, kb * 64, lane); }
    it -= 768;
    { const int kb = it >> 4, nb = it & 15;
      return tr_desc(p.w_out + (size_t)l * 1048576, 1024, nb * 64 + c4, (bf16_t*)(ws + WS_WOUT), 1024, nb * 64, 0, kb * 64, lane); }
}
__device__ __forceinline__ void convert_run(const Params& p, int le, int lm, int first, int step, float* scr, int lane) {
    const int nitems = (le >= 0 ? CV_EXP_ITEMS : 0) + (lm >= 0 ? CV_MIX_ITEMS : 0);
    if (first >= nitems) return;
    f32x4 va[16], vb[16];
    TrDesc da = convert_desc(p, le, lm, first, lane), db;
    tr_load(da, va);
    for (int it = first; it < nitems; it += 2 * step) {
        const int i1 = it + step, i2 = it + 2 * step;
        if (i1 < nitems) { db = convert_desc(p, le, lm, i1, lane); tr_load(db, vb); }
        tr_store(da, va, scr, lane);
        if (i1 >= nitems) break;
        if (i2 < nitems) { da = convert_desc(p, le, lm, i2, lane); tr_load(da, va); }
        tr_store(db, vb, scr, lane);
    }
}

__device__ __forceinline__ void cvmicro_load(const Params& p, int le, int m, int lane, f32x4 (&v)[8], TrDesc& d) {
    d = convert_desc(p, le, -1, m >> 1, lane);
    const float* s = d.src + (size_t)(32 * (m & 1)) * d.ld_src;
#pragma unroll
    for (int i = 0; i < 8; ++i) v[i] = *(const f32x4*)(s + (size_t)(4 * i) * d.ld_src);
}
__device__ __forceinline__ void cvmicro_store(const TrDesc& d, int m, const f32x4 (&v)[8], LAS float* scr, int lane) {
    const int c4 = (lane & 15) * 4, kr = lane >> 4;
#pragma unroll
    for (int i = 0; i < 8; ++i) { LAS float* q = scr + (kr + 4 * i) * 65 + c4; q[0] = v[i][0]; q[1] = v[i][1]; q[2] = v[i][2]; q[3] = v[i][3]; }
    asm volatile("s_waitcnt lgkmcnt(0)" ::: "memory");
    bf16_t* drow = d.dst + (size_t)lane * d.ld_dst + 32 * (m & 1);
#pragma unroll
    for (int g = 0; g < 4; ++g) { const LAS float* s = scr + (8 * g) * 65 + lane;
        u32x4 o; o.x = pk2(s[0 * 65], s[1 * 65]); o.y = pk2(s[2 * 65], s[3 * 65]); o.z = pk2(s[4 * 65], s[5 * 65]); o.w = pk2(s[6 * 65], s[7 * 65]);
        *(u32x4*)(drow + 8 * g) = o; }
    asm volatile("s_waitcnt lgkmcnt(0)" ::: "memory");
}

__device__ __forceinline__ void phase_pre(const Params& p, unsigned char* ldsb, int bid, int nb) {
    float* lds = reinterpret_cast<float*>(ldsb);
    const int tid = tid_fresh(), lane = tid & 63, wave = tid >> 6;
    for (int i = tid; i < 5 * 1024; i += NTHR) { const float v = i < 4096 ? p.c[i] : p.c_ctx[i - 4096]; lds[i] = silu_f(v); }
    __syncthreads();
    float* red = lds + 5120;
    for (int it = bid; it < 2 * 96; it += nb) {
        const int l = it / 96, j = (it % 96) * 64 + lane;
        const float* w = p.w_ada + (size_t)l * 1024 * 6144 + j;
        float a0 = 0, a1 = 0, a2 = 0, a3 = 0, a4 = 0;
#pragma unroll 16
        for (int k = wave * 128; k < wave * 128 + 128; ++k) { const float wv = w[(size_t)k * 6144];
            a0 += lds[k] * wv; a1 += lds[1024 + k] * wv; a2 += lds[2048 + k] * wv; a3 += lds[3072 + k] * wv; a4 += lds[4096 + k] * wv; }
        red[(wave * 5 + 0) * 64 + lane] = a0; red[(wave * 5 + 1) * 64 + lane] = a1; red[(wave * 5 + 2) * 64 + lane] = a2;
        red[(wave * 5 + 3) * 64 + lane] = a3; red[(wave * 5 + 4) * 64 + lane] = a4;
        __syncthreads();
        if (tid < 320) { const int r = tid >> 6, jj = tid & 63; float s = 0;
            for (int w8 = 0; w8 < 8; ++w8) s += red[(w8 * 5 + r) * 64 + jj];
            const int col = (it % 96) * 64 + jj;
            ((float*)(p.ws + WS_MOD))[(size_t)(l * 5 + r) * 6144 + col] = s + p.b_ada[l * 6144 + col]; }
        __syncthreads();
    }
    __syncthreads();
    float* scr = lds + wave * (64 * 65);
    convert_run(p, -1, 0, bid * 8 + wave, nb * 8, scr, lane);
}

__device__ __forceinline__ void norm_mod_row(f32x4 (&v)[4], const float* g, const float* shift, const float* scale, int lane) {
    float s = 0.f;
#pragma unroll
    for (int j = 0; j < 4; ++j) s += (v[j][0] * v[j][0] + v[j][1] * v[j][1]) + (v[j][2] * v[j][2] + v[j][3] * v[j][3]);
    const float rs = __builtin_amdgcn_rsqf(wave_sum(s) * (1.f / 1024.f) + EPS);
#pragma unroll
    for (int j = 0; j < 4; ++j) { const int c = 4 * lane + 256 * j; const f32x4 gg = *(const f32x4*)(g + c);
        f32x4 y = v[j] * rs * gg;
        if (shift) { const f32x4 sh = *(const f32x4*)(shift + c), sc = *(const f32x4*)(scale + c); y = y * (1.f + sc) + sh; }
        v[j] = y; }
}
__device__ __forceinline__ void store_row_bf16(bf16_t* dst, const f32x4 (&v)[4], int lane) {
#pragma unroll
    for (int j = 0; j < 4; ++j) { u32x2 w; w.x = pk2(v[j][0], v[j][1]); w.y = pk2(v[j][2], v[j][3]); *(u32x2*)(dst + 4 * lane + 256 * j) = w; }
}

__device__ __forceinline__ void phase_norm1(const Params& p, int bid, int nb) {
    const int lane = tid_fresh() & 63, wave = tid_fresh() >> 6;
    const float* mod = (const float*)(p.ws + WS_MOD);
    const int stride = nb * 8;
    int m = bid * 8 + wave;
    f32x4 v[4], w[4];
    if (m < MT) { const float* src = m < MC ? p.ctx + (size_t)m * 1024 : p.x + (size_t)(m - MC) * 1024;
#pragma unroll
        for (int j = 0; j < 4; ++j) v[j] = *(const f32x4*)(src + 4 * lane + 256 * j); }
    for (; m < MT; m += stride) {
        const int mn = m + stride;
        if (mn < MT) { const float* src = mn < MC ? p.ctx + (size_t)mn * 1024 : p.x + (size_t)(mn - MC) * 1024;
#pragma unroll
            for (int j = 0; j < 4; ++j) w[j] = *(const f32x4*)(src + 4 * lane + 256 * j); }
        const float* mr = mod + modrow(m) * 6144;
        norm_mod_row(v, p.g_mix, mr, mr + 1024, lane);
        store_row_bf16((bf16_t*)(p.ws + WS_H) + (size_t)m * 1024, v, lane);
#pragma unroll
        for (int j = 0; j < 4; ++j) v[j] = w[j];
    }
}

__device__ __forceinline__ float wave_incl_sum(float v, int lane) {
#pragma unroll
    for (int o = 1; o < 64; o <<= 1) { const float u = __shfl_up(v, o); if (lane >= o) v += u; }
    return v;
}
__device__ __forceinline__ float wave_incl_max(float v, int lane) {
#pragma unroll
    for (int o = 1; o < 64; o <<= 1) { const float u = __shfl_up(v, o); if (lane >= o) v = fmaxf(v, u); }
    return v;
}
__device__ __forceinline__ u32x2 pack4(f32x4 a) { u32x2 w; w.x = pk2(a[0], a[1]); w.y = pk2(a[2], a[3]); return w; }

__device__ __forceinline__ void chunk_geom(int gc, int& rbase, int& n0, int& len) {
    const int b = gc / 68, cin = gc % 68;
    if (cin < 4) { rbase = b * 256; n0 = cin * 64; len = 256; } else { rbase = MC + b * 4096; n0 = (cin - 4) * 64; len = 4096; }
}
struct ConvW { float w[4][8], b[8]; };
__device__ __forceinline__ void conv_load_w(const float* cw, const float* cb, int ch0, ConvW& W) {
#pragma unroll
    for (int j = 0; j < 4; ++j) { const f32x4 a = *(const f32x4*)(cw + j * 2048 + ch0), b2 = *(const f32x4*)(cw + j * 2048 + ch0 + 4);
#pragma unroll
        for (int i = 0; i < 4; ++i) { W.w[j][i] = a[i]; W.w[j][4 + i] = b2[i]; } }
    { const f32x4 a = *(const f32x4*)(cb + ch0), b2 = *(const f32x4*)(cb + ch0 + 4);
#pragma unroll
      for (int i = 0; i < 4; ++i) { W.b[i] = a[i]; W.b[4 + i] = b2[i]; } }
}
__device__ __forceinline__ void conv8x4(const u32x4 (&raw)[7], const ConvW& W, float scale, u32x4 (&out)[4]) {
    float f[7][8];
#pragma unroll
    for (int k = 0; k < 7; ++k) unpack8(raw[k], f[k]);
#pragma unroll
    for (int pp = 0; pp < 4; ++pp) { f32x4 o0, o1;
#pragma unroll
        for (int i = 0; i < 8; ++i) { float a = W.b[i];
#pragma unroll
            for (int j = 0; j < 4; ++j) a += W.w[j][i] * f[pp + j][i];
            a = silu_f(a) * scale; if (i < 4) o0[i] = a; else o1[i - 4] = a; }
        out[pp] = pack8(o0, o1); }
}
__device__ __forceinline__ void load_raw7(const bf16_t* src, size_t ld, int rbase, int tbase, int len, u32x4 (&raw)[7]) {
#pragma unroll
    for (int k = 0; k < 7; ++k) { const int t = tbase + k; const bool ok = (t >= 0) && (t < len); const int tc = t < 0 ? 0 : (t >= len ? len - 1 : t);
        u32x4 a = *(const u32x4*)(src + (size_t)(rbase + tc) * ld);
        if (!ok) a = (u32x4){0u, 0u, 0u, 0u};
        raw[k] = a; }
}
template <class F>
__device__ __forceinline__ void tile_transpose_out(const LAS bf16_t* tile, int ldsw, int ncol, int tid, F rowptr) {
    for (int q = tid; q < ncol * 8; q += NTHR) { const int c = q % ncol, sc = q / ncol;
        unsigned v[8];
#pragma unroll
        for (int i = 0; i < 8; ++i) v[i] = tile[(sc * 8 + i) * ldsw + c];
        u32x4 w; w.x = v[0] | (v[1] << 16); w.y = v[2] | (v[3] << 16); w.z = v[4] | (v[5] << 16); w.w = v[6] | (v[7] << 16);
        *(u32x4*)(rowptr(c) + sc * 8) = w; }
}

__device__ __forceinline__ void conv_m_item(const Params& p, int l, int item, LAS unsigned char* lds, const ConvW& Wq, const ConvW& Wk) {
    const int tid = tid_fresh(), gc = item >> 2, hd = item & 3;
    int rbase, n0, len; chunk_geom(gc, rbase, n0, len);
    const int cs = tid & 31, tg = tid >> 5, d0 = cs * 8, i0 = tg * 4;
    u32x4 rq[7], rk[7]; float g0 = 0.f, g1 = 0.f;
    load_raw7((const bf16_t*)(p.ws + WS_Q) + hd * 256 + d0, 1024, rbase, n0 + i0 - 2, len, rq);
    load_raw7((const bf16_t*)(p.ws + WS_K) + hd * 256 + d0, 1024, rbase, n0 + i0 - 2, len, rk);
    const int gdir = tid >> 6, glane = tid & 63, gj = gdir ? 63 - glane : glane;
    if (gdir < 2) { const float* g = (const float*)(p.ws + WS_GA) + (size_t)(rbase + n0 + gj) * 16; g0 = g[gdir * 4 + hd]; g1 = g[(2 + gdir) * 4 + hd]; }
    { u32x4 o[4];
      conv8x4(rq, Wq, 1.0f, o);
#pragma unroll
      for (int pp = 0; pp < 4; ++pp) *(u32x4*)((bf16_t*)(p.ws + WS_QC) + (size_t)(rbase + n0 + i0 + pp) * 1024 + hd * 256 + d0) = o[pp];
      conv8x4(rk, Wk, 0.0625f, o);
#pragma unroll
      for (int pp = 0; pp < 4; ++pp) *(u32x4*)((bf16_t*)(p.ws + WS_KC) + (size_t)(rbase + n0 + i0 + pp) * 1024 + hd * 256 + d0) = o[pp]; }
    for (int rep_ = 0; rep_ < ((CONVDUP & 4) ? 2 : 1); ++rep_)
    if (gdir < 2) {
        const float ig = g0 + p.mgate_b[l * 16 + gdir * 4 + hd], lf = logsigmoid_f(g1 + p.mgate_b[l * 16 + (2 + gdir) * 4 + hd]);
        const float cum = wave_incl_sum(lf, glane), a = ig - cum, pm = wave_incl_max(a, glane);
        const size_t o = (size_t)(gc * 8 + gdir * 4 + hd) * 64 + gj;
        ((float*)(p.ws + WS_MGA))[o] = a; ((float*)(p.ws + WS_MGC))[o] = cum; ((float*)(p.ws + WS_MGP))[o] = pm;
    }
}

__device__ __forceinline__ void conv_s_item(const Params& p, int l, int item, LAS unsigned char* lds, const ConvW& Wbc, const ConvW& Wx) {
    const int tid = tid_fresh(), gc = item >> 2, grp = item & 3;
    int rbase, n0, len; chunk_geom(gc, rbase, n0, len);
    const int cs = tid & 31, tg = tid >> 5, i0 = tg * 4;
    const int isC = cs >> 4, nn = (cs & 15) * 8;
    u32x4 rbc[7], rx[7];
    load_raw7((const bf16_t*)(p.ws + (isC ? WS_SC : WS_SB)) + grp * 128 + nn, 512, rbase, n0 + i0 - 2, len, rbc);
    load_raw7((const bf16_t*)(p.ws + WS_SX) + grp * 256 + cs * 8, 1024, rbase, n0 + i0 - 2, len, rx);
    const int wv = tid >> 6, lane = tid & 63, dir = wv >> 2, hd = grp * 4 + (wv & 3), jn = dir ? 63 - lane : lane;
    const float dtraw = ((const float*)(p.ws + WS_DT))[(size_t)(rbase + n0 + jn) * 32 + dir * 16 + hd];
    { u32x4 o[4];
      conv8x4(rbc, Wbc, 1.0f, o);
      bf16_t* dst = (bf16_t*)(p.ws + (isC ? WS_CC : WS_BC)) + grp * 128 + nn;
#pragma unroll
      for (int pp = 0; pp < 4; ++pp) *(u32x4*)(dst + (size_t)(rbase + n0 + i0 + pp) * 512) = o[pp];
      conv8x4(rx, Wx, 1.0f, o);
      bf16_t* dx = (bf16_t*)(p.ws + WS_XCT) + grp * 256 + cs * 8;
#pragma unroll
      for (int pp = 0; pp < 4; ++pp) *(u32x4*)(dx + (size_t)(rbase + n0 + i0 + pp) * 1024) = o[pp]; }
    { const float dtv = softplus_f(dtraw + p.sdt_bias[l * 32 + dir * 16 + hd]);
      const float acs = wave_incl_sum(dtv * -__expf(p.sa_log[l * 32 + dir * 16 + hd]), lane);
      const size_t o = (size_t)(gc * 32 + dir * 16 + hd) * 64 + jn;
      ((float*)(p.ws + WS_SACS))[o] = acs; ((float*)(p.ws + WS_SDT))[o] = dtv; }
}

__device__ __forceinline__ void pool_window_item(const Params& p, int it, LAS unsigned char* lds) {
    const int tid = tid_fresh();
    bf16_t* BR = (bf16_t*)(p.ws + WS_BR);
    __syncthreads();
    if (it < 256) {
        const int row0 = MC + it * 64;
        { u32x4 t[16];
#pragma unroll
          for (int i = 0; i < 16; ++i) { const int q = tid + NTHR * i, r = q >> 7, ch = q & 127; t[i] = *(const u32x4*)(BR + (size_t)(row0 + r) * 3072 + ch * 8); }
#pragma unroll
          for (int i = 0; i < 16; ++i) *(LAS u32x4*)(lds + (tid + NTHR * i) * 16) = t[i]; }
        __syncthreads();
        for (int q = tid; q < 64 * 128; q += NTHR) { const int r = q >> 7, ch = q & 127, w = 2 << (ch >> 5);
            int lo = r - (w >> 1), hi = lo + w - 1; lo = lo < 0 ? 0 : lo; hi = hi > 63 ? 63 : hi;
            float s[8] = {0, 0, 0, 0, 0, 0, 0, 0}, self[8];
            for (int rr = lo; rr <= hi; ++rr) { float f[8]; unpack8(*(const LAS u32x4*)(lds + (rr * 128 + ch) * 16), f);
#pragma unroll
                for (int j = 0; j < 8; ++j) s[j] += f[j]; }
            unpack8(*(const LAS u32x4*)(lds + q * 16), self);
            const float inv = __builtin_amdgcn_rcpf((float)(hi - lo + 1)); f32x4 a, b;
#pragma unroll
            for (int j = 0; j < 4; ++j) { a[j] = s[j] * inv - self[j]; b[j] = s[4 + j] * inv - self[4 + j]; }
            *(u32x4*)(BR + (size_t)(row0 + r) * 3072 + ch * 8) = pack8(a, b); }
    } else {
        const int bb = (it - 256) >> 2, g = (it - 256) & 3, row0 = bb * 256, w = 2 << g;
        { u32x4 t[16];
#pragma unroll
          for (int i = 0; i < 16; ++i) { const int q = tid + NTHR * i, r = q >> 5, ch = q & 31; t[i] = *(const u32x4*)(BR + (size_t)(row0 + r) * 3072 + g * 256 + ch * 8); }
#pragma unroll
          for (int i = 0; i < 16; ++i) *(LAS u32x4*)(lds + (tid + NTHR * i) * 16) = t[i]; }
        __syncthreads();
        for (int q = tid; q < 256 * 32; q += NTHR) { const int r = q >> 5, ch = q & 31;
            int lo = r - (w >> 1), hi = lo + w - 1; lo = lo < 0 ? 0 : lo; hi = hi > 255 ? 255 : hi;
            float s[8] = {0, 0, 0, 0, 0, 0, 0, 0}, self[8];
            for (int rr = lo; rr <= hi; ++rr) { float f[8]; unpack8(*(const LAS u32x4*)(lds + (rr * 32 + ch) * 16), f);
#pragma unroll
                for (int j = 0; j < 8; ++j) s[j] += f[j]; }
            unpack8(*(const LAS u32x4*)(lds + q * 16), self);
            const float inv = __builtin_amdgcn_rcpf((float)(hi - lo + 1)); f32x4 a, b;
#pragma unroll
            for (int j = 0; j < 4; ++j) { a[j] = s[j] * inv - self[j]; b[j] = s[4 + j] * inv - self[4 + j]; }
            *(u32x4*)(BR + (size_t)(row0 + r) * 3072 + g * 256 + ch * 8) = pack8(a, b); }
    }
    __syncthreads();
}

typedef short bf16x4 __attribute__((ext_vector_type(4)));
__device__ __forceinline__ bf16x8 tr_join(bf16x4 r0, bf16x4 r1) { bf16x8 o; o[0] = r0[0]; o[1] = r0[1]; o[2] = r0[2]; o[3] = r0[3]; o[4] = r1[0]; o[5] = r1[1]; o[6] = r1[2]; o[7] = r1[3]; return o; }
__device__ __forceinline__ bf16x8 tr_frag(unsigned a0, unsigned a1) {
    bf16x4 r0, r1;
    asm volatile("ds_read_b64_tr_b16 %0, %2\n\tds_read_b64_tr_b16 %1, %3\n\ts_waitcnt lgkmcnt(0)" : "=&v"(r0), "=&v"(r1) : "v"(a0), "v"(a1) : "memory");
    return tr_join(r0, r1);
}
__device__ __forceinline__ void tr_frag4(const unsigned (&a)[4], unsigned d, bf16x8 (&f)[4]) {
    bf16x4 r[8];
    asm volatile("ds_read_b64_tr_b16 %0, %8\n\tds_read_b64_tr_b16 %1, %9\n\tds_read_b64_tr_b16 %2, %10\n\tds_read_b64_tr_b16 %3, %11\n\t"
                 "ds_read_b64_tr_b16 %4, %12\n\tds_read_b64_tr_b16 %5, %13\n\tds_read_b64_tr_b16 %6, %14\n\tds_read_b64_tr_b16 %7, %15\n\ts_waitcnt lgkmcnt(0)"
                 : "=&v"(r[0]), "=&v"(r[1]), "=&v"(r[2]), "=&v"(r[3]), "=&v"(r[4]), "=&v"(r[5]), "=&v"(r[6]), "=&v"(r[7])
                 : "v"(a[0]), "v"(a[0] + d), "v"(a[1]), "v"(a[1] + d), "v"(a[2]), "v"(a[2] + d), "v"(a[3]), "v"(a[3] + d) : "memory");
#pragma unroll
    for (int i = 0; i < 4; ++i) f[i] = tr_join(r[2 * i], r[2 * i + 1]);
}
__device__ __forceinline__ void tr_frag6(const unsigned (&a)[6], unsigned d, bf16x8 (&f)[6]) {
    bf16x4 r[12];
    asm volatile("ds_read_b64_tr_b16 %0, %12\n\tds_read_b64_tr_b16 %1, %13\n\tds_read_b64_tr_b16 %2, %14\n\tds_read_b64_tr_b16 %3, %15\n\t"
                 "ds_read_b64_tr_b16 %4, %16\n\tds_read_b64_tr_b16 %5, %17\n\tds_read_b64_tr_b16 %6, %18\n\tds_read_b64_tr_b16 %7, %19\n\t"
                 "ds_read_b64_tr_b16 %8, %20\n\tds_read_b64_tr_b16 %9, %21\n\tds_read_b64_tr_b16 %10, %22\n\tds_read_b64_tr_b16 %11, %23\n\ts_waitcnt lgkmcnt(0)"
                 : "=&v"(r[0]), "=&v"(r[1]), "=&v"(r[2]), "=&v"(r[3]), "=&v"(r[4]), "=&v"(r[5]), "=&v"(r[6]), "=&v"(r[7]), "=&v"(r[8]), "=&v"(r[9]), "=&v"(r[10]), "=&v"(r[11])
                 : "v"(a[0]), "v"(a[0] + d), "v"(a[1]), "v"(a[1] + d), "v"(a[2]), "v"(a[2] + d), "v"(a[3]), "v"(a[3] + d), "v"(a[4]), "v"(a[4] + d), "v"(a[5]), "v"(a[5] + d) : "memory");
#pragma unroll
    for (int i = 0; i < 6; ++i) f[i] = tr_join(r[2 * i], r[2 * i + 1]);
}
constexpr int ML_CT = 0, ML_Q = 36864, ML_K = 71680, ML_V = 106496, ML_A = 135168;
__device__ __forceinline__ void mlstm_chunk_item(const Params& p, int l, int item, LAS unsigned char* lds) {
    const int tid0 = tid_fresh(), wid = __builtin_amdgcn_readfirstlane(tid0 >> 6);
    const int b = item >> 5, hd = (item >> 3) & 3, dir = (item >> 2) & 1, eg2 = item & 3;
    const bf16_t* QC = (const bf16_t*)(p.ws + WS_QC); const bf16_t* KC = (const bf16_t*)(p.ws + WS_KC);
    const bf16_t* Vg = (const bf16_t*)(p.ws + WS_V);
    const float* GAa = (const float*)(p.ws + WS_MGA); const float* GCc = (const float*)(p.ws + WS_MGC); const float* GPp = (const float*)(p.ws + WS_MGP);
    bf16_t* OUT = (bf16_t*)(p.ws + (dir ? WS_HB2 : WS_HF2));
    const int ti = wid >> 1, wh = wid & 1;
    __syncthreads();
    for (int i = tid0; i < 36864 / 4; i += NTHR) ((LAS unsigned*)(lds + ML_CT))[i] = 0u;
    if (tid0 < 128) { const int es = tid0 >> 6, r = tid0 & 63; *(LAS u32x4*)(lds + ML_V + es * 14336 + r * 112 + 64) = (u32x4){0x3F80u, 0u, 0u, 0u}; *(LAS u32x4*)(lds + ML_V + es * 14336 + r * 112 + 80) = (u32x4){0u, 0u, 0u, 0u}; }
    f32x4 Cacc[2][2][3];
#pragma unroll
    for (int es = 0; es < 2; ++es)
#pragma unroll
        for (int j = 0; j < 2; ++j)
#pragma unroll
            for (int e = 0; e < 3; ++e) Cacc[es][j][e] = (f32x4){0.f, 0.f, 0.f, 0.f};
    float m_st = 0.f;
    f32x4 ca0 = (f32x4){0.f, 0.f, 0.f, 0.f}, ca1 = ca0, cP4 = ca0, cC4 = ca0; float cPt = 0.f, cPl = 0.f, cCl = 0.f, caw = 0.f;
    const int jl = dir ? 0 : 63;
    __syncthreads();
    for (int c = -1; c < 68; ++c) {
        const int cn = c + 1;
        const int tid = tid_fresh(), lane = tid & 63, fr = lane & 15, fq = lane >> 4;
        const int vrow = tid < 384 ? tid / 6 : 63, vch = tid < 384 ? tid % 6 : 0;
        const int gs0 = 16 * (2 * wh) + 4 * fq, gt = 16 * ti + fr, gt0 = 16 * ti + 4 * fq;
        u32x4 rq[4], rk[4], rv[1];
#pragma unroll
        for (int j = 0; j < 4; ++j) { rq[j] = (u32x4){0u, 0u, 0u, 0u}; rk[j] = rq[j]; }
        rv[0] = (u32x4){0u, 0u, 0u, 0u};
        if (cn < 68) {
            const int cin = cn < 4 ? (dir ? 3 - cn : cn) : 4 + (dir ? 67 - cn : cn - 4), gc = b * 68 + cin;
            int rbase, n0, len; chunk_geom(gc, rbase, n0, len);
#pragma unroll
            for (int j = 0; j < 4; ++j) { const int q = tid + NTHR * j;
                const size_t ro = (size_t)(rbase + n0 + (q >> 5)) * 1024 + hd * 256 + (q & 31) * 8;
                rq[j] = *(const u32x4*)(QC + ro); rk[j] = *(const u32x4*)(KC + ro); }
            { const int es = tid >> 8, r = (tid & 255) >> 2, ch = tid & 3;
              rv[0] = *(const u32x4*)(Vg + (size_t)(rbase + n0 + r) * 1024 + hd * 256 + (2 * eg2 + es) * 32 + ch * 8); }
        }
        if (c >= 0) {
            const int cin = c < 4 ? (dir ? 3 - c : c) : 4 + (dir ? 67 - c : c - 4), gc = b * 68 + cin;
            int rbase, n0, len; chunk_geom(gc, rbase, n0, len);
            {
                f32x4 st[2] = {(f32x4){0.f, 0.f, 0.f, 0.f}, (f32x4){0.f, 0.f, 0.f, 0.f}};
                const LAS unsigned char* qb = lds + ML_Q + (16 * ti + fr) * 544 + fq * 16;
                const LAS unsigned char* kb0 = lds + ML_K + (16 * (2 * wh) + fr) * 544 + fq * 16;
                bf16x8 qfa[4], k0f[4], k1f[4];
#pragma unroll
                for (int hb = 0; hb < 2; ++hb) {
#pragma unroll
                    for (int kd = 0; kd < 4; ++kd) { qfa[kd] = *(const LAS bf16x8*)(qb + (4 * (1 - hb) + kd) * 64); k0f[kd] = *(const LAS bf16x8*)(kb0 + (4 * (1 - hb) + kd) * 64); k1f[kd] = *(const LAS bf16x8*)(kb0 + 16 * 544 + (4 * (1 - hb) + kd) * 64); }
                    __builtin_amdgcn_sched_barrier(0);
#pragma unroll
                    for (int kd = 0; kd < 4; ++kd) {
                        st[0] = __builtin_amdgcn_mfma_f32_16x16x32_bf16(k0f[kd], qfa[kd], st[0], 0, 0, 0);
                        st[1] = __builtin_amdgcn_mfma_f32_16x16x32_bf16(k1f[kd], qfa[kd], st[1], 0, 0, 0);
                    }
                    __builtin_amdgcn_sched_barrier(0);
                }
                const int t = 16 * ti + fr; const float Mt = fmaxf(m_st, cPt), M63 = fmaxf(m_st, cPl);
#pragma unroll
                for (int j = 0; j < 2; ++j) { const int s0 = 16 * (2 * wh + j) + 4 * fq; const f32x4 av = j ? ca1 : ca0;
                    f32x4 o;
#pragma unroll
                    for (int r = 0; r < 4; ++r) { const bool keep = dir ? (s0 + r >= t) : (s0 + r <= t); o[r] = keep ? st[j][r] * __expf(av[r] - Mt) : 0.f; }
                    *(LAS u32x2*)(lds + ML_A + t * 160 + s0 * 2) = pack4(o); }
                if (tid < 384) { const float w = __expf(caw - M63);
#pragma unroll
                    for (int es = 0; es < 2; ++es) { float f[8]; unpack8(*(const LAS u32x4*)(lds + ML_V + es * 14336 + vrow * 112 + vch * 16), f);
                        f32x4 o0, o1;
#pragma unroll
                        for (int i = 0; i < 4; ++i) { o0[i] = f[i] * w; o1[i] = f[4 + i] * w; }
                        *(LAS u32x4*)(lds + ML_V + es * 14336 + 7168 + vrow * 112 + vch * 16) = pack8(o0, o1); } }
            }
            __syncthreads();
            {
                const LAS unsigned char* ab = lds + ML_A + (16 * ti + fr) * 160 + fq * 16;
                const LAS unsigned char* qb = lds + ML_Q + (16 * ti + fr) * 544 + fq * 16;
                bf16x8 af[2], k0f[2], k1f[2], qf[8];
#pragma unroll
                for (int ks = 0; ks < 2; ++ks) af[ks] = *(const LAS bf16x8*)(ab + ks * 64);
#pragma unroll
                for (int kd = 0; kd < 8; ++kd) qf[kd] = *(const LAS bf16x8*)(qb + kd * 64);
                { const unsigned kb_ = (unsigned)(size_t)(lds + ML_K) + (unsigned)((8 * fq + (fr >> 2)) * 544 + (fr & 3) * 8 + wid * 64);
                  const unsigned ka[4] = {kb_, kb_ + 32, kb_ + 32 * 544, kb_ + 32 * 544 + 32}; bf16x8 kf[4]; tr_frag4(ka, 4 * 544, kf);
                  k0f[0] = kf[0]; k1f[0] = kf[1]; k0f[1] = kf[2]; k1f[1] = kf[3]; }
                const int t0 = 16 * ti + 4 * fq;
                f32x4 sgv, emv;
#pragma unroll
                for (int r = 0; r < 4; ++r) { const float Mr = fmaxf(m_st, cP4[r]); sgv[r] = __expf(m_st - Mr); emv[r] = __expf(-(cC4[r] + Mr)); }
                const float decay = __expf(m_st - fmaxf(m_st, cPl));
                const bool wr_out = !(l == 1 && cin < 4);
#pragma unroll
                for (int es = 0; es < 2; ++es) {
                    f32x4 n1o = (f32x4){0.f, 0.f, 0.f, 0.f}, n1a = n1o, n2o = n1o, n2a = n1o;
                    const LAS unsigned char* co = lds + ML_CT + es * 18432 + (16 * wh + fr) * 544 + fq * 16;
                    const LAS unsigned char* ca = lds + ML_CT + es * 18432 + (32 + fr) * 544 + fq * 16;
                    const unsigned vtr = (unsigned)(size_t)(lds + ML_V + es * 14336) + (unsigned)((8 * fq + (fr >> 2)) * 112 + (fr & 3) * 8);
                    { bf16x8 vof[2], vaf[2];
                      { const unsigned va_[4] = {vtr + wh * 32, vtr + 64, vtr + 3584 + wh * 32, vtr + 3584 + 64}; bf16x8 vf[4]; tr_frag4(va_, 448, vf); vof[0] = vf[0]; vaf[0] = vf[1]; vof[1] = vf[2]; vaf[1] = vf[3]; }
                      __builtin_amdgcn_sched_barrier(0);
#pragma unroll
                      for (int ks = 0; ks < 2; ++ks) {
                          n1o = __builtin_amdgcn_mfma_f32_16x16x32_bf16(af[ks], vof[ks], n1o, 0, 0, 0);
                          n1a = __builtin_amdgcn_mfma_f32_16x16x32_bf16(af[ks], vaf[ks], n1a, 0, 0, 0); }
                      __builtin_amdgcn_sched_barrier(0); }
#pragma unroll
                    for (int kb = 0; kb < 2; ++kb) {
                        bf16x8 cof[4], caf[4];
#pragma unroll
                        for (int kd = 0; kd < 4; ++kd) { cof[kd] = *(const LAS bf16x8*)(co + (4 * kb + kd) * 64); caf[kd] = *(const LAS bf16x8*)(ca + (4 * kb + kd) * 64); }
                        __builtin_amdgcn_sched_barrier(0);
#pragma unroll
                        for (int kd = 0; kd < 4; ++kd) {
                            n2o = __builtin_amdgcn_mfma_f32_16x16x32_bf16(qf[4 * kb + kd], cof[kd], n2o, 0, 0, 0);
                            n2a = __builtin_amdgcn_mfma_f32_16x16x32_bf16(qf[4 * kb + kd], caf[kd], n2a, 0, 0, 0); }
                        __builtin_amdgcn_sched_barrier(0);
                    }
#pragma unroll
                    for (int r = 0; r < 4; ++r) {
                        const float den = __shfl(n1a[r] + sgv[r] * n2a[r], lane & 48);
                        const float hv = (n1o[r] + sgv[r] * n2o[r]) * __builtin_amdgcn_rcpf(fmaxf(fabsf(den), emv[r]));
                        if (wr_out) OUT[(size_t)(rbase + n0 + t0 + r) * 1024 + hd * 256 + (2 * eg2 + es) * 32 + 16 * wh + fr] = (bf16_t)f2bf(hv);
                    }
#pragma unroll
                    for (int j = 0; j < 2; ++j)
#pragma unroll
                        for (int e = 0; e < 3; ++e) Cacc[es][j][e] = Cacc[es][j][e] * decay;
                    const unsigned vwr = vtr + 7168;
                    bf16x8 v0f[2], v1f[2], v2f[2];
                    { const unsigned wa_[6] = {vwr, vwr + 32, vwr + 64, vwr + 3584, vwr + 3584 + 32, vwr + 3584 + 64}; bf16x8 wf[6]; tr_frag6(wa_, 448, wf);
                      v0f[0] = wf[0]; v1f[0] = wf[1]; v2f[0] = wf[2]; v0f[1] = wf[3]; v1f[1] = wf[4]; v2f[1] = wf[5]; }
                    __builtin_amdgcn_sched_barrier(0);
#pragma unroll
                    for (int ks = 0; ks < 2; ++ks) {
                        Cacc[es][0][0] = __builtin_amdgcn_mfma_f32_16x16x32_bf16(k0f[ks], v0f[ks], Cacc[es][0][0], 0, 0, 0);
                        Cacc[es][0][1] = __builtin_amdgcn_mfma_f32_16x16x32_bf16(k0f[ks], v1f[ks], Cacc[es][0][1], 0, 0, 0);
                        Cacc[es][0][2] = __builtin_amdgcn_mfma_f32_16x16x32_bf16(k0f[ks], v2f[ks], Cacc[es][0][2], 0, 0, 0);
                        Cacc[es][1][0] = __builtin_amdgcn_mfma_f32_16x16x32_bf16(k1f[ks], v0f[ks], Cacc[es][1][0], 0, 0, 0);
                        Cacc[es][1][1] = __builtin_amdgcn_mfma_f32_16x16x32_bf16(k1f[ks], v1f[ks], Cacc[es][1][1], 0, 0, 0);
                        Cacc[es][1][2] = __builtin_amdgcn_mfma_f32_16x16x32_bf16(k1f[ks], v2f[ks], Cacc[es][1][2], 0, 0, 0);
                    }
                    __builtin_amdgcn_sched_barrier(0);
                }
            }
            __syncthreads();
#pragma unroll
            for (int es = 0; es < 2; ++es)
#pragma unroll
                for (int j = 0; j < 2; ++j) { const int dcol = (16 * (2 * wid + j) + 4 * fq) * 2;
                    *(LAS u32x2*)(lds + ML_CT + es * 18432 + fr * 544 + dcol) = pack4(Cacc[es][j][0]);
                    *(LAS u32x2*)(lds + ML_CT + es * 18432 + (16 + fr) * 544 + dcol) = pack4(Cacc[es][j][1]);
                    if (fr == 0) *(LAS u32x2*)(lds + ML_CT + es * 18432 + 32 * 544 + dcol) = pack4(Cacc[es][j][2]); }
        }
        if (c >= 0) m_st = cCl + fmaxf(m_st, cPl);
        if (cn < 68) {
            const int cin = cn < 4 ? (dir ? 3 - cn : cn) : 4 + (dir ? 67 - cn : cn - 4); const size_t gb = (size_t)((b * 68 + cin) * 8 + dir * 4 + hd) * 64;
            ca0 = *(const f32x4*)(GAa + gb + gs0); ca1 = *(const f32x4*)(GAa + gb + gs0 + 16); caw = GAa[gb + vrow];
            cP4 = *(const f32x4*)(GPp + gb + gt0); cC4 = *(const f32x4*)(GCc + gb + gt0); cPt = GPp[gb + gt]; cPl = GPp[gb + jl]; cCl = GCc[gb + jl]; }
        if (cn < 68) {
#pragma unroll
            for (int j = 0; j < 4; ++j) { const int q = tid + NTHR * j;
                *(LAS u32x4*)(lds + ML_Q + (q >> 5) * 544 + (q & 31) * 16) = rq[j];
                *(LAS u32x4*)(lds + ML_K + (q >> 5) * 544 + (q & 31) * 16) = rk[j]; }
            *(LAS u32x4*)(lds + ML_V + (tid >> 8) * 14336 + ((tid & 255) >> 2) * 112 + (tid & 3) * 16) = rv[0];
        }
        __syncthreads();
    }
}

constexpr int SS_C = 0, SS_B = 18432, SS_X = 36864, SS_G = 67584, SS_S = 77824;
__device__ __forceinline__ void ssd_chunk_item(const Params& p, int l, int item, LAS unsigned char* lds) {
    const int tid0 = tid_fresh(), wid = __builtin_amdgcn_readfirstlane(tid0 >> 6);
    const int b = item >> 5, hd = (item >> 1) & 15, dir = item & 1, grp = hd >> 2;
    const bf16_t* BC = (const bf16_t*)(p.ws + WS_BC); const bf16_t* CC = (const bf16_t*)(p.ws + WS_CC); const bf16_t* XC = (const bf16_t*)(p.ws + WS_XCT);
    const float* ACS = (const float*)(p.ws + WS_SACS); const float* SDT = (const float*)(p.ws + WS_SDT);
    bf16_t* OUT = (bf16_t*)(p.ws + (dir ? WS_YB : WS_YF));
    const float dskip = p.sd[l * 16 + hd];
    const int ti = wid >> 1, wh = wid & 1, jl = dir ? 0 : 63;
    __syncthreads();
    for (int i = tid0; i < 18432 / 4; i += NTHR) ((LAS unsigned*)(lds + SS_S))[i] = 0u;
    f32x4 Sacc[2][2];
#pragma unroll
    for (int ph = 0; ph < 2; ++ph) { Sacc[ph][0] = (f32x4){0.f, 0.f, 0.f, 0.f}; Sacc[ph][1] = Sacc[ph][0]; }
    f32x4 cs0 = (f32x4){0.f, 0.f, 0.f, 0.f}, cs1 = cs0, ct4 = cs0; float cat = 0.f, cal = 0.f, csw = 0.f, cdw = 0.f;
    __syncthreads();
    for (int c = -1; c < 68; ++c) {
        const int cn = c + 1;
        const int tid = tid_fresh(), lane = tid & 63, fr = lane & 15, fq = lane >> 4;
        const int xph = tid >> 8, xrow = (tid & 255) >> 2, xch = tid & 3;
        const int gs0 = 16 * (2 * wh) + 4 * fq, gt = 16 * ti + fr, gt0 = 16 * ti + 4 * fq;
        u32x4 rc[2], rb[2], rx = (u32x4){0u, 0u, 0u, 0u};
#pragma unroll
        for (int j = 0; j < 2; ++j) { rc[j] = (u32x4){0u, 0u, 0u, 0u}; rb[j] = rc[j]; }
        if (cn < 68) {
            const int cin = cn < 4 ? (dir ? 3 - cn : cn) : 4 + (dir ? 67 - cn : cn - 4), gc = b * 68 + cin;
            int rbase, n0, len; chunk_geom(gc, rbase, n0, len);
#pragma unroll
            for (int j = 0; j < 2; ++j) { const int q = tid + NTHR * j;
                const size_t ro = (size_t)(rbase + n0 + (q >> 4)) * 512 + grp * 128 + (q & 15) * 8;
                rc[j] = *(const u32x4*)(CC + ro); rb[j] = *(const u32x4*)(BC + ro); }
            rx = *(const u32x4*)(XC + (size_t)(rbase + n0 + xrow) * 1024 + hd * 64 + xph * 32 + xch * 8);
        }
        if (c >= 0) {
            const int cin = c < 4 ? (dir ? 3 - c : c) : 4 + (dir ? 67 - c : c - 4), gc = b * 68 + cin;
            int rbase, n0, len; chunk_geom(gc, rbase, n0, len);
            {
                f32x4 st[2] = {(f32x4){0.f, 0.f, 0.f, 0.f}, (f32x4){0.f, 0.f, 0.f, 0.f}};
                const LAS unsigned char* cbp = lds + SS_C + (16 * ti + fr) * 288 + fq * 16;
                const LAS unsigned char* bb0 = lds + SS_B + (16 * (2 * wh) + fr) * 288 + fq * 16;
                bf16x8 cf[4], b0f[4], b1f[4];
#pragma unroll
                for (int kn = 0; kn < 4; ++kn) { cf[kn] = *(const LAS bf16x8*)(cbp + kn * 64); b0f[kn] = *(const LAS bf16x8*)(bb0 + kn * 64); b1f[kn] = *(const LAS bf16x8*)(bb0 + 16 * 288 + kn * 64); }
                __builtin_amdgcn_sched_barrier(0);
#pragma unroll
                for (int kn = 0; kn < 4; ++kn) {
                    st[0] = __builtin_amdgcn_mfma_f32_16x16x32_bf16(b0f[kn], cf[kn], st[0], 0, 0, 0);
                    st[1] = __builtin_amdgcn_mfma_f32_16x16x32_bf16(b1f[kn], cf[kn], st[1], 0, 0, 0);
                }
                __builtin_amdgcn_sched_barrier(0);
                const int t = 16 * ti + fr; const float at = cat;
#pragma unroll
                for (int j = 0; j < 2; ++j) { const int s0 = 16 * (2 * wh + j) + 4 * fq; const f32x4 av = j ? cs1 : cs0;
                    f32x4 o;
#pragma unroll
                    for (int r = 0; r < 4; ++r) { const bool keep = dir ? (s0 + r >= t) : (s0 + r <= t); o[r] = keep ? st[j][r] * __expf(at - av[r]) : 0.f; }
                    *(LAS u32x2*)(lds + SS_G + t * 160 + s0 * 2) = pack4(o); }
                { float f[8]; unpack8(*(const LAS u32x4*)(lds + SS_X + xph * 15360 + xrow * 80 + xch * 16), f);
                  const float w = __expf(cal - csw); f32x4 o0, o1, w0, w1;
#pragma unroll
                  for (int i = 0; i < 4; ++i) { o0[i] = f[i] * cdw; o1[i] = f[4 + i] * cdw; w0[i] = o0[i] * w; w1[i] = o1[i] * w; }
                  *(LAS u32x4*)(lds + SS_X + xph * 15360 + 5120 + xrow * 80 + xch * 16) = pack8(o0, o1);
                  *(LAS u32x4*)(lds + SS_X + xph * 15360 + 10240 + xrow * 80 + xch * 16) = pack8(w0, w1); }
            }
            __syncthreads();
            {
                const LAS unsigned char* gb = lds + SS_G + (16 * ti + fr) * 160 + fq * 16;
                const LAS unsigned char* cbp = lds + SS_C + (16 * ti + fr) * 288 + fq * 16;
                const unsigned btr = (unsigned)(size_t)(lds + SS_B) + (unsigned)((8 * fq + (fr >> 2)) * 288 + (fr & 3) * 8 + wid * 32);
                bf16x8 gf[2], cf[4], btf[2];
#pragma unroll
                for (int ks = 0; ks < 2; ++ks) gf[ks] = *(const LAS bf16x8*)(gb + ks * 64);
#pragma unroll
                for (int kn = 0; kn < 4; ++kn) cf[kn] = *(const LAS bf16x8*)(cbp + kn * 64);
#pragma unroll
                for (int ks = 0; ks < 2; ++ks) btf[ks] = tr_frag(btr + ks * 9216, btr + ks * 9216 + 1152);
                const int t0 = 16 * ti + 4 * fq;
                f32x4 eav; eav[0] = __expf(ct4[0]); eav[1] = __expf(ct4[1]); eav[2] = __expf(ct4[2]); eav[3] = __expf(ct4[3]);
                const float dec = __expf(cal);
                const bool wr_out = !(l == 1 && cin < 4);
#pragma unroll
                for (int ph = 0; ph < 2; ++ph) {
                    f32x4 y1 = (f32x4){0.f, 0.f, 0.f, 0.f}, y2 = y1;
                    const LAS unsigned char* sb = lds + SS_S + ph * 9216 + (16 * wh + fr) * 288 + fq * 16;
                    const unsigned xtr = (unsigned)(size_t)(lds + SS_X + ph * 15360 + 5120) + (unsigned)((8 * fq + (fr >> 2)) * 80 + (fr & 3) * 8);
                    bf16x8 xf[2], sf[4], xw0f[2], xw1f[2];
#pragma unroll
                    for (int kn = 0; kn < 4; ++kn) sf[kn] = *(const LAS bf16x8*)(sb + kn * 64);
                    { const unsigned xa_[6] = {xtr + wh * 32, xtr + 2560 + wh * 32, xtr + 5120, xtr + 5120 + 32, xtr + 5120 + 2560, xtr + 5120 + 2560 + 32}; bf16x8 xq[6]; tr_frag6(xa_, 320, xq);
                      xf[0] = xq[0]; xf[1] = xq[1]; xw0f[0] = xq[2]; xw1f[0] = xq[3]; xw0f[1] = xq[4]; xw1f[1] = xq[5]; }
                    __builtin_amdgcn_sched_barrier(0);
#pragma unroll
                    for (int ks = 0; ks < 2; ++ks) y1 = __builtin_amdgcn_mfma_f32_16x16x32_bf16(gf[ks], xf[ks], y1, 0, 0, 0);
#pragma unroll
                    for (int kn = 0; kn < 4; ++kn) y2 = __builtin_amdgcn_mfma_f32_16x16x32_bf16(cf[kn], sf[kn], y2, 0, 0, 0);
#pragma unroll
                    for (int r = 0; r < 4; ++r) {
                        float yv = y1[r] + eav[r] * y2[r];
                        if (dir == 0) yv += dskip * bf2f(*(const LAS bf16_t*)(lds + SS_X + ph * 15360 + (t0 + r) * 80 + (16 * wh + fr) * 2));
                        if (wr_out) OUT[(size_t)(rbase + n0 + t0 + r) * 1024 + hd * 64 + ph * 32 + 16 * wh + fr] = (bf16_t)f2bf(yv);
                    }
                    Sacc[ph][0] = Sacc[ph][0] * dec; Sacc[ph][1] = Sacc[ph][1] * dec;
#pragma unroll
                    for (int ks = 0; ks < 2; ++ks) {
                        Sacc[ph][0] = __builtin_amdgcn_mfma_f32_16x16x32_bf16(btf[ks], xw0f[ks], Sacc[ph][0], 0, 0, 0);
                        Sacc[ph][1] = __builtin_amdgcn_mfma_f32_16x16x32_bf16(btf[ks], xw1f[ks], Sacc[ph][1], 0, 0, 0); }
                    __builtin_amdgcn_sched_barrier(0);
                }
            }
            __syncthreads();
#pragma unroll
            for (int ph = 0; ph < 2; ++ph) { const int ncol = (16 * wid + 4 * fq) * 2;
              *(LAS u32x2*)(lds + SS_S + ph * 9216 + fr * 288 + ncol) = pack4(Sacc[ph][0]);
              *(LAS u32x2*)(lds + SS_S + ph * 9216 + (16 + fr) * 288 + ncol) = pack4(Sacc[ph][1]); }
        }
        if (cn < 68) {
            const int cin = cn < 4 ? (dir ? 3 - cn : cn) : 4 + (dir ? 67 - cn : cn - 4); const size_t gb = (size_t)((b * 68 + cin) * 32 + dir * 16 + hd) * 64;
            cs0 = *(const f32x4*)(ACS + gb + gs0); cs1 = *(const f32x4*)(ACS + gb + gs0 + 16); csw = ACS[gb + xrow]; cdw = SDT[gb + xrow];
            ct4 = *(const f32x4*)(ACS + gb + gt0); cat = ACS[gb + gt]; cal = ACS[gb + jl];
#pragma unroll
            for (int j = 0; j < 2; ++j) { const int q = tid + NTHR * j;
                *(LAS u32x4*)(lds + SS_C + (q >> 4) * 288 + (q & 15) * 16) = rc[j];
                *(LAS u32x4*)(lds + SS_B + (q >> 4) * 288 + (q & 15) * 16) = rb[j]; }
            *(LAS u32x4*)(lds + SS_X + xph * 15360 + xrow * 80 + xch * 16) = rx;
        }
        __syncthreads();
    }
}

__device__ __forceinline__ void mlstm_finish_rows(const Params& p, int l, int row_lo, int gw, int ngw) {
    if (p.dup) return;
    const int lane = tid_fresh() & 63;
    const bf16_t* HF = (const bf16_t*)(p.ws + WS_HF2); const bf16_t* HB = (const bf16_t*)(p.ws + WS_HB2);
    bf16_t* BR = (bf16_t*)(p.ws + WS_BR);
    const float* ng = p.mnorm_g + l * 1024;
    int row = row_lo + gw;
    u32x2 ca[4], cb[4], co[4], na[4], nbv[4], no[4];
    if (row < MT) { const size_t so = (size_t)scanrow(row) * 1024;
#pragma unroll
        for (int hd = 0; hd < 4; ++hd) { const int c = hd * 256 + 4 * lane; ca[hd] = *(const u32x2*)(HF + so + c); cb[hd] = *(const u32x2*)(HB + so + c); co[hd] = *(const u32x2*)(BR + (size_t)row * 3072 + 1024 + c); } }
    for (; row < MT; row += ngw) {
        const int rn = row + ngw;
        if (rn < MT) { const size_t so = (size_t)scanrow(rn) * 1024;
#pragma unroll
            for (int hd = 0; hd < 4; ++hd) { const int c = hd * 256 + 4 * lane; na[hd] = *(const u32x2*)(HF + so + c); nbv[hd] = *(const u32x2*)(HB + so + c); no[hd] = *(const u32x2*)(BR + (size_t)rn * 3072 + 1024 + c); } }
#pragma unroll
        for (int hd = 0; hd < 4; ++hd) { const int c = hd * 256 + 4 * lane;
            const u32x2 a = ca[hd], b2 = cb[hd], o = co[hd];
            f32x4 h; h[0] = lo16(a.x) + lo16(b2.x); h[1] = hi16(a.x) + hi16(b2.x); h[2] = lo16(a.y) + lo16(b2.y); h[3] = hi16(a.y) + hi16(b2.y);
            const float ss = wave_sum((h[0] * h[0] + h[1] * h[1]) + (h[2] * h[2] + h[3] * h[3]));
            const float rs = __builtin_amdgcn_rsqf(ss * (1.f / 256.f) + EPS);
            const f32x4 g = *(const f32x4*)(ng + c);
            f32x4 r; r[0] = sigmoid_f(lo16(o.x)) * (h[0] * rs * g[0]); r[1] = sigmoid_f(hi16(o.x)) * (h[1] * rs * g[1]);
            r[2] = sigmoid_f(lo16(o.y)) * (h[2] * rs * g[2]); r[3] = sigmoid_f(hi16(o.y)) * (h[3] * rs * g[3]);
            u32x2 w; w.x = pk2(r[0], r[1]); w.y = pk2(r[2], r[3]);
            *(u32x2*)(BR + (size_t)row * 3072 + 1024 + c) = w; }
#pragma unroll
        for (int hd = 0; hd < 4; ++hd) { ca[hd] = na[hd]; cb[hd] = nbv[hd]; co[hd] = no[hd]; }
    }
}
__device__ __forceinline__ void ssd_finish_rows(const Params& p, int l, int row_lo, int gw, int ngw) {
    if (p.dup) return;
    const int lane = tid_fresh() & 63;
    const bf16_t* YF = (const bf16_t*)(p.ws + WS_YF); const bf16_t* YB = (const bf16_t*)(p.ws + WS_YB);
    bf16_t* BR = (bf16_t*)(p.ws + WS_BR);
    const float* ng = p.snorm_g + l * 1024;
    int row = row_lo + gw;
    u32x2 ca[4], cb[4], cz[4], na[4], nbv[4], nz[4];
    if (row < MT) {
#pragma unroll
        for (int j = 0; j < 4; ++j) { const int c = 4 * lane + 256 * j; ca[j] = *(const u32x2*)(YF + (size_t)row * 1024 + c); cb[j] = *(const u32x2*)(YB + (size_t)row * 1024 + c); cz[j] = *(const u32x2*)(BR + (size_t)row * 3072 + 2048 + c); } }
    for (; row < MT; row += ngw) {
        const int rn = row + ngw;
        if (rn < MT) {
#pragma unroll
            for (int j = 0; j < 4; ++j) { const int c = 4 * lane + 256 * j; na[j] = *(const u32x2*)(YF + (size_t)rn * 1024 + c); nbv[j] = *(const u32x2*)(YB + (size_t)rn * 1024 + c); nz[j] = *(const u32x2*)(BR + (size_t)rn * 3072 + 2048 + c); } }
        f32x4 v[4]; float ss = 0.f;
#pragma unroll
        for (int j = 0; j < 4; ++j) { const u32x2 a = ca[j], b2 = cb[j], z = cz[j];
            v[j][0] = (lo16(a.x) + lo16(b2.x)) * silu_f(lo16(z.x)); v[j][1] = (hi16(a.x) + hi16(b2.x)) * silu_f(hi16(z.x));
            v[j][2] = (lo16(a.y) + lo16(b2.y)) * silu_f(lo16(z.y)); v[j][3] = (hi16(a.y) + hi16(b2.y)) * silu_f(hi16(z.y));
            ss += (v[j][0] * v[j][0] + v[j][1] * v[j][1]) + (v[j][2] * v[j][2] + v[j][3] * v[j][3]); }
        const float rs = __builtin_amdgcn_rsqf(wave_sum(ss) * (1.f / 1024.f) + EPS);
#pragma unroll
        for (int j = 0; j < 4; ++j) { const int c = 4 * lane + 256 * j; const f32x4 g = *(const f32x4*)(ng + c);
            u32x2 w; w.x = pk2(v[j][0] * rs * g[0], v[j][1] * rs * g[1]); w.y = pk2(v[j][2] * rs * g[2], v[j][3] * rs * g[3]);
            *(u32x2*)(BR + (size_t)row * 3072 + 2048 + c) = w; }
#pragma unroll
        for (int j = 0; j < 4; ++j) { ca[j] = na[j]; cb[j] = nbv[j]; cz[j] = nz[j]; }
    }
}

__device__ __forceinline__ void phase_route(const Params& p, int l, unsigned char* ldsb, int bid, int nb) {
    float* lds = reinterpret_cast<float*>(ldsb);
    float* Wt = lds;
    int* hist = reinterpret_cast<int*>(lds + 36 * 1024);
    const int tid = tid_fresh(), lane = tid & 63, wave = tid >> 6;
    const int row_lo = l == 0 ? 0 : MC, rpb = l == 0 ? 68 : 64;
    const float* wrg = p.w_rg + (size_t)l * 1024 * 4; const float* wre = p.w_re + (size_t)l * 1024 * 32;
    for (int i = tid; i < 1024 * 4; i += NTHR) { const int k = i >> 2, g = i & 3; Wt[g * 1024 + (k ^ ((g & 7) << 2))] = wrg[i]; }
    for (int i = tid; i < 1024 * 32; i += NTHR) { const int k = i >> 5, e = i & 31; Wt[(4 + e) * 1024 + (k ^ (((4 + e) & 7) << 2))] = wre[i]; }
    const float* mod = (const float*)(p.ws + WS_MOD) + l * 5 * 6144;
    int* EID = (int*)(p.ws + WS_EID); float* EWT = (float*)(p.ws + WS_EWT);
    for (int vb = bid; vb < 256; vb += nb) {
        if (tid < 32) hist[tid] = 0;
        __syncthreads();
        for (int rr = wave; rr < rpb; rr += 8) {
            const int row = row_lo + vb * rpb + rr;
            f32x4 v[4];
            const float* mr = mod + modrow(row) * 6144;
            {
              const bool from_in = (l == 0) && !p.dup;
              const float* res = row < MC ? p.ctx + (size_t)row * 1024 : p.x + (size_t)(row - MC) * 1024;
              bf16_t* xlr = (bf16_t*)(p.ws + WS_XL) + (size_t)row * 1024;
              u32x2 o2[4];
#pragma unroll
              for (int j = 0; j < 4; ++j) {
                  if (from_in) v[j] = *(const f32x4*)(res + 4 * lane + 256 * j);
                  else { const u32x2 xr = *(const u32x2*)(xlr + 4 * lane + 256 * j); v[j] = (f32x4){lo16(xr.x), hi16(xr.x), lo16(xr.y), hi16(xr.y)}; }
                  o2[j] = *(const u32x2*)((const bf16_t*)(p.ws + WS_OL) + (size_t)row * 1024 + 4 * lane + 256 * j); }
              if (!p.dup) {
#pragma unroll
                  for (int j = 0; j < 4; ++j) { const f32x4 g2 = *(const f32x4*)(mr + 2 * 1024 + 4 * lane + 256 * j);
                      v[j][0] += g2[0] * lo16(o2[j].x); v[j][1] += g2[1] * hi16(o2[j].x); v[j][2] += g2[2] * lo16(o2[j].y); v[j][3] += g2[3] * hi16(o2[j].y);
                      *(u32x2*)(xlr + 4 * lane + 256 * j) = pack4(v[j]); } } }
            norm_mod_row(v, p.g_ffn + l * 1024, mr + 3 * 1024, mr + 4 * 1024, lane);
            store_row_bf16((bf16_t*)(p.ws + WS_H) + (size_t)row * 1024, v, lane);
            float lg[36];
#pragma unroll
            for (int e = 0; e < 36; ++e) { float s = 0.f;
#pragma unroll
                for (int j = 0; j < 4; ++j) { const f32x4 w = *(const f32x4*)(Wt + e * 1024 + ((4 * lane + 256 * j) ^ ((e & 7) << 2))); s += (v[j][0] * w[0] + v[j][1] * w[1]) + (v[j][2] * w[2] + v[j][3] * w[3]); }
                lg[e] = wave_sum(s); }
            float gl[4]; int gi = 0; float gmax;
#pragma unroll
            for (int g = 0; g < 4; ++g) gl[g] = lg[g] + p.b_rg[l * 4 + g];
            gmax = gl[0];
#pragma unroll
            for (int g = 1; g < 4; ++g) if (gl[g] > gmax) { gmax = gl[g]; gi = g; }
            float den = 0.f;
#pragma unroll
            for (int g = 0; g < 4; ++g) den += __expf(gl[g] - gmax);
            const float pg = 1.f / den;
            float v1 = -3.0e38f, v2 = -3.0e38f; int i1 = 0, i2 = 0;
#pragma unroll
            for (int g = 0; g < 4; ++g) if (g == gi) {
#pragma unroll
                for (int j = 0; j < 8; ++j) { const float x = lg[4 + g * 8 + j] + p.b_re[l * 32 + g * 8 + j];
                    if (x > v1) { v2 = v1; i2 = i1; v1 = x; i1 = j; } else if (x > v2) { v2 = x; i2 = j; } } }
            const float e2 = __expf(v2 - v1), w1 = pg / (1.f + e2), w2 = pg * e2 / (1.f + e2);
            if (lane == 0) { EID[row * 2] = gi * 8 + i1; EID[row * 2 + 1] = gi * 8 + i2; EWT[row * 2] = w1; EWT[row * 2 + 1] = w2;
                atomicAdd(&hist[gi * 8 + i1], 1); atomicAdd(&hist[gi * 8 + i2], 1); }
        }
        __syncthreads();
        if (tid < 32) ((int*)(p.ws + WS_HIST))[vb * 32 + tid] = hist[tid];
        __syncthreads();
    }
    __syncthreads();
    float* scr = lds + wave * (64 * 65);
    convert_run(p, (CV_IN_SCAN && nb == 256) ? -1 : l, l + 1 < 2 ? l + 1 : -1, bid * 8 + wave, nb * 8, scr, lane);
}

__device__ __forceinline__ void phase_scatter(const Params& p, int l, unsigned char* ldsb, int bid, int nb) {
    int* li = reinterpret_cast<int*>(ldsb);
    int* tot = li; int* pre = li + 32; int* pst = li + 64; int* ea = li + 128; int* pos = li + 384;
    const int tid = tid_fresh(), lane = tid & 63, wave = tid >> 6;
    const int row_lo = l == 0 ? 0 : MC, rpb = l == 0 ? 68 : 64;
    const int* HIST = (const int*)(p.ws + WS_HIST); const int* EID = (const int*)(p.ws + WS_EID);
    int* SLOT = (int*)(p.ws + WS_SLOT);
    for (int vb = bid; vb < 256; vb += nb) {
        __syncthreads();
        { const int e = tid & 31, jg = tid >> 5; int hv[16];
#pragma unroll
          for (int i = 0; i < 16; ++i) hv[i] = HIST[(jg * 16 + i) * 32 + e];
          int t = 0, pr = 0;
#pragma unroll
          for (int i = 0; i < 16; ++i) { t += hv[i]; pr += (jg * 16 + i < vb) ? hv[i] : 0; }
          li[512 + jg * 32 + e] = t; li[1024 + jg * 32 + e] = pr; }
        __syncthreads();
        if (tid < 32) { int t = 0, pr = 0;
#pragma unroll
            for (int g = 0; g < 16; ++g) { t += li[512 + g * 32 + tid]; pr += li[1024 + g * 32 + tid]; }
            tot[tid] = t; pre[tid] = pr; }
        __syncthreads();
        if (tid == 0) { int s = 0; for (int e = 0; e < 32; ++e) { pst[e] = s; s += ((tot[e] + 255) >> 8) << 8; }
            if (vb == 0) { int* BE = (int*)(p.ws + WS_BLKEXP); int nblk = 0;
                for (int e = 0; e < 32; ++e) { const int nbk = (tot[e] + 255) >> 8; for (int j = 0; j < nbk; ++j) BE[nblk++] = e; }
                BE[200] = nblk; } }
        if (tid < rpb * 2) ea[tid] = EID[(row_lo + vb * rpb) * 2 + tid];
        __syncthreads();
        if (tid < rpb * 2) { const int e = ea[tid]; int rk = 0; for (int j = 0; j < tid; ++j) rk += (ea[j] == e) ? 1 : 0;
            const int ps = pst[e] + pre[e] + rk; SLOT[(row_lo + vb * rpb) * 2 + tid] = ps; ((int*)(p.ws + WS_TOK))[ps] = row_lo + vb * rpb + (tid >> 1); }
        if (vb == 0 && tid < 32) { int* TOK = (int*)(p.ws + WS_TOK); const int e0 = pst[tid] + tot[tid], e1 = pst[tid] + (((tot[tid] + 255) >> 8) << 8);
            for (int q = e0; q < e1; ++q) TOK[q] = row_lo; }
    }
    __syncthreads();
}

__device__ __forceinline__ void phase_combine(const Params& p, int l, int bid, int nb) {
    if (p.dup && l == 0) return;
    const int lane = tid_fresh() & 63, wave = tid_fresh() >> 6;
    const float* mod = (const float*)(p.ws + WS_MOD);
    const int* SLOT = (const int*)(p.ws + WS_SLOT); const float* EWT = (const float*)(p.ws + WS_EWT);
    const bf16_t* Y = (const bf16_t*)(p.ws + WS_Y);
    bf16_t* XL = (bf16_t*)(p.ws + WS_XL);
    const int row_lo = l == 0 ? 0 : MC, stride = nb * 8;
    for (int rowA = row_lo + bid * 8 + wave; rowA < MT; rowA += 2 * stride) {
        const int rowB = rowA + stride; const bool hasB = rowB < MT; const int rb = hasB ? rowB : rowA;
        const int sA0 = SLOT[rowA * 2], sA1 = SLOT[rowA * 2 + 1], sB0 = SLOT[rb * 2], sB1 = SLOT[rb * 2 + 1];
        const float wA0 = EWT[rowA * 2], wA1 = EWT[rowA * 2 + 1], wB0 = EWT[rb * 2], wB1 = EWT[rb * 2 + 1];
        u32x2 yA0[4], yA1[4], yB0[4], yB1[4], xA[4], xB[4];
#pragma unroll
        for (int j = 0; j < 4; ++j) { const int c = 4 * lane + 256 * j;
            yA0[j] = *(const u32x2*)(Y + (size_t)sA0 * 1024 + c); yA1[j] = *(const u32x2*)(Y + (size_t)sA1 * 1024 + c); xA[j] = *(const u32x2*)(XL + (size_t)rowA * 1024 + c);
            yB0[j] = *(const u32x2*)(Y + (size_t)sB0 * 1024 + c); yB1[j] = *(const u32x2*)(Y + (size_t)sB1 * 1024 + c); xB[j] = *(const u32x2*)(XL + (size_t)rb * 1024 + c); }
#pragma unroll
        for (int half = 0; half < 2; ++half) {
            if (half == 1 && !hasB) break;
            const int row = half ? rowB : rowA; const float w0 = half ? wB0 : wA0, w1 = half ? wB1 : wA1;
            const float* g5 = mod + (l * 5 + modrow(row)) * 6144 + 5 * 1024;
            f32x4 v[4];
#pragma unroll
            for (int j = 0; j < 4; ++j) { const int c = 4 * lane + 256 * j;
                const u32x2 a = half ? yB0[j] : yA0[j], b2 = half ? yB1[j] : yA1[j];
                f32x4 y; y[0] = w0 * lo16(a.x) + w1 * lo16(b2.x); y[1] = w0 * hi16(a.x) + w1 * hi16(b2.x); y[2] = w0 * lo16(a.y) + w1 * lo16(b2.y); y[3] = w0 * hi16(a.y) + w1 * hi16(b2.y);
                const u32x2 xr = half ? xB[j] : xA[j];
                v[j] = (f32x4){lo16(xr.x), hi16(xr.x), lo16(xr.y), hi16(xr.y)} + *(const f32x4*)(g5 + c) * y; }
            if (l == 0) {
#pragma unroll
                for (int j = 0; j < 4; ++j) *(u32x2*)(XL + (size_t)row * 1024 + 4 * lane + 256 * j) = pack4(v[j]);
                const float* mr = mod + (5 + modrow(row)) * 6144;
                norm_mod_row(v, p.g_mix + 1024, mr, mr + 1024, lane);
                store_row_bf16((bf16_t*)(p.ws + WS_H) + (size_t)row * 1024, v, lane);
            } else {
                norm_mod_row(v, p.g_final, nullptr, nullptr, lane);
                float* o = p.out + (size_t)(row - MC) * 1024;
#pragma unroll
                for (int j = 0; j < 4; ++j) *(f32x4*)(o + 4 * lane + 256 * j) = v[j];
            }
        }
    }
}

constexpr int NPH_L = 12, NPHASES = 1 + 2 * NPH_L;
__device__ __forceinline__ void run_phase(const Params& p, int ph, unsigned char* lds) {
    const int bid = blockIdx.x, nb = gridDim.x;
    const int wave = tid_fresh() >> 6;
#ifndef ONLY_S
    if (ph == 0) { phase_pre(p, lds, bid, nb); return; }
#else
    if (ph == 0) { if (ONLY_S == 99) phase_pre(p, lds, bid, nb); return; }
#endif
    const int l = (ph - 1) / NPH_L, s = (ph - 1) % NPH_L;
    unsigned char* ws = p.ws;
    const int pm0 = l == 0 ? 0 : 4, nMrows = l == 0 ? 68 : 64, row_lo = l == 0 ? 0 : MC;
#ifdef ONLY_S
    if (s != ONLY_S) return;
#endif
    switch (s) {
    case 0: if (l == 0) phase_norm1(p, bid, nb); break;
    case 1: { EpiInproj E{ws};
              if (l == 0) { SchedGrid S{(const bf16_t*)(ws + WS_H), (const bf16_t*)(ws + WS_WIN), 1024, 1024, 0, 68, 45, nb, bid}; gemm_run(lds, S, E, 1024, 1024, 1024, 1); }
              else { SchedInproj1 S{(const bf16_t*)(ws + WS_H), (const bf16_t*)(ws + WS_WIN), nb, bid}; gemm_run(lds, S, E, 1024, 1024, 1024, 1); } } break;
    case 2: { { ConvW Wq, Wk; int whd = -1; const int d0 = (tid_fresh() & 31) * 8;
                for (int v = (bid * 1088) / nb; v < ((bid + 1) * 1088) / nb; ++v) { const int hd = v / 272, it = (v % 272) * 4 + hd;
                    if (hd != whd) { conv_load_w(p.mconv_w + (size_t)l * 4 * 2048, p.mconv_b + (size_t)l * 2048, hd * 256 + d0, Wq); conv_load_w(p.mconv_w + (size_t)l * 4 * 2048, p.mconv_b + (size_t)l * 2048, 1024 + hd * 256 + d0, Wk); whd = hd; }
                    conv_m_item(p, l, it, (LAS unsigned char*)lds, Wq, Wk); } }
              { ConvW Wbc, Wx; int wg = -1; const int cs = tid_fresh() & 31;
                for (int v = (bid * 1088) / nb; v < ((bid + 1) * 1088) / nb; ++v) { const int grp = v / 272, it = (v % 272) * 4 + grp;
                    if (grp != wg) { conv_load_w(p.sconv_w + (size_t)l * 4 * 2048, p.sconv_b + (size_t)l * 2048, 1024 + (cs >> 4) * 512 + grp * 128 + (cs & 15) * 8, Wbc); conv_load_w(p.sconv_w + (size_t)l * 4 * 2048, p.sconv_b + (size_t)l * 2048, grp * 256 + cs * 8, Wx); wg = grp; }
                    conv_s_item(p, l, it, (LAS unsigned char*)lds, Wbc, Wx); } }
              if (!p.dup) for (int it = bid; it < (l == 0 ? 272 : 256); it += nb) pool_window_item(p, it, (LAS unsigned char*)lds); } break;
    case 3: {
              int pool_c = bid, pool_g = nb;
              if (nb == 256) { const int x = bid & 7, y = bid >> 3;
                  if (y < 16) { mlstm_chunk_item(p, l, (((y >> 3) * 8 + x) << 3) | (y & 7), (LAS unsigned char*)lds); pool_c = -1; }
                  else { ssd_chunk_item(p, l, ((((y - 16) >> 3) * 8 + x) << 3) | ((y - 16) & 7), (LAS unsigned char*)lds); pool_c = (y - 16) * 8 + x; pool_g = 128; } }
              else { for (int it = bid; it < 256; it += nb) { if (it < 128) mlstm_chunk_item(p, l, it, (LAS unsigned char*)lds); else ssd_chunk_item(p, l, it - 128, (LAS unsigned char*)lds); } }
              if (pool_c >= 0 && !p.dup) { SchedPool S{(const bf16_t*)(ws + WS_BR), (const bf16_t*)(ws + WS_WPOOL), pm0, nMrows, pool_g, pool_c}; EpiPool E{(bf16_t*)(ws + WS_BR)};
                  gemm_run(lds, S, E, 256, 3072, 256, 1); } } break;
    case 4: { mlstm_finish_rows(p, l, row_lo, bid * 8 + wave, nb * 8); ssd_finish_rows(p, l, row_lo, bid * 8 + wave, nb * 8); } break;
    case 5: { SchedGrid S{(const bf16_t*)(ws + WS_BR), (const bf16_t*)(ws + WS_WBR), 3072, 3072, pm0, nMrows, 4, nb, bid}; EpiBranch E{(const bf16_t*)(ws + WS_MG), (bf16_t*)(ws + WS_MERGED)};
              gemm_run(lds, S, E, 3072, 3072, 3072, 3); } break;
    case 6: { SchedGrid S{(const bf16_t*)(ws + WS_MERGED), (const bf16_t*)(ws + WS_WOUT), 1024, 1024, pm0, nMrows, 4, nb, bid}; EpiOut E{(bf16_t*)(ws + WS_OL)};
              gemm_run(lds, S, E, 1024, 1024, 1024, 1); } break;
    case 7: phase_route(p, l, lds, bid, nb); break;
    case 8: phase_scatter(p, l, lds, bid, nb); break;
    case 9: { const int* BE = (const int*)(ws + WS_BLKEXP);
              SchedMoe S{(const bf16_t*)(ws + WS_H), (const bf16_t*)(ws + WS_EW1), BE, (const int*)(ws + WS_TOK), 1024, BE[200], nb, bid, (size_t)1048576, (size_t)1024}; EpiMoe1 E{(bf16_t*)(ws + WS_ACT)};
              gemm_run<true>(lds, S, E, 1024, 1024, 1024, 1); } break;
    case 10: { const int* BE = (const int*)(ws + WS_BLKEXP);
              SchedMoe S{(const bf16_t*)(ws + WS_ACT), (const bf16_t*)(ws + WS_EW2), BE, nullptr, 512, BE[200], nb, bid, (size_t)524288, (size_t)512}; EpiMoe2 E{(bf16_t*)(ws + WS_Y)};
              gemm_run(lds, S, E, 512, 512, 512, 1); } break;
    case 11: phase_combine(p, l, bid, nb); break;
    }
}

#define XB_TMO      128
#define XB_XCNT(j)  (256  + 64 * (j))
#define XB_XSUB(j)  (1280 + 64 * (j))
#define XB_XGEN(j)  (2304 + 64 * (j))
#define XB_TOP      3328
#define XB_TOPGEN   3392
#define XCD_BAR_WORDS 3456
#define XB_SPIN_CAP (1u << 18)
__device__ __forceinline__ unsigned xb_ld(unsigned* p)              { return __hip_atomic_load(p, __ATOMIC_RELAXED, __HIP_MEMORY_SCOPE_AGENT); }
__device__ __forceinline__ unsigned xb_add(unsigned* p, unsigned v) { return __hip_atomic_fetch_add(p, v, __ATOMIC_RELAXED, __HIP_MEMORY_SCOPE_AGENT); }
__device__ __forceinline__ unsigned xb_xcc_id() { return (unsigned)__builtin_amdgcn_s_getreg((3 << 11) | 20) & 0xFu; }
#define XB_SPIN(cond, bar) do { unsigned _sp = 0; while (cond) { __builtin_amdgcn_s_sleep(1); \
    if ((++_sp & 255u) == 0u) { if (xb_ld(&(bar)[XB_TMO])) break; if (_sp > XB_SPIN_CAP) { atomicAdd(&(bar)[XB_TMO], 1u); break; } } } } while (0)
__device__ __forceinline__ void xcd_barrier_complete(unsigned* bar, unsigned x, unsigned& nloc, unsigned& nx) {
    const unsigned G = gridDim.x * gridDim.y * gridDim.z;
    unsigned sum, cnt, mine, sp = 0u;
    for (;;) {
        sum = 0u; cnt = 0u; mine = 0u;
#pragma unroll
        for (unsigned j = 0; j < 16; ++j) { const unsigned c = xb_ld(&bar[XB_XCNT(j)]); sum += c; cnt += (c > 0u) ? 1u : 0u; mine = (j == x) ? c : mine; }
        if (sum == G) break;
        __builtin_amdgcn_s_sleep(1);
        if ((++sp & 255u) == 0u) { if (xb_ld(&bar[XB_TMO])) break; if (sp > XB_SPIN_CAP) { atomicAdd(&bar[XB_TMO], 1u); break; } }
    }
    nloc = mine > 0u ? mine : 1u; nx = cnt > 0u ? cnt : 1u;
}
__device__ __forceinline__ void xcd_barrier(unsigned* bar, volatile LAS unsigned* st) {
    asm volatile("s_waitcnt vmcnt(0)" ::: "memory");
    __syncthreads();
    if (threadIdx.x == 0) {
        __builtin_amdgcn_s_waitcnt(0);
        const unsigned x = xb_xcc_id();
        unsigned nloc = st[0], nx = st[1];
        if (nloc == 0u) { xcd_barrier_complete(bar, x, nloc, nx); st[0] = nloc; st[1] = nx; }
        const unsigned old = xb_add(&bar[XB_XSUB(x)], 1u);
        const unsigned gen = old / nloc;
        if (old + 1u == (gen + 1u) * nloc) {
            __builtin_amdgcn_fence(__ATOMIC_RELEASE, "agent");
            asm volatile("s_waitcnt vmcnt(0)" ::: "memory");
            const unsigned og = xb_add(&bar[XB_TOP], 1u);
            const unsigned tg = og / nx;
            if (og + 1u == (tg + 1u) * nx) xb_add(&bar[XB_TOPGEN], 1u);
            else XB_SPIN(xb_ld(&bar[XB_TOPGEN]) == tg, bar);
            __builtin_amdgcn_fence(__ATOMIC_ACQUIRE, "agent");
            xb_add(&bar[XB_XGEN(x)], 1u);
            asm volatile("s_waitcnt vmcnt(0)" ::: "memory");
        } else {
            XB_SPIN(xb_ld(&bar[XB_XGEN(x)]) == gen, bar);
            __builtin_amdgcn_fence(__ATOMIC_ACQUIRE, "agent");
            asm volatile("s_waitcnt vmcnt(0)" ::: "memory");
        }
    }
    __syncthreads();
}

constexpr int BAR_LDS_OFF = LDS_BYTES - 16;
__global__ void __launch_bounds__(NTHR, 2) fwd_kernel(Params pk) {
    extern __shared__ __attribute__((aligned(16))) unsigned char lds[];
    const Params& p = pk;
    const int lo = pk.ph_lo, hi = pk.ph_hi;
    unsigned* bar = (unsigned*)(pk.ws + WS_BAR);
    volatile LAS unsigned* bst = (volatile LAS unsigned*)((LAS unsigned char*)lds + BAR_LDS_OFF);
    if (hi - lo > 1) {
        if (threadIdx.x == 0) { bst[0] = 0u; bst[1] = 0u; (void)xb_add(&bar[XB_XCNT(xb_xcc_id())], 1u); }
        __syncthreads();
    }
#define STEP(k) if (lo <= (k) && (k) < hi) { \
    if (PROF_S >= 0 && blockIdx.x == 0 && threadIdx.x == 0) ((volatile LAS unsigned long long*)((LAS unsigned char*)lds + 163000))[k] = __builtin_amdgcn_s_memrealtime(); \
    run_phase(p, (k), lds); if ((k) + 1 < hi) { if (pk.dup < 0) cg::this_grid().sync(); else xcd_barrier(bar, bst); } }
    STEP(0) STEP(1) STEP(2) STEP(3) STEP(4) STEP(5) STEP(6) STEP(7) STEP(8) STEP(9) STEP(10) STEP(11) STEP(12)
    STEP(14) STEP(15) STEP(16) STEP(17) STEP(18) STEP(19) STEP(20) STEP(21) STEP(22) STEP(23) STEP(24)
#undef STEP
    if (PROF_S >= 0 && hi - lo > 1) {
        __syncthreads();
        if (blockIdx.x == 0 && threadIdx.x == 0) {
            volatile LAS unsigned long long* ts = (volatile LAS unsigned long long*)((LAS unsigned char*)lds + 163000);
            const unsigned long long tend = __builtin_amdgcn_s_memrealtime();
            float acc = 0.f;
            for (int k = 0; k < NPHASES; ++k) { if (k == 1 + NPH_L) continue; const int s = k == 0 ? 14 : (k - 1) % NPH_L; if (s != PROF_S) continue;
                int kn = k + 1; if (kn == 1 + NPH_L) kn++; const unsigned long long t1 = kn < NPHASES ? ts[kn] : tend; acc += (float)(t1 - ts[k]) * 0.001f; }
            __threadfence(); atomicAdd(pk.out, acc);
        }
    }
}

extern "C" void kernel_launch(void* const* d_in, const int* in_sizes, int n_in, void* d_out, int out_size, void* d_ws, size_t ws_size, hipStream_t stream) {
    static int grid_blocks = 0;
    if (!grid_blocks) {
        if (n_in != 31 || ws_size < WS_END) { fprintf(stderr, "kernel_launch: unexpected n_in %d / ws_size %zu (need %zu)\n", n_in, ws_size, (size_t)WS_END); grid_blocks = -1; return; }
        int dev = 0, cus = 0, per_cu = 0;
        hipGetDevice(&dev);
        hipDeviceGetAttribute(&cus, hipDeviceAttributeMultiprocessorCount, dev);
        if (hipFuncSetAttribute((const void*)fwd_kernel, hipFuncAttributeMaxDynamicSharedMemorySize, LDS_BYTES) != hipSuccess) fprintf(stderr, "kernel_launch: hipFuncSetAttribute failed\n");
        hipOccupancyMaxActiveBlocksPerMultiprocessor(&per_cu, (const void*)fwd_kernel, NTHR, LDS_BYTES);
        if (per_cu < 1) { fprintf(stderr, "kernel_launch: occupancy query says %d blocks per CU\n", per_cu); per_cu = 1; }
        grid_blocks = cus * per_cu;
        (void)hipGetLastError();
    }
    if (grid_blocks < 0) return;
    Params p{};
    const float** dst = (const float**)&p;
    for (int i = 0; i < 31; ++i) dst[i] = (const float*)d_in[i];
    p.out = (float*)d_out; p.ws = (unsigned char*)d_ws;
#if SINGLE_LAUNCH
    if (hipMemsetAsync((char*)d_ws + WS_BAR, 0, 16384, stream) != hipSuccess) fprintf(stderr, "kernel_launch: hipMemsetAsync failed\n");
    p.ph_lo = 0; p.ph_hi = NPHASES;
    void* args[] = {&p};
    hipError_t e = hipLaunchCooperativeKernel((const void*)fwd_kernel, dim3(grid_blocks), dim3(NTHR), args, LDS_BYTES, stream);
    if (e != hipSuccess) fprintf(stderr, "cooperative launch failed: %s (grid %d)\n", hipGetErrorString(e), grid_blocks);
#else
    for (int ph = 0; ph < NPHASES; ++ph) {
        if (ph == 1 + NPH_L) continue;
        p.ph_lo = ph; p.ph_hi = ph + 1;
        hipLaunchKernelGGL(fwd_kernel, dim3(grid_blocks), dim3(NTHR), LDS_BYTES, stream, p);
        const int sidx = ph == 0 ? 14 : (ph - 1) % NPH_L;
        if ((PROBE_DUP_MASK >> sidx) & 1) { p.dup = 1; for (int r = 0; r < PROBE_DUP_N; ++r) hipLaunchKernelGGL(fwd_kernel, dim3(grid_blocks), dim3(NTHR), LDS_BYTES, stream, p); p.dup = 0; }
    }
#endif
}
```

```cpp
#include <hip/hip_runtime.h>
#include <hip/hip_cooperative_groups.h>
#include <cstdio>
namespace cg = cooperative_groups;

#ifndef SINGLE_LAUNCH
#define SINGLE_LAUNCH 1
#endif
#ifndef PROBE_DUP_MASK
#define PROBE_DUP_MASK 0
#endif
#ifndef PROBE_DUP_N
#define PROBE_DUP_N 1
#endif
#ifndef USE_MLSTM_CHUNK
#define USE_MLSTM_CHUNK 1
#endif
#ifndef USE_SSD_CHUNK
#define USE_SSD_CHUNK 1
#endif
#ifndef CV_IN_SCAN
#define CV_IN_SCAN 0
#endif
#ifndef PROF_S
#define PROF_S (-1)
#endif
#ifndef CONVDUP
#define CONVDUP 0
#endif
#ifndef INPROJ_WGM
#define INPROJ_WGM 4
#endif
#ifndef USE_MFMA_GEMM
#define USE_MFMA_GEMM 1
#endif

typedef unsigned short bf16_t;
typedef float f32x4 __attribute__((ext_vector_type(4)));
typedef unsigned u32x4 __attribute__((ext_vector_type(4)));
typedef unsigned u32x2 __attribute__((ext_vector_type(2)));

constexpr int NTHR = 512;
constexpr int D = 1024, NB = 4, SEQ = 4096, CTXL = 256;
constexpr int MC = NB * CTXL;
constexpr int ML = NB * SEQ;
constexpr int MT = MC + ML;
constexpr int DIN = 11312, NPAD = 11520;
constexpr int NE = 32, DE = 512;
constexpr int CAP = 43008;
constexpr float EPS = 1e-6f;
constexpr int LDS_BYTES = 163840;

constexpr size_t MiB = 1u << 20;
constexpr size_t WS_HIST = 0;
constexpr size_t WS_BLKEXP = 64 * 1024;
constexpr size_t WS_BAR = 128 * 1024;
constexpr size_t WS_TOK = 256 * 1024;
constexpr size_t WS_MOD = 1 * MiB;
constexpr size_t WS_GA = 2 * MiB;
constexpr size_t WS_DT = 4 * MiB;
constexpr size_t WS_EID = 7 * MiB;
constexpr size_t WS_EWT = 7 * MiB + 256 * 1024;
constexpr size_t WS_SLOT = 7 * MiB + 512 * 1024;
constexpr size_t WS_WIN = 8 * MiB;
constexpr size_t WS_WPOOL = 31 * MiB;
constexpr size_t WS_WBR = 32 * MiB;
constexpr size_t WS_WOUT = 38 * MiB;
constexpr size_t WS_XL = 40 * MiB;
constexpr size_t WS_H = 108 * MiB;
constexpr size_t WS_BR = 142 * MiB;
constexpr size_t WS_Q = 244 * MiB, WS_K = 278 * MiB, WS_V = 312 * MiB;
constexpr size_t WS_SX = 346 * MiB, WS_SB = 380 * MiB, WS_SC = 397 * MiB;
constexpr size_t WS_MG = 414 * MiB;
constexpr size_t WS_HF = 516 * MiB, WS_HB = 550 * MiB;
constexpr size_t WS_VT = 584 * MiB;
constexpr size_t WS_END = 618 * MiB;
constexpr size_t WS_MGA = WS_WIN, WS_MGC = WS_WIN + 576 * 1024, WS_MGP = WS_WIN + 1152 * 1024;
constexpr size_t WS_SACS = WS_WIN + 2 * MiB, WS_SDT = WS_WIN + 5 * MiB;
constexpr size_t WS_QC = WS_H, WS_KC = WS_HF, WS_KCT = WS_HB;
constexpr size_t WS_HF2 = WS_Q, WS_HB2 = WS_K;
constexpr size_t WS_XCT = WS_HB;
constexpr size_t WS_BC = WS_VT, WS_CC = WS_VT + 17 * MiB;
constexpr size_t WS_OL = WS_HF;
constexpr size_t WS_YF = WS_SX, WS_YB = WS_SB;
constexpr size_t WS_MERGED = WS_H;
constexpr size_t WS_EW1 = 244 * MiB;
constexpr size_t WS_EW2 = 308 * MiB;
constexpr size_t WS_XB = WS_BR;
constexpr size_t WS_ACT = WS_SX;
constexpr size_t WS_Y = WS_MG;

struct Params {
    const float *x, *c, *ctx, *c_ctx, *w_ada, *b_ada, *g_mix, *g_ffn, *w_in, *pool_w, *pool_scale,
        *mconv_w, *mconv_b, *mgate_b, *mnorm_g, *sconv_w, *sconv_b, *sdt_bias, *sa_log, *sd, *snorm_g,
        *w_branch, *w_out, *w_rg, *b_rg, *w_re, *b_re, *w_eg, *w_eu, *w_ed, *g_final;
    float* out; unsigned char* ws; int ph_lo, ph_hi, dup, pad;
};

__device__ __forceinline__ int tid_fresh() { int t = threadIdx.x; asm volatile("" : "+v"(t)); return t; }
__device__ __forceinline__ float bf2f(unsigned b) { return __uint_as_float(b << 16); }
__device__ __forceinline__ unsigned f2bf(float f) { unsigned u = __float_as_uint(f); return (u + 0x7fffu + ((u >> 16) & 1u)) >> 16; }
typedef __bf16 bf16x2_t __attribute__((ext_vector_type(2)));
typedef float f32x2_t __attribute__((ext_vector_type(2)));
__device__ __forceinline__ unsigned pk2(float lo, float hi) { const f32x2_t v = {lo, hi}; return __builtin_bit_cast(unsigned, __builtin_convertvector(v, bf16x2_t)); }
__device__ __forceinline__ float lo16(unsigned w) { return __uint_as_float(w << 16); }
__device__ __forceinline__ float hi16(unsigned w) { return __uint_as_float(w & 0xffff0000u); }
__device__ __forceinline__ float wave_sum(float v) {
#pragma unroll
    for (int o = 1; o < 64; o <<= 1) v += __shfl_xor(v, o);
    return v;
}
__device__ __forceinline__ float sigmoid_f(float x) { return __builtin_amdgcn_rcpf(1.f + __expf(-x)); }
__device__ __forceinline__ float silu_f(float x) { return x * __builtin_amdgcn_rcpf(1.f + __expf(-x)); }
__device__ __forceinline__ float softplus_f(float x) { return fmaxf(x, 0.f) + log1pf(__expf(-fabsf(x))); }
__device__ __forceinline__ float logsigmoid_f(float x) { return fminf(x, 0.f) - log1pf(__expf(-fabsf(x))); }
__device__ __forceinline__ void unpack8(u32x4 w, float* f) {
    f[0] = lo16(w.x); f[1] = hi16(w.x); f[2] = lo16(w.y); f[3] = hi16(w.y);
    f[4] = lo16(w.z); f[5] = hi16(w.z); f[6] = lo16(w.w); f[7] = hi16(w.w);
}
__device__ __forceinline__ u32x4 pack8(f32x4 a, f32x4 b) {
    u32x4 w; w.x = pk2(a[0], a[1]); w.y = pk2(a[2], a[3]); w.z = pk2(b[0], b[1]); w.w = pk2(b[2], b[3]); return w;
}
__device__ __forceinline__ int scanrow(int row) {
    if (row < MC) return row;
    const int r = row - MC, b = r >> 12, t = r & 4095;
    return MC + (b << 12) + ((t & 63) << 6) + (t >> 6);
}
__device__ __forceinline__ int modrow(int row) { return row < MC ? 4 : ((row - MC) >> 12); }

struct Unit { const bf16_t* A; const bf16_t* B; const int* tok; int pm, pn; };

template <int WGM = 8>
__device__ __forceinline__ void tile_order(int L, int nM, int nN, int& pm, int& pn) {
    const int nwg = nM * nN; int wgid = L;
    { const int q = nwg / 8, r = nwg % 8, xcd = wgid % 8, off = wgid / 8; wgid = (xcd < r ? xcd * (q + 1) : r * (q + 1) + (xcd - r) * q) + off; }
    const int nig = WGM * nN, gid = wgid / nig, fm = gid * WGM, gsz = (nM - fm) < WGM ? (nM - fm) : WGM;
    pm = fm + ((wgid % nig) % gsz); pn = (wgid % nig) / gsz;
}
struct SchedGrid {
    const bf16_t* A; const bf16_t* B; int lda, ldb, pm0, nM, nN, G, c;
    __device__ __forceinline__ bool next(int i, Unit& u) const {
        const long L = (long)i * G + c; if (L >= (long)nM * nN) return false;
        int pm, pn; if (nN == 45) tile_order<INPROJ_WGM>((int)L, nM, nN, pm, pn); else tile_order<8>((int)L, nM, nN, pm, pn); pm += pm0;
        u.pm = pm; u.pn = pn; u.tok = nullptr; u.A = A + (size_t)pm * 256 * lda; u.B = B + (size_t)pn * 256 * ldb; return true;
    }
};
struct SchedInproj1 {
    const bf16_t* A; const bf16_t* B; int G, c;
    __device__ __forceinline__ bool next(int i, Unit& u) const {
        const long L = (long)i * G + c; if (L >= 2880 + 84) return false;
        int pm, pn;
        if (L < 2880) { tile_order<INPROJ_WGM>((int)L, 64, 45, pm, pn); pm += 4; }
        else { const int idx = (int)L - 2880, k = idx % 21; pm = idx / 21; pn = k < 12 ? 4 + k : (k < 16 ? 20 + (k - 12) : (k < 20 ? 28 + (k - 16) : 44)); }
        u.pm = pm; u.pn = pn; u.tok = nullptr; u.A = A + (size_t)pm * 256 * 1024; u.B = B + (size_t)pn * 256 * 1024; return true;
    }
};
struct SchedPool {
    const bf16_t* A; const bf16_t* B; int pm0, nM, G, c;
    __device__ __forceinline__ bool next(int i, Unit& u) const {
        const long L = (long)i * G + c; if (L >= (long)nM * 4) return false;
        const int pm = pm0 + (int)(L >> 2), g = (int)(L & 3);
        u.pm = pm; u.pn = g; u.tok = nullptr; u.A = A + (size_t)pm * 256 * 3072 + g * 256; u.B = B + (size_t)g * 65536; return true;
    }
};
struct SchedMoe {
    const bf16_t* A; const bf16_t* B; const int* blkexp; const int* tok; int lda, nblk, G, c; size_t bexp_stride, ldb;
    __device__ __forceinline__ bool next(int i, Unit& u) const {
        const long L = (long)i * G + c; if (L >= (long)nblk * 4) return false;
        const int blk = (int)(L >> 2), nt = (int)(L & 3); const int e = blkexp[blk];
        u.pm = blk; u.pn = nt; u.tok = tok ? tok + blk * 256 : nullptr; u.A = tok ? A : A + (size_t)blk * 256 * lda;
        u.B = B + (size_t)e * bexp_stride + (size_t)nt * 256 * ldb; return true;
    }
};

struct EpiInproj {
    unsigned char* ws;
    __device__ __forceinline__ void seg(const Unit& u, int, int r, int c0, f32x4& lo0, f32x4& lo1, f32x4& hi0, f32x4& hi1) const {
        const int row = u.pm * 256 + r, t = u.pn;
        bf16_t* dst; size_t ld; int cb;
        if (t < 4) { dst = (bf16_t*)(ws + WS_BR) + (size_t)row * 3072; cb = t * 256; }
        else if (t < 16) { const int w = (t - 4) >> 2; dst = (bf16_t*)(ws + WS_Q + (size_t)w * 34 * MiB) + (size_t)scanrow(row) * 1024; cb = ((t - 4) & 3) * 256; }
        else if (t < 20) { dst = (bf16_t*)(ws + WS_BR) + (size_t)row * 3072 + 1024; cb = (t - 16) * 256; }
        else if (t < 24) { dst = (bf16_t*)(ws + WS_SX) + (size_t)row * 1024; cb = (t - 20) * 256; }
        else if (t < 28) { dst = (bf16_t*)(ws + WS_BR) + (size_t)row * 3072 + 2048; cb = (t - 24) * 256; }
        else if (t < 30) { dst = (bf16_t*)(ws + WS_SB) + (size_t)row * 512; cb = (t - 28) * 256; }
        else if (t < 32) { dst = (bf16_t*)(ws + WS_SC) + (size_t)row * 512; cb = (t - 30) * 256; }
        else if (t < 44) {
            dst = (bf16_t*)(ws + WS_MG) + (size_t)row * 3072; cb = (t - 32) * 256;
#pragma unroll
            for (int j = 0; j < 4; ++j) { lo0[j] = sigmoid_f(lo0[j]); lo1[j] = sigmoid_f(lo1[j]); hi0[j] = sigmoid_f(hi0[j]); hi1[j] = sigmoid_f(hi1[j]); }
        } else {
            if (c0 < 32) { float* d = (float*)(ws + WS_DT) + (size_t)row * 32 + c0; *(f32x4*)d = lo0; *(f32x4*)(d + 4) = lo1; }
            else if (c0 < 48) { float* d = (float*)(ws + WS_GA) + (size_t)scanrow(row) * 16 + (c0 - 32); *(f32x4*)d = lo0; *(f32x4*)(d + 4) = lo1; }
            return;
        }
        *(u32x4*)(dst + cb + c0) = pack8(lo0, lo1);
        *(u32x4*)(dst + cb + 128 + c0) = pack8(hi0, hi1);
    }
};
struct EpiPool {
    bf16_t* BR;
    __device__ __forceinline__ void seg(const Unit& u, int, int r, int c0, f32x4& lo0, f32x4& lo1, f32x4& hi0, f32x4& hi1) const {
        bf16_t* d = BR + (size_t)(u.pm * 256 + r) * 3072 + u.pn * 256 + c0;
        *(u32x4*)d = pack8(lo0, lo1);
        *(u32x4*)(d + 128) = pack8(hi0, hi1);
    }
};
struct EpiBranch {
    const bf16_t* MG; bf16_t* OUT;
    static constexpr bool PRELOAD = true;
    __device__ __forceinline__ void load(const Unit& u, int sg, int r, int c0, u32x4 (&b)[4]) const {
        const bf16_t* g = MG + (size_t)(u.pm * 256 + r) * 3072 + sg * 1024 + u.pn * 256 + c0;
        const int nx = sg < 2 ? 1024 : 0;
        b[0] = *(const u32x4*)g; b[1] = *(const u32x4*)(g + 128); b[2] = *(const u32x4*)(g + nx); b[3] = *(const u32x4*)(g + nx + 128);
    }
    __device__ __forceinline__ void apply(const Unit& u, int sg, int r, int c0, const u32x4 (&bb)[4], f32x4& lo0, f32x4& lo1, f32x4& hi0, f32x4& hi1) const {
        float a[8], b[8], a2[8], b2[8]; unpack8(bb[0], a); unpack8(bb[1], b); unpack8(bb[2], a2); unpack8(bb[3], b2);
        if (sg < 2) {
#pragma unroll
            for (int j = 0; j < 8; ++j) { a[j] = a[j] * __builtin_amdgcn_rcpf(a2[j]); b[j] = b[j] * __builtin_amdgcn_rcpf(b2[j]); } }
#pragma unroll
        for (int j = 0; j < 4; ++j) { lo0[j] *= a[j]; lo1[j] *= a[4 + j]; hi0[j] *= b[j]; hi1[j] *= b[4 + j]; }
        if (sg == 2) { bf16_t* d = OUT + (size_t)(u.pm * 256 + r) * 1024 + u.pn * 256 + c0; *(u32x4*)d = pack8(lo0, lo1); *(u32x4*)(d + 128) = pack8(hi0, hi1); }
    }
    __device__ __forceinline__ void seg(const Unit&, int, int, int, f32x4&, f32x4&, f32x4&, f32x4&) const {}
};
struct EpiOut {
    bf16_t* OL;
    __device__ __forceinline__ void seg(const Unit& u, int, int r, int c0, f32x4& lo0, f32x4& lo1, f32x4& hi0, f32x4& hi1) const {
        bf16_t* d = OL + (size_t)(u.pm * 256 + r) * 1024 + u.pn * 256 + c0;
        *(u32x4*)d = pack8(lo0, lo1); *(u32x4*)(d + 128) = pack8(hi0, hi1);
    }
};
struct EpiMoe1 {
    bf16_t* ACT;
    __device__ __forceinline__ void seg(const Unit& u, int, int r, int c0, f32x4& lo0, f32x4& lo1, f32x4& hi0, f32x4& hi1) const {
        const int row = u.pm * 256 + r;
        f32x4 a, b;
#pragma unroll
        for (int j = 0; j < 4; ++j) { a[j] = silu_f(lo0[j]) * hi0[j]; b[j] = silu_f(lo1[j]) * hi1[j]; }
        *(u32x4*)(ACT + (size_t)row * 512 + u.pn * 128 + c0) = pack8(a, b);
    }
};
struct EpiMoe2 {
    bf16_t* Y;
    __device__ __forceinline__ void seg(const Unit& u, int, int r, int c0, f32x4& lo0, f32x4& lo1, f32x4& hi0, f32x4& hi1) const {
        bf16_t* d = Y + (size_t)(u.pm * 256 + r) * 1024 + u.pn * 256 + c0;
        *(u32x4*)d = pack8(lo0, lo1); *(u32x4*)(d + 128) = pack8(hi0, hi1);
    }
};

template <class E, class = void> struct epi_preload { static constexpr bool value = false; };
template <class E> struct epi_preload<E, decltype((void)E::PRELOAD)> { static constexpr bool value = E::PRELOAD; };

#define LAS __attribute__((address_space(3)))
typedef short bf16x8 __attribute__((ext_vector_type(8)));
constexpr int HTB = 128 * 64 * 2;
__device__ __forceinline__ int lds_byte(int r, int c) { const int st = (r >> 4) * 2 + (c >> 5), rr = r & 15, cc = c & 31, ob = rr * 64 + cc * 2; return st * 1024 + (ob ^ (((ob >> 9) & 1) << 5)); }
__device__ __forceinline__ void stage_rc(int b, int& R, int& C) { const int st = b / 1024, sb = b % 1024, swz = sb ^ (((sb >> 9) & 1) << 5); R = (st >> 1) * 16 + swz / 64; C = (st & 1) * 32 + (swz % 64) / 2; }
__device__ __forceinline__ int perm32(int rho) { const int n = rho >> 4, i = rho & 15; return 8 * (i >> 2) + 4 * n + (i & 3); }

template <bool GATHER, class Sched, class Epi>
__device__ __forceinline__ void gemm_mfma(LAS unsigned char* lds, const Sched& S, const Epi& E, const int K, const int lda, const int ldb, const int nseg) {
    const int tid = tid_fresh(), wid = __builtin_amdgcn_readfirstlane(tid >> 6), lane = tid & 63, wr = wid >> 2, wc = wid & 3, fr = lane & 15, fq = lane >> 4;
    const int nt = K / 64, tseg = nt / nseg;
    unsigned vA0[2], vA1[2], nA0[2], nA1[2], voffB[2]; int rowA[2], colA[2];
#pragma unroll
    for (int i = 0; i < 2; ++i) { int R, C; stage_rc(tid * 16 + i * 8192, R, C); const int Rb = (R & ~31) + perm32(R & 31);
        rowA[i] = R; colA[i] = C;
        vA0[i] = (unsigned)(R * lda + C) * 2u; vA1[i] = vA0[i] + (unsigned)(128 * lda * 2); nA0[i] = vA0[i]; nA1[i] = vA1[i];
        voffB[i] = (unsigned)(Rb * ldb + C) * 2u; }
    const size_t kstep = 128;
    const size_t hstepB = (size_t)128 * ldb * 2;
    const unsigned ldsw = (unsigned)wid * 1024u;
    const int aoff = lds_byte(wr * 64 + fr, fq * 8), boff = lds_byte(wc * 32 + fr, fq * 8);
#define PG8_SA(b, h) (((b) * 2 + (h)) * HTB)
#define PG8_SB(b, h) ((4 + (b) * 2 + (h)) * HTB)
#define PG8_STAGE(bufoff, gbase, voff) do { _Pragma("unroll") for (int _i = 0; _i < 2; ++_i) \
        __builtin_amdgcn_global_load_lds((const unsigned*)((const char*)(gbase) + (voff)[_i]), (LAS unsigned*)(lds + (bufoff) + ldsw + _i * 8192), 16, 0, 0); } while (0)
#define PG8_LDA(dst, b, h) do { _Pragma("unroll") for (int m = 0; m < 4; ++m) _Pragma("unroll") for (int k = 0; k < 2; ++k) dst[m][k] = *(const LAS bf16x8*)(lds + PG8_SA(b, h) + aoff + m * 2048 + k * 1024); } while (0)
#define PG8_LDB(dst, b, h) do { _Pragma("unroll") for (int n = 0; n < 2; ++n) _Pragma("unroll") for (int k = 0; k < 2; ++k) dst[n][k] = *(const LAS bf16x8*)(lds + PG8_SB(b, h) + boff + n * 2048 + k * 1024); } while (0)
#define PG8_MMA(ai, bj, At, Bt) do { __builtin_amdgcn_s_setprio(1); _Pragma("unroll") for (int m = 0; m < 4; ++m) _Pragma("unroll") for (int n = 0; n < 2; ++n) _Pragma("unroll") for (int k = 0; k < 2; ++k) \
        acc[ai][bj][m][n] = __builtin_amdgcn_mfma_f32_16x16x32_bf16(Bt[n][k], At[m][k], acc[ai][bj][m][n], 0, 0, 0); __builtin_amdgcn_s_setprio(0); } while (0)
#define PG8_WAIT_V(n) asm volatile("s_waitcnt vmcnt(" #n ")" ::: "memory")
#define PG8_WAIT_L(n) asm volatile("s_waitcnt lgkmcnt(" #n ")" ::: "memory")
#define PG8_BAR __builtin_amdgcn_s_barrier()
#define PG8_SCHED __builtin_amdgcn_sched_barrier(0)
#define PG8_EPI(sg) do { \
    if constexpr (epi_preload<Epi>::value) { \
        _Pragma("unroll") for (int ai = 0; ai < 2; ++ai) _Pragma("unroll") for (int mh = 0; mh < 2; ++mh) { u32x4 gbuf[2][4]; int rr_[2]; \
            _Pragma("unroll") for (int m = 0; m < 2; ++m) { int r_ = ai * 128 + wr * 64 + (2 * mh + m) * 16 + fr; asm volatile("" : "+v"(r_)); rr_[m] = r_; E.load(cur, (sg), r_, wc * 32 + fq * 8, gbuf[m]); } \
            __builtin_amdgcn_sched_barrier(0); \
            _Pragma("unroll") for (int m = 0; m < 2; ++m) E.apply(cur, (sg), rr_[m], wc * 32 + fq * 8, gbuf[m], acc[ai][0][2 * mh + m][0], acc[ai][0][2 * mh + m][1], acc[ai][1][2 * mh + m][0], acc[ai][1][2 * mh + m][1]); \
            __builtin_amdgcn_sched_barrier(0); } \
    } else { \
        _Pragma("unroll") for (int ai = 0; ai < 2; ++ai) _Pragma("unroll") for (int m = 0; m < 4; ++m) { \
            int r_ = ai * 128 + wr * 64 + m * 16 + fr; asm volatile("" : "+v"(r_));     \
            E.seg(cur, (sg), r_, wc * 32 + fq * 8, acc[ai][0][m][0], acc[ai][0][m][1], acc[ai][1][m][0], acc[ai][1][m][1]); } } } while (0)
    Unit cur, nxt; int ui = 0;
    if (!S.next(0, cur)) return;
    f32x4 acc[2][2][4][2];
#pragma unroll
    for (int a = 0; a < 2; ++a)
#pragma unroll
        for (int b = 0; b < 2; ++b)
#pragma unroll
            for (int m = 0; m < 4; ++m)
#pragma unroll
                for (int n = 0; n < 2; ++n) acc[a][b][m][n] = (f32x4){0.f, 0.f, 0.f, 0.f};
    bf16x8 At[4][2], B0[2][2], B1[2][2];
    const char* cA = (const char*)cur.A; const char* cB = (const char*)cur.B;
    if (GATHER) {
#pragma unroll
        for (int i = 0; i < 2; ++i) { vA0[i] = (unsigned)(cur.tok[rowA[i]] * lda + colA[i]) * 2u; vA1[i] = (unsigned)(cur.tok[128 + rowA[i]] * lda + colA[i]) * 2u; nA0[i] = vA0[i]; nA1[i] = vA1[i]; }
    }
    PG8_STAGE(PG8_SB(0, 0), cB, voffB); PG8_STAGE(PG8_SA(0, 0), cA, vA0); PG8_STAGE(PG8_SB(0, 1), cB + hstepB, voffB); PG8_STAGE(PG8_SA(0, 1), cA, vA1);
    if (wr == 1) PG8_BAR;
    PG8_WAIT_V(4); PG8_BAR;
    PG8_STAGE(PG8_SB(1, 0), cB + kstep, voffB); PG8_STAGE(PG8_SA(1, 0), cA + kstep, vA0); PG8_STAGE(PG8_SB(1, 1), cB + hstepB + kstep, voffB);
    PG8_WAIT_V(6); PG8_BAR;
    for (;;) {
        const bool has_next = S.next(ui + 1, nxt);
        const char* nA = has_next ? (const char*)nxt.A : cA; const char* nB = has_next ? (const char*)nxt.B : cB;
        if (GATHER) {
            const int* tk = has_next ? nxt.tok : cur.tok;
#pragma unroll
            for (int i = 0; i < 2; ++i) { nA0[i] = (unsigned)(tk[rowA[i]] * lda + colA[i]) * 2u; nA1[i] = (unsigned)(tk[128 + rowA[i]] * lda + colA[i]) * 2u; }
        }
#pragma nounroll
        for (int sg = 0; sg < nseg; ++sg) {
#pragma nounroll
        for (int tt = 0; tt < tseg; tt += 2) {
            const int t = sg * tseg + tt;
            const bool last = (t == nt - 2);
            const char* a1 = cA + (size_t)(t + 1) * kstep;
            const char* a2 = last ? nA : cA + (size_t)(t + 2) * kstep; const char* b2 = last ? nB : cB + (size_t)(t + 2) * kstep;
            const char* a3 = a2 + kstep; const char* b3 = b2 + kstep;
            unsigned w0[2], w1[2];
#pragma unroll
            for (int i = 0; i < 2; ++i) { w0[i] = last ? nA0[i] : vA0[i]; w1[i] = last ? nA1[i] : vA1[i]; }
            PG8_LDB(B0, 0, 0); PG8_SCHED; PG8_LDA(At, 0, 0); PG8_STAGE(PG8_SA(1, 1), a1, vA1);
            PG8_WAIT_L(8); PG8_BAR; PG8_WAIT_L(0); PG8_MMA(0, 0, At, B0); PG8_BAR; PG8_SCHED;
            PG8_LDB(B1, 0, 1); PG8_STAGE(PG8_SB(0, 0), b2, voffB);
            PG8_BAR; PG8_WAIT_L(0); PG8_MMA(0, 1, At, B1); PG8_BAR;
            PG8_LDA(At, 0, 1); PG8_STAGE(PG8_SA(0, 0), a2, w0);
            PG8_BAR; PG8_WAIT_L(0); PG8_MMA(1, 0, At, B0); PG8_BAR; PG8_SCHED;
            PG8_STAGE(PG8_SB(0, 1), b2 + hstepB, voffB);
            PG8_WAIT_V(6); PG8_BAR; PG8_MMA(1, 1, At, B1); PG8_BAR;
            PG8_LDB(B0, 1, 0); PG8_SCHED; PG8_LDA(At, 1, 0); PG8_STAGE(PG8_SA(0, 1), a2, w1);
            PG8_WAIT_L(8); PG8_BAR; PG8_WAIT_L(0); PG8_MMA(0, 0, At, B0); PG8_BAR; PG8_SCHED;
            PG8_LDB(B1, 1, 1); PG8_STAGE(PG8_SB(1, 0), b3, voffB);
            PG8_BAR; PG8_WAIT_L(0); PG8_MMA(0, 1, At, B1); PG8_BAR;
            PG8_LDA(At, 1, 1); PG8_STAGE(PG8_SA(1, 0), a3, w0);
            PG8_BAR; PG8_WAIT_L(0); PG8_MMA(1, 0, At, B0); PG8_BAR; PG8_SCHED;
            PG8_STAGE(PG8_SB(1, 1), b3 + hstepB, voffB);
            PG8_WAIT_V(6); PG8_BAR; PG8_MMA(1, 1, At, B1); PG8_BAR;
        }
        PG8_EPI(sg);
        }
        if (!has_next) break;
#pragma unroll
        for (int a = 0; a < 2; ++a)
#pragma unroll
            for (int b = 0; b < 2; ++b)
#pragma unroll
                for (int m = 0; m < 4; ++m)
#pragma unroll
                    for (int n = 0; n < 2; ++n) acc[a][b][m][n] = (f32x4){0.f, 0.f, 0.f, 0.f};
        cur = nxt; cA = nA; cB = nB; ++ui;
#pragma unroll
        for (int i = 0; i < 2; ++i) { vA0[i] = nA0[i]; vA1[i] = nA1[i]; }
    }
    PG8_WAIT_V(0);
    if (wr == 0) PG8_BAR;
    PG8_BAR;
#undef PG8_SA
#undef PG8_SB
#undef PG8_STAGE
#undef PG8_LDA
#undef PG8_LDB
#undef PG8_MMA
#undef PG8_WAIT_V
#undef PG8_WAIT_L
#undef PG8_BAR
#undef PG8_SCHED
#undef PG8_EPI
}

template <bool GATHER = false, class Sched, class Epi>
__device__ __forceinline__ void gemm_run(unsigned char* lds, const Sched& S, const Epi& E, int K, int lda, int ldb, int nseg) {
    __syncthreads();
    gemm_mfma<GATHER>((LAS unsigned char*)lds, S, E, K, lda, ldb, nseg);
    __syncthreads();
}

struct TrDesc { const float* src; const float* cscale; bf16_t* dst; int ld_src, ld_dst, valid; };
__device__ __forceinline__ void tr_load(const TrDesc& d, f32x4 (&v)[16]) {
    if (d.src) {
#pragma unroll
        for (int i = 0; i < 16; ++i) v[i] = *(const f32x4*)(d.src + (size_t)(4 * i) * d.ld_src);
    } else {
#pragma unroll
        for (int i = 0; i < 16; ++i) v[i] = (f32x4){0.f, 0.f, 0.f, 0.f};
    }
}
__device__ __forceinline__ void tr_store(const TrDesc& d, f32x4 (&v)[16], float* scr, int lane) {
    const int c4 = (lane & 15) * 4, kr = lane >> 4;
    if (d.cscale) { const f32x4 s = *(const f32x4*)d.cscale;
#pragma unroll
        for (int i = 0; i < 16; ++i) v[i] = v[i] * s; }
#pragma unroll
    for (int i = 0; i < 16; ++i) { float* q = scr + (kr + 4 * i) * 65 + c4; q[0] = v[i][0]; q[1] = v[i][1]; q[2] = v[i][2]; q[3] = v[i][3]; }
    asm volatile("s_waitcnt lgkmcnt(0)" ::: "memory");
    const int c = lane & 7;
#pragma unroll
    for (int j = 0; j < 8; ++j) { const int n = (lane >> 3) + 8 * j; const float* s = scr + (8 * c) * 65 + n;
        u32x4 o; o.x = pk2(s[0 * 65], s[1 * 65]); o.y = pk2(s[2 * 65], s[3 * 65]); o.z = pk2(s[4 * 65], s[5 * 65]); o.w = pk2(s[6 * 65], s[7 * 65]);
        *(u32x4*)(d.dst + (size_t)n * d.ld_dst + 8 * c) = o; }
    asm volatile("s_waitcnt lgkmcnt(0)" ::: "memory");
}
__device__ __forceinline__ TrDesc tr_desc(const float* W, int ld_src, int srcq, bf16_t* WT, int ld_dst, int n_dst, int kdst0, int k0, int lane, const float* cscale = nullptr) {
    TrDesc d; d.ld_src = ld_src; d.ld_dst = ld_dst; d.valid = 1;
    d.src = srcq >= 0 ? W + (size_t)(k0 + (lane >> 4)) * ld_src + srcq : nullptr;
    d.cscale = (cscale && srcq >= 0) ? cscale + srcq : nullptr;
    d.dst = WT + (size_t)n_dst * ld_dst + kdst0 + k0; return d;
}
constexpr int CV_MIX_ITEMS = 2880 + 64 + 768 + 256;
constexpr int CV_EXP_ITEMS = 32 * 384;
__device__ __forceinline__ TrDesc convert_desc(const Params& p, int le, int lm, int it, int lane) {
    unsigned char* ws = p.ws;
    const int c4 = (lane & 15) * 4;
    if (le >= 0) {
        if (it < CV_EXP_ITEMS) {
            const int e = it / 384, r = it % 384;
            if (r < 256) { const int up = r >> 7, q = r & 127, kb = ((q >> 5) << 2) | ((q >> 1) & 3), nb = (((q >> 3) & 3) << 1) | (q & 1); const int c = nb * 64;
                const float* src = (up ? p.w_eu : p.w_eg) + (size_t)(le * 32 + e) * 1024 * 512;
                return tr_desc(src, 512, c + c4, (bf16_t*)(ws + WS_EW1) + (size_t)e * 1048576, 1024, (c >> 7) * 256 + up * 128 + (c & 127), 0, kb * 64, lane); }
            const int q = r - 256, kb = ((q >> 6) << 2) | ((q >> 1) & 3), nb = (((q >> 3) & 7) << 1) | (q & 1);
            return tr_desc(p.w_ed + (size_t)(le * 32 + e) * 512 * 1024, 1024, nb * 64 + c4, (bf16_t*)(ws + WS_EW2) + (size_t)e * 524288, 512, nb * 64, 0, kb * 64, lane);
        }
        it -= CV_EXP_ITEMS;
    }
    const int l = lm;
    if (it < 2880) { const int R = it >> 4, kb = it & 15, dstn = R * 64; int srcq;
        if (R < 80) srcq = dstn + c4; else if (R < 128) srcq = dstn + 16 + c4; else if (R < 176) srcq = dstn + 48 + c4;
        else if (R == 176) srcq = c4 < 32 ? 8208 + c4 : (c4 < 48 ? 5120 + (c4 - 32) : -1); else srcq = -1;
        return tr_desc(p.w_in + (size_t)l * 1024 * DIN, DIN, srcq, (bf16_t*)(ws + WS_WIN), 1024, dstn, 0, kb * 64, lane); }
    it -= 2880;
    if (it < 64) { const int g = it >> 4, r = it & 15, kb = r >> 2, nb = r & 3;
        return tr_desc(p.pool_w + (size_t)(l * 4 + g) * 65536, 256, nb * 64 + c4, (bf16_t*)(ws + WS_WPOOL) + (size_t)g * 65536, 256, nb * 64, 0, kb * 64, lane, p.pool_scale + l * 1024 + g * 256); }
    it -= 64;
    if (it < 768) { const int br = it >> 8, r = it & 255, kb = r >> 4, nb = r & 15;
        return tr_desc(p.w_branch + (size_t)(l * 3 + br) * 1048576, 1024, nb * 64 + c4, (bf16_t*)(ws + WS_WBR), 3072, nb * 64, br * 1024, kb * 64, lane); }
    it -= 768;
    { const int kb = it >> 4, nb = it & 15;
      return tr_desc(p.w_out + (size_t)l * 1048576, 1024, nb * 64 + c4, (bf16_t*)(ws + WS_WOUT), 1024, nb * 64, 0, kb * 64, lane); }
}
__device__ __forceinline__ void convert_run(const Params& p, int le, int lm, int first, int step, float* scr, int lane) {
    const int nitems = (le >= 0 ? CV_EXP_ITEMS : 0) + (lm >= 0 ? CV_MIX_ITEMS : 0);
    if (first >= nitems) return;
    f32x4 va[16], vb[16];
    TrDesc da = convert_desc(p, le, lm, first, lane), db;
    tr_load(da, va);
    for (int it = first; it < nitems; it += 2 * step) {
        const int i1 = it + step, i2 = it + 2 * step;
        if (i1 < nitems) { db = convert_desc(p, le, lm, i1, lane); tr_load(db, vb); }
        tr_store(da, va, scr, lane);
        if (i1 >= nitems) break;
        if (i2 < nitems) { da = convert_desc(p, le, lm, i2, lane); tr_load(da, va); }
        tr_store(db, vb, scr, lane);
    }
}

__device__ __forceinline__ void cvmicro_load(const Params& p, int le, int m, int lane, f32x4 (&v)[8], TrDesc& d) {
    d = convert_desc(p, le, -1, m >> 1, lane);
    const float* s = d.src + (size_t)(32 * (m & 1)) * d.ld_src;
#pragma unroll
    for (int i = 0; i < 8; ++i) v[i] = *(const f32x4*)(s + (size_t)(4 * i) * d.ld_src);
}
__device__ __forceinline__ void cvmicro_store(const TrDesc& d, int m, const f32x4 (&v)[8], LAS float* scr, int lane) {
    const int c4 = (lane & 15) * 4, kr = lane >> 4;
#pragma unroll
    for (int i = 0; i < 8; ++i) { LAS float* q = scr + (kr + 4 * i) * 65 + c4; q[0] = v[i][0]; q[1] = v[i][1]; q[2] = v[i][2]; q[3] = v[i][3]; }
    asm volatile("s_waitcnt lgkmcnt(0)" ::: "memory");
    bf16_t* drow = d.dst + (size_t)lane * d.ld_dst + 32 * (m & 1);
#pragma unroll
    for (int g = 0; g < 4; ++g) { const LAS float* s = scr + (8 * g) * 65 + lane;
        u32x4 o; o.x = pk2(s[0 * 65], s[1 * 65]); o.y = pk2(s[2 * 65], s[3 * 65]); o.z = pk2(s[4 * 65], s[5 * 65]); o.w = pk2(s[6 * 65], s[7 * 65]);
        *(u32x4*)(drow + 8 * g) = o; }
    asm volatile("s_waitcnt lgkmcnt(0)" ::: "memory");
}

__device__ __forceinline__ void phase_pre(const Params& p, unsigned char* ldsb, int bid, int nb) {
    float* lds = reinterpret_cast<float*>(ldsb);
    const int tid = tid_fresh(), lane = tid & 63, wave = tid >> 6;
    for (int i = tid; i < 5 * 1024; i += NTHR) { const float v = i < 4096 ? p.c[i] : p.c_ctx[i - 4096]; lds[i] = silu_f(v); }
    __syncthreads();
    float* red = lds + 5120;
    for (int it = bid; it < 2 * 96; it += nb) {
        const int l = it / 96, j = (it % 96) * 64 + lane;
        const float* w = p.w_ada + (size_t)l * 1024 * 6144 + j;
        float a0 = 0, a1 = 0, a2 = 0, a3 = 0, a4 = 0;
#pragma unroll 16
        for (int k = wave * 128; k < wave * 128 + 128; ++k) { const float wv = w[(size_t)k * 6144];
            a0 += lds[k] * wv; a1 += lds[1024 + k] * wv; a2 += lds[2048 + k] * wv; a3 += lds[3072 + k] * wv; a4 += lds[4096 + k] * wv; }
        red[(wave * 5 + 0) * 64 + lane] = a0; red[(wave * 5 + 1) * 64 + lane] = a1; red[(wave * 5 + 2) * 64 + lane] = a2;
        red[(wave * 5 + 3) * 64 + lane] = a3; red[(wave * 5 + 4) * 64 + lane] = a4;
        __syncthreads();
        if (tid < 320) { const int r = tid >> 6, jj = tid & 63; float s = 0;
            for (int w8 = 0; w8 < 8; ++w8) s += red[(w8 * 5 + r) * 64 + jj];
            const int col = (it % 96) * 64 + jj;
            ((float*)(p.ws + WS_MOD))[(size_t)(l * 5 + r) * 6144 + col] = s + p.b_ada[l * 6144 + col]; }
        __syncthreads();
    }
    __syncthreads();
    float* scr = lds + wave * (64 * 65);
    convert_run(p, -1, 0, bid * 8 + wave, nb * 8, scr, lane);
}

__device__ __forceinline__ void norm_mod_row(f32x4 (&v)[4], const float* g, const float* shift, const float* scale, int lane) {
    float s = 0.f;
#pragma unroll
    for (int j = 0; j < 4; ++j) s += (v[j][0] * v[j][0] + v[j][1] * v[j][1]) + (v[j][2] * v[j][2] + v[j][3] * v[j][3]);
    const float rs = __builtin_amdgcn_rsqf(wave_sum(s) * (1.f / 1024.f) + EPS);
#pragma unroll
    for (int j = 0; j < 4; ++j) { const int c = 4 * lane + 256 * j; const f32x4 gg = *(const f32x4*)(g + c);
        f32x4 y = v[j] * rs * gg;
        if (shift) { const f32x4 sh = *(const f32x4*)(shift + c), sc = *(const f32x4*)(scale + c); y = y * (1.f + sc) + sh; }
        v[j] = y; }
}
__device__ __forceinline__ void store_row_bf16(bf16_t* dst, const f32x4 (&v)[4], int lane) {
#pragma unroll
    for (int j = 0; j < 4; ++j) { u32x2 w; w.x = pk2(v[j][0], v[j][1]); w.y = pk2(v[j][2], v[j][3]); *(u32x2*)(dst + 4 * lane + 256 * j) = w; }
}

__device__ __forceinline__ void phase_norm1(const Params& p, int bid, int nb) {
    const int lane = tid_fresh() & 63, wave = tid_fresh() >> 6;
    const float* mod = (const float*)(p.ws + WS_MOD);
    const int stride = nb * 8;
    int m = bid * 8 + wave;
    f32x4 v[4], w[4];
    if (m < MT) { const float* src = m < MC ? p.ctx + (size_t)m * 1024 : p.x + (size_t)(m - MC) * 1024;
#pragma unroll
        for (int j = 0; j < 4; ++j) v[j] = *(const f32x4*)(src + 4 * lane + 256 * j); }
    for (; m < MT; m += stride) {
        const int mn = m + stride;
        if (mn < MT) { const float* src = mn < MC ? p.ctx + (size_t)mn * 1024 : p.x + (size_t)(mn - MC) * 1024;
#pragma unroll
            for (int j = 0; j < 4; ++j) w[j] = *(const f32x4*)(src + 4 * lane + 256 * j); }
        const float* mr = mod + modrow(m) * 6144;
        norm_mod_row(v, p.g_mix, mr, mr + 1024, lane);
        store_row_bf16((bf16_t*)(p.ws + WS_H) + (size_t)m * 1024, v, lane);
#pragma unroll
        for (int j = 0; j < 4; ++j) v[j] = w[j];
    }
}

__device__ __forceinline__ float wave_incl_sum(float v, int lane) {
#pragma unroll
    for (int o = 1; o < 64; o <<= 1) { const float u = __shfl_up(v, o); if (lane >= o) v += u; }
    return v;
}
__device__ __forceinline__ float wave_incl_max(float v, int lane) {
#pragma unroll
    for (int o = 1; o < 64; o <<= 1) { const float u = __shfl_up(v, o); if (lane >= o) v = fmaxf(v, u); }
    return v;
}
__device__ __forceinline__ u32x2 pack4(f32x4 a) { u32x2 w; w.x = pk2(a[0], a[1]); w.y = pk2(a[2], a[3]); return w; }

__device__ __forceinline__ void chunk_geom(int gc, int& rbase, int& n0, int& len) {
    const int b = gc / 68, cin = gc % 68;
    if (cin < 4) { rbase = b * 256; n0 = cin * 64; len = 256; } else { rbase = MC + b * 4096; n0 = (cin - 4) * 64; len = 4096; }
}
struct ConvW { float w[4][8], b[8]; };
__device__ __forceinline__ void conv_load_w(const float* cw, const float* cb, int ch0, ConvW& W) {
#pragma unroll
    for (int j = 0; j < 4; ++j) { const f32x4 a = *(const f32x4*)(cw + j * 2048 + ch0), b2 = *(const f32x4*)(cw + j * 2048 + ch0 + 4);
#pragma unroll
        for (int i = 0; i < 4; ++i) { W.w[j][i] = a[i]; W.w[j][4 + i] = b2[i]; } }
    { const f32x4 a = *(const f32x4*)(cb + ch0), b2 = *(const f32x4*)(cb + ch0 + 4);
#pragma unroll
      for (int i = 0; i < 4; ++i) { W.b[i] = a[i]; W.b[4 + i] = b2[i]; } }
}
__device__ __forceinline__ void conv8x4(const u32x4 (&raw)[7], const ConvW& W, float scale, u32x4 (&out)[4]) {
    float f[7][8];
#pragma unroll
    for (int k = 0; k < 7; ++k) unpack8(raw[k], f[k]);
#pragma unroll
    for (int pp = 0; pp < 4; ++pp) { f32x4 o0, o1;
#pragma unroll
        for (int i = 0; i < 8; ++i) { float a = W.b[i];
#pragma unroll
            for (int j = 0; j < 4; ++j) a += W.w[j][i] * f[pp + j][i];
            a = silu_f(a) * scale; if (i < 4) o0[i] = a; else o1[i - 4] = a; }
        out[pp] = pack8(o0, o1); }
}
__device__ __forceinline__ void load_raw7(const bf16_t* src, size_t ld, int rbase, int tbase, int len, u32x4 (&raw)[7]) {
#pragma unroll
    for (int k = 0; k < 7; ++k) { const int t = tbase + k; const bool ok = (t >= 0) && (t < len); const int tc = t < 0 ? 0 : (t >= len ? len - 1 : t);
        u32x4 a = *(const u32x4*)(src + (size_t)(rbase + tc) * ld);
        if (!ok) a = (u32x4){0u, 0u, 0u, 0u};
        raw[k] = a; }
}
template <class F>
__device__ __forceinline__ void tile_transpose_out(const LAS bf16_t* tile, int ldsw, int ncol, int tid, F rowptr) {
    for (int q = tid; q < ncol * 8; q += NTHR) { const int c = q % ncol, sc = q / ncol;
        unsigned v[8];
#pragma unroll
        for (int i = 0; i < 8; ++i) v[i] = tile[(sc * 8 + i) * ldsw + c];
        u32x4 w; w.x = v[0] | (v[1] << 16); w.y = v[2] | (v[3] << 16); w.z = v[4] | (v[5] << 16); w.w = v[6] | (v[7] << 16);
        *(u32x4*)(rowptr(c) + sc * 8) = w; }
}

__device__ __forceinline__ void conv_m_item(const Params& p, int l, int item, LAS unsigned char* lds, const ConvW& Wq, const ConvW& Wk) {
    const int tid = tid_fresh(), gc = item >> 2, hd = item & 3;
    int rbase, n0, len; chunk_geom(gc, rbase, n0, len);
    const int cs = tid & 31, tg = tid >> 5, d0 = cs * 8, i0 = tg * 4;
    u32x4 rq[7], rk[7]; float g0 = 0.f, g1 = 0.f;
    load_raw7((const bf16_t*)(p.ws + WS_Q) + hd * 256 + d0, 1024, rbase, n0 + i0 - 2, len, rq);
    load_raw7((const bf16_t*)(p.ws + WS_K) + hd * 256 + d0, 1024, rbase, n0 + i0 - 2, len, rk);
    const int gdir = tid >> 6, glane = tid & 63, gj = gdir ? 63 - glane : glane;
    if (gdir < 2) { const float* g = (const float*)(p.ws + WS_GA) + (size_t)(rbase + n0 + gj) * 16; g0 = g[gdir * 4 + hd]; g1 = g[(2 + gdir) * 4 + hd]; }
    { u32x4 o[4];
      conv8x4(rq, Wq, 1.0f, o);
#pragma unroll
      for (int pp = 0; pp < 4; ++pp) *(u32x4*)((bf16_t*)(p.ws + WS_QC) + (size_t)(rbase + n0 + i0 + pp) * 1024 + hd * 256 + d0) = o[pp];
      conv8x4(rk, Wk, 0.0625f, o);
#pragma unroll
      for (int pp = 0; pp < 4; ++pp) *(u32x4*)((bf16_t*)(p.ws + WS_KC) + (size_t)(rbase + n0 + i0 + pp) * 1024 + hd * 256 + d0) = o[pp]; }
    for (int rep_ = 0; rep_ < ((CONVDUP & 4) ? 2 : 1); ++rep_)
    if (gdir < 2) {
        const float ig = g0 + p.mgate_b[l * 16 + gdir * 4 + hd], lf = logsigmoid_f(g1 + p.mgate_b[l * 16 + (2 + gdir) * 4 + hd]);
        const float cum = wave_incl_sum(lf, glane), a = ig - cum, pm = wave_incl_max(a, glane);
        const size_t o = (size_t)(gc * 8 + gdir * 4 + hd) * 64 + gj;
        ((float*)(p.ws + WS_MGA))[o] = a; ((float*)(p.ws + WS_MGC))[o] = cum; ((float*)(p.ws + WS_MGP))[o] = pm;
    }
}

__device__ __forceinline__ void conv_s_item(const Params& p, int l, int item, LAS unsigned char* lds, const ConvW& Wbc, const ConvW& Wx) {
    const int tid = tid_fresh(), gc = item >> 2, grp = item & 3;
    int rbase, n0, len; chunk_geom(gc, rbase, n0, len);
    const int cs = tid & 31, tg = tid >> 5, i0 = tg * 4;
    const int isC = cs >> 4, nn = (cs & 15) * 8;
    u32x4 rbc[7], rx[7];
    load_raw7((const bf16_t*)(p.ws + (isC ? WS_SC : WS_SB)) + grp * 128 + nn, 512, rbase, n0 + i0 - 2, len, rbc);
    load_raw7((const bf16_t*)(p.ws + WS_SX) + grp * 256 + cs * 8, 1024, rbase, n0 + i0 - 2, len, rx);
    const int wv = tid >> 6, lane = tid & 63, dir = wv >> 2, hd = grp * 4 + (wv & 3), jn = dir ? 63 - lane : lane;
    const float dtraw = ((const float*)(p.ws + WS_DT))[(size_t)(rbase + n0 + jn) * 32 + dir * 16 + hd];
    { u32x4 o[4];
      conv8x4(rbc, Wbc, 1.0f, o);
      bf16_t* dst = (bf16_t*)(p.ws + (isC ? WS_CC : WS_BC)) + grp * 128 + nn;
#pragma unroll
      for (int pp = 0; pp < 4; ++pp) *(u32x4*)(dst + (size_t)(rbase + n0 + i0 + pp) * 512) = o[pp];
      conv8x4(rx, Wx, 1.0f, o);
      bf16_t* dx = (bf16_t*)(p.ws + WS_XCT) + grp * 256 + cs * 8;
#pragma unroll
      for (int pp = 0; pp < 4; ++pp) *(u32x4*)(dx + (size_t)(rbase + n0 + i0 + pp) * 1024) = o[pp]; }
    { const float dtv = softplus_f(dtraw + p.sdt_bias[l * 32 + dir * 16 + hd]);
      const float acs = wave_incl_sum(dtv * -__expf(p.sa_log[l * 32 + dir * 16 + hd]), lane);
      const size_t o = (size_t)(gc * 32 + dir * 16 + hd) * 64 + jn;
      ((float*)(p.ws + WS_SACS))[o] = acs; ((float*)(p.ws + WS_SDT))[o] = dtv; }
}

__device__ __forceinline__ void pool_window_item(const Params& p, int it, LAS unsigned char* lds) {
    const int tid = tid_fresh();
    bf16_t* BR = (bf16_t*)(p.ws + WS_BR);
    __syncthreads();
    if (it < 256) {
        const int row0 = MC + it * 64;
        { u32x4 t[16];
#pragma unroll
          for (int i = 0; i < 16; ++i) { const int q = tid + NTHR * i, r = q >> 7, ch = q & 127; t[i] = *(const u32x4*)(BR + (size_t)(row0 + r) * 3072 + ch * 8); }
#pragma unroll
          for (int i = 0; i < 16; ++i) *(LAS u32x4*)(lds + (tid + NTHR * i) * 16) = t[i]; }
        __syncthreads();
        for (int q = tid; q < 64 * 128; q += NTHR) { const int r = q >> 7, ch = q & 127, w = 2 << (ch >> 5);
            int lo = r - (w >> 1), hi = lo + w - 1; lo = lo < 0 ? 0 : lo; hi = hi > 63 ? 63 : hi;
            float s[8] = {0, 0, 0, 0, 0, 0, 0, 0}, self[8];
            for (int rr = lo; rr <= hi; ++rr) { float f[8]; unpack8(*(const LAS u32x4*)(lds + (rr * 128 + ch) * 16), f);
#pragma unroll
                for (int j = 0; j < 8; ++j) s[j] += f[j]; }
            unpack8(*(const LAS u32x4*)(lds + q * 16), self);
            const float inv = __builtin_amdgcn_rcpf((float)(hi - lo + 1)); f32x4 a, b;
#pragma unroll
            for (int j = 0; j < 4; ++j) { a[j] = s[j] * inv - self[j]; b[j] = s[4 + j] * inv - self[4 + j]; }
            *(u32x4*)(BR + (size_t)(row0 + r) * 3072 + ch * 8) = pack8(a, b); }
    } else {
        const int bb = (it - 256) >> 2, g = (it - 256) & 3, row0 = bb * 256, w = 2 << g;
        { u32x4 t[16];
#pragma unroll
          for (int i = 0; i < 16; ++i) { const int q = tid + NTHR * i, r = q >> 5, ch = q & 31; t[i] = *(const u32x4*)(BR + (size_t)(row0 + r) * 3072 + g * 256 + ch * 8); }
#pragma unroll
          for (int i = 0; i < 16; ++i) *(LAS u32x4*)(lds + (tid + NTHR * i) * 16) = t[i]; }
        __syncthreads();
        for (int q = tid; q < 256 * 32; q += NTHR) { const int r = q >> 5, ch = q & 31;
            int lo = r - (w >> 1), hi = lo + w - 1; lo = lo < 0 ? 0 : lo; hi = hi > 255 ? 255 : hi;
            float s[8] = {0, 0, 0, 0, 0, 0, 0, 0}, self[8];
            for (int rr = lo; rr <= hi; ++rr) { float f[8]; unpack8(*(const LAS u32x4*)(lds + (rr * 32 + ch) * 16), f);
#pragma unroll
                for (int j = 0; j < 8; ++j) s[j] += f[j]; }
            unpack8(*(const LAS u32x4*)(lds + q * 16), self);
            const float inv = __builtin_amdgcn_rcpf((float)(hi - lo + 1)); f32x4 a, b;
#pragma unroll
            for (int j = 0; j < 4; ++j) { a[j] = s[j] * inv - self[j]; b[j] = s[4 + j] * inv - self[4 + j]; }
            *(u32x4*)(BR + (size_t)(row0 + r) * 3072 + g * 256 + ch * 8) = pack8(a, b); }
    }
    __syncthreads();
}

typedef short bf16x4 __attribute__((ext_vector_type(4)));
__device__ __forceinline__ bf16x8 tr_join(bf16x4 r0, bf16x4 r1) { bf16x8 o; o[0] = r0[0]; o[1] = r0[1]; o[2] = r0[2]; o[3] = r0[3]; o[4] = r1[0]; o[5] = r1[1]; o[6] = r1[2]; o[7] = r1[3]; return o; }
__device__ __forceinline__ bf16x8 tr_frag(unsigned a0, unsigned a1) {
    bf16x4 r0, r1;
    asm volatile("ds_read_b64_tr_b16 %0, %2\n\tds_read_b64_tr_b16 %1, %3\n\ts_waitcnt lgkmcnt(0)" : "=&v"(r0), "=&v"(r1) : "v"(a0), "v"(a1) : "memory");
    return tr_join(r0, r1);
}
__device__ __forceinline__ void tr_frag4(const unsigned (&a)[4], unsigned d, bf16x8 (&f)[4]) {
    bf16x4 r[8];
    asm volatile("ds_read_b64_tr_b16 %0, %8\n\tds_read_b64_tr_b16 %1, %9\n\tds_read_b64_tr_b16 %2, %10\n\tds_read_b64_tr_b16 %3, %11\n\t"
                 "ds_read_b64_tr_b16 %4, %12\n\tds_read_b64_tr_b16 %5, %13\n\tds_read_b64_tr_b16 %6, %14\n\tds_read_b64_tr_b16 %7, %15\n\ts_waitcnt lgkmcnt(0)"
                 : "=&v"(r[0]), "=&v"(r[1]), "=&v"(r[2]), "=&v"(r[3]), "=&v"(r[4]), "=&v"(r[5]), "=&v"(r[6]), "=&v"(r[7])
                 : "v"(a[0]), "v"(a[0] + d), "v"(a[1]), "v"(a[1] + d), "v"(a[2]), "v"(a[2] + d), "v"(a[3]), "v"(a[3] + d) : "memory");
#pragma unroll
    for (int i = 0; i < 4; ++i) f[i] = tr_join(r[2 * i], r[2 * i + 1]);
}
__device__ __forceinline__ void tr_frag6(const unsigned (&a)[6], unsigned d, bf16x8 (&f)[6]) {
    bf16x4 r[12];
    asm volatile("ds_read_b64_tr_b16 %0, %12\n\tds_read_b64_tr_b16 %1, %13\n\tds_read_b64_tr_b16 %2, %14\n\tds_read_b64_tr_b16 %3, %15\n\t"
                 "ds_read_b64_tr_b16 %4, %16\n\tds_read_b64_tr_b16 %5, %17\n\tds_read_b64_tr_b16 %6, %18\n\tds_read_b64_tr_b16 %7, %19\n\t"
                 "ds_read_b64_tr_b16 %8, %20\n\tds_read_b64_tr_b16 %9, %21\n\tds_read_b64_tr_b16 %10, %22\n\tds_read_b64_tr_b16 %11, %23\n\ts_waitcnt lgkmcnt(0)"
                 : "=&v"(r[0]), "=&v"(r[1]), "=&v"(r[2]), "=&v"(r[3]), "=&v"(r[4]), "=&v"(r[5]), "=&v"(r[6]), "=&v"(r[7]), "=&v"(r[8]), "=&v"(r[9]), "=&v"(r[10]), "=&v"(r[11])
                 : "v"(a[0]), "v"(a[0] + d), "v"(a[1]), "v"(a[1] + d), "v"(a[2]), "v"(a[2] + d), "v"(a[3]), "v"(a[3] + d), "v"(a[4]), "v"(a[4] + d), "v"(a[5]), "v"(a[5] + d) : "memory");
#pragma unroll
    for (int i = 0; i < 6; ++i) f[i] = tr_join(r[2 * i], r[2 * i + 1]);
}
constexpr int ML_CT = 0, ML_Q = 36864, ML_K = 71680, ML_V = 106496, ML_A = 135168;
__device__ __forceinline__ void mlstm_chunk_item(const Params& p, int l, int item, LAS unsigned char* lds) {
    const int tid0 = tid_fresh(), wid = __builtin_amdgcn_readfirstlane(tid0 >> 6);
    const int b = item >> 5, hd = (item >> 3) & 3, dir = (item >> 2) & 1, eg2 = item & 3;
    const bf16_t* QC = (const bf16_t*)(p.ws + WS_QC); const bf16_t* KC = (const bf16_t*)(p.ws + WS_KC);
    const bf16_t* Vg = (const bf16_t*)(p.ws + WS_V);
    const float* GAa = (const float*)(p.ws + WS_MGA); const float* GCc = (const float*)(p.ws + WS_MGC); const float* GPp = (const float*)(p.ws + WS_MGP);
    bf16_t* OUT = (bf16_t*)(p.ws + (dir ? WS_HB2 : WS_HF2));
    const int ti = wid >> 1, wh = wid & 1;
    __syncthreads();
    for (int i = tid0; i < 36864 / 4; i += NTHR) ((LAS unsigned*)(lds + ML_CT))[i] = 0u;
    if (tid0 < 128) { const int es = tid0 >> 6, r = tid0 & 63; *(LAS u32x4*)(lds + ML_V + es * 14336 + r * 112 + 64) = (u32x4){0x3F80u, 0u, 0u, 0u}; *(LAS u32x4*)(lds + ML_V + es * 14336 + r * 112 + 80) = (u32x4){0u, 0u, 0u, 0u}; }
    f32x4 Cacc[2][2][3];
#pragma unroll
    for (int es = 0; es < 2; ++es)
#pragma unroll
        for (int j = 0; j < 2; ++j)
#pragma unroll
            for (int e = 0; e < 3; ++e) Cacc[es][j][e] = (f32x4){0.f, 0.f, 0.f, 0.f};
    float m_st = 0.f;
    f32x4 ca0 = (f32x4){0.f, 0.f, 0.f, 0.f}, ca1 = ca0, cP4 = ca0, cC4 = ca0; float cPt = 0.f, cPl = 0.f, cCl = 0.f, caw = 0.f;
    const int jl = dir ? 0 : 63;
    __syncthreads();
    for (int c = -1; c < 68; ++c) {
        const int cn = c + 1;
        const int tid = tid_fresh(), lane = tid & 63, fr = lane & 15, fq = lane >> 4;
        const int vrow = tid < 384 ? tid / 6 : 63, vch = tid < 384 ? tid % 6 : 0;
        const int gs0 = 16 * (2 * wh) + 4 * fq, gt = 16 * ti + fr, gt0 = 16 * ti + 4 * fq;
        u32x4 rq[4], rk[4], rv[1];
#pragma unroll
        for (int j = 0; j < 4; ++j) { rq[j] = (u32x4){0u, 0u, 0u, 0u}; rk[j] = rq[j]; }
        rv[0] = (u32x4){0u, 0u, 0u, 0u};
        if (cn < 68) {
            const int cin = cn < 4 ? (dir ? 3 - cn : cn) : 4 + (dir ? 67 - cn : cn - 4), gc = b * 68 + cin;
            int rbase, n0, len; chunk_geom(gc, rbase, n0, len);
#pragma unroll
            for (int j = 0; j < 4; ++j) { const int q = tid + NTHR * j;
                const size_t ro = (size_t)(rbase + n0 + (q >> 5)) * 1024 + hd * 256 + (q & 31) * 8;
                rq[j] = *(const u32x4*)(QC + ro); rk[j] = *(const u32x4*)(KC + ro); }
            { const int es = tid >> 8, r = (tid & 255) >> 2, ch = tid & 3;
              rv[0] = *(const u32x4*)(Vg + (size_t)(rbase + n0 + r) * 1024 + hd * 256 + (2 * eg2 + es) * 32 + ch * 8); }
        }
        if (c >= 0) {
            const int cin = c < 4 ? (dir ? 3 - c : c) : 4 + (dir ? 67 - c : c - 4), gc = b * 68 + cin;
            int rbase, n0, len; chunk_geom(gc, rbase, n0, len);
            {
                f32x4 st[2] = {(f32x4){0.f, 0.f, 0.f, 0.f}, (f32x4){0.f, 0.f, 0.f, 0.f}};
                const LAS unsigned char* qb = lds + ML_Q + (16 * ti + fr) * 544 + fq * 16;
                const LAS unsigned char* kb0 = lds + ML_K + (16 * (2 * wh) + fr) * 544 + fq * 16;
                bf16x8 qfa[4], k0f[4], k1f[4];
#pragma unroll
                for (int hb = 0; hb < 2; ++hb) {
#pragma unroll
                    for (int kd = 0; kd < 4; ++kd) { qfa[kd] = *(const LAS bf16x8*)(qb + (4 * (1 - hb) + kd) * 64); k0f[kd] = *(const LAS bf16x8*)(kb0 + (4 * (1 - hb) + kd) * 64); k1f[kd] = *(const LAS bf16x8*)(kb0 + 16 * 544 + (4 * (1 - hb) + kd) * 64); }
                    __builtin_amdgcn_sched_barrier(0);
#pragma unroll
                    for (int kd = 0; kd < 4; ++kd) {
                        st[0] = __builtin_amdgcn_mfma_f32_16x16x32_bf16(k0f[kd], qfa[kd], st[0], 0, 0, 0);
                        st[1] = __builtin_amdgcn_mfma_f32_16x16x32_bf16(k1f[kd], qfa[kd], st[1], 0, 0, 0);
                    }
                    __builtin_amdgcn_sched_barrier(0);
                }
                const int t = 16 * ti + fr; const float Mt = fmaxf(m_st, cPt), M63 = fmaxf(m_st, cPl);
#pragma unroll
                for (int j = 0; j < 2; ++j) { const int s0 = 16 * (2 * wh + j) + 4 * fq; const f32x4 av = j ? ca1 : ca0;
                    f32x4 o;
#pragma unroll
                    for (int r = 0; r < 4; ++r) { const bool keep = dir ? (s0 + r >= t) : (s0 + r <= t); o[r] = keep ? st[j][r] * __expf(av[r] - Mt) : 0.f; }
                    *(LAS u32x2*)(lds + ML_A + t * 160 + s0 * 2) = pack4(o); }
                if (tid < 384) { const float w = __expf(caw - M63);
#pragma unroll
                    for (int es = 0; es < 2; ++es) { float f[8]; unpack8(*(const LAS u32x4*)(lds + ML_V + es * 14336 + vrow * 112 + vch * 16), f);
                        f32x4 o0, o1;
#pragma unroll
                        for (int i = 0; i < 4; ++i) { o0[i] = f[i] * w; o1[i] = f[4 + i] * w; }
                        *(LAS u32x4*)(lds + ML_V + es * 14336 + 7168 + vrow * 112 + vch * 16) = pack8(o0, o1); } }
            }
            __syncthreads();
            {
                const LAS unsigned char* ab = lds + ML_A + (16 * ti + fr) * 160 + fq * 16;
                const LAS unsigned char* qb = lds + ML_Q + (16 * ti + fr) * 544 + fq * 16;
                bf16x8 af[2], k0f[2], k1f[2], qf[8];
#pragma unroll
                for (int ks = 0; ks < 2; ++ks) af[ks] = *(const LAS bf16x8*)(ab + ks * 64);
#pragma unroll
                for (int kd = 0; kd < 8; ++kd) qf[kd] = *(const LAS bf16x8*)(qb + kd * 64);
                { const unsigned kb_ = (unsigned)(size_t)(lds + ML_K) + (unsigned)((8 * fq + (fr >> 2)) * 544 + (fr & 3) * 8 + wid * 64);
                  const unsigned ka[4] = {kb_, kb_ + 32, kb_ + 32 * 544, kb_ + 32 * 544 + 32}; bf16x8 kf[4]; tr_frag4(ka, 4 * 544, kf);
                  k0f[0] = kf[0]; k1f[0] = kf[1]; k0f[1] = kf[2]; k1f[1] = kf[3]; }
                const int t0 = 16 * ti + 4 * fq;
                f32x4 sgv, emv;
#pragma unroll
                for (int r = 0; r < 4; ++r) { const float Mr = fmaxf(m_st, cP4[r]); sgv[r] = __expf(m_st - Mr); emv[r] = __expf(-(cC4[r] + Mr)); }
                const float decay = __expf(m_st - fmaxf(m_st, cPl));
                const bool wr_out = !(l == 1 && cin < 4);
#pragma unroll
                for (int es = 0; es < 2; ++es) {
                    f32x4 n1o = (f32x4){0.f, 0.f, 0.f, 0.f}, n1a = n1o, n2o = n1o, n2a = n1o;
                    const LAS unsigned char* co = lds + ML_CT + es * 18432 + (16 * wh + fr) * 544 + fq * 16;
                    const LAS unsigned char* ca = lds + ML_CT + es * 18432 + (32 + fr) * 544 + fq * 16;
                    const unsigned vtr = (unsigned)(size_t)(lds + ML_V + es * 14336) + (unsigned)((8 * fq + (fr >> 2)) * 112 + (fr & 3) * 8);
                    { bf16x8 vof[2], vaf[2];
                      { const unsigned va_[4] = {vtr + wh * 32, vtr + 64, vtr + 3584 + wh * 32, vtr + 3584 + 64}; bf16x8 vf[4]; tr_frag4(va_, 448, vf); vof[0] = vf[0]; vaf[0] = vf[1]; vof[1] = vf[2]; vaf[1] = vf[3]; }
                      __builtin_amdgcn_sched_barrier(0);
#pragma unroll
                      for (int ks = 0; ks < 2; ++ks) {
                          n1o = __builtin_amdgcn_mfma_f32_16x16x32_bf16(af[ks], vof[ks], n1o, 0, 0, 0);
                          n1a = __builtin_amdgcn_mfma_f32_16x16x32_bf16(af[ks], vaf[ks], n1a, 0, 0, 0); }
                      __builtin_amdgcn_sched_barrier(0); }
#pragma unroll
                    for (int kb = 0; kb < 2; ++kb) {
                        bf16x8 cof[4], caf[4];
#pragma unroll
                        for (int kd = 0; kd < 4; ++kd) { cof[kd] = *(const LAS bf16x8*)(co + (4 * kb + kd) * 64); caf[kd] = *(const LAS bf16x8*)(ca + (4 * kb + kd) * 64); }
                        __builtin_amdgcn_sched_barrier(0);
#pragma unroll
                        for (int kd = 0; kd < 4; ++kd) {
                            n2o = __builtin_amdgcn_mfma_f32_16x16x32_bf16(qf[4 * kb + kd], cof[kd], n2o, 0, 0, 0);
                            n2a = __builtin_amdgcn_mfma_f32_16x16x32_bf16(qf[4 * kb + kd], caf[kd], n2a, 0, 0, 0); }
                        __builtin_amdgcn_sched_barrier(0);
                    }
#pragma unroll
                    for (int r = 0; r < 4; ++r) {
                        const float den = __shfl(n1a[r] + sgv[r] * n2a[r], lane & 48);
                        const float hv = (n1o[r] + sgv[r] * n2o[r]) * __builtin_amdgcn_rcpf(fmaxf(fabsf(den), emv[r]));
                        if (wr_out) OUT[(size_t)(rbase + n0 + t0 + r) * 1024 + hd * 256 + (2 * eg2 + es) * 32 + 16 * wh + fr] = (bf16_t)f2bf(hv);
                    }
#pragma unroll
                    for (int j = 0; j < 2; ++j)
#pragma unroll
                        for (int e = 0; e < 3; ++e) Cacc[es][j][e] = Cacc[es][j][e] * decay;
                    const unsigned vwr = vtr + 7168;
                    bf16x8 v0f[2], v1f[2], v2f[2];
                    { const unsigned wa_[6] = {vwr, vwr + 32, vwr + 64, vwr + 3584, vwr + 3584 + 32, vwr + 3584 + 64}; bf16x8 wf[6]; tr_frag6(wa_, 448, wf);
                      v0f[0] = wf[0]; v1f[0] = wf[1]; v2f[0] = wf[2]; v0f[1] = wf[3]; v1f[1] = wf[4]; v2f[1] = wf[5]; }
                    __builtin_amdgcn_sched_barrier(0);
#pragma unroll
                    for (int ks = 0; ks < 2; ++ks) {
                        Cacc[es][0][0] = __builtin_amdgcn_mfma_f32_16x16x32_bf16(k0f[ks], v0f[ks], Cacc[es][0][0], 0, 0, 0);
                        Cacc[es][0][1] = __builtin_amdgcn_mfma_f32_16x16x32_bf16(k0f[ks], v1f[ks], Cacc[es][0][1], 0, 0, 0);
                        Cacc[es][0][2] = __builtin_amdgcn_mfma_f32_16x16x32_bf16(k0f[ks], v2f[ks], Cacc[es][0][2], 0, 0, 0);
                        Cacc[es][1][0] = __builtin_amdgcn_mfma_f32_16x16x32_bf16(k1f[ks], v0f[ks], Cacc[es][1][0], 0, 0, 0);
                        Cacc[es][1][1] = __builtin_amdgcn_mfma_f32_16x16x32_bf16(k1f[ks], v1f[ks], Cacc[es][1][1], 0, 0, 0);
                        Cacc[es][1][2] = __builtin_amdgcn_mfma_f32_16x16x32_bf16(k1f[ks], v2f[ks], Cacc[es][1][2], 0, 0, 0);
                    }
                    __builtin_amdgcn_sched_barrier(0);
                }
            }
            __syncthreads();
#pragma unroll
            for (int es = 0; es < 2; ++es)
#pragma unroll
                for (int j = 0; j < 2; ++j) { const int dcol = (16 * (2 * wid + j) + 4 * fq) * 2;
                    *(LAS u32x2*)(lds + ML_CT + es * 18432 + fr * 544 + dcol) = pack4(Cacc[es][j][0]);
                    *(LAS u32x2*)(lds + ML_CT + es * 18432 + (16 + fr) * 544 + dcol) = pack4(Cacc[es][j][1]);
                    if (fr == 0) *(LAS u32x2*)(lds + ML_CT + es * 18432 + 32 * 544 + dcol) = pack4(Cacc[es][j][2]); }
        }
        if (c >= 0) m_st = cCl + fmaxf(m_st, cPl);
        if (cn < 68) {
            const int cin = cn < 4 ? (dir ? 3 - cn : cn) : 4 + (dir ? 67 - cn : cn - 4); const size_t gb = (size_t)((b * 68 + cin) * 8 + dir * 4 + hd) * 64;
            ca0 = *(const f32x4*)(GAa + gb + gs0); ca1 = *(const f32x4*)(GAa + gb + gs0 + 16); caw = GAa[gb + vrow];
            cP4 = *(const f32x4*)(GPp + gb + gt0); cC4 = *(const f32x4*)(GCc + gb + gt0); cPt = GPp[gb + gt]; cPl = GPp[gb + jl]; cCl = GCc[gb + jl]; }
        if (cn < 68) {
#pragma unroll
            for (int j = 0; j < 4; ++j) { const int q = tid + NTHR * j;
                *(LAS u32x4*)(lds + ML_Q + (q >> 5) * 544 + (q & 31) * 16) = rq[j];
                *(LAS u32x4*)(lds + ML_K + (q >> 5) * 544 + (q & 31) * 16) = rk[j]; }
            *(LAS u32x4*)(lds + ML_V + (tid >> 8) * 14336 + ((tid & 255) >> 2) * 112 + (tid & 3) * 16) = rv[0];
        }
        __syncthreads();
    }
}

constexpr int SS_C = 0, SS_B = 18432, SS_X = 36864, SS_G = 67584, SS_S = 77824;
__device__ __forceinline__ void ssd_chunk_item(const Params& p, int l, int item, LAS unsigned char* lds) {
    const int tid0 = tid_fresh(), wid = __builtin_amdgcn_readfirstlane(tid0 >> 6);
    const int b = item >> 5, hd = (item >> 1) & 15, dir = item & 1, grp = hd >> 2;
    const bf16_t* BC = (const bf16_t*)(p.ws + WS_BC); const bf16_t* CC = (const bf16_t*)(p.ws + WS_CC); const bf16_t* XC = (const bf16_t*)(p.ws + WS_XCT);
    const float* ACS = (const float*)(p.ws + WS_SACS); const float* SDT = (const float*)(p.ws + WS_SDT);
    bf16_t* OUT = (bf16_t*)(p.ws + (dir ? WS_YB : WS_YF));
    const float dskip = p.sd[l * 16 + hd];
    const int ti = wid >> 1, wh = wid & 1, jl = dir ? 0 : 63;
    __syncthreads();
    for (int i = tid0; i < 18432 / 4; i += NTHR) ((LAS unsigned*)(lds + SS_S))[i] = 0u;
    f32x4 Sacc[2][2];
#pragma unroll
    for (int ph = 0; ph < 2; ++ph) { Sacc[ph][0] = (f32x4){0.f, 0.f, 0.f, 0.f}; Sacc[ph][1] = Sacc[ph][0]; }
    f32x4 cs0 = (f32x4){0.f, 0.f, 0.f, 0.f}, cs1 = cs0, ct4 = cs0; float cat = 0.f, cal = 0.f, csw = 0.f, cdw = 0.f;
    __syncthreads();
    for (int c = -1; c < 68; ++c) {
        const int cn = c + 1;
        const int tid = tid_fresh(), lane = tid & 63, fr = lane & 15, fq = lane >> 4;
        const int xph = tid >> 8, xrow = (tid & 255) >> 2, xch = tid & 3;
        const int gs0 = 16 * (2 * wh) + 4 * fq, gt = 16 * ti + fr, gt0 = 16 * ti + 4 * fq;
        u32x4 rc[2], rb[2], rx = (u32x4){0u, 0u, 0u, 0u};
#pragma unroll
        for (int j = 0; j < 2; ++j) { rc[j] = (u32x4){0u, 0u, 0u, 0u}; rb[j] = rc[j]; }
        if (cn < 68) {
            const int cin = cn < 4 ? (dir ? 3 - cn : cn) : 4 + (dir ? 67 - cn : cn - 4), gc = b * 68 + cin;
            int rbase, n0, len; chunk_geom(gc, rbase, n0, len);
#pragma unroll
            for (int j = 0; j < 2; ++j) { const int q = tid + NTHR * j;
                const size_t ro = (size_t)(rbase + n0 + (q >> 4)) * 512 + grp * 128 + (q & 15) * 8;
                rc[j] = *(const u32x4*)(CC + ro); rb[j] = *(const u32x4*)(BC + ro); }
            rx = *(const u32x4*)(XC + (size_t)(rbase + n0 + xrow) * 1024 + hd * 64 + xph * 32 + xch * 8);
        }
        if (c >= 0) {
            const int cin = c < 4 ? (dir ? 3 - c : c) : 4 + (dir ? 67 - c : c - 4), gc = b * 68 + cin;
            int rbase, n0, len; chunk_geom(gc, rbase, n0, len);
            {
                f32x4 st[2] = {(f32x4){0.f, 0.f, 0.f, 0.f}, (f32x4){0.f, 0.f, 0.f, 0.f}};
                const LAS unsigned char* cbp = lds + SS_C + (16 * ti + fr) * 288 + fq * 16;
                const LAS unsigned char* bb0 = lds + SS_B + (16 * (2 * wh) + fr) * 288 + fq * 16;
                bf16x8 cf[4], b0f[4], b1f[4];
#pragma unroll
                for (int kn = 0; kn < 4; ++kn) { cf[kn] = *(const LAS bf16x8*)(cbp + kn * 64); b0f[kn] = *(const LAS bf16x8*)(bb0 + kn * 64); b1f[kn] = *(const LAS bf16x8*)(bb0 + 16 * 288 + kn * 64); }
                __builtin_amdgcn_sched_barrier(0);
#pragma unroll
                for (int kn = 0; kn < 4; ++kn) {
                    st[0] = __builtin_amdgcn_mfma_f32_16x16x32_bf16(b0f[kn], cf[kn], st[0], 0, 0, 0);
                    st[1] = __builtin_amdgcn_mfma_f32_16x16x32_bf16(b1f[kn], cf[kn], st[1], 0, 0, 0);
                }
                __builtin_amdgcn_sched_barrier(0);
                const int t = 16 * ti + fr; const float at = cat;
#pragma unroll
                for (int j = 0; j < 2; ++j) { const int s0 = 16 * (2 * wh + j) + 4 * fq; const f32x4 av = j ? cs1 : cs0;
                    f32x4 o;
#pragma unroll
                    for (int r = 0; r < 4; ++r) { const bool keep = dir ? (s0 + r >= t) : (s0 + r <= t); o[r] = keep ? st[j][r] * __expf(at - av[r]) : 0.f; }
                    *(LAS u32x2*)(lds + SS_G + t * 160 + s0 * 2) = pack4(o); }
                { float f[8]; unpack8(*(const LAS u32x4*)(lds + SS_X + xph * 15360 + xrow * 80 + xch * 16), f);
                  const float w = __expf(cal - csw); f32x4 o0, o1, w0, w1;
#pragma unroll
                  for (int i = 0; i < 4; ++i) { o0[i] = f[i] * cdw; o1[i] = f[4 + i] * cdw; w0[i] = o0[i] * w; w1[i] = o1[i] * w; }
                  *(LAS u32x4*)(lds + SS_X + xph * 15360 + 5120 + xrow * 80 + xch * 16) = pack8(o0, o1);
                  *(LAS u32x4*)(lds + SS_X + xph * 15360 + 10240 + xrow * 80 + xch * 16) = pack8(w0, w1); }
            }
            __syncthreads();
            {
                const LAS unsigned char* gb = lds + SS_G + (16 * ti + fr) * 160 + fq * 16;
                const LAS unsigned char* cbp = lds + SS_C + (16 * ti + fr) * 288 + fq * 16;
                const unsigned btr = (unsigned)(size_t)(lds + SS_B) + (unsigned)((8 * fq + (fr >> 2)) * 288 + (fr & 3) * 8 + wid * 32);
                bf16x8 gf[2], cf[4], btf[2];
#pragma unroll
                for (int ks = 0; ks < 2; ++ks) gf[ks] = *(const LAS bf16x8*)(gb + ks * 64);
#pragma unroll
                for (int kn = 0; kn < 4; ++kn) cf[kn] = *(const LAS bf16x8*)(cbp + kn * 64);
#pragma unroll
                for (int ks = 0; ks < 2; ++ks) btf[ks] = tr_frag(btr + ks * 9216, btr + ks * 9216 + 1152);
                const int t0 = 16 * ti + 4 * fq;
                f32x4 eav; eav[0] = __expf(ct4[0]); eav[1] = __expf(ct4[1]); eav[2] = __expf(ct4[2]); eav[3] = __expf(ct4[3]);
                const float dec = __expf(cal);
                const bool wr_out = !(l == 1 && cin < 4);
#pragma unroll
                for (int ph = 0; ph < 2; ++ph) {
                    f32x4 y1 = (f32x4){0.f, 0.f, 0.f, 0.f}, y2 = y1;
                    const LAS unsigned char* sb = lds + SS_S + ph * 9216 + (16 * wh + fr) * 288 + fq * 16;
                    const unsigned xtr = (unsigned)(size_t)(lds + SS_X + ph * 15360 + 5120) + (unsigned)((8 * fq + (fr >> 2)) * 80 + (fr & 3) * 8);
                    bf16x8 xf[2], sf[4], xw0f[2], xw1f[2];
#pragma unroll
                    for (int kn = 0; kn < 4; ++kn) sf[kn] = *(const LAS bf16x8*)(sb + kn * 64);
                    { const unsigned xa_[6] = {xtr + wh * 32, xtr + 2560 + wh * 32, xtr + 5120, xtr + 5120 + 32, xtr + 5120 + 2560, xtr + 5120 + 2560 + 32}; bf16x8 xq[6]; tr_frag6(xa_, 320, xq);
                      xf[0] = xq[0]; xf[1] = xq[1]; xw0f[0] = xq[2]; xw1f[0] = xq[3]; xw0f[1] = xq[4]; xw1f[1] = xq[5]; }
                    __builtin_amdgcn_sched_barrier(0);
#pragma unroll
                    for (int ks = 0; ks < 2; ++ks) y1 = __builtin_amdgcn_mfma_f32_16x16x32_bf16(gf[ks], xf[ks], y1, 0, 0, 0);
#pragma unroll
                    for (int kn = 0; kn < 4; ++kn) y2 = __builtin_amdgcn_mfma_f32_16x16x32_bf16(cf[kn], sf[kn], y2, 0, 0, 0);
#pragma unroll
                    for (int r = 0; r < 4; ++r) {
                        float yv = y1[r] + eav[r] * y2[r];
                        if (dir == 0) yv += dskip * bf2f(*(const LAS bf16_t*)(lds + SS_X + ph * 15360 + (t0 + r) * 80 + (16 * wh + fr) * 2));
                        if (wr_out) OUT[(size_t)(rbase + n0 + t0 + r) * 1024 + hd * 64 + ph * 32 + 16 * wh + fr] = (bf16_t)f2bf(yv);
                    }
                    Sacc[ph][0] = Sacc[ph][0] * dec; Sacc[ph][1] = Sacc[ph][1] * dec;
#pragma unroll
                    for (int ks = 0; ks < 2; ++ks) {
                        Sacc[ph][0] = __builtin_amdgcn_mfma_f32_16x16x32_bf16(btf[ks], xw0f[ks], Sacc[ph][0], 0, 0, 0);
                        Sacc[ph][1] = __builtin_amdgcn_mfma_f32_16x16x32_bf16(btf[ks], xw1f[ks], Sacc[ph][1], 0, 0, 0); }
                    __builtin_amdgcn_sched_barrier(0);
                }
            }
            __syncthreads();
#pragma unroll
            for (int ph = 0; ph < 2; ++ph) { const int ncol = (16 * wid + 4 * fq) * 2;
              *(LAS u32x2*)(lds + SS_S + ph * 9216 + fr * 288 + ncol) = pack4(Sacc[ph][0]);
              *(LAS u32x2*)(lds + SS_S + ph * 9216 + (16 + fr) * 288 + ncol) = pack4(Sacc[ph][1]); }
        }
        if (cn < 68) {
            const int cin = cn < 4 ? (dir ? 3 - cn : cn) : 4 + (dir ? 67 - cn : cn - 4); const size_t gb = (size_t)((b * 68 + cin) * 32 + dir * 16 + hd) * 64;
            cs0 = *(const f32x4*)(ACS + gb + gs0); cs1 = *(const f32x4*)(ACS + gb + gs0 + 16); csw = ACS[gb + xrow]; cdw = SDT[gb + xrow];
            ct4 = *(const f32x4*)(ACS + gb + gt0); cat = ACS[gb + gt]; cal = ACS[gb + jl];
#pragma unroll
            for (int j = 0; j < 2; ++j) { const int q = tid + NTHR * j;
                *(LAS u32x4*)(lds + SS_C + (q >> 4) * 288 + (q & 15) * 16) = rc[j];
                *(LAS u32x4*)(lds + SS_B + (q >> 4) * 288 + (q & 15) * 16) = rb[j]; }
            *(LAS u32x4*)(lds + SS_X + xph * 15360 + xrow * 80 + xch * 16) = rx;
        }
        __syncthreads();
    }
}

__device__ __forceinline__ void mlstm_finish_rows(const Params& p, int l, int row_lo, int gw, int ngw) {
    if (p.dup) return;
    const int lane = tid_fresh() & 63;
    const bf16_t* HF = (const bf16_t*)(p.ws + WS_HF2); const bf16_t* HB = (const bf16_t*)(p.ws + WS_HB2);
    bf16_t* BR = (bf16_t*)(p.ws + WS_BR);
    const float* ng = p.mnorm_g + l * 1024;
    int row = row_lo + gw;
    u32x2 ca[4], cb[4], co[4], na[4], nbv[4], no[4];
    if (row < MT) { const size_t so = (size_t)scanrow(row) * 1024;
#pragma unroll
        for (int hd = 0; hd < 4; ++hd) { const int c = hd * 256 + 4 * lane; ca[hd] = *(const u32x2*)(HF + so + c); cb[hd] = *(const u32x2*)(HB + so + c); co[hd] = *(const u32x2*)(BR + (size_t)row * 3072 + 1024 + c); } }
    for (; row < MT; row += ngw) {
        const int rn = row + ngw;
        if (rn < MT) { const size_t so = (size_t)scanrow(rn) * 1024;
#pragma unroll
            for (int hd = 0; hd < 4; ++hd) { const int c = hd * 256 + 4 * lane; na[hd] = *(const u32x2*)(HF + so + c); nbv[hd] = *(const u32x2*)(HB + so + c); no[hd] = *(const u32x2*)(BR + (size_t)rn * 3072 + 1024 + c); } }
#pragma unroll
        for (int hd = 0; hd < 4; ++hd) { const int c = hd * 256 + 4 * lane;
            const u32x2 a = ca[hd], b2 = cb[hd], o = co[hd];
            f32x4 h; h[0] = lo16(a.x) + lo16(b2.x); h[1] = hi16(a.x) + hi16(b2.x); h[2] = lo16(a.y) + lo16(b2.y); h[3] = hi16(a.y) + hi16(b2.y);
            const float ss = wave_sum((h[0] * h[0] + h[1] * h[1]) + (h[2] * h[2] + h[3] * h[3]));
            const float rs = __builtin_amdgcn_rsqf(ss * (1.f / 256.f) + EPS);
            const f32x4 g = *(const f32x4*)(ng + c);
            f32x4 r; r[0] = sigmoid_f(lo16(o.x)) * (h[0] * rs * g[0]); r[1] = sigmoid_f(hi16(o.x)) * (h[1] * rs * g[1]);
            r[2] = sigmoid_f(lo16(o.y)) * (h[2] * rs * g[2]); r[3] = sigmoid_f(hi16(o.y)) * (h[3] * rs * g[3]);
            u32x2 w; w.x = pk2(r[0], r[1]); w.y = pk2(r[2], r[3]);
            *(u32x2*)(BR + (size_t)row * 3072 + 1024 + c) = w; }
#pragma unroll
        for (int hd = 0; hd < 4; ++hd) { ca[hd] = na[hd]; cb[hd] = nbv[hd]; co[hd] = no[hd]; }
    }
}
__device__ __forceinline__ void ssd_finish_rows(const Params& p, int l, int row_lo, int gw, int ngw) {
    if (p.dup) return;
    const int lane = tid_fresh() & 63;
    const bf16_t* YF = (const bf16_t*)(p.ws + WS_YF); const bf16_t* YB = (const bf16_t*)(p.ws + WS_YB);
    bf16_t* BR = (bf16_t*)(p.ws + WS_BR);
    const float* ng = p.snorm_g + l * 1024;
    int row = row_lo + gw;
    u32x2 ca[4], cb[4], cz[4], na[4], nbv[4], nz[4];
    if (row < MT) {
#pragma unroll
        for (int j = 0; j < 4; ++j) { const int c = 4 * lane + 256 * j; ca[j] = *(const u32x2*)(YF + (size_t)row * 1024 + c); cb[j] = *(const u32x2*)(YB + (size_t)row * 1024 + c); cz[j] = *(const u32x2*)(BR + (size_t)row * 3072 + 2048 + c); } }
    for (; row < MT; row += ngw) {
        const int rn = row + ngw;
        if (rn < MT) {
#pragma unroll
            for (int j = 0; j < 4; ++j) { const int c = 4 * lane + 256 * j; na[j] = *(const u32x2*)(YF + (size_t)rn * 1024 + c); nbv[j] = *(const u32x2*)(YB + (size_t)rn * 1024 + c); nz[j] = *(const u32x2*)(BR + (size_t)rn * 3072 + 2048 + c); } }
        f32x4 v[4]; float ss = 0.f;
#pragma unroll
        for (int j = 0; j < 4; ++j) { const u32x2 a = ca[j], b2 = cb[j], z = cz[j];
            v[j][0] = (lo16(a.x) + lo16(b2.x)) * silu_f(lo16(z.x)); v[j][1] = (hi16(a.x) + hi16(b2.x)) * silu_f(hi16(z.x));
            v[j][2] = (lo16(a.y) + lo16(b2.y)) * silu_f(lo16(z.y)); v[j][3] = (hi16(a.y) + hi16(b2.y)) * silu_f(hi16(z.y));
            ss += (v[j][0] * v[j][0] + v[j][1] * v[j][1]) + (v[j][2] * v[j][2] + v[j][3] * v[j][3]); }
        const float rs = __builtin_amdgcn_rsqf(wave_sum(ss) * (1.f / 1024.f) + EPS);
#pragma unroll
        for (int j = 0; j < 4; ++j) { const int c = 4 * lane + 256 * j; const f32x4 g = *(const f32x4*)(ng + c);
            u32x2 w; w.x = pk2(v[j][0] * rs * g[0], v[j][1] * rs * g[1]); w.y = pk2(v[j][2] * rs * g[2], v[j][3] * rs * g[3]);
            *(u32x2*)(BR + (size_t)row * 3072 + 2048 + c) = w; }
#pragma unroll
        for (int j = 0; j < 4; ++j) { ca[j] = na[j]; cb[j] = nbv[j]; cz[j] = nz[j]; }
    }
}

__device__ __forceinline__ void phase_route(const Params& p, int l, unsigned char* ldsb, int bid, int nb) {
    float* lds = reinterpret_cast<float*>(ldsb);
    float* Wt = lds;
    int* hist = reinterpret_cast<int*>(lds + 36 * 1024);
    const int tid = tid_fresh(), lane = tid & 63, wave = tid >> 6;
    const int row_lo = l == 0 ? 0 : MC, rpb = l == 0 ? 68 : 64;
    const float* wrg = p.w_rg + (size_t)l * 1024 * 4; const float* wre = p.w_re + (size_t)l * 1024 * 32;
    for (int i = tid; i < 1024 * 4; i += NTHR) { const int k = i >> 2, g = i & 3; Wt[g * 1024 + (k ^ ((g & 7) << 2))] = wrg[i]; }
    for (int i = tid; i < 1024 * 32; i += NTHR) { const int k = i >> 5, e = i & 31; Wt[(4 + e) * 1024 + (k ^ (((4 + e) & 7) << 2))] = wre[i]; }
    const float* mod = (const float*)(p.ws + WS_MOD) + l * 5 * 6144;
    int* EID = (int*)(p.ws + WS_EID); float* EWT = (float*)(p.ws + WS_EWT);
    for (int vb = bid; vb < 256; vb += nb) {
        if (tid < 32) hist[tid] = 0;
        __syncthreads();
        for (int rr = wave; rr < rpb; rr += 8) {
            const int row = row_lo + vb * rpb + rr;
            f32x4 v[4];
            const float* mr = mod + modrow(row) * 6144;
            {
              const bool from_in = (l == 0) && !p.dup;
              const float* res = row < MC ? p.ctx + (size_t)row * 1024 : p.x + (size_t)(row - MC) * 1024;
              bf16_t* xlr = (bf16_t*)(p.ws + WS_XL) + (size_t)row * 1024;
              u32x2 o2[4];
#pragma unroll
              for (int j = 0; j < 4; ++j) {
                  if (from_in) v[j] = *(const f32x4*)(res + 4 * lane + 256 * j);
                  else { const u32x2 xr = *(const u32x2*)(xlr + 4 * lane + 256 * j); v[j] = (f32x4){lo16(xr.x), hi16(xr.x), lo16(xr.y), hi16(xr.y)}; }
                  o2[j] = *(const u32x2*)((const bf16_t*)(p.ws + WS_OL) + (size_t)row * 1024 + 4 * lane + 256 * j); }
              if (!p.dup) {
#pragma unroll
                  for (int j = 0; j < 4; ++j) { const f32x4 g2 = *(const f32x4*)(mr + 2 * 1024 + 4 * lane + 256 * j);
                      v[j][0] += g2[0] * lo16(o2[j].x); v[j][1] += g2[1] * hi16(o2[j].x); v[j][2] += g2[2] * lo16(o2[j].y); v[j][3] += g2[3] * hi16(o2[j].y);
                      *(u32x2*)(xlr + 4 * lane + 256 * j) = pack4(v[j]); } } }
            norm_mod_row(v, p.g_ffn + l * 1024, mr + 3 * 1024, mr + 4 * 1024, lane);
            store_row_bf16((bf16_t*)(p.ws + WS_H) + (size_t)row * 1024, v, lane);
            float lg[36];
#pragma unroll
            for (int e = 0; e < 36; ++e) { float s = 0.f;
#pragma unroll
                for (int j = 0; j < 4; ++j) { const f32x4 w = *(const f32x4*)(Wt + e * 1024 + ((4 * lane + 256 * j) ^ ((e & 7) << 2))); s += (v[j][0] * w[0] + v[j][1] * w[1]) + (v[j][2] * w[2] + v[j][3] * w[3]); }
                lg[e] = wave_sum(s); }
            float gl[4]; int gi = 0; float gmax;
#pragma unroll
            for (int g = 0; g < 4; ++g) gl[g] = lg[g] + p.b_rg[l * 4 + g];
            gmax = gl[0];
#pragma unroll
            for (int g = 1; g < 4; ++g) if (gl[g] > gmax) { gmax = gl[g]; gi = g; }
            float den = 0.f;
#pragma unroll
            for (int g = 0; g < 4; ++g) den += __expf(gl[g] - gmax);
            const float pg = 1.f / den;
            float v1 = -3.0e38f, v2 = -3.0e38f; int i1 = 0, i2 = 0;
#pragma unroll
            for (int g = 0; g < 4; ++g) if (g == gi) {
#pragma unroll
                for (int j = 0; j < 8; ++j) { const float x = lg[4 + g * 8 + j] + p.b_re[l * 32 + g * 8 + j];
                    if (x > v1) { v2 = v1; i2 = i1; v1 = x; i1 = j; } else if (x > v2) { v2 = x; i2 = j; } } }
            const float e2 = __expf(v2 - v1), w1 = pg / (1.f + e2), w2 = pg * e2 / (1.f + e2);
            if (lane == 0) { EID[row * 2] = gi * 8 + i1; EID[row * 2 + 1] = gi * 8 + i2; EWT[row * 2] = w1; EWT[row * 2 + 1] = w2;
                atomicAdd(&hist[gi * 8 + i1], 1); atomicAdd(&hist[gi * 8 + i2], 1); }
        }
        __syncthreads();
        if (tid < 32) ((int*)(p.ws + WS_HIST))[vb * 32 + tid] = hist[tid];
        __syncthreads();
    }
    __syncthreads();
    float* scr = lds + wave * (64 * 65);
    convert_run(p, (CV_IN_SCAN && nb == 256) ? -1 : l, l + 1 < 2 ? l + 1 : -1, bid * 8 + wave, nb * 8, scr, lane);
}

__device__ __forceinline__ void phase_scatter(const Params& p, int l, unsigned char* ldsb, int bid, int nb) {
    int* li = reinterpret_cast<int*>(ldsb);
    int* tot = li; int* pre = li + 32; int* pst = li + 64; int* ea = li + 128; int* pos = li + 384;
    const int tid = tid_fresh(), lane = tid & 63, wave = tid >> 6;
    const int row_lo = l == 0 ? 0 : MC, rpb = l == 0 ? 68 : 64;
    const int* HIST = (const int*)(p.ws + WS_HIST); const int* EID = (const int*)(p.ws + WS_EID);
    int* SLOT = (int*)(p.ws + WS_SLOT);
    for (int vb = bid; vb < 256; vb += nb) {
        __syncthreads();
        { const int e = tid & 31, jg = tid >> 5; int hv[16];
#pragma unroll
          for (int i = 0; i < 16; ++i) hv[i] = HIST[(jg * 16 + i) * 32 + e];
          int t = 0, pr = 0;
#pragma unroll
          for (int i = 0; i < 16; ++i) { t += hv[i]; pr += (jg * 16 + i < vb) ? hv[i] : 0; }
          li[512 + jg * 32 + e] = t; li[1024 + jg * 32 + e] = pr; }
        __syncthreads();
        if (tid < 32) { int t = 0, pr = 0;
#pragma unroll
            for (int g = 0; g < 16; ++g) { t += li[512 + g * 32 + tid]; pr += li[1024 + g * 32 + tid]; }
            tot[tid] = t; pre[tid] = pr; }
        __syncthreads();
        if (tid == 0) { int s = 0; for (int e = 0; e < 32; ++e) { pst[e] = s; s += ((tot[e] + 255) >> 8) << 8; }
            if (vb == 0) { int* BE = (int*)(p.ws + WS_BLKEXP); int nblk = 0;
                for (int e = 0; e < 32; ++e) { const int nbk = (tot[e] + 255) >> 8; for (int j = 0; j < nbk; ++j) BE[nblk++] = e; }
                BE[200] = nblk; } }
        if (tid < rpb * 2) ea[tid] = EID[(row_lo + vb * rpb) * 2 + tid];
        __syncthreads();
        if (tid < rpb * 2) { const int e = ea[tid]; int rk = 0; for (int j = 0; j < tid; ++j) rk += (ea[j] == e) ? 1 : 0;
            const int ps = pst[e] + pre[e] + rk; SLOT[(row_lo + vb * rpb) * 2 + tid] = ps; ((int*)(p.ws + WS_TOK))[ps] = row_lo + vb * rpb + (tid >> 1); }
        if (vb == 0 && tid < 32) { int* TOK = (int*)(p.ws + WS_TOK); const int e0 = pst[tid] + tot[tid], e1 = pst[tid] + (((tot[tid] + 255) >> 8) << 8);
            for (int q = e0; q < e1; ++q) TOK[q] = row_lo; }
    }
    __syncthreads();
}

__device__ __forceinline__ void phase_combine(const Params& p, int l, int bid, int nb) {
    if (p.dup && l == 0) return;
    const int lane = tid_fresh() & 63, wave = tid_fresh() >> 6;
    const float* mod = (const float*)(p.ws + WS_MOD);
    const int* SLOT = (const int*)(p.ws + WS_SLOT); const float* EWT = (const float*)(p.ws + WS_EWT);
    const bf16_t* Y = (const bf16_t*)(p.ws + WS_Y);
    bf16_t* XL = (bf16_t*)(p.ws + WS_XL);
    const int row_lo = l == 0 ? 0 : MC, stride = nb * 8;
    for (int rowA = row_lo + bid * 8 + wave; rowA < MT; rowA += 2 * stride) {
        const int rowB = rowA + stride; const bool hasB = rowB < MT; const int rb = hasB ? rowB : rowA;
        const int sA0 = SLOT[rowA * 2], sA1 = SLOT[rowA * 2 + 1], sB0 = SLOT[rb * 2], sB1 = SLOT[rb * 2 + 1];
        const float wA0 = EWT[rowA * 2], wA1 = EWT[rowA * 2 + 1], wB0 = EWT[rb * 2], wB1 = EWT[rb * 2 + 1];
        u32x2 yA0[4], yA1[4], yB0[4], yB1[4], xA[4], xB[4];
#pragma unroll
        for (int j = 0; j < 4; ++j) { const int c = 4 * lane + 256 * j;
            yA0[j] = *(const u32x2*)(Y + (size_t)sA0 * 1024 + c); yA1[j] = *(const u32x2*)(Y + (size_t)sA1 * 1024 + c); xA[j] = *(const u32x2*)(XL + (size_t)rowA * 1024 + c);
            yB0[j] = *(const u32x2*)(Y + (size_t)sB0 * 1024 + c); yB1[j] = *(const u32x2*)(Y + (size_t)sB1 * 1024 + c); xB[j] = *(const u32x2*)(XL + (size_t)rb * 1024 + c); }
#pragma unroll
        for (int half = 0; half < 2; ++half) {
            if (half == 1 && !hasB) break;
            const int row = half ? rowB : rowA; const float w0 = half ? wB0 : wA0, w1 = half ? wB1 : wA1;
            const float* g5 = mod + (l * 5 + modrow(row)) * 6144 + 5 * 1024;
            f32x4 v[4];
#pragma unroll
            for (int j = 0; j < 4; ++j) { const int c = 4 * lane + 256 * j;
                const u32x2 a = half ? yB0[j] : yA0[j], b2 = half ? yB1[j] : yA1[j];
                f32x4 y; y[0] = w0 * lo16(a.x) + w1 * lo16(b2.x); y[1] = w0 * hi16(a.x) + w1 * hi16(b2.x); y[2] = w0 * lo16(a.y) + w1 * lo16(b2.y); y[3] = w0 * hi16(a.y) + w1 * hi16(b2.y);
                const u32x2 xr = half ? xB[j] : xA[j];
                v[j] = (f32x4){lo16(xr.x), hi16(xr.x), lo16(xr.y), hi16(xr.y)} + *(const f32x4*)(g5 + c) * y; }
            if (l == 0) {
#pragma unroll
                for (int j = 0; j < 4; ++j) *(u32x2*)(XL + (size_t)row * 1024 + 4 * lane + 256 * j) = pack4(v[j]);
                const float* mr = mod + (5 + modrow(row)) * 6144;
                norm_mod_row(v, p.g_mix + 1024, mr, mr + 1024, lane);
                store_row_bf16((bf16_t*)(p.ws + WS_H) + (size_t)row * 1024, v, lane);
            } else {
                norm_mod_row(v, p.g_final, nullptr, nullptr, lane);
                float* o = p.out + (size_t)(row - MC) * 1024;
#pragma unroll
                for (int j = 0; j < 4; ++j) *(f32x4*)(o + 4 * lane + 256 * j) = v[j];
            }
        }
    }
}

#define XB_TMO      128
#define XB_XCNT(j)  (256  + 64 * (j))
#define XB_XSUB(j)  (1280 + 64 * (j))
#define XB_XGEN(j)  (2304 + 64 * (j))
#define XB_TOP      3328
#define XB_TOPGEN   3392
#define XCD_BAR_WORDS 3456
#define XB_SSD_DONE(l) (3520 + 64 * (l))
#define XB_SPIN_CAP (1u << 18)
__device__ __forceinline__ unsigned xb_ld(unsigned* p)              { return __hip_atomic_load(p, __ATOMIC_RELAXED, __HIP_MEMORY_SCOPE_AGENT); }
__device__ __forceinline__ unsigned xb_add(unsigned* p, unsigned v) { return __hip_atomic_fetch_add(p, v, __ATOMIC_RELAXED, __HIP_MEMORY_SCOPE_AGENT); }
__device__ __forceinline__ unsigned xb_xcc_id() { return (unsigned)__builtin_amdgcn_s_getreg((3 << 11) | 20) & 0xFu; }
#define XB_SPIN(cond, bar) do { unsigned _sp = 0; while (cond) { __builtin_amdgcn_s_sleep(1); \
    if ((++_sp & 255u) == 0u) { if (xb_ld(&(bar)[XB_TMO])) break; if (_sp > XB_SPIN_CAP) { atomicAdd(&(bar)[XB_TMO], 1u); break; } } } } while (0)
constexpr int NPH_L = 12, NPHASES = 1 + 2 * NPH_L;
__device__ __forceinline__ void run_phase(const Params& p, int ph, unsigned char* lds) {
    const int bid = blockIdx.x, nb = gridDim.x;
    const int wave = tid_fresh() >> 6;
#ifndef ONLY_S
    if (ph == 0) { phase_pre(p, lds, bid, nb); return; }
#else
    if (ph == 0) { if (ONLY_S == 99) phase_pre(p, lds, bid, nb); return; }
#endif
    const int l = (ph - 1) / NPH_L, s = (ph - 1) % NPH_L;
    unsigned char* ws = p.ws;
    const int pm0 = l == 0 ? 0 : 4, nMrows = l == 0 ? 68 : 64, row_lo = l == 0 ? 0 : MC;
#ifdef ONLY_S
    if (s != ONLY_S) return;
#endif
    switch (s) {
    case 0: if (l == 0) phase_norm1(p, bid, nb); break;
    case 1: { EpiInproj E{ws};
              if (l == 0) { SchedGrid S{(const bf16_t*)(ws + WS_H), (const bf16_t*)(ws + WS_WIN), 1024, 1024, 0, 68, 45, nb, bid}; gemm_run(lds, S, E, 1024, 1024, 1024, 1); }
              else { SchedInproj1 S{(const bf16_t*)(ws + WS_H), (const bf16_t*)(ws + WS_WIN), nb, bid}; gemm_run(lds, S, E, 1024, 1024, 1024, 1); } } break;
    case 2: { { ConvW Wq, Wk; int whd = -1; const int d0 = (tid_fresh() & 31) * 8;
                for (int v = (bid * 1088) / nb; v < ((bid + 1) * 1088) / nb; ++v) { const int hd = v / 272, it = (v % 272) * 4 + hd;
                    if (hd != whd) { conv_load_w(p.mconv_w + (size_t)l * 4 * 2048, p.mconv_b + (size_t)l * 2048, hd * 256 + d0, Wq); conv_load_w(p.mconv_w + (size_t)l * 4 * 2048, p.mconv_b + (size_t)l * 2048, 1024 + hd * 256 + d0, Wk); whd = hd; }
                    conv_m_item(p, l, it, (LAS unsigned char*)lds, Wq, Wk); } }
              { ConvW Wbc, Wx; int wg = -1; const int cs = tid_fresh() & 31;
                for (int v = (bid * 1088) / nb; v < ((bid + 1) * 1088) / nb; ++v) { const int grp = v / 272, it = (v % 272) * 4 + grp;
                    if (grp != wg) { conv_load_w(p.sconv_w + (size_t)l * 4 * 2048, p.sconv_b + (size_t)l * 2048, 1024 + (cs >> 4) * 512 + grp * 128 + (cs & 15) * 8, Wbc); conv_load_w(p.sconv_w + (size_t)l * 4 * 2048, p.sconv_b + (size_t)l * 2048, grp * 256 + cs * 8, Wx); wg = grp; }
                    conv_s_item(p, l, it, (LAS unsigned char*)lds, Wbc, Wx); } }
              if (!p.dup) for (int it = bid; it < (l == 0 ? 272 : 256); it += nb) pool_window_item(p, it, (LAS unsigned char*)lds); } break;
    case 3: {
              int pool_c = bid, pool_g = nb;
              unsigned* sbar = (unsigned*)(ws + WS_BAR) + XB_SSD_DONE(l);
              if (nb == 256) { const int x = bid & 7, y = bid >> 3;
                  if (y < 16) { mlstm_chunk_item(p, l, (((y >> 3) * 8 + x) << 3) | (y & 7), (LAS unsigned char*)lds); pool_c = -1; }
                  else { ssd_chunk_item(p, l, ((((y - 16) >> 3) * 8 + x) << 3) | ((y - 16) & 7), (LAS unsigned char*)lds); pool_c = (y - 16) * 8 + x; pool_g = 128;
                      asm volatile("s_waitcnt vmcnt(0)" ::: "memory"); __syncthreads();
                      if (tid_fresh() == 0) { __builtin_amdgcn_fence(__ATOMIC_RELEASE, "agent"); asm volatile("s_waitcnt vmcnt(0)" ::: "memory"); (void)xb_add(sbar, 1u); } } }
              else { for (int it = bid; it < 256; it += nb) { if (it < 128) mlstm_chunk_item(p, l, it, (LAS unsigned char*)lds); else ssd_chunk_item(p, l, it - 128, (LAS unsigned char*)lds); } }
              if (pool_c >= 0 && !p.dup) { SchedPool S{(const bf16_t*)(ws + WS_BR), (const bf16_t*)(ws + WS_WPOOL), pm0, nMrows, pool_g, pool_c}; EpiPool E{(bf16_t*)(ws + WS_BR)};
                  gemm_run(lds, S, E, 256, 3072, 256, 1); }
              if (nb == 256 && bid >= 128) {
                  if (tid_fresh() == 0) { XB_SPIN(xb_ld(sbar) < 128u, (unsigned*)(ws + WS_BAR)); __builtin_amdgcn_fence(__ATOMIC_ACQUIRE, "agent"); asm volatile("s_waitcnt vmcnt(0)" ::: "memory"); }
                  __syncthreads();
                  ssd_finish_rows(p, l, row_lo, (bid - 128) * 8 + wave, 128 * 8); } } break;
    case 4: { mlstm_finish_rows(p, l, row_lo, bid * 8 + wave, nb * 8); if (nb != 256) ssd_finish_rows(p, l, row_lo, bid * 8 + wave, nb * 8); } break;
    case 5: { SchedGrid S{(const bf16_t*)(ws + WS_BR), (const bf16_t*)(ws + WS_WBR), 3072, 3072, pm0, nMrows, 4, nb, bid}; EpiBranch E{(const bf16_t*)(ws + WS_MG), (bf16_t*)(ws + WS_MERGED)};
              gemm_run(lds, S, E, 3072, 3072, 3072, 3); } break;
    case 6: { SchedGrid S{(const bf16_t*)(ws + WS_MERGED), (const bf16_t*)(ws + WS_WOUT), 1024, 1024, pm0, nMrows, 4, nb, bid}; EpiOut E{(bf16_t*)(ws + WS_OL)};
              gemm_run(lds, S, E, 1024, 1024, 1024, 1); } break;
    case 7: phase_route(p, l, lds, bid, nb); break;
    case 8: phase_scatter(p, l, lds, bid, nb); break;
    case 9: { const int* BE = (const int*)(ws + WS_BLKEXP);
              SchedMoe S{(const bf16_t*)(ws + WS_H), (const bf16_t*)(ws + WS_EW1), BE, (const int*)(ws + WS_TOK), 1024, BE[200], nb, bid, (size_t)1048576, (size_t)1024}; EpiMoe1 E{(bf16_t*)(ws + WS_ACT)};
              gemm_run<true>(lds, S, E, 1024, 1024, 1024, 1); } break;
    case 10: { const int* BE = (const int*)(ws + WS_BLKEXP);
              SchedMoe S{(const bf16_t*)(ws + WS_ACT), (const bf16_t*)(ws + WS_EW2), BE, nullptr, 512, BE[200], nb, bid, (size_t)524288, (size_t)512}; EpiMoe2 E{(bf16_t*)(ws + WS_Y)};
              gemm_run(lds, S, E, 512, 512, 512, 1); } break;
    case 11: phase_combine(p, l, bid, nb); break;
    }
}

__device__ __forceinline__ void xcd_barrier_complete(unsigned* bar, unsigned x, unsigned& nloc, unsigned& nx) {
    const unsigned G = gridDim.x * gridDim.y * gridDim.z;
    unsigned sum, cnt, mine, sp = 0u;
    for (;;) {
        sum = 0u; cnt = 0u; mine = 0u;
#pragma unroll
        for (unsigned j = 0; j < 16; ++j) { const unsigned c = xb_ld(&bar[XB_XCNT(j)]); sum += c; cnt += (c > 0u) ? 1u : 0u; mine = (j == x) ? c : mine; }
        if (sum == G) break;
        __builtin_amdgcn_s_sleep(1);
        if ((++sp & 255u) == 0u) { if (xb_ld(&bar[XB_TMO])) break; if (sp > XB_SPIN_CAP) { atomicAdd(&bar[XB_TMO], 1u); break; } }
    }
    nloc = mine > 0u ? mine : 1u; nx = cnt > 0u ? cnt : 1u;
}
__device__ __forceinline__ void xcd_barrier(unsigned* bar, volatile LAS unsigned* st) {
    asm volatile("s_waitcnt vmcnt(0)" ::: "memory");
    __syncthreads();
    if (threadIdx.x == 0) {
        __builtin_amdgcn_s_waitcnt(0);
        const unsigned x = xb_xcc_id();
        unsigned nloc = st[0], nx = st[1];
        if (nloc == 0u) { xcd_barrier_complete(bar, x, nloc, nx); st[0] = nloc; st[1] = nx; }
        const unsigned old = xb_add(&bar[XB_XSUB(x)], 1u);
        const unsigned gen = old / nloc;
        if (old + 1u == (gen + 1u) * nloc) {
            __builtin_amdgcn_fence(__ATOMIC_RELEASE, "agent");
            asm volatile("s_waitcnt vmcnt(0)" ::: "memory");
            const unsigned og = xb_add(&bar[XB_TOP], 1u);
            const unsigned tg = og / nx;
            if (og + 1u == (tg + 1u) * nx) xb_add(&bar[XB_TOPGEN], 1u);
            else XB_SPIN(xb_ld(&bar[XB_TOPGEN]) == tg, bar);
            __builtin_amdgcn_fence(__ATOMIC_ACQUIRE, "agent");
            xb_add(&bar[XB_XGEN(x)], 1u);
            asm volatile("s_waitcnt vmcnt(0)" ::: "memory");
        } else {
            XB_SPIN(xb_ld(&bar[XB_XGEN(x)]) == gen, bar);
            __builtin_amdgcn_fence(__ATOMIC_ACQUIRE, "agent");
            asm volatile("s_waitcnt vmcnt(0)" ::: "memory");
        }
    }
    __syncthreads();
}

constexpr int BAR_LDS_OFF = LDS_BYTES - 16;
__global__ void __launch_bounds__(NTHR, 2) fwd_kernel(Params pk) {
    extern __shared__ __attribute__((aligned(16))) unsigned char lds[];
    const Params& p = pk;
    const int lo = pk.ph_lo, hi = pk.ph_hi;
    unsigned* bar = (unsigned*)(pk.ws + WS_BAR);
    volatile LAS unsigned* bst = (volatile LAS unsigned*)((LAS unsigned char*)lds + BAR_LDS_OFF);
    if (hi - lo > 1) {
        if (threadIdx.x == 0) { bst[0] = 0u; bst[1] = 0u; (void)xb_add(&bar[XB_XCNT(xb_xcc_id())], 1u); }
        __syncthreads();
    }
#define STEP(k) if (lo <= (k) && (k) < hi) { \
    if (PROF_S >= 0 && blockIdx.x == 0 && threadIdx.x == 0) ((volatile LAS unsigned long long*)((LAS unsigned char*)lds + 163000))[k] = __builtin_amdgcn_s_memrealtime(); \
    run_phase(p, (k), lds); if ((k) + 1 < hi) { if (pk.dup < 0) cg::this_grid().sync(); else xcd_barrier(bar, bst); } }
    STEP(0) STEP(1) STEP(2) STEP(3) STEP(4) STEP(5) STEP(6) STEP(7) STEP(8) STEP(9) STEP(10) STEP(11) STEP(12)
    STEP(14) STEP(15) STEP(16) STEP(17) STEP(18) STEP(19) STEP(20) STEP(21) STEP(22) STEP(23) STEP(24)
#undef STEP
    if (PROF_S >= 0 && hi - lo > 1) {
        __syncthreads();
        if (blockIdx.x == 0 && threadIdx.x == 0) {
            volatile LAS unsigned long long* ts = (volatile LAS unsigned long long*)((LAS unsigned char*)lds + 163000);
            const unsigned long long tend = __builtin_amdgcn_s_memrealtime();
            float acc = 0.f;
            for (int k = 0; k < NPHASES; ++k) { if (k == 1 + NPH_L) continue; const int s = k == 0 ? 14 : (k - 1) % NPH_L; if (s != PROF_S) continue;
                int kn = k + 1; if (kn == 1 + NPH_L) kn++; const unsigned long long t1 = kn < NPHASES ? ts[kn] : tend; acc += (float)(t1 - ts[k]) * 0.001f; }
            __threadfence(); atomicAdd(pk.out, acc);
        }
    }
}

extern "C" void kernel_launch(void* const* d_in, const int* in_sizes, int n_in, void* d_out, int out_size, void* d_ws, size_t ws_size, hipStream_t stream) {
    static int grid_blocks = 0;
    if (!grid_blocks) {
        if (n_in != 31 || ws_size < WS_END) { fprintf(stderr, "kernel_launch: unexpected n_in %d / ws_size %zu (need %zu)\n", n_in, ws_size, (size_t)WS_END); grid_blocks = -1; return; }
        int dev = 0, cus = 0, per_cu = 0;
        hipGetDevice(&dev);
        hipDeviceGetAttribute(&cus, hipDeviceAttributeMultiprocessorCount, dev);
        if (hipFuncSetAttribute((const void*)fwd_kernel, hipFuncAttributeMaxDynamicSharedMemorySize, LDS_BYTES) != hipSuccess) fprintf(stderr, "kernel_launch: hipFuncSetAttribute failed\n");
        hipOccupancyMaxActiveBlocksPerMultiprocessor(&per_cu, (const void*)fwd_kernel, NTHR, LDS_BYTES);
        if (per_cu < 1) { fprintf(stderr, "kernel_launch: occupancy query says %d blocks per CU\n", per_cu); per_cu = 1; }
        grid_blocks = cus * per_cu;
        (void)hipGetLastError();
    }
    if (grid_blocks < 0) return;
    Params p{};
    const float** dst = (const float**)&p;
    for (int i = 0; i < 31; ++i) dst[i] = (const float*)d_in[i];
    p.out = (float*)d_out; p.ws = (unsigned char*)d_ws;
#if SINGLE_LAUNCH
    if (hipMemsetAsync((char*)d_ws + WS_BAR, 0, 16384, stream) != hipSuccess) fprintf(stderr, "kernel_launch: hipMemsetAsync failed\n");
    p.ph_lo = 0; p.ph_hi = NPHASES;
    void* args[] = {&p};
    hipError_t e = hipLaunchCooperativeKernel((const void*)fwd_kernel, dim3(grid_blocks), dim3(NTHR), args, LDS_BYTES, stream);
    if (e != hipSuccess) fprintf(stderr, "cooperative launch failed: %s (grid %d)\n", hipGetErrorString(e), grid_blocks);
#else
    for (int ph = 0; ph < NPHASES; ++ph) {
        if (ph == 1 + NPH_L) continue;
        p.ph_lo = ph; p.ph_hi = ph + 1;
        hipLaunchKernelGGL(fwd_kernel, dim3(grid_blocks), dim3(NTHR), LDS_BYTES, stream, p);
        const int sidx = ph == 0 ? 14 : (ph - 1) % NPH_L;
        if ((PROBE_DUP_MASK >> sidx) & 1) { p.dup = 1; for (int r = 0; r < PROBE_DUP_N; ++r) hipLaunchKernelGGL(fwd_kernel, dim3(grid_blocks), dim3(NTHR), LDS_BYTES, stream, p); p.dup = 0; }
    }
#endif
}
```

```cpp
#include <hip/hip_runtime.h>
#include <hip/hip_cooperative_groups.h>
#include <cstdio>
namespace cg = cooperative_groups;

#ifndef SINGLE_LAUNCH
#define SINGLE_LAUNCH 1
#endif
#ifndef PROBE_DUP_MASK
#define PROBE_DUP_MASK 0
#endif
#ifndef PROBE_DUP_N
#define PROBE_DUP_N 1
#endif
#ifndef USE_MLSTM_CHUNK
#define USE_MLSTM_CHUNK 1
#endif
#ifndef USE_SSD_CHUNK
#define USE_SSD_CHUNK 1
#endif
#ifndef CV_IN_SCAN
#define CV_IN_SCAN 0
#endif
#ifndef PROF_S
#define PROF_S (-1)
#endif
#ifndef CONVDUP
#define CONVDUP 0
#endif
#ifndef INPROJ_WGM
#define INPROJ_WGM 4
#endif
#define PROF_BLK (PROF_S == 40 ? 255 : 0)
#ifndef USE_MFMA_GEMM
#define USE_MFMA_GEMM 1
#endif

typedef unsigned short bf16_t;
typedef float f32x4 __attribute__((ext_vector_type(4)));
typedef unsigned u32x4 __attribute__((ext_vector_type(4)));
typedef unsigned u32x2 __attribute__((ext_vector_type(2)));

constexpr int NTHR = 512;
constexpr int D = 1024, NB = 4, SEQ = 4096, CTXL = 256;
constexpr int MC = NB * CTXL;
constexpr int ML = NB * SEQ;
constexpr int MT = MC + ML;
constexpr int DIN = 11312, NPAD = 11520;
constexpr int NE = 32, DE = 512;
constexpr int CAP = 43008;
constexpr float EPS = 1e-6f;
constexpr int LDS_BYTES = 163840;

constexpr size_t MiB = 1u << 20;
constexpr size_t WS_HIST = 0;
constexpr size_t WS_BLKEXP = 64 * 1024;
constexpr size_t WS_BAR = 128 * 1024;
constexpr size_t WS_TOK = 256 * 1024;
constexpr size_t WS_MOD = 1 * MiB;
constexpr size_t WS_GA = 2 * MiB;
constexpr size_t WS_DT = 4 * MiB;
constexpr size_t WS_EID = 7 * MiB;
constexpr size_t WS_EWT = 7 * MiB + 256 * 1024;
constexpr size_t WS_SLOT = 7 * MiB + 512 * 1024;
constexpr size_t WS_WIN = 8 * MiB;
constexpr size_t WS_WPOOL = 31 * MiB;
constexpr size_t WS_WBR = 32 * MiB;
constexpr size_t WS_WOUT = 38 * MiB;
constexpr size_t WS_XL = 40 * MiB;
constexpr size_t WS_H = 108 * MiB;
constexpr size_t WS_BR = 142 * MiB;
constexpr size_t WS_Q = 244 * MiB, WS_K = 278 * MiB, WS_V = 312 * MiB;
constexpr size_t WS_SX = 346 * MiB, WS_SB = 380 * MiB, WS_SC = 397 * MiB;
constexpr size_t WS_MG = 414 * MiB;
constexpr size_t WS_HF = 516 * MiB, WS_HB = 550 * MiB;
constexpr size_t WS_VT = 584 * MiB;
constexpr size_t WS_END = 618 * MiB;
constexpr size_t WS_MGA = WS_WIN, WS_MGC = WS_WIN + 576 * 1024, WS_MGP = WS_WIN + 1152 * 1024;
constexpr size_t WS_SACS = WS_WIN + 2 * MiB, WS_SDT = WS_WIN + 5 * MiB;
constexpr size_t WS_QC = WS_H, WS_KC = WS_HF, WS_KCT = WS_HB;
constexpr size_t WS_HF2 = WS_Q, WS_HB2 = WS_K;
constexpr size_t WS_XCT = WS_HB;
constexpr size_t WS_BC = WS_VT, WS_CC = WS_VT + 17 * MiB;
constexpr size_t WS_OL = WS_HF;
constexpr size_t WS_YF = WS_SX, WS_YB = WS_SB;
constexpr size_t WS_MERGED = WS_H;
constexpr size_t WS_EW1 = 550 * MiB;
constexpr size_t WS_EW2 = 308 * MiB;
constexpr size_t WS_XB = WS_BR;
constexpr size_t WS_ACT = WS_SX;
constexpr size_t WS_Y = WS_MG;

struct Params {
    const float *x, *c, *ctx, *c_ctx, *w_ada, *b_ada, *g_mix, *g_ffn, *w_in, *pool_w, *pool_scale,
        *mconv_w, *mconv_b, *mgate_b, *mnorm_g, *sconv_w, *sconv_b, *sdt_bias, *sa_log, *sd, *snorm_g,
        *w_branch, *w_out, *w_rg, *b_rg, *w_re, *b_re, *w_eg, *w_eu, *w_ed, *g_final;
    float* out; unsigned char* ws; int ph_lo, ph_hi, dup, pad;
};

__device__ __forceinline__ int tid_fresh() { int t = threadIdx.x; asm volatile("" : "+v"(t)); return t; }
__device__ __forceinline__ float bf2f(unsigned b) { return __uint_as_float(b << 16); }
__device__ __forceinline__ unsigned f2bf(float f) { unsigned u = __float_as_uint(f); return (u + 0x7fffu + ((u >> 16) & 1u)) >> 16; }
typedef __bf16 bf16x2_t __attribute__((ext_vector_type(2)));
typedef float f32x2_t __attribute__((ext_vector_type(2)));
__device__ __forceinline__ unsigned pk2(float lo, float hi) { const f32x2_t v = {lo, hi}; return __builtin_bit_cast(unsigned, __builtin_convertvector(v, bf16x2_t)); }
__device__ __forceinline__ float lo16(unsigned w) { return __uint_as_float(w << 16); }
__device__ __forceinline__ float hi16(unsigned w) { return __uint_as_float(w & 0xffff0000u); }
__device__ __forceinline__ float wave_sum(float v) {
#pragma unroll
    for (int o = 1; o < 64; o <<= 1) v += __shfl_xor(v, o);
    return v;
}
__device__ __forceinline__ float sigmoid_f(float x) { return __builtin_amdgcn_rcpf(1.f + __expf(-x)); }
__device__ __forceinline__ float silu_f(float x) { return x * __builtin_amdgcn_rcpf(1.f + __expf(-x)); }
__device__ __forceinline__ float softplus_f(float x) { return fmaxf(x, 0.f) + log1pf(__expf(-fabsf(x))); }
__device__ __forceinline__ float logsigmoid_f(float x) { return fminf(x, 0.f) - log1pf(__expf(-fabsf(x))); }
__device__ __forceinline__ void unpack8(u32x4 w, float* f) {
    f[0] = lo16(w.x); f[1] = hi16(w.x); f[2] = lo16(w.y); f[3] = hi16(w.y);
    f[4] = lo16(w.z); f[5] = hi16(w.z); f[6] = lo16(w.w); f[7] = hi16(w.w);
}
__device__ __forceinline__ u32x4 pack8(f32x4 a, f32x4 b) {
    u32x4 w; w.x = pk2(a[0], a[1]); w.y = pk2(a[2], a[3]); w.z = pk2(b[0], b[1]); w.w = pk2(b[2], b[3]); return w;
}
__device__ __forceinline__ int scanrow(int row) {
    if (row < MC) return row;
    const int r = row - MC, b = r >> 12, t = r & 4095;
    return MC + (b << 12) + ((t & 63) << 6) + (t >> 6);
}
__device__ __forceinline__ int modrow(int row) { return row < MC ? 4 : ((row - MC) >> 12); }

struct Unit { const bf16_t* A; const bf16_t* B; const int* tok; int pm, pn; };

template <int WGM = 8>
__device__ __forceinline__ void tile_order(int L, int nM, int nN, int& pm, int& pn) {
    const int nwg = nM * nN; int wgid = L;
    { const int q = nwg / 8, r = nwg % 8, xcd = wgid % 8, off = wgid / 8; wgid = (xcd < r ? xcd * (q + 1) : r * (q + 1) + (xcd - r) * q) + off; }
    const int nig = WGM * nN, gid = wgid / nig, fm = gid * WGM, gsz = (nM - fm) < WGM ? (nM - fm) : WGM;
    pm = fm + ((wgid % nig) % gsz); pn = (wgid % nig) / gsz;
}
struct SchedGrid {
    const bf16_t* A; const bf16_t* B; int lda, ldb, pm0, nM, nN, G, c;
    __device__ __forceinline__ bool next(int i, Unit& u) const {
        const long L = (long)i * G + c; if (L >= (long)nM * nN) return false;
        int pm, pn; if (nN == 45) tile_order<INPROJ_WGM>((int)L, nM, nN, pm, pn); else tile_order<8>((int)L, nM, nN, pm, pn); pm += pm0;
        u.pm = pm; u.pn = pn; u.tok = nullptr; u.A = A + (size_t)pm * 256 * lda; u.B = B + (size_t)pn * 256 * ldb; return true;
    }
};
struct SchedInproj1 {
    const bf16_t* A; const bf16_t* B; int G, c;
    __device__ __forceinline__ bool next(int i, Unit& u) const {
        const long L = (long)i * G + c; if (L >= 2880 + 84) return false;
        int pm, pn;
        if (L < 2880) { tile_order<INPROJ_WGM>((int)L, 64, 45, pm, pn); pm += 4; }
        else { const int idx = (int)L - 2880, k = idx % 21; pm = idx / 21; pn = k < 12 ? 4 + k : (k < 16 ? 20 + (k - 12) : (k < 20 ? 28 + (k - 16) : 44)); }
        u.pm = pm; u.pn = pn; u.tok = nullptr; u.A = A + (size_t)pm * 256 * 1024; u.B = B + (size_t)pn * 256 * 1024; return true;
    }
};
struct SchedPool {
    const bf16_t* A; const bf16_t* B; int pm0, nM, G, c;
    __device__ __forceinline__ bool next(int i, Unit& u) const {
        const long L = (long)i * G + c; if (L >= (long)nM * 4) return false;
        const int pm = pm0 + (int)(L >> 2), g = (int)(L & 3);
        u.pm = pm; u.pn = g; u.tok = nullptr; u.A = A + (size_t)pm * 256 * 3072 + g * 256; u.B = B + (size_t)g * 65536; return true;
    }
};
struct SchedMoe {
    const bf16_t* A; const bf16_t* B; const int* blkexp; const int* tok; int lda, nblk, G, c; size_t bexp_stride, ldb;
    __device__ __forceinline__ bool next(int i, Unit& u) const {
        const long L = (long)i * G + c; if (L >= (long)nblk * 4) return false;
        const int blk = (int)(L >> 2), nt = (int)(L & 3); const int e = blkexp[blk];
        u.pm = blk; u.pn = nt; u.tok = tok ? tok + blk * 256 : nullptr; u.A = tok ? A : A + (size_t)blk * 256 * lda;
        u.B = B + (size_t)e * bexp_stride + (size_t)nt * 256 * ldb; return true;
    }
};

struct EpiInproj {
    unsigned char* ws;
    __device__ __forceinline__ void seg(const Unit& u, int, int r, int c0, f32x4& lo0, f32x4& lo1, f32x4& hi0, f32x4& hi1) const {
        const int row = u.pm * 256 + r, t = u.pn;
        bf16_t* dst; size_t ld; int cb;
        if (t < 4) { dst = (bf16_t*)(ws + WS_BR) + (size_t)row * 3072; cb = t * 256; }
        else if (t < 16) { const int w = (t - 4) >> 2; dst = (bf16_t*)(ws + WS_Q + (size_t)w * 34 * MiB) + (size_t)scanrow(row) * 1024; cb = ((t - 4) & 3) * 256; }
        else if (t < 20) { dst = (bf16_t*)(ws + WS_BR) + (size_t)row * 3072 + 1024; cb = (t - 16) * 256; }
        else if (t < 24) { dst = (bf16_t*)(ws + WS_SX) + (size_t)row * 1024; cb = (t - 20) * 256; }
        else if (t < 28) { dst = (bf16_t*)(ws + WS_BR) + (size_t)row * 3072 + 2048; cb = (t - 24) * 256; }
        else if (t < 30) { dst = (bf16_t*)(ws + WS_SB) + (size_t)row * 512; cb = (t - 28) * 256; }
        else if (t < 32) { dst = (bf16_t*)(ws + WS_SC) + (size_t)row * 512; cb = (t - 30) * 256; }
        else if (t < 44) {
            dst = (bf16_t*)(ws + WS_MG) + (size_t)row * 3072; cb = (t - 32) * 256;
#pragma unroll
            for (int j = 0; j < 4; ++j) { lo0[j] = sigmoid_f(lo0[j]); lo1[j] = sigmoid_f(lo1[j]); hi0[j] = sigmoid_f(hi0[j]); hi1[j] = sigmoid_f(hi1[j]); }
        } else {
            if (c0 < 32) { float* d = (float*)(ws + WS_DT) + (size_t)row * 32 + c0; *(f32x4*)d = lo0; *(f32x4*)(d + 4) = lo1; }
            else if (c0 < 48) { float* d = (float*)(ws + WS_GA) + (size_t)scanrow(row) * 16 + (c0 - 32); *(f32x4*)d = lo0; *(f32x4*)(d + 4) = lo1; }
            return;
        }
        *(u32x4*)(dst + cb + c0) = pack8(lo0, lo1);
        *(u32x4*)(dst + cb + 128 + c0) = pack8(hi0, hi1);
    }
};
struct EpiPool {
    bf16_t* BR;
    __device__ __forceinline__ void seg(const Unit& u, int, int r, int c0, f32x4& lo0, f32x4& lo1, f32x4& hi0, f32x4& hi1) const {
        bf16_t* d = BR + (size_t)(u.pm * 256 + r) * 3072 + u.pn * 256 + c0;
        *(u32x4*)d = pack8(lo0, lo1);
        *(u32x4*)(d + 128) = pack8(hi0, hi1);
    }
};
struct EpiBranch {
    const bf16_t* MG; bf16_t* OUT;
    static constexpr bool PRELOAD = true;
    __device__ __forceinline__ void load(const Unit& u, int sg, int r, int c0, u32x4 (&b)[4]) const {
        const bf16_t* g = MG + (size_t)(u.pm * 256 + r) * 3072 + sg * 1024 + u.pn * 256 + c0;
        const int nx = sg < 2 ? 1024 : 0;
        b[0] = *(const u32x4*)g; b[1] = *(const u32x4*)(g + 128); b[2] = *(const u32x4*)(g + nx); b[3] = *(const u32x4*)(g + nx + 128);
    }
    __device__ __forceinline__ void apply(const Unit& u, int sg, int r, int c0, const u32x4 (&bb)[4], f32x4& lo0, f32x4& lo1, f32x4& hi0, f32x4& hi1) const {
        float a[8], b[8], a2[8], b2[8]; unpack8(bb[0], a); unpack8(bb[1], b); unpack8(bb[2], a2); unpack8(bb[3], b2);
        if (sg < 2) {
#pragma unroll
            for (int j = 0; j < 8; ++j) { a[j] = a[j] * __builtin_amdgcn_rcpf(a2[j]); b[j] = b[j] * __builtin_amdgcn_rcpf(b2[j]); } }
#pragma unroll
        for (int j = 0; j < 4; ++j) { lo0[j] *= a[j]; lo1[j] *= a[4 + j]; hi0[j] *= b[j]; hi1[j] *= b[4 + j]; }
        if (sg == 2) { bf16_t* d = OUT + (size_t)(u.pm * 256 + r) * 1024 + u.pn * 256 + c0; *(u32x4*)d = pack8(lo0, lo1); *(u32x4*)(d + 128) = pack8(hi0, hi1); }
    }
    __device__ __forceinline__ void seg(const Unit&, int, int, int, f32x4&, f32x4&, f32x4&, f32x4&) const {}
};
struct EpiOut {
    bf16_t* OL;
    __device__ __forceinline__ void seg(const Unit& u, int, int r, int c0, f32x4& lo0, f32x4& lo1, f32x4& hi0, f32x4& hi1) const {
        bf16_t* d = OL + (size_t)(u.pm * 256 + r) * 1024 + u.pn * 256 + c0;
        *(u32x4*)d = pack8(lo0, lo1); *(u32x4*)(d + 128) = pack8(hi0, hi1);
    }
};
struct EpiMoe1 {
    bf16_t* ACT;
    __device__ __forceinline__ void seg(const Unit& u, int, int r, int c0, f32x4& lo0, f32x4& lo1, f32x4& hi0, f32x4& hi1) const {
        const int row = u.pm * 256 + r;
        f32x4 a, b;
#pragma unroll
        for (int j = 0; j < 4; ++j) { a[j] = silu_f(lo0[j]) * hi0[j]; b[j] = silu_f(lo1[j]) * hi1[j]; }
        *(u32x4*)(ACT + (size_t)row * 512 + u.pn * 128 + c0) = pack8(a, b);
    }
};
struct EpiMoe2 {
    bf16_t* Y;
    __device__ __forceinline__ void seg(const Unit& u, int, int r, int c0, f32x4& lo0, f32x4& lo1, f32x4& hi0, f32x4& hi1) const {
        bf16_t* d = Y + (size_t)(u.pm * 256 + r) * 1024 + u.pn * 256 + c0;
        *(u32x4*)d = pack8(lo0, lo1); *(u32x4*)(d + 128) = pack8(hi0, hi1);
    }
};

template <class E, class = void> struct epi_preload { static constexpr bool value = false; };
template <class E> struct epi_preload<E, decltype((void)E::PRELOAD)> { static constexpr bool value = E::PRELOAD; };

#define LAS __attribute__((address_space(3)))
typedef short bf16x8 __attribute__((ext_vector_type(8)));
constexpr int HTB = 128 * 64 * 2;
__device__ __forceinline__ int lds_byte(int r, int c) { const int st = (r >> 4) * 2 + (c >> 5), rr = r & 15, cc = c & 31, ob = rr * 64 + cc * 2; return st * 1024 + (ob ^ (((ob >> 9) & 1) << 5)); }
__device__ __forceinline__ void stage_rc(int b, int& R, int& C) { const int st = b / 1024, sb = b % 1024, swz = sb ^ (((sb >> 9) & 1) << 5); R = (st >> 1) * 16 + swz / 64; C = (st & 1) * 32 + (swz % 64) / 2; }
__device__ __forceinline__ int perm32(int rho) { const int n = rho >> 4, i = rho & 15; return 8 * (i >> 2) + 4 * n + (i & 3); }

template <bool GATHER, class Sched, class Epi>
__device__ __forceinline__ void gemm_mfma(LAS unsigned char* lds, const Sched& S, const Epi& E, const int K, const int lda, const int ldb, const int nseg) {
    const int tid = tid_fresh(), wid = __builtin_amdgcn_readfirstlane(tid >> 6), lane = tid & 63, wr = wid >> 2, wc = wid & 3, fr = lane & 15, fq = lane >> 4;
    const int nt = K / 64, tseg = nt / nseg;
    unsigned vA0[2], vA1[2], nA0[2], nA1[2], voffB[2]; int rowA[2], colA[2];
#pragma unroll
    for (int i = 0; i < 2; ++i) { int R, C; stage_rc(tid * 16 + i * 8192, R, C); const int Rb = (R & ~31) + perm32(R & 31);
        rowA[i] = R; colA[i] = C;
        vA0[i] = (unsigned)(R * lda + C) * 2u; vA1[i] = vA0[i] + (unsigned)(128 * lda * 2); nA0[i] = vA0[i]; nA1[i] = vA1[i];
        voffB[i] = (unsigned)(Rb * ldb + C) * 2u; }
    const size_t kstep = 128;
    const size_t hstepB = (size_t)128 * ldb * 2;
    const unsigned ldsw = (unsigned)wid * 1024u;
    const int aoff = lds_byte(wr * 64 + fr, fq * 8), boff = lds_byte(wc * 32 + fr, fq * 8);
#define PG8_SA(b, h) (((b) * 2 + (h)) * HTB)
#define PG8_SB(b, h) ((4 + (b) * 2 + (h)) * HTB)
#define PG8_STAGE(bufoff, gbase, voff) do { _Pragma("unroll") for (int _i = 0; _i < 2; ++_i) \
        __builtin_amdgcn_global_load_lds((const unsigned*)((const char*)(gbase) + (voff)[_i]), (LAS unsigned*)(lds + (bufoff) + ldsw + _i * 8192), 16, 0, 0); } while (0)
#define PG8_LDA(dst, b, h) do { _Pragma("unroll") for (int m = 0; m < 4; ++m) _Pragma("unroll") for (int k = 0; k < 2; ++k) dst[m][k] = *(const LAS bf16x8*)(lds + PG8_SA(b, h) + aoff + m * 2048 + k * 1024); } while (0)
#define PG8_LDB(dst, b, h) do { _Pragma("unroll") for (int n = 0; n < 2; ++n) _Pragma("unroll") for (int k = 0; k < 2; ++k) dst[n][k] = *(const LAS bf16x8*)(lds + PG8_SB(b, h) + boff + n * 2048 + k * 1024); } while (0)
#define PG8_MMA(ai, bj, At, Bt) do { __builtin_amdgcn_s_setprio(1); _Pragma("unroll") for (int m = 0; m < 4; ++m) _Pragma("unroll") for (int n = 0; n < 2; ++n) _Pragma("unroll") for (int k = 0; k < 2; ++k) \
        acc[ai][bj][m][n] = __builtin_amdgcn_mfma_f32_16x16x32_bf16(Bt[n][k], At[m][k], acc[ai][bj][m][n], 0, 0, 0); __builtin_amdgcn_s_setprio(0); } while (0)
#define PG8_WAIT_V(n) asm volatile("s_waitcnt vmcnt(" #n ")" ::: "memory")
#define PG8_WAIT_L(n) asm volatile("s_waitcnt lgkmcnt(" #n ")" ::: "memory")
#define PG8_BAR __builtin_amdgcn_s_barrier()
#define PG8_SCHED __builtin_amdgcn_sched_barrier(0)
#define PG8_EPI(sg) do { \
    if constexpr (epi_preload<Epi>::value) { \
        _Pragma("unroll") for (int ai = 0; ai < 2; ++ai) _Pragma("unroll") for (int mh = 0; mh < 2; ++mh) { u32x4 gbuf[2][4]; int rr_[2]; \
            _Pragma("unroll") for (int m = 0; m < 2; ++m) { int r_ = ai * 128 + wr * 64 + (2 * mh + m) * 16 + fr; asm volatile("" : "+v"(r_)); rr_[m] = r_; E.load(cur, (sg), r_, wc * 32 + fq * 8, gbuf[m]); } \
            __builtin_amdgcn_sched_barrier(0); \
            _Pragma("unroll") for (int m = 0; m < 2; ++m) E.apply(cur, (sg), rr_[m], wc * 32 + fq * 8, gbuf[m], acc[ai][0][2 * mh + m][0], acc[ai][0][2 * mh + m][1], acc[ai][1][2 * mh + m][0], acc[ai][1][2 * mh + m][1]); \
            __builtin_amdgcn_sched_barrier(0); } \
    } else { \
        _Pragma("unroll") for (int ai = 0; ai < 2; ++ai) _Pragma("unroll") for (int m = 0; m < 4; ++m) { \
            int r_ = ai * 128 + wr * 64 + m * 16 + fr; asm volatile("" : "+v"(r_));     \
            E.seg(cur, (sg), r_, wc * 32 + fq * 8, acc[ai][0][m][0], acc[ai][0][m][1], acc[ai][1][m][0], acc[ai][1][m][1]); } } } while (0)
    Unit cur, nxt; int ui = 0;
    if (!S.next(0, cur)) return;
    f32x4 acc[2][2][4][2];
#pragma unroll
    for (int a = 0; a < 2; ++a)
#pragma unroll
        for (int b = 0; b < 2; ++b)
#pragma unroll
            for (int m = 0; m < 4; ++m)
#pragma unroll
                for (int n = 0; n < 2; ++n) acc[a][b][m][n] = (f32x4){0.f, 0.f, 0.f, 0.f};
    bf16x8 At[4][2], B0[2][2], B1[2][2];
    const char* cA = (const char*)cur.A; const char* cB = (const char*)cur.B;
    if (GATHER) {
#pragma unroll
        for (int i = 0; i < 2; ++i) { vA0[i] = (unsigned)(cur.tok[rowA[i]] * lda + colA[i]) * 2u; vA1[i] = (unsigned)(cur.tok[128 + rowA[i]] * lda + colA[i]) * 2u; nA0[i] = vA0[i]; nA1[i] = vA1[i]; }
    }
    PG8_STAGE(PG8_SB(0, 0), cB, voffB); PG8_STAGE(PG8_SA(0, 0), cA, vA0); PG8_STAGE(PG8_SB(0, 1), cB + hstepB, voffB); PG8_STAGE(PG8_SA(0, 1), cA, vA1);
    if (wr == 1) PG8_BAR;
    PG8_WAIT_V(4); PG8_BAR;
    PG8_STAGE(PG8_SB(1, 0), cB + kstep, voffB); PG8_STAGE(PG8_SA(1, 0), cA + kstep, vA0); PG8_STAGE(PG8_SB(1, 1), cB + hstepB + kstep, voffB);
    PG8_WAIT_V(6); PG8_BAR;
    for (;;) {
        const bool has_next = S.next(ui + 1, nxt);
        const char* nA = has_next ? (const char*)nxt.A : cA; const char* nB = has_next ? (const char*)nxt.B : cB;
        if (GATHER) {
            const int* tk = has_next ? nxt.tok : cur.tok;
#pragma unroll
            for (int i = 0; i < 2; ++i) { nA0[i] = (unsigned)(tk[rowA[i]] * lda + colA[i]) * 2u; nA1[i] = (unsigned)(tk[128 + rowA[i]] * lda + colA[i]) * 2u; }
        }
#pragma nounroll
        for (int sg = 0; sg < nseg; ++sg) {
#pragma nounroll
        for (int tt = 0; tt < tseg; tt += 2) {
            const int t = sg * tseg + tt;
            const bool last = (t == nt - 2);
            const char* a1 = cA + (size_t)(t + 1) * kstep;
            const char* a2 = last ? nA : cA + (size_t)(t + 2) * kstep; const char* b2 = last ? nB : cB + (size_t)(t + 2) * kstep;
            const char* a3 = a2 + kstep; const char* b3 = b2 + kstep;
            unsigned w0[2], w1[2];
#pragma unroll
            for (int i = 0; i < 2; ++i) { w0[i] = last ? nA0[i] : vA0[i]; w1[i] = last ? nA1[i] : vA1[i]; }
            PG8_LDB(B0, 0, 0); PG8_SCHED; PG8_LDA(At, 0, 0); PG8_STAGE(PG8_SA(1, 1), a1, vA1);
            PG8_WAIT_L(8); PG8_BAR; PG8_WAIT_L(0); PG8_MMA(0, 0, At, B0); PG8_BAR; PG8_SCHED;
            PG8_LDB(B1, 0, 1); PG8_STAGE(PG8_SB(0, 0), b2, voffB);
            PG8_BAR; PG8_WAIT_L(0); PG8_MMA(0, 1, At, B1); PG8_BAR;
            PG8_LDA(At, 0, 1); PG8_STAGE(PG8_SA(0, 0), a2, w0);
            PG8_BAR; PG8_WAIT_L(0); PG8_MMA(1, 0, At, B0); PG8_BAR; PG8_SCHED;
            PG8_STAGE(PG8_SB(0, 1), b2 + hstepB, voffB);
            PG8_WAIT_V(6); PG8_BAR; PG8_MMA(1, 1, At, B1); PG8_BAR;
            PG8_LDB(B0, 1, 0); PG8_SCHED; PG8_LDA(At, 1, 0); PG8_STAGE(PG8_SA(0, 1), a2, w1);
            PG8_WAIT_L(8); PG8_BAR; PG8_WAIT_L(0); PG8_MMA(0, 0, At, B0); PG8_BAR; PG8_SCHED;
            PG8_LDB(B1, 1, 1); PG8_STAGE(PG8_SB(1, 0), b3, voffB);
            PG8_BAR; PG8_WAIT_L(0); PG8_MMA(0, 1, At, B1); PG8_BAR;
            PG8_LDA(At, 1, 1); PG8_STAGE(PG8_SA(1, 0), a3, w0);
            PG8_BAR; PG8_WAIT_L(0); PG8_MMA(1, 0, At, B0); PG8_BAR; PG8_SCHED;
            PG8_STAGE(PG8_SB(1, 1), b3 + hstepB, voffB);
            PG8_WAIT_V(6); PG8_BAR; PG8_MMA(1, 1, At, B1); PG8_BAR;
        }
        PG8_EPI(sg);
        }
        if (!has_next) break;
#pragma unroll
        for (int a = 0; a < 2; ++a)
#pragma unroll
            for (int b = 0; b < 2; ++b)
#pragma unroll
                for (int m = 0; m < 4; ++m)
#pragma unroll
                    for (int n = 0; n < 2; ++n) acc[a][b][m][n] = (f32x4){0.f, 0.f, 0.f, 0.f};
        cur = nxt; cA = nA; cB = nB; ++ui;
#pragma unroll
        for (int i = 0; i < 2; ++i) { vA0[i] = nA0[i]; vA1[i] = nA1[i]; }
    }
    PG8_WAIT_V(0);
    if (wr == 0) PG8_BAR;
    PG8_BAR;
#undef PG8_SA
#undef PG8_SB
#undef PG8_STAGE
#undef PG8_LDA
#undef PG8_LDB
#undef PG8_MMA
#undef PG8_WAIT_V
#undef PG8_WAIT_L
#undef PG8_BAR
#undef PG8_SCHED
#undef PG8_EPI
}

template <bool GATHER = false, class Sched, class Epi>
__device__ __forceinline__ void gemm_run(unsigned char* lds, const Sched& S, const Epi& E, int K, int lda, int ldb, int nseg) {
    __syncthreads();
    gemm_mfma<GATHER>((LAS unsigned char*)lds, S, E, K, lda, ldb, nseg);
    __syncthreads();
}

struct TrDesc { const float* src; const float* cscale; bf16_t* dst; int ld_src, ld_dst, valid; };
__device__ __forceinline__ void tr_load(const TrDesc& d, f32x4 (&v)[16]) {
    if (d.src) {
#pragma unroll
        for (int i = 0; i < 16; ++i) v[i] = *(const f32x4*)(d.src + (size_t)(4 * i) * d.ld_src);
    } else {
#pragma unroll
        for (int i = 0; i < 16; ++i) v[i] = (f32x4){0.f, 0.f, 0.f, 0.f};
    }
}
__device__ __forceinline__ void tr_store(const TrDesc& d, f32x4 (&v)[16], float* scr, int lane) {
    const int c4 = (lane & 15) * 4, kr = lane >> 4;
    if (d.cscale) { const f32x4 s = *(const f32x4*)d.cscale;
#pragma unroll
        for (int i = 0; i < 16; ++i) v[i] = v[i] * s; }
#pragma unroll
    for (int i = 0; i < 16; ++i) { float* q = scr + (kr + 4 * i) * 65 + c4; q[0] = v[i][0]; q[1] = v[i][1]; q[2] = v[i][2]; q[3] = v[i][3]; }
    asm volatile("s_waitcnt lgkmcnt(0)" ::: "memory");
    const int c = lane & 7;
#pragma unroll
    for (int j = 0; j < 8; ++j) { const int n = (lane >> 3) + 8 * j; const float* s = scr + (8 * c) * 65 + n;
        u32x4 o; o.x = pk2(s[0 * 65], s[1 * 65]); o.y = pk2(s[2 * 65], s[3 * 65]); o.z = pk2(s[4 * 65], s[5 * 65]); o.w = pk2(s[6 * 65], s[7 * 65]);
        *(u32x4*)(d.dst + (size_t)n * d.ld_dst + 8 * c) = o; }
    asm volatile("s_waitcnt lgkmcnt(0)" ::: "memory");
}
__device__ __forceinline__ TrDesc tr_desc(const float* W, int ld_src, int srcq, bf16_t* WT, int ld_dst, int n_dst, int kdst0, int k0, int lane, const float* cscale = nullptr) {
    TrDesc d; d.ld_src = ld_src; d.ld_dst = ld_dst; d.valid = 1;
    d.src = srcq >= 0 ? W + (size_t)(k0 + (lane >> 4)) * ld_src + srcq : nullptr;
    d.cscale = (cscale && srcq >= 0) ? cscale + srcq : nullptr;
    d.dst = WT + (size_t)n_dst * ld_dst + kdst0 + k0; return d;
}
constexpr int CV_MIX_ITEMS = 2880 + 64 + 768 + 256;
constexpr int CV_EXP_ITEMS = 32 * 384;
__device__ __forceinline__ TrDesc convert_desc(const Params& p, int le, int lm, int it, int lane) {
    unsigned char* ws = p.ws;
    const int c4 = (lane & 15) * 4;
    if (le >= 0) {
        if (it < CV_EXP_ITEMS) {
            const int e = it / 384, r = it % 384;
            if (r < 256) { const int up = r >> 7, q = r & 127, kb = ((q >> 5) << 2) | ((q >> 1) & 3), nb = (((q >> 3) & 3) << 1) | (q & 1); const int c = nb * 64;
                const float* src = (up ? p.w_eu : p.w_eg) + (size_t)(le * 32 + e) * 1024 * 512;
                return tr_desc(src, 512, c + c4, (bf16_t*)(ws + WS_EW1) + (size_t)e * 1048576, 1024, (c >> 7) * 256 + up * 128 + (c & 127), 0, kb * 64, lane); }
            const int q = r - 256, kb = ((q >> 6) << 2) | ((q >> 1) & 3), nb = (((q >> 3) & 7) << 1) | (q & 1);
            return tr_desc(p.w_ed + (size_t)(le * 32 + e) * 512 * 1024, 1024, nb * 64 + c4, (bf16_t*)(ws + WS_EW2) + (size_t)e * 524288, 512, nb * 64, 0, kb * 64, lane);
        }
        it -= CV_EXP_ITEMS;
    }
    const int l = lm;
    if (it < 2880) { const int R = it >> 4, kb = it & 15, dstn = R * 64; int srcq;
        if (R < 80) srcq = dstn + c4; else if (R < 128) srcq = dstn + 16 + c4; else if (R < 176) srcq = dstn + 48 + c4;
        else if (R == 176) srcq = c4 < 32 ? 8208 + c4 : (c4 < 48 ? 5120 + (c4 - 32) : -1); else srcq = -1;
        return tr_desc(p.w_in + (size_t)l * 1024 * DIN, DIN, srcq, (bf16_t*)(ws + WS_WIN), 1024, dstn, 0, kb * 64, lane); }
    it -= 2880;
    if (it < 64) { const int g = it >> 4, r = it & 15, kb = r >> 2, nb = r & 3;
        return tr_desc(p.pool_w + (size_t)(l * 4 + g) * 65536, 256, nb * 64 + c4, (bf16_t*)(ws + WS_WPOOL) + (size_t)g * 65536, 256, nb * 64, 0, kb * 64, lane, p.pool_scale + l * 1024 + g * 256); }
    it -= 64;
    if (it < 768) { const int br = it >> 8, r = it & 255, kb = r >> 4, nb = r & 15;
        return tr_desc(p.w_branch + (size_t)(l * 3 + br) * 1048576, 1024, nb * 64 + c4, (bf16_t*)(ws + WS_WBR), 3072, nb * 64, br * 1024, kb * 64, lane); }
    it -= 768;
    { const int kb = it >> 4, nb = it & 15;
      return tr_desc(p.w_out + (size_t)l * 1048576, 1024, nb * 64 + c4, (bf16_t*)(ws + WS_WOUT), 1024, nb * 64, 0, kb * 64, lane); }
}
__device__ __forceinline__ void convert_run(const Params& p, int le, int lm, int first, int step, float* scr, int lane) {
    const int nitems = (le >= 0 ? CV_EXP_ITEMS : 0) + (lm >= 0 ? CV_MIX_ITEMS : 0);
    if (first >= nitems) return;
    f32x4 va[16], vb[16];
    TrDesc da = convert_desc(p, le, lm, first, lane), db;
    tr_load(da, va);
    for (int it = first; it < nitems; it += 2 * step) {
        const int i1 = it + step, i2 = it + 2 * step;
        if (i1 < nitems) { db = convert_desc(p, le, lm, i1, lane); tr_load(db, vb); }
        tr_store(da, va, scr, lane);
        if (i1 >= nitems) break;
        if (i2 < nitems) { da = convert_desc(p, le, lm, i2, lane); tr_load(da, va); }
        tr_store(db, vb, scr, lane);
    }
}

__device__ __forceinline__ int cv_map(int listB, int n) { return listB ? (n < 4096 ? (n >> 7) * 384 + 256 + (n & 127) : CV_EXP_ITEMS + (n - 4096)) : (n >> 8) * 384 + (n & 255); }
__device__ __forceinline__ void convert_list(const Params& p, int le, int lm, int listB, int count, int first, int step, float* scr, int lane) {
    if (first >= count) return;
    f32x4 va[16], vb[16];
    TrDesc da = convert_desc(p, le, lm, cv_map(listB, first), lane), db;
    tr_load(da, va);
    for (int it = first; it < count; it += 2 * step) {
        const int i1 = it + step, i2 = it + 2 * step;
        if (i1 < count) { db = convert_desc(p, le, lm, cv_map(listB, i1), lane); tr_load(db, vb); }
        tr_store(da, va, scr, lane);
        if (i1 >= count) break;
        if (i2 < count) { da = convert_desc(p, le, lm, cv_map(listB, i2), lane); tr_load(da, va); }
        tr_store(db, vb, scr, lane);
    }
}

__device__ __forceinline__ void cvmicro_load(const Params& p, int le, int m, int lane, f32x4 (&v)[8], TrDesc& d) {
    d = convert_desc(p, le, -1, m >> 1, lane);
    const float* s = d.src + (size_t)(32 * (m & 1)) * d.ld_src;
#pragma unroll
    for (int i = 0; i < 8; ++i) v[i] = *(const f32x4*)(s + (size_t)(4 * i) * d.ld_src);
}
__device__ __forceinline__ void cvmicro_store(const TrDesc& d, int m, const f32x4 (&v)[8], LAS float* scr, int lane) {
    const int c4 = (lane & 15) * 4, kr = lane >> 4;
#pragma unroll
    for (int i = 0; i < 8; ++i) { LAS float* q = scr + (kr + 4 * i) * 65 + c4; q[0] = v[i][0]; q[1] = v[i][1]; q[2] = v[i][2]; q[3] = v[i][3]; }
    asm volatile("s_waitcnt lgkmcnt(0)" ::: "memory");
    bf16_t* drow = d.dst + (size_t)lane * d.ld_dst + 32 * (m & 1);
#pragma unroll
    for (int g = 0; g < 4; ++g) { const LAS float* s = scr + (8 * g) * 65 + lane;
        u32x4 o; o.x = pk2(s[0 * 65], s[1 * 65]); o.y = pk2(s[2 * 65], s[3 * 65]); o.z = pk2(s[4 * 65], s[5 * 65]); o.w = pk2(s[6 * 65], s[7 * 65]);
        *(u32x4*)(drow + 8 * g) = o; }
    asm volatile("s_waitcnt lgkmcnt(0)" ::: "memory");
}

__device__ __forceinline__ void phase_pre(const Params& p, unsigned char* ldsb, int bid, int nb) {
    float* lds = reinterpret_cast<float*>(ldsb);
    const int tid = tid_fresh(), lane = tid & 63, wave = tid >> 6;
    for (int i = tid; i < 5 * 1024; i += NTHR) { const float v = i < 4096 ? p.c[i] : p.c_ctx[i - 4096]; lds[i] = silu_f(v); }
    __syncthreads();
    float* red = lds + 5120;
    for (int it = bid; it < 2 * 96; it += nb) {
        const int l = it / 96, j = (it % 96) * 64 + lane;
        const float* w = p.w_ada + (size_t)l * 1024 * 6144 + j;
        float a0 = 0, a1 = 0, a2 = 0, a3 = 0, a4 = 0;
#pragma unroll 16
        for (int k = wave * 128; k < wave * 128 + 128; ++k) { const float wv = w[(size_t)k * 6144];
            a0 += lds[k] * wv; a1 += lds[1024 + k] * wv; a2 += lds[2048 + k] * wv; a3 += lds[3072 + k] * wv; a4 += lds[4096 + k] * wv; }
        red[(wave * 5 + 0) * 64 + lane] = a0; red[(wave * 5 + 1) * 64 + lane] = a1; red[(wave * 5 + 2) * 64 + lane] = a2;
        red[(wave * 5 + 3) * 64 + lane] = a3; red[(wave * 5 + 4) * 64 + lane] = a4;
        __syncthreads();
        if (tid < 320) { const int r = tid >> 6, jj = tid & 63; float s = 0;
            for (int w8 = 0; w8 < 8; ++w8) s += red[(w8 * 5 + r) * 64 + jj];
            const int col = (it % 96) * 64 + jj;
            ((float*)(p.ws + WS_MOD))[(size_t)(l * 5 + r) * 6144 + col] = s + p.b_ada[l * 6144 + col]; }
        __syncthreads();
    }
    __syncthreads();
    float* scr = lds + wave * (64 * 65);
    convert_run(p, -1, 0, bid * 8 + wave, nb * 8, scr, lane);
}

__device__ __forceinline__ void norm_mod_row(f32x4 (&v)[4], const float* g, const float* shift, const float* scale, int lane) {
    float s = 0.f;
#pragma unroll
    for (int j = 0; j < 4; ++j) s += (v[j][0] * v[j][0] + v[j][1] * v[j][1]) + (v[j][2] * v[j][2] + v[j][3] * v[j][3]);
    const float rs = __builtin_amdgcn_rsqf(wave_sum(s) * (1.f / 1024.f) + EPS);
#pragma unroll
    for (int j = 0; j < 4; ++j) { const int c = 4 * lane + 256 * j; const f32x4 gg = *(const f32x4*)(g + c);
        f32x4 y = v[j] * rs * gg;
        if (shift) { const f32x4 sh = *(const f32x4*)(shift + c), sc = *(const f32x4*)(scale + c); y = y * (1.f + sc) + sh; }
        v[j] = y; }
}
__device__ __forceinline__ void store_row_bf16(bf16_t* dst, const f32x4 (&v)[4], int lane) {
#pragma unroll
    for (int j = 0; j < 4; ++j) { u32x2 w; w.x = pk2(v[j][0], v[j][1]); w.y = pk2(v[j][2], v[j][3]); *(u32x2*)(dst + 4 * lane + 256 * j) = w; }
}

__device__ __forceinline__ void phase_norm1(const Params& p, int bid, int nb) {
    const int lane = tid_fresh() & 63, wave = tid_fresh() >> 6;
    const float* mod = (const float*)(p.ws + WS_MOD);
    const int stride = nb * 8;
    int m = bid * 8 + wave;
    f32x4 v[4], w[4];
    if (m < MT) { const float* src = m < MC ? p.ctx + (size_t)m * 1024 : p.x + (size_t)(m - MC) * 1024;
#pragma unroll
        for (int j = 0; j < 4; ++j) v[j] = *(const f32x4*)(src + 4 * lane + 256 * j); }
    for (; m < MT; m += stride) {
        const int mn = m + stride;
        if (mn < MT) { const float* src = mn < MC ? p.ctx + (size_t)mn * 1024 : p.x + (size_t)(mn - MC) * 1024;
#pragma unroll
            for (int j = 0; j < 4; ++j) w[j] = *(const f32x4*)(src + 4 * lane + 256 * j); }
        const float* mr = mod + modrow(m) * 6144;
        norm_mod_row(v, p.g_mix, mr, mr + 1024, lane);
        store_row_bf16((bf16_t*)(p.ws + WS_H) + (size_t)m * 1024, v, lane);
#pragma unroll
        for (int j = 0; j < 4; ++j) v[j] = w[j];
    }
}

__device__ __forceinline__ float wave_incl_sum(float v, int lane) {
#pragma unroll
    for (int o = 1; o < 64; o <<= 1) { const float u = __shfl_up(v, o); if (lane >= o) v += u; }
    return v;
}
__device__ __forceinline__ float wave_incl_max(float v, int lane) {
#pragma unroll
    for (int o = 1; o < 64; o <<= 1) { const float u = __shfl_up(v, o); if (lane >= o) v = fmaxf(v, u); }
    return v;
}
__device__ __forceinline__ u32x2 pack4(f32x4 a) { u32x2 w; w.x = pk2(a[0], a[1]); w.y = pk2(a[2], a[3]); return w; }

__device__ __forceinline__ void chunk_geom(int gc, int& rbase, int& n0, int& len) {
    const int b = gc / 68, cin = gc % 68;
    if (cin < 4) { rbase = b * 256; n0 = cin * 64; len = 256; } else { rbase = MC + b * 4096; n0 = (cin - 4) * 64; len = 4096; }
}
struct ConvW { float w[4][8], b[8]; };
__device__ __forceinline__ void conv_load_w(const float* cw, const float* cb, int ch0, ConvW& W) {
#pragma unroll
    for (int j = 0; j < 4; ++j) { const f32x4 a = *(const f32x4*)(cw + j * 2048 + ch0), b2 = *(const f32x4*)(cw + j * 2048 + ch0 + 4);
#pragma unroll
        for (int i = 0; i < 4; ++i) { W.w[j][i] = a[i]; W.w[j][4 + i] = b2[i]; } }
    { const f32x4 a = *(const f32x4*)(cb + ch0), b2 = *(const f32x4*)(cb + ch0 + 4);
#pragma unroll
      for (int i = 0; i < 4; ++i) { W.b[i] = a[i]; W.b[4 + i] = b2[i]; } }
}
__device__ __forceinline__ void conv8x4(const u32x4 (&raw)[7], const ConvW& W, float scale, u32x4 (&out)[4]) {
    float f[7][8];
#pragma unroll
    for (int k = 0; k < 7; ++k) unpack8(raw[k], f[k]);
#pragma unroll
    for (int pp = 0; pp < 4; ++pp) { f32x4 o0, o1;
#pragma unroll
        for (int i = 0; i < 8; ++i) { float a = W.b[i];
#pragma unroll
            for (int j = 0; j < 4; ++j) a += W.w[j][i] * f[pp + j][i];
            a = silu_f(a) * scale; if (i < 4) o0[i] = a; else o1[i - 4] = a; }
        out[pp] = pack8(o0, o1); }
}
__device__ __forceinline__ void load_raw7(const bf16_t* src, size_t ld, int rbase, int tbase, int len, u32x4 (&raw)[7]) {
#pragma unroll
    for (int k = 0; k < 7; ++k) { const int t = tbase + k; const bool ok = (t >= 0) && (t < len); const int tc = t < 0 ? 0 : (t >= len ? len - 1 : t);
        u32x4 a = *(const u32x4*)(src + (size_t)(rbase + tc) * ld);
        if (!ok) a = (u32x4){0u, 0u, 0u, 0u};
        raw[k] = a; }
}
template <class F>
__device__ __forceinline__ void tile_transpose_out(const LAS bf16_t* tile, int ldsw, int ncol, int tid, F rowptr) {
    for (int q = tid; q < ncol * 8; q += NTHR) { const int c = q % ncol, sc = q / ncol;
        unsigned v[8];
#pragma unroll
        for (int i = 0; i < 8; ++i) v[i] = tile[(sc * 8 + i) * ldsw + c];
        u32x4 w; w.x = v[0] | (v[1] << 16); w.y = v[2] | (v[3] << 16); w.z = v[4] | (v[5] << 16); w.w = v[6] | (v[7] << 16);
        *(u32x4*)(rowptr(c) + sc * 8) = w; }
}

__device__ __forceinline__ void conv_m_item(const Params& p, int l, int item, LAS unsigned char* lds, const ConvW& Wq, const ConvW& Wk) {
    const int tid = tid_fresh(), gc = item >> 2, hd = item & 3;
    int rbase, n0, len; chunk_geom(gc, rbase, n0, len);
    const int cs = tid & 31, tg = tid >> 5, d0 = cs * 8, i0 = tg * 4;
    u32x4 rq[7], rk[7]; float g0 = 0.f, g1 = 0.f;
    load_raw7((const bf16_t*)(p.ws + WS_Q) + hd * 256 + d0, 1024, rbase, n0 + i0 - 2, len, rq);
    load_raw7((const bf16_t*)(p.ws + WS_K) + hd * 256 + d0, 1024, rbase, n0 + i0 - 2, len, rk);
    const int gdir = tid >> 6, glane = tid & 63, gj = gdir ? 63 - glane : glane;
    if (gdir < 2) { const float* g = (const float*)(p.ws + WS_GA) + (size_t)(rbase + n0 + gj) * 16; g0 = g[gdir * 4 + hd]; g1 = g[(2 + gdir) * 4 + hd]; }
    { u32x4 o[4];
      conv8x4(rq, Wq, 1.0f, o);
#pragma unroll
      for (int pp = 0; pp < 4; ++pp) *(u32x4*)((bf16_t*)(p.ws + WS_QC) + (size_t)(rbase + n0 + i0 + pp) * 1024 + hd * 256 + d0) = o[pp];
      conv8x4(rk, Wk, 0.0625f, o);
#pragma unroll
      for (int pp = 0; pp < 4; ++pp) *(u32x4*)((bf16_t*)(p.ws + WS_KC) + (size_t)(rbase + n0 + i0 + pp) * 1024 + hd * 256 + d0) = o[pp]; }
    for (int rep_ = 0; rep_ < ((CONVDUP & 4) ? 2 : 1); ++rep_)
    if (gdir < 2) {
        const float ig = g0 + p.mgate_b[l * 16 + gdir * 4 + hd], lf = logsigmoid_f(g1 + p.mgate_b[l * 16 + (2 + gdir) * 4 + hd]);
        const float cum = wave_incl_sum(lf, glane), a = ig - cum, pm = wave_incl_max(a, glane);
        const size_t o = (size_t)(gc * 8 + gdir * 4 + hd) * 64 + gj;
        ((float*)(p.ws + WS_MGA))[o] = a; ((float*)(p.ws + WS_MGC))[o] = cum; ((float*)(p.ws + WS_MGP))[o] = pm;
    }
}

__device__ __forceinline__ void conv_s_item(const Params& p, int l, int item, LAS unsigned char* lds, const ConvW& Wbc, const ConvW& Wx) {
    const int tid = tid_fresh(), gc = item >> 2, grp = item & 3;
    int rbase, n0, len; chunk_geom(gc, rbase, n0, len);
    const int cs = tid & 31, tg = tid >> 5, i0 = tg * 4;
    const int isC = cs >> 4, nn = (cs & 15) * 8;
    u32x4 rbc[7], rx[7];
    load_raw7((const bf16_t*)(p.ws + (isC ? WS_SC : WS_SB)) + grp * 128 + nn, 512, rbase, n0 + i0 - 2, len, rbc);
    load_raw7((const bf16_t*)(p.ws + WS_SX) + grp * 256 + cs * 8, 1024, rbase, n0 + i0 - 2, len, rx);
    const int wv = tid >> 6, lane = tid & 63, dir = wv >> 2, hd = grp * 4 + (wv & 3), jn = dir ? 63 - lane : lane;
    const float dtraw = ((const float*)(p.ws + WS_DT))[(size_t)(rbase + n0 + jn) * 32 + dir * 16 + hd];
    { u32x4 o[4];
      conv8x4(rbc, Wbc, 1.0f, o);
      bf16_t* dst = (bf16_t*)(p.ws + (isC ? WS_CC : WS_BC)) + grp * 128 + nn;
#pragma unroll
      for (int pp = 0; pp < 4; ++pp) *(u32x4*)(dst + (size_t)(rbase + n0 + i0 + pp) * 512) = o[pp];
      conv8x4(rx, Wx, 1.0f, o);
      bf16_t* dx = (bf16_t*)(p.ws + WS_XCT) + grp * 256 + cs * 8;
#pragma unroll
      for (int pp = 0; pp < 4; ++pp) *(u32x4*)(dx + (size_t)(rbase + n0 + i0 + pp) * 1024) = o[pp]; }
    { const float dtv = softplus_f(dtraw + p.sdt_bias[l * 32 + dir * 16 + hd]);
      const float acs = wave_incl_sum(dtv * -__expf(p.sa_log[l * 32 + dir * 16 + hd]), lane);
      const size_t o = (size_t)(gc * 32 + dir * 16 + hd) * 64 + jn;
      ((float*)(p.ws + WS_SACS))[o] = acs; ((float*)(p.ws + WS_SDT))[o] = dtv; }
}

__device__ __forceinline__ void pool_window_item(const Params& p, int it, LAS unsigned char* lds) {
    const int tid = tid_fresh();
    bf16_t* BR = (bf16_t*)(p.ws + WS_BR);
    __syncthreads();
    if (it < 256) {
        const int row0 = MC + it * 64;
        { u32x4 t[16];
#pragma unroll
          for (int i = 0; i < 16; ++i) { const int q = tid + NTHR * i, r = q >> 7, ch = q & 127; t[i] = *(const u32x4*)(BR + (size_t)(row0 + r) * 3072 + ch * 8); }
#pragma unroll
          for (int i = 0; i < 16; ++i) *(LAS u32x4*)(lds + (tid + NTHR * i) * 16) = t[i]; }
        __syncthreads();
        for (int q = tid; q < 64 * 128; q += NTHR) { const int r = q >> 7, ch = q & 127, w = 2 << (ch >> 5);
            int lo = r - (w >> 1), hi = lo + w - 1; lo = lo < 0 ? 0 : lo; hi = hi > 63 ? 63 : hi;
            float s[8] = {0, 0, 0, 0, 0, 0, 0, 0}, self[8];
            for (int rr = lo; rr <= hi; ++rr) { float f[8]; unpack8(*(const LAS u32x4*)(lds + (rr * 128 + ch) * 16), f);
#pragma unroll
                for (int j = 0; j < 8; ++j) s[j] += f[j]; }
            unpack8(*(const LAS u32x4*)(lds + q * 16), self);
            const float inv = __builtin_amdgcn_rcpf((float)(hi - lo + 1)); f32x4 a, b;
#pragma unroll
            for (int j = 0; j < 4; ++j) { a[j] = s[j] * inv - self[j]; b[j] = s[4 + j] * inv - self[4 + j]; }
            *(u32x4*)(BR + (size_t)(row0 + r) * 3072 + ch * 8) = pack8(a, b); }
    } else {
        const int bb = (it - 256) >> 2, g = (it - 256) & 3, row0 = bb * 256, w = 2 << g;
        { u32x4 t[16];
#pragma unroll
          for (int i = 0; i < 16; ++i) { const int q = tid + NTHR * i, r = q >> 5, ch = q & 31; t[i] = *(const u32x4*)(BR + (size_t)(row0 + r) * 3072 + g * 256 + ch * 8); }
#pragma unroll
          for (int i = 0; i < 16; ++i) *(LAS u32x4*)(lds + (tid + NTHR * i) * 16) = t[i]; }
        __syncthreads();
        for (int q = tid; q < 256 * 32; q += NTHR) { const int r = q >> 5, ch = q & 31;
            int lo = r - (w >> 1), hi = lo + w - 1; lo = lo < 0 ? 0 : lo; hi = hi > 255 ? 255 : hi;
            float s[8] = {0, 0, 0, 0, 0, 0, 0, 0}, self[8];
            for (int rr = lo; rr <= hi; ++rr) { float f[8]; unpack8(*(const LAS u32x4*)(lds + (rr * 32 + ch) * 16), f);
#pragma unroll
                for (int j = 0; j < 8; ++j) s[j] += f[j]; }
            unpack8(*(const LAS u32x4*)(lds + q * 16), self);
            const float inv = __builtin_amdgcn_rcpf((float)(hi - lo + 1)); f32x4 a, b;
#pragma unroll
            for (int j = 0; j < 4; ++j) { a[j] = s[j] * inv - self[j]; b[j] = s[4 + j] * inv - self[4 + j]; }
            *(u32x4*)(BR + (size_t)(row0 + r) * 3072 + g * 256 + ch * 8) = pack8(a, b); }
    }
    __syncthreads();
}

typedef short bf16x4 __attribute__((ext_vector_type(4)));
__device__ __forceinline__ bf16x8 tr_join(bf16x4 r0, bf16x4 r1) { bf16x8 o; o[0] = r0[0]; o[1] = r0[1]; o[2] = r0[2]; o[3] = r0[3]; o[4] = r1[0]; o[5] = r1[1]; o[6] = r1[2]; o[7] = r1[3]; return o; }
__device__ __forceinline__ bf16x8 tr_frag(unsigned a0, unsigned a1) {
    bf16x4 r0, r1;
    asm volatile("ds_read_b64_tr_b16 %0, %2\n\tds_read_b64_tr_b16 %1, %3\n\ts_waitcnt lgkmcnt(0)" : "=&v"(r0), "=&v"(r1) : "v"(a0), "v"(a1) : "memory");
    return tr_join(r0, r1);
}
__device__ __forceinline__ void tr_frag4(const unsigned (&a)[4], unsigned d, bf16x8 (&f)[4]) {
    bf16x4 r[8];
    asm volatile("ds_read_b64_tr_b16 %0, %8\n\tds_read_b64_tr_b16 %1, %9\n\tds_read_b64_tr_b16 %2, %10\n\tds_read_b64_tr_b16 %3, %11\n\t"
                 "ds_read_b64_tr_b16 %4, %12\n\tds_read_b64_tr_b16 %5, %13\n\tds_read_b64_tr_b16 %6, %14\n\tds_read_b64_tr_b16 %7, %15\n\ts_waitcnt lgkmcnt(0)"
                 : "=&v"(r[0]), "=&v"(r[1]), "=&v"(r[2]), "=&v"(r[3]), "=&v"(r[4]), "=&v"(r[5]), "=&v"(r[6]), "=&v"(r[7])
                 : "v"(a[0]), "v"(a[0] + d), "v"(a[1]), "v"(a[1] + d), "v"(a[2]), "v"(a[2] + d), "v"(a[3]), "v"(a[3] + d) : "memory");
#pragma unroll
    for (int i = 0; i < 4; ++i) f[i] = tr_join(r[2 * i], r[2 * i + 1]);
}
__device__ __forceinline__ void tr_frag6(const unsigned (&a)[6], unsigned d, bf16x8 (&f)[6]) {
    bf16x4 r[12];
    asm volatile("ds_read_b64_tr_b16 %0, %12\n\tds_read_b64_tr_b16 %1, %13\n\tds_read_b64_tr_b16 %2, %14\n\tds_read_b64_tr_b16 %3, %15\n\t"
                 "ds_read_b64_tr_b16 %4, %16\n\tds_read_b64_tr_b16 %5, %17\n\tds_read_b64_tr_b16 %6, %18\n\tds_read_b64_tr_b16 %7, %19\n\t"
                 "ds_read_b64_tr_b16 %8, %20\n\tds_read_b64_tr_b16 %9, %21\n\tds_read_b64_tr_b16 %10, %22\n\tds_read_b64_tr_b16 %11, %23\n\ts_waitcnt lgkmcnt(0)"
                 : "=&v"(r[0]), "=&v"(r[1]), "=&v"(r[2]), "=&v"(r[3]), "=&v"(r[4]), "=&v"(r[5]), "=&v"(r[6]), "=&v"(r[7]), "=&v"(r[8]), "=&v"(r[9]), "=&v"(r[10]), "=&v"(r[11])
                 : "v"(a[0]), "v"(a[0] + d), "v"(a[1]), "v"(a[1] + d), "v"(a[2]), "v"(a[2] + d), "v"(a[3]), "v"(a[3] + d), "v"(a[4]), "v"(a[4] + d), "v"(a[5]), "v"(a[5] + d) : "memory");
#pragma unroll
    for (int i = 0; i < 6; ++i) f[i] = tr_join(r[2 * i], r[2 * i + 1]);
}
constexpr int ML_CT = 0, ML_Q = 36864, ML_K = 71680, ML_V = 106496, ML_A = 135168;
__device__ __forceinline__ void mlstm_chunk_item(const Params& p, int l, int item, LAS unsigned char* lds) {
    const int tid0 = tid_fresh(), wid = __builtin_amdgcn_readfirstlane(tid0 >> 6);
    const int b = item >> 5, hd = (item >> 3) & 3, dir = (item >> 2) & 1, eg2 = item & 3;
    const bf16_t* QC = (const bf16_t*)(p.ws + WS_QC); const bf16_t* KC = (const bf16_t*)(p.ws + WS_KC);
    const bf16_t* Vg = (const bf16_t*)(p.ws + WS_V);
    const float* GAa = (const float*)(p.ws + WS_MGA); const float* GCc = (const float*)(p.ws + WS_MGC); const float* GPp = (const float*)(p.ws + WS_MGP);
    bf16_t* OUT = (bf16_t*)(p.ws + (dir ? WS_HB2 : WS_HF2));
    const int ti = wid >> 1, wh = wid & 1;
    __syncthreads();
    for (int i = tid0; i < 36864 / 4; i += NTHR) ((LAS unsigned*)(lds + ML_CT))[i] = 0u;
    if (tid0 < 128) { const int es = tid0 >> 6, r = tid0 & 63; *(LAS u32x4*)(lds + ML_V + es * 14336 + r * 112 + 64) = (u32x4){0x3F80u, 0u, 0u, 0u}; *(LAS u32x4*)(lds + ML_V + es * 14336 + r * 112 + 80) = (u32x4){0u, 0u, 0u, 0u}; }
    f32x4 Cacc[2][2][3];
#pragma unroll
    for (int es = 0; es < 2; ++es)
#pragma unroll
        for (int j = 0; j < 2; ++j)
#pragma unroll
            for (int e = 0; e < 3; ++e) Cacc[es][j][e] = (f32x4){0.f, 0.f, 0.f, 0.f};
    float m_st = 0.f;
    f32x4 ca0 = (f32x4){0.f, 0.f, 0.f, 0.f}, ca1 = ca0, cP4 = ca0, cC4 = ca0; float cPt = 0.f, cPl = 0.f, cCl = 0.f, caw = 0.f;
    const int jl = dir ? 0 : 63;
    __syncthreads();
    for (int c = -1; c < 68; ++c) {
        const int cn = c + 1;
        const int tid = tid_fresh(), lane = tid & 63, fr = lane & 15, fq = lane >> 4;
        const int vrow = tid < 384 ? tid / 6 : 63, vch = tid < 384 ? tid % 6 : 0;
        const int gs0 = 16 * (2 * wh) + 4 * fq, gt = 16 * ti + fr, gt0 = 16 * ti + 4 * fq;
        u32x4 rq[4], rk[4], rv[1];
#pragma unroll
        for (int j = 0; j < 4; ++j) { rq[j] = (u32x4){0u, 0u, 0u, 0u}; rk[j] = rq[j]; }
        rv[0] = (u32x4){0u, 0u, 0u, 0u};
        if (cn < 68) {
            const int cin = cn < 4 ? (dir ? 3 - cn : cn) : 4 + (dir ? 67 - cn : cn - 4), gc = b * 68 + cin;
            int rbase, n0, len; chunk_geom(gc, rbase, n0, len);
#pragma unroll
            for (int j = 0; j < 4; ++j) { const int q = tid + NTHR * j;
                const size_t ro = (size_t)(rbase + n0 + (q >> 5)) * 1024 + hd * 256 + (q & 31) * 8;
                rq[j] = *(const u32x4*)(QC + ro); rk[j] = *(const u32x4*)(KC + ro); }
            { const int es = tid >> 8, r = (tid & 255) >> 2, ch = tid & 3;
              rv[0] = *(const u32x4*)(Vg + (size_t)(rbase + n0 + r) * 1024 + hd * 256 + (2 * eg2 + es) * 32 + ch * 8); }
        }
        if (c >= 0) {
            const int cin = c < 4 ? (dir ? 3 - c : c) : 4 + (dir ? 67 - c : c - 4), gc = b * 68 + cin;
            int rbase, n0, len; chunk_geom(gc, rbase, n0, len);
            {
                f32x4 st[2] = {(f32x4){0.f, 0.f, 0.f, 0.f}, (f32x4){0.f, 0.f, 0.f, 0.f}};
                const LAS unsigned char* qb = lds + ML_Q + (16 * ti + fr) * 544 + fq * 16;
                const LAS unsigned char* kb0 = lds + ML_K + (16 * (2 * wh) + fr) * 544 + fq * 16;
                bf16x8 qfa[4], k0f[4], k1f[4];
#pragma unroll
                for (int hb = 0; hb < 2; ++hb) {
#pragma unroll
                    for (int kd = 0; kd < 4; ++kd) { qfa[kd] = *(const LAS bf16x8*)(qb + (4 * (1 - hb) + kd) * 64); k0f[kd] = *(const LAS bf16x8*)(kb0 + (4 * (1 - hb) + kd) * 64); k1f[kd] = *(const LAS bf16x8*)(kb0 + 16 * 544 + (4 * (1 - hb) + kd) * 64); }
                    __builtin_amdgcn_sched_barrier(0);
#pragma unroll
                    for (int kd = 0; kd < 4; ++kd) {
                        st[0] = __builtin_amdgcn_mfma_f32_16x16x32_bf16(k0f[kd], qfa[kd], st[0], 0, 0, 0);
                        st[1] = __builtin_amdgcn_mfma_f32_16x16x32_bf16(k1f[kd], qfa[kd], st[1], 0, 0, 0);
                    }
                    __builtin_amdgcn_sched_barrier(0);
                }
                const int t = 16 * ti + fr; const float Mt = fmaxf(m_st, cPt), M63 = fmaxf(m_st, cPl);
#pragma unroll
                for (int j = 0; j < 2; ++j) { const int s0 = 16 * (2 * wh + j) + 4 * fq; const f32x4 av = j ? ca1 : ca0;
                    f32x4 o;
#pragma unroll
                    for (int r = 0; r < 4; ++r) { const bool keep = dir ? (s0 + r >= t) : (s0 + r <= t); o[r] = keep ? st[j][r] * __expf(av[r] - Mt) : 0.f; }
                    *(LAS u32x2*)(lds + ML_A + t * 160 + s0 * 2) = pack4(o); }
                if (tid < 384) { const float w = __expf(caw - M63);
#pragma unroll
                    for (int es = 0; es < 2; ++es) { float f[8]; unpack8(*(const LAS u32x4*)(lds + ML_V + es * 14336 + vrow * 112 + vch * 16), f);
                        f32x4 o0, o1;
#pragma unroll
                        for (int i = 0; i < 4; ++i) { o0[i] = f[i] * w; o1[i] = f[4 + i] * w; }
                        *(LAS u32x4*)(lds + ML_V + es * 14336 + 7168 + vrow * 112 + vch * 16) = pack8(o0, o1); } }
            }
            __syncthreads();
            {
                const LAS unsigned char* ab = lds + ML_A + (16 * ti + fr) * 160 + fq * 16;
                const LAS unsigned char* qb = lds + ML_Q + (16 * ti + fr) * 544 + fq * 16;
                bf16x8 af[2], k0f[2], k1f[2], qf[8];
#pragma unroll
                for (int ks = 0; ks < 2; ++ks) af[ks] = *(const LAS bf16x8*)(ab + ks * 64);
#pragma unroll
                for (int kd = 0; kd < 8; ++kd) qf[kd] = *(const LAS bf16x8*)(qb + kd * 64);
                { const unsigned kb_ = (unsigned)(size_t)(lds + ML_K) + (unsigned)((8 * fq + (fr >> 2)) * 544 + (fr & 3) * 8 + wid * 64);
                  const unsigned ka[4] = {kb_, kb_ + 32, kb_ + 32 * 544, kb_ + 32 * 544 + 32}; bf16x8 kf[4]; tr_frag4(ka, 4 * 544, kf);
                  k0f[0] = kf[0]; k1f[0] = kf[1]; k0f[1] = kf[2]; k1f[1] = kf[3]; }
                const int t0 = 16 * ti + 4 * fq;
                f32x4 sgv, emv;
#pragma unroll
                for (int r = 0; r < 4; ++r) { const float Mr = fmaxf(m_st, cP4[r]); sgv[r] = __expf(m_st - Mr); emv[r] = __expf(-(cC4[r] + Mr)); }
                const float decay = __expf(m_st - fmaxf(m_st, cPl));
                const bool wr_out = !(l == 1 && cin < 4);
#pragma unroll
                for (int es = 0; es < 2; ++es) {
                    f32x4 n1o = (f32x4){0.f, 0.f, 0.f, 0.f}, n1a = n1o, n2o = n1o, n2a = n1o;
                    const LAS unsigned char* co = lds + ML_CT + es * 18432 + (16 * wh + fr) * 544 + fq * 16;
                    const LAS unsigned char* ca = lds + ML_CT + es * 18432 + (32 + fr) * 544 + fq * 16;
                    const unsigned vtr = (unsigned)(size_t)(lds + ML_V + es * 14336) + (unsigned)((8 * fq + (fr >> 2)) * 112 + (fr & 3) * 8);
                    { bf16x8 vof[2], vaf[2];
                      { const unsigned va_[4] = {vtr + wh * 32, vtr + 64, vtr + 3584 + wh * 32, vtr + 3584 + 64}; bf16x8 vf[4]; tr_frag4(va_, 448, vf); vof[0] = vf[0]; vaf[0] = vf[1]; vof[1] = vf[2]; vaf[1] = vf[3]; }
                      __builtin_amdgcn_sched_barrier(0);
#pragma unroll
                      for (int ks = 0; ks < 2; ++ks) {
                          n1o = __builtin_amdgcn_mfma_f32_16x16x32_bf16(af[ks], vof[ks], n1o, 0, 0, 0);
                          n1a = __builtin_amdgcn_mfma_f32_16x16x32_bf16(af[ks], vaf[ks], n1a, 0, 0, 0); }
                      __builtin_amdgcn_sched_barrier(0); }
#pragma unroll
                    for (int kb = 0; kb < 2; ++kb) {
                        bf16x8 cof[4], caf[4];
#pragma unroll
                        for (int kd = 0; kd < 4; ++kd) { cof[kd] = *(const LAS bf16x8*)(co + (4 * kb + kd) * 64); caf[kd] = *(const LAS bf16x8*)(ca + (4 * kb + kd) * 64); }
                        __builtin_amdgcn_sched_barrier(0);
#pragma unroll
                        for (int kd = 0; kd < 4; ++kd) {
                            n2o = __builtin_amdgcn_mfma_f32_16x16x32_bf16(qf[4 * kb + kd], cof[kd], n2o, 0, 0, 0);
                            n2a = __builtin_amdgcn_mfma_f32_16x16x32_bf16(qf[4 * kb + kd], caf[kd], n2a, 0, 0, 0); }
                        __builtin_amdgcn_sched_barrier(0);
                    }
#pragma unroll
                    for (int r = 0; r < 4; ++r) {
                        const float den = __shfl(n1a[r] + sgv[r] * n2a[r], lane & 48);
                        const float hv = (n1o[r] + sgv[r] * n2o[r]) * __builtin_amdgcn_rcpf(fmaxf(fabsf(den), emv[r]));
                        if (wr_out) OUT[(size_t)(rbase + n0 + t0 + r) * 1024 + hd * 256 + (2 * eg2 + es) * 32 + 16 * wh + fr] = (bf16_t)f2bf(hv);
                    }
#pragma unroll
                    for (int j = 0; j < 2; ++j)
#pragma unroll
                        for (int e = 0; e < 3; ++e) Cacc[es][j][e] = Cacc[es][j][e] * decay;
                    const unsigned vwr = vtr + 7168;
                    bf16x8 v0f[2], v1f[2], v2f[2];
                    { const unsigned wa_[6] = {vwr, vwr + 32, vwr + 64, vwr + 3584, vwr + 3584 + 32, vwr + 3584 + 64}; bf16x8 wf[6]; tr_frag6(wa_, 448, wf);
                      v0f[0] = wf[0]; v1f[0] = wf[1]; v2f[0] = wf[2]; v0f[1] = wf[3]; v1f[1] = wf[4]; v2f[1] = wf[5]; }
                    __builtin_amdgcn_sched_barrier(0);
#pragma unroll
                    for (int ks = 0; ks < 2; ++ks) {
                        Cacc[es][0][0] = __builtin_amdgcn_mfma_f32_16x16x32_bf16(k0f[ks], v0f[ks], Cacc[es][0][0], 0, 0, 0);
                        Cacc[es][0][1] = __builtin_amdgcn_mfma_f32_16x16x32_bf16(k0f[ks], v1f[ks], Cacc[es][0][1], 0, 0, 0);
                        Cacc[es][0][2] = __builtin_amdgcn_mfma_f32_16x16x32_bf16(k0f[ks], v2f[ks], Cacc[es][0][2], 0, 0, 0);
                        Cacc[es][1][0] = __builtin_amdgcn_mfma_f32_16x16x32_bf16(k1f[ks], v0f[ks], Cacc[es][1][0], 0, 0, 0);
                        Cacc[es][1][1] = __builtin_amdgcn_mfma_f32_16x16x32_bf16(k1f[ks], v1f[ks], Cacc[es][1][1], 0, 0, 0);
                        Cacc[es][1][2] = __builtin_amdgcn_mfma_f32_16x16x32_bf16(k1f[ks], v2f[ks], Cacc[es][1][2], 0, 0, 0);
                    }
                    __builtin_amdgcn_sched_barrier(0);
                }
            }
            __syncthreads();
#pragma unroll
            for (int es = 0; es < 2; ++es)
#pragma unroll
                for (int j = 0; j < 2; ++j) { const int dcol = (16 * (2 * wid + j) + 4 * fq) * 2;
                    *(LAS u32x2*)(lds + ML_CT + es * 18432 + fr * 544 + dcol) = pack4(Cacc[es][j][0]);
                    *(LAS u32x2*)(lds + ML_CT + es * 18432 + (16 + fr) * 544 + dcol) = pack4(Cacc[es][j][1]);
                    if (fr == 0) *(LAS u32x2*)(lds + ML_CT + es * 18432 + 32 * 544 + dcol) = pack4(Cacc[es][j][2]); }
        }
        if (c >= 0) m_st = cCl + fmaxf(m_st, cPl);
        if (cn < 68) {
            const int cin = cn < 4 ? (dir ? 3 - cn : cn) : 4 + (dir ? 67 - cn : cn - 4); const size_t gb = (size_t)((b * 68 + cin) * 8 + dir * 4 + hd) * 64;
            ca0 = *(const f32x4*)(GAa + gb + gs0); ca1 = *(const f32x4*)(GAa + gb + gs0 + 16); caw = GAa[gb + vrow];
            cP4 = *(const f32x4*)(GPp + gb + gt0); cC4 = *(const f32x4*)(GCc + gb + gt0); cPt = GPp[gb + gt]; cPl = GPp[gb + jl]; cCl = GCc[gb + jl]; }
        if (cn < 68) {
#pragma unroll
            for (int j = 0; j < 4; ++j) { const int q = tid + NTHR * j;
                *(LAS u32x4*)(lds + ML_Q + (q >> 5) * 544 + (q & 31) * 16) = rq[j];
                *(LAS u32x4*)(lds + ML_K + (q >> 5) * 544 + (q & 31) * 16) = rk[j]; }
            *(LAS u32x4*)(lds + ML_V + (tid >> 8) * 14336 + ((tid & 255) >> 2) * 112 + (tid & 3) * 16) = rv[0];
        }
        __syncthreads();
    }
}

constexpr int SS_C = 0, SS_B = 18432, SS_X = 36864, SS_G = 67584, SS_S = 77824;
__device__ __forceinline__ void ssd_chunk_item(const Params& p, int l, int item, LAS unsigned char* lds) {
    const int tid0 = tid_fresh(), wid = __builtin_amdgcn_readfirstlane(tid0 >> 6);
    const int b = item >> 5, hd = (item >> 1) & 15, dir = item & 1, grp = hd >> 2;
    const bf16_t* BC = (const bf16_t*)(p.ws + WS_BC); const bf16_t* CC = (const bf16_t*)(p.ws + WS_CC); const bf16_t* XC = (const bf16_t*)(p.ws + WS_XCT);
    const float* ACS = (const float*)(p.ws + WS_SACS); const float* SDT = (const float*)(p.ws + WS_SDT);
    bf16_t* OUT = (bf16_t*)(p.ws + (dir ? WS_YB : WS_YF));
    const float dskip = p.sd[l * 16 + hd];
    const int ti = wid >> 1, wh = wid & 1, jl = dir ? 0 : 63;
    __syncthreads();
    for (int i = tid0; i < 18432 / 4; i += NTHR) ((LAS unsigned*)(lds + SS_S))[i] = 0u;
    f32x4 Sacc[2][2];
#pragma unroll
    for (int ph = 0; ph < 2; ++ph) { Sacc[ph][0] = (f32x4){0.f, 0.f, 0.f, 0.f}; Sacc[ph][1] = Sacc[ph][0]; }
    f32x4 cs0 = (f32x4){0.f, 0.f, 0.f, 0.f}, cs1 = cs0, ct4 = cs0; float cat = 0.f, cal = 0.f, csw = 0.f, cdw = 0.f;
    __syncthreads();
    for (int c = -1; c < 68; ++c) {
        const int cn = c + 1;
        const int tid = tid_fresh(), lane = tid & 63, fr = lane & 15, fq = lane >> 4;
        const int xph = tid >> 8, xrow = (tid & 255) >> 2, xch = tid & 3;
        const int gs0 = 16 * (2 * wh) + 4 * fq, gt = 16 * ti + fr, gt0 = 16 * ti + 4 * fq;
        u32x4 rc[2], rb[2], rx = (u32x4){0u, 0u, 0u, 0u};
#pragma unroll
        for (int j = 0; j < 2; ++j) { rc[j] = (u32x4){0u, 0u, 0u, 0u}; rb[j] = rc[j]; }
        if (cn < 68) {
            const int cin = cn < 4 ? (dir ? 3 - cn : cn) : 4 + (dir ? 67 - cn : cn - 4), gc = b * 68 + cin;
            int rbase, n0, len; chunk_geom(gc, rbase, n0, len);
#pragma unroll
            for (int j = 0; j < 2; ++j) { const int q = tid + NTHR * j;
                const size_t ro = (size_t)(rbase + n0 + (q >> 4)) * 512 + grp * 128 + (q & 15) * 8;
                rc[j] = *(const u32x4*)(CC + ro); rb[j] = *(const u32x4*)(BC + ro); }
            rx = *(const u32x4*)(XC + (size_t)(rbase + n0 + xrow) * 1024 + hd * 64 + xph * 32 + xch * 8);
        }
        if (c >= 0) {
            const int cin = c < 4 ? (dir ? 3 - c : c) : 4 + (dir ? 67 - c : c - 4), gc = b * 68 + cin;
            int rbase, n0, len; chunk_geom(gc, rbase, n0, len);
            {
                f32x4 st[2] = {(f32x4){0.f, 0.f, 0.f, 0.f}, (f32x4){0.f, 0.f, 0.f, 0.f}};
                const LAS unsigned char* cbp = lds + SS_C + (16 * ti + fr) * 288 + fq * 16;
                const LAS unsigned char* bb0 = lds + SS_B + (16 * (2 * wh) + fr) * 288 + fq * 16;
                bf16x8 cf[4], b0f[4], b1f[4];
#pragma unroll
                for (int kn = 0; kn < 4; ++kn) { cf[kn] = *(const LAS bf16x8*)(cbp + kn * 64); b0f[kn] = *(const LAS bf16x8*)(bb0 + kn * 64); b1f[kn] = *(const LAS bf16x8*)(bb0 + 16 * 288 + kn * 64); }
                __builtin_amdgcn_sched_barrier(0);
#pragma unroll
                for (int kn = 0; kn < 4; ++kn) {
                    st[0] = __builtin_amdgcn_mfma_f32_16x16x32_bf16(b0f[kn], cf[kn], st[0], 0, 0, 0);
                    st[1] = __builtin_amdgcn_mfma_f32_16x16x32_bf16(b1f[kn], cf[kn], st[1], 0, 0, 0);
                }
                __builtin_amdgcn_sched_barrier(0);
                const int t = 16 * ti + fr; const float at = cat;
#pragma unroll
                for (int j = 0; j < 2; ++j) { const int s0 = 16 * (2 * wh + j) + 4 * fq; const f32x4 av = j ? cs1 : cs0;
                    f32x4 o;
#pragma unroll
                    for (int r = 0; r < 4; ++r) { const bool keep = dir ? (s0 + r >= t) : (s0 + r <= t); o[r] = keep ? st[j][r] * __expf(at - av[r]) : 0.f; }
                    *(LAS u32x2*)(lds + SS_G + t * 160 + s0 * 2) = pack4(o); }
                { float f[8]; unpack8(*(const LAS u32x4*)(lds + SS_X + xph * 15360 + xrow * 80 + xch * 16), f);
                  const float w = __expf(cal - csw); f32x4 o0, o1, w0, w1;
#pragma unroll
                  for (int i = 0; i < 4; ++i) { o0[i] = f[i] * cdw; o1[i] = f[4 + i] * cdw; w0[i] = o0[i] * w; w1[i] = o1[i] * w; }
                  *(LAS u32x4*)(lds + SS_X + xph * 15360 + 5120 + xrow * 80 + xch * 16) = pack8(o0, o1);
                  *(LAS u32x4*)(lds + SS_X + xph * 15360 + 10240 + xrow * 80 + xch * 16) = pack8(w0, w1); }
            }
            __syncthreads();
            {
                const LAS unsigned char* gb = lds + SS_G + (16 * ti + fr) * 160 + fq * 16;
                const LAS unsigned char* cbp = lds + SS_C + (16 * ti + fr) * 288 + fq * 16;
                const unsigned btr = (unsigned)(size_t)(lds + SS_B) + (unsigned)((8 * fq + (fr >> 2)) * 288 + (fr & 3) * 8 + wid * 32);
                bf16x8 gf[2], cf[4], btf[2];
#pragma unroll
                for (int ks = 0; ks < 2; ++ks) gf[ks] = *(const LAS bf16x8*)(gb + ks * 64);
#pragma unroll
                for (int kn = 0; kn < 4; ++kn) cf[kn] = *(const LAS bf16x8*)(cbp + kn * 64);
#pragma unroll
                for (int ks = 0; ks < 2; ++ks) btf[ks] = tr_frag(btr + ks * 9216, btr + ks * 9216 + 1152);
                const int t0 = 16 * ti + 4 * fq;
                f32x4 eav; eav[0] = __expf(ct4[0]); eav[1] = __expf(ct4[1]); eav[2] = __expf(ct4[2]); eav[3] = __expf(ct4[3]);
                const float dec = __expf(cal);
                const bool wr_out = !(l == 1 && cin < 4);
#pragma unroll
                for (int ph = 0; ph < 2; ++ph) {
                    f32x4 y1 = (f32x4){0.f, 0.f, 0.f, 0.f}, y2 = y1;
                    const LAS unsigned char* sb = lds + SS_S + ph * 9216 + (16 * wh + fr) * 288 + fq * 16;
                    const unsigned xtr = (unsigned)(size_t)(lds + SS_X + ph * 15360 + 5120) + (unsigned)((8 * fq + (fr >> 2)) * 80 + (fr & 3) * 8);
                    bf16x8 xf[2], sf[4], xw0f[2], xw1f[2];
#pragma unroll
                    for (int kn = 0; kn < 4; ++kn) sf[kn] = *(const LAS bf16x8*)(sb + kn * 64);
                    { const unsigned xa_[6] = {xtr + wh * 32, xtr + 2560 + wh * 32, xtr + 5120, xtr + 5120 + 32, xtr + 5120 + 2560, xtr + 5120 + 2560 + 32}; bf16x8 xq[6]; tr_frag6(xa_, 320, xq);
                      xf[0] = xq[0]; xf[1] = xq[1]; xw0f[0] = xq[2]; xw1f[0] = xq[3]; xw0f[1] = xq[4]; xw1f[1] = xq[5]; }
                    __builtin_amdgcn_sched_barrier(0);
#pragma unroll
                    for (int ks = 0; ks < 2; ++ks) y1 = __builtin_amdgcn_mfma_f32_16x16x32_bf16(gf[ks], xf[ks], y1, 0, 0, 0);
#pragma unroll
                    for (int kn = 0; kn < 4; ++kn) y2 = __builtin_amdgcn_mfma_f32_16x16x32_bf16(cf[kn], sf[kn], y2, 0, 0, 0);
#pragma unroll
                    for (int r = 0; r < 4; ++r) {
                        float yv = y1[r] + eav[r] * y2[r];
                        if (dir == 0) yv += dskip * bf2f(*(const LAS bf16_t*)(lds + SS_X + ph * 15360 + (t0 + r) * 80 + (16 * wh + fr) * 2));
                        if (wr_out) OUT[(size_t)(rbase + n0 + t0 + r) * 1024 + hd * 64 + ph * 32 + 16 * wh + fr] = (bf16_t)f2bf(yv);
                    }
                    Sacc[ph][0] = Sacc[ph][0] * dec; Sacc[ph][1] = Sacc[ph][1] * dec;
#pragma unroll
                    for (int ks = 0; ks < 2; ++ks) {
                        Sacc[ph][0] = __builtin_amdgcn_mfma_f32_16x16x32_bf16(btf[ks], xw0f[ks], Sacc[ph][0], 0, 0, 0);
                        Sacc[ph][1] = __builtin_amdgcn_mfma_f32_16x16x32_bf16(btf[ks], xw1f[ks], Sacc[ph][1], 0, 0, 0); }
                    __builtin_amdgcn_sched_barrier(0);
                }
            }
            __syncthreads();
#pragma unroll
            for (int ph = 0; ph < 2; ++ph) { const int ncol = (16 * wid + 4 * fq) * 2;
              *(LAS u32x2*)(lds + SS_S + ph * 9216 + fr * 288 + ncol) = pack4(Sacc[ph][0]);
              *(LAS u32x2*)(lds + SS_S + ph * 9216 + (16 + fr) * 288 + ncol) = pack4(Sacc[ph][1]); }
        }
        if (cn < 68) {
            const int cin = cn < 4 ? (dir ? 3 - cn : cn) : 4 + (dir ? 67 - cn : cn - 4); const size_t gb = (size_t)((b * 68 + cin) * 32 + dir * 16 + hd) * 64;
            cs0 = *(const f32x4*)(ACS + gb + gs0); cs1 = *(const f32x4*)(ACS + gb + gs0 + 16); csw = ACS[gb + xrow]; cdw = SDT[gb + xrow];
            ct4 = *(const f32x4*)(ACS + gb + gt0); cat = ACS[gb + gt]; cal = ACS[gb + jl];
#pragma unroll
            for (int j = 0; j < 2; ++j) { const int q = tid + NTHR * j;
                *(LAS u32x4*)(lds + SS_C + (q >> 4) * 288 + (q & 15) * 16) = rc[j];
                *(LAS u32x4*)(lds + SS_B + (q >> 4) * 288 + (q & 15) * 16) = rb[j]; }
            *(LAS u32x4*)(lds + SS_X + xph * 15360 + xrow * 80 + xch * 16) = rx;
        }
        __syncthreads();
    }
}

__device__ __forceinline__ void mlstm_finish_rows(const Params& p, int l, int row_lo, int gw, int ngw) {
    if (p.dup) return;
    const int lane = tid_fresh() & 63;
    const bf16_t* HF = (const bf16_t*)(p.ws + WS_HF2); const bf16_t* HB = (const bf16_t*)(p.ws + WS_HB2);
    bf16_t* BR = (bf16_t*)(p.ws + WS_BR);
    const float* ng = p.mnorm_g + l * 1024;
    int row = row_lo + gw;
    u32x2 ca[4], cb[4], co[4], na[4], nbv[4], no[4];
    if (row < MT) { const size_t so = (size_t)scanrow(row) * 1024;
#pragma unroll
        for (int hd = 0; hd < 4; ++hd) { const int c = hd * 256 + 4 * lane; ca[hd] = *(const u32x2*)(HF + so + c); cb[hd] = *(const u32x2*)(HB + so + c); co[hd] = *(const u32x2*)(BR + (size_t)row * 3072 + 1024 + c); } }
    for (; row < MT; row += ngw) {
        const int rn = row + ngw;
        if (rn < MT) { const size_t so = (size_t)scanrow(rn) * 1024;
#pragma unroll
            for (int hd = 0; hd < 4; ++hd) { const int c = hd * 256 + 4 * lane; na[hd] = *(const u32x2*)(HF + so + c); nbv[hd] = *(const u32x2*)(HB + so + c); no[hd] = *(const u32x2*)(BR + (size_t)rn * 3072 + 1024 + c); } }
#pragma unroll
        for (int hd = 0; hd < 4; ++hd) { const int c = hd * 256 + 4 * lane;
            const u32x2 a = ca[hd], b2 = cb[hd], o = co[hd];
            f32x4 h; h[0] = lo16(a.x) + lo16(b2.x); h[1] = hi16(a.x) + hi16(b2.x); h[2] = lo16(a.y) + lo16(b2.y); h[3] = hi16(a.y) + hi16(b2.y);
            const float ss = wave_sum((h[0] * h[0] + h[1] * h[1]) + (h[2] * h[2] + h[3] * h[3]));
            const float rs = __builtin_amdgcn_rsqf(ss * (1.f / 256.f) + EPS);
            const f32x4 g = *(const f32x4*)(ng + c);
            f32x4 r; r[0] = sigmoid_f(lo16(o.x)) * (h[0] * rs * g[0]); r[1] = sigmoid_f(hi16(o.x)) * (h[1] * rs * g[1]);
            r[2] = sigmoid_f(lo16(o.y)) * (h[2] * rs * g[2]); r[3] = sigmoid_f(hi16(o.y)) * (h[3] * rs * g[3]);
            u32x2 w; w.x = pk2(r[0], r[1]); w.y = pk2(r[2], r[3]);
            *(u32x2*)(BR + (size_t)row * 3072 + 1024 + c) = w; }
#pragma unroll
        for (int hd = 0; hd < 4; ++hd) { ca[hd] = na[hd]; cb[hd] = nbv[hd]; co[hd] = no[hd]; }
    }
}
__device__ __forceinline__ void ssd_finish_rows(const Params& p, int l, int row_lo, int gw, int ngw) {
    if (p.dup) return;
    const int lane = tid_fresh() & 63;
    const bf16_t* YF = (const bf16_t*)(p.ws + WS_YF); const bf16_t* YB = (const bf16_t*)(p.ws + WS_YB);
    bf16_t* BR = (bf16_t*)(p.ws + WS_BR);
    const float* ng = p.snorm_g + l * 1024;
    int row = row_lo + gw;
    u32x2 ca[4], cb[4], cz[4], na[4], nbv[4], nz[4];
    if (row < MT) {
#pragma unroll
        for (int j = 0; j < 4; ++j) { const int c = 4 * lane + 256 * j; ca[j] = *(const u32x2*)(YF + (size_t)row * 1024 + c); cb[j] = *(const u32x2*)(YB + (size_t)row * 1024 + c); cz[j] = *(const u32x2*)(BR + (size_t)row * 3072 + 2048 + c); } }
    for (; row < MT; row += ngw) {
        const int rn = row + ngw;
        if (rn < MT) {
#pragma unroll
            for (int j = 0; j < 4; ++j) { const int c = 4 * lane + 256 * j; na[j] = *(const u32x2*)(YF + (size_t)rn * 1024 + c); nbv[j] = *(const u32x2*)(YB + (size_t)rn * 1024 + c); nz[j] = *(const u32x2*)(BR + (size_t)rn * 3072 + 2048 + c); } }
        f32x4 v[4]; float ss = 0.f;
#pragma unroll
        for (int j = 0; j < 4; ++j) { const u32x2 a = ca[j], b2 = cb[j], z = cz[j];
            v[j][0] = (lo16(a.x) + lo16(b2.x)) * silu_f(lo16(z.x)); v[j][1] = (hi16(a.x) + hi16(b2.x)) * silu_f(hi16(z.x));
            v[j][2] = (lo16(a.y) + lo16(b2.y)) * silu_f(lo16(z.y)); v[j][3] = (hi16(a.y) + hi16(b2.y)) * silu_f(hi16(z.y));
            ss += (v[j][0] * v[j][0] + v[j][1] * v[j][1]) + (v[j][2] * v[j][2] + v[j][3] * v[j][3]); }
        const float rs = __builtin_amdgcn_rsqf(wave_sum(ss) * (1.f / 1024.f) + EPS);
#pragma unroll
        for (int j = 0; j < 4; ++j) { const int c = 4 * lane + 256 * j; const f32x4 g = *(const f32x4*)(ng + c);
            u32x2 w; w.x = pk2(v[j][0] * rs * g[0], v[j][1] * rs * g[1]); w.y = pk2(v[j][2] * rs * g[2], v[j][3] * rs * g[3]);
            *(u32x2*)(BR + (size_t)row * 3072 + 2048 + c) = w; }
#pragma unroll
        for (int j = 0; j < 4; ++j) { ca[j] = na[j]; cb[j] = nbv[j]; cz[j] = nz[j]; }
    }
}

__device__ __forceinline__ void phase_route(const Params& p, int l, unsigned char* ldsb, int bid, int nb) {
    float* lds = reinterpret_cast<float*>(ldsb);
    float* Wt = lds;
    int* hist = reinterpret_cast<int*>(lds + 36 * 1024);
    const int tid = tid_fresh(), lane = tid & 63, wave = tid >> 6;
    const int row_lo = l == 0 ? 0 : MC, rpb = l == 0 ? 68 : 64;
    const float* wrg = p.w_rg + (size_t)l * 1024 * 4; const float* wre = p.w_re + (size_t)l * 1024 * 32;
    for (int i = tid; i < 1024 * 4; i += NTHR) { const int k = i >> 2, g = i & 3; Wt[g * 1024 + (k ^ ((g & 7) << 2))] = wrg[i]; }
    for (int i = tid; i < 1024 * 32; i += NTHR) { const int k = i >> 5, e = i & 31; Wt[(4 + e) * 1024 + (k ^ (((4 + e) & 7) << 2))] = wre[i]; }
    const float* mod = (const float*)(p.ws + WS_MOD) + l * 5 * 6144;
    int* EID = (int*)(p.ws + WS_EID); float* EWT = (float*)(p.ws + WS_EWT);
    for (int vb = bid; vb < 256; vb += nb) {
        if (tid < 32) hist[tid] = 0;
        __syncthreads();
        for (int rr = wave; rr < rpb; rr += 8) {
            const int row = row_lo + vb * rpb + rr;
            f32x4 v[4];
            const float* mr = mod + modrow(row) * 6144;
            {
              const bool from_in = (l == 0) && !p.dup;
              const float* res = row < MC ? p.ctx + (size_t)row * 1024 : p.x + (size_t)(row - MC) * 1024;
              bf16_t* xlr = (bf16_t*)(p.ws + WS_XL) + (size_t)row * 1024;
              u32x2 o2[4];
#pragma unroll
              for (int j = 0; j < 4; ++j) {
                  if (from_in) v[j] = *(const f32x4*)(res + 4 * lane + 256 * j);
                  else { const u32x2 xr = *(const u32x2*)(xlr + 4 * lane + 256 * j); v[j] = (f32x4){lo16(xr.x), hi16(xr.x), lo16(xr.y), hi16(xr.y)}; }
                  o2[j] = *(const u32x2*)((const bf16_t*)(p.ws + WS_OL) + (size_t)row * 1024 + 4 * lane + 256 * j); }
              if (!p.dup) {
#pragma unroll
                  for (int j = 0; j < 4; ++j) { const f32x4 g2 = *(const f32x4*)(mr + 2 * 1024 + 4 * lane + 256 * j);
                      v[j][0] += g2[0] * lo16(o2[j].x); v[j][1] += g2[1] * hi16(o2[j].x); v[j][2] += g2[2] * lo16(o2[j].y); v[j][3] += g2[3] * hi16(o2[j].y);
                      *(u32x2*)(xlr + 4 * lane + 256 * j) = pack4(v[j]); } } }
            norm_mod_row(v, p.g_ffn + l * 1024, mr + 3 * 1024, mr + 4 * 1024, lane);
            store_row_bf16((bf16_t*)(p.ws + WS_H) + (size_t)row * 1024, v, lane);
            float lg[36];
#pragma unroll
            for (int e = 0; e < 36; ++e) { float s = 0.f;
#pragma unroll
                for (int j = 0; j < 4; ++j) { const f32x4 w = *(const f32x4*)(Wt + e * 1024 + ((4 * lane + 256 * j) ^ ((e & 7) << 2))); s += (v[j][0] * w[0] + v[j][1] * w[1]) + (v[j][2] * w[2] + v[j][3] * w[3]); }
                lg[e] = wave_sum(s); }
            float gl[4]; int gi = 0; float gmax;
#pragma unroll
            for (int g = 0; g < 4; ++g) gl[g] = lg[g] + p.b_rg[l * 4 + g];
            gmax = gl[0];
#pragma unroll
            for (int g = 1; g < 4; ++g) if (gl[g] > gmax) { gmax = gl[g]; gi = g; }
            float den = 0.f;
#pragma unroll
            for (int g = 0; g < 4; ++g) den += __expf(gl[g] - gmax);
            const float pg = 1.f / den;
            float v1 = -3.0e38f, v2 = -3.0e38f; int i1 = 0, i2 = 0;
#pragma unroll
            for (int g = 0; g < 4; ++g) if (g == gi) {
#pragma unroll
                for (int j = 0; j < 8; ++j) { const float x = lg[4 + g * 8 + j] + p.b_re[l * 32 + g * 8 + j];
                    if (x > v1) { v2 = v1; i2 = i1; v1 = x; i1 = j; } else if (x > v2) { v2 = x; i2 = j; } } }
            const float e2 = __expf(v2 - v1), w1 = pg / (1.f + e2), w2 = pg * e2 / (1.f + e2);
            if (lane == 0) { EID[row * 2] = gi * 8 + i1; EID[row * 2 + 1] = gi * 8 + i2; EWT[row * 2] = w1; EWT[row * 2 + 1] = w2;
                atomicAdd(&hist[gi * 8 + i1], 1); atomicAdd(&hist[gi * 8 + i2], 1); }
        }
        __syncthreads();
        if (tid < 32) ((int*)(p.ws + WS_HIST))[vb * 32 + tid] = hist[tid];
        __syncthreads();
    }
    __syncthreads();
    float* scr = lds + wave * (64 * 65);
    { const int lm = l + 1 < 2 ? l + 1 : -1;
      if (nb != 256) convert_list(p, l, lm, 0, 8192, bid * 8 + wave, nb * 8, scr, lane);
      convert_list(p, l, lm, 1, 4096 + (lm >= 0 ? CV_MIX_ITEMS : 0), bid * 8 + wave, nb * 8, scr, lane); }
}

__device__ __forceinline__ void phase_scatter(const Params& p, int l, unsigned char* ldsb, int bid, int nb) {
    int* li = reinterpret_cast<int*>(ldsb);
    int* tot = li; int* pre = li + 32; int* pst = li + 64; int* ea = li + 128; int* pos = li + 384;
    const int tid = tid_fresh(), lane = tid & 63, wave = tid >> 6;
    const int row_lo = l == 0 ? 0 : MC, rpb = l == 0 ? 68 : 64;
    const int* HIST = (const int*)(p.ws + WS_HIST); const int* EID = (const int*)(p.ws + WS_EID);
    int* SLOT = (int*)(p.ws + WS_SLOT);
    for (int vb = bid; vb < 256; vb += nb) {
        __syncthreads();
        { const int e = tid & 31, jg = tid >> 5; int hv[16];
#pragma unroll
          for (int i = 0; i < 16; ++i) hv[i] = HIST[(jg * 16 + i) * 32 + e];
          int t = 0, pr = 0;
#pragma unroll
          for (int i = 0; i < 16; ++i) { t += hv[i]; pr += (jg * 16 + i < vb) ? hv[i] : 0; }
          li[512 + jg * 32 + e] = t; li[1024 + jg * 32 + e] = pr; }
        __syncthreads();
        if (tid < 32) { int t = 0, pr = 0;
#pragma unroll
            for (int g = 0; g < 16; ++g) { t += li[512 + g * 32 + tid]; pr += li[1024 + g * 32 + tid]; }
            tot[tid] = t; pre[tid] = pr; }
        __syncthreads();
        if (tid == 0) { int s = 0; for (int e = 0; e < 32; ++e) { pst[e] = s; s += ((tot[e] + 255) >> 8) << 8; }
            if (vb == 0) { int* BE = (int*)(p.ws + WS_BLKEXP); int nblk = 0;
                for (int e = 0; e < 32; ++e) { const int nbk = (tot[e] + 255) >> 8; for (int j = 0; j < nbk; ++j) BE[nblk++] = e; }
                BE[200] = nblk; } }
        if (tid < rpb * 2) ea[tid] = EID[(row_lo + vb * rpb) * 2 + tid];
        __syncthreads();
        if (tid < rpb * 2) { const int e = ea[tid]; int rk = 0; for (int j = 0; j < tid; ++j) rk += (ea[j] == e) ? 1 : 0;
            const int ps = pst[e] + pre[e] + rk; SLOT[(row_lo + vb * rpb) * 2 + tid] = ps; ((int*)(p.ws + WS_TOK))[ps] = row_lo + vb * rpb + (tid >> 1); }
        if (vb == 0 && tid < 32) { int* TOK = (int*)(p.ws + WS_TOK); const int e0 = pst[tid] + tot[tid], e1 = pst[tid] + (((tot[tid] + 255) >> 8) << 8);
            for (int q = e0; q < e1; ++q) TOK[q] = row_lo; }
    }
    __syncthreads();
}

__device__ __forceinline__ void phase_combine(const Params& p, int l, int bid, int nb) {
    if (p.dup && l == 0) return;
    const int lane = tid_fresh() & 63, wave = tid_fresh() >> 6;
    const float* mod = (const float*)(p.ws + WS_MOD);
    const int* SLOT = (const int*)(p.ws + WS_SLOT); const float* EWT = (const float*)(p.ws + WS_EWT);
    const bf16_t* Y = (const bf16_t*)(p.ws + WS_Y);
    bf16_t* XL = (bf16_t*)(p.ws + WS_XL);
    const int row_lo = l == 0 ? 0 : MC, stride = nb * 8;
    for (int rowA = row_lo + bid * 8 + wave; rowA < MT; rowA += 2 * stride) {
        const int rowB = rowA + stride; const bool hasB = rowB < MT; const int rb = hasB ? rowB : rowA;
        const int sA0 = SLOT[rowA * 2], sA1 = SLOT[rowA * 2 + 1], sB0 = SLOT[rb * 2], sB1 = SLOT[rb * 2 + 1];
        const float wA0 = EWT[rowA * 2], wA1 = EWT[rowA * 2 + 1], wB0 = EWT[rb * 2], wB1 = EWT[rb * 2 + 1];
        u32x2 yA0[4], yA1[4], yB0[4], yB1[4], xA[4], xB[4];
#pragma unroll
        for (int j = 0; j < 4; ++j) { const int c = 4 * lane + 256 * j;
            yA0[j] = *(const u32x2*)(Y + (size_t)sA0 * 1024 + c); yA1[j] = *(const u32x2*)(Y + (size_t)sA1 * 1024 + c); xA[j] = *(const u32x2*)(XL + (size_t)rowA * 1024 + c);
            yB0[j] = *(const u32x2*)(Y + (size_t)sB0 * 1024 + c); yB1[j] = *(const u32x2*)(Y + (size_t)sB1 * 1024 + c); xB[j] = *(const u32x2*)(XL + (size_t)rb * 1024 + c); }
#pragma unroll
        for (int half = 0; half < 2; ++half) {
            if (half == 1 && !hasB) break;
            const int row = half ? rowB : rowA; const float w0 = half ? wB0 : wA0, w1 = half ? wB1 : wA1;
            const float* g5 = mod + (l * 5 + modrow(row)) * 6144 + 5 * 1024;
            f32x4 v[4];
#pragma unroll
            for (int j = 0; j < 4; ++j) { const int c = 4 * lane + 256 * j;
                const u32x2 a = half ? yB0[j] : yA0[j], b2 = half ? yB1[j] : yA1[j];
                f32x4 y; y[0] = w0 * lo16(a.x) + w1 * lo16(b2.x); y[1] = w0 * hi16(a.x) + w1 * hi16(b2.x); y[2] = w0 * lo16(a.y) + w1 * lo16(b2.y); y[3] = w0 * hi16(a.y) + w1 * hi16(b2.y);
                const u32x2 xr = half ? xB[j] : xA[j];
                v[j] = (f32x4){lo16(xr.x), hi16(xr.x), lo16(xr.y), hi16(xr.y)} + *(const f32x4*)(g5 + c) * y; }
            if (l == 0) {
#pragma unroll
                for (int j = 0; j < 4; ++j) *(u32x2*)(XL + (size_t)row * 1024 + 4 * lane + 256 * j) = pack4(v[j]);
                const float* mr = mod + (5 + modrow(row)) * 6144;
                norm_mod_row(v, p.g_mix + 1024, mr, mr + 1024, lane);
                store_row_bf16((bf16_t*)(p.ws + WS_H) + (size_t)row * 1024, v, lane);
            } else {
                norm_mod_row(v, p.g_final, nullptr, nullptr, lane);
                float* o = p.out + (size_t)(row - MC) * 1024;
#pragma unroll
                for (int j = 0; j < 4; ++j) *(f32x4*)(o + 4 * lane + 256 * j) = v[j];
            }
        }
    }
}

#define XB_TMO      128
#define XB_XCNT(j)  (256  + 64 * (j))
#define XB_XSUB(j)  (1280 + 64 * (j))
#define XB_XGEN(j)  (2304 + 64 * (j))
#define XB_TOP      3328
#define XB_TOPGEN   3392
#define XCD_BAR_WORDS 3456
#define XB_SSD_DONE(l) (3520 + 64 * (l))
#define XB_SPIN_CAP (1u << 18)
__device__ __forceinline__ unsigned xb_ld(unsigned* p)              { return __hip_atomic_load(p, __ATOMIC_RELAXED, __HIP_MEMORY_SCOPE_AGENT); }
__device__ __forceinline__ unsigned xb_add(unsigned* p, unsigned v) { return __hip_atomic_fetch_add(p, v, __ATOMIC_RELAXED, __HIP_MEMORY_SCOPE_AGENT); }
__device__ __forceinline__ unsigned xb_xcc_id() { return (unsigned)__builtin_amdgcn_s_getreg((3 << 11) | 20) & 0xFu; }
#define XB_SPIN(cond, bar) do { unsigned _sp = 0; while (cond) { __builtin_amdgcn_s_sleep(1); \
    if ((++_sp & 255u) == 0u) { if (xb_ld(&(bar)[XB_TMO])) break; if (_sp > XB_SPIN_CAP) { atomicAdd(&(bar)[XB_TMO], 1u); break; } } } } while (0)
constexpr int NPH_L = 12, NPHASES = 1 + 2 * NPH_L;
__device__ __forceinline__ void run_phase(const Params& p, int ph, unsigned char* lds) {
    const int bid = blockIdx.x, nb = gridDim.x;
    const int wave = tid_fresh() >> 6;
#ifndef ONLY_S
    if (ph == 0) { phase_pre(p, lds, bid, nb); return; }
#else
    if (ph == 0) { if (ONLY_S == 99) phase_pre(p, lds, bid, nb); return; }
#endif
    const int l = (ph - 1) / NPH_L, s = (ph - 1) % NPH_L;
    unsigned char* ws = p.ws;
    const int pm0 = l == 0 ? 0 : 4, nMrows = l == 0 ? 68 : 64, row_lo = l == 0 ? 0 : MC;
#ifdef ONLY_S
    if (s != ONLY_S) return;
#endif
    switch (s) {
    case 0: if (l == 0) phase_norm1(p, bid, nb); break;
    case 1: { EpiInproj E{ws};
              if (l == 0) { SchedGrid S{(const bf16_t*)(ws + WS_H), (const bf16_t*)(ws + WS_WIN), 1024, 1024, 0, 68, 45, nb, bid}; gemm_run(lds, S, E, 1024, 1024, 1024, 1); }
              else { SchedInproj1 S{(const bf16_t*)(ws + WS_H), (const bf16_t*)(ws + WS_WIN), nb, bid}; gemm_run(lds, S, E, 1024, 1024, 1024, 1); } } break;
    case 2: { { ConvW Wq, Wk; int whd = -1; const int d0 = (tid_fresh() & 31) * 8;
                for (int v = (bid * 1088) / nb; v < ((bid + 1) * 1088) / nb; ++v) { const int hd = v / 272, it = (v % 272) * 4 + hd;
                    if (hd != whd) { conv_load_w(p.mconv_w + (size_t)l * 4 * 2048, p.mconv_b + (size_t)l * 2048, hd * 256 + d0, Wq); conv_load_w(p.mconv_w + (size_t)l * 4 * 2048, p.mconv_b + (size_t)l * 2048, 1024 + hd * 256 + d0, Wk); whd = hd; }
                    conv_m_item(p, l, it, (LAS unsigned char*)lds, Wq, Wk); } }
              { ConvW Wbc, Wx; int wg = -1; const int cs = tid_fresh() & 31;
                for (int v = (bid * 1088) / nb; v < ((bid + 1) * 1088) / nb; ++v) { const int grp = v / 272, it = (v % 272) * 4 + grp;
                    if (grp != wg) { conv_load_w(p.sconv_w + (size_t)l * 4 * 2048, p.sconv_b + (size_t)l * 2048, 1024 + (cs >> 4) * 512 + grp * 128 + (cs & 15) * 8, Wbc); conv_load_w(p.sconv_w + (size_t)l * 4 * 2048, p.sconv_b + (size_t)l * 2048, grp * 256 + cs * 8, Wx); wg = grp; }
                    conv_s_item(p, l, it, (LAS unsigned char*)lds, Wbc, Wx); } }
              if (!p.dup) for (int it = bid; it < (l == 0 ? 272 : 256); it += nb) pool_window_item(p, it, (LAS unsigned char*)lds); } break;
    case 3: {
              int pool_c = bid, pool_g = nb;
              unsigned* sbar = (unsigned*)(ws + WS_BAR) + XB_SSD_DONE(l);
              if (nb == 256) { const int x = bid & 7, y = bid >> 3;
                  if (y < 16) { mlstm_chunk_item(p, l, (((y >> 3) * 8 + x) << 3) | (y & 7), (LAS unsigned char*)lds); pool_c = -1;
}
                  else { ssd_chunk_item(p, l, ((((y - 16) >> 3) * 8 + x) << 3) | ((y - 16) & 7), (LAS unsigned char*)lds); pool_c = (y - 16) * 8 + x; pool_g = 128;
                      asm volatile("s_waitcnt vmcnt(0)" ::: "memory"); __syncthreads();
                      if (tid_fresh() == 0) { __builtin_amdgcn_fence(__ATOMIC_RELEASE, "agent"); asm volatile("s_waitcnt vmcnt(0)" ::: "memory"); (void)xb_add(sbar, 1u); } } }
              else { for (int it = bid; it < 256; it += nb) { if (it < 128) mlstm_chunk_item(p, l, it, (LAS unsigned char*)lds); else ssd_chunk_item(p, l, it - 128, (LAS unsigned char*)lds); } }
              if (pool_c >= 0 && !p.dup) { SchedPool S{(const bf16_t*)(ws + WS_BR), (const bf16_t*)(ws + WS_WPOOL), pm0, nMrows, pool_g, pool_c}; EpiPool E{(bf16_t*)(ws + WS_BR)};
                  gemm_run(lds, S, E, 256, 3072, 256, 1); }
              if (nb == 256 && bid >= 128) {
                  if (tid_fresh() == 0) { XB_SPIN(xb_ld(sbar) < 128u, (unsigned*)(ws + WS_BAR)); __builtin_amdgcn_fence(__ATOMIC_ACQUIRE, "agent"); asm volatile("s_waitcnt vmcnt(0)" ::: "memory"); }
                  __syncthreads();
                  ssd_finish_rows(p, l, row_lo, (bid - 128) * 8 + wave, 128 * 8);
                  convert_list(p, l, -1, 0, 8192, (bid - 128) * 8 + wave, 128 * 8, reinterpret_cast<float*>(lds) + wave * (64 * 65), tid_fresh() & 63);
                  if (PROF_S == 40 && bid == 255) { asm volatile("s_waitcnt vmcnt(0)" ::: "memory"); __syncthreads(); if (tid_fresh() == 0) ((volatile LAS unsigned long long*)((LAS unsigned char*)lds + 163000))[32 + l] = __builtin_amdgcn_s_memrealtime(); } } } break;
    case 4: { mlstm_finish_rows(p, l, row_lo, bid * 8 + wave, nb * 8); if (nb != 256) ssd_finish_rows(p, l, row_lo, bid * 8 + wave, nb * 8); } break;
    case 5: { SchedGrid S{(const bf16_t*)(ws + WS_BR), (const bf16_t*)(ws + WS_WBR), 3072, 3072, pm0, nMrows, 4, nb, bid}; EpiBranch E{(const bf16_t*)(ws + WS_MG), (bf16_t*)(ws + WS_MERGED)};
              gemm_run(lds, S, E, 3072, 3072, 3072, 3); } break;
    case 6: { SchedGrid S{(const bf16_t*)(ws + WS_MERGED), (const bf16_t*)(ws + WS_WOUT), 1024, 1024, pm0, nMrows, 4, nb, bid}; EpiOut E{(bf16_t*)(ws + WS_OL)};
              gemm_run(lds, S, E, 1024, 1024, 1024, 1); } break;
    case 7: phase_route(p, l, lds, bid, nb); break;
    case 8: phase_scatter(p, l, lds, bid, nb); break;
    case 9: { const int* BE = (const int*)(ws + WS_BLKEXP);
              SchedMoe S{(const bf16_t*)(ws + WS_H), (const bf16_t*)(ws + WS_EW1), BE, (const int*)(ws + WS_TOK), 1024, BE[200], nb, bid, (size_t)1048576, (size_t)1024}; EpiMoe1 E{(bf16_t*)(ws + WS_ACT)};
              gemm_run<true>(lds, S, E, 1024, 1024, 1024, 1); } break;
    case 10: { const int* BE = (const int*)(ws + WS_BLKEXP);
              SchedMoe S{(const bf16_t*)(ws + WS_ACT), (const bf16_t*)(ws + WS_EW2), BE, nullptr, 512, BE[200], nb, bid, (size_t)524288, (size_t)512}; EpiMoe2 E{(bf16_t*)(ws + WS_Y)};
              gemm_run(lds, S, E, 512, 512, 512, 1); } break;
    case 11: phase_combine(p, l, bid, nb); break;
    }
}

__device__ __forceinline__ void xcd_barrier_complete(unsigned* bar, unsigned x, unsigned& nloc, unsigned& nx) {
    const unsigned G = gridDim.x * gridDim.y * gridDim.z;
    unsigned sum, cnt, mine, sp = 0u;
    for (;;) {
        sum = 0u; cnt = 0u; mine = 0u;
#pragma unroll
        for (unsigned j = 0; j < 16; ++j) { const unsigned c = xb_ld(&bar[XB_XCNT(j)]); sum += c; cnt += (c > 0u) ? 1u : 0u; mine = (j == x) ? c : mine; }
        if (sum == G) break;
        __builtin_amdgcn_s_sleep(1);
        if ((++sp & 255u) == 0u) { if (xb_ld(&bar[XB_TMO])) break; if (sp > XB_SPIN_CAP) { atomicAdd(&bar[XB_TMO], 1u); break; } }
    }
    nloc = mine > 0u ? mine : 1u; nx = cnt > 0u ? cnt : 1u;
}
__device__ __forceinline__ void xcd_barrier(unsigned* bar, volatile LAS unsigned* st) {
    asm volatile("s_waitcnt vmcnt(0)" ::: "memory");
    __syncthreads();
    if (threadIdx.x == 0) {
        __builtin_amdgcn_s_waitcnt(0);
        const unsigned x = xb_xcc_id();
        unsigned nloc = st[0], nx = st[1];
        if (nloc == 0u) { xcd_barrier_complete(bar, x, nloc, nx); st[0] = nloc; st[1] = nx; }
        const unsigned old = xb_add(&bar[XB_XSUB(x)], 1u);
        const unsigned gen = old / nloc;
        if (old + 1u == (gen + 1u) * nloc) {
            __builtin_amdgcn_fence(__ATOMIC_RELEASE, "agent");
            asm volatile("s_waitcnt vmcnt(0)" ::: "memory");
            const unsigned og = xb_add(&bar[XB_TOP], 1u);
            const unsigned tg = og / nx;
            if (og + 1u == (tg + 1u) * nx) xb_add(&bar[XB_TOPGEN], 1u);
            else XB_SPIN(xb_ld(&bar[XB_TOPGEN]) == tg, bar);
            __builtin_amdgcn_fence(__ATOMIC_ACQUIRE, "agent");
            xb_add(&bar[XB_XGEN(x)], 1u);
            asm volatile("s_waitcnt vmcnt(0)" ::: "memory");
        } else {
            XB_SPIN(xb_ld(&bar[XB_XGEN(x)]) == gen, bar);
            __builtin_amdgcn_fence(__ATOMIC_ACQUIRE, "agent");
            asm volatile("s_waitcnt vmcnt(0)" ::: "memory");
        }
    }
    __syncthreads();
}

constexpr int BAR_LDS_OFF = LDS_BYTES - 16;
__global__ void __launch_bounds__(NTHR, 2) fwd_kernel(Params pk) {
    extern __shared__ __attribute__((aligned(16))) unsigned char lds[];
    const Params& p = pk;
    const int lo = pk.ph_lo, hi = pk.ph_hi;
    unsigned* bar = (unsigned*)(pk.ws + WS_BAR);
    volatile LAS unsigned* bst = (volatile LAS unsigned*)((LAS unsigned char*)lds + BAR_LDS_OFF);
    if (hi - lo > 1) {
        if (threadIdx.x == 0) { bst[0] = 0u; bst[1] = 0u; (void)xb_add(&bar[XB_XCNT(xb_xcc_id())], 1u); }
        __syncthreads();
    }
#define STEP(k) if (lo <= (k) && (k) < hi) { \
    if (PROF_S >= 0 && blockIdx.x == PROF_BLK && threadIdx.x == 0) ((volatile LAS unsigned long long*)((LAS unsigned char*)lds + 163000))[k] = __builtin_amdgcn_s_memrealtime(); \
    run_phase(p, (k), lds); if ((k) + 1 < hi) { if (pk.dup < 0) cg::this_grid().sync(); else xcd_barrier(bar, bst); } }
    STEP(0) STEP(1) STEP(2) STEP(3) STEP(4) STEP(5) STEP(6) STEP(7) STEP(8) STEP(9) STEP(10) STEP(11) STEP(12)
    STEP(14) STEP(15) STEP(16) STEP(17) STEP(18) STEP(19) STEP(20) STEP(21) STEP(22) STEP(23) STEP(24)
#undef STEP
    if (PROF_S >= 0 && hi - lo > 1) {
        __syncthreads();
        if (blockIdx.x == PROF_BLK && threadIdx.x == 0) {
            volatile LAS unsigned long long* ts = (volatile LAS unsigned long long*)((LAS unsigned char*)lds + 163000);
            const unsigned long long tend = __builtin_amdgcn_s_memrealtime();
            float acc = 0.f;
            if (PROF_S == 40) { for (int l = 0; l < 2; ++l) acc += (float)(ts[1 + NPH_L * l + 4] - ts[32 + l]) * 0.001f; }
            for (int k = 0; k < NPHASES; ++k) { if (k == 1 + NPH_L) continue; const int s = k == 0 ? 14 : (k - 1) % NPH_L; if (s != PROF_S) continue;
                int kn = k + 1; if (kn == 1 + NPH_L) kn++; const unsigned long long t1 = kn < NPHASES ? ts[kn] : tend; acc += (float)(t1 - ts[k]) * 0.001f; }
            __threadfence(); atomicAdd(pk.out, acc);
        }
    }
}

extern "C" void kernel_launch(void* const* d_in, const int* in_sizes, int n_in, void* d_out, int out_size, void* d_ws, size_t ws_size, hipStream_t stream) {
    static int grid_blocks = 0;
    if (!grid_blocks) {
        if (n_in != 31 || ws_size < WS_END) { fprintf(stderr, "kernel_launch: unexpected n_in %d / ws_size %zu (need %zu)\n", n_in, ws_size, (size_t)WS_END); grid_blocks = -1; return; }
        int dev = 0, cus = 0, per_cu = 0;
        hipGetDevice(&dev);
        hipDeviceGetAttribute(&cus, hipDeviceAttributeMultiprocessorCount, dev);
        if (hipFuncSetAttribute((const void*)fwd_kernel, hipFuncAttributeMaxDynamicSharedMemorySize, LDS_BYTES) != hipSuccess) fprintf(stderr, "kernel_launch: hipFuncSetAttribute failed\n");
        hipOccupancyMaxActiveBlocksPerMultiprocessor(&per_cu, (const void*)fwd_kernel, NTHR, LDS_BYTES);
        if (per_cu < 1) { fprintf(stderr, "kernel_launch: occupancy query says %d blocks per CU\n", per_cu); per_cu = 1; }
        grid_blocks = cus * per_cu;
        (void)hipGetLastError();
    }
    if (grid_blocks < 0) return;
    Params p{};
    const float** dst = (const float**)&p;
    for (int i = 0; i < 31; ++i) dst[i] = (const float*)d_in[i];
    p.out = (float*)d_out; p.ws = (unsigned char*)d_ws;
#if SINGLE_LAUNCH
    if (hipMemsetAsync((char*)d_ws + WS_BAR, 0, 16384, stream) != hipSuccess) fprintf(stderr, "kernel_launch: hipMemsetAsync failed\n");
    p.ph_lo = 0; p.ph_hi = NPHASES;
    void* args[] = {&p};
    hipError_t e = hipLaunchCooperativeKernel((const void*)fwd_kernel, dim3(grid_blocks), dim3(NTHR), args, LDS_BYTES, stream);
    if (e != hipSuccess) fprintf(stderr, "cooperative launch failed: %s (grid %d)\n", hipGetErrorString(e), grid_blocks);
#else
    for (int ph = 0; ph < NPHASES; ++ph) {
        if (ph == 1 + NPH_L) continue;
        p.ph_lo = ph; p.ph_hi = ph + 1;
        hipLaunchKernelGGL(fwd_kernel, dim3(grid_blocks), dim3(NTHR), LDS_BYTES, stream, p);
        const int sidx = ph == 0 ? 14 : (ph - 1) % NPH_L;
        if ((PROBE_DUP_MASK >> sidx) & 1) { p.dup = 1; for (int r = 0; r < PROBE_DUP_N; ++r) hipLaunchKernelGGL(fwd_kernel, dim3(grid_blocks), dim3(NTHR), LDS_BYTES, stream, p); p.dup = 0; }
    }
#endif
}
```

```cpp
#include <hip/hip_runtime.h>
#include <hip/hip_cooperative_groups.h>
#include <cstdio>
namespace cg = cooperative_groups;

#ifndef SINGLE_LAUNCH
#define SINGLE_LAUNCH 1
#endif
#ifndef PROBE_DUP_MASK
#define PROBE_DUP_MASK 0
#endif
#ifndef PROBE_DUP_N
#define PROBE_DUP_N 1
#endif
#ifndef USE_MLSTM_CHUNK
#define USE_MLSTM_CHUNK 1
#endif
#ifndef USE_SSD_CHUNK
#define USE_SSD_CHUNK 1
#endif
#ifndef CV_IN_SCAN
#define CV_IN_SCAN 0
#endif
#ifndef PROF_S
#define PROF_S (-1)
#endif
#ifndef CONVDUP
#define CONVDUP 0
#endif
#ifndef INPROJ_WGM
#define INPROJ_WGM 4
#endif
#define PROF_BLK (PROF_S == 40 ? 255 : 0)
#ifndef USE_MFMA_GEMM
#define USE_MFMA_GEMM 1
#endif

typedef unsigned short bf16_t;
typedef float f32x4 __attribute__((ext_vector_type(4)));
typedef unsigned u32x4 __attribute__((ext_vector_type(4)));
typedef unsigned u32x2 __attribute__((ext_vector_type(2)));

constexpr int NTHR = 512;
constexpr int D = 1024, NB = 4, SEQ = 4096, CTXL = 256;
constexpr int MC = NB * CTXL;
constexpr int ML = NB * SEQ;
constexpr int MT = MC + ML;
constexpr int DIN = 11312, NPAD = 11520;
constexpr int NE = 32, DE = 512;
constexpr int CAP = 43008;
constexpr float EPS = 1e-6f;
constexpr int LDS_BYTES = 163840;

constexpr size_t MiB = 1u << 20;
constexpr size_t WS_HIST = 0;
constexpr size_t WS_BLKEXP = 64 * 1024;
constexpr size_t WS_BAR = 128 * 1024;
constexpr size_t WS_TOK = 256 * 1024;
constexpr size_t WS_MOD = 1 * MiB;
constexpr size_t WS_GA = 2 * MiB;
constexpr size_t WS_DT = 4 * MiB;
constexpr size_t WS_EID = 7 * MiB;
constexpr size_t WS_EWT = 7 * MiB + 256 * 1024;
constexpr size_t WS_SLOT = 7 * MiB + 512 * 1024;
constexpr size_t WS_WIN = 8 * MiB;
constexpr size_t WS_WPOOL = 31 * MiB;
constexpr size_t WS_WBR = 32 * MiB;
constexpr size_t WS_WOUT = 38 * MiB;
constexpr size_t WS_W1OFS = 66 * MiB;
constexpr size_t WS_XL = 40 * MiB;
constexpr size_t WS_H = 108 * MiB;
constexpr size_t WS_BR = 142 * MiB;
constexpr size_t WS_Q = 244 * MiB, WS_K = 278 * MiB, WS_V = 312 * MiB;
constexpr size_t WS_SX = 346 * MiB, WS_SB = 380 * MiB, WS_SC = 397 * MiB;
constexpr size_t WS_MG = 414 * MiB;
constexpr size_t WS_HF = 516 * MiB, WS_HB = 550 * MiB;
constexpr size_t WS_VT = 584 * MiB;
constexpr size_t WS_END = 618 * MiB;
constexpr size_t WS_MGA = WS_WIN, WS_MGC = WS_WIN + 576 * 1024, WS_MGP = WS_WIN + 1152 * 1024;
constexpr size_t WS_SACS = WS_WIN + 2 * MiB, WS_SDT = WS_WIN + 5 * MiB;
constexpr size_t WS_QC = WS_H, WS_KC = WS_HF, WS_KCT = WS_HB;
constexpr size_t WS_HF2 = WS_Q, WS_HB2 = WS_K;
constexpr size_t WS_XCT = WS_HB;
constexpr size_t WS_BC = WS_VT, WS_CC = WS_VT + 17 * MiB;
constexpr size_t WS_OL = WS_HF;
constexpr size_t WS_YF = WS_SX, WS_YB = WS_SB;
constexpr size_t WS_MERGED = WS_H;
constexpr size_t WS_EW1 = 550 * MiB;
constexpr size_t WS_EW2A = 614 * MiB, WS_EW2B = 386 * MiB;
constexpr long EW2_SPLIT_OFF = ((long)WS_EW2B - 4 * (long)MiB - (long)WS_EW2A) / 2;
constexpr size_t WS_XB = WS_BR;
constexpr size_t WS_ACT = WS_SX;
constexpr size_t WS_Y = WS_MG;

struct Params {
    const float *x, *c, *ctx, *c_ctx, *w_ada, *b_ada, *g_mix, *g_ffn, *w_in, *pool_w, *pool_scale,
        *mconv_w, *mconv_b, *mgate_b, *mnorm_g, *sconv_w, *sconv_b, *sdt_bias, *sa_log, *sd, *snorm_g,
        *w_branch, *w_out, *w_rg, *b_rg, *w_re, *b_re, *w_eg, *w_eu, *w_ed, *g_final;
    float* out; unsigned char* ws; int ph_lo, ph_hi, dup, pad;
};

__device__ __forceinline__ int tid_fresh() { int t = threadIdx.x; asm volatile("" : "+v"(t)); return t; }
__device__ __forceinline__ float bf2f(unsigned b) { return __uint_as_float(b << 16); }
__device__ __forceinline__ unsigned f2bf(float f) { unsigned u = __float_as_uint(f); return (u + 0x7fffu + ((u >> 16) & 1u)) >> 16; }
typedef __bf16 bf16x2_t __attribute__((ext_vector_type(2)));
typedef float f32x2_t __attribute__((ext_vector_type(2)));
__device__ __forceinline__ unsigned pk2(float lo, float hi) { const f32x2_t v = {lo, hi}; return __builtin_bit_cast(unsigned, __builtin_convertvector(v, bf16x2_t)); }
__device__ __forceinline__ float lo16(unsigned w) { return __uint_as_float(w << 16); }
__device__ __forceinline__ float hi16(unsigned w) { return __uint_as_float(w & 0xffff0000u); }
__device__ __forceinline__ float wave_sum(float v) {
#pragma unroll
    for (int o = 1; o < 64; o <<= 1) v += __shfl_xor(v, o);
    return v;
}
__device__ __forceinline__ float sigmoid_f(float x) { return __builtin_amdgcn_rcpf(1.f + __expf(-x)); }
__device__ __forceinline__ float silu_f(float x) { return x * __builtin_amdgcn_rcpf(1.f + __expf(-x)); }
__device__ __forceinline__ float softplus_f(float x) { return fmaxf(x, 0.f) + log1pf(__expf(-fabsf(x))); }
__device__ __forceinline__ float logsigmoid_f(float x) { return fminf(x, 0.f) - log1pf(__expf(-fabsf(x))); }
__device__ __forceinline__ void unpack8(u32x4 w, float* f) {
    f[0] = lo16(w.x); f[1] = hi16(w.x); f[2] = lo16(w.y); f[3] = hi16(w.y);
    f[4] = lo16(w.z); f[5] = hi16(w.z); f[6] = lo16(w.w); f[7] = hi16(w.w);
}
__device__ __forceinline__ u32x4 pack8(f32x4 a, f32x4 b) {
    u32x4 w; w.x = pk2(a[0], a[1]); w.y = pk2(a[2], a[3]); w.z = pk2(b[0], b[1]); w.w = pk2(b[2], b[3]); return w;
}
__device__ __forceinline__ int scanrow(int row) {
    if (row < MC) return row;
    const int r = row - MC, b = r >> 12, t = r & 4095;
    return MC + (b << 12) + ((t & 63) << 6) + (t >> 6);
}
__device__ __forceinline__ int modrow(int row) { return row < MC ? 4 : ((row - MC) >> 12); }

struct Unit { const bf16_t* A; const bf16_t* B; const int* tok; int pm, pn; };

template <int WGM = 8>
__device__ __forceinline__ void tile_order(int L, int nM, int nN, int& pm, int& pn) {
    const int nwg = nM * nN; int wgid = L;
    { const int q = nwg / 8, r = nwg % 8, xcd = wgid % 8, off = wgid / 8; wgid = (xcd < r ? xcd * (q + 1) : r * (q + 1) + (xcd - r) * q) + off; }
    const int nig = WGM * nN, gid = wgid / nig, fm = gid * WGM, gsz = (nM - fm) < WGM ? (nM - fm) : WGM;
    pm = fm + ((wgid % nig) % gsz); pn = (wgid % nig) / gsz;
}
struct SchedGrid {
    const bf16_t* A; const bf16_t* B; int lda, ldb, pm0, nM, nN, G, c;
    __device__ __forceinline__ bool next(int i, Unit& u) const {
        const long L = (long)i * G + c; if (L >= (long)nM * nN) return false;
        int pm, pn; if (nN == 45) tile_order<INPROJ_WGM>((int)L, nM, nN, pm, pn); else tile_order<8>((int)L, nM, nN, pm, pn); pm += pm0;
        u.pm = pm; u.pn = pn; u.tok = nullptr; u.A = A + (size_t)pm * 256 * lda; u.B = B + (size_t)pn * 256 * ldb; return true;
    }
};
struct SchedInproj1 {
    const bf16_t* A; const bf16_t* B; int G, c;
    __device__ __forceinline__ bool next(int i, Unit& u) const {
        const long L = (long)i * G + c; if (L >= 2880 + 84) return false;
        int pm, pn;
        if (L < 2880) { tile_order<INPROJ_WGM>((int)L, 64, 45, pm, pn); pm += 4; }
        else { const int idx = (int)L - 2880, k = idx % 21; pm = idx / 21; pn = k < 12 ? 4 + k : (k < 16 ? 20 + (k - 12) : (k < 20 ? 28 + (k - 16) : 44)); }
        u.pm = pm; u.pn = pn; u.tok = nullptr; u.A = A + (size_t)pm * 256 * 1024; u.B = B + (size_t)pn * 256 * 1024; return true;
    }
};
struct SchedPool {
    const bf16_t* A; const bf16_t* B; int pm0, nM, G, c;
    __device__ __forceinline__ bool next(int i, Unit& u) const {
        const long L = (long)i * G + c; if (L >= (long)nM * 4) return false;
        const int pm = pm0 + (int)(L >> 2), g = (int)(L & 3);
        u.pm = pm; u.pn = g; u.tok = nullptr; u.A = A + (size_t)pm * 256 * 3072 + g * 256; u.B = B + (size_t)g * 65536; return true;
    }
};
struct SchedMoe {
    const bf16_t* A; const bf16_t* B; const int* blkexp; const int* tok; int lda, nblk, G, c; size_t bexp_stride, ldb; long split_off;
    __device__ __forceinline__ bool next(int i, Unit& u) const {
        const long L = (long)i * G + c; if (L >= (long)nblk * 4) return false;
        const int blk = (int)(L >> 2), nt = (int)(L & 3); const int e = blkexp[blk];
        u.pm = blk; u.pn = nt; u.tok = tok ? tok + blk * 256 : nullptr; u.A = tok ? A : A + (size_t)blk * 256 * lda;
        u.B = B + (size_t)e * bexp_stride + (e >= 4 ? split_off : 0) + (size_t)nt * 256 * ldb; return true;
    }
};

struct EpiInproj {
    unsigned char* ws;
    __device__ __forceinline__ void seg(const Unit& u, int, int r, int c0, f32x4& lo0, f32x4& lo1, f32x4& hi0, f32x4& hi1) const {
        const int row = u.pm * 256 + r, t = u.pn;
        bf16_t* dst; size_t ld; int cb;
        if (t < 4) { dst = (bf16_t*)(ws + WS_BR) + (size_t)row * 3072; cb = t * 256; }
        else if (t < 16) { const int w = (t - 4) >> 2; dst = (bf16_t*)(ws + WS_Q + (size_t)w * 34 * MiB) + (size_t)scanrow(row) * 1024; cb = ((t - 4) & 3) * 256; }
        else if (t < 20) { dst = (bf16_t*)(ws + WS_BR) + (size_t)row * 3072 + 1024; cb = (t - 16) * 256; }
        else if (t < 24) { dst = (bf16_t*)(ws + WS_SX) + (size_t)row * 1024; cb = (t - 20) * 256; }
        else if (t < 28) { dst = (bf16_t*)(ws + WS_BR) + (size_t)row * 3072 + 2048; cb = (t - 24) * 256; }
        else if (t < 30) { dst = (bf16_t*)(ws + WS_SB) + (size_t)row * 512; cb = (t - 28) * 256; }
        else if (t < 32) { dst = (bf16_t*)(ws + WS_SC) + (size_t)row * 512; cb = (t - 30) * 256; }
        else if (t < 44) {
            dst = (bf16_t*)(ws + WS_MG) + (size_t)row * 3072; cb = (t - 32) * 256;
#pragma unroll
            for (int j = 0; j < 4; ++j) { lo0[j] = sigmoid_f(lo0[j]); lo1[j] = sigmoid_f(lo1[j]); hi0[j] = sigmoid_f(hi0[j]); hi1[j] = sigmoid_f(hi1[j]); }
        } else {
            if (c0 < 32) { float* d = (float*)(ws + WS_DT) + (size_t)row * 32 + c0; *(f32x4*)d = lo0; *(f32x4*)(d + 4) = lo1; }
            else if (c0 < 48) { float* d = (float*)(ws + WS_GA) + (size_t)scanrow(row) * 16 + (c0 - 32); *(f32x4*)d = lo0; *(f32x4*)(d + 4) = lo1; }
            return;
        }
        *(u32x4*)(dst + cb + c0) = pack8(lo0, lo1);
        *(u32x4*)(dst + cb + 128 + c0) = pack8(hi0, hi1);
    }
};
struct EpiPool {
    bf16_t* BR;
    __device__ __forceinline__ void seg(const Unit& u, int, int r, int c0, f32x4& lo0, f32x4& lo1, f32x4& hi0, f32x4& hi1) const {
        bf16_t* d = BR + (size_t)(u.pm * 256 + r) * 3072 + u.pn * 256 + c0;
        *(u32x4*)d = pack8(lo0, lo1);
        *(u32x4*)(d + 128) = pack8(hi0, hi1);
    }
};
struct EpiBranch {
    const bf16_t* MG; bf16_t* OUT;
    static constexpr bool PRELOAD = true;
    __device__ __forceinline__ void load(const Unit& u, int sg, int r, int c0, u32x4 (&b)[4]) const {
        const bf16_t* g = MG + (size_t)(u.pm * 256 + r) * 3072 + sg * 1024 + u.pn * 256 + c0;
        const int nx = sg < 2 ? 1024 : 0;
        b[0] = *(const u32x4*)g; b[1] = *(const u32x4*)(g + 128); b[2] = *(const u32x4*)(g + nx); b[3] = *(const u32x4*)(g + nx + 128);
    }
    __device__ __forceinline__ void apply(const Unit& u, int sg, int r, int c0, const u32x4 (&bb)[4], f32x4& lo0, f32x4& lo1, f32x4& hi0, f32x4& hi1) const {
        float a[8], b[8], a2[8], b2[8]; unpack8(bb[0], a); unpack8(bb[1], b); unpack8(bb[2], a2); unpack8(bb[3], b2);
        if (sg < 2) {
#pragma unroll
            for (int j = 0; j < 8; ++j) { a[j] = a[j] * __builtin_amdgcn_rcpf(a2[j]); b[j] = b[j] * __builtin_amdgcn_rcpf(b2[j]); } }
#pragma unroll
        for (int j = 0; j < 4; ++j) { lo0[j] *= a[j]; lo1[j] *= a[4 + j]; hi0[j] *= b[j]; hi1[j] *= b[4 + j]; }
        if (sg == 2) { bf16_t* d = OUT + (size_t)(u.pm * 256 + r) * 1024 + u.pn * 256 + c0; *(u32x4*)d = pack8(lo0, lo1); *(u32x4*)(d + 128) = pack8(hi0, hi1); }
    }
    __device__ __forceinline__ void seg(const Unit&, int, int, int, f32x4&, f32x4&, f32x4&, f32x4&) const {}
};
struct EpiOut {
    bf16_t* OL;
    __device__ __forceinline__ void seg(const Unit& u, int, int r, int c0, f32x4& lo0, f32x4& lo1, f32x4& hi0, f32x4& hi1) const {
        bf16_t* d = OL + (size_t)(u.pm * 256 + r) * 1024 + u.pn * 256 + c0;
        *(u32x4*)d = pack8(lo0, lo1); *(u32x4*)(d + 128) = pack8(hi0, hi1);
    }
};
struct EpiMoe1 {
    bf16_t* ACT;
    __device__ __forceinline__ void seg(const Unit& u, int, int r, int c0, f32x4& lo0, f32x4& lo1, f32x4& hi0, f32x4& hi1) const {
        const int row = u.pm * 256 + r;
        f32x4 a, b;
#pragma unroll
        for (int j = 0; j < 4; ++j) { a[j] = silu_f(lo0[j]) * hi0[j]; b[j] = silu_f(lo1[j]) * hi1[j]; }
        *(u32x4*)(ACT + (size_t)row * 512 + u.pn * 128 + c0) = pack8(a, b);
    }
};
struct EpiMoe2 {
    bf16_t* Y;
    __device__ __forceinline__ void seg(const Unit& u, int, int r, int c0, f32x4& lo0, f32x4& lo1, f32x4& hi0, f32x4& hi1) const {
        bf16_t* d = Y + (size_t)(u.pm * 256 + r) * 1024 + u.pn * 256 + c0;
        *(u32x4*)d = pack8(lo0, lo1); *(u32x4*)(d + 128) = pack8(hi0, hi1);
    }
};

template <class E, class = void> struct epi_preload { static constexpr bool value = false; };
template <class E> struct epi_preload<E, decltype((void)E::PRELOAD)> { static constexpr bool value = E::PRELOAD; };

#define LAS __attribute__((address_space(3)))
typedef short bf16x8 __attribute__((ext_vector_type(8)));
constexpr int HTB = 128 * 64 * 2;
__device__ __forceinline__ int lds_byte(int r, int c) { const int st = (r >> 4) * 2 + (c >> 5), rr = r & 15, cc = c & 31, ob = rr * 64 + cc * 2; return st * 1024 + (ob ^ (((ob >> 9) & 1) << 5)); }
__device__ __forceinline__ void stage_rc(int b, int& R, int& C) { const int st = b / 1024, sb = b % 1024, swz = sb ^ (((sb >> 9) & 1) << 5); R = (st >> 1) * 16 + swz / 64; C = (st & 1) * 32 + (swz % 64) / 2; }
__device__ __forceinline__ int perm32(int rho) { const int n = rho >> 4, i = rho & 15; return 8 * (i >> 2) + 4 * n + (i & 3); }

template <bool GATHER, class Sched, class Epi>
__device__ __forceinline__ void gemm_mfma(LAS unsigned char* lds, const Sched& S, const Epi& E, const int K, const int lda, const int ldb, const int nseg) {
    const int tid = tid_fresh(), wid = __builtin_amdgcn_readfirstlane(tid >> 6), lane = tid & 63, wr = wid >> 2, wc = wid & 3, fr = lane & 15, fq = lane >> 4;
    const int nt = K / 64, tseg = nt / nseg;
    unsigned vA0[2], vA1[2], nA0[2], nA1[2], voffB[2]; int rowA[2], colA[2];
#pragma unroll
    for (int i = 0; i < 2; ++i) { int R, C; stage_rc(tid * 16 + i * 8192, R, C); const int Rb = (R & ~31) + perm32(R & 31);
        rowA[i] = R; colA[i] = C;
        vA0[i] = (unsigned)(R * lda + C) * 2u; vA1[i] = vA0[i] + (unsigned)(128 * lda * 2); nA0[i] = vA0[i]; nA1[i] = vA1[i];
        voffB[i] = (unsigned)(Rb * ldb + C) * 2u; }
    const size_t kstep = 128;
    const size_t hstepB = (size_t)128 * ldb * 2;
    const unsigned ldsw = (unsigned)wid * 1024u;
    const int aoff = lds_byte(wr * 64 + fr, fq * 8), boff = lds_byte(wc * 32 + fr, fq * 8);
#define PG8_SA(b, h) (((b) * 2 + (h)) * HTB)
#define PG8_SB(b, h) ((4 + (b) * 2 + (h)) * HTB)
#define PG8_STAGE(bufoff, gbase, voff) do { _Pragma("unroll") for (int _i = 0; _i < 2; ++_i) \
        __builtin_amdgcn_global_load_lds((const unsigned*)((const char*)(gbase) + (voff)[_i]), (LAS unsigned*)(lds + (bufoff) + ldsw + _i * 8192), 16, 0, 0); } while (0)
#define PG8_LDA(dst, b, h) do { _Pragma("unroll") for (int m = 0; m < 4; ++m) _Pragma("unroll") for (int k = 0; k < 2; ++k) dst[m][k] = *(const LAS bf16x8*)(lds + PG8_SA(b, h) + aoff + m * 2048 + k * 1024); } while (0)
#define PG8_LDB(dst, b, h) do { _Pragma("unroll") for (int n = 0; n < 2; ++n) _Pragma("unroll") for (int k = 0; k < 2; ++k) dst[n][k] = *(const LAS bf16x8*)(lds + PG8_SB(b, h) + boff + n * 2048 + k * 1024); } while (0)
#define PG8_MMA(ai, bj, At, Bt) do { __builtin_amdgcn_s_setprio(1); _Pragma("unroll") for (int m = 0; m < 4; ++m) _Pragma("unroll") for (int n = 0; n < 2; ++n) _Pragma("unroll") for (int k = 0; k < 2; ++k) \
        acc[ai][bj][m][n] = __builtin_amdgcn_mfma_f32_16x16x32_bf16(Bt[n][k], At[m][k], acc[ai][bj][m][n], 0, 0, 0); __builtin_amdgcn_s_setprio(0); } while (0)
#define PG8_WAIT_V(n) asm volatile("s_waitcnt vmcnt(" #n ")" ::: "memory")
#define PG8_WAIT_L(n) asm volatile("s_waitcnt lgkmcnt(" #n ")" ::: "memory")
#define PG8_BAR __builtin_amdgcn_s_barrier()
#define PG8_SCHED __builtin_amdgcn_sched_barrier(0)
#define PG8_EPI(sg) do { \
    if constexpr (epi_preload<Epi>::value) { \
        _Pragma("unroll") for (int ai = 0; ai < 2; ++ai) _Pragma("unroll") for (int mh = 0; mh < 2; ++mh) { u32x4 gbuf[2][4]; int rr_[2]; \
            _Pragma("unroll") for (int m = 0; m < 2; ++m) { int r_ = ai * 128 + wr * 64 + (2 * mh + m) * 16 + fr; asm volatile("" : "+v"(r_)); rr_[m] = r_; E.load(cur, (sg), r_, wc * 32 + fq * 8, gbuf[m]); } \
            __builtin_amdgcn_sched_barrier(0); \
            _Pragma("unroll") for (int m = 0; m < 2; ++m) E.apply(cur, (sg), rr_[m], wc * 32 + fq * 8, gbuf[m], acc[ai][0][2 * mh + m][0], acc[ai][0][2 * mh + m][1], acc[ai][1][2 * mh + m][0], acc[ai][1][2 * mh + m][1]); \
            __builtin_amdgcn_sched_barrier(0); } \
    } else { \
        _Pragma("unroll") for (int ai = 0; ai < 2; ++ai) _Pragma("unroll") for (int m = 0; m < 4; ++m) { \
            int r_ = ai * 128 + wr * 64 + m * 16 + fr; asm volatile("" : "+v"(r_));     \
            E.seg(cur, (sg), r_, wc * 32 + fq * 8, acc[ai][0][m][0], acc[ai][0][m][1], acc[ai][1][m][0], acc[ai][1][m][1]); } } } while (0)
    Unit cur, nxt; int ui = 0;
    if (!S.next(0, cur)) return;
    f32x4 acc[2][2][4][2];
#pragma unroll
    for (int a = 0; a < 2; ++a)
#pragma unroll
        for (int b = 0; b < 2; ++b)
#pragma unroll
            for (int m = 0; m < 4; ++m)
#pragma unroll
                for (int n = 0; n < 2; ++n) acc[a][b][m][n] = (f32x4){0.f, 0.f, 0.f, 0.f};
    bf16x8 At[4][2], B0[2][2], B1[2][2];
    const char* cA = (const char*)cur.A; const char* cB = (const char*)cur.B;
    if (GATHER) {
#pragma unroll
        for (int i = 0; i < 2; ++i) { vA0[i] = (unsigned)(cur.tok[rowA[i]] * lda + colA[i]) * 2u; vA1[i] = (unsigned)(cur.tok[128 + rowA[i]] * lda + colA[i]) * 2u; nA0[i] = vA0[i]; nA1[i] = vA1[i]; }
    }
    PG8_STAGE(PG8_SB(0, 0), cB, voffB); PG8_STAGE(PG8_SA(0, 0), cA, vA0); PG8_STAGE(PG8_SB(0, 1), cB + hstepB, voffB); PG8_STAGE(PG8_SA(0, 1), cA, vA1);
    if (wr == 1) PG8_BAR;
    PG8_WAIT_V(4); PG8_BAR;
    PG8_STAGE(PG8_SB(1, 0), cB + kstep, voffB); PG8_STAGE(PG8_SA(1, 0), cA + kstep, vA0); PG8_STAGE(PG8_SB(1, 1), cB + hstepB + kstep, voffB);
    PG8_WAIT_V(6); PG8_BAR;
    for (;;) {
        const bool has_next = S.next(ui + 1, nxt);
        const char* nA = has_next ? (const char*)nxt.A : cA; const char* nB = has_next ? (const char*)nxt.B : cB;
        if (GATHER) {
            const int* tk = has_next ? nxt.tok : cur.tok;
#pragma unroll
            for (int i = 0; i < 2; ++i) { nA0[i] = (unsigned)(tk[rowA[i]] * lda + colA[i]) * 2u; nA1[i] = (unsigned)(tk[128 + rowA[i]] * lda + colA[i]) * 2u; }
        }
#pragma nounroll
        for (int sg = 0; sg < nseg; ++sg) {
#pragma nounroll
        for (int tt = 0; tt < tseg; tt += 2) {
            const int t = sg * tseg + tt;
            const bool last = (t == nt - 2);
            const char* a1 = cA + (size_t)(t + 1) * kstep;
            const char* a2 = last ? nA : cA + (size_t)(t + 2) * kstep; const char* b2 = last ? nB : cB + (size_t)(t + 2) * kstep;
            const char* a3 = a2 + kstep; const char* b3 = b2 + kstep;
            unsigned w0[2], w1[2];
#pragma unroll
            for (int i = 0; i < 2; ++i) { w0[i] = last ? nA0[i] : vA0[i]; w1[i] = last ? nA1[i] : vA1[i]; }
            PG8_LDB(B0, 0, 0); PG8_SCHED; PG8_LDA(At, 0, 0); PG8_STAGE(PG8_SA(1, 1), a1, vA1);
            PG8_WAIT_L(8); PG8_BAR; PG8_WAIT_L(0); PG8_MMA(0, 0, At, B0); PG8_BAR; PG8_SCHED;
            PG8_LDB(B1, 0, 1); PG8_STAGE(PG8_SB(0, 0), b2, voffB);
            PG8_BAR; PG8_WAIT_L(0); PG8_MMA(0, 1, At, B1); PG8_BAR;
            PG8_LDA(At, 0, 1); PG8_STAGE(PG8_SA(0, 0), a2, w0);
            PG8_BAR; PG8_WAIT_L(0); PG8_MMA(1, 0, At, B0); PG8_BAR; PG8_SCHED;
            PG8_STAGE(PG8_SB(0, 1), b2 + hstepB, voffB);
            PG8_WAIT_V(6); PG8_BAR; PG8_MMA(1, 1, At, B1); PG8_BAR;
            PG8_LDB(B0, 1, 0); PG8_SCHED; PG8_LDA(At, 1, 0); PG8_STAGE(PG8_SA(0, 1), a2, w1);
            PG8_WAIT_L(8); PG8_BAR; PG8_WAIT_L(0); PG8_MMA(0, 0, At, B0); PG8_BAR; PG8_SCHED;
            PG8_LDB(B1, 1, 1); PG8_STAGE(PG8_SB(1, 0), b3, voffB);
            PG8_BAR; PG8_WAIT_L(0); PG8_MMA(0, 1, At, B1); PG8_BAR;
            PG8_LDA(At, 1, 1); PG8_STAGE(PG8_SA(1, 0), a3, w0);
            PG8_BAR; PG8_WAIT_L(0); PG8_MMA(1, 0, At, B0); PG8_BAR; PG8_SCHED;
            PG8_STAGE(PG8_SB(1, 1), b3 + hstepB, voffB);
            PG8_WAIT_V(6); PG8_BAR; PG8_MMA(1, 1, At, B1); PG8_BAR;
        }
        PG8_EPI(sg);
        }
        if (!has_next) break;
#pragma unroll
        for (int a = 0; a < 2; ++a)
#pragma unroll
            for (int b = 0; b < 2; ++b)
#pragma unroll
                for (int m = 0; m < 4; ++m)
#pragma unroll
                    for (int n = 0; n < 2; ++n) acc[a][b][m][n] = (f32x4){0.f, 0.f, 0.f, 0.f};
        cur = nxt; cA = nA; cB = nB; ++ui;
#pragma unroll
        for (int i = 0; i < 2; ++i) { vA0[i] = nA0[i]; vA1[i] = nA1[i]; }
    }
    PG8_WAIT_V(0);
    if (wr == 0) PG8_BAR;
    PG8_BAR;
#undef PG8_SA
#undef PG8_SB
#undef PG8_STAGE
#undef PG8_LDA
#undef PG8_LDB
#undef PG8_MMA
#undef PG8_WAIT_V
#undef PG8_WAIT_L
#undef PG8_BAR
#undef PG8_SCHED
#undef PG8_EPI
}

template <bool GATHER = false, class Sched, class Epi>
__device__ __forceinline__ void gemm_run(unsigned char* lds, const Sched& S, const Epi& E, int K, int lda, int ldb, int nseg) {
    __syncthreads();
    gemm_mfma<GATHER>((LAS unsigned char*)lds, S, E, K, lda, ldb, nseg);
    __syncthreads();
}

struct TrDesc { const float* src; const float* cscale; bf16_t* dst; int ld_src, ld_dst, valid; };
__device__ __forceinline__ void tr_load(const TrDesc& d, f32x4 (&v)[16]) {
    if (d.src) {
#pragma unroll
        for (int i = 0; i < 16; ++i) v[i] = *(const f32x4*)(d.src + (size_t)(4 * i) * d.ld_src);
    } else {
#pragma unroll
        for (int i = 0; i < 16; ++i) v[i] = (f32x4){0.f, 0.f, 0.f, 0.f};
    }
}
__device__ __forceinline__ void tr_store(const TrDesc& d, f32x4 (&v)[16], float* scr, int lane) {
    const int c4 = (lane & 15) * 4, kr = lane >> 4;
    if (d.cscale) { const f32x4 s = *(const f32x4*)d.cscale;
#pragma unroll
        for (int i = 0; i < 16; ++i) v[i] = v[i] * s; }
#pragma unroll
    for (int i = 0; i < 16; ++i) { float* q = scr + (kr + 4 * i) * 65 + c4; q[0] = v[i][0]; q[1] = v[i][1]; q[2] = v[i][2]; q[3] = v[i][3]; }
    asm volatile("s_waitcnt lgkmcnt(0)" ::: "memory");
    const int c = lane & 7;
#pragma unroll
    for (int j = 0; j < 8; ++j) { const int n = (lane >> 3) + 8 * j; const float* s = scr + (8 * c) * 65 + n;
        u32x4 o; o.x = pk2(s[0 * 65], s[1 * 65]); o.y = pk2(s[2 * 65], s[3 * 65]); o.z = pk2(s[4 * 65], s[5 * 65]); o.w = pk2(s[6 * 65], s[7 * 65]);
        *(u32x4*)(d.dst + (size_t)n * d.ld_dst + 8 * c) = o; }
    asm volatile("s_waitcnt lgkmcnt(0)" ::: "memory");
}
__device__ __forceinline__ TrDesc tr_desc(const float* W, int ld_src, int srcq, bf16_t* WT, int ld_dst, int n_dst, int kdst0, int k0, int lane, const float* cscale = nullptr) {
    TrDesc d; d.ld_src = ld_src; d.ld_dst = ld_dst; d.valid = 1;
    d.src = srcq >= 0 ? W + (size_t)(k0 + (lane >> 4)) * ld_src + srcq : nullptr;
    d.cscale = (cscale && srcq >= 0) ? cscale + srcq : nullptr;
    d.dst = WT + (size_t)n_dst * ld_dst + kdst0 + k0; return d;
}
constexpr int CV_MIX_ITEMS = 2880 + 64 + 768 + 256;
constexpr int CV_EXP_ITEMS = 32 * 384;
__device__ __forceinline__ TrDesc convert_desc(const Params& p, int le, int lm, int it, int lane) {
    unsigned char* ws = p.ws;
    const int c4 = (lane & 15) * 4;
    if (le >= 0) {
        if (it < CV_EXP_ITEMS) {
            const int e = it / 384, r = it % 384;
            if (r < 256) { const int up = r >> 7, q = r & 127, kb = ((q >> 5) << 2) | ((q >> 1) & 3), nb = (((q >> 3) & 3) << 1) | (q & 1); const int c = nb * 64;
                const float* src = (up ? p.w_eu : p.w_eg) + (size_t)(le * 32 + e) * 1024 * 512;
                return tr_desc(src, 512, c + c4, (bf16_t*)(ws + WS_EW1) + (size_t)e * 1048576, 1024, (c >> 7) * 256 + up * 128 + (c & 127), 0, kb * 64, lane); }
            const int q = r - 256, kb = ((q >> 6) << 2) | ((q >> 1) & 3), nb = (((q >> 3) & 7) << 1) | (q & 1);
            return tr_desc(p.w_ed + (size_t)(le * 32 + e) * 512 * 1024, 1024, nb * 64 + c4, (bf16_t*)(ws + WS_EW2A) + (size_t)e * 524288 + (e >= 4 ? EW2_SPLIT_OFF : 0), 512, nb * 64, 0, kb * 64, lane);
        }
        it -= CV_EXP_ITEMS;
    }
    const int l = lm;
    if (it < 2880) { const int R = it >> 4, kb = it & 15, dstn = R * 64; int srcq;
        if (R < 80) srcq = dstn + c4; else if (R < 128) srcq = dstn + 16 + c4; else if (R < 176) srcq = dstn + 48 + c4;
        else if (R == 176) srcq = c4 < 32 ? 8208 + c4 : (c4 < 48 ? 5120 + (c4 - 32) : -1); else srcq = -1;
        return tr_desc(p.w_in + (size_t)l * 1024 * DIN, DIN, srcq, (bf16_t*)(ws + WS_WIN + (l ? WS_W1OFS : 0)), 1024, dstn, 0, kb * 64, lane); }
    it -= 2880;
    if (it < 64) { const int g = it >> 4, r = it & 15, kb = r >> 2, nb = r & 3;
        return tr_desc(p.pool_w + (size_t)(l * 4 + g) * 65536, 256, nb * 64 + c4, (bf16_t*)(ws + WS_WPOOL + (l ? WS_W1OFS : 0)) + (size_t)g * 65536, 256, nb * 64, 0, kb * 64, lane, p.pool_scale + l * 1024 + g * 256); }
    it -= 64;
    if (it < 768) { const int br = it >> 8, r = it & 255, kb = r >> 4, nb = r & 15;
        return tr_desc(p.w_branch + (size_t)(l * 3 + br) * 1048576, 1024, nb * 64 + c4, (bf16_t*)(ws + WS_WBR + (l ? WS_W1OFS : 0)), 3072, nb * 64, br * 1024, kb * 64, lane); }
    it -= 768;
    { const int kb = it >> 4, nb = it & 15;
      return tr_desc(p.w_out + (size_t)l * 1048576, 1024, nb * 64 + c4, (bf16_t*)(ws + WS_WOUT + (l ? WS_W1OFS : 0)), 1024, nb * 64, 0, kb * 64, lane); }
}
__device__ __forceinline__ void convert_run(const Params& p, int le, int lm, int first, int step, float* scr, int lane) {
    const int nitems = (le >= 0 ? CV_EXP_ITEMS : 0) + (lm >= 0 ? CV_MIX_ITEMS : 0);
    if (first >= nitems) return;
    f32x4 va[16], vb[16];
    TrDesc da = convert_desc(p, le, lm, first, lane), db;
    tr_load(da, va);
    for (int it = first; it < nitems; it += 2 * step) {
        const int i1 = it + step, i2 = it + 2 * step;
        if (i1 < nitems) { db = convert_desc(p, le, lm, i1, lane); tr_load(db, vb); }
        tr_store(da, va, scr, lane);
        if (i1 >= nitems) break;
        if (i2 < nitems) { da = convert_desc(p, le, lm, i2, lane); tr_load(da, va); }
        tr_store(db, vb, scr, lane);
    }
}

__device__ __forceinline__ int cv_map(int listB, int n) { return listB ? (n < 4096 ? (n >> 7) * 384 + 256 + (n & 127) : CV_EXP_ITEMS + (n - 4096)) : (n >> 8) * 384 + (n & 255); }
__device__ __forceinline__ void convert_list(const Params& p, int le, int lm, int listB, int count, int first, int step, float* scr, int lane) {
    if (first >= count) return;
    f32x4 va[16], vb[16];
    TrDesc da = convert_desc(p, le, lm, cv_map(listB, first), lane), db;
    tr_load(da, va);
    for (int it = first; it < count; it += 2 * step) {
        const int i1 = it + step, i2 = it + 2 * step;
        if (i1 < count) { db = convert_desc(p, le, lm, cv_map(listB, i1), lane); tr_load(db, vb); }
        tr_store(da, va, scr, lane);
        if (i1 >= count) break;
        if (i2 < count) { da = convert_desc(p, le, lm, cv_map(listB, i2), lane); tr_load(da, va); }
        tr_store(db, vb, scr, lane);
    }
}

__device__ __forceinline__ void cvmicro_load(const Params& p, int le, int m, int lane, f32x4 (&v)[8], TrDesc& d) {
    d = convert_desc(p, le, -1, m >> 1, lane);
    const float* s = d.src + (size_t)(32 * (m & 1)) * d.ld_src;
#pragma unroll
    for (int i = 0; i < 8; ++i) v[i] = *(const f32x4*)(s + (size_t)(4 * i) * d.ld_src);
}
__device__ __forceinline__ void cvmicro_store(const TrDesc& d, int m, const f32x4 (&v)[8], LAS float* scr, int lane) {
    const int c4 = (lane & 15) * 4, kr = lane >> 4;
#pragma unroll
    for (int i = 0; i < 8; ++i) { LAS float* q = scr + (kr + 4 * i) * 65 + c4; q[0] = v[i][0]; q[1] = v[i][1]; q[2] = v[i][2]; q[3] = v[i][3]; }
    asm volatile("s_waitcnt lgkmcnt(0)" ::: "memory");
    bf16_t* drow = d.dst + (size_t)lane * d.ld_dst + 32 * (m & 1);
#pragma unroll
    for (int g = 0; g < 4; ++g) { const LAS float* s = scr + (8 * g) * 65 + lane;
        u32x4 o; o.x = pk2(s[0 * 65], s[1 * 65]); o.y = pk2(s[2 * 65], s[3 * 65]); o.z = pk2(s[4 * 65], s[5 * 65]); o.w = pk2(s[6 * 65], s[7 * 65]);
        *(u32x4*)(drow + 8 * g) = o; }
    asm volatile("s_waitcnt lgkmcnt(0)" ::: "memory");
}

__device__ __forceinline__ void phase_pre(const Params& p, unsigned char* ldsb, int bid, int nb) {
    float* lds = reinterpret_cast<float*>(ldsb);
    const int tid = tid_fresh(), lane = tid & 63, wave = tid >> 6;
    for (int i = tid; i < 5 * 1024; i += NTHR) { const float v = i < 4096 ? p.c[i] : p.c_ctx[i - 4096]; lds[i] = silu_f(v); }
    __syncthreads();
    float* red = lds + 5120;
    for (int it = bid; it < 2 * 96; it += nb) {
        const int l = it / 96, j = (it % 96) * 64 + lane;
        const float* w = p.w_ada + (size_t)l * 1024 * 6144 + j;
        float a0 = 0, a1 = 0, a2 = 0, a3 = 0, a4 = 0;
#pragma unroll 16
        for (int k = wave * 128; k < wave * 128 + 128; ++k) { const float wv = w[(size_t)k * 6144];
            a0 += lds[k] * wv; a1 += lds[1024 + k] * wv; a2 += lds[2048 + k] * wv; a3 += lds[3072 + k] * wv; a4 += lds[4096 + k] * wv; }
        red[(wave * 5 + 0) * 64 + lane] = a0; red[(wave * 5 + 1) * 64 + lane] = a1; red[(wave * 5 + 2) * 64 + lane] = a2;
        red[(wave * 5 + 3) * 64 + lane] = a3; red[(wave * 5 + 4) * 64 + lane] = a4;
        __syncthreads();
        if (tid < 320) { const int r = tid >> 6, jj = tid & 63; float s = 0;
            for (int w8 = 0; w8 < 8; ++w8) s += red[(w8 * 5 + r) * 64 + jj];
            const int col = (it % 96) * 64 + jj;
            ((float*)(p.ws + WS_MOD))[(size_t)(l * 5 + r) * 6144 + col] = s + p.b_ada[l * 6144 + col]; }
        __syncthreads();
    }
    __syncthreads();
    float* scr = lds + wave * (64 * 65);
    convert_run(p, -1, 0, bid * 8 + wave, nb * 8, scr, lane);
}

__device__ __forceinline__ void norm_mod_row(f32x4 (&v)[4], const float* g, const float* shift, const float* scale, int lane) {
    float s = 0.f;
#pragma unroll
    for (int j = 0; j < 4; ++j) s += (v[j][0] * v[j][0] + v[j][1] * v[j][1]) + (v[j][2] * v[j][2] + v[j][3] * v[j][3]);
    const float rs = __builtin_amdgcn_rsqf(wave_sum(s) * (1.f / 1024.f) + EPS);
#pragma unroll
    for (int j = 0; j < 4; ++j) { const int c = 4 * lane + 256 * j; const f32x4 gg = *(const f32x4*)(g + c);
        f32x4 y = v[j] * rs * gg;
        if (shift) { const f32x4 sh = *(const f32x4*)(shift + c), sc = *(const f32x4*)(scale + c); y = y * (1.f + sc) + sh; }
        v[j] = y; }
}
__device__ __forceinline__ void store_row_bf16(bf16_t* dst, const f32x4 (&v)[4], int lane) {
#pragma unroll
    for (int j = 0; j < 4; ++j) { u32x2 w; w.x = pk2(v[j][0], v[j][1]); w.y = pk2(v[j][2], v[j][3]); *(u32x2*)(dst + 4 * lane + 256 * j) = w; }
}

__device__ __forceinline__ void phase_norm1(const Params& p, int bid, int nb) {
    const int lane = tid_fresh() & 63, wave = tid_fresh() >> 6;
    const float* mod = (const float*)(p.ws + WS_MOD);
    const int stride = nb * 8;
    int m = bid * 8 + wave;
    f32x4 v[4], w[4];
    if (m < MT) { const float* src = m < MC ? p.ctx + (size_t)m * 1024 : p.x + (size_t)(m - MC) * 1024;
#pragma unroll
        for (int j = 0; j < 4; ++j) v[j] = *(const f32x4*)(src + 4 * lane + 256 * j); }
    for (; m < MT; m += stride) {
        const int mn = m + stride;
        if (mn < MT) { const float* src = mn < MC ? p.ctx + (size_t)mn * 1024 : p.x + (size_t)(mn - MC) * 1024;
#pragma unroll
            for (int j = 0; j < 4; ++j) w[j] = *(const f32x4*)(src + 4 * lane + 256 * j); }
        const float* mr = mod + modrow(m) * 6144;
        norm_mod_row(v, p.g_mix, mr, mr + 1024, lane);
        store_row_bf16((bf16_t*)(p.ws + WS_H) + (size_t)m * 1024, v, lane);
#pragma unroll
        for (int j = 0; j < 4; ++j) v[j] = w[j];
    }
}

__device__ __forceinline__ float wave_incl_sum(float v, int lane) {
#pragma unroll
    for (int o = 1; o < 64; o <<= 1) { const float u = __shfl_up(v, o); if (lane >= o) v += u; }
    return v;
}
__device__ __forceinline__ float wave_incl_max(float v, int lane) {
#pragma unroll
    for (int o = 1; o < 64; o <<= 1) { const float u = __shfl_up(v, o); if (lane >= o) v = fmaxf(v, u); }
    return v;
}
__device__ __forceinline__ u32x2 pack4(f32x4 a) { u32x2 w; w.x = pk2(a[0], a[1]); w.y = pk2(a[2], a[3]); return w; }

__device__ __forceinline__ void chunk_geom(int gc, int& rbase, int& n0, int& len) {
    const int b = gc / 68, cin = gc % 68;
    if (cin < 4) { rbase = b * 256; n0 = cin * 64; len = 256; } else { rbase = MC + b * 4096; n0 = (cin - 4) * 64; len = 4096; }
}
struct ConvW { float w[4][8], b[8]; };
__device__ __forceinline__ void conv_load_w(const float* cw, const float* cb, int ch0, ConvW& W) {
#pragma unroll
    for (int j = 0; j < 4; ++j) { const f32x4 a = *(const f32x4*)(cw + j * 2048 + ch0), b2 = *(const f32x4*)(cw + j * 2048 + ch0 + 4);
#pragma unroll
        for (int i = 0; i < 4; ++i) { W.w[j][i] = a[i]; W.w[j][4 + i] = b2[i]; } }
    { const f32x4 a = *(const f32x4*)(cb + ch0), b2 = *(const f32x4*)(cb + ch0 + 4);
#pragma unroll
      for (int i = 0; i < 4; ++i) { W.b[i] = a[i]; W.b[4 + i] = b2[i]; } }
}
__device__ __forceinline__ void conv_load_w_lds(const LAS float* img, int ch0, ConvW& W) {
#pragma unroll
    for (int j = 0; j < 4; ++j) { const f32x4 a = *(const LAS f32x4*)(img + j * 2048 + ch0), b2 = *(const LAS f32x4*)(img + j * 2048 + ch0 + 4);
#pragma unroll
        for (int i = 0; i < 4; ++i) { W.w[j][i] = a[i]; W.w[j][4 + i] = b2[i]; } }
    { const f32x4 a = *(const LAS f32x4*)(img + 4 * 2048 + ch0), b2 = *(const LAS f32x4*)(img + 4 * 2048 + ch0 + 4);
#pragma unroll
      for (int i = 0; i < 4; ++i) { W.b[i] = a[i]; W.b[4 + i] = b2[i]; } }
}
__device__ __forceinline__ void conv8x4(const u32x4 (&raw)[7], const ConvW& W, float scale, u32x4 (&out)[4]) {
    float f[7][8];
#pragma unroll
    for (int k = 0; k < 7; ++k) unpack8(raw[k], f[k]);
#pragma unroll
    for (int pp = 0; pp < 4; ++pp) { f32x4 o0, o1;
#pragma unroll
        for (int i = 0; i < 8; ++i) { float a = W.b[i];
#pragma unroll
            for (int j = 0; j < 4; ++j) a += W.w[j][i] * f[pp + j][i];
            a = silu_f(a) * scale; if (i < 4) o0[i] = a; else o1[i - 4] = a; }
        out[pp] = pack8(o0, o1); }
}
__device__ __forceinline__ void load_raw7(const bf16_t* src, size_t ld, int rbase, int tbase, int len, u32x4 (&raw)[7]) {
#pragma unroll
    for (int k = 0; k < 7; ++k) { const int t = tbase + k; const bool ok = (t >= 0) && (t < len); const int tc = t < 0 ? 0 : (t >= len ? len - 1 : t);
        u32x4 a = *(const u32x4*)(src + (size_t)(rbase + tc) * ld);
        if (!ok) a = (u32x4){0u, 0u, 0u, 0u};
        raw[k] = a; }
}
template <class F>
__device__ __forceinline__ void tile_transpose_out(const LAS bf16_t* tile, int ldsw, int ncol, int tid, F rowptr) {
    for (int q = tid; q < ncol * 8; q += NTHR) { const int c = q % ncol, sc = q / ncol;
        unsigned v[8];
#pragma unroll
        for (int i = 0; i < 8; ++i) v[i] = tile[(sc * 8 + i) * ldsw + c];
        u32x4 w; w.x = v[0] | (v[1] << 16); w.y = v[2] | (v[3] << 16); w.z = v[4] | (v[5] << 16); w.w = v[6] | (v[7] << 16);
        *(u32x4*)(rowptr(c) + sc * 8) = w; }
}

struct RawM { u32x4 rq[7], rk[7]; float g0, g1; };
__device__ __forceinline__ void conv_m_load(const Params& p, int item, RawM& R) {
    const int tid = tid_fresh(), gc = item >> 2, hd = item & 3;
    int rbase, n0, len; chunk_geom(gc, rbase, n0, len);
    const int cs = tid & 31, tg = tid >> 5, d0 = cs * 8, i0 = tg * 4;
    R.g0 = 0.f; R.g1 = 0.f;
    load_raw7((const bf16_t*)(p.ws + WS_Q) + hd * 256 + d0, 1024, rbase, n0 + i0 - 2, len, R.rq);
    load_raw7((const bf16_t*)(p.ws + WS_K) + hd * 256 + d0, 1024, rbase, n0 + i0 - 2, len, R.rk);
    const int gdir = tid >> 6, glane = tid & 63, gj = gdir ? 63 - glane : glane;
    if (gdir < 2) { const float* g = (const float*)(p.ws + WS_GA) + (size_t)(rbase + n0 + gj) * 16; R.g0 = g[gdir * 4 + hd]; R.g1 = g[(2 + gdir) * 4 + hd]; }
}
__device__ __forceinline__ void conv_m_compute(const Params& p, int l, int item, const RawM& R, const LAS float* img) {
    const int tid = tid_fresh(), gc = item >> 2, hd = item & 3;
    int rbase, n0, len; chunk_geom(gc, rbase, n0, len);
    const int cs = tid & 31, tg = tid >> 5, d0 = cs * 8, i0 = tg * 4;
    const int gdir = tid >> 6, glane = tid & 63, gj = gdir ? 63 - glane : glane;
    { u32x4 o[4]; ConvW W;
      conv_load_w_lds(img, hd * 256 + d0, W);
      conv8x4(R.rq, W, 1.0f, o);
#pragma unroll
      for (int pp = 0; pp < 4; ++pp) *(u32x4*)((bf16_t*)(p.ws + WS_QC) + (size_t)(rbase + n0 + i0 + pp) * 1024 + hd * 256 + d0) = o[pp];
      conv_load_w_lds(img, 1024 + hd * 256 + d0, W);
      conv8x4(R.rk, W, 0.0625f, o);
#pragma unroll
      for (int pp = 0; pp < 4; ++pp) *(u32x4*)((bf16_t*)(p.ws + WS_KC) + (size_t)(rbase + n0 + i0 + pp) * 1024 + hd * 256 + d0) = o[pp]; }
    if (gdir < 2) {
        const float ig = R.g0 + p.mgate_b[l * 16 + gdir * 4 + hd], lf = logsigmoid_f(R.g1 + p.mgate_b[l * 16 + (2 + gdir) * 4 + hd]);
        const float cum = wave_incl_sum(lf, glane), a = ig - cum, pm = wave_incl_max(a, glane);
        const size_t o = (size_t)(gc * 8 + gdir * 4 + hd) * 64 + gj;
        ((float*)(p.ws + WS_MGA))[o] = a; ((float*)(p.ws + WS_MGC))[o] = cum; ((float*)(p.ws + WS_MGP))[o] = pm;
    }
}

struct RawS { u32x4 rbc[7], rx[7]; float dtraw; };
__device__ __forceinline__ void conv_s_load(const Params& p, int item, RawS& R) {
    const int tid = tid_fresh(), gc = item >> 2, grp = item & 3;
    int rbase, n0, len; chunk_geom(gc, rbase, n0, len);
    const int cs = tid & 31, tg = tid >> 5, i0 = tg * 4;
    const int isC = cs >> 4, nn = (cs & 15) * 8;
    load_raw7((const bf16_t*)(p.ws + (isC ? WS_SC : WS_SB)) + grp * 128 + nn, 512, rbase, n0 + i0 - 2, len, R.rbc);
    load_raw7((const bf16_t*)(p.ws + WS_SX) + grp * 256 + cs * 8, 1024, rbase, n0 + i0 - 2, len, R.rx);
    const int wv = tid >> 6, lane = tid & 63, dir = wv >> 2, hd = grp * 4 + (wv & 3), jn = dir ? 63 - lane : lane;
    R.dtraw = ((const float*)(p.ws + WS_DT))[(size_t)(rbase + n0 + jn) * 32 + dir * 16 + hd];
}
__device__ __forceinline__ void conv_s_compute(const Params& p, int l, int item, const RawS& R, const LAS float* img) {
    const int tid = tid_fresh(), gc = item >> 2, grp = item & 3;
    int rbase, n0, len; chunk_geom(gc, rbase, n0, len);
    const int cs = tid & 31, tg = tid >> 5, i0 = tg * 4;
    const int isC = cs >> 4, nn = (cs & 15) * 8;
    const int wv = tid >> 6, lane = tid & 63, dir = wv >> 2, hd = grp * 4 + (wv & 3), jn = dir ? 63 - lane : lane;
    { u32x4 o[4]; ConvW W;
      conv_load_w_lds(img, 1024 + isC * 512 + grp * 128 + nn, W);
      conv8x4(R.rbc, W, 1.0f, o);
      bf16_t* dst = (bf16_t*)(p.ws + (isC ? WS_CC : WS_BC)) + grp * 128 + nn;
#pragma unroll
      for (int pp = 0; pp < 4; ++pp) *(u32x4*)(dst + (size_t)(rbase + n0 + i0 + pp) * 512) = o[pp];
      conv_load_w_lds(img, grp * 256 + cs * 8, W);
      conv8x4(R.rx, W, 1.0f, o);
      bf16_t* dx = (bf16_t*)(p.ws + WS_XCT) + grp * 256 + cs * 8;
#pragma unroll
      for (int pp = 0; pp < 4; ++pp) *(u32x4*)(dx + (size_t)(rbase + n0 + i0 + pp) * 1024) = o[pp]; }
    { const float dtv = softplus_f(R.dtraw + p.sdt_bias[l * 32 + dir * 16 + hd]);
      const float acs = wave_incl_sum(dtv * -__expf(p.sa_log[l * 32 + dir * 16 + hd]), lane);
      const size_t o = (size_t)(gc * 32 + dir * 16 + hd) * 64 + jn;
      ((float*)(p.ws + WS_SACS))[o] = acs; ((float*)(p.ws + WS_SDT))[o] = dtv; }
}

__device__ __forceinline__ void pool_window_item(const Params& p, int it, LAS unsigned char* lds) {
    const int tid = tid_fresh();
    bf16_t* BR = (bf16_t*)(p.ws + WS_BR);
    __syncthreads();
    if (it < 256) {
        const int row0 = MC + it * 64;
        { u32x4 t[16];
#pragma unroll
          for (int i = 0; i < 16; ++i) { const int q = tid + NTHR * i, r = q >> 7, ch = q & 127; t[i] = *(const u32x4*)(BR + (size_t)(row0 + r) * 3072 + ch * 8); }
#pragma unroll
          for (int i = 0; i < 16; ++i) *(LAS u32x4*)(lds + (tid + NTHR * i) * 16) = t[i]; }
        __syncthreads();
        for (int q = tid; q < 64 * 128; q += NTHR) { const int r = q >> 7, ch = q & 127, w = 2 << (ch >> 5);
            int lo = r - (w >> 1), hi = lo + w - 1; lo = lo < 0 ? 0 : lo; hi = hi > 63 ? 63 : hi;
            float s[8] = {0, 0, 0, 0, 0, 0, 0, 0}, self[8];
            for (int rr = lo; rr <= hi; ++rr) { float f[8]; unpack8(*(const LAS u32x4*)(lds + (rr * 128 + ch) * 16), f);
#pragma unroll
                for (int j = 0; j < 8; ++j) s[j] += f[j]; }
            unpack8(*(const LAS u32x4*)(lds + q * 16), self);
            const float inv = __builtin_amdgcn_rcpf((float)(hi - lo + 1)); f32x4 a, b;
#pragma unroll
            for (int j = 0; j < 4; ++j) { a[j] = s[j] * inv - self[j]; b[j] = s[4 + j] * inv - self[4 + j]; }
            *(u32x4*)(BR + (size_t)(row0 + r) * 3072 + ch * 8) = pack8(a, b); }
    } else {
        const int bb = (it - 256) >> 2, g = (it - 256) & 3, row0 = bb * 256, w = 2 << g;
        { u32x4 t[16];
#pragma unroll
          for (int i = 0; i < 16; ++i) { const int q = tid + NTHR * i, r = q >> 5, ch = q & 31; t[i] = *(const u32x4*)(BR + (size_t)(row0 + r) * 3072 + g * 256 + ch * 8); }
#pragma unroll
          for (int i = 0; i < 16; ++i) *(LAS u32x4*)(lds + (tid + NTHR * i) * 16) = t[i]; }
        __syncthreads();
        for (int q = tid; q < 256 * 32; q += NTHR) { const int r = q >> 5, ch = q & 31;
            int lo = r - (w >> 1), hi = lo + w - 1; lo = lo < 0 ? 0 : lo; hi = hi > 255 ? 255 : hi;
            float s[8] = {0, 0, 0, 0, 0, 0, 0, 0}, self[8];
            for (int rr = lo; rr <= hi; ++rr) { float f[8]; unpack8(*(const LAS u32x4*)(lds + (rr * 32 + ch) * 16), f);
#pragma unroll
                for (int j = 0; j < 8; ++j) s[j] += f[j]; }
            unpack8(*(const LAS u32x4*)(lds + q * 16), self);
            const float inv = __builtin_amdgcn_rcpf((float)(hi - lo + 1)); f32x4 a, b;
#pragma unroll
            for (int j = 0; j < 4; ++j) { a[j] = s[j] * inv - self[j]; b[j] = s[4 + j] * inv - self[4 + j]; }
            *(u32x4*)(BR + (size_t)(row0 + r) * 3072 + g * 256 + ch * 8) = pack8(a, b); }
    }
    __syncthreads();
}

typedef short bf16x4 __attribute__((ext_vector_type(4)));
__device__ __forceinline__ bf16x8 tr_join(bf16x4 r0, bf16x4 r1) { bf16x8 o; o[0] = r0[0]; o[1] = r0[1]; o[2] = r0[2]; o[3] = r0[3]; o[4] = r1[0]; o[5] = r1[1]; o[6] = r1[2]; o[7] = r1[3]; return o; }
__device__ __forceinline__ bf16x4 tr_ld(unsigned a) { return __builtin_amdgcn_ds_read_tr16_b64_v4i16((LAS bf16x4*)(size_t)a); }
__device__ __forceinline__ bf16x8 tr_frag(unsigned a0, unsigned a1) { const bf16x4 r0 = tr_ld(a0), r1 = tr_ld(a1); return tr_join(r0, r1); }
__device__ __forceinline__ void tr_frag4(const unsigned (&a)[4], unsigned d, bf16x8 (&f)[4]) {
    bf16x4 r[8];
#pragma unroll
    for (int i = 0; i < 4; ++i) { r[2 * i] = tr_ld(a[i]); r[2 * i + 1] = tr_ld(a[i] + d); }
#pragma unroll
    for (int i = 0; i < 4; ++i) f[i] = tr_join(r[2 * i], r[2 * i + 1]);
}
__device__ __forceinline__ void tr_frag6(const unsigned (&a)[6], unsigned d, bf16x8 (&f)[6]) {
    bf16x4 r[12];
#pragma unroll
    for (int i = 0; i < 6; ++i) { r[2 * i] = tr_ld(a[i]); r[2 * i + 1] = tr_ld(a[i] + d); }
#pragma unroll
    for (int i = 0; i < 6; ++i) f[i] = tr_join(r[2 * i], r[2 * i + 1]);
}
constexpr int ML_CT = 0, ML_Q = 36864, ML_K = 71680, ML_V = 106496, ML_A = 135168;
__device__ __forceinline__ void mlstm_chunk_item(const Params& p, int l, int item, LAS unsigned char* lds) {
    const int tid0 = tid_fresh(), wid = __builtin_amdgcn_readfirstlane(tid0 >> 6);
    const int b = item >> 5, hd = (item >> 3) & 3, dir = (item >> 2) & 1, eg2 = item & 3;
    const bf16_t* QC = (const bf16_t*)(p.ws + WS_QC); const bf16_t* KC = (const bf16_t*)(p.ws + WS_KC);
    const bf16_t* Vg = (const bf16_t*)(p.ws + WS_V);
    const float* GAa = (const float*)(p.ws + WS_MGA); const float* GCc = (const float*)(p.ws + WS_MGC); const float* GPp = (const float*)(p.ws + WS_MGP);
    bf16_t* OUT = (bf16_t*)(p.ws + (dir ? WS_HB2 : WS_HF2));
    const int ti = wid >> 1, wh = wid & 1;
    __syncthreads();
    for (int i = tid0; i < 36864 / 4; i += NTHR) ((LAS unsigned*)(lds + ML_CT))[i] = 0u;
    if (tid0 < 128) { const int es = tid0 >> 6, r = tid0 & 63; *(LAS u32x4*)(lds + ML_V + es * 14336 + r * 112 + 64) = (u32x4){0x3F80u, 0u, 0u, 0u}; *(LAS u32x4*)(lds + ML_V + es * 14336 + r * 112 + 80) = (u32x4){0u, 0u, 0u, 0u}; }
    f32x4 Cacc[2][2][3];
#pragma unroll
    for (int es = 0; es < 2; ++es)
#pragma unroll
        for (int j = 0; j < 2; ++j)
#pragma unroll
            for (int e = 0; e < 3; ++e) Cacc[es][j][e] = (f32x4){0.f, 0.f, 0.f, 0.f};
    float m_st = 0.f;
    f32x4 ca0 = (f32x4){0.f, 0.f, 0.f, 0.f}, ca1 = ca0, cP4 = ca0, cC4 = ca0; float cPt = 0.f, cPl = 0.f, cCl = 0.f, caw = 0.f;
    const int jl = dir ? 0 : 63;
    __syncthreads();
    for (int c = -1; c < 68; ++c) {
        const int cn = c + 1;
        const int tid = tid_fresh(), lane = tid & 63, fr = lane & 15, fq = lane >> 4;
        const int vrow = tid < 384 ? tid / 6 : 63, vch = tid < 384 ? tid % 6 : 0;
        const int gs0 = 16 * (2 * wh) + 4 * fq, gt = 16 * ti + fr, gt0 = 16 * ti + 4 * fq;
        u32x4 rq[4], rk[4], rv[1];
#pragma unroll
        for (int j = 0; j < 4; ++j) { rq[j] = (u32x4){0u, 0u, 0u, 0u}; rk[j] = rq[j]; }
        rv[0] = (u32x4){0u, 0u, 0u, 0u};
        if (cn < 68) {
            const int cin = cn < 4 ? (dir ? 3 - cn : cn) : 4 + (dir ? 67 - cn : cn - 4), gc = b * 68 + cin;
            int rbase, n0, len; chunk_geom(gc, rbase, n0, len);
#pragma unroll
            for (int j = 0; j < 4; ++j) { const int q = tid + NTHR * j;
                const size_t ro = (size_t)(rbase + n0 + (q >> 5)) * 1024 + hd * 256 + (q & 31) * 8;
                rq[j] = *(const u32x4*)(QC + ro); rk[j] = *(const u32x4*)(KC + ro); }
            { const int es = tid >> 8, r = (tid & 255) >> 2, ch = tid & 3;
              rv[0] = *(const u32x4*)(Vg + (size_t)(rbase + n0 + r) * 1024 + hd * 256 + (2 * eg2 + es) * 32 + ch * 8); }
        }
        if (c >= 0) {
            const int cin = c < 4 ? (dir ? 3 - c : c) : 4 + (dir ? 67 - c : c - 4), gc = b * 68 + cin;
            int rbase, n0, len; chunk_geom(gc, rbase, n0, len);
            bf16x8 qf[8];
            {
                f32x4 st[2] = {(f32x4){0.f, 0.f, 0.f, 0.f}, (f32x4){0.f, 0.f, 0.f, 0.f}};
                const LAS unsigned char* qb = lds + ML_Q + (16 * ti + fr) * 544 + fq * 16;
                const LAS unsigned char* kb0 = lds + ML_K + (16 * (2 * wh) + fr) * 544 + fq * 16;
                bf16x8 k0f[4], k1f[4];
#pragma unroll
                for (int hb = 0; hb < 2; ++hb) {
#pragma unroll
                    for (int kd = 0; kd < 4; ++kd) { qf[4 * (1 - hb) + kd] = *(const LAS bf16x8*)(qb + (4 * (1 - hb) + kd) * 64); k0f[kd] = *(const LAS bf16x8*)(kb0 + (4 * (1 - hb) + kd) * 64); k1f[kd] = *(const LAS bf16x8*)(kb0 + 16 * 544 + (4 * (1 - hb) + kd) * 64); }
                    __builtin_amdgcn_sched_barrier(0);
#pragma unroll
                    for (int kd = 0; kd < 4; ++kd) {
                        st[0] = __builtin_amdgcn_mfma_f32_16x16x32_bf16(k0f[kd], qf[4 * (1 - hb) + kd], st[0], 0, 0, 0);
                        st[1] = __builtin_amdgcn_mfma_f32_16x16x32_bf16(k1f[kd], qf[4 * (1 - hb) + kd], st[1], 0, 0, 0);
                    }
                    __builtin_amdgcn_sched_barrier(0);
                }
                const int t = 16 * ti + fr; const float Mt = fmaxf(m_st, cPt), M63 = fmaxf(m_st, cPl);
#pragma unroll
                for (int j = 0; j < 2; ++j) { const int s0 = 16 * (2 * wh + j) + 4 * fq; const f32x4 av = j ? ca1 : ca0;
                    f32x4 o;
#pragma unroll
                    for (int r = 0; r < 4; ++r) { const bool keep = dir ? (s0 + r >= t) : (s0 + r <= t); o[r] = keep ? st[j][r] * __expf(av[r] - Mt) : 0.f; }
                    *(LAS u32x2*)(lds + ML_A + t * 160 + s0 * 2) = pack4(o); }
                if (tid < 384) { const float w = __expf(caw - M63);
#pragma unroll
                    for (int es = 0; es < 2; ++es) { float f[8]; unpack8(*(const LAS u32x4*)(lds + ML_V + es * 14336 + vrow * 112 + vch * 16), f);
                        f32x4 o0, o1;
#pragma unroll
                        for (int i = 0; i < 4; ++i) { o0[i] = f[i] * w; o1[i] = f[4 + i] * w; }
                        *(LAS u32x4*)(lds + ML_V + es * 14336 + 7168 + vrow * 112 + vch * 16) = pack8(o0, o1); } }
            }
            __syncthreads();
            {
                const LAS unsigned char* ab = lds + ML_A + (16 * ti + fr) * 160 + fq * 16;
                const LAS unsigned char* qb = lds + ML_Q + (16 * ti + fr) * 544 + fq * 16;
                bf16x8 af[2], k0f[2], k1f[2];
#pragma unroll
                for (int ks = 0; ks < 2; ++ks) af[ks] = *(const LAS bf16x8*)(ab + ks * 64);
                { const unsigned kb_ = (unsigned)(size_t)(lds + ML_K) + (unsigned)((8 * fq + (fr >> 2)) * 544 + (fr & 3) * 8 + wid * 64);
                  const unsigned ka[4] = {kb_, kb_ + 32, kb_ + 32 * 544, kb_ + 32 * 544 + 32}; bf16x8 kf[4]; tr_frag4(ka, 4 * 544, kf);
                  k0f[0] = kf[0]; k1f[0] = kf[1]; k0f[1] = kf[2]; k1f[1] = kf[3]; }
                const int t0 = 16 * ti + 4 * fq;
                f32x4 sgv, emv;
#pragma unroll
                for (int r = 0; r < 4; ++r) { const float Mr = fmaxf(m_st, cP4[r]); sgv[r] = __expf(m_st - Mr); emv[r] = __expf(-(cC4[r] + Mr)); }
                const float decay = __expf(m_st - fmaxf(m_st, cPl));
                const bool wr_out = !(l == 1 && cin < 4);
                {
                    f32x4 n1[3], n2[3];
#pragma unroll
                    for (int et = 0; et < 3; ++et) { n1[et] = (f32x4){0.f, 0.f, 0.f, 0.f}; n2[et] = n1[et]; }
                    const LAS unsigned char* cb_ = lds + ML_CT + wh * 18432 + fr * 544 + fq * 16;
                    const unsigned vtr = (unsigned)(size_t)(lds + ML_V + wh * 14336) + (unsigned)((8 * fq + (fr >> 2)) * 112 + (fr & 3) * 8);
                    { bf16x8 vf[6];
                      { const unsigned va_[6] = {vtr, vtr + 32, vtr + 64, vtr + 3584, vtr + 3584 + 32, vtr + 3584 + 64}; tr_frag6(va_, 448, vf); }
                      __builtin_amdgcn_sched_barrier(0);
#pragma unroll
                      for (int ks = 0; ks < 2; ++ks)
#pragma unroll
                          for (int et = 0; et < 3; ++et) n1[et] = __builtin_amdgcn_mfma_f32_16x16x32_bf16(af[ks], vf[3 * ks + et], n1[et], 0, 0, 0);
                      __builtin_amdgcn_sched_barrier(0); }
#pragma unroll
                    for (int kb = 0; kb < 4; ++kb) {
                        bf16x8 cf[2][3];
#pragma unroll
                        for (int kd = 0; kd < 2; ++kd)
#pragma unroll
                            for (int et = 0; et < 3; ++et) cf[kd][et] = *(const LAS bf16x8*)(cb_ + et * 16 * 544 + (2 * kb + kd) * 64);
                        __builtin_amdgcn_sched_barrier(0);
#pragma unroll
                        for (int kd = 0; kd < 2; ++kd)
#pragma unroll
                            for (int et = 0; et < 3; ++et) n2[et] = __builtin_amdgcn_mfma_f32_16x16x32_bf16(qf[2 * kb + kd], cf[kd][et], n2[et], 0, 0, 0);
                        __builtin_amdgcn_sched_barrier(0);
                    }
#pragma unroll
                    for (int r = 0; r < 4; ++r) {
                        const float den = __shfl(n1[2][r] + sgv[r] * n2[2][r], lane & 48);
                        const float rden = __builtin_amdgcn_rcpf(fmaxf(fabsf(den), emv[r]));
                        if (wr_out) {
                            bf16_t* o = OUT + (size_t)(rbase + n0 + t0 + r) * 1024 + hd * 256 + (2 * eg2 + wh) * 32 + fr;
                            o[0] = (bf16_t)f2bf((n1[0][r] + sgv[r] * n2[0][r]) * rden); o[16] = (bf16_t)f2bf((n1[1][r] + sgv[r] * n2[1][r]) * rden); }
                    }
                }
#pragma unroll
                for (int es = 0; es < 2; ++es) {
#pragma unroll
                    for (int j = 0; j < 2; ++j)
#pragma unroll
                        for (int e = 0; e < 3; ++e) Cacc[es][j][e] = Cacc[es][j][e] * decay;
                    const unsigned vwr = (unsigned)(size_t)(lds + ML_V + es * 14336) + (unsigned)((8 * fq + (fr >> 2)) * 112 + (fr & 3) * 8) + 7168;
                    bf16x8 v0f[2], v1f[2], v2f[2];
                    { const unsigned wa_[6] = {vwr, vwr + 32, vwr + 64, vwr + 3584, vwr + 3584 + 32, vwr + 3584 + 64}; bf16x8 wf[6]; tr_frag6(wa_, 448, wf);
                      v0f[0] = wf[0]; v1f[0] = wf[1]; v2f[0] = wf[2]; v0f[1] = wf[3]; v1f[1] = wf[4]; v2f[1] = wf[5]; }
                    __builtin_amdgcn_sched_barrier(0);
#pragma unroll
                    for (int ks = 0; ks < 2; ++ks) {
                        Cacc[es][0][0] = __builtin_amdgcn_mfma_f32_16x16x32_bf16(k0f[ks], v0f[ks], Cacc[es][0][0], 0, 0, 0);
                        Cacc[es][0][1] = __builtin_amdgcn_mfma_f32_16x16x32_bf16(k0f[ks], v1f[ks], Cacc[es][0][1], 0, 0, 0);
                        Cacc[es][0][2] = __builtin_amdgcn_mfma_f32_16x16x32_bf16(k0f[ks], v2f[ks], Cacc[es][0][2], 0, 0, 0);
                        Cacc[es][1][0] = __builtin_amdgcn_mfma_f32_16x16x32_bf16(k1f[ks], v0f[ks], Cacc[es][1][0], 0, 0, 0);
                        Cacc[es][1][1] = __builtin_amdgcn_mfma_f32_16x16x32_bf16(k1f[ks], v1f[ks], Cacc[es][1][1], 0, 0, 0);
                        Cacc[es][1][2] = __builtin_amdgcn_mfma_f32_16x16x32_bf16(k1f[ks], v2f[ks], Cacc[es][1][2], 0, 0, 0);
                    }
                    __builtin_amdgcn_sched_barrier(0);
                }
            }
            __syncthreads();
#pragma unroll
            for (int es = 0; es < 2; ++es)
#pragma unroll
                for (int j = 0; j < 2; ++j) { const int dcol = (16 * (2 * wid + j) + 4 * fq) * 2;
                    *(LAS u32x2*)(lds + ML_CT + es * 18432 + fr * 544 + dcol) = pack4(Cacc[es][j][0]);
                    *(LAS u32x2*)(lds + ML_CT + es * 18432 + (16 + fr) * 544 + dcol) = pack4(Cacc[es][j][1]);
                    if (fr == 0) *(LAS u32x2*)(lds + ML_CT + es * 18432 + 32 * 544 + dcol) = pack4(Cacc[es][j][2]); }
        }
        if (c >= 0) m_st = cCl + fmaxf(m_st, cPl);
        if (cn < 68) {
            const int cin = cn < 4 ? (dir ? 3 - cn : cn) : 4 + (dir ? 67 - cn : cn - 4); const size_t gb = (size_t)((b * 68 + cin) * 8 + dir * 4 + hd) * 64;
            ca0 = *(const f32x4*)(GAa + gb + gs0); ca1 = *(const f32x4*)(GAa + gb + gs0 + 16); caw = GAa[gb + vrow];
            cP4 = *(const f32x4*)(GPp + gb + gt0); cC4 = *(const f32x4*)(GCc + gb + gt0); cPt = GPp[gb + gt]; cPl = GPp[gb + jl]; cCl = GCc[gb + jl]; }
        if (cn < 68) {
#pragma unroll
            for (int j = 0; j < 4; ++j) { const int q = tid + NTHR * j;
                *(LAS u32x4*)(lds + ML_Q + (q >> 5) * 544 + (q & 31) * 16) = rq[j];
                *(LAS u32x4*)(lds + ML_K + (q >> 5) * 544 + (q & 31) * 16) = rk[j]; }
            *(LAS u32x4*)(lds + ML_V + (tid >> 8) * 14336 + ((tid & 255) >> 2) * 112 + (tid & 3) * 16) = rv[0];
        }
        __syncthreads();
    }
}

constexpr int SS_C = 0, SS_B = 18432, SS_X = 36864, SS_G = 67584, SS_S = 77824;
__device__ __forceinline__ void ssd_chunk_item(const Params& p, int l, int item, LAS unsigned char* lds) {
    const int tid0 = tid_fresh(), wid = __builtin_amdgcn_readfirstlane(tid0 >> 6);
    const int b = item >> 5, hd = (item >> 1) & 15, dir = item & 1, grp = hd >> 2;
    const bf16_t* BC = (const bf16_t*)(p.ws + WS_BC); const bf16_t* CC = (const bf16_t*)(p.ws + WS_CC); const bf16_t* XC = (const bf16_t*)(p.ws + WS_XCT);
    const float* ACS = (const float*)(p.ws + WS_SACS); const float* SDT = (const float*)(p.ws + WS_SDT);
    bf16_t* OUT = (bf16_t*)(p.ws + (dir ? WS_YB : WS_YF));
    const float dskip = p.sd[l * 16 + hd];
    const int ti = wid >> 1, wh = wid & 1, jl = dir ? 0 : 63;
    __syncthreads();
    for (int i = tid0; i < 18432 / 4; i += NTHR) ((LAS unsigned*)(lds + SS_S))[i] = 0u;
    f32x4 Sacc[2][2];
#pragma unroll
    for (int ph = 0; ph < 2; ++ph) { Sacc[ph][0] = (f32x4){0.f, 0.f, 0.f, 0.f}; Sacc[ph][1] = Sacc[ph][0]; }
    f32x4 cs0 = (f32x4){0.f, 0.f, 0.f, 0.f}, cs1 = cs0, ct4 = cs0; float cat = 0.f, cal = 0.f, csw = 0.f, cdw = 0.f;
    __syncthreads();
    for (int c = -1; c < 68; ++c) {
        const int cn = c + 1;
        const int tid = tid_fresh(), lane = tid & 63, fr = lane & 15, fq = lane >> 4;
        const int xph = tid >> 8, xrow = (tid & 255) >> 2, xch = tid & 3;
        const int gs0 = 16 * (2 * wh) + 4 * fq, gt = 16 * ti + fr, gt0 = 16 * ti + 4 * fq;
        u32x4 rc[2], rb[2], rx = (u32x4){0u, 0u, 0u, 0u};
#pragma unroll
        for (int j = 0; j < 2; ++j) { rc[j] = (u32x4){0u, 0u, 0u, 0u}; rb[j] = rc[j]; }
        if (cn < 68) {
            const int cin = cn < 4 ? (dir ? 3 - cn : cn) : 4 + (dir ? 67 - cn : cn - 4), gc = b * 68 + cin;
            int rbase, n0, len; chunk_geom(gc, rbase, n0, len);
#pragma unroll
            for (int j = 0; j < 2; ++j) { const int q = tid + NTHR * j;
                const size_t ro = (size_t)(rbase + n0 + (q >> 4)) * 512 + grp * 128 + (q & 15) * 8;
                rc[j] = *(const u32x4*)(CC + ro); rb[j] = *(const u32x4*)(BC + ro); }
            rx = *(const u32x4*)(XC + (size_t)(rbase + n0 + xrow) * 1024 + hd * 64 + xph * 32 + xch * 8);
        }
        if (c >= 0) {
            const int cin = c < 4 ? (dir ? 3 - c : c) : 4 + (dir ? 67 - c : c - 4), gc = b * 68 + cin;
            int rbase, n0, len; chunk_geom(gc, rbase, n0, len);
            {
                f32x4 st[2] = {(f32x4){0.f, 0.f, 0.f, 0.f}, (f32x4){0.f, 0.f, 0.f, 0.f}};
                const LAS unsigned char* cbp = lds + SS_C + (16 * ti + fr) * 288 + fq * 16;
                const LAS unsigned char* bb0 = lds + SS_B + (16 * (2 * wh) + fr) * 288 + fq * 16;
                bf16x8 cf[4], b0f[4], b1f[4];
#pragma unroll
                for (int kn = 0; kn < 4; ++kn) { cf[kn] = *(const LAS bf16x8*)(cbp + kn * 64); b0f[kn] = *(const LAS bf16x8*)(bb0 + kn * 64); b1f[kn] = *(const LAS bf16x8*)(bb0 + 16 * 288 + kn * 64); }
                __builtin_amdgcn_sched_barrier(0);
#pragma unroll
                for (int kn = 0; kn < 4; ++kn) {
                    st[0] = __builtin_amdgcn_mfma_f32_16x16x32_bf16(b0f[kn], cf[kn], st[0], 0, 0, 0);
                    st[1] = __builtin_amdgcn_mfma_f32_16x16x32_bf16(b1f[kn], cf[kn], st[1], 0, 0, 0);
                }
                __builtin_amdgcn_sched_barrier(0);
                const int t = 16 * ti + fr; const float at = cat;
#pragma unroll
                for (int j = 0; j < 2; ++j) { const int s0 = 16 * (2 * wh + j) + 4 * fq; const f32x4 av = j ? cs1 : cs0;
                    f32x4 o;
#pragma unroll
                    for (int r = 0; r < 4; ++r) { const bool keep = dir ? (s0 + r >= t) : (s0 + r <= t); o[r] = keep ? st[j][r] * __expf(at - av[r]) : 0.f; }
                    *(LAS u32x2*)(lds + SS_G + t * 160 + s0 * 2) = pack4(o); }
                { float f[8]; unpack8(*(const LAS u32x4*)(lds + SS_X + xph * 15360 + xrow * 80 + xch * 16), f);
                  const float w = __expf(cal - csw); f32x4 o0, o1, w0, w1;
#pragma unroll
                  for (int i = 0; i < 4; ++i) { o0[i] = f[i] * cdw; o1[i] = f[4 + i] * cdw; w0[i] = o0[i] * w; w1[i] = o1[i] * w; }
                  *(LAS u32x4*)(lds + SS_X + xph * 15360 + 5120 + xrow * 80 + xch * 16) = pack8(o0, o1);
                  *(LAS u32x4*)(lds + SS_X + xph * 15360 + 10240 + xrow * 80 + xch * 16) = pack8(w0, w1); }
            }
            __syncthreads();
            {
                const LAS unsigned char* gb = lds + SS_G + (16 * ti + fr) * 160 + fq * 16;
                const LAS unsigned char* cbp = lds + SS_C + (16 * ti + fr) * 288 + fq * 16;
                const unsigned btr = (unsigned)(size_t)(lds + SS_B) + (unsigned)((8 * fq + (fr >> 2)) * 288 + (fr & 3) * 8 + wid * 32);
                bf16x8 gf[2], cf[4], btf[2];
#pragma unroll
                for (int ks = 0; ks < 2; ++ks) gf[ks] = *(const LAS bf16x8*)(gb + ks * 64);
#pragma unroll
                for (int kn = 0; kn < 4; ++kn) cf[kn] = *(const LAS bf16x8*)(cbp + kn * 64);
#pragma unroll
                for (int ks = 0; ks < 2; ++ks) btf[ks] = tr_frag(btr + ks * 9216, btr + ks * 9216 + 1152);
                const int t0 = 16 * ti + 4 * fq;
                f32x4 eav; eav[0] = __expf(ct4[0]); eav[1] = __expf(ct4[1]); eav[2] = __expf(ct4[2]); eav[3] = __expf(ct4[3]);
                const float dec = __expf(cal);
                const bool wr_out = !(l == 1 && cin < 4);
#pragma unroll
                for (int ph = 0; ph < 2; ++ph) {
                    f32x4 y1 = (f32x4){0.f, 0.f, 0.f, 0.f}, y2 = y1;
                    const LAS unsigned char* sb = lds + SS_S + ph * 9216 + (16 * wh + fr) * 288 + fq * 16;
                    const unsigned xtr = (unsigned)(size_t)(lds + SS_X + ph * 15360 + 5120) + (unsigned)((8 * fq + (fr >> 2)) * 80 + (fr & 3) * 8);
                    bf16x8 xf[2], sf[4], xw0f[2], xw1f[2];
#pragma unroll
                    for (int kn = 0; kn < 4; ++kn) sf[kn] = *(const LAS bf16x8*)(sb + kn * 64);
                    { const unsigned xa_[6] = {xtr + wh * 32, xtr + 2560 + wh * 32, xtr + 5120, xtr + 5120 + 32, xtr + 5120 + 2560, xtr + 5120 + 2560 + 32}; bf16x8 xq[6]; tr_frag6(xa_, 320, xq);
                      xf[0] = xq[0]; xf[1] = xq[1]; xw0f[0] = xq[2]; xw1f[0] = xq[3]; xw0f[1] = xq[4]; xw1f[1] = xq[5]; }
                    __builtin_amdgcn_sched_barrier(0);
#pragma unroll
                    for (int ks = 0; ks < 2; ++ks) y1 = __builtin_amdgcn_mfma_f32_16x16x32_bf16(gf[ks], xf[ks], y1, 0, 0, 0);
#pragma unroll
                    for (int kn = 0; kn < 4; ++kn) y2 = __builtin_amdgcn_mfma_f32_16x16x32_bf16(cf[kn], sf[kn], y2, 0, 0, 0);
#pragma unroll
                    for (int r = 0; r < 4; ++r) {
                        float yv = y1[r] + eav[r] * y2[r];
                        if (dir == 0) yv += dskip * bf2f(*(const LAS bf16_t*)(lds + SS_X + ph * 15360 + (t0 + r) * 80 + (16 * wh + fr) * 2));
                        if (wr_out) OUT[(size_t)(rbase + n0 + t0 + r) * 1024 + hd * 64 + ph * 32 + 16 * wh + fr] = (bf16_t)f2bf(yv);
                    }
                    Sacc[ph][0] = Sacc[ph][0] * dec; Sacc[ph][1] = Sacc[ph][1] * dec;
#pragma unroll
                    for (int ks = 0; ks < 2; ++ks) {
                        Sacc[ph][0] = __builtin_amdgcn_mfma_f32_16x16x32_bf16(btf[ks], xw0f[ks], Sacc[ph][0], 0, 0, 0);
                        Sacc[ph][1] = __builtin_amdgcn_mfma_f32_16x16x32_bf16(btf[ks], xw1f[ks], Sacc[ph][1], 0, 0, 0); }
                    __builtin_amdgcn_sched_barrier(0);
                }
            }
            __syncthreads();
#pragma unroll
            for (int ph = 0; ph < 2; ++ph) { const int ncol = (16 * wid + 4 * fq) * 2;
              *(LAS u32x2*)(lds + SS_S + ph * 9216 + fr * 288 + ncol) = pack4(Sacc[ph][0]);
              *(LAS u32x2*)(lds + SS_S + ph * 9216 + (16 + fr) * 288 + ncol) = pack4(Sacc[ph][1]); }
        }
        if (cn < 68) {
            const int cin = cn < 4 ? (dir ? 3 - cn : cn) : 4 + (dir ? 67 - cn : cn - 4); const size_t gb = (size_t)((b * 68 + cin) * 32 + dir * 16 + hd) * 64;
            cs0 = *(const f32x4*)(ACS + gb + gs0); cs1 = *(const f32x4*)(ACS + gb + gs0 + 16); csw = ACS[gb + xrow]; cdw = SDT[gb + xrow];
            ct4 = *(const f32x4*)(ACS + gb + gt0); cat = ACS[gb + gt]; cal = ACS[gb + jl];
#pragma unroll
            for (int j = 0; j < 2; ++j) { const int q = tid + NTHR * j;
                *(LAS u32x4*)(lds + SS_C + (q >> 4) * 288 + (q & 15) * 16) = rc[j];
                *(LAS u32x4*)(lds + SS_B + (q >> 4) * 288 + (q & 15) * 16) = rb[j]; }
            *(LAS u32x4*)(lds + SS_X + xph * 15360 + xrow * 80 + xch * 16) = rx;
        }
        __syncthreads();
    }
}

__device__ __forceinline__ void mlstm_finish_rows(const Params& p, int l, int row_lo, int gw, int ngw) {
    if (p.dup) return;
    const int lane = tid_fresh() & 63;
    const bf16_t* HF = (const bf16_t*)(p.ws + WS_HF2); const bf16_t* HB = (const bf16_t*)(p.ws + WS_HB2);
    bf16_t* BR = (bf16_t*)(p.ws + WS_BR);
    const float* ng = p.mnorm_g + l * 1024;
    int row = row_lo + gw;
    u32x2 ca[4], cb[4], co[4], na[4], nbv[4], no[4];
    if (row < MT) { const size_t so = (size_t)scanrow(row) * 1024;
#pragma unroll
        for (int hd = 0; hd < 4; ++hd) { const int c = hd * 256 + 4 * lane; ca[hd] = *(const u32x2*)(HF + so + c); cb[hd] = *(const u32x2*)(HB + so + c); co[hd] = *(const u32x2*)(BR + (size_t)row * 3072 + 1024 + c); } }
    for (; row < MT; row += ngw) {
        const int rn = row + ngw;
        if (rn < MT) { const size_t so = (size_t)scanrow(rn) * 1024;
#pragma unroll
            for (int hd = 0; hd < 4; ++hd) { const int c = hd * 256 + 4 * lane; na[hd] = *(const u32x2*)(HF + so + c); nbv[hd] = *(const u32x2*)(HB + so + c); no[hd] = *(const u32x2*)(BR + (size_t)rn * 3072 + 1024 + c); } }
#pragma unroll
        for (int hd = 0; hd < 4; ++hd) { const int c = hd * 256 + 4 * lane;
            const u32x2 a = ca[hd], b2 = cb[hd], o = co[hd];
            f32x4 h; h[0] = lo16(a.x) + lo16(b2.x); h[1] = hi16(a.x) + hi16(b2.x); h[2] = lo16(a.y) + lo16(b2.y); h[3] = hi16(a.y) + hi16(b2.y);
            const float ss = wave_sum((h[0] * h[0] + h[1] * h[1]) + (h[2] * h[2] + h[3] * h[3]));
            const float rs = __builtin_amdgcn_rsqf(ss * (1.f / 256.f) + EPS);
            const f32x4 g = *(const f32x4*)(ng + c);
            f32x4 r; r[0] = sigmoid_f(lo16(o.x)) * (h[0] * rs * g[0]); r[1] = sigmoid_f(hi16(o.x)) * (h[1] * rs * g[1]);
            r[2] = sigmoid_f(lo16(o.y)) * (h[2] * rs * g[2]); r[3] = sigmoid_f(hi16(o.y)) * (h[3] * rs * g[3]);
            u32x2 w; w.x = pk2(r[0], r[1]); w.y = pk2(r[2], r[3]);
            *(u32x2*)(BR + (size_t)row * 3072 + 1024 + c) = w; }
#pragma unroll
        for (int hd = 0; hd < 4; ++hd) { ca[hd] = na[hd]; cb[hd] = nbv[hd]; co[hd] = no[hd]; }
    }
}
__device__ __forceinline__ void ssd_finish_rows(const Params& p, int l, int row_lo, int gw, int ngw) {
    if (p.dup) return;
    const int lane = tid_fresh() & 63;
    const bf16_t* YF = (const bf16_t*)(p.ws + WS_YF); const bf16_t* YB = (const bf16_t*)(p.ws + WS_YB);
    bf16_t* BR = (bf16_t*)(p.ws + WS_BR);
    const float* ng = p.snorm_g + l * 1024;
    int row = row_lo + gw;
    u32x2 ca[4], cb[4], cz[4], na[4], nbv[4], nz[4];
    if (row < MT) {
#pragma unroll
        for (int j = 0; j < 4; ++j) { const int c = 4 * lane + 256 * j; ca[j] = *(const u32x2*)(YF + (size_t)row * 1024 + c); cb[j] = *(const u32x2*)(YB + (size_t)row * 1024 + c); cz[j] = *(const u32x2*)(BR + (size_t)row * 3072 + 2048 + c); } }
    for (; row < MT; row += ngw) {
        const int rn = row + ngw;
        if (rn < MT) {
#pragma unroll
            for (int j = 0; j < 4; ++j) { const int c = 4 * lane + 256 * j; na[j] = *(const u32x2*)(YF + (size_t)rn * 1024 + c); nbv[j] = *(const u32x2*)(YB + (size_t)rn * 1024 + c); nz[j] = *(const u32x2*)(BR + (size_t)rn * 3072 + 2048 + c); } }
        f32x4 v[4]; float ss = 0.f;
#pragma unroll
        for (int j = 0; j < 4; ++j) { const u32x2 a = ca[j], b2 = cb[j], z = cz[j];
            v[j][0] = (lo16(a.x) + lo16(b2.x)) * silu_f(lo16(z.x)); v[j][1] = (hi16(a.x) + hi16(b2.x)) * silu_f(hi16(z.x));
            v[j][2] = (lo16(a.y) + lo16(b2.y)) * silu_f(lo16(z.y)); v[j][3] = (hi16(a.y) + hi16(b2.y)) * silu_f(hi16(z.y));
            ss += (v[j][0] * v[j][0] + v[j][1] * v[j][1]) + (v[j][2] * v[j][2] + v[j][3] * v[j][3]); }
        const float rs = __builtin_amdgcn_rsqf(wave_sum(ss) * (1.f / 1024.f) + EPS);
#pragma unroll
        for (int j = 0; j < 4; ++j) { const int c = 4 * lane + 256 * j; const f32x4 g = *(const f32x4*)(ng + c);
            u32x2 w; w.x = pk2(v[j][0] * rs * g[0], v[j][1] * rs * g[1]); w.y = pk2(v[j][2] * rs * g[2], v[j][3] * rs * g[3]);
            *(u32x2*)(BR + (size_t)row * 3072 + 2048 + c) = w; }
#pragma unroll
        for (int j = 0; j < 4; ++j) { ca[j] = na[j]; cb[j] = nbv[j]; cz[j] = nz[j]; }
    }
}

__device__ __forceinline__ void phase_route(const Params& p, int l, unsigned char* ldsb, int bid, int nb) {
    constexpr int RT_ROW = 2064, RT_HI = 0, RT_LO = 16 * RT_ROW, RT_RED = 32 * RT_ROW, RT_LG = RT_RED + 8 * 64 * 48, RT_HIST = RT_LG + 16 * 36 * 4;
    float* lds = reinterpret_cast<float*>(ldsb);
    LAS unsigned char* L = (LAS unsigned char*)ldsb;
    LAS int* hist = (LAS int*)(L + RT_HIST);
    const int tid = tid_fresh(), lane = tid & 63, wave = __builtin_amdgcn_readfirstlane(tid >> 6), fr = lane & 15, fq = lane >> 4;
    const int row_lo = l == 0 ? 0 : MC, rpb = l == 0 ? 68 : 64;
    const float* wrg = p.w_rg + (size_t)l * 1024 * 4; const float* wre = p.w_re + (size_t)l * 1024 * 32;
    bf16x8 whi[4][3], wlo[4][3];
#pragma unroll
    for (int s = 0; s < 4; ++s)
#pragma unroll
        for (int nt = 0; nt < 3; ++nt) { float w[8]; unsigned h[4], lo_[4];
#pragma unroll
            for (int i = 0; i < 8; ++i) { const int k = 128 * wave + 32 * s + 8 * fq + i; w[i] = nt < 2 ? wre[k * 32 + 16 * nt + fr] : (fr < 4 ? wrg[k * 4 + fr] : 0.f); }
#pragma unroll
            for (int i = 0; i < 4; ++i) { h[i] = pk2(w[2 * i], w[2 * i + 1]); lo_[i] = pk2(w[2 * i] - lo16(h[i]), w[2 * i + 1] - hi16(h[i])); }
            whi[s][nt] = __builtin_bit_cast(bf16x8, (u32x4){h[0], h[1], h[2], h[3]}); wlo[s][nt] = __builtin_bit_cast(bf16x8, (u32x4){lo_[0], lo_[1], lo_[2], lo_[3]}); }
    const float* mod = (const float*)(p.ws + WS_MOD) + l * 5 * 6144;
    int* EID = (int*)(p.ws + WS_EID); float* EWT = (float*)(p.ws + WS_EWT);
    for (int vb = bid; vb < 256; vb += nb) {
        if (tid < 32) hist[tid] = 0;
        __syncthreads();
        for (int r0 = 0; r0 < rpb; r0 += 16) {
#pragma unroll
            for (int half = 0; half < 2; ++half) {
                const int tr = wave + 8 * half, rr = r0 + tr;
                if (rr < rpb) {
                    const int row = row_lo + vb * rpb + rr;
                    f32x4 v[4];
                    const float* mr = mod + modrow(row) * 6144;
                    { const bool from_in = (l == 0) && !p.dup;
                      const float* res = row < MC ? p.ctx + (size_t)row * 1024 : p.x + (size_t)(row - MC) * 1024;
                      bf16_t* xlr = (bf16_t*)(p.ws + WS_XL) + (size_t)row * 1024;
                      u32x2 o2[4];
#pragma unroll
                      for (int j = 0; j < 4; ++j) {
                          if (from_in) v[j] = *(const f32x4*)(res + 4 * lane + 256 * j);
                          else { const u32x2 xr = *(const u32x2*)(xlr + 4 * lane + 256 * j); v[j] = (f32x4){lo16(xr.x), hi16(xr.x), lo16(xr.y), hi16(xr.y)}; }
                          o2[j] = *(const u32x2*)((const bf16_t*)(p.ws + WS_OL) + (size_t)row * 1024 + 4 * lane + 256 * j); }
                      if (!p.dup) {
#pragma unroll
                          for (int j = 0; j < 4; ++j) { const f32x4 g2 = *(const f32x4*)(mr + 2 * 1024 + 4 * lane + 256 * j);
                              v[j][0] += g2[0] * lo16(o2[j].x); v[j][1] += g2[1] * hi16(o2[j].x); v[j][2] += g2[2] * lo16(o2[j].y); v[j][3] += g2[3] * hi16(o2[j].y);
                              *(u32x2*)(xlr + 4 * lane + 256 * j) = pack4(v[j]); } } }
                    norm_mod_row(v, p.g_ffn + l * 1024, mr + 3 * 1024, mr + 4 * 1024, lane);
#pragma unroll
                    for (int j = 0; j < 4; ++j) { u32x2 h, lo_;
                        h.x = pk2(v[j][0], v[j][1]); h.y = pk2(v[j][2], v[j][3]);
                        lo_.x = pk2(v[j][0] - lo16(h.x), v[j][1] - hi16(h.x)); lo_.y = pk2(v[j][2] - lo16(h.y), v[j][3] - hi16(h.y));
                        *(u32x2*)((bf16_t*)(p.ws + WS_H) + (size_t)row * 1024 + 4 * lane + 256 * j) = h;
                        *(LAS u32x2*)(L + RT_HI + tr * RT_ROW + (4 * lane + 256 * j) * 2) = h;
                        *(LAS u32x2*)(L + RT_LO + tr * RT_ROW + (4 * lane + 256 * j) * 2) = lo_; }
                }
            }
            __syncthreads();
            { f32x4 acc[3] = {(f32x4){0.f, 0.f, 0.f, 0.f}, (f32x4){0.f, 0.f, 0.f, 0.f}, (f32x4){0.f, 0.f, 0.f, 0.f}};
              bf16x8 ah[4], al[4];
#pragma unroll
              for (int s = 0; s < 4; ++s) { const int ko = (128 * wave + 32 * s + 8 * fq) * 2;
                  ah[s] = *(const LAS bf16x8*)(L + RT_HI + fr * RT_ROW + ko); al[s] = *(const LAS bf16x8*)(L + RT_LO + fr * RT_ROW + ko); }
#pragma unroll
              for (int s = 0; s < 4; ++s)
#pragma unroll
                  for (int nt = 0; nt < 3; ++nt) {
                      acc[nt] = __builtin_amdgcn_mfma_f32_16x16x32_bf16(ah[s], whi[s][nt], acc[nt], 0, 0, 0);
                      acc[nt] = __builtin_amdgcn_mfma_f32_16x16x32_bf16(ah[s], wlo[s][nt], acc[nt], 0, 0, 0);
                      acc[nt] = __builtin_amdgcn_mfma_f32_16x16x32_bf16(al[s], whi[s][nt], acc[nt], 0, 0, 0); }
#pragma unroll
              for (int nt = 0; nt < 3; ++nt) *(LAS f32x4*)(L + RT_RED + (wave * 64 + lane) * 48 + nt * 16) = acc[nt]; }
            __syncthreads();
            { const int m = tid >> 5, n = tid & 31; float s = 0.f;
#pragma unroll
              for (int w = 0; w < 8; ++w) s += *(const LAS float*)(L + RT_RED + (w * 64 + (m >> 2) * 16 + (n & 15)) * 48 + ((n >> 4) * 4 + (m & 3)) * 4);
              *(LAS float*)(L + RT_LG + (m * 36 + 4 + n) * 4) = s;
              if (tid < 64) { const int m2 = tid >> 2, g = tid & 3; float s2 = 0.f;
#pragma unroll
                  for (int w = 0; w < 8; ++w) s2 += *(const LAS float*)(L + RT_RED + (w * 64 + (m2 >> 2) * 16 + g) * 48 + (8 + (m2 & 3)) * 4);
                  *(LAS float*)(L + RT_LG + (m2 * 36 + g) * 4) = s2; } }
            __syncthreads();
            if (tid < 16 && r0 + tid < rpb) {
                const int row = row_lo + vb * rpb + r0 + tid;
                const LAS float* lg = (const LAS float*)(L + RT_LG + tid * 36 * 4);
                float gl[4]; int gi = 0; float gmax;
#pragma unroll
                for (int g = 0; g < 4; ++g) gl[g] = lg[g] + p.b_rg[l * 4 + g];
                gmax = gl[0];
#pragma unroll
                for (int g = 1; g < 4; ++g) if (gl[g] > gmax) { gmax = gl[g]; gi = g; }
                float den = 0.f;
#pragma unroll
                for (int g = 0; g < 4; ++g) den += __expf(gl[g] - gmax);
                const float pg = 1.f / den;
                float v1 = -3.0e38f, v2 = -3.0e38f; int i1 = 0, i2 = 0;
#pragma unroll
                for (int j = 0; j < 8; ++j) { const float x = lg[4 + gi * 8 + j] + p.b_re[l * 32 + gi * 8 + j];
                    if (x > v1) { v2 = v1; i2 = i1; v1 = x; i1 = j; } else if (x > v2) { v2 = x; i2 = j; } }
                const float e2 = __expf(v2 - v1), w1 = pg / (1.f + e2), w2 = pg * e2 / (1.f + e2);
                EID[row * 2] = gi * 8 + i1; EID[row * 2 + 1] = gi * 8 + i2; EWT[row * 2] = w1; EWT[row * 2 + 1] = w2;
                atomicAdd((int*)&hist[gi * 8 + i1], 1); atomicAdd((int*)&hist[gi * 8 + i2], 1);
            }
        }
        __syncthreads();
        if (tid < 32) ((int*)(p.ws + WS_HIST))[vb * 32 + tid] = hist[tid];
        __syncthreads();
    }
    __syncthreads();
    float* scr = lds + wave * (64 * 65);
    if (nb != 256) { const int lm = l + 1 < 2 ? l + 1 : -1;
      convert_list(p, l, lm, 0, 8192, bid * 8 + wave, nb * 8, scr, lane);
      convert_list(p, l, lm, 1, 4096 + (lm >= 0 ? CV_MIX_ITEMS : 0), bid * 8 + wave, nb * 8, scr, lane); }
}

__device__ __forceinline__ void phase_scatter(const Params& p, int l, unsigned char* ldsb, int bid, int nb) {
    int* li = reinterpret_cast<int*>(ldsb);
    int* tot = li; int* pre = li + 32; int* pst = li + 64; int* ea = li + 128; int* pos = li + 384;
    const int tid = tid_fresh(), lane = tid & 63, wave = tid >> 6;
    const int row_lo = l == 0 ? 0 : MC, rpb = l == 0 ? 68 : 64;
    const int* HIST = (const int*)(p.ws + WS_HIST); const int* EID = (const int*)(p.ws + WS_EID);
    int* SLOT = (int*)(p.ws + WS_SLOT);
    for (int vb = bid; vb < 256; vb += nb) {
        __syncthreads();
        { const int e = tid & 31, jg = tid >> 5; int hv[16];
#pragma unroll
          for (int i = 0; i < 16; ++i) hv[i] = HIST[(jg * 16 + i) * 32 + e];
          int t = 0, pr = 0;
#pragma unroll
          for (int i = 0; i < 16; ++i) { t += hv[i]; pr += (jg * 16 + i < vb) ? hv[i] : 0; }
          li[512 + jg * 32 + e] = t; li[1024 + jg * 32 + e] = pr; }
        __syncthreads();
        if (tid < 32) { int t = 0, pr = 0;
#pragma unroll
            for (int g = 0; g < 16; ++g) { t += li[512 + g * 32 + tid]; pr += li[1024 + g * 32 + tid]; }
            tot[tid] = t; pre[tid] = pr; }
        __syncthreads();
        if (tid == 0) { int s = 0; for (int e = 0; e < 32; ++e) { pst[e] = s; s += ((tot[e] + 255) >> 8) << 8; }
            if (vb == 0) { int* BE = (int*)(p.ws + WS_BLKEXP); int nblk = 0;
                for (int e = 0; e < 32; ++e) { const int nbk = (tot[e] + 255) >> 8; for (int j = 0; j < nbk; ++j) BE[nblk++] = e; }
                BE[200] = nblk; } }
        if (tid < rpb * 2) ea[tid] = EID[(row_lo + vb * rpb) * 2 + tid];
        __syncthreads();
        if (tid < rpb * 2) { const int e = ea[tid]; int rk = 0; for (int j = 0; j < tid; ++j) rk += (ea[j] == e) ? 1 : 0;
            const int ps = pst[e] + pre[e] + rk; SLOT[(row_lo + vb * rpb) * 2 + tid] = ps; ((int*)(p.ws + WS_TOK))[ps] = row_lo + vb * rpb + (tid >> 1); }
        if (vb == 0 && tid < 32) { int* TOK = (int*)(p.ws + WS_TOK); const int e0 = pst[tid] + tot[tid], e1 = pst[tid] + (((tot[tid] + 255) >> 8) << 8);
            for (int q = e0; q < e1; ++q) TOK[q] = row_lo; }
    }
    __syncthreads();
}

__device__ __forceinline__ void phase_combine(const Params& p, int l, int bid, int nb) {
    if (p.dup && l == 0) return;
    const int lane = tid_fresh() & 63, wave = tid_fresh() >> 6;
    const float* mod = (const float*)(p.ws + WS_MOD);
    const int* SLOT = (const int*)(p.ws + WS_SLOT); const float* EWT = (const float*)(p.ws + WS_EWT);
    const bf16_t* Y = (const bf16_t*)(p.ws + WS_Y);
    bf16_t* XL = (bf16_t*)(p.ws + WS_XL);
    const int row_lo = l == 0 ? 0 : MC, stride = nb * 8;
    for (int rowA = row_lo + bid * 8 + wave; rowA < MT; rowA += 2 * stride) {
        const int rowB = rowA + stride; const bool hasB = rowB < MT; const int rb = hasB ? rowB : rowA;
        const int sA0 = SLOT[rowA * 2], sA1 = SLOT[rowA * 2 + 1], sB0 = SLOT[rb * 2], sB1 = SLOT[rb * 2 + 1];
        const float wA0 = EWT[rowA * 2], wA1 = EWT[rowA * 2 + 1], wB0 = EWT[rb * 2], wB1 = EWT[rb * 2 + 1];
        u32x2 yA0[4], yA1[4], yB0[4], yB1[4], xA[4], xB[4];
#pragma unroll
        for (int j = 0; j < 4; ++j) { const int c = 4 * lane + 256 * j;
            yA0[j] = *(const u32x2*)(Y + (size_t)sA0 * 1024 + c); yA1[j] = *(const u32x2*)(Y + (size_t)sA1 * 1024 + c); xA[j] = *(const u32x2*)(XL + (size_t)rowA * 1024 + c);
            yB0[j] = *(const u32x2*)(Y + (size_t)sB0 * 1024 + c); yB1[j] = *(const u32x2*)(Y + (size_t)sB1 * 1024 + c); xB[j] = *(const u32x2*)(XL + (size_t)rb * 1024 + c); }
#pragma unroll
        for (int half = 0; half < 2; ++half) {
            if (half == 1 && !hasB) break;
            const int row = half ? rowB : rowA; const float w0 = half ? wB0 : wA0, w1 = half ? wB1 : wA1;
            const float* g5 = mod + (l * 5 + modrow(row)) * 6144 + 5 * 1024;
            f32x4 v[4];
#pragma unroll
            for (int j = 0; j < 4; ++j) { const int c = 4 * lane + 256 * j;
                const u32x2 a = half ? yB0[j] : yA0[j], b2 = half ? yB1[j] : yA1[j];
                f32x4 y; y[0] = w0 * lo16(a.x) + w1 * lo16(b2.x); y[1] = w0 * hi16(a.x) + w1 * hi16(b2.x); y[2] = w0 * lo16(a.y) + w1 * lo16(b2.y); y[3] = w0 * hi16(a.y) + w1 * hi16(b2.y);
                const u32x2 xr = half ? xB[j] : xA[j];
                v[j] = (f32x4){lo16(xr.x), hi16(xr.x), lo16(xr.y), hi16(xr.y)} + *(const f32x4*)(g5 + c) * y; }
            if (l == 0) {
#pragma unroll
                for (int j = 0; j < 4; ++j) *(u32x2*)(XL + (size_t)row * 1024 + 4 * lane + 256 * j) = pack4(v[j]);
                const float* mr = mod + (5 + modrow(row)) * 6144;
                norm_mod_row(v, p.g_mix + 1024, mr, mr + 1024, lane);
                store_row_bf16((bf16_t*)(p.ws + WS_H) + (size_t)row * 1024, v, lane);
            } else {
                norm_mod_row(v, p.g_final, nullptr, nullptr, lane);
                float* o = p.out + (size_t)(row - MC) * 1024;
#pragma unroll
                for (int j = 0; j < 4; ++j) *(f32x4*)(o + 4 * lane + 256 * j) = v[j];
            }
        }
    }
}

#define XB_TMO      128
#define XB_XCNT(j)  (256  + 64 * (j))
#define XB_XSUB(j)  (1280 + 64 * (j))
#define XB_XGEN(j)  (2304 + 64 * (j))
#define XB_TOP      3328
#define XB_TOPGEN   3392
#define XCD_BAR_WORDS 3456
#define XB_SSD_DONE(l) (3520 + 64 * (l))
#define XB_SPIN_CAP (1u << 18)
__device__ __forceinline__ unsigned xb_ld(unsigned* p)              { return __hip_atomic_load(p, __ATOMIC_RELAXED, __HIP_MEMORY_SCOPE_AGENT); }
__device__ __forceinline__ unsigned xb_add(unsigned* p, unsigned v) { return __hip_atomic_fetch_add(p, v, __ATOMIC_RELAXED, __HIP_MEMORY_SCOPE_AGENT); }
__device__ __forceinline__ unsigned xb_xcc_id() { return (unsigned)__builtin_amdgcn_s_getreg((3 << 11) | 20) & 0xFu; }
#define XB_SPIN(cond, bar) do { unsigned _sp = 0; while (cond) { __builtin_amdgcn_s_sleep(1); \
    if ((++_sp & 255u) == 0u) { if (xb_ld(&(bar)[XB_TMO])) break; if (_sp > XB_SPIN_CAP) { atomicAdd(&(bar)[XB_TMO], 1u); break; } } } } while (0)
constexpr int NPH_L = 12, NPHASES = 1 + 2 * NPH_L;
__device__ __forceinline__ void run_phase(const Params& p, int ph, unsigned char* lds) {
    const int bid = blockIdx.x, nb = gridDim.x;
    const int wave = tid_fresh() >> 6;
#ifndef ONLY_S
    if (ph == 0) { phase_pre(p, lds, bid, nb); return; }
#else
    if (ph == 0) { if (ONLY_S == 99) phase_pre(p, lds, bid, nb); return; }
#endif
    const int l = (ph - 1) / NPH_L, s = (ph - 1) % NPH_L;
    unsigned char* ws = p.ws;
    const int pm0 = l == 0 ? 0 : 4, nMrows = l == 0 ? 68 : 64, row_lo = l == 0 ? 0 : MC;
#ifdef ONLY_S
    if (s != ONLY_S) return;
#endif
    switch (s) {
    case 0: if (l == 0) phase_norm1(p, bid, nb); break;
    case 1: { EpiInproj E{ws};
              if (l == 0) { SchedGrid S{(const bf16_t*)(ws + WS_H), (const bf16_t*)(ws + WS_WIN), 1024, 1024, 0, 68, 45, nb, bid}; gemm_run(lds, S, E, 1024, 1024, 1024, 1); }
              else { SchedInproj1 S{(const bf16_t*)(ws + WS_H), (const bf16_t*)(ws + WS_WIN + WS_W1OFS), nb, bid}; gemm_run(lds, S, E, 1024, 1024, 1024, 1); } } break;
    case 2: {
              { LAS float* img = (LAS float*)lds; const int tid = tid_fresh();
                for (int i = tid; i < 10240; i += NTHR) { img[i] = i < 8192 ? p.mconv_w[(size_t)l * 8192 + i] : p.mconv_b[(size_t)l * 2048 + (i - 8192)];
                                                          img[10240 + i] = i < 8192 ? p.sconv_w[(size_t)l * 8192 + i] : p.sconv_b[(size_t)l * 2048 + (i - 8192)]; } }
              __syncthreads();
              {
                const LAS float* img = (const LAS float*)lds;
                const int v0 = (bid * 1088) / nb, v1 = ((bid + 1) * 1088) / nb;
                RawM Ra, Rb;
                if (v0 < v1) conv_m_load(p, (v0 % 272) * 4 + v0 / 272, Ra);
                for (int v = v0; v < v1; v += 2) {
                    if (v + 1 < v1) conv_m_load(p, ((v + 1) % 272) * 4 + (v + 1) / 272, Rb);
                    conv_m_compute(p, l, (v % 272) * 4 + v / 272, Ra, img);
                    if (v + 1 >= v1) break;
                    if (v + 2 < v1) conv_m_load(p, ((v + 2) % 272) * 4 + (v + 2) / 272, Ra);
                    conv_m_compute(p, l, ((v + 1) % 272) * 4 + (v + 1) / 272, Rb, img); } }
              { const LAS float* img = (const LAS float*)lds + 10240;
                const int v0 = (bid * 1088) / nb, v1 = ((bid + 1) * 1088) / nb;
                RawS Ra, Rb;
                if (v0 < v1) conv_s_load(p, (v0 % 272) * 4 + v0 / 272, Ra);
                for (int v = v0; v < v1; v += 2) {
                    if (v + 1 < v1) conv_s_load(p, ((v + 1) % 272) * 4 + (v + 1) / 272, Rb);
                    conv_s_compute(p, l, (v % 272) * 4 + v / 272, Ra, img);
                    if (v + 1 >= v1) break;
                    if (v + 2 < v1) conv_s_load(p, ((v + 2) % 272) * 4 + (v + 2) / 272, Ra);
                    conv_s_compute(p, l, ((v + 1) % 272) * 4 + (v + 1) / 272, Rb, img); } }
              if (!p.dup) for (int it = bid; it < (l == 0 ? 272 : 256); it += nb) pool_window_item(p, it, (LAS unsigned char*)lds); } break;
    case 3: {
              int pool_c = bid, pool_g = nb;
              unsigned* sbar = (unsigned*)(ws + WS_BAR) + XB_SSD_DONE(l);
              if (nb == 256) { const int x = bid & 7, y = bid >> 3;
                  if (y < 16) { mlstm_chunk_item(p, l, (((y >> 3) * 8 + x) << 3) | (y & 7), (LAS unsigned char*)lds); pool_c = -1;
}
                  else { ssd_chunk_item(p, l, ((((y - 16) >> 3) * 8 + x) << 3) | ((y - 16) & 7), (LAS unsigned char*)lds); pool_c = (y - 16) * 8 + x; pool_g = 128;
                      asm volatile("s_waitcnt vmcnt(0)" ::: "memory"); __syncthreads();
                      if (tid_fresh() == 0) { __builtin_amdgcn_fence(__ATOMIC_RELEASE, "agent"); asm volatile("s_waitcnt vmcnt(0)" ::: "memory"); (void)xb_add(sbar, 1u); } } }
              else { for (int it = bid; it < 256; it += nb) { if (it < 128) mlstm_chunk_item(p, l, it, (LAS unsigned char*)lds); else ssd_chunk_item(p, l, it - 128, (LAS unsigned char*)lds); } }
              if (pool_c >= 0 && !p.dup) { SchedPool S{(const bf16_t*)(ws + WS_BR), (const bf16_t*)(ws + WS_WPOOL + (l ? WS_W1OFS : 0)), pm0, nMrows, pool_g, pool_c}; EpiPool E{(bf16_t*)(ws + WS_BR)};
                  gemm_run(lds, S, E, 256, 3072, 256, 1); }
              if (nb == 256 && bid >= 128) {
                  if (tid_fresh() == 0) { XB_SPIN(xb_ld(sbar) < 128u, (unsigned*)(ws + WS_BAR)); __builtin_amdgcn_fence(__ATOMIC_ACQUIRE, "agent"); asm volatile("s_waitcnt vmcnt(0)" ::: "memory"); }
                  __syncthreads();
                  ssd_finish_rows(p, l, row_lo, (bid - 128) * 8 + wave, 128 * 8);
                  asm volatile("s_waitcnt vmcnt(0)" ::: "memory"); __syncthreads();
                  if (tid_fresh() == 0) (void)xb_add(sbar + 128, 1u);
                  convert_list(p, l, -1, 0, 8192, (bid - 128) * 8 + wave, 128 * 8, reinterpret_cast<float*>(lds) + wave * (64 * 65), tid_fresh() & 63);
                  if (tid_fresh() == 0) { XB_SPIN(xb_ld(sbar + 128) < 128u, (unsigned*)(ws + WS_BAR)); }
                  __syncthreads();
                  convert_list(p, l, -1, 1, 4096, (bid - 128) * 8 + wave, 128 * 8, reinterpret_cast<float*>(lds) + wave * (64 * 65), tid_fresh() & 63);
                  if (l == 0) convert_list(p, l, 1, 1, 4096 + CV_MIX_ITEMS, 4096 + (bid - 128) * 8 + wave, 128 * 8, reinterpret_cast<float*>(lds) + wave * (64 * 65), tid_fresh() & 63);
                  if (PROF_S == 40 && bid == 255 && tid_fresh() == 0) ((volatile LAS unsigned long long*)((LAS unsigned char*)lds + 163000))[32 + l] = __builtin_amdgcn_s_memrealtime(); } } break;
    case 4: { mlstm_finish_rows(p, l, row_lo, bid * 8 + wave, nb * 8); if (nb != 256) ssd_finish_rows(p, l, row_lo, bid * 8 + wave, nb * 8); } break;
    case 5: { SchedGrid S{(const bf16_t*)(ws + WS_BR), (const bf16_t*)(ws + WS_WBR + (l ? WS_W1OFS : 0)), 3072, 3072, pm0, nMrows, 4, nb, bid}; EpiBranch E{(const bf16_t*)(ws + WS_MG), (bf16_t*)(ws + WS_MERGED)};
              gemm_run(lds, S, E, 3072, 3072, 3072, 3); } break;
    case 6: { SchedGrid S{(const bf16_t*)(ws + WS_MERGED), (const bf16_t*)(ws + WS_WOUT + (l ? WS_W1OFS : 0)), 1024, 1024, pm0, nMrows, 4, nb, bid}; EpiOut E{(bf16_t*)(ws + WS_OL)};
              gemm_run(lds, S, E, 1024, 1024, 1024, 1); } break;
    case 7: phase_route(p, l, lds, bid, nb); break;
    case 8: phase_scatter(p, l, lds, bid, nb); break;
    case 9: { const int* BE = (const int*)(ws + WS_BLKEXP);
              SchedMoe S{(const bf16_t*)(ws + WS_H), (const bf16_t*)(ws + WS_EW1), BE, (const int*)(ws + WS_TOK), 1024, BE[200], nb, bid, (size_t)1048576, (size_t)1024, 0}; EpiMoe1 E{(bf16_t*)(ws + WS_ACT)};
              gemm_run<true>(lds, S, E, 1024, 1024, 1024, 1); } break;
    case 10: { const int* BE = (const int*)(ws + WS_BLKEXP);
              SchedMoe S{(const bf16_t*)(ws + WS_ACT), (const bf16_t*)(ws + WS_EW2A), BE, nullptr, 512, BE[200], nb, bid, (size_t)524288, (size_t)512, EW2_SPLIT_OFF}; EpiMoe2 E{(bf16_t*)(ws + WS_Y)};
              gemm_run(lds, S, E, 512, 512, 512, 1); } break;
    case 11: phase_combine(p, l, bid, nb); break;
    }
}

__device__ __forceinline__ void xcd_barrier_complete(unsigned* bar, unsigned x, unsigned& nloc, unsigned& nx) {
    const unsigned G = gridDim.x * gridDim.y * gridDim.z;
    unsigned sum, cnt, mine, sp = 0u;
    for (;;) {
        sum = 0u; cnt = 0u; mine = 0u;
#pragma unroll
        for (unsigned j = 0; j < 16; ++j) { const unsigned c = xb_ld(&bar[XB_XCNT(j)]); sum += c; cnt += (c > 0u) ? 1u : 0u; mine = (j == x) ? c : mine; }
        if (sum == G) break;
        __builtin_amdgcn_s_sleep(1);
        if ((++sp & 255u) == 0u) { if (xb_ld(&bar[XB_TMO])) break; if (sp > XB_SPIN_CAP) { atomicAdd(&bar[XB_TMO], 1u); break; } }
    }
    nloc = mine > 0u ? mine : 1u; nx = cnt > 0u ? cnt : 1u;
}
__device__ __forceinline__ void xcd_barrier(unsigned* bar, volatile LAS unsigned* st) {
    asm volatile("s_waitcnt vmcnt(0)" ::: "memory");
    __syncthreads();
    if (threadIdx.x == 0) {
        __builtin_amdgcn_s_waitcnt(0);
        const unsigned x = xb_xcc_id();
        unsigned nloc = st[0], nx = st[1];
        if (nloc == 0u) { xcd_barrier_complete(bar, x, nloc, nx); st[0] = nloc; st[1] = nx; }
        const unsigned old = xb_add(&bar[XB_XSUB(x)], 1u);
        const unsigned gen = old / nloc;
        if (old + 1u == (gen + 1u) * nloc) {
            __builtin_amdgcn_fence(__ATOMIC_RELEASE, "agent");
            asm volatile("s_waitcnt vmcnt(0)" ::: "memory");
            const unsigned og = xb_add(&bar[XB_TOP], 1u);
            const unsigned tg = og / nx;
            if (og + 1u == (tg + 1u) * nx) xb_add(&bar[XB_TOPGEN], 1u);
            else XB_SPIN(xb_ld(&bar[XB_TOPGEN]) == tg, bar);
            __builtin_amdgcn_fence(__ATOMIC_ACQUIRE, "agent");
            xb_add(&bar[XB_XGEN(x)], 1u);
            asm volatile("s_waitcnt vmcnt(0)" ::: "memory");
        } else {
            XB_SPIN(xb_ld(&bar[XB_XGEN(x)]) == gen, bar);
            __builtin_amdgcn_fence(__ATOMIC_ACQUIRE, "agent");
            asm volatile("s_waitcnt vmcnt(0)" ::: "memory");
        }
    }
    __syncthreads();
}

constexpr int BAR_LDS_OFF = LDS_BYTES - 16;
__global__ void __launch_bounds__(NTHR, 2) fwd_kernel(Params pk) {
    extern __shared__ __attribute__((aligned(16))) unsigned char lds[];
    const Params& p = pk;
    const int lo = pk.ph_lo, hi = pk.ph_hi;
    unsigned* bar = (unsigned*)(pk.ws + WS_BAR);
    volatile LAS unsigned* bst = (volatile LAS unsigned*)((LAS unsigned char*)lds + BAR_LDS_OFF);
    if (hi - lo > 1) {
        if (threadIdx.x == 0) { bst[0] = 0u; bst[1] = 0u; (void)xb_add(&bar[XB_XCNT(xb_xcc_id())], 1u); }
        __syncthreads();
    }
#define STEP(k) if (lo <= (k) && (k) < hi) { \
    if (PROF_S >= 0 && blockIdx.x == PROF_BLK && threadIdx.x == 0) ((volatile LAS unsigned long long*)((LAS unsigned char*)lds + 163000))[k] = __builtin_amdgcn_s_memrealtime(); \
    run_phase(p, (k), lds); if ((k) + 1 < hi) { if (pk.dup < 0) cg::this_grid().sync(); else xcd_barrier(bar, bst); } }
    STEP(0) STEP(1) STEP(2) STEP(3) STEP(4) STEP(5) STEP(6) STEP(7) STEP(8) STEP(9) STEP(10) STEP(11) STEP(12)
    STEP(14) STEP(15) STEP(16) STEP(17) STEP(18) STEP(19) STEP(20) STEP(21) STEP(22) STEP(23) STEP(24)
#undef STEP
    if (PROF_S >= 0 && hi - lo > 1) {
        __syncthreads();
        if (blockIdx.x == PROF_BLK && threadIdx.x == 0) {
            volatile LAS unsigned long long* ts = (volatile LAS unsigned long long*)((LAS unsigned char*)lds + 163000);
            const unsigned long long tend = __builtin_amdgcn_s_memrealtime();
            float acc = 0.f;
            if (PROF_S == 40) { for (int l = 0; l < 2; ++l) acc += (float)(ts[1 + NPH_L * l + 4] - ts[32 + l]) * 0.001f; }
            for (int k = 0; k < NPHASES; ++k) { if (k == 1 + NPH_L) continue; const int s = k == 0 ? 14 : (k - 1) % NPH_L; if (s != PROF_S) continue;
                int kn = k + 1; if (kn == 1 + NPH_L) kn++; const unsigned long long t1 = kn < NPHASES ? ts[kn] : tend; acc += (float)(t1 - ts[k]) * 0.001f; }
            __threadfence(); atomicAdd(pk.out, acc);
        }
    }
}

extern "C" void kernel_launch(void* const* d_in, const int* in_sizes, int n_in, void* d_out, int out_size, void* d_ws, size_t ws_size, hipStream_t stream) {
    static int grid_blocks = 0;
    if (!grid_blocks) {
        if (n_in != 31 || ws_size < WS_END) { fprintf(stderr, "kernel_launch: unexpected n_in %d / ws_size %zu (need %zu)\n", n_in, ws_size, (size_t)WS_END); grid_blocks = -1; return; }
        int dev = 0, cus = 0, per_cu = 0;
        hipGetDevice(&dev);
        hipDeviceGetAttribute(&cus, hipDeviceAttributeMultiprocessorCount, dev);
        if (hipFuncSetAttribute((const void*)fwd_kernel, hipFuncAttributeMaxDynamicSharedMemorySize, LDS_BYTES) != hipSuccess) fprintf(stderr, "kernel_launch: hipFuncSetAttribute failed\n");
        hipOccupancyMaxActiveBlocksPerMultiprocessor(&per_cu, (const void*)fwd_kernel, NTHR, LDS_BYTES);
        if (per_cu < 1) { fprintf(stderr, "kernel_launch: occupancy query says %d blocks per CU\n", per_cu); per_cu = 1; }
        grid_blocks = cus * per_cu;
        (void)hipGetLastError();
    }
    if (grid_blocks < 0) return;
    Params p{};
    const float** dst = (const float**)&p;
    for (int i = 0; i < 31; ++i) dst[i] = (const float*)d_in[i];
    p.out = (float*)d_out; p.ws = (unsigned char*)d_ws;
#if SINGLE_LAUNCH
    if (hipMemsetAsync((char*)d_ws + WS_BAR, 0, 16384, stream) != hipSuccess) fprintf(stderr, "kernel_launch: hipMemsetAsync failed\n");
    p.ph_lo = 0; p.ph_hi = NPHASES;
    void* args[] = {&p};
    hipError_t e = hipLaunchCooperativeKernel((const void*)fwd_kernel, dim3(grid_blocks), dim3(NTHR), args, LDS_BYTES, stream);
    if (e != hipSuccess) fprintf(stderr, "cooperative launch failed: %s (grid %d)\n", hipGetErrorString(e), grid_blocks);
#else
    for (int ph = 0; ph < NPHASES; ++ph) {
        if (ph == 1 + NPH_L) continue;
        p.ph_lo = ph; p.ph_hi = ph + 1;
        hipLaunchKernelGGL(fwd_kernel, dim3(grid_blocks), dim3(NTHR), LDS_BYTES, stream, p);
        const int sidx = ph == 0 ? 14 : (ph - 1) % NPH_L;
        if ((PROBE_DUP_MASK >> sidx) & 1) { p.dup = 1; for (int r = 0; r < PROBE_DUP_N; ++r) hipLaunchKernelGGL(fwd_kernel, dim3(grid_blocks), dim3(NTHR), LDS_BYTES, stream, p); p.dup = 0; }
    }
#endif
}
```
